# Optimizing an MI355X kernel written in HIP

```python
import math
import jax, jax.numpy as jnp
from jax import lax
import numpy as np

D_MODEL = 1024
BATCH = 8
SEQ = 2048
DEPTH = 4
DEC_BATCH = 128
DEC_SEQ = 1
PAST_LEN = 16384
PAGE_SIZE = 128

HG_HEADS = 8
HG_DK = 128
HG_DV = D_MODEL // HG_HEADS
HG_WIDTH = HG_HEADS * HG_DK
HG_VWIDTH = HG_HEADS * HG_DV
HG_CHUNK = 32
SSM_EXPAND = 2
SSM_INNER = SSM_EXPAND * D_MODEL
SSM_HEADDIM = 64
SSM_HEADS = SSM_INNER // SSM_HEADDIM
SSM_GROUPS = 8
SSM_HPG = SSM_HEADS // SSM_GROUPS
SSM_STATE = 128
SSM_CONV = 4
SSM_CONV_CH = SSM_INNER + 2 * SSM_GROUPS * SSM_STATE
SSM_CHUNK = 64
D_FF = 4 * D_MODEL
N_ADA = 6
EPS = 1e-6
IN_SIZES = (HG_WIDTH, HG_WIDTH, HG_VWIDTH, HG_VWIDTH, SSM_INNER, SSM_CONV_CH, SSM_HEADS, D_MODEL, D_MODEL)
IN_WIDTH = sum(IN_SIZES)
IN_OFFSETS = tuple(int(v) for v in np.cumsum(IN_SIZES)[:-1])

kernel_name = "hgrn2_mamba2_gated_hybrid_step"


def _rmsnorm(x, w):
    xf = x.astype(jnp.float32)
    xf = xf * lax.rsqrt(jnp.mean(jnp.square(xf), axis=-1, keepdims=True) + EPS)
    return (xf * w.astype(jnp.float32)).astype(x.dtype)


def _chunk(a, C):
    B, T = a.shape[:2]
    pad = (-T) % C
    a = jnp.pad(a, [(0, 0), (0, pad)] + [(0, 0)] * (a.ndim - 2))
    a = a.reshape((B, (T + pad) // C, C) + a.shape[2:])
    return jnp.moveaxis(a, 1, 0)


def _unchunk(a, T):
    a = jnp.moveaxis(a, 0, 1)
    a = a.reshape((a.shape[0], -1) + a.shape[3:])
    return a[:, :T]


def _hgrn2_recurrence(q, k, v, logf, S0):
    T = q.shape[1]
    C = min(HG_CHUNK, T)
    xs = tuple(_chunk(a, C) for a in (q, k, v, logf))
    causal = jnp.tril(jnp.ones((C, C), dtype=bool))[None, :, :, None, None]

    def step(S, inp):
        qc, kc, vc, gc = inp
        b = jnp.cumsum(gc, axis=1)
        b_end = b[:, -1]
        o_inter = jnp.einsum('bihd,bhde->bihe', qc * jnp.exp(b), S)
        rel = b[:, :, None] - b[:, None, :]
        decay = jnp.exp(jnp.where(causal, rel, -jnp.inf))
        scores = jnp.einsum('bihd,bjhd,bijhd->bhij', qc, kc, decay)
        o_intra = jnp.einsum('bhij,bjhe->bihe', scores, vc)
        S = jnp.exp(b_end)[..., None] * S + jnp.einsum(
            'bjhd,bjhe->bhde', kc * jnp.exp(b_end[:, None] - b), vc)
        return S, o_inter + o_intra

    S, o = lax.scan(step, S0, xs)
    return _unchunk(o, T), S


def _ssd_recurrence(x, la, Bm, Cm, h0):
    T = x.shape[1]
    C = min(SSM_CHUNK, T)
    xs = tuple(_chunk(a, C) for a in (x, la, Bm, Cm))
    causal = jnp.tril(jnp.ones((C, C), dtype=bool))[None, :, :, None, None]

    def step(h, inp):
        xc, lc, bc, cc = inp
        cum = jnp.cumsum(lc, axis=1)
        y_inter = jnp.einsum('bign,bgkpn,bigk->bigkp', cc, h, jnp.exp(cum))
        rel = cum[:, :, None] - cum[:, None, :]
        L = jnp.exp(jnp.where(causal, rel, -jnp.inf))
        cb = jnp.einsum('bign,bjgn->bgij', cc, bc)
        y_intra = jnp.einsum('bgij,bijgk,bjgkp->bigkp', cb, L, xc)
        h = jnp.exp(cum[:, -1])[..., None, None] * h + jnp.einsum(
            'bjgn,bjgk,bjgkp->bgkpn', bc, jnp.exp(cum[:, -1:] - cum), xc)
        return h, y_inter + y_intra

    h, y = lax.scan(step, h0, xs)
    return _unchunk(y, T), h


def _causal_conv(u, prev, w, b):
    T = u.shape[1]
    full = jnp.concatenate([prev, u], axis=1)
    y = b + sum(full[:, j:j + T] * w[j] for j in range(SSM_CONV))
    return y, full[:, -(SSM_CONV - 1):]


def _layer(x, c, S_hg, h_ssm, conv_prev, p, lb, first_layer):
    f32 = jnp.float32
    Bsz, T, _ = x.shape
    mod = jnp.dot(jax.nn.silu(c), p['w_ada']) + p['b_ada']
    sh1, sc1, g1, sh2, sc2, g2 = [m[:, None, :] for m in jnp.split(mod, N_ADA, axis=-1)]
    h = _rmsnorm(x, p['norm_mix']) * (1 + sc1) + sh1
    proj = h @ p['w_in']
    q, f, i, og, z, xbc, dt, ga, gb = jnp.split(proj, IN_OFFSETS, axis=-1)

    ff = f.astype(f32)
    if first_layer:
        logf = jax.nn.log_sigmoid(ff)
        k = jax.nn.sigmoid(-ff)
    else:
        fg = lb + (1 - lb) * jax.nn.sigmoid(ff)
        logf = jnp.log(fg)
        k = 1 - fg
    qh = (jax.nn.silu(q.astype(f32)) * HG_DK ** -0.5).reshape(Bsz, T, HG_HEADS, HG_DK)
    kh = k.reshape(Bsz, T, HG_HEADS, HG_DK)
    lh = logf.reshape(Bsz, T, HG_HEADS, HG_DK)
    vh = i.astype(f32).reshape(Bsz, T, HG_HEADS, HG_DV)
    o_hg, S_new = _hgrn2_recurrence(qh, kh, vh, lh, S_hg.astype(f32))
    o_hg = _rmsnorm(o_hg, p['hg_norm']) * jax.nn.silu(og.astype(f32).reshape(Bsz, T, HG_HEADS, HG_DV))
    o_hg = o_hg.reshape(Bsz, T, HG_VWIDTH).astype(x.dtype)

    xbc_c, conv_new = _causal_conv(xbc, conv_prev.astype(xbc.dtype), p['conv_w'], p['conv_b'])
    xbc_c = jax.nn.silu(xbc_c).astype(f32)
    xs_, Bm, Cm = jnp.split(xbc_c, [SSM_INNER, SSM_INNER + SSM_GROUPS * SSM_STATE], axis=-1)
    dtv = jax.nn.softplus(dt.astype(f32) + p['dt_bias'].astype(f32))
    A = -jnp.exp(p['a_log'].astype(f32))
    la = (dtv * A).reshape(Bsz, T, SSM_GROUPS, SSM_HPG)
    xh = xs_.reshape(Bsz, T, SSM_GROUPS, SSM_HPG, SSM_HEADDIM)
    y, h_new = _ssd_recurrence(
        xh * dtv.reshape(Bsz, T, SSM_GROUPS, SSM_HPG, 1), la,
        Bm.reshape(Bsz, T, SSM_GROUPS, SSM_STATE), Cm.reshape(Bsz, T, SSM_GROUPS, SSM_STATE),
        h_ssm.astype(f32).reshape(Bsz, SSM_GROUPS, SSM_HPG, SSM_HEADDIM, SSM_STATE))
    y = y + p['d_skip'].astype(f32).reshape(SSM_GROUPS, SSM_HPG, 1) * xh
    y = y.reshape(Bsz, T, SSM_INNER) * jax.nn.silu(z.astype(f32))
    y = _rmsnorm(y.reshape(Bsz, T, SSM_GROUPS, SSM_INNER // SSM_GROUPS),
                 p['ssm_norm'].reshape(SSM_GROUPS, SSM_INNER // SSM_GROUPS))
    y = y.reshape(Bsz, T, SSM_INNER).astype(x.dtype)

    bma, bmb = jnp.split(p['b_merge'], 2, axis=-1)
    u = jax.nn.sigmoid(ga + bma) * (o_hg @ p['w_br_a']) + jax.nn.sigmoid(gb + bmb) * (y @ p['w_br_b'])
    x = x + g1 * (u @ p['w_out'])

    h2 = _rmsnorm(x, p['norm_mlp']) * (1 + sc2) + sh2
    x = x + g2 * (jnp.square(jax.nn.relu(h2 @ p['w_up'])) @ p['w_down'])

    S_out = S_new.astype(x.dtype)
    h_out = h_new.reshape(Bsz, SSM_HEADS, SSM_HEADDIM, SSM_STATE).astype(x.dtype)
    return x, S_out, h_out, conv_new.astype(x.dtype)


def setup_inputs(seed: int = 0) -> dict:
    key = jax.random.key(seed)
    ks = jax.random.split(key, 32)
    D = D_MODEL

    def nrm(k, shape, s):
        return s * jax.random.normal(k, shape, jnp.float32)

    dt0 = jnp.exp(jax.random.uniform(ks[16], (DEPTH, SSM_HEADS), jnp.float32,
                                     math.log(1e-3), math.log(1e-1)))
    return {
        'x_prompt': nrm(ks[0], (BATCH, SEQ, D), 1.0),
        'x_sample': nrm(ks[1], (DEC_BATCH, DEC_SEQ, D), 1.0),
        'state_hgrn': nrm(ks[2], (DEPTH, DEC_BATCH, HG_HEADS, HG_DK, HG_DV), 0.5),
        'state_ssm': nrm(ks[3], (DEPTH, DEC_BATCH, SSM_HEADS, SSM_HEADDIM, SSM_STATE), 0.5),
        'state_conv': nrm(ks[4], (DEPTH, DEC_BATCH, SSM_CONV - 1, SSM_CONV_CH), 1.0),
        'c_prompt': nrm(ks[5], (BATCH, D), 1.0),
        'c_sample': nrm(ks[6], (DEC_BATCH, D), 1.0),
        'w_ada': nrm(ks[7], (DEPTH, D, N_ADA * D), 0.5 * D ** -0.5),
        'b_ada': nrm(ks[8], (DEPTH, N_ADA * D), 0.01),
        'norm_mix': 1.0 + nrm(ks[9], (DEPTH, D), 0.05),
        'w_in': nrm(ks[10], (DEPTH, D, IN_WIDTH), D ** -0.5),
        'b_merge': nrm(ks[11], (DEPTH, 2 * D), 0.01),
        'lower_bounds': nrm(ks[12], (DEPTH, HG_WIDTH), 0.1),
        'hg_norm': 1.0 + nrm(ks[13], (DEPTH, HG_DV), 0.05),
        'conv_w': nrm(ks[14], (DEPTH, SSM_CONV, SSM_CONV_CH), SSM_CONV ** -0.5),
        'conv_b': nrm(ks[15], (DEPTH, SSM_CONV_CH), 0.01),
        'dt_bias': dt0 + jnp.log(-jnp.expm1(-dt0)),
        'a_log': jnp.log(jax.random.uniform(ks[17], (DEPTH, SSM_HEADS), jnp.float32, 1.0, 16.0)),
        'd_skip': 1.0 + nrm(ks[18], (DEPTH, SSM_HEADS), 0.05),
        'ssm_norm': 1.0 + nrm(ks[19], (DEPTH, SSM_INNER), 0.05),
        'w_br_a': nrm(ks[20], (DEPTH, HG_VWIDTH, D), HG_VWIDTH ** -0.5),
        'w_br_b': nrm(ks[21], (DEPTH, SSM_INNER, D), SSM_INNER ** -0.5),
        'w_out': nrm(ks[22], (DEPTH, D, D), D ** -0.5),
        'norm_mlp': 1.0 + nrm(ks[23], (DEPTH, D), 0.05),
        'w_up': nrm(ks[24], (DEPTH, D, D_FF), D ** -0.5),
        'w_down': nrm(ks[25], (DEPTH, D_FF, D), D_FF ** -0.5),
        'norm_final': 1.0 + nrm(ks[26], (D,), 0.05),
    }


def reference(x_prompt, x_sample, state_hgrn, state_ssm, state_conv, c_prompt, c_sample,
              w_ada, b_ada, norm_mix, w_in, b_merge, lower_bounds, hg_norm, conv_w, conv_b,
              dt_bias, a_log, d_skip, ssm_norm, w_br_a, w_br_b, w_out, norm_mlp, w_up, w_down,
              norm_final):
    lbs = jnp.cumsum(jax.nn.softmax(lower_bounds.astype(jnp.float32), axis=0), axis=0)
    lbs = lbs - lbs[0:1]
    dt = x_prompt.dtype
    xp, xs = x_prompt, x_sample
    hg_p, ssm_p, cv_p, hg_s, ssm_s, cv_s = [], [], [], [], [], []
    for l in range(DEPTH):
        p = {'w_ada': w_ada[l], 'b_ada': b_ada[l], 'norm_mix': norm_mix[l], 'w_in': w_in[l],
             'b_merge': b_merge[l], 'hg_norm': hg_norm[l], 'conv_w': conv_w[l], 'conv_b': conv_b[l],
             'dt_bias': dt_bias[l], 'a_log': a_log[l], 'd_skip': d_skip[l], 'ssm_norm': ssm_norm[l],
             'w_br_a': w_br_a[l], 'w_br_b': w_br_b[l], 'w_out': w_out[l], 'norm_mlp': norm_mlp[l],
             'w_up': w_up[l], 'w_down': w_down[l]}
        first = l == 0
        xp, s1, s2, s3 = _layer(
            xp, c_prompt,
            jnp.zeros((xp.shape[0], HG_HEADS, HG_DK, HG_DV), dt),
            jnp.zeros((xp.shape[0], SSM_HEADS, SSM_HEADDIM, SSM_STATE), dt),
            jnp.zeros((xp.shape[0], SSM_CONV - 1, SSM_CONV_CH), dt),
            p, lbs[l], first)
        hg_p.append(s1); ssm_p.append(s2); cv_p.append(s3)
        xs, t1, t2, t3 = _layer(xs, c_sample, state_hgrn[l], state_ssm[l], state_conv[l],
                                p, lbs[l], first)
        hg_s.append(t1); ssm_s.append(t2); cv_s.append(t3)
    y_prompt = _rmsnorm(xp, norm_final)
    y_sample = _rmsnorm(xs, norm_final)
    return (y_prompt, y_sample, jnp.stack(hg_p), jnp.stack(ssm_p), jnp.stack(cv_p),
            jnp.stack(hg_s), jnp.stack(ssm_s), jnp.stack(cv_s))
```

```cpp
#include <hip/hip_runtime.h>
#include <cstdio>
#include <cstdint>

constexpr int D = 1024, NB = 8, SEQ = 2048, DEPTH = 4, NSB = 128;
constexpr int MP = NB * SEQ;
constexpr int MS = NSB;
constexpr int MR = MP + MS;
constexpr int MT = 16640;
constexpr int HG_H = 8, HG_DK = 128, HG_DV = 128;
constexpr int SSM_INNER = 2048, SSM_P = 64, SSM_HEADS = 32, SSM_G = 8, SSM_HPG = 4, SSM_N = 128, SSM_CH = 4096;
constexpr int DFF = 4096, NADA = 6;
constexpr int IN_WIDTH = 12320;
constexpr int LDP = 12544;
constexpr int PC_Q = 0, PC_F = 1024, PC_I = 2048, PC_OG = 3072, PC_Z = 4096, PC_XBC = 6144, PC_GA = 10240, PC_GB = 11264, PC_DT = 12288;
constexpr int NCOND = NB + NSB;
constexpr int MODLD = DEPTH * NADA * D;
constexpr float EPS = 1e-6f;

enum { I_XP = 0, I_XS, I_SHG, I_SSSM, I_SCONV, I_CP, I_CS, I_WADA, I_BADA, I_NMIX, I_WIN, I_BMERGE, I_LB, I_HGN, I_CONVW, I_CONVB, I_DTB, I_ALOG, I_DSKIP,
       I_SSMN, I_WBRA, I_WBRB, I_WOUT, I_NMLP, I_WUP, I_WDOWN, I_NFIN, N_IN };

constexpr size_t O_YP = 0;
constexpr size_t O_YS = O_YP + (size_t)MP * D;
constexpr size_t O_HGP = O_YS + (size_t)MS * D;
constexpr size_t O_SSMP = O_HGP + (size_t)DEPTH * NB * HG_H * HG_DK * HG_DV;
constexpr size_t O_CVP = O_SSMP + (size_t)DEPTH * NB * SSM_HEADS * SSM_P * SSM_N;
constexpr size_t O_HGS = O_CVP + (size_t)DEPTH * NB * 3 * SSM_CH;
constexpr size_t O_SSMS = O_HGS + (size_t)DEPTH * NSB * HG_H * HG_DK * HG_DV;
constexpr size_t O_CVS = O_SSMS + (size_t)DEPTH * NSB * SSM_HEADS * SSM_P * SSM_N;
constexpr size_t O_END = O_CVS + (size_t)DEPTH * NSB * 3 * SSM_CH;

constexpr size_t MiB = 1u << 20;
constexpr size_t WS_CTL = 0, CTL_ZERO_BYTES = 1 * MiB;
constexpr size_t WS_LBS = 1 * MiB;
constexpr size_t WS_AC = 2 * MiB;
constexpr size_t WS_MOD = 3 * MiB;
constexpr size_t WS_WADA = 32 * MiB;
constexpr size_t WS_W = 80 * MiB, W_LSTRIDE = 49 * MiB;
constexpr size_t WO_IN = 0, WO_BRA = 24 * MiB + MiB / 2, WO_BRB = WO_BRA + 2 * MiB, WO_OUT = WO_BRB + 4 * MiB, WO_UP = WO_OUT + 2 * MiB, WO_DOWN = WO_UP + 8 * MiB;
constexpr size_t WS_X = 276 * MiB;
constexpr size_t WS_H = 341 * MiB;
constexpr size_t WS_PROJ = 374 * MiB;
constexpr size_t WS_OHG = 773 * MiB;
constexpr size_t WS_Y = 806 * MiB;
constexpr size_t WS_T = 871 * MiB;
constexpr size_t WS_U = 936 * MiB;
constexpr size_t WS_UP = 969 * MiB;
constexpr size_t WS_XBCC = 1100 * MiB;
constexpr size_t WS_DTV = 1230 * MiB, WS_CUM = 1232 * MiB;
constexpr size_t WS_CV = 1234 * MiB;
constexpr size_t WS_SSEG = 1238 * MiB;
constexpr size_t WS_DSEG = 1254 * MiB;
constexpr size_t WS_HSEG = 1255 * MiB;
constexpr size_t WS_TSEG = 1287 * MiB;
constexpr size_t WS_END = 1288 * MiB;
static_assert(WO_DOWN + 8 * MiB <= W_LSTRIDE && (size_t)LDP * D * 2 <= WO_BRA, "weight map");
static_assert(WS_W + 4 * W_LSTRIDE <= WS_X && WS_X + (size_t)MT * D * 4 <= WS_H && WS_H + (size_t)MT * D * 2 <= WS_PROJ && WS_PROJ + (size_t)MT * LDP * 2 <= WS_OHG, "ws map 1");
static_assert(WS_OHG + (size_t)MT * D * 2 <= WS_Y && WS_Y + (size_t)MT * 2048 * 2 <= WS_T && WS_T + (size_t)MT * D * 4 <= WS_U && WS_U + (size_t)MT * D * 2 <= WS_UP && WS_UP + (size_t)MT * DFF * 2 <= WS_XBCC && WS_XBCC + (size_t)MT * 4096 * 2 <= WS_DTV, "ws map 2");
static_assert(WS_MOD + (size_t)256 * MODLD * 4 <= WS_WADA && WS_WADA + (size_t)MODLD * D * 2 <= WS_W, "ws map 0");

typedef unsigned short bf16;
__device__ __forceinline__ float bf2f(bf16 v) { return __uint_as_float(((unsigned)v) << 16); }
__device__ __forceinline__ unsigned pk2(float lo, float hi) { unsigned r; asm("v_cvt_pk_bf16_f32 %0, %1, %2" : "=v"(r) : "v"(lo), "v"(hi)); return r; }
__device__ __forceinline__ bf16 f2bf(float f) { return (bf16)pk2(f, f); }
__device__ __forceinline__ float frcp_(float x) { return __builtin_amdgcn_rcpf(x); }
__device__ __forceinline__ float sigmoidf_(float x) { return frcp_(1.0f + __expf(-x)); }
__device__ __forceinline__ float siluf_(float x) { return x * frcp_(1.0f + __expf(-x)); }
__device__ __forceinline__ float softplusf_(float x) { return x > 20.f ? x : log1pf(__expf(x)); }
__host__ __device__ __forceinline__ int cidx_of_row(int row) { return row < MP ? (row >> 11) : ((row - MP + NB) < NCOND ? (row - MP + NB) : (NCOND - 1)); }
__host__ __device__ __forceinline__ int hg_vpos(int e) { return (e & 64) + 16 * (e & 3) + ((e & 63) >> 2); }

namespace pg8 {
#define PG8_LAS __attribute__((address_space(3)))
typedef unsigned short bf16_t;
typedef short bf16x8 __attribute__((ext_vector_type(8)));
typedef float f32x4 __attribute__((ext_vector_type(4)));
typedef unsigned u32x4 __attribute__((ext_vector_type(4)));
constexpr int BM = 256, BK = 64, HALF = 128, HTB = HALF * BK * 2  , STAGE_BYTES = 8 * HTB, NXCD = 8, WGM = 4;

__host__ __device__ __forceinline__ int lds_byte(int r, int c) { const int st = (r >> 4) * 2 + (c >> 5), rr = r & 15, cc = c & 31, ob = rr * 64 + cc * 2; return st * 1024 + (ob ^ (((ob >> 9) & 1) << 5)); }
__host__ __device__ __forceinline__ void stage_rc(int b, int& R, int& C) { const int st = b / 1024, sb = b % 1024, swz = sb ^ (((sb >> 9) & 1) << 5); R = (st >> 1) * 16 + swz / 64; C = (st & 1) * 32 + (swz % 64) / 2; }
__host__ __device__ __forceinline__ int perm32(int rho) { const int n = rho >> 4, i = rho & 15; return 8 * (i >> 2) + 4 * n + (i & 3); }

struct Unit { int pm, pn; };
struct Gemm { const bf16_t* A; const bf16_t* Bt; int M, N, K; };

struct StaticOrder {
    int nM, nN, nwg, G, c;
    __host__ __device__ void init(int M, int N, int G_, int c_) { nM = M / BM; nN = N / BM; nwg = nM * nN; G = G_; c = c_; }
    __host__ __device__ bool next(int i, Unit& u) const {
        const long L = (long)i * G + c; if (L >= nwg) return false;
        int wgid = (int)L; { const int q = nwg / NXCD, r = nwg % NXCD, xcd = wgid % NXCD, off = wgid / NXCD; wgid = (xcd < r ? xcd * (q + 1) : r * (q + 1) + (xcd - r) * q) + off; }
        const int nig = WGM * nN, gid = wgid / nig, fm = gid * WGM, gsz = (nM - fm) < WGM ? (nM - fm) : WGM;
        u.pm = fm + ((wgid % nig) % gsz); u.pn = (wgid % nig) / gsz; return true;
    }
    __device__ __forceinline__ void a_ready(const Unit&) const {}
    __device__ __forceinline__ void done(const Unit&) const {}
};
__device__ __forceinline__ unsigned cvt_pk_bf16(float lo, float hi) { unsigned r; asm volatile("v_cvt_pk_bf16_f32 %0, %1, %2" : "=v"(r) : "v"(lo), "v"(hi)); return r; }
__device__ __forceinline__ float ep_sigmoid(float x) { return __builtin_amdgcn_rcpf(1.0f + __expf(-x)); }
__device__ __forceinline__ void unpack8(const u32x4 w, f32x4& lo, f32x4& hi) {
    lo = (f32x4){__uint_as_float(w.x << 16), __uint_as_float(w.x & 0xffff0000u), __uint_as_float(w.y << 16), __uint_as_float(w.y & 0xffff0000u)};
    hi = (f32x4){__uint_as_float(w.z << 16), __uint_as_float(w.z & 0xffff0000u), __uint_as_float(w.w << 16), __uint_as_float(w.w & 0xffff0000u)};
}

struct EpiF32 {
    static constexpr bool PERM = false, AFTER_DRAIN = false;
    float* C; int ldc; const float* bias;
    __device__ __forceinline__ void operator()(const f32x4 (&acc)[2][2][4][2], const Unit& u, int wr, int wc, int fr, int fq) const {
        const int row0 = u.pm * BM + wr * 64 + fr, col0 = u.pn * BM + wc * 32 + 4 * fq;
        f32x4 bv[2][2];
#pragma unroll
        for (int bj = 0; bj < 2; ++bj)
#pragma unroll
            for (int n = 0; n < 2; ++n) bv[bj][n] = *(const f32x4*)(bias + col0 + bj * HALF + n * 16);
#pragma unroll
        for (int ai = 0; ai < 2; ++ai)
#pragma unroll
            for (int m = 0; m < 4; ++m) { float* rowp = C + (size_t)(row0 + ai * HALF + m * 16) * ldc + col0;
#pragma unroll
                for (int bj = 0; bj < 2; ++bj)
#pragma unroll
                    for (int n = 0; n < 2; ++n) *(f32x4*)(rowp + bj * HALF + n * 16) = acc[ai][bj][m][n] + bv[bj][n]; }
    }
};
template <int ACT  > struct EpiBf16 {
    static constexpr bool PERM = true, AFTER_DRAIN = false;
    bf16_t* O; int ldc;
    __device__ __forceinline__ void operator()(const f32x4 (&acc)[2][2][4][2], const Unit& u, int wr, int wc, int fr, int fq) const {
        const int row0 = u.pm * BM + wr * 64 + fr; const int col0 = u.pn * BM + wc * 32 + 8 * fq;
#pragma unroll
        for (int ai = 0; ai < 2; ++ai)
#pragma unroll
            for (int m = 0; m < 4; ++m) { bf16_t* rowp = O + (size_t)(row0 + ai * HALF + m * 16) * ldc + col0;
#pragma unroll
                for (int bj = 0; bj < 2; ++bj) { f32x4 v0 = acc[ai][bj][m][0], v1 = acc[ai][bj][m][1];
                    if (ACT == 1) {
#pragma unroll
                        for (int j = 0; j < 4; ++j) { const float a = fmaxf(v0[j], 0.f), b = fmaxf(v1[j], 0.f); v0[j] = a * a; v1[j] = b * b; } }
                    u32x4 w; w.x = cvt_pk_bf16(v0[0], v0[1]); w.y = cvt_pk_bf16(v0[2], v0[3]); w.z = cvt_pk_bf16(v1[0], v1[1]); w.w = cvt_pk_bf16(v1[2], v1[3]);
                    *(u32x4*)(rowp + bj * HALF) = w; } }
    }
};
struct EpiGateA {
    static constexpr bool PERM = true, AFTER_DRAIN = false;
    bf16_t* T; const bf16_t* G; int ldg; const float* bm;
    __device__ __forceinline__ void operator()(const f32x4 (&acc)[2][2][4][2], const Unit& u, int wr, int wc, int fr, int fq) const {
        const int row0 = u.pm * BM + wr * 64 + fr; const int col0 = u.pn * BM + wc * 32 + 8 * fq;
        f32x4 bv[2][2];
#pragma unroll
        for (int bj = 0; bj < 2; ++bj)
#pragma unroll
            for (int n = 0; n < 2; ++n) bv[bj][n] = *(const f32x4*)(bm + col0 + bj * HALF + 4 * n);
#pragma unroll
        for (int ai = 0; ai < 2; ++ai)
#pragma unroll
            for (int m = 0; m < 4; ++m) { const size_t row = (size_t)(row0 + ai * HALF + m * 16);
#pragma unroll
                for (int bj = 0; bj < 2; ++bj) {
                    const u32x4 gw = *(const u32x4*)(G + row * ldg + col0 + bj * HALF); f32x4 g0, g1; unpack8(gw, g0, g1);
                    f32x4 o0, o1;
#pragma unroll
                    for (int j = 0; j < 4; ++j) { o0[j] = ep_sigmoid(g0[j] + bv[bj][0][j]) * acc[ai][bj][m][0][j]; o1[j] = ep_sigmoid(g1[j] + bv[bj][1][j]) * acc[ai][bj][m][1][j]; }
                    u32x4 w; w.x = cvt_pk_bf16(o0[0], o0[1]); w.y = cvt_pk_bf16(o0[2], o0[3]); w.z = cvt_pk_bf16(o1[0], o1[1]); w.w = cvt_pk_bf16(o1[2], o1[3]);
                    *(u32x4*)(T + row * 1024 + col0 + bj * HALF) = w; } }
    }
};
struct EpiGateB {
    static constexpr bool PERM = true, AFTER_DRAIN = false;
    const bf16_t* T; bf16_t* U; const bf16_t* G; int ldg; const float* bm;
    __device__ __forceinline__ void operator()(const f32x4 (&acc)[2][2][4][2], const Unit& u, int wr, int wc, int fr, int fq) const {
        const int row0 = u.pm * BM + wr * 64 + fr; const int col0 = u.pn * BM + wc * 32 + 8 * fq;
        f32x4 bv[2][2];
#pragma unroll
        for (int bj = 0; bj < 2; ++bj)
#pragma unroll
            for (int n = 0; n < 2; ++n) bv[bj][n] = *(const f32x4*)(bm + col0 + bj * HALF + 4 * n);
#pragma unroll
        for (int ai = 0; ai < 2; ++ai)
#pragma unroll
            for (int m = 0; m < 4; ++m) { const size_t row = (size_t)(row0 + ai * HALF + m * 16);
#pragma unroll
                for (int bj = 0; bj < 2; ++bj) {
                    const u32x4 gw = *(const u32x4*)(G + row * ldg + col0 + bj * HALF); f32x4 g0, g1; unpack8(gw, g0, g1);
                    f32x4 t0, t1; unpack8(*(const u32x4*)(T + row * 1024 + col0 + bj * HALF), t0, t1);
                    f32x4 o0, o1;
#pragma unroll
                    for (int j = 0; j < 4; ++j) { o0[j] = t0[j] + ep_sigmoid(g0[j] + bv[bj][0][j]) * acc[ai][bj][m][0][j]; o1[j] = t1[j] + ep_sigmoid(g1[j] + bv[bj][1][j]) * acc[ai][bj][m][1][j]; }
                    u32x4 w; w.x = cvt_pk_bf16(o0[0], o0[1]); w.y = cvt_pk_bf16(o0[2], o0[3]); w.z = cvt_pk_bf16(o1[0], o1[1]); w.w = cvt_pk_bf16(o1[2], o1[3]);
                    *(u32x4*)(U + row * 1024 + col0 + bj * HALF) = w; } }
    }
};
struct EpiRes {
    static constexpr bool PERM = false, AFTER_DRAIN = false;
    bf16_t* X; const float* gate; int ldgate;
    __device__ __forceinline__ void operator()(const f32x4 (&acc)[2][2][4][2], const Unit& u, int wr, int wc, int fr, int fq) const {
        typedef unsigned u32x2 __attribute__((ext_vector_type(2)));
        const int row0 = u.pm * BM + wr * 64 + fr, col0 = u.pn * BM + wc * 32 + 4 * fq;
        const float* gp = gate + (size_t)((u.pm * BM) >> 11) * ldgate + col0;
        f32x4 gv[2][2];
#pragma unroll
        for (int bj = 0; bj < 2; ++bj)
#pragma unroll
            for (int n = 0; n < 2; ++n) gv[bj][n] = *(const f32x4*)(gp + bj * HALF + n * 16);
#pragma unroll
        for (int ai = 0; ai < 2; ++ai)
#pragma unroll
            for (int m = 0; m < 4; ++m) { bf16_t* xp = X + (size_t)(row0 + ai * HALF + m * 16) * 1024 + col0;
#pragma unroll
                for (int bj = 0; bj < 2; ++bj)
#pragma unroll
                    for (int n = 0; n < 2; ++n) { const u32x2 xw = *(const u32x2*)(xp + bj * HALF + n * 16);
                        const f32x4 xv = (f32x4){__uint_as_float(xw.x << 16), __uint_as_float(xw.x & 0xffff0000u), __uint_as_float(xw.y << 16), __uint_as_float(xw.y & 0xffff0000u)};
                        const f32x4 o = xv + gv[bj][n] * acc[ai][bj][m][n];
                        u32x2 ow; ow.x = cvt_pk_bf16(o[0], o[1]); ow.y = cvt_pk_bf16(o[2], o[3]); *(u32x2*)(xp + bj * HALF + n * 16) = ow; } }
    }
};


#ifndef GEMM_ALIGN
#define GEMM_ALIGN true
#endif
#ifndef GEMM_SP2
#define GEMM_SP2 true
#endif
template <class Epi, class Sched, bool ALIGN_EPI = GEMM_ALIGN, bool SP2 = GEMM_SP2>
__device__ __forceinline__ void gemm_phase(PG8_LAS unsigned char* lds, const Gemm g, const Sched& S, const Epi& E, unsigned long long*  , int tid_in) {
    int tid_ = tid_in; asm volatile("" : "+v"(tid_));
    const int tid = tid_, wid = __builtin_amdgcn_readfirstlane(tid >> 6), lane = tid & 63, wr = wid >> 2, wc = wid & 3, fr = lane & 15, fq = lane >> 4;
    const int K = g.K, nt = K / BK;
    unsigned voffA[2], voffB[2];
#pragma unroll
    for (int i = 0; i < 2; ++i) { int R, C; stage_rc(tid * 16 + i * 8192, R, C); const int Rb = Epi::PERM ? ((R & ~31) + perm32(R & 31)) : R;
        voffA[i] = (unsigned)(R * K + C) * 2u; voffB[i] = (unsigned)(Rb * K + C) * 2u; }
    const size_t kstep = (size_t)(BK * 2);
    const size_t hstep = (size_t)HALF * K * 2;
    const size_t tstep = 2 * hstep;
    const unsigned ldsw = (unsigned)wid * 1024u;
    const int aoff = lds_byte(wr * 64 + fr, fq * 8), boff = lds_byte(wc * 32 + fr, fq * 8);
#define PG8_SA(b, h) (((b) * 2 + (h)) * HTB)
#define PG8_SB(b, h) ((4 + (b) * 2 + (h)) * HTB)
#define PG8_STAGE(bufoff, gbase, voff) do { _Pragma("unroll") for (int _i = 0; _i < 2; ++_i) \
        __builtin_amdgcn_global_load_lds((const unsigned*)((const char*)(gbase) + (voff)[_i]), (PG8_LAS unsigned*)(lds + (bufoff) + ldsw + _i * 8192), 16, 0, 0); } while (0)
#define PG8_LDA(dst, b, h) do { _Pragma("unroll") for (int m = 0; m < 4; ++m) _Pragma("unroll") for (int k = 0; k < 2; ++k) dst[m][k] = *(const PG8_LAS bf16x8*)(lds + PG8_SA(b, h) + aoff + m * 2048 + k * 1024); } while (0)
#define PG8_LDB(dst, b, h) do { _Pragma("unroll") for (int n = 0; n < 2; ++n) _Pragma("unroll") for (int k = 0; k < 2; ++k) dst[n][k] = *(const PG8_LAS bf16x8*)(lds + PG8_SB(b, h) + boff + n * 2048 + k * 1024); } while (0)
#define PG8_MMA(ai, bj, At, Bt) do { __builtin_amdgcn_s_setprio(1); _Pragma("unroll") for (int m = 0; m < 4; ++m) _Pragma("unroll") for (int n = 0; n < 2; ++n) _Pragma("unroll") for (int k = 0; k < 2; ++k) \
        acc[ai][bj][m][n] = __builtin_amdgcn_mfma_f32_16x16x32_bf16(Bt[n][k], At[m][k], acc[ai][bj][m][n], 0, 0, 0); __builtin_amdgcn_s_setprio(0); } while (0)
#define PG8_WAIT_V(n) asm volatile("s_waitcnt vmcnt(" #n ")" ::: "memory")
#define PG8_WAIT_L(n) asm volatile("s_waitcnt lgkmcnt(" #n ")" ::: "memory")
#define PG8_BAR __builtin_amdgcn_s_barrier()
#define PG8_SCHED __builtin_amdgcn_sched_barrier(0)
    Unit cur, nxt; int ui = 0;
    if (!S.next(0, cur)) return;
    f32x4 acc[2][2][4][2];
#pragma unroll
    for (int a = 0; a < 2; ++a)
#pragma unroll
        for (int b = 0; b < 2; ++b)
#pragma unroll
            for (int m = 0; m < 4; ++m)
#pragma unroll
                for (int n = 0; n < 2; ++n) acc[a][b][m][n] = (f32x4){0.f, 0.f, 0.f, 0.f};
    bf16x8 At[4][2], B0[2][2], B1[2][2];
    const char* cA = (const char*)g.A + (size_t)cur.pm * tstep; const char* cB = (const char*)g.Bt + (size_t)cur.pn * tstep;
    S.a_ready(cur);
    if constexpr (SP2) {
        PG8_STAGE(PG8_SB(0, 0), cB, voffB); PG8_STAGE(PG8_SB(0, 1), cB + hstep, voffB); PG8_STAGE(PG8_SA(0, 0), cA, voffA); PG8_STAGE(PG8_SA(0, 1), cA + hstep, voffA);
        if (wr == 1) PG8_BAR;
        PG8_WAIT_V(2); PG8_BAR;
        PG8_STAGE(PG8_SB(1, 0), cB + kstep, voffB); PG8_STAGE(PG8_SA(1, 0), cA + kstep, voffA); PG8_STAGE(PG8_SB(1, 1), cB + hstep + kstep, voffB);
        PG8_WAIT_V(6); PG8_BAR;
    } else {
        PG8_STAGE(PG8_SB(0, 0), cB, voffB); PG8_STAGE(PG8_SA(0, 0), cA, voffA); PG8_STAGE(PG8_SB(0, 1), cB + hstep, voffB); PG8_STAGE(PG8_SA(0, 1), cA + hstep, voffA);
        if (wr == 1) PG8_BAR;
        PG8_WAIT_V(4); PG8_BAR;
        PG8_STAGE(PG8_SB(1, 0), cB + kstep, voffB); PG8_STAGE(PG8_SA(1, 0), cA + kstep, voffA); PG8_STAGE(PG8_SB(1, 1), cB + hstep + kstep, voffB);
        PG8_WAIT_V(6); PG8_BAR;
    }
    for (;;) {
        const bool has_next = S.next(ui + 1, nxt);
        const char* nA = has_next ? (const char*)g.A + (size_t)nxt.pm * tstep : cA; const char* nB = has_next ? (const char*)g.Bt + (size_t)nxt.pn * tstep : cB;
        for (int t = 0; t < nt; t += 2) {
            const bool last = (t == nt - 2);
            const char* a1 = cA + (size_t)(t + 1) * kstep;
            const char* a2 = last ? nA : cA + (size_t)(t + 2) * kstep; const char* b2 = last ? nB : cB + (size_t)(t + 2) * kstep;
            const char* a3 = a2 + kstep; const char* b3 = b2 + kstep;
            if (last && has_next) S.a_ready(nxt);
            if constexpr (SP2) {
            PG8_LDB(B0, 0, 0); PG8_LDB(B1, 0, 1); PG8_SCHED; PG8_LDA(At, 0, 0); PG8_STAGE(PG8_SA(1, 1), a1 + hstep, voffA);
            PG8_WAIT_V(8); PG8_WAIT_L(0); PG8_BAR; PG8_MMA(0, 0, At, B0); PG8_MMA(0, 1, At, B1); PG8_BAR; PG8_SCHED;
            PG8_LDA(At, 0, 1); PG8_STAGE(PG8_SB(0, 0), b2, voffB); PG8_STAGE(PG8_SB(0, 1), b2 + hstep, voffB); PG8_STAGE(PG8_SA(0, 0), a2, voffA);
            PG8_WAIT_V(8); PG8_WAIT_L(0); PG8_BAR; PG8_MMA(1, 0, At, B0); PG8_MMA(1, 1, At, B1); PG8_BAR; PG8_SCHED;
            PG8_LDB(B0, 1, 0); PG8_LDB(B1, 1, 1); PG8_SCHED; PG8_LDA(At, 1, 0); PG8_STAGE(PG8_SA(0, 1), a2 + hstep, voffA);
            PG8_WAIT_V(8); PG8_WAIT_L(0); PG8_BAR; PG8_MMA(0, 0, At, B0); PG8_MMA(0, 1, At, B1); PG8_BAR; PG8_SCHED;
            PG8_LDA(At, 1, 1); PG8_STAGE(PG8_SB(1, 0), b3, voffB); PG8_STAGE(PG8_SB(1, 1), b3 + hstep, voffB); PG8_STAGE(PG8_SA(1, 0), a3, voffA);
            PG8_WAIT_V(8); PG8_WAIT_L(0); PG8_BAR; PG8_MMA(1, 0, At, B0); PG8_MMA(1, 1, At, B1); PG8_BAR; PG8_SCHED;
            } else {
            PG8_LDB(B0, 0, 0); PG8_SCHED; PG8_LDA(At, 0, 0); PG8_STAGE(PG8_SA(1, 1), a1 + hstep, voffA);
            PG8_WAIT_L(8); PG8_BAR; PG8_WAIT_L(0); PG8_MMA(0, 0, At, B0); PG8_BAR; PG8_SCHED;
            PG8_LDB(B1, 0, 1); PG8_STAGE(PG8_SB(0, 0), b2, voffB);
            PG8_BAR; PG8_WAIT_L(0); PG8_MMA(0, 1, At, B1); PG8_BAR;
            PG8_LDA(At, 0, 1); PG8_STAGE(PG8_SA(0, 0), a2, voffA);
            PG8_BAR; PG8_WAIT_L(0); PG8_MMA(1, 0, At, B0); PG8_BAR; PG8_SCHED;
            PG8_STAGE(PG8_SB(0, 1), b2 + hstep, voffB);
            PG8_WAIT_V(6); PG8_BAR; PG8_MMA(1, 1, At, B1); PG8_BAR;
            PG8_LDB(B0, 1, 0); PG8_SCHED; PG8_LDA(At, 1, 0); PG8_STAGE(PG8_SA(0, 1), a2 + hstep, voffA);
            PG8_WAIT_L(8); PG8_BAR; PG8_WAIT_L(0); PG8_MMA(0, 0, At, B0); PG8_BAR; PG8_SCHED;
            PG8_LDB(B1, 1, 1); PG8_STAGE(PG8_SB(1, 0), b3, voffB);
            PG8_BAR; PG8_WAIT_L(0); PG8_MMA(0, 1, At, B1); PG8_BAR;
            PG8_LDA(At, 1, 1); PG8_STAGE(PG8_SA(1, 0), a3, voffA);
            PG8_BAR; PG8_WAIT_L(0); PG8_MMA(1, 0, At, B0); PG8_BAR; PG8_SCHED;
            PG8_STAGE(PG8_SB(1, 1), b3 + hstep, voffB);
            PG8_WAIT_V(6); PG8_BAR; PG8_MMA(1, 1, At, B1); PG8_BAR;
            }
        }
        if constexpr (ALIGN_EPI) { if (wr == 0) PG8_BAR; }
        if constexpr (!Epi::AFTER_DRAIN) { E(acc, cur, wr, wc, fr, fq); S.done(cur); }
        if (!has_next) break;
#pragma unroll
        for (int a = 0; a < 2; ++a)
#pragma unroll
            for (int b = 0; b < 2; ++b)
#pragma unroll
                for (int m = 0; m < 4; ++m)
#pragma unroll
                    for (int n = 0; n < 2; ++n) acc[a][b][m][n] = (f32x4){0.f, 0.f, 0.f, 0.f};
        cur = nxt; cA = nA; cB = nB; ++ui;
        if constexpr (ALIGN_EPI) { if (wr == 1) PG8_BAR; }
    }
    PG8_WAIT_V(0);
    if constexpr (!ALIGN_EPI) { if (wr == 0) PG8_BAR; }
    PG8_BAR;
    if constexpr (Epi::AFTER_DRAIN) { E.fused(acc, cur, wr, wc, fr, fq, lds, wid, lane); S.done(cur); }
#undef PG8_SA
#undef PG8_SB
#undef PG8_STAGE
#undef PG8_LDA
#undef PG8_LDB
#undef PG8_MMA
#undef PG8_WAIT_V
#undef PG8_WAIT_L
#undef PG8_BAR
#undef PG8_SCHED
}
}

#define XB_TMO      128
#define XB_XCNT(j)  (256  + 64 * (j))
#define XB_XSUB(j)  (1280 + 64 * (j))
#define XB_XGEN(j)  (2304 + 64 * (j))
#define XB_TOP      3328
#define XB_TOPGEN   3392
#define XCD_BAR_WORDS 3456
#define XB_SPIN_CAP (1u << 18)
#define LAS __attribute__((address_space(3)))

__device__ __forceinline__ unsigned xb_ld(unsigned* p)              { return __hip_atomic_load(p, __ATOMIC_RELAXED, __HIP_MEMORY_SCOPE_AGENT); }
__device__ __forceinline__ unsigned xb_add(unsigned* p, unsigned v) { return __hip_atomic_fetch_add(p, v, __ATOMIC_RELAXED, __HIP_MEMORY_SCOPE_AGENT); }
__device__ __forceinline__ unsigned xb_xcc_id() { return (unsigned)__builtin_amdgcn_s_getreg((3 << 11) | 20) & 0xFu; }
#define XB_SPIN(cond, bar) do { unsigned _sp = 0; while (cond) { __builtin_amdgcn_s_sleep(1); \
    if ((++_sp & 255u) == 0u) { if (xb_ld(&(bar)[XB_TMO])) break; if (_sp > XB_SPIN_CAP) { atomicAdd(&(bar)[XB_TMO], 1u); break; } } } } while (0)

struct XcdBarrier {
    unsigned* bar; unsigned x;
    volatile LAS unsigned* st;
};

__device__ __forceinline__ XcdBarrier xcd_barrier_post(unsigned* bar, volatile LAS unsigned* st, int tid) {
    XcdBarrier b; b.bar = bar; b.x = (unsigned)__builtin_amdgcn_readfirstlane((int)xb_xcc_id()); b.st = st;
    if (tid == 0) (void)xb_add(&bar[XB_XCNT(b.x)], 1u);
    return b;
}
__device__ __forceinline__ void xcd_barrier_complete(unsigned* bar, unsigned x, unsigned& nloc, unsigned& nx) {
    const unsigned G = gridDim.x * gridDim.y * gridDim.z;
    unsigned sum, cnt, mine, sp = 0u;
    for (;;) {
        sum = 0u; cnt = 0u; mine = 0u;
#pragma unroll
        for (unsigned j = 0; j < 16; ++j) { const unsigned c = xb_ld(&bar[XB_XCNT(j)]); sum += c; cnt += (c > 0u) ? 1u : 0u; mine = (j == x) ? c : mine; }
        if (sum == G) break;
        __builtin_amdgcn_s_sleep(1);
        if ((++sp & 255u) == 0u) { if (xb_ld(&bar[XB_TMO])) break; if (sp > XB_SPIN_CAP) { atomicAdd(&bar[XB_TMO], 1u); break; } }
    }
    nloc = mine > 0u ? mine : 1u; nx = cnt > 0u ? cnt : 1u;
}

__device__ __forceinline__ void xcd_barrier(const XcdBarrier& b, int tid) {
    asm volatile("s_waitcnt vmcnt(0)" ::: "memory");
    __syncthreads();
    if (tid == 0) {
        unsigned* bar = b.bar; unsigned bx_ = b.x; asm volatile("" : "+s"(bar), "+s"(bx_));
        __builtin_amdgcn_s_waitcnt(0);
        unsigned nloc = b.st[0], nx = b.st[1];
        if (nloc == 0u) { xcd_barrier_complete(bar, bx_, nloc, nx); b.st[0] = nloc; b.st[1] = nx; }
        const unsigned old = xb_add(&bar[XB_XSUB(bx_)], 1u);
        const unsigned gen = old / nloc;
        if (old + 1u == (gen + 1u) * nloc) {
            __builtin_amdgcn_fence(__ATOMIC_RELEASE, "agent");
            asm volatile("s_waitcnt vmcnt(0)" ::: "memory");
            const unsigned og = xb_add(&bar[XB_TOP], 1u);
            const unsigned tg = og / nx;
            if (og + 1u == (tg + 1u) * nx) xb_add(&bar[XB_TOPGEN], 1u);
            else XB_SPIN(xb_ld(&bar[XB_TOPGEN]) == tg, bar);
            __builtin_amdgcn_fence(__ATOMIC_ACQUIRE, "agent");
            xb_add(&bar[XB_XGEN(bx_)], 1u);
            asm volatile("s_waitcnt vmcnt(0)" ::: "memory");
        } else {
            XB_SPIN(xb_ld(&bar[XB_XGEN(bx_)]) == gen, bar);
            __builtin_amdgcn_fence(__ATOMIC_ACQUIRE, "agent");
            asm volatile("s_waitcnt vmcnt(0)" ::: "memory");
        }
    }
    __syncthreads();
}


typedef unsigned v4u __attribute__((ext_vector_type(4)));
typedef float f32x4 __attribute__((ext_vector_type(4)));
#define LDS_WAIT() asm volatile("s_waitcnt lgkmcnt(0)" ::: "memory")
constexpr int NWAVES = 8, NTHREADS = 512;
constexpr int RING_BYTES = 131072, LDS_BYTES = 155648;

struct P { const float* in[N_IN]; float* out; unsigned char* ws; };

template <int M> __device__ __forceinline__ float swz_xor(float v) { static_assert(M >= 1 && M < 32, "swizzle xor mask"); return __int_as_float(__builtin_amdgcn_ds_swizzle(__float_as_int(v), (M << 10) | 0x1f)); }
__device__ __forceinline__ float xor32_sum(float v) { auto r = __builtin_amdgcn_permlane32_swap(__float_as_uint(v), __float_as_uint(v), false, false); return __uint_as_float(r[0]) + __uint_as_float(r[1]); }
__device__ __forceinline__ float wave_sum(float v) {
    v += swz_xor<1>(v); v += swz_xor<2>(v); v += swz_xor<4>(v); v += swz_xor<8>(v); v += swz_xor<16>(v);
    return xor32_sum(v);
}

template <bool VPERM = false>
__device__ __forceinline__ void transpose_item(const float* W, int K, int N, bf16* WT, int k0, int n0, int drow0, LAS float* scr, int lane) {
    float tv[32];
#pragma unroll
    for (int i = 0; i < 32; ++i) { const int kk = 2 * i + (lane >> 5); tv[i] = W[(size_t)(k0 + kk) * N + n0 + (lane & 31)]; }
#pragma unroll
    for (int i = 0; i < 32; ++i) { const int kk = 2 * i + (lane >> 5); scr[kk * 33 + (lane & 31)] = tv[i]; }
    LDS_WAIT(); asm volatile("" ::: "memory");
    const int c = lane & 7;
#pragma unroll
    for (int j = 0; j < 4; ++j) { const int n = (lane >> 3) + 8 * j; const LAS float* s = scr + (8 * c) * 33 + n;
        v4u o; o.x = pk2(s[0 * 33], s[1 * 33]); o.y = pk2(s[2 * 33], s[3 * 33]); o.z = pk2(s[4 * 33], s[5 * 33]); o.w = pk2(s[6 * 33], s[7 * 33]);
        const int dr = VPERM ? (((drow0 + n) & ~127) + hg_vpos((drow0 + n) & 127)) : (drow0 + n);
        *(v4u*)(WT + (size_t)dr * K + k0 + 8 * c) = o; }
    LDS_WAIT(); asm volatile("" ::: "memory");
}

__device__ __forceinline__ void phase_prologue(const P& p, LAS unsigned char* lds, int gw, int NGW, int lane, int wave) {
    LAS float* scr = (LAS float*)(lds + wave * 16384);
    unsigned char* ws = p.ws;
    constexpr int IT_ADA = 16 * 192, IT_IN = 16 * 385, IT_BRA = 16 * 32, IT_BRB = 32 * 32, IT_OUT = 16 * 32, IT_UP = 16 * 128, IT_DOWN = 64 * 32;
    constexpr int IT_L = IT_ADA + IT_IN + IT_BRA + IT_BRB + IT_OUT + IT_UP + IT_DOWN;
    for (int it = gw; it < DEPTH * IT_L; it += NGW) {
        const int l = it / IT_L; int r = it % IT_L;
        bf16* wl = (bf16*)(ws + WS_W + (size_t)l * W_LSTRIDE);
        if (r < IT_ADA) { const int kb = r / 192, nb = r % 192; transpose_item(p.in[I_WADA] + (size_t)l * D * 6144, D, 6144, (bf16*)(ws + WS_WADA) + (size_t)l * 6144 * D, kb * 64, nb * 32, nb * 32, scr, lane); continue; } r -= IT_ADA;
        if (r < IT_IN) { const int kb = r / 385, nb = r % 385; const int n0 = nb * 32; const int dr = n0 < 10240 ? n0 : (n0 < 10272 ? PC_DT + (n0 - 10240) : n0 - 32);
            if (n0 >= PC_I && n0 < PC_OG) transpose_item<true>(p.in[I_WIN] + (size_t)l * D * IN_WIDTH, D, IN_WIDTH, (bf16*)((unsigned char*)wl + WO_IN), kb * 64, n0, dr, scr, lane);
            else transpose_item(p.in[I_WIN] + (size_t)l * D * IN_WIDTH, D, IN_WIDTH, (bf16*)((unsigned char*)wl + WO_IN), kb * 64, n0, dr, scr, lane);
            continue; } r -= IT_IN;
        if (r < IT_BRA) { const int kb = r / 32, nb = r % 32; transpose_item(p.in[I_WBRA] + (size_t)l * 1024 * 1024, 1024, 1024, (bf16*)((unsigned char*)wl + WO_BRA), kb * 64, nb * 32, nb * 32, scr, lane); continue; } r -= IT_BRA;
        if (r < IT_BRB) { const int kb = r / 32, nb = r % 32; transpose_item(p.in[I_WBRB] + (size_t)l * 2048 * 1024, 2048, 1024, (bf16*)((unsigned char*)wl + WO_BRB), kb * 64, nb * 32, nb * 32, scr, lane); continue; } r -= IT_BRB;
        if (r < IT_OUT) { const int kb = r / 32, nb = r % 32; transpose_item(p.in[I_WOUT] + (size_t)l * 1024 * 1024, 1024, 1024, (bf16*)((unsigned char*)wl + WO_OUT), kb * 64, nb * 32, nb * 32, scr, lane); continue; } r -= IT_OUT;
        if (r < IT_UP) { const int kb = r / 128, nb = r % 128; transpose_item(p.in[I_WUP] + (size_t)l * 1024 * 4096, 1024, 4096, (bf16*)((unsigned char*)wl + WO_UP), kb * 64, nb * 32, nb * 32, scr, lane); continue; } r -= IT_UP;
        { const int kb = r / 32, nb = r % 32; transpose_item(p.in[I_WDOWN] + (size_t)l * 4096 * 1024, 4096, 1024, (bf16*)((unsigned char*)wl + WO_DOWN), kb * 64, nb * 32, nb * 32, scr, lane); }
    }
    for (int i = gw * 64 + lane; i < DEPTH * 28672; i += NGW * 64) { const int l = i / 28672, r = i % 28672;
        ((v4u*)(ws + WS_W + (size_t)l * W_LSTRIDE + WO_IN + (size_t)IN_WIDTH * D * 2))[r] = (v4u){0u, 0u, 0u, 0u}; }
    for (int i = gw * 64 + lane; i < 256 * 1024; i += NGW * 64) { const int r = i >> 10, c = i & 1023;
        float v = 0.f; if (r < NB) v = p.in[I_CP][r * D + c]; else if (r < NCOND) v = p.in[I_CS][(r - NB) * D + c];
        ((bf16*)(ws + WS_AC))[i] = f2bf(siluf_(v)); }
    for (int c = gw * 64 + lane; c < 1024; c += NGW * 64) { float v[DEPTH], mx = -3.0e38f;
#pragma unroll
        for (int l = 0; l < DEPTH; ++l) { v[l] = p.in[I_LB][l * 1024 + c]; mx = fmaxf(mx, v[l]); }
        float s = 0.f;
#pragma unroll
        for (int l = 0; l < DEPTH; ++l) { v[l] = expf(v[l] - mx); s += v[l]; }
        float cum = 0.f; float* lbs = (float*)(ws + WS_LBS);
#pragma unroll
        for (int l = 0; l < DEPTH; ++l) { if (l > 0) cum += v[l] / s; lbs[l * 1024 + c] = cum; }
    }
}

__device__ __forceinline__ f32x4 unpack4(unsigned long long w) { const unsigned lo = (unsigned)w, hi = (unsigned)(w >> 32); return (f32x4){__uint_as_float(lo << 16), __uint_as_float(lo & 0xffff0000u), __uint_as_float(hi << 16), __uint_as_float(hi & 0xffff0000u)}; }
template <int MODE, int NR>
__device__ __forceinline__ void norm_rows(const float* X32, bf16* X, bf16* H, float* out32, const f32x4 (&mul)[4], const f32x4 (&sh)[4], int lane) {
    if constexpr (MODE == 1) {
        f32x4 v[NR][4];
#pragma unroll
        for (int r = 0; r < NR; ++r) { const f32x4* xr = (const f32x4*)(X32 + (size_t)r * D) + lane;
#pragma unroll
            for (int j = 0; j < 4; ++j) v[r][j] = xr[64 * j]; }
#pragma unroll
        for (int r = 0; r < NR; ++r) { float s = 0.f;
#pragma unroll
            for (int j = 0; j < 4; ++j) s += (v[r][j].x * v[r][j].x + v[r][j].y * v[r][j].y) + (v[r][j].z * v[r][j].z + v[r][j].w * v[r][j].w);
            const float rstd = rsqrtf(wave_sum(s) * (1.f / D) + EPS);
            unsigned long long* o8 = (unsigned long long*)(H + (size_t)r * D) + lane; unsigned long long* x8 = (unsigned long long*)(X + (size_t)r * D) + lane;
#pragma unroll
            for (int j = 0; j < 4; ++j) { const f32x4 y = v[r][j] * rstd * mul[j] + sh[j];
                x8[64 * j] = (unsigned long long)pk2(v[r][j].x, v[r][j].y) | ((unsigned long long)pk2(v[r][j].z, v[r][j].w) << 32);
                o8[64 * j] = (unsigned long long)pk2(y.x, y.y) | ((unsigned long long)pk2(y.z, y.w) << 32); } }
    } else {
        unsigned long long raw[NR][4];
#pragma unroll
        for (int r = 0; r < NR; ++r) { const unsigned long long* xr = (const unsigned long long*)(X + (size_t)r * D) + lane;
#pragma unroll
            for (int j = 0; j < 4; ++j) raw[r][j] = xr[64 * j]; }
#pragma unroll
        for (int r = 0; r < NR; ++r) { f32x4 v[4]; float s = 0.f;
#pragma unroll
            for (int j = 0; j < 4; ++j) { v[j] = unpack4(raw[r][j]); s += (v[j].x * v[j].x + v[j].y * v[j].y) + (v[j].z * v[j].z + v[j].w * v[j].w); }
            const float rstd = rsqrtf(wave_sum(s) * (1.f / D) + EPS);
            if constexpr (MODE == 2) { f32x4* o = (f32x4*)(out32 + (size_t)r * D) + lane;
#pragma unroll
                for (int j = 0; j < 4; ++j) o[64 * j] = v[j] * rstd * mul[j];
            } else { unsigned long long* o8 = (unsigned long long*)(H + (size_t)r * D) + lane;
#pragma unroll
                for (int j = 0; j < 4; ++j) { const f32x4 y = v[j] * rstd * mul[j] + sh[j]; o8[64 * j] = (unsigned long long)pk2(y.x, y.y) | ((unsigned long long)pk2(y.z, y.w) << 32); } } }
    }
}
template <int MODE>
__device__ __forceinline__ void phase_norm(const float* Xp32, const float* Xs32, bf16* X, bf16* H, const float* nw, const float* mod_sh, const float* mod_sc, int gw, int NGW, int lane) {
    f32x4 w4[4];
#pragma unroll
    for (int j = 0; j < 4; ++j) w4[j] = ((const f32x4*)nw)[lane + 64 * j];
    for (int b = gw; b < MP / 8; b += NGW) {
        const int ci = b >> 8; f32x4 mul[4], sh[4];
        const f32x4* shp = (const f32x4*)(mod_sh + (size_t)ci * MODLD) + lane; const f32x4* scp = (const f32x4*)(mod_sc + (size_t)ci * MODLD) + lane;
#pragma unroll
        for (int j = 0; j < 4; ++j) { sh[j] = shp[64 * j]; mul[j] = w4[j] * (scp[64 * j] + 1.0f); }
        const size_t ro = (size_t)b * 8 * D;
        norm_rows<MODE, MODE == 1 ? 4 : 8>(MODE == 1 ? Xp32 + ro : nullptr, X + ro, H + ro, nullptr, mul, sh, lane);
        if constexpr (MODE == 1) norm_rows<MODE, 4>(Xp32 + ro + 4 * D, X + ro + 4 * D, H + ro + 4 * D, nullptr, mul, sh, lane);
    }
    for (int sr = gw; sr < MS; sr += NGW) {
        const int ci = NB + sr; f32x4 mul[4], sh[4];
        const f32x4* shp = (const f32x4*)(mod_sh + (size_t)ci * MODLD) + lane; const f32x4* scp = (const f32x4*)(mod_sc + (size_t)ci * MODLD) + lane;
#pragma unroll
        for (int j = 0; j < 4; ++j) { sh[j] = shp[64 * j]; mul[j] = w4[j] * (scp[64 * j] + 1.0f); }
        const size_t ro = (size_t)(MP + sr) * D;
        norm_rows<MODE, 1>(MODE == 1 ? Xs32 + (size_t)sr * D : nullptr, X + ro, H + ro, nullptr, mul, sh, lane);
    }
}
__device__ __forceinline__ void phase_final(const bf16* X, float* out, const float* nw, int gw, int NGW, int lane) {
    f32x4 w4[4];
#pragma unroll
    for (int j = 0; j < 4; ++j) w4[j] = ((const f32x4*)nw)[lane + 64 * j];
    for (int b = gw; b < MP / 8; b += NGW) { const size_t ro = (size_t)b * 8 * D; norm_rows<2, 8>(nullptr, (bf16*)X + ro, nullptr, out + ro, w4, w4, lane); }
    for (int sr = gw; sr < MS; sr += NGW) { const size_t ro = (size_t)(MP + sr) * D; norm_rows<2, 1>(nullptr, (bf16*)X + ro, nullptr, out + ro, w4, w4, lane); }
}


typedef short s16x4 __attribute__((ext_vector_type(4)));
typedef short bf16x8 __attribute__((ext_vector_type(8)));
__device__ __forceinline__ f32x4 mfma16(bf16x8 a, bf16x8 b, f32x4 c) { return __builtin_amdgcn_mfma_f32_16x16x32_bf16(a, b, c, 0, 0, 0); }
__device__ __forceinline__ s16x4 tr_read4(LAS unsigned char* p) { return __builtin_amdgcn_ds_read_tr16_b64_v4i16((LAS s16x4*)p); }
#define SHFL_XOR(v, M) swz_xor<M>(v)
__device__ __forceinline__ float shfl_up_f(float v, int o, int lane) { return __int_as_float(__builtin_amdgcn_ds_bpermute((lane >= o ? lane - o : lane) << 2, __float_as_int(v))); }
__device__ __forceinline__ void sync_threads() { __syncthreads(); }
__device__ __forceinline__ float __builtin_amdgcn_exp2f_(float x) { return __builtin_amdgcn_exp2f(x); }
#ifdef HOST_EMU
#define FENCE_MEM() do {} while (0)
#define SCHED_FENCE() do {} while (0)
#define LAUNDER_PTR(p) do {} while (0)
#else
#define LAUNDER_PTR(p) asm volatile("" : "+v"(p))
#define FENCE_MEM() asm volatile("" ::: "memory")
#define SCHED_FENCE() __builtin_amdgcn_sched_barrier(0)
#endif
constexpr int RC = 64;
constexpr int NSEG = 4, SEGLEN = 512, NCH = SEGLEN / RC;
constexpr int PQ = 272;
constexpr int PX = 528;

struct RecurBufs {
    bf16* proj;
    bf16* xbcc;
    float* dtv;
    float* cum;
    float* cv;
    float* sseg;
    float* dseg;
    float* hseg;
    float* tseg;
    bf16* ohg;
    bf16* y;
};

__device__ __forceinline__ bf16x8 frag_rows(LAS unsigned char* img, int pitch, int row, int kcol) { return *(LAS bf16x8*)(img + row * pitch + kcol * 2); }
__device__ __forceinline__ bf16x8 frag_tr(LAS unsigned char* img, int pitch, int k0a, int k0b, int col0, int lane) {
    const int q = (lane & 15) >> 2, p = lane & 3;
    const s16x4 a = tr_read4(img + (k0a + q) * pitch + (col0 + 4 * p) * 2);
    const s16x4 b = tr_read4(img + (k0b + q) * pitch + (col0 + 4 * p) * 2);
    return (bf16x8){a[0], a[1], a[2], a[3], b[0], b[1], b[2], b[3]};
}
__device__ __forceinline__ bf16x8 scale_frag(bf16x8 f, float s) {
    bf16x8 o;
#pragma unroll
    for (int j = 0; j < 8; ++j) o[j] = (short)f2bf(bf2f((bf16)f[j]) * s);
    return o;
}
__device__ __forceinline__ bf16x8 scale_frag8(bf16x8 f, const float (&s)[8]) {
    bf16x8 o;
#pragma unroll
    for (int j = 0; j < 8; ++j) o[j] = (short)f2bf(bf2f((bf16)f[j]) * s[j]);
    return o;
}
__device__ __forceinline__ void stage_tile128(const bf16* g, size_t ld, LAS unsigned char* img, int tid) {
#pragma unroll
    for (int i = 0; i < 2; ++i) { const int idx = tid + i * 512, r = idx >> 4, c16 = idx & 15;
        *(LAS v4u*)(img + r * PQ + c16 * 16) = *(const v4u*)(g + (size_t)r * ld + c16 * 8); }
}

constexpr int HG_QT = 0, HG_KT = 17408, HG_V = 34816, HG_PART = 52224, HG_VEC1 = 54272, HG_ST = 52224, HG_VEC = 87040, HG_RED = 89088;

__device__ __forceinline__ void hgrn_state_update(f32x4 (&S)[8], LAS unsigned char* Kt, LAS unsigned char* V, const LAS float* escale, const LAS float* edec, int w, int lane) {
    const int c = lane & 15, g = lane >> 4;
    const f32x4 dc = *(const LAS f32x4*)(edec + 16 * w + 4 * g);
#pragma unroll
    for (int et = 0; et < 8; ++et) S[et] = S[et] * dc;
    const float es = escale[16 * w + c];
#pragma unroll
    for (int ks = 0; ks < 2; ++ks) {
        const bf16x8 A = scale_frag(frag_tr(Kt, PQ, 32 * ks + 8 * g, 32 * ks + 8 * g + 4, 16 * w, lane), es);
#pragma unroll
        for (int et = 0; et < 8; ++et) { const bf16x8 B = frag_tr(V, PQ, 32 * ks + 8 * g, 32 * ks + 8 * g + 4, 16 * et, lane); S[et] = mfma16(A, B, S[et]); }
        SCHED_FENCE();
    }
}

__device__ __forceinline__ void hgrn_pass1(const RecurBufs& rb, const float* lbs_l, int u, int tid, LAS unsigned char* lds) {
    const int b = u >> 5, h = (u >> 2) & 7, seg = u & 3, lane = tid & 63, w = tid >> 6;
    const int d = tid & 127, jq = tid >> 7;
    LAS unsigned char* Qt = lds + HG_QT; LAS unsigned char* Kt = lds + HG_KT; LAS unsigned char* V = lds + HG_V; LAS float* part = (LAS float*)(lds + HG_PART); LAS float* vec = (LAS float*)(lds + HG_VEC1);
    const float lb = lbs_l[h * 128 + d];
    f32x4 S[8];
#pragma unroll
    for (int et = 0; et < 8; ++et) S[et] = (f32x4){0.f, 0.f, 0.f, 0.f};
    float dprod = 1.f;
    const int sr = tid >> 4, sc16 = tid & 15;
    v4u pre[6];
    {   const bf16* gq = rb.proj + ((size_t)b * SEQ + seg * SEGLEN + sr) * LDP + PC_Q + h * 128 + sc16 * 8;
        pre[0] = *(const v4u*)gq; pre[1] = *(const v4u*)(gq + 32 * (size_t)LDP); pre[2] = *(const v4u*)(gq + PC_F); pre[3] = *(const v4u*)(gq + 32 * (size_t)LDP + PC_F);
        pre[4] = *(const v4u*)(gq + PC_I); pre[5] = *(const v4u*)(gq + 32 * (size_t)LDP + PC_I); }
    for (int ch = 0; ch < NCH; ++ch) {
        const size_t row0 = (size_t)b * SEQ + seg * SEGLEN + ch * RC;
        bf16* gq = rb.proj + (row0 + sr) * LDP + PC_Q + h * 128 + sc16 * 8;
        *(LAS v4u*)(Qt + sr * PQ + sc16 * 16) = pre[0]; *(LAS v4u*)(Qt + (sr + 32) * PQ + sc16 * 16) = pre[1];
        *(LAS v4u*)(Kt + sr * PQ + sc16 * 16) = pre[2]; *(LAS v4u*)(Kt + (sr + 32) * PQ + sc16 * 16) = pre[3];
        *(LAS v4u*)(V + sr * PQ + sc16 * 16) = pre[4]; *(LAS v4u*)(V + (sr + 32) * PQ + sc16 * 16) = pre[5];
        if (ch + 1 < NCH) { const bf16* gn = gq + RC * (size_t)LDP;
            pre[0] = *(const v4u*)gn; pre[1] = *(const v4u*)(gn + 32 * (size_t)LDP); pre[2] = *(const v4u*)(gn + PC_F); pre[3] = *(const v4u*)(gn + 32 * (size_t)LDP + PC_F);
            pre[4] = *(const v4u*)(gn + PC_I); pre[5] = *(const v4u*)(gn + 32 * (size_t)LDP + PC_I); }
        sync_threads();
        float qq[16], kk[16], lg[16];
#pragma unroll
        for (int j = 0; j < 16; ++j) { const float q = bf2f(*(const LAS bf16*)(Qt + (16 * jq + j) * PQ + d * 2)), f = bf2f(*(const LAS bf16*)(Kt + (16 * jq + j) * PQ + d * 2));
            const float fg = lb + (1.f - lb) * sigmoidf_(f);
            qq[j] = siluf_(q) * 0.08838834764831845f; kk[j] = 1.f - fg; lg[j] = __logf(fg); }
#pragma unroll
        for (int j = 1; j < 16; ++j) lg[j] += lg[j - 1];
        part[jq * 128 + d] = lg[15];
        sync_threads();
        const float p0 = part[d], p1 = part[128 + d], p2 = part[256 + d], p3 = part[384 + d];
        const float off = (jq > 0 ? p0 : 0.f) + (jq > 1 ? p1 : 0.f) + (jq > 2 ? p2 : 0.f);
        const float bref = p0 + p1, bend = (p0 + p1) + (p2 + p3);
#pragma unroll
        for (int j = 0; j < 16; ++j) { const float e1 = __expf(fminf(fmaxf(off + lg[j] - bref, -80.f), 80.f));
            *(LAS bf16*)(Qt + (16 * jq + j) * PQ + d * 2) = f2bf(qq[j] * e1); *(LAS bf16*)(Kt + (16 * jq + j) * PQ + d * 2) = f2bf(kk[j] * frcp_(e1)); }
        if (jq == 0) { const float eref = __expf(bref), esc = __expf(bend - bref), edc = __expf(bend);
            float* cvp = rb.cv + ((size_t)((b * 8 + h) * 32 + seg * NCH + ch) * 3) * 128;
            cvp[d] = eref; cvp[128 + d] = esc; cvp[256 + d] = edc; vec[128 + d] = esc; vec[256 + d] = edc; }
        dprod *= __expf(bend);
        sync_threads();
        *(v4u*)gq = *(const LAS v4u*)(Qt + sr * PQ + sc16 * 16); *(v4u*)(gq + 32 * (size_t)LDP) = *(const LAS v4u*)(Qt + (sr + 32) * PQ + sc16 * 16);
        *(v4u*)(gq + PC_F) = *(const LAS v4u*)(Kt + sr * PQ + sc16 * 16); *(v4u*)(gq + 32 * (size_t)LDP + PC_F) = *(const LAS v4u*)(Kt + (sr + 32) * PQ + sc16 * 16);
        hgrn_state_update(S, Kt, V, vec + 128, vec + 256, w, lane);
        sync_threads();
    }
    float* sp = rb.sseg + (size_t)u * 16384 + tid * 4;
#pragma unroll
    for (int et = 0; et < 8; ++et) { LAUNDER_PTR(sp); *(f32x4*)sp = S[et]; sp += 2048; }
    if (jq == 0) rb.dseg[u * 128 + d] = dprod;
}

__device__ __forceinline__ void hgrn_pass2(const RecurBufs& rb, const float* hgn_l, float* state_out_l, int u, int tid, LAS unsigned char* lds) {
    const int b = u >> 5, h = (u >> 2) & 7, seg = u & 3, lane = tid & 63, w = tid >> 6, c = lane & 15, g = lane >> 4;
    const int it = w & 3, eh = w >> 2;
    LAS unsigned char* Qt = lds + HG_QT; LAS unsigned char* Kt = lds + HG_KT; LAS unsigned char* V = lds + HG_V; LAS unsigned char* ST = lds + HG_ST;
    LAS float* vec = (LAS float*)(lds + HG_VEC); LAS float* red = (LAS float*)(lds + HG_RED);
    f32x4 S[8];
#pragma unroll
    for (int et = 0; et < 8; ++et) S[et] = (f32x4){0.f, 0.f, 0.f, 0.f};
    for (int s = 0; s < seg; ++s) { const int u2 = u - seg + s;
        const f32x4 dc = *(const f32x4*)(rb.dseg + u2 * 128 + 16 * w + 4 * g);
        const float* sp = rb.sseg + (size_t)u2 * 16384 + tid * 4;
#pragma unroll
        for (int et = 0; et < 8; ++et) { LAUNDER_PTR(sp); S[et] = S[et] * dc + *(const f32x4*)sp; sp += 2048; } }
    const int e0 = 64 * eh + 4 * c;
    const f32x4 hn = *(const f32x4*)(hgn_l + e0);
    const float* cvb = rb.cv + ((size_t)((b * 8 + h) * 32 + seg * NCH) * 3) * 128;
    const int sr = tid >> 4, sc16 = tid & 15;
    const size_t rowS = (size_t)b * SEQ + seg * SEGLEN;
    v4u pre[6];
    {   const bf16* gq = rb.proj + (rowS + sr) * LDP + PC_Q + h * 128 + sc16 * 8;
        pre[0] = *(const v4u*)gq; pre[1] = *(const v4u*)(gq + 32 * (size_t)LDP); pre[2] = *(const v4u*)(gq + PC_F); pre[3] = *(const v4u*)(gq + 32 * (size_t)LDP + PC_F);
        pre[4] = *(const v4u*)(gq + PC_I); pre[5] = *(const v4u*)(gq + 32 * (size_t)LDP + PC_I); }
    float cvn = tid < 384 ? cvb[tid] : 0.f; f32x4 ern = *(const f32x4*)(cvb + 16 * w + 4 * g);
    for (int ch = 0; ch < NCH; ++ch) {
        const size_t row0 = rowS + ch * RC;
        *(LAS v4u*)(Qt + sr * PQ + sc16 * 16) = pre[0]; *(LAS v4u*)(Qt + (sr + 32) * PQ + sc16 * 16) = pre[1];
        *(LAS v4u*)(Kt + sr * PQ + sc16 * 16) = pre[2]; *(LAS v4u*)(Kt + (sr + 32) * PQ + sc16 * 16) = pre[3];
        *(LAS v4u*)(V + sr * PQ + sc16 * 16) = pre[4]; *(LAS v4u*)(V + (sr + 32) * PQ + sc16 * 16) = pre[5];
        if (ch + 1 < NCH) { const bf16* gq = rb.proj + (row0 + RC + sr) * LDP + PC_Q + h * 128 + sc16 * 8;
            pre[0] = *(const v4u*)gq; pre[1] = *(const v4u*)(gq + 32 * (size_t)LDP); pre[2] = *(const v4u*)(gq + PC_F); pre[3] = *(const v4u*)(gq + 32 * (size_t)LDP + PC_F);
            pre[4] = *(const v4u*)(gq + PC_I); pre[5] = *(const v4u*)(gq + 32 * (size_t)LDP + PC_I); }
        if (tid < 384) vec[tid] = cvn;
        {
            const f32x4 er = ern;
            if (ch + 1 < NCH) { if (tid < 384) cvn = cvb[(size_t)(ch + 1) * 384 + tid]; ern = *(const f32x4*)(cvb + (size_t)(ch + 1) * 384 + 16 * w + 4 * g); }
#pragma unroll
            for (int et = 0; et < 8; ++et) { const f32x4 v = S[et] * er;
                *(LAS unsigned long long*)(ST + (16 * et + c) * PQ + (16 * w + 4 * g) * 2) = (unsigned long long)pk2(v[0], v[1]) | ((unsigned long long)pk2(v[2], v[3]) << 32); } }
        unsigned long long ogv[4];
#pragma unroll
        for (int r = 0; r < 4; ++r) ogv[r] = *(const unsigned long long*)(rb.proj + (row0 + 16 * it + 4 * g + r) * LDP + PC_OG + h * 128 + e0);
        sync_threads();
        bf16x8 Qfr[4];
#pragma unroll
        for (int kd = 0; kd < 4; ++kd) Qfr[kd] = frag_rows(Qt, PQ, 16 * it + c, 32 * kd + 8 * g);
        unsigned PT[4][2];
#pragma unroll
        for (int jt = 0; jt < 4; ++jt) {
            f32x4 acc = (f32x4){0.f, 0.f, 0.f, 0.f};
            if (jt <= it) {
#pragma unroll
                for (int kd = 0; kd < 4; ++kd) acc = mfma16(frag_rows(Kt, PQ, 16 * jt + c, 32 * kd + 8 * g), Qfr[kd], acc);
                if (jt == it) {
#pragma unroll
                    for (int r = 0; r < 4; ++r) acc[r] = (4 * g + r <= c) ? acc[r] : 0.f; }
            }
            PT[jt][0] = pk2(acc[0], acc[1]); PT[jt][1] = pk2(acc[2], acc[3]); SCHED_FENCE();
        }
        f32x4 o[4];
#pragma unroll
        for (int et = 0; et < 4; ++et) o[et] = (f32x4){0.f, 0.f, 0.f, 0.f};
#pragma unroll
        for (int ks = 0; ks < 2; ++ks) if (2 * ks <= it) {
            v4u pa = (v4u){PT[2 * ks][0], PT[2 * ks][1], PT[2 * ks + 1][0], PT[2 * ks + 1][1]};
            const bf16x8 A = __builtin_bit_cast(bf16x8, pa);
#pragma unroll
            for (int et = 0; et < 4; ++et) o[et] = mfma16(A, frag_tr(V, PQ, 32 * ks + 4 * g, 32 * ks + 16 + 4 * g, 16 * (4 * eh + et), lane), o[et]);
        }
#pragma unroll
        for (int kd = 0; kd < 4; ++kd) {
#pragma unroll
            for (int et = 0; et < 4; ++et) o[et] = mfma16(Qfr[kd], frag_rows(ST, PQ, 16 * (4 * eh + et) + c, 32 * kd + 8 * g), o[et]);
            SCHED_FENCE(); }
        hgrn_state_update(S, Kt, V, vec + 128, vec + 256, w, lane);
        float ss[4];
#pragma unroll
        for (int r = 0; r < 4; ++r) { float s = 0.f;
#pragma unroll
            for (int et = 0; et < 4; ++et) s += o[et][r] * o[et][r];
            s += SHFL_XOR(s, 1); s += SHFL_XOR(s, 2); s += SHFL_XOR(s, 4); s += SHFL_XOR(s, 8); ss[r] = s; }
        if (c == 0) {
#pragma unroll
            for (int r = 0; r < 4; ++r) red[(16 * it + 4 * g + r) * 2 + eh] = ss[r]; }
        sync_threads();
#pragma unroll
        for (int r = 0; r < 4; ++r) { const int i = 16 * it + 4 * g + r; const float rstd = rsqrtf((red[i * 2] + red[i * 2 + 1]) * (1.f / 128.f) + EPS);
            float ov[4];
#pragma unroll
            for (int et = 0; et < 4; ++et) { const float og = bf2f((bf16)(ogv[r] >> (16 * et))); ov[et] = o[et][r] * rstd * hn[et] * siluf_(og); }
            *(unsigned long long*)(rb.ohg + (row0 + i) * 1024 + h * 128 + e0) = (unsigned long long)pk2(ov[0], ov[1]) | ((unsigned long long)pk2(ov[2], ov[3]) << 32); }
        sync_threads();
    }
    if (seg == NSEG - 1) { float* so = state_out_l + (size_t)(b * 8 + h) * 16384 + (size_t)(16 * w + 4 * g) * 128 + 4 * c;
#pragma unroll
        for (int r = 0; r < 4; ++r)
#pragma unroll
            for (int a = 0; a < 2; ++a) *(f32x4*)(so + r * 128 + 64 * a) = (f32x4){S[4 * a][r], S[4 * a + 1][r], S[4 * a + 2][r], S[4 * a + 3][r]}; }
}

constexpr int PR = 1040;
constexpr int SD_T = 0, SD_H = 66560, SD_XO = 66560  , SD_DT = 136192, SD_CUM = 137216, SD_RED = 138240, SD_END = 139264;
__device__ __forceinline__ int ssd_gcol(int grp, int ch16) { return ch16 < 32 ? grp * 256 + ch16 * 8 : (ch16 < 48 ? 2048 + grp * 128 + (ch16 - 32) * 8 : 3072 + grp * 128 + (ch16 - 48) * 8); }

__device__ __forceinline__ void ssd_state_update(f32x4 (&H)[4][4], LAS unsigned char* Xi, int xp, LAS unsigned char* Bi, int bp, const LAS float* sDt, const LAS float* sCum, int w, int lane) {
    const int g = lane >> 4, k = w >> 1, nh = w & 1;
    const float tot = sCum[63 * 4 + k]; const float et = __expf(tot);
#pragma unroll
    for (int nt = 0; nt < 4; ++nt)
#pragma unroll
        for (int pt = 0; pt < 4; ++pt) H[nt][pt] = H[nt][pt] * et;
#pragma unroll
    for (int ks = 0; ks < 2; ++ks) {
        float wg[8];
#pragma unroll
        for (int j = 0; j < 8; ++j) wg[j] = __expf(tot - sCum[(32 * ks + 8 * g + j) * 4 + k]) * sDt[(32 * ks + 8 * g + j) * 4 + k];
        bf16x8 Bx[4];
#pragma unroll
        for (int pt = 0; pt < 4; ++pt) Bx[pt] = scale_frag8(frag_tr(Xi, xp, 32 * ks + 8 * g, 32 * ks + 8 * g + 4, 64 * k + 16 * pt, lane), wg);
#pragma unroll
        for (int nt = 0; nt < 4; ++nt) { const bf16x8 A = frag_tr(Bi, bp, 32 * ks + 8 * g, 32 * ks + 8 * g + 4, 16 * (4 * nh + nt), lane);
#pragma unroll
            for (int pt = 0; pt < 4; ++pt) H[nt][pt] = mfma16(A, Bx[pt], H[nt][pt]);
            SCHED_FENCE(); }
    }
}

typedef float f32x2r __attribute__((ext_vector_type(2)));
__device__ __forceinline__ f32x2r unpack2(unsigned w) { return (f32x2r){__uint_as_float(w << 16), __uint_as_float(w & 0xffff0000u)}; }
__device__ __forceinline__ f32x2r silu2(f32x2r a) {
    const f32x2r t = a * (-1.4426950408889634f); f32x2r e; e.x = __builtin_amdgcn_exp2f_(t.x); e.y = __builtin_amdgcn_exp2f_(t.y);
    const f32x2r d = e + 1.0f; f32x2r r; r.x = frcp_(d.x); r.y = frcp_(d.y); return a * r; }
constexpr int SD_RH = SD_XO + 64 * PX;
__device__ __forceinline__ void ssd_pass1(const RecurBufs& rb, const float* conv_w, const float* conv_b, const float* dt_bias, const float* a_log, float* conv_out_l, int u, int tid, LAS unsigned char* lds) {
    const int b = u >> 5, grp = (u >> 2) & 7, seg = u & 3, lane = tid & 63, w = tid >> 6;
    LAS unsigned char* T = lds + SD_T; LAS float* sDt = (LAS float*)(lds + SD_DT); LAS float* sCum = (LAS float*)(lds + SD_CUM); LAS unsigned char* RH = lds + SD_RH;
    const int cp = tid & 255, half = tid >> 8, t0c = 2 * cp;
    const int chx = t0c < 256 ? (grp * 256 + t0c) : (t0c < 384 ? (2048 + grp * 128 + (t0c - 256)) : (3072 + grp * 128 + (t0c - 384)));
    const int xcol = (t0c & ~63) + 16 * (t0c & 3) + ((t0c & 63) >> 2);
    const f32x2r w0 = (f32x2r){conv_w[chx], conv_w[chx + 1]}, w1 = (f32x2r){conv_w[4096 + chx], conv_w[4096 + chx + 1]}, w2 = (f32x2r){conv_w[8192 + chx], conv_w[8192 + chx + 1]},
                 w3 = (f32x2r){conv_w[12288 + chx], conv_w[12288 + chx + 1]}, cb = (f32x2r){conv_b[chx], conv_b[chx + 1]};
    const size_t rowS = (size_t)b * SEQ + seg * SEGLEN;
    if (half == 0) {
#pragma unroll
        for (int j = 0; j < 3; ++j) { unsigned v = 0u; if (seg > 0) v = *(const unsigned*)(rb.proj + (rowS - 3 + j) * LDP + PC_XBC + chx); *(LAS unsigned*)(RH + j * 1024 + cp * 4) = v; } }
    f32x4 H[4][4];
#pragma unroll
    for (int nt = 0; nt < 4; ++nt)
#pragma unroll
        for (int pt = 0; pt < 4; ++pt) H[nt][pt] = (f32x4){0.f, 0.f, 0.f, 0.f};
    float tsum = 0.f;
    const int ch16 = tid & 63, rr = tid >> 6;
    const int gcol = ssd_gcol(grp, ch16);
    LAS unsigned char* XO = lds + SD_XO;
    v4u raw[8];
    {   const bf16* gp = rb.proj + (rowS + rr) * LDP + PC_XBC + gcol;
#pragma unroll
        for (int i = 0; i < 8; ++i) { LAUNDER_PTR(gp); raw[i] = *(const v4u*)gp; gp += 8 * (size_t)LDP; } }
    bf16 dtn = 0;
    if (w < 4) dtn = rb.proj[(rowS + lane) * LDP + PC_DT + grp * 4 + w];
    unsigned hr0 = 0u, hr1 = 0u, hr2 = 0u;
    for (int ch = 0; ch < NCH; ++ch) {
        const size_t row0 = rowS + ch * RC;
        if (w < 4) {
            const int head = grp * 4 + w; const size_t row = row0 + lane;
            const float dv = softplusf_(bf2f(dtn) + dt_bias[head]);
            if (ch + 1 < NCH) dtn = rb.proj[(row + RC) * LDP + PC_DT + head];
            float la = dv * (-__expf(a_log[head]));
#pragma unroll
            for (int o = 1; o < 64; o <<= 1) { const float t = shfl_up_f(la, o, lane); if (lane >= o) la += t; }
            sDt[lane * 4 + w] = dv; sCum[lane * 4 + w] = la; rb.dtv[row * 32 + head] = dv; rb.cum[row * 32 + head] = la;
        }
#pragma unroll
        for (int i = 0; i < 8; ++i) *(LAS v4u*)(T + (rr + 8 * i) * PR + ch16 * 16) = raw[i];
        if (ch + 1 < NCH) { const bf16* gp = rb.proj + (row0 + RC + rr) * LDP + PC_XBC + gcol;
#pragma unroll
            for (int i = 0; i < 8; ++i) { LAUNDER_PTR(gp); raw[i] = *(const v4u*)gp; gp += 8 * (size_t)LDP; } }
        sync_threads();
        if (half == 0) { hr0 = *(const LAS unsigned*)(RH + cp * 4); hr1 = *(const LAS unsigned*)(RH + 1024 + cp * 4); hr2 = *(const LAS unsigned*)(RH + 2048 + cp * 4); }
        else { hr0 = *(const LAS unsigned*)(T + 29 * PR + cp * 4); hr1 = *(const LAS unsigned*)(T + 30 * PR + cp * 4); hr2 = *(const LAS unsigned*)(T + 31 * PR + cp * 4); }
        sync_threads();
        {
            f32x2r r0 = unpack2(hr0), r1 = unpack2(hr1), r2 = unpack2(hr2);
            const LAS unsigned char* src = T + (32 * half) * PR + cp * 4;
            unsigned lastw0 = hr0, lastw1 = hr1, lastw2 = hr2;
#pragma unroll 8
            for (int j = 0; j < 32; ++j) { const unsigned cw = *(const LAS unsigned*)(src + j * PR); const f32x2r cur = unpack2(cw);
                const f32x2r a = cb + w0 * r0 + w1 * r1 + w2 * r2 + w3 * cur; r0 = r1; r1 = r2; r2 = cur; lastw0 = lastw1; lastw1 = lastw2; lastw2 = cw;
                const f32x2r v = silu2(a); const unsigned ow = pk2(v.x, v.y);
                if (cp < 128) { LAS unsigned char* d = XO + (32 * half + j) * PX + xcol * 2; *(LAS bf16*)d = (bf16)ow; *(LAS bf16*)(d + 32) = (bf16)(ow >> 16); }
                else *(LAS unsigned*)(T + (32 * half + j) * PR + cp * 4) = ow; }
            if (half == 1) { *(LAS unsigned*)(RH + cp * 4) = lastw0; *(LAS unsigned*)(RH + 1024 + cp * 4) = lastw1; *(LAS unsigned*)(RH + 2048 + cp * 4) = lastw2;
                hr0 = lastw0; hr1 = lastw1; hr2 = lastw2; }
        }
        sync_threads();
        tsum += sCum[63 * 4 + (w >> 1)];
        ssd_state_update(H, XO, PX, T + 512, PR, sDt, sCum, w, lane);
        {   bf16* gp = rb.xbcc + (row0 + rr) * 4096 + gcol;
            const LAS unsigned char* src = ch16 < 32 ? (XO + ch16 * 16) : (T + ch16 * 16); const int spitch = ch16 < 32 ? PX : PR;
#pragma unroll
            for (int i = 0; i < 8; ++i) { LAUNDER_PTR(gp); *(v4u*)gp = *(const LAS v4u*)(src + (rr + 8 * i) * spitch); gp += 8 * 4096; } }
        sync_threads();
    }
    float* hp = rb.hseg + (size_t)u * 32768 + tid * 4;
#pragma unroll
    for (int nt = 0; nt < 4; ++nt)
#pragma unroll
        for (int pt = 0; pt < 4; ++pt) { LAUNDER_PTR(hp); *(f32x4*)hp = H[nt][pt]; hp += 2048; }
    if ((tid & 127) == 0) rb.tseg[u * 4 + (w >> 1)] = tsum;
    if (seg == NSEG - 1 && half == 1) { float* co = conv_out_l + (size_t)b * 3 * 4096;
        const f32x2r a0 = unpack2(hr0), a1 = unpack2(hr1), a2 = unpack2(hr2);
        co[chx] = a0.x; co[chx + 1] = a0.y; co[4096 + chx] = a1.x; co[4096 + chx + 1] = a1.y; co[8192 + chx] = a2.x; co[8192 + chx + 1] = a2.y; }
}

__device__ __forceinline__ void ssd_pass2(const RecurBufs& rb, const float* d_skip, const float* ssm_norm, float* state_out_l, int u, int tid, LAS unsigned char* lds) {
    const int b = u >> 5, grp = (u >> 2) & 7, seg = u & 3, lane = tid & 63, w = tid >> 6, c = lane & 15, g = lane >> 4;
    const int k = w >> 1, hf = w & 1, head = grp * 4 + k;
    LAS unsigned char* T = lds + SD_T; LAS unsigned char* sB = T + 512; LAS unsigned char* sC = T + 768; LAS unsigned char* hS = lds + SD_H + k * (64 * PQ);
    LAS float* sDt = (LAS float*)(lds + SD_DT); LAS float* sCum = (LAS float*)(lds + SD_CUM); LAS float* red = (LAS float*)(lds + SD_RED);
    f32x4 H[4][4];
#pragma unroll
    for (int nt = 0; nt < 4; ++nt)
#pragma unroll
        for (int pt = 0; pt < 4; ++pt) H[nt][pt] = (f32x4){0.f, 0.f, 0.f, 0.f};
    for (int s = 0; s < seg; ++s) { const int u2 = u - seg + s; const float dc = __expf(rb.tseg[u2 * 4 + k]); const float* hp = rb.hseg + (size_t)u2 * 32768 + tid * 4;
#pragma unroll
        for (int nt = 0; nt < 4; ++nt)
#pragma unroll
            for (int pt = 0; pt < 4; ++pt) { LAUNDER_PTR(hp); H[nt][pt] = H[nt][pt] * dc + *(const f32x4*)hp; hp += 2048; } }
    const float Dk = d_skip[head];
    const size_t rowS = (size_t)b * SEQ + seg * SEGLEN;
    const int ch16 = tid & 63, rr = tid >> 6; const int gcol = ssd_gcol(grp, ch16);
    const int chn0 = grp * 256 + k * 64 + 4 * c;
    for (int ch = 0; ch < NCH; ++ch) {
        const size_t row0 = rowS + ch * RC;
        {   v4u raw[8];
            {   const bf16* gp = rb.xbcc + (row0 + rr) * 4096 + gcol;
#pragma unroll
                for (int i = 0; i < 8; ++i) { LAUNDER_PTR(gp); raw[i] = *(const v4u*)gp; gp += 8 * 4096; } }
            if (tid < 256) { sDt[tid] = rb.dtv[(row0 + (tid >> 2)) * 32 + grp * 4 + (tid & 3)]; sCum[tid] = rb.cum[(row0 + (tid >> 2)) * 32 + grp * 4 + (tid & 3)]; }
#pragma unroll
            for (int nt = 0; nt < 4; ++nt)
#pragma unroll
                for (int pt = 0; pt < 4; ++pt) { const f32x4 v = H[nt][pt];
                    *(LAS unsigned long long*)(hS + (4 * c + pt) * PQ + (16 * (4 * hf + nt) + 4 * g) * 2) = (unsigned long long)pk2(v[0], v[1]) | ((unsigned long long)pk2(v[2], v[3]) << 32); }
#pragma unroll
            for (int i = 0; i < 8; ++i) *(LAS v4u*)(T + (rr + 8 * i) * PR + ch16 * 16) = raw[i]; }
        sync_threads();
#pragma unroll 1
        for (int i2 = 0; i2 < 2; ++i2) {
            const int it = i2 ? 3 - hf : hf;
            unsigned long long zz[4];
#pragma unroll
            for (int r = 0; r < 4; ++r) zz[r] = *(const unsigned long long*)(rb.proj + (row0 + 16 * it + 4 * g + r) * LDP + PC_Z + chn0);
            f32x4 ya[4];
#pragma unroll
            for (int pt = 0; pt < 4; ++pt) ya[pt] = (f32x4){0.f, 0.f, 0.f, 0.f};
#pragma unroll
            for (int kn = 0; kn < 4; ++kn) { const bf16x8 Cf = frag_rows(sC, PR, 16 * it + c, 32 * kn + 8 * g);
#pragma unroll
                for (int pt = 0; pt < 4; ++pt) ya[pt] = mfma16(Cf, frag_rows(hS, PQ, 4 * c + pt, 32 * kn + 8 * g), ya[pt]);
                SCHED_FENCE(); }
            {   float ei[4];
#pragma unroll
                for (int r = 0; r < 4; ++r) ei[r] = __expf(sCum[(16 * it + 4 * g + r) * 4 + k]);
#pragma unroll
                for (int pt = 0; pt < 4; ++pt)
#pragma unroll
                    for (int r = 0; r < 4; ++r) ya[pt][r] *= ei[r]; }
            const float cum_i = sCum[(16 * it + c) * 4 + k];
            unsigned PT[4][2];
#pragma unroll
            for (int jt = 0; jt < 4; ++jt) {
                f32x4 acc = (f32x4){0.f, 0.f, 0.f, 0.f};
                if (jt <= it) {
#pragma unroll
                    for (int kn = 0; kn < 4; ++kn) acc = mfma16(frag_rows(sB, PR, 16 * jt + c, 32 * kn + 8 * g), frag_rows(sC, PR, 16 * it + c, 32 * kn + 8 * g), acc);
#pragma unroll
                    for (int r = 0; r < 4; ++r) { const int j = 16 * jt + 4 * g + r; const float df = cum_i - sCum[j * 4 + k]; const bool keep = (jt < it) || (4 * g + r <= c);
                        acc[r] = keep ? acc[r] * __expf(fminf(df, 0.f)) * sDt[j * 4 + k] : 0.f; }
                }
                PT[jt][0] = pk2(acc[0], acc[1]); PT[jt][1] = pk2(acc[2], acc[3]); SCHED_FENCE();
            }
#pragma unroll
            for (int ks = 0; ks < 2; ++ks) if (2 * ks <= it) {
                v4u pa = (v4u){PT[2 * ks][0], PT[2 * ks][1], PT[2 * ks + 1][0], PT[2 * ks + 1][1]};
                const bf16x8 A = __builtin_bit_cast(bf16x8, pa);
#pragma unroll
                for (int pt = 0; pt < 4; ++pt) ya[pt] = mfma16(A, frag_tr(T, PR, 32 * ks + 4 * g, 32 * ks + 16 + 4 * g, 64 * k + 16 * pt, lane), ya[pt]);
                SCHED_FENCE();
            }
#pragma unroll
            for (int r = 0; r < 4; ++r) { const int i = 16 * it + 4 * g + r; float s = 0.f; float yv[4];
#pragma unroll
                for (int pt = 0; pt < 4; ++pt) { const float xc = bf2f(*(const LAS bf16*)(T + i * PR + (64 * k + 16 * pt + c) * 2)); const float z = bf2f((bf16)(zz[r] >> (16 * pt)));
                    const bf16 yb = f2bf((ya[pt][r] + Dk * xc) * siluf_(z)); yv[pt] = bf2f(yb); s += yv[pt] * yv[pt]; }
                *(unsigned long long*)(rb.y + (row0 + i) * 2048 + chn0) = (unsigned long long)pk2(yv[0], yv[1]) | ((unsigned long long)pk2(yv[2], yv[3]) << 32);
                s += SHFL_XOR(s, 1); s += SHFL_XOR(s, 2); s += SHFL_XOR(s, 4); s += SHFL_XOR(s, 8);
                if (c == 0) red[i * 4 + k] = s; }
            SCHED_FENCE();
        }
        ssd_state_update(H, T, PR, T + 512, PR, sDt, sCum, w, lane);
        sync_threads();
        {   const f32x4 nw = *(const f32x4*)(ssm_norm + chn0);
            unsigned long long yy[8];
            const int itA = hf, itB = 3 - hf;
            bf16* yb0 = rb.y + (row0 + 16 * itA + 4 * g) * 2048 + chn0;
            const int jump = (16 * (itB - itA) - 3) * 2048;
            {   bf16* yp = yb0;
#pragma unroll
                for (int q = 0; q < 8; ++q) { LAUNDER_PTR(yp); yy[q] = *(const unsigned long long*)yp; yp += (q == 3) ? jump : 2048; } }
            bf16* yp = yb0;
#pragma unroll
            for (int q = 0; q < 8; ++q) { const int i = 16 * (q < 4 ? itA : itB) + 4 * g + (q & 3);
                const float rstd = rsqrtf(((red[i * 4] + red[i * 4 + 1]) + (red[i * 4 + 2] + red[i * 4 + 3])) * (1.f / 256.f) + EPS);
                const unsigned lo = (unsigned)yy[q], hi = (unsigned)(yy[q] >> 32);
                const float y0 = __uint_as_float(lo << 16) * rstd * nw[0], y1 = __uint_as_float(lo & 0xffff0000u) * rstd * nw[1], y2 = __uint_as_float(hi << 16) * rstd * nw[2], y3 = __uint_as_float(hi & 0xffff0000u) * rstd * nw[3];
                LAUNDER_PTR(yp); *(unsigned long long*)yp = (unsigned long long)pk2(y0, y1) | ((unsigned long long)pk2(y2, y3) << 32); yp += (q == 3) ? jump : 2048; } }
        sync_threads();
    }
    if (seg == NSEG - 1) { float* so = state_out_l + ((size_t)(b * 32 + head) * 64 + 4 * c) * 128 + 64 * hf + 4 * g;
#pragma unroll
        for (int pt = 0; pt < 4; ++pt)
#pragma unroll
            for (int nt = 0; nt < 4; ++nt) *(f32x4*)(so + pt * 128 + 16 * nt) = H[nt][pt]; }
}

__device__ __forceinline__ float row32_sum(float s) { s += SHFL_XOR(s, 1); s += SHFL_XOR(s, 2); s += SHFL_XOR(s, 4); s += SHFL_XOR(s, 8); s += SHFL_XOR(s, 16); return s; }

__device__ __forceinline__ void hgrn_sample_load(f32x4 (&st)[8], const float* state_in, int bh, int tid) {
    const float* sp = state_in + (size_t)bh * 16384 + tid * 4;
#pragma unroll
    for (int it = 0; it < 8; ++it) { LAUNDER_PTR(sp); st[it] = *(const f32x4*)sp; sp += 2048; }
}
__device__ __forceinline__ void hgrn_sample_step(const bf16* proj, const float* lbs_l, const float* hgn_l, const float* state_in, float* state_out, bf16* ohg, int bh, int tid, LAS unsigned char* lds,
                                                 f32x4 (&st)[8], int bh_next) {
    const int b = bh >> 3, h = bh & 7, lane = tid & 63, w = tid >> 6;
    LAS float* sq = (LAS float*)lds; LAS float* sg = sq + 128; LAS float* sk = sq + 256; LAS float* sv = sq + 384; LAS float* so = (LAS float*)(lds + 8192); LAS float* sred = (LAS float*)(lds + 16384);
    const size_t row = (size_t)MP + b;
    float ogv = 0.f, q_ = 0.f, f_ = 0.f, v_ = 0.f, lb_ = 0.f;
    if (tid < 128) { const bf16* pr = proj + row * LDP + h * 128; q_ = bf2f(pr[PC_Q + tid]); f_ = bf2f(pr[PC_F + tid]); lb_ = lbs_l[h * 128 + tid]; v_ = bf2f(pr[PC_I + hg_vpos(tid)]); ogv = bf2f(pr[PC_OG + tid]); }
    if (tid < 128) { const float fg = lb_ + (1.f - lb_) * sigmoidf_(f_);
        sq[tid] = siluf_(q_) * 0.08838834764831845f; sg[tid] = fg; sk[tid] = 1.f - fg; sv[tid] = v_; }
    sync_threads();
    const int dv4 = tid & 31, rg = tid >> 5;
    const f32x4 vv = *(const LAS f32x4*)(sv + 4 * dv4);
    f32x4 oacc = (f32x4){0.f, 0.f, 0.f, 0.f};
    float* op = state_out + (size_t)bh * 16384 + tid * 4;
    const float* np = state_in + (size_t)(bh_next >= 0 ? bh_next : bh) * 16384 + tid * 4;
#pragma unroll
    for (int it = 0; it < 8; ++it) { const int dk = it * 16 + rg; const f32x4 sn = st[it] * sg[dk] + vv * sk[dk]; LAUNDER_PTR(op); *(f32x4*)op = sn; op += 2048; oacc = oacc + sn * sq[dk];
        LAUNDER_PTR(np); if (bh_next >= 0) st[it] = *(const f32x4*)np; np += 2048; }
    *(LAS f32x4*)(so + rg * 128 + 4 * dv4) = oacc;
    sync_threads();
    if (tid < 128) { float o = 0.f;
#pragma unroll
        for (int r = 0; r < 16; ++r) o += so[r * 128 + tid];
        float ss = o * o; ss = row32_sum(ss);
        if ((lane & 31) == 0) sred[tid >> 5] = ss;
        sq[tid] = o; }
    sync_threads();
    if (tid < 128) { const float rstd = rsqrtf(((sred[0] + sred[1]) + (sred[2] + sred[3])) * (1.f / 128.f) + EPS);
        ohg[row * 1024 + h * 128 + tid] = f2bf(sq[tid] * rstd * hgn_l[tid] * siluf_(ogv)); }
    sync_threads();
    (void)w;
}

__device__ __forceinline__ void ssd_sample_load(f32x4 (&st)[16], const float* state_in, int bg, int tid) {
    const float* sp = state_in + ((size_t)((bg >> 3) * 32 + (bg & 7) * 4)) * 8192 + tid * 4;
#pragma unroll
    for (int it = 0; it < 16; ++it) { LAUNDER_PTR(sp); st[it] = *(const f32x4*)sp; sp += 2048; }
}
__device__ __forceinline__ void ssd_sample_step(const bf16* proj, const float* conv_w, const float* conv_b, const float* dt_bias, const float* a_log, const float* d_skip, const float* ssm_norm,
                                                const float* state_in, const float* conv_in, float* state_out, float* conv_out, bf16* ybuf, int bg, int tid, LAS unsigned char* lds,
                                                f32x4 (&st)[16], int bg_next) {
    const int b = bg >> 3, grp = bg & 7, lane = tid & 63, w = tid >> 6;
    LAS float* sx = (LAS float*)(lds + 2048); LAS float* sB = (LAS float*)(lds + 3072); LAS float* sC = (LAS float*)(lds + 3584); LAS float* sdt = (LAS float*)(lds + 4096); LAS float* sdec = (LAS float*)(lds + 4112);
    LAS float* sy = (LAS float*)(lds + 4608); LAS float* sred = (LAS float*)(lds + 16384);
    const size_t row = (size_t)MP + b;
    {
        const int chx = tid < 256 ? (grp * 256 + tid) : (tid < 384 ? (2048 + grp * 128 + (tid - 256)) : (3072 + grp * 128 + (tid - 384)));
        const float* ci = conv_in + (size_t)b * 3 * 4096; const float r0 = ci[chx], r1 = ci[4096 + chx], r2 = ci[8192 + chx];
        const float cur = bf2f(proj[row * LDP + PC_XBC + chx]);
        const float cw0 = conv_w[chx], cw1 = conv_w[4096 + chx], cw2 = conv_w[8192 + chx], cw3 = conv_w[12288 + chx], cbb = conv_b[chx];
        float dtr = 0.f, dtbv = 0.f, alg = 0.f; if (tid < 4) { const int head = grp * 4 + tid; dtr = bf2f(proj[row * LDP + PC_DT + head]); dtbv = dt_bias[head]; alg = a_log[head]; }
        const float a = cbb + cw0 * r0 + cw1 * r1 + cw2 * r2 + cw3 * cur;
        const float v = siluf_(a);
        if (tid < 256) sx[tid] = v; else if (tid < 384) sB[tid - 256] = v; else sC[tid - 384] = v;
        float* co = conv_out + (size_t)b * 3 * 4096; co[chx] = r1; co[4096 + chx] = r2; co[8192 + chx] = cur;
        if (tid < 4) { const float dv = softplusf_(dtr + dtbv); sdt[tid] = dv; sdec[tid] = __expf(dv * (-__expf(alg))); } }
    sync_threads();
    const int n4 = tid & 31, pr_ = tid >> 5;
    const f32x4 Bv = *(const LAS f32x4*)(sB + 4 * n4), Cv = *(const LAS f32x4*)(sC + 4 * n4);
    float* op = state_out + ((size_t)(b * 32 + grp * 4)) * 8192 + tid * 4;
    const int bgn = bg_next >= 0 ? bg_next : bg; const float* np = state_in + ((size_t)((bgn >> 3) * 32 + (bgn & 7) * 4)) * 8192 + tid * 4;
#pragma unroll
    for (int it = 0; it < 16; ++it) { const int k = it >> 2, p = (it & 3) * 16 + pr_; const float xdt = sx[k * 64 + p] * sdt[k];
        const f32x4 hn = st[it] * sdec[k] + Bv * xdt; LAUNDER_PTR(op); *(f32x4*)op = hn; op += 2048;
        LAUNDER_PTR(np); if (bg_next >= 0) st[it] = *(const f32x4*)np; np += 2048;
        const f32x4 t = hn * Cv; float y = (t[0] + t[1]) + (t[2] + t[3]); y = row32_sum(y);
        if ((lane & 31) == 0) sy[k * 64 + p] = y; }
    sync_threads();
    float yv = 0.f;
    if (tid < 256) { const int k = tid >> 6; const float z = bf2f(proj[row * LDP + PC_Z + grp * 256 + tid]);
        yv = (sy[tid] + d_skip[grp * 4 + k] * sx[tid]) * siluf_(z);
        float ss = yv * yv; ss = row32_sum(ss); if ((lane & 31) == 0) sred[tid >> 5] = ss; }
    sync_threads();
    if (tid < 256) { float tot = 0.f;
#pragma unroll
        for (int r = 0; r < 8; ++r) tot += sred[r];
        ybuf[row * 2048 + grp * 256 + tid] = f2bf(yv * rsqrtf(tot * (1.f / 256.f) + EPS) * ssm_norm[grp * 256 + tid]); }
    sync_threads();
    (void)w;
}

static_assert(SD_END <= LDS_BYTES - 256, "LDS map");
static_assert(8 * 16384 <= LDS_BYTES - 256, "skinny LDS");
constexpr int SK_PART = 128 * 32 * 4;
template <int RT, class Epi>
__device__ __forceinline__ void skinny_gemm(const bf16* A, size_t lda, const bf16* Bt, int K, int N, const Epi& epi, int wg, int wg_first, int wg_count, int tid, LAS unsigned char* lds, int nrb = 1) {
    const int lane = tid & 63, w = tid >> 6, c = lane & 15, g = lane >> 4;
    constexpr int NRG = 8 / RT;
    const int upb = (N / 32) * NRG, nunit = upb * nrb, ksteps = K / 256;
    int me = wg - wg_first; if (me < 0 || me >= wg_count) return;
    for (int s = me; s < nunit; s += wg_count) {
        const int rb = s / upb, sr = s - rb * upb; const int n0 = 32 * (sr / NRG), r0 = rb * 128 + (sr % NRG) * (16 * RT);
        f32x4 acc[RT][2];
#pragma unroll
        for (int rt = 0; rt < RT; ++rt) { acc[rt][0] = (f32x4){0.f, 0.f, 0.f, 0.f}; acc[rt][1] = (f32x4){0.f, 0.f, 0.f, 0.f}; }
        const bf16* ap = A + (size_t)(r0 + c) * lda + (size_t)w * (K / 8) + 8 * g;
        const bf16* bp = Bt + (size_t)(n0 + c) * K + (size_t)w * (K / 8) + 8 * g;
#pragma unroll 4
        for (int ks = 0; ks < ksteps; ++ks) {
            bf16x8 af[RT], bfr[2];
#pragma unroll
            for (int rt = 0; rt < RT; ++rt) af[rt] = *(const bf16x8*)(ap + (size_t)(16 * rt) * lda + 32 * ks);
            bfr[0] = *(const bf16x8*)(bp + 32 * ks); bfr[1] = *(const bf16x8*)(bp + (size_t)16 * K + 32 * ks);
#pragma unroll
            for (int rt = 0; rt < RT; ++rt) { acc[rt][0] = mfma16(af[rt], bfr[0], acc[rt][0]); acc[rt][1] = mfma16(af[rt], bfr[1], acc[rt][1]); }
        }
        LAS float* part = (LAS float*)(lds + w * SK_PART);
#pragma unroll
        for (int rt = 0; rt < RT; ++rt)
#pragma unroll
            for (int nt = 0; nt < 2; ++nt)
#pragma unroll
                for (int r = 0; r < 4; ++r) part[(16 * rt + 4 * g + r) * 32 + 16 * nt + c] = acc[rt][nt][r];
        sync_threads();
        if (RT == 8 || tid < 64 * RT) {
            const int row = tid >> 2, c8 = (tid & 3) * 8;
            f32x4 v0 = (f32x4){0.f, 0.f, 0.f, 0.f}, v1 = (f32x4){0.f, 0.f, 0.f, 0.f};
#pragma unroll
            for (int ww = 0; ww < 8; ++ww) { const LAS float* pp = (const LAS float*)(lds + ww * SK_PART) + row * 32 + c8; v0 = v0 + *(const LAS f32x4*)pp; v1 = v1 + *(const LAS f32x4*)(pp + 4); }
            epi(r0 + row, n0 + c8, v0, v1);
        }
        sync_threads();
    }
}
struct SkStoreBf16 { bf16* O; int ld; int act;
    __device__ __forceinline__ void operator()(int row, int col, f32x4 v0, f32x4 v1) const {
        if (act) {
#pragma unroll
            for (int j = 0; j < 4; ++j) { const float a = fmaxf(v0[j], 0.f), b = fmaxf(v1[j], 0.f); v0[j] = a * a; v1[j] = b * b; } }
        v4u o; o.x = pk2(v0[0], v0[1]); o.y = pk2(v0[2], v0[3]); o.z = pk2(v1[0], v1[1]); o.w = pk2(v1[2], v1[3]);
        *(v4u*)(O + (size_t)row * ld + col) = o; } };
__device__ __forceinline__ void sk_unpack8(const v4u w, f32x4& lo, f32x4& hi) {
    lo = (f32x4){__uint_as_float(w.x << 16), __uint_as_float(w.x & 0xffff0000u), __uint_as_float(w.y << 16), __uint_as_float(w.y & 0xffff0000u)};
    hi = (f32x4){__uint_as_float(w.z << 16), __uint_as_float(w.z & 0xffff0000u), __uint_as_float(w.w << 16), __uint_as_float(w.w & 0xffff0000u)}; }
struct SkGateA { bf16* T; const bf16* G; int ldg; const float* bm;
    __device__ __forceinline__ void operator()(int row, int col, f32x4 v0, f32x4 v1) const {
        f32x4 g0, g1; sk_unpack8(*(const v4u*)(G + (size_t)row * ldg + col), g0, g1);
        const f32x4 b0 = *(const f32x4*)(bm + col), b1 = *(const f32x4*)(bm + col + 4);
#pragma unroll
        for (int j = 0; j < 4; ++j) { v0[j] *= sigmoidf_(g0[j] + b0[j]); v1[j] *= sigmoidf_(g1[j] + b1[j]); }
        v4u o; o.x = pk2(v0[0], v0[1]); o.y = pk2(v0[2], v0[3]); o.z = pk2(v1[0], v1[1]); o.w = pk2(v1[2], v1[3]);
        *(v4u*)(T + (size_t)row * 1024 + col) = o; } };
struct SkGateB { const bf16* T; bf16* U; const bf16* G; int ldg; const float* bm;
    __device__ __forceinline__ void operator()(int row, int col, f32x4 v0, f32x4 v1) const {
        f32x4 g0, g1; sk_unpack8(*(const v4u*)(G + (size_t)row * ldg + col), g0, g1);
        const f32x4 b0 = *(const f32x4*)(bm + col), b1 = *(const f32x4*)(bm + col + 4);
        f32x4 t0, t1; sk_unpack8(*(const v4u*)(T + (size_t)row * 1024 + col), t0, t1);
#pragma unroll
        for (int j = 0; j < 4; ++j) { v0[j] = t0[j] + v0[j] * sigmoidf_(g0[j] + b0[j]); v1[j] = t1[j] + v1[j] * sigmoidf_(g1[j] + b1[j]); }
        v4u o; o.x = pk2(v0[0], v0[1]); o.y = pk2(v0[2], v0[3]); o.z = pk2(v1[0], v1[1]); o.w = pk2(v1[2], v1[3]);
        *(v4u*)(U + (size_t)row * 1024 + col) = o; } };
struct SkRes { bf16* X; const float* gate; int ldgate;
    __device__ __forceinline__ void operator()(int row, int col, f32x4 v0, f32x4 v1) const {
        const float* gp = gate + (size_t)row * ldgate + col; bf16* xp = X + (size_t)row * 1024 + col;
        f32x4 x0, x1; sk_unpack8(*(const v4u*)xp, x0, x1);
        const f32x4 o0 = x0 + *(const f32x4*)gp * v0, o1 = x1 + *(const f32x4*)(gp + 4) * v1;
        v4u o; o.x = pk2(o0[0], o0[1]); o.y = pk2(o0[2], o0[3]); o.z = pk2(o1[0], o1[1]); o.w = pk2(o1[2], o1[3]); *(v4u*)xp = o; } };

template <int TB>
__device__ __forceinline__ void hgrn_seq(const bf16* proj, const float* lbs_l, const float* hgn_l, const float* state_in, float* state_out, bf16* ohg, int row_base, int T, int bh, int tid,
                                         LAS unsigned char* smem) {
    const int b = bh >> 3, h = bh & 7, lane = tid & 63, wv = tid >> 6;
    typedef float (LAS * arr_t)[128];
    arr_t sQ = (arr_t)(smem), sG = (arr_t)(smem + TB * 512), sK = (arr_t)(smem + 2 * TB * 512);
    LAS float* sRed = (LAS float*)(smem + 3 * TB * 512);
    float S[128];
    if (state_in) {
        const float* sp = state_in + (size_t)bh * 16384 + tid;
#pragma unroll
        for (int c = 0; c < 16; ++c) { asm volatile("" : "+v"(sp));
#pragma unroll
            for (int j = 0; j < 8; ++j) S[c * 8 + j] = sp[j * 128];
            sp += 1024; }
    } else {
#pragma unroll
        for (int d = 0; d < 128; ++d) S[d] = 0.f;
    }
    const float lb = lbs_l[h * 128 + tid], hn = hgn_l[tid];
    for (int t0 = 0; t0 < T; t0 += TB) {
        float v[TB], og[TB], o[TB];
#pragma unroll
        for (int tt = 0; tt < TB; ++tt) { v[tt] = 0.f; og[tt] = 0.f;
            if (t0 + tt < T) { const bf16* pr = proj + (size_t)(row_base + b * T + t0 + tt) * LDP + h * 128 + tid;
                const float q = bf2f(pr[PC_Q]), f = bf2f(pr[PC_F]); v[tt] = bf2f(pr[PC_I + hg_vpos(tid) - tid]); og[tt] = bf2f(pr[PC_OG]);
                const float fg = lb + (1.f - lb) * sigmoidf_(f);
                sQ[tt][tid] = siluf_(q) * 0.08838834764831845f; sG[tt][tid] = fg; sK[tt][tid] = 1.f - fg; } }
        __syncthreads();
#pragma unroll
        for (int tt = 0; tt < TB; ++tt) { float acc = 0.f;
            if (t0 + tt < T) { const float vv = v[tt];
#pragma unroll
                for (int d4 = 0; d4 < 32; ++d4) { const f32x4 g = *(const LAS f32x4*)&sG[tt][d4 * 4], k = *(const LAS f32x4*)&sK[tt][d4 * 4], q = *(const LAS f32x4*)&sQ[tt][d4 * 4];
                    S[d4 * 4 + 0] = g.x * S[d4 * 4 + 0] + k.x * vv; acc += q.x * S[d4 * 4 + 0];
                    S[d4 * 4 + 1] = g.y * S[d4 * 4 + 1] + k.y * vv; acc += q.y * S[d4 * 4 + 1];
                    S[d4 * 4 + 2] = g.z * S[d4 * 4 + 2] + k.z * vv; acc += q.z * S[d4 * 4 + 2];
                    S[d4 * 4 + 3] = g.w * S[d4 * 4 + 3] + k.w * vv; acc += q.w * S[d4 * 4 + 3]; } }
            o[tt] = acc;
            const float ss = wave_sum(acc * acc); if (lane == 0) sRed[tt * 2 + wv] = ss; }
        __syncthreads();
#pragma unroll
        for (int tt = 0; tt < TB; ++tt) if (t0 + tt < T) { const float rstd = rsqrtf((sRed[tt * 2] + sRed[tt * 2 + 1]) * (1.f / 128.f) + EPS);
            ohg[(size_t)(row_base + b * T + t0 + tt) * 1024 + h * 128 + tid] = f2bf(o[tt] * rstd * hn * siluf_(og[tt])); }
        __syncthreads();
    }
    { float* sp = state_out + (size_t)bh * 16384 + tid;
#pragma unroll
      for (int c = 0; c < 16; ++c) { asm volatile("" : "+v"(sp));
#pragma unroll
          for (int j = 0; j < 8; ++j) sp[j * 128] = S[c * 8 + j];
          sp += 1024; } }
}

template <int TB>
__device__ __forceinline__ void ssd_seq(const bf16* proj, const float* conv_w, const float* conv_b, const float* dt_bias, const float* a_log, const float* d_skip, const float* ssm_norm,
                                        const float* state_in, const float* conv_in, float* state_out, float* conv_out, bf16* ybuf, int row_base, int T, int bg, int tid, LAS unsigned char* smem) {
    const int b = bg >> 3, g = bg & 7, lane = tid & 63, wv = tid >> 6, head = g * 4 + wv;
    const int ch_x = g * 256 + tid, ch_bc = tid < 128 ? (2048 + g * 128 + tid) : (3072 + g * 128 + (tid - 128));
    typedef float (LAS * arr_t)[128];
    arr_t sB = (arr_t)(smem), sC = (arr_t)(smem + TB * 512);
    LAS float* sRed = (LAS float*)(smem + 2 * TB * 512);
    const float wx0 = conv_w[0 * 4096 + ch_x], wx1 = conv_w[1 * 4096 + ch_x], wx2 = conv_w[2 * 4096 + ch_x], wx3 = conv_w[3 * 4096 + ch_x], bx = conv_b[ch_x];
    const float wb0 = conv_w[0 * 4096 + ch_bc], wb1 = conv_w[1 * 4096 + ch_bc], wb2 = conv_w[2 * 4096 + ch_bc], wb3 = conv_w[3 * 4096 + ch_bc], bb = conv_b[ch_bc];
    float rx0 = 0.f, rx1 = 0.f, rx2 = 0.f, rb0 = 0.f, rb1 = 0.f, rb2 = 0.f;
    if (conv_in) { const float* ci = conv_in + (size_t)b * 3 * 4096; rx0 = ci[ch_x]; rx1 = ci[4096 + ch_x]; rx2 = ci[8192 + ch_x]; rb0 = ci[ch_bc]; rb1 = ci[4096 + ch_bc]; rb2 = ci[8192 + ch_bc]; }
    float hs[128];
    const size_t sbase = (((size_t)b * 32 + head) * 64 + lane) * 128;
    if (state_in) {
#pragma unroll
        for (int n4 = 0; n4 < 32; ++n4) { const f32x4 t = *(const f32x4*)(state_in + sbase + n4 * 4); hs[n4 * 4] = t.x; hs[n4 * 4 + 1] = t.y; hs[n4 * 4 + 2] = t.z; hs[n4 * 4 + 3] = t.w; }
    } else {
#pragma unroll
        for (int n = 0; n < 128; ++n) hs[n] = 0.f;
    }
    const float A = -expf(a_log[head]), dtb = dt_bias[head], Dk = d_skip[head], nw = ssm_norm[ch_x];
    for (int t0 = 0; t0 < T; t0 += TB) {
        float xc[TB], dtv[TB], dec[TB], zz[TB], yv[TB];
#pragma unroll
        for (int tt = 0; tt < TB; ++tt) { xc[tt] = 0.f; dtv[tt] = 0.f; dec[tt] = 1.f; zz[tt] = 0.f;
            if (t0 + tt < T) { const bf16* pr = proj + (size_t)(row_base + b * T + t0 + tt) * LDP;
                const float cx = bf2f(pr[PC_XBC + ch_x]), cb = bf2f(pr[PC_XBC + ch_bc]);
                const float ax = bx + wx0 * rx0 + wx1 * rx1 + wx2 * rx2 + wx3 * cx; rx0 = rx1; rx1 = rx2; rx2 = cx; xc[tt] = siluf_(ax);
                const float ab = bb + wb0 * rb0 + wb1 * rb1 + wb2 * rb2 + wb3 * cb; rb0 = rb1; rb1 = rb2; rb2 = cb;
                const float sbv = siluf_(ab); if (tid < 128) sB[tt][tid] = sbv; else sC[tt][tid - 128] = sbv;
                const float dv = softplusf_(bf2f(pr[PC_DT + head]) + dtb); dtv[tt] = dv; dec[tt] = __expf(dv * A); zz[tt] = bf2f(pr[PC_Z + ch_x]); } }
        __syncthreads();
#pragma unroll
        for (int tt = 0; tt < TB; ++tt) { float y = 0.f;
            if (t0 + tt < T) { const float xdt = xc[tt] * dtv[tt], dc = dec[tt];
#pragma unroll
                for (int n4 = 0; n4 < 32; ++n4) { const f32x4 bv = *(const LAS f32x4*)&sB[tt][n4 * 4], cv = *(const LAS f32x4*)&sC[tt][n4 * 4];
                    hs[n4 * 4 + 0] = dc * hs[n4 * 4 + 0] + xdt * bv.x; y += hs[n4 * 4 + 0] * cv.x;
                    hs[n4 * 4 + 1] = dc * hs[n4 * 4 + 1] + xdt * bv.y; y += hs[n4 * 4 + 1] * cv.y;
                    hs[n4 * 4 + 2] = dc * hs[n4 * 4 + 2] + xdt * bv.z; y += hs[n4 * 4 + 2] * cv.z;
                    hs[n4 * 4 + 3] = dc * hs[n4 * 4 + 3] + xdt * bv.w; y += hs[n4 * 4 + 3] * cv.w; }
                y = (y + Dk * xc[tt]) * siluf_(zz[tt]); }
            yv[tt] = y;
            const float ss = wave_sum(y * y); if (lane == 0) sRed[tt * 4 + wv] = ss; }
        __syncthreads();
#pragma unroll
        for (int tt = 0; tt < TB; ++tt) if (t0 + tt < T) { const float rstd = rsqrtf(((sRed[tt * 4] + sRed[tt * 4 + 1]) + (sRed[tt * 4 + 2] + sRed[tt * 4 + 3])) * (1.f / 256.f) + EPS);
            ybuf[(size_t)(row_base + b * T + t0 + tt) * 2048 + ch_x] = f2bf(yv[tt] * rstd * nw); }
        __syncthreads();
    }
#pragma unroll
    for (int n4 = 0; n4 < 32; ++n4) *(f32x4*)(state_out + sbase + n4 * 4) = (f32x4){hs[n4 * 4], hs[n4 * 4 + 1], hs[n4 * 4 + 2], hs[n4 * 4 + 3]};
    float* co = conv_out + (size_t)b * 3 * 4096;
    co[ch_x] = rx0; co[4096 + ch_x] = rx1; co[8192 + ch_x] = rx2; co[ch_bc] = rb0; co[4096 + ch_bc] = rb1; co[8192 + ch_bc] = rb2;
}

#ifndef REP_G
#define REP_G 1
#endif
#ifndef REP_R2
#define REP_R2 1
#endif
#ifndef REP_R1
#define REP_R1 1
#endif
#ifndef REP_N
#define REP_N 1
#endif
#ifndef REP_P
#define REP_P 1
#endif
#ifndef REP_H2
#define REP_H2 1
#endif
#ifndef REP_S2
#define REP_S2 1
#endif
#ifndef REP_S1
#define REP_S1 1
#endif
#ifndef REP_SS
#define REP_SS 1
#endif
#ifndef REP_BAR
#define REP_BAR 0
#endif
__device__ __forceinline__ void phase_recur1(const P& p, int l, LAS unsigned char* lds, int tid_in, int skip_hgrn1) {
    unsigned char* ws = p.ws; asm volatile("" : "+s"(ws)); int tid_ = tid_in; asm volatile("" : "+v"(tid_)); const int tid = tid_, G = gridDim.x, wg = blockIdx.x;
    RecurBufs rb{(bf16*)(ws + WS_PROJ), (bf16*)(ws + WS_XBCC), (float*)(ws + WS_DTV), (float*)(ws + WS_CUM), (float*)(ws + WS_CV), (float*)(ws + WS_SSEG), (float*)(ws + WS_DSEG),
                 (float*)(ws + WS_HSEG), (float*)(ws + WS_TSEG), (bf16*)(ws + WS_OHG), (bf16*)(ws + WS_Y)};
    const float* lbs_l = (const float*)(ws + WS_LBS) + l * 1024; float* out = p.out;
    const float* hgn = p.in[I_HGN] + l * HG_DV;
    const float* cw = p.in[I_CONVW] + (size_t)l * 4 * SSM_CH; const float* cb = p.in[I_CONVB] + l * SSM_CH; const float* dtb = p.in[I_DTB] + l * SSM_HEADS;
    const float* alog = p.in[I_ALOG] + l * SSM_HEADS; const float* dsk = p.in[I_DSKIP] + l * SSM_HEADS; const float* ssmn = p.in[I_SSMN] + l * SSM_INNER;
#define TID_L() int tl_ = tid; asm volatile("" : "+v"(tl_)); const int t = tl_
#define R1_PROMPT() do { \
        if (!skip_hgrn1) for (int u = wg; u < 256; u += G) { TID_L(); hgrn_pass1(rb, lbs_l, u, t, lds); } \
        for (int rep = 0; rep < REP_S1; ++rep) for (int u = wg; u < 256; u += G) { TID_L(); ssd_pass1(rb, cw, cb, dtb, alog, out + O_CVP + (size_t)l * NB * 3 * SSM_CH, u, t, lds); } } while (0)
#define R1_SAMPLE() do { for (int rep = 0; rep < REP_SS; ++rep) { \
        {   const float* shg = p.in[I_SHG] + (size_t)l * NSB * HG_H * HG_DK * HG_DV; f32x4 sa[8];        \
            if (wg < NSB * HG_H) { TID_L(); hgrn_sample_load(sa, shg, wg, t); } \
            for (int u = wg; u < NSB * HG_H; u += G) { TID_L(); const int un = u + G < NSB * HG_H ? u + G : -1; \
                hgrn_sample_step(rb.proj, lbs_l, hgn, shg, out + O_HGS + (size_t)l * NSB * HG_H * HG_DK * HG_DV, rb.ohg, u, t, lds, sa, un); } } \
        {   const float* sss = p.in[I_SSSM] + (size_t)l * NSB * SSM_HEADS * SSM_P * SSM_N; f32x4 sa[16]; \
            if (wg < NSB * SSM_G) { TID_L(); ssd_sample_load(sa, sss, wg, t); } \
            for (int u = wg; u < NSB * SSM_G; u += G) { TID_L(); const int un = u + G < NSB * SSM_G ? u + G : -1; \
                ssd_sample_step(rb.proj, cw, cb, dtb, alog, dsk, ssmn, sss, p.in[I_SCONV] + (size_t)l * NSB * 3 * SSM_CH, \
                                out + O_SSMS + (size_t)l * NSB * SSM_HEADS * SSM_P * SSM_N, out + O_CVS + (size_t)l * NSB * 3 * SSM_CH, rb.y, u, t, lds, sa, un); } } } } while (0)
    if (((wg >> 3) & 1) == 0) { R1_PROMPT(); R1_SAMPLE(); } else { R1_SAMPLE(); R1_PROMPT(); }
#undef R1_PROMPT
#undef R1_SAMPLE
}
__device__ __forceinline__ void phase_recur2(const P& p, int l, LAS unsigned char* lds, int tid_in) {
    unsigned char* ws = p.ws; asm volatile("" : "+s"(ws)); int tid_ = tid_in; asm volatile("" : "+v"(tid_)); const int tid = tid_, G = gridDim.x, wg = blockIdx.x;
    RecurBufs rb{(bf16*)(ws + WS_PROJ), (bf16*)(ws + WS_XBCC), (float*)(ws + WS_DTV), (float*)(ws + WS_CUM), (float*)(ws + WS_CV), (float*)(ws + WS_SSEG), (float*)(ws + WS_DSEG),
                 (float*)(ws + WS_HSEG), (float*)(ws + WS_TSEG), (bf16*)(ws + WS_OHG), (bf16*)(ws + WS_Y)};
    float* out = p.out;
    for (int rep = 0; rep < REP_H2; ++rep) for (int u = wg; u < 256; u += G) { TID_L(); hgrn_pass2(rb, p.in[I_HGN] + l * HG_DV, out + O_HGP + (size_t)l * NB * HG_H * HG_DK * HG_DV, u, t, lds); }
    for (int rep = 0; rep < REP_S2; ++rep) for (int u = wg; u < 256; u += G) { TID_L(); ssd_pass2(rb, p.in[I_DSKIP] + l * SSM_HEADS, p.in[I_SSMN] + l * SSM_INNER, out + O_SSMP + (size_t)l * NB * SSM_HEADS * SSM_P * SSM_N, u ^ 3, t, lds); }
}


constexpr int CW_BAR = 4096;
constexpr int MISC_OFF = LDS_BYTES - 256;

__global__ __launch_bounds__(NTHREADS, 2) void k_mega(P p) {
    extern __shared__ __attribute__((aligned(16))) unsigned char shm[];
    LAS unsigned char* lds = (LAS unsigned char*)shm;
    const int wave_u = __builtin_amdgcn_readfirstlane((int)threadIdx.x >> 6);
#define TID() ({ int t__; asm volatile("v_mbcnt_lo_u32_b32 %0, -1, 0\n\tv_mbcnt_hi_u32_b32 %0, -1, %0" : "=v"(t__)); (wave_u << 6) | t__; })
    const int G = gridDim.x, NGW = G * NWAVES;
    unsigned char* ws = p.ws;
#define LANE_GW() int t_ = TID(); asm volatile("" : "+v"(t_)); const int ln = t_ & 63, wv = __builtin_amdgcn_readfirstlane(t_ >> 6), gwv = blockIdx.x * NWAVES + wv; (void)wv
    volatile LAS unsigned* MISC = (volatile LAS unsigned*)(lds + MISC_OFF);
    if (TID() < 16) MISC[TID()] = 0u;
    __syncthreads();
    XcdBarrier bar = xcd_barrier_post((unsigned*)(ws + WS_CTL) + CW_BAR, MISC + 8, TID());
#define WSL() ({ unsigned char* w_ = ws; asm volatile("" : "+s"(w_)); w_; })

    for (int rep = 0; rep < REP_P; ++rep) {   LANE_GW(); phase_prologue(p, lds, gwv, NGW, ln, wv); }
    xcd_barrier(bar, TID());
    {   unsigned char* w = WSL();
        pg8::Gemm g{(const bf16*)(w + WS_AC), (const bf16*)(w + WS_WADA), 256, MODLD, D}; pg8::StaticOrder S; S.init(256, MODLD, G, (int)blockIdx.x);
        pg8::EpiF32 E{(float*)(w + WS_MOD), MODLD, p.in[I_BADA]};
        pg8::gemm_phase<pg8::EpiF32, pg8::StaticOrder>(lds, g, S, E, nullptr, TID()); }
    xcd_barrier(bar, TID());
    for (int li = 0; li < DEPTH; ++li) {
        int l = li; asm volatile("" : "+s"(l));
        for (int rep = 0; rep < REP_N; ++rep) {   unsigned char* w = WSL(); const float* mod_l = (const float*)(w + WS_MOD) + (size_t)l * NADA * D;
            LANE_GW();
            if (l == 0) phase_norm<1>(p.in[I_XP], p.in[I_XS], (bf16*)(w + WS_X), (bf16*)(w + WS_H), p.in[I_NMIX] + l * D, mod_l + 0 * D, mod_l + 1 * D, gwv, NGW, ln);
            else phase_norm<0>(nullptr, nullptr, (bf16*)(w + WS_X), (bf16*)(w + WS_H), p.in[I_NMIX] + l * D, mod_l + 0 * D, mod_l + 1 * D, gwv, NGW, ln); }
        xcd_barrier(bar, TID());
        for (int rep = 0; rep < REP_G; ++rep) { if (rep) xcd_barrier(bar, TID());
        {   unsigned char* w = WSL(); const unsigned char* wl = w + WS_W + (size_t)l * W_LSTRIDE;
            pg8::Gemm g{(const bf16*)(w + WS_H), (const bf16*)(wl + WO_IN), MP, PC_DT, D}; pg8::StaticOrder S; S.init(MP, PC_DT, G, (int)blockIdx.x);
            pg8::EpiBf16<0> E{(bf16*)(w + WS_PROJ), LDP};
            pg8::gemm_phase<pg8::EpiBf16<0>, pg8::StaticOrder>(lds, g, S, E, nullptr, TID());
            skinny_gemm<4>((const bf16*)(w + WS_H), D, (const bf16*)(wl + WO_IN) + (size_t)PC_DT * D, D, 32, SkStoreBf16{(bf16*)(w + WS_PROJ) + PC_DT, LDP, 0}, (int)blockIdx.x, 0, G, TID(), lds, MP / 128);
            skinny_gemm<8>((const bf16*)(w + WS_H) + (size_t)MP * D, D, (const bf16*)(wl + WO_IN), D, IN_WIDTH, SkStoreBf16{(bf16*)(w + WS_PROJ) + (size_t)MP * LDP, LDP, 0}, (int)blockIdx.x, 0, G, TID(), lds); } }
        xcd_barrier(bar, TID());
        for (int rep = 0; rep < REP_BAR; ++rep) xcd_barrier(bar, TID());
        phase_recur1(p, l, lds, TID(), 0);
        for (int rep = 1; rep < REP_R1; ++rep) { xcd_barrier(bar, TID()); phase_recur1(p, l, lds, TID(), 1); }
        xcd_barrier(bar, TID());
        for (int rep = 0; rep < REP_R2; ++rep) { if (rep) xcd_barrier(bar, TID()); phase_recur2(p, l, lds, TID()); }
        xcd_barrier(bar, TID());
        for (int rep = 0; rep < REP_G; ++rep) { if (rep) xcd_barrier(bar, TID());
        {   unsigned char* w = WSL(); const unsigned char* wl = w + WS_W + (size_t)l * W_LSTRIDE;
            pg8::Gemm g{(const bf16*)(w + WS_OHG), (const bf16*)(wl + WO_BRA), MP, D, 1024}; pg8::StaticOrder S; S.init(MP, D, G, (int)blockIdx.x);
            pg8::EpiGateA E{(bf16*)(w + WS_T), (const bf16*)(w + WS_PROJ) + PC_GA, LDP, p.in[I_BMERGE] + l * 2048};
            pg8::gemm_phase<pg8::EpiGateA, pg8::StaticOrder>(lds, g, S, E, nullptr, TID());
            skinny_gemm<1>((const bf16*)(w + WS_OHG) + (size_t)MP * D, D, (const bf16*)(wl + WO_BRA), 1024, D, SkGateA{(bf16*)(w + WS_T) + (size_t)MP * D, (const bf16*)(w + WS_PROJ) + (size_t)MP * LDP + PC_GA, LDP, p.in[I_BMERGE] + l * 2048}, (int)blockIdx.x, 0, G, TID(), lds); } }
        asm volatile("s_waitcnt vmcnt(0)" ::: "memory"); __syncthreads();
        for (int rep = 0; rep < REP_G; ++rep) { if (rep) xcd_barrier(bar, TID());
        {   unsigned char* w = WSL(); const unsigned char* wl = w + WS_W + (size_t)l * W_LSTRIDE;
            pg8::Gemm g{(const bf16*)(w + WS_Y), (const bf16*)(wl + WO_BRB), MP, D, 2048}; pg8::StaticOrder S; S.init(MP, D, G, (int)blockIdx.x);
            pg8::EpiGateB E{(const bf16*)(w + WS_T), (bf16*)(w + WS_U), (const bf16*)(w + WS_PROJ) + PC_GB, LDP, p.in[I_BMERGE] + l * 2048 + 1024};
            pg8::gemm_phase<pg8::EpiGateB, pg8::StaticOrder>(lds, g, S, E, nullptr, TID());
            skinny_gemm<1>((const bf16*)(w + WS_Y) + (size_t)MP * 2048, 2048, (const bf16*)(wl + WO_BRB), 2048, D, SkGateB{(const bf16*)(w + WS_T) + (size_t)MP * D, (bf16*)(w + WS_U) + (size_t)MP * D, (const bf16*)(w + WS_PROJ) + (size_t)MP * LDP + PC_GB, LDP, p.in[I_BMERGE] + l * 2048 + 1024}, (int)blockIdx.x, 0, G, TID(), lds); } }
        xcd_barrier(bar, TID());
        {   unsigned char* w = WSL(); const unsigned char* wl = w + WS_W + (size_t)l * W_LSTRIDE; const float* mod_l = (const float*)(w + WS_MOD) + (size_t)l * NADA * D;
            pg8::Gemm g{(const bf16*)(w + WS_U), (const bf16*)(wl + WO_OUT), MP, D, 1024}; pg8::StaticOrder S; S.init(MP, D, G, (int)blockIdx.x);
            pg8::EpiRes E{(bf16*)(w + WS_X), mod_l + 2 * D, MODLD};
            pg8::gemm_phase<pg8::EpiRes, pg8::StaticOrder>(lds, g, S, E, nullptr, TID());
            skinny_gemm<1>((const bf16*)(w + WS_U) + (size_t)MP * D, D, (const bf16*)(wl + WO_OUT), 1024, D, SkRes{(bf16*)(w + WS_X) + (size_t)MP * D, mod_l + (size_t)NB * MODLD + 2 * D, MODLD}, (int)blockIdx.x, 0, G, TID(), lds); }
        xcd_barrier(bar, TID());
        for (int rep = 0; rep < REP_N; ++rep) {   unsigned char* w = WSL(); const float* mod_l = (const float*)(w + WS_MOD) + (size_t)l * NADA * D;
            LANE_GW(); phase_norm<0>(nullptr, nullptr, (bf16*)(w + WS_X), (bf16*)(w + WS_H), p.in[I_NMLP] + l * D, mod_l + 3 * D, mod_l + 4 * D, gwv, NGW, ln); }
        xcd_barrier(bar, TID());
        for (int rep = 0; rep < REP_G; ++rep) { if (rep) xcd_barrier(bar, TID());
        {   unsigned char* w = WSL(); const unsigned char* wl = w + WS_W + (size_t)l * W_LSTRIDE;
            pg8::Gemm g{(const bf16*)(w + WS_H), (const bf16*)(wl + WO_UP), MP, DFF, 1024}; pg8::StaticOrder S; S.init(MP, DFF, G, (int)blockIdx.x);
            pg8::EpiBf16<1> E{(bf16*)(w + WS_UP), DFF};
            pg8::gemm_phase<pg8::EpiBf16<1>, pg8::StaticOrder>(lds, g, S, E, nullptr, TID());
            skinny_gemm<4>((const bf16*)(w + WS_H) + (size_t)MP * D, D, (const bf16*)(wl + WO_UP), 1024, DFF, SkStoreBf16{(bf16*)(w + WS_UP) + (size_t)MP * DFF, DFF, 1}, (int)blockIdx.x, 0, G, TID(), lds); } }
        xcd_barrier(bar, TID());
        {   unsigned char* w = WSL(); const unsigned char* wl = w + WS_W + (size_t)l * W_LSTRIDE; const float* mod_l = (const float*)(w + WS_MOD) + (size_t)l * NADA * D;
            pg8::Gemm g{(const bf16*)(w + WS_UP), (const bf16*)(wl + WO_DOWN), MP, D, DFF}; pg8::StaticOrder S; S.init(MP, D, G, (int)blockIdx.x);
            pg8::EpiRes E{(bf16*)(w + WS_X), mod_l + 5 * D, MODLD};
            pg8::gemm_phase<pg8::EpiRes, pg8::StaticOrder>(lds, g, S, E, nullptr, TID());
            skinny_gemm<1>((const bf16*)(w + WS_UP) + (size_t)MP * DFF, DFF, (const bf16*)(wl + WO_DOWN), DFF, D, SkRes{(bf16*)(w + WS_X) + (size_t)MP * D, mod_l + (size_t)NB * MODLD + 5 * D, MODLD}, (int)blockIdx.x, 0, G, TID(), lds); }
        xcd_barrier(bar, TID());
    }
    {   unsigned char* w = WSL(); LANE_GW(); phase_final((const bf16*)(w + WS_X), p.out + O_YP, p.in[I_NFIN], gwv, NGW, ln); }
}

extern "C" void kernel_launch(void* const* d_in, const int* in_sizes, int n_in, void* d_out, int out_size, void* d_ws, size_t ws_size, hipStream_t stream) {
    static int grid = 0;
    if (grid == 0) {
        if (n_in != N_IN || (size_t)out_size != O_END || ws_size < WS_END) { fprintf(stderr, "kernel_launch: unexpected sizes n_in %d out %d ws %zu\n", n_in, out_size, ws_size); grid = -1; return; }
        int dev = 0, cus = 0, per_cu = 0;
        if (hipGetDevice(&dev) != hipSuccess || hipDeviceGetAttribute(&cus, hipDeviceAttributeMultiprocessorCount, dev) != hipSuccess) { grid = -1; return; }
        if (hipFuncSetAttribute((const void*)k_mega, hipFuncAttributeMaxDynamicSharedMemorySize, LDS_BYTES) != hipSuccess) { fprintf(stderr, "kernel_launch: hipFuncSetAttribute failed\n"); grid = -1; return; }
        if (hipOccupancyMaxActiveBlocksPerMultiprocessor(&per_cu, (const void*)k_mega, NTHREADS, LDS_BYTES) != hipSuccess || per_cu < 1)
            fprintf(stderr, "kernel_launch: note: occupancy query reports %d workgroups per CU\n", per_cu);
        (void)hipGetLastError();
        grid = cus;
    }
    if (grid < 0) return;
    if (hipMemsetAsync((char*)d_ws + WS_CTL, 0, CTL_ZERO_BYTES, stream) != hipSuccess) return;
    P p{};
    for (int i = 0; i < N_IN; ++i) p.in[i] = (const float*)d_in[i];
    p.out = (float*)d_out; p.ws = (unsigned char*)d_ws;
    hipLaunchKernelGGL(k_mega, dim3(grid), dim3(NTHREADS), LDS_BYTES, stream, p);
}
```

```cpp
#include <hip/hip_runtime.h>
#include <cstdio>
#include <cstdint>

constexpr int D = 1024, NB = 8, SEQ = 2048, DEPTH = 4, NSB = 128;
constexpr int MP = NB * SEQ;
constexpr int MS = NSB;
constexpr int MR = MP + MS;
constexpr int MT = 16640;
constexpr int HG_H = 8, HG_DK = 128, HG_DV = 128;
constexpr int SSM_INNER = 2048, SSM_P = 64, SSM_HEADS = 32, SSM_G = 8, SSM_HPG = 4, SSM_N = 128, SSM_CH = 4096;
constexpr int DFF = 4096, NADA = 6;
constexpr int IN_WIDTH = 12320;
constexpr int LDP = 12544;
constexpr int PC_Q = 0, PC_F = 1024, PC_I = 2048, PC_OG = 3072, PC_Z = 4096, PC_XBC = 6144, PC_GA = 10240, PC_GB = 11264, PC_DT = 12288;
constexpr int NCOND = NB + NSB;
constexpr int MODLD = DEPTH * NADA * D;
constexpr float EPS = 1e-6f;

enum { I_XP = 0, I_XS, I_SHG, I_SSSM, I_SCONV, I_CP, I_CS, I_WADA, I_BADA, I_NMIX, I_WIN, I_BMERGE, I_LB, I_HGN, I_CONVW, I_CONVB, I_DTB, I_ALOG, I_DSKIP,
       I_SSMN, I_WBRA, I_WBRB, I_WOUT, I_NMLP, I_WUP, I_WDOWN, I_NFIN, N_IN };

constexpr size_t O_YP = 0;
constexpr size_t O_YS = O_YP + (size_t)MP * D;
constexpr size_t O_HGP = O_YS + (size_t)MS * D;
constexpr size_t O_SSMP = O_HGP + (size_t)DEPTH * NB * HG_H * HG_DK * HG_DV;
constexpr size_t O_CVP = O_SSMP + (size_t)DEPTH * NB * SSM_HEADS * SSM_P * SSM_N;
constexpr size_t O_HGS = O_CVP + (size_t)DEPTH * NB * 3 * SSM_CH;
constexpr size_t O_SSMS = O_HGS + (size_t)DEPTH * NSB * HG_H * HG_DK * HG_DV;
constexpr size_t O_CVS = O_SSMS + (size_t)DEPTH * NSB * SSM_HEADS * SSM_P * SSM_N;
constexpr size_t O_END = O_CVS + (size_t)DEPTH * NSB * 3 * SSM_CH;

constexpr size_t MiB = 1u << 20;
constexpr size_t WS_CTL = 0, CTL_ZERO_BYTES = 1 * MiB;
constexpr size_t WS_LBS = 1 * MiB;
constexpr size_t WS_AC = 2 * MiB;
constexpr size_t WS_MOD = 3 * MiB;
constexpr size_t WS_WADA = 32 * MiB;
constexpr size_t WS_W = 80 * MiB, W_LSTRIDE = 49 * MiB;
constexpr size_t WO_IN = 0, WO_BRA = 24 * MiB + MiB / 2, WO_BRB = WO_BRA + 2 * MiB, WO_OUT = WO_BRB + 4 * MiB, WO_UP = WO_OUT + 2 * MiB, WO_DOWN = WO_UP + 8 * MiB;
constexpr size_t WS_X = 276 * MiB;
constexpr size_t WS_H = 341 * MiB;
constexpr size_t WS_PROJ = 374 * MiB;
constexpr size_t WS_OHG = 773 * MiB;
constexpr size_t WS_Y = 806 * MiB;
constexpr size_t WS_T = 871 * MiB;
constexpr size_t WS_U = 936 * MiB;
constexpr size_t WS_UP = 969 * MiB;
constexpr size_t WS_XBCC = 1100 * MiB;
constexpr size_t WS_DTV = 1230 * MiB, WS_CUM = 1232 * MiB;
constexpr size_t WS_CV = 1234 * MiB;
constexpr size_t WS_SSEG = 1238 * MiB;
constexpr size_t WS_DSEG = 1254 * MiB;
constexpr size_t WS_HSEG = 1255 * MiB;
constexpr size_t WS_TSEG = 1287 * MiB;
constexpr size_t WS_END = 1288 * MiB;
static_assert(WO_DOWN + 8 * MiB <= W_LSTRIDE && (size_t)LDP * D * 2 <= WO_BRA, "weight map");
static_assert(WS_W + 4 * W_LSTRIDE <= WS_X && WS_X + (size_t)MT * D * 4 <= WS_H && WS_H + (size_t)MT * D * 2 <= WS_PROJ && WS_PROJ + (size_t)MT * LDP * 2 <= WS_OHG, "ws map 1");
static_assert(WS_OHG + (size_t)MT * D * 2 <= WS_Y && WS_Y + (size_t)MT * 2048 * 2 <= WS_T && WS_T + (size_t)MT * D * 4 <= WS_U && WS_U + (size_t)MT * D * 2 <= WS_UP && WS_UP + (size_t)MT * DFF * 2 <= WS_XBCC && WS_XBCC + (size_t)MT * 4096 * 2 <= WS_DTV, "ws map 2");
static_assert(WS_MOD + (size_t)256 * MODLD * 4 <= WS_WADA && WS_WADA + (size_t)MODLD * D * 2 <= WS_W, "ws map 0");

typedef unsigned short bf16;
__device__ __forceinline__ float bf2f(bf16 v) { return __uint_as_float(((unsigned)v) << 16); }
__device__ __forceinline__ unsigned pk2(float lo, float hi) { unsigned r; asm("v_cvt_pk_bf16_f32 %0, %1, %2" : "=v"(r) : "v"(lo), "v"(hi)); return r; }
__device__ __forceinline__ bf16 f2bf(float f) { return (bf16)pk2(f, f); }
__device__ __forceinline__ float frcp_(float x) { return __builtin_amdgcn_rcpf(x); }
__device__ __forceinline__ float sigmoidf_(float x) { return frcp_(1.0f + __expf(-x)); }
__device__ __forceinline__ float siluf_(float x) { return x * frcp_(1.0f + __expf(-x)); }
__device__ __forceinline__ float softplusf_(float x) { return x > 20.f ? x : log1pf(__expf(x)); }
__host__ __device__ __forceinline__ int cidx_of_row(int row) { return row < MP ? (row >> 11) : ((row - MP + NB) < NCOND ? (row - MP + NB) : (NCOND - 1)); }
__host__ __device__ __forceinline__ int hg_vpos(int e) { return (e & 64) + 16 * (e & 3) + ((e & 63) >> 2); }

namespace pg8 {
#define PG8_LAS __attribute__((address_space(3)))
typedef unsigned short bf16_t;
typedef short bf16x8 __attribute__((ext_vector_type(8)));
typedef float f32x4 __attribute__((ext_vector_type(4)));
typedef unsigned u32x4 __attribute__((ext_vector_type(4)));
constexpr int BM = 256, BK = 64, HALF = 128, HTB = HALF * BK * 2  , STAGE_BYTES = 8 * HTB, NXCD = 8, WGM = 4;

__host__ __device__ __forceinline__ int lds_byte(int r, int c) { const int st = (r >> 4) * 2 + (c >> 5), rr = r & 15, cc = c & 31, ob = rr * 64 + cc * 2; return st * 1024 + (ob ^ (((ob >> 9) & 1) << 5)); }
__host__ __device__ __forceinline__ void stage_rc(int b, int& R, int& C) { const int st = b / 1024, sb = b % 1024, swz = sb ^ (((sb >> 9) & 1) << 5); R = (st >> 1) * 16 + swz / 64; C = (st & 1) * 32 + (swz % 64) / 2; }
__host__ __device__ __forceinline__ int perm32(int rho) { const int n = rho >> 4, i = rho & 15; return 8 * (i >> 2) + 4 * n + (i & 3); }

struct Unit { int pm, pn; };
struct Gemm { const bf16_t* A; const bf16_t* Bt; int M, N, K; };

struct StaticOrder {
    int nM, nN, nwg, G, c;
    __host__ __device__ void init(int M, int N, int G_, int c_) { nM = M / BM; nN = N / BM; nwg = nM * nN; G = G_; c = c_; }
    __host__ __device__ bool next(int i, Unit& u) const {
        const long L = (long)i * G + c; if (L >= nwg) return false;
        int wgid = (int)L; { const int q = nwg / NXCD, r = nwg % NXCD, xcd = wgid % NXCD, off = wgid / NXCD; wgid = (xcd < r ? xcd * (q + 1) : r * (q + 1) + (xcd - r) * q) + off; }
        const int nig = WGM * nN, gid = wgid / nig, fm = gid * WGM, gsz = (nM - fm) < WGM ? (nM - fm) : WGM;
        u.pm = fm + ((wgid % nig) % gsz); u.pn = (wgid % nig) / gsz; return true;
    }
    __device__ __forceinline__ void a_ready(const Unit&) const {}
    __device__ __forceinline__ void done(const Unit&) const {}
};
__device__ __forceinline__ unsigned cvt_pk_bf16(float lo, float hi) { unsigned r; asm volatile("v_cvt_pk_bf16_f32 %0, %1, %2" : "=v"(r) : "v"(lo), "v"(hi)); return r; }
__device__ __forceinline__ float ep_sigmoid(float x) { return __builtin_amdgcn_rcpf(1.0f + __expf(-x)); }
__device__ __forceinline__ void unpack8(const u32x4 w, f32x4& lo, f32x4& hi) {
    lo = (f32x4){__uint_as_float(w.x << 16), __uint_as_float(w.x & 0xffff0000u), __uint_as_float(w.y << 16), __uint_as_float(w.y & 0xffff0000u)};
    hi = (f32x4){__uint_as_float(w.z << 16), __uint_as_float(w.z & 0xffff0000u), __uint_as_float(w.w << 16), __uint_as_float(w.w & 0xffff0000u)};
}

struct EpiF32 {
    static constexpr bool PERM = false, AFTER_DRAIN = false;
    float* C; int ldc; const float* bias;
    __device__ __forceinline__ void operator()(const f32x4 (&acc)[2][2][4][2], const Unit& u, int wr, int wc, int fr, int fq) const {
        const int row0 = u.pm * BM + wr * 64 + fr, col0 = u.pn * BM + wc * 32 + 4 * fq;
        f32x4 bv[2][2];
#pragma unroll
        for (int bj = 0; bj < 2; ++bj)
#pragma unroll
            for (int n = 0; n < 2; ++n) bv[bj][n] = *(const f32x4*)(bias + col0 + bj * HALF + n * 16);
#pragma unroll
        for (int ai = 0; ai < 2; ++ai)
#pragma unroll
            for (int m = 0; m < 4; ++m) { float* rowp = C + (size_t)(row0 + ai * HALF + m * 16) * ldc + col0;
#pragma unroll
                for (int bj = 0; bj < 2; ++bj)
#pragma unroll
                    for (int n = 0; n < 2; ++n) *(f32x4*)(rowp + bj * HALF + n * 16) = acc[ai][bj][m][n] + bv[bj][n]; }
    }
};
template <int ACT  > struct EpiBf16 {
    static constexpr bool PERM = true, AFTER_DRAIN = false;
    bf16_t* O; int ldc;
    __device__ __forceinline__ void operator()(const f32x4 (&acc)[2][2][4][2], const Unit& u, int wr, int wc, int fr, int fq) const {
        const int row0 = u.pm * BM + wr * 64 + fr; const int col0 = u.pn * BM + wc * 32 + 8 * fq;
#pragma unroll
        for (int ai = 0; ai < 2; ++ai)
#pragma unroll
            for (int m = 0; m < 4; ++m) { bf16_t* rowp = O + (size_t)(row0 + ai * HALF + m * 16) * ldc + col0;
#pragma unroll
                for (int bj = 0; bj < 2; ++bj) { f32x4 v0 = acc[ai][bj][m][0], v1 = acc[ai][bj][m][1];
                    if (ACT == 1) {
#pragma unroll
                        for (int j = 0; j < 4; ++j) { const float a = fmaxf(v0[j], 0.f), b = fmaxf(v1[j], 0.f); v0[j] = a * a; v1[j] = b * b; } }
                    u32x4 w; w.x = cvt_pk_bf16(v0[0], v0[1]); w.y = cvt_pk_bf16(v0[2], v0[3]); w.z = cvt_pk_bf16(v1[0], v1[1]); w.w = cvt_pk_bf16(v1[2], v1[3]);
                    *(u32x4*)(rowp + bj * HALF) = w; } }
    }
};
struct EpiGateA {
    static constexpr bool PERM = true, AFTER_DRAIN = false;
    bf16_t* T; const bf16_t* G; int ldg; const float* bm;
    __device__ __forceinline__ void operator()(const f32x4 (&acc)[2][2][4][2], const Unit& u, int wr, int wc, int fr, int fq) const {
        const int row0 = u.pm * BM + wr * 64 + fr; const int col0 = u.pn * BM + wc * 32 + 8 * fq;
        f32x4 bv[2][2];
#pragma unroll
        for (int bj = 0; bj < 2; ++bj)
#pragma unroll
            for (int n = 0; n < 2; ++n) bv[bj][n] = *(const f32x4*)(bm + col0 + bj * HALF + 4 * n);
#pragma unroll
        for (int ai = 0; ai < 2; ++ai)
#pragma unroll
            for (int m = 0; m < 4; ++m) { const size_t row = (size_t)(row0 + ai * HALF + m * 16);
#pragma unroll
                for (int bj = 0; bj < 2; ++bj) {
                    const u32x4 gw = *(const u32x4*)(G + row * ldg + col0 + bj * HALF); f32x4 g0, g1; unpack8(gw, g0, g1);
                    f32x4 o0, o1;
#pragma unroll
                    for (int j = 0; j < 4; ++j) { o0[j] = ep_sigmoid(g0[j] + bv[bj][0][j]) * acc[ai][bj][m][0][j]; o1[j] = ep_sigmoid(g1[j] + bv[bj][1][j]) * acc[ai][bj][m][1][j]; }
                    u32x4 w; w.x = cvt_pk_bf16(o0[0], o0[1]); w.y = cvt_pk_bf16(o0[2], o0[3]); w.z = cvt_pk_bf16(o1[0], o1[1]); w.w = cvt_pk_bf16(o1[2], o1[3]);
                    *(u32x4*)(T + row * 1024 + col0 + bj * HALF) = w; } }
    }
};
struct EpiGateB {
    static constexpr bool PERM = true, AFTER_DRAIN = false;
    const bf16_t* T; bf16_t* U; const bf16_t* G; int ldg; const float* bm;
    __device__ __forceinline__ void operator()(const f32x4 (&acc)[2][2][4][2], const Unit& u, int wr, int wc, int fr, int fq) const {
        const int row0 = u.pm * BM + wr * 64 + fr; const int col0 = u.pn * BM + wc * 32 + 8 * fq;
        f32x4 bv[2][2];
#pragma unroll
        for (int bj = 0; bj < 2; ++bj)
#pragma unroll
            for (int n = 0; n < 2; ++n) bv[bj][n] = *(const f32x4*)(bm + col0 + bj * HALF + 4 * n);
#pragma unroll
        for (int ai = 0; ai < 2; ++ai)
#pragma unroll
            for (int m = 0; m < 4; ++m) { const size_t row = (size_t)(row0 + ai * HALF + m * 16);
#pragma unroll
                for (int bj = 0; bj < 2; ++bj) {
                    const u32x4 gw = *(const u32x4*)(G + row * ldg + col0 + bj * HALF); f32x4 g0, g1; unpack8(gw, g0, g1);
                    f32x4 t0, t1; unpack8(*(const u32x4*)(T + row * 1024 + col0 + bj * HALF), t0, t1);
                    f32x4 o0, o1;
#pragma unroll
                    for (int j = 0; j < 4; ++j) { o0[j] = t0[j] + ep_sigmoid(g0[j] + bv[bj][0][j]) * acc[ai][bj][m][0][j]; o1[j] = t1[j] + ep_sigmoid(g1[j] + bv[bj][1][j]) * acc[ai][bj][m][1][j]; }
                    u32x4 w; w.x = cvt_pk_bf16(o0[0], o0[1]); w.y = cvt_pk_bf16(o0[2], o0[3]); w.z = cvt_pk_bf16(o1[0], o1[1]); w.w = cvt_pk_bf16(o1[2], o1[3]);
                    *(u32x4*)(U + row * 1024 + col0 + bj * HALF) = w; } }
    }
};
struct EpiRes {
    static constexpr bool PERM = false, AFTER_DRAIN = false;
    bf16_t* X; const float* gate; int ldgate;
    __device__ __forceinline__ void operator()(const f32x4 (&acc)[2][2][4][2], const Unit& u, int wr, int wc, int fr, int fq) const {
        typedef unsigned u32x2 __attribute__((ext_vector_type(2)));
        const int row0 = u.pm * BM + wr * 64 + fr, col0 = u.pn * BM + wc * 32 + 4 * fq;
        const float* gp = gate + (size_t)((u.pm * BM) >> 11) * ldgate + col0;
        f32x4 gv[2][2];
#pragma unroll
        for (int bj = 0; bj < 2; ++bj)
#pragma unroll
            for (int n = 0; n < 2; ++n) gv[bj][n] = *(const f32x4*)(gp + bj * HALF + n * 16);
#pragma unroll
        for (int ai = 0; ai < 2; ++ai)
#pragma unroll
            for (int m = 0; m < 4; ++m) { bf16_t* xp = X + (size_t)(row0 + ai * HALF + m * 16) * 1024 + col0;
#pragma unroll
                for (int bj = 0; bj < 2; ++bj)
#pragma unroll
                    for (int n = 0; n < 2; ++n) { const u32x2 xw = *(const u32x2*)(xp + bj * HALF + n * 16);
                        const f32x4 xv = (f32x4){__uint_as_float(xw.x << 16), __uint_as_float(xw.x & 0xffff0000u), __uint_as_float(xw.y << 16), __uint_as_float(xw.y & 0xffff0000u)};
                        const f32x4 o = xv + gv[bj][n] * acc[ai][bj][m][n];
                        u32x2 ow; ow.x = cvt_pk_bf16(o[0], o[1]); ow.y = cvt_pk_bf16(o[2], o[3]); *(u32x2*)(xp + bj * HALF + n * 16) = ow; } }
    }
};


#ifndef GEMM_ALIGN
#define GEMM_ALIGN true
#endif
#ifndef GEMM_SP2
#define GEMM_SP2 true
#endif
template <class Epi, class Sched, bool ALIGN_EPI = GEMM_ALIGN, bool SP2 = GEMM_SP2>
__device__ __forceinline__ void gemm_phase(PG8_LAS unsigned char* lds, const Gemm g, const Sched& S, const Epi& E, unsigned long long*  , int tid_in) {
    int tid_ = tid_in; asm volatile("" : "+v"(tid_));
    const int tid = tid_, wid = __builtin_amdgcn_readfirstlane(tid >> 6), lane = tid & 63, wr = wid >> 2, wc = wid & 3, fr = lane & 15, fq = lane >> 4;
    const int K = g.K, nt = K / BK;
    unsigned voffA[2], voffB[2];
#pragma unroll
    for (int i = 0; i < 2; ++i) { int R, C; stage_rc(tid * 16 + i * 8192, R, C); const int Rb = Epi::PERM ? ((R & ~31) + perm32(R & 31)) : R;
        voffA[i] = (unsigned)(R * K + C) * 2u; voffB[i] = (unsigned)(Rb * K + C) * 2u; }
    const size_t kstep = (size_t)(BK * 2);
    const size_t hstep = (size_t)HALF * K * 2;
    const size_t tstep = 2 * hstep;
    const unsigned ldsw = (unsigned)wid * 1024u;
    const int aoff = lds_byte(wr * 64 + fr, fq * 8), boff = lds_byte(wc * 32 + fr, fq * 8);
#define PG8_SA(b, h) (((b) * 2 + (h)) * HTB)
#define PG8_SB(b, h) ((4 + (b) * 2 + (h)) * HTB)
#define PG8_STAGE(bufoff, gbase, voff) do { _Pragma("unroll") for (int _i = 0; _i < 2; ++_i) \
        __builtin_amdgcn_global_load_lds((const unsigned*)((const char*)(gbase) + (voff)[_i]), (PG8_LAS unsigned*)(lds + (bufoff) + ldsw + _i * 8192), 16, 0, 0); } while (0)
#define PG8_LDA(dst, b, h) do { _Pragma("unroll") for (int m = 0; m < 4; ++m) _Pragma("unroll") for (int k = 0; k < 2; ++k) dst[m][k] = *(const PG8_LAS bf16x8*)(lds + PG8_SA(b, h) + aoff + m * 2048 + k * 1024); } while (0)
#define PG8_LDB(dst, b, h) do { _Pragma("unroll") for (int n = 0; n < 2; ++n) _Pragma("unroll") for (int k = 0; k < 2; ++k) dst[n][k] = *(const PG8_LAS bf16x8*)(lds + PG8_SB(b, h) + boff + n * 2048 + k * 1024); } while (0)
#define PG8_MMA(ai, bj, At, Bt) do { __builtin_amdgcn_s_setprio(1); _Pragma("unroll") for (int m = 0; m < 4; ++m) _Pragma("unroll") for (int n = 0; n < 2; ++n) _Pragma("unroll") for (int k = 0; k < 2; ++k) \
        acc[ai][bj][m][n] = __builtin_amdgcn_mfma_f32_16x16x32_bf16(Bt[n][k], At[m][k], acc[ai][bj][m][n], 0, 0, 0); __builtin_amdgcn_s_setprio(0); } while (0)
#define PG8_WAIT_V(n) asm volatile("s_waitcnt vmcnt(" #n ")" ::: "memory")
#define PG8_WAIT_L(n) asm volatile("s_waitcnt lgkmcnt(" #n ")" ::: "memory")
#define PG8_BAR __builtin_amdgcn_s_barrier()
#define PG8_SCHED __builtin_amdgcn_sched_barrier(0)
    Unit cur, nxt; int ui = 0;
    if (!S.next(0, cur)) return;
    f32x4 acc[2][2][4][2];
#pragma unroll
    for (int a = 0; a < 2; ++a)
#pragma unroll
        for (int b = 0; b < 2; ++b)
#pragma unroll
            for (int m = 0; m < 4; ++m)
#pragma unroll
                for (int n = 0; n < 2; ++n) acc[a][b][m][n] = (f32x4){0.f, 0.f, 0.f, 0.f};
    bf16x8 At[4][2], B0[2][2], B1[2][2];
    const char* cA = (const char*)g.A + (size_t)cur.pm * tstep; const char* cB = (const char*)g.Bt + (size_t)cur.pn * tstep;
    S.a_ready(cur);
    if constexpr (SP2) {
        PG8_STAGE(PG8_SB(0, 0), cB, voffB); PG8_STAGE(PG8_SB(0, 1), cB + hstep, voffB); PG8_STAGE(PG8_SA(0, 0), cA, voffA); PG8_STAGE(PG8_SA(0, 1), cA + hstep, voffA);
        if (wr == 1) PG8_BAR;
        PG8_WAIT_V(2); PG8_BAR;
        PG8_STAGE(PG8_SB(1, 0), cB + kstep, voffB); PG8_STAGE(PG8_SA(1, 0), cA + kstep, voffA); PG8_STAGE(PG8_SB(1, 1), cB + hstep + kstep, voffB);
        PG8_WAIT_V(6); PG8_BAR;
    } else {
        PG8_STAGE(PG8_SB(0, 0), cB, voffB); PG8_STAGE(PG8_SA(0, 0), cA, voffA); PG8_STAGE(PG8_SB(0, 1), cB + hstep, voffB); PG8_STAGE(PG8_SA(0, 1), cA + hstep, voffA);
        if (wr == 1) PG8_BAR;
        PG8_WAIT_V(4); PG8_BAR;
        PG8_STAGE(PG8_SB(1, 0), cB + kstep, voffB); PG8_STAGE(PG8_SA(1, 0), cA + kstep, voffA); PG8_STAGE(PG8_SB(1, 1), cB + hstep + kstep, voffB);
        PG8_WAIT_V(6); PG8_BAR;
    }
    for (;;) {
        const bool has_next = S.next(ui + 1, nxt);
        const char* nA = has_next ? (const char*)g.A + (size_t)nxt.pm * tstep : cA; const char* nB = has_next ? (const char*)g.Bt + (size_t)nxt.pn * tstep : cB;
        for (int t = 0; t < nt; t += 2) {
            const bool last = (t == nt - 2);
            const char* a1 = cA + (size_t)(t + 1) * kstep;
            const char* a2 = last ? nA : cA + (size_t)(t + 2) * kstep; const char* b2 = last ? nB : cB + (size_t)(t + 2) * kstep;
            const char* a3 = a2 + kstep; const char* b3 = b2 + kstep;
            if (last && has_next) S.a_ready(nxt);
            if constexpr (SP2) {
            PG8_LDB(B0, 0, 0); PG8_LDB(B1, 0, 1); PG8_SCHED; PG8_LDA(At, 0, 0); PG8_STAGE(PG8_SA(1, 1), a1 + hstep, voffA);
            PG8_WAIT_V(8); PG8_WAIT_L(0); PG8_BAR; PG8_MMA(0, 0, At, B0); PG8_MMA(0, 1, At, B1); PG8_BAR; PG8_SCHED;
            PG8_LDA(At, 0, 1); PG8_STAGE(PG8_SB(0, 0), b2, voffB); PG8_STAGE(PG8_SB(0, 1), b2 + hstep, voffB); PG8_STAGE(PG8_SA(0, 0), a2, voffA);
            PG8_WAIT_V(8); PG8_WAIT_L(0); PG8_BAR; PG8_MMA(1, 0, At, B0); PG8_MMA(1, 1, At, B1); PG8_BAR; PG8_SCHED;
            PG8_LDB(B0, 1, 0); PG8_LDB(B1, 1, 1); PG8_SCHED; PG8_LDA(At, 1, 0); PG8_STAGE(PG8_SA(0, 1), a2 + hstep, voffA);
            PG8_WAIT_V(8); PG8_WAIT_L(0); PG8_BAR; PG8_MMA(0, 0, At, B0); PG8_MMA(0, 1, At, B1); PG8_BAR; PG8_SCHED;
            PG8_LDA(At, 1, 1); PG8_STAGE(PG8_SB(1, 0), b3, voffB); PG8_STAGE(PG8_SB(1, 1), b3 + hstep, voffB); PG8_STAGE(PG8_SA(1, 0), a3, voffA);
            PG8_WAIT_V(8); PG8_WAIT_L(0); PG8_BAR; PG8_MMA(1, 0, At, B0); PG8_MMA(1, 1, At, B1); PG8_BAR; PG8_SCHED;
            } else {
            PG8_LDB(B0, 0, 0); PG8_SCHED; PG8_LDA(At, 0, 0); PG8_STAGE(PG8_SA(1, 1), a1 + hstep, voffA);
            PG8_WAIT_L(8); PG8_BAR; PG8_WAIT_L(0); PG8_MMA(0, 0, At, B0); PG8_BAR; PG8_SCHED;
            PG8_LDB(B1, 0, 1); PG8_STAGE(PG8_SB(0, 0), b2, voffB);
            PG8_BAR; PG8_WAIT_L(0); PG8_MMA(0, 1, At, B1); PG8_BAR;
            PG8_LDA(At, 0, 1); PG8_STAGE(PG8_SA(0, 0), a2, voffA);
            PG8_BAR; PG8_WAIT_L(0); PG8_MMA(1, 0, At, B0); PG8_BAR; PG8_SCHED;
            PG8_STAGE(PG8_SB(0, 1), b2 + hstep, voffB);
            PG8_WAIT_V(6); PG8_BAR; PG8_MMA(1, 1, At, B1); PG8_BAR;
            PG8_LDB(B0, 1, 0); PG8_SCHED; PG8_LDA(At, 1, 0); PG8_STAGE(PG8_SA(0, 1), a2 + hstep, voffA);
            PG8_WAIT_L(8); PG8_BAR; PG8_WAIT_L(0); PG8_MMA(0, 0, At, B0); PG8_BAR; PG8_SCHED;
            PG8_LDB(B1, 1, 1); PG8_STAGE(PG8_SB(1, 0), b3, voffB);
            PG8_BAR; PG8_WAIT_L(0); PG8_MMA(0, 1, At, B1); PG8_BAR;
            PG8_LDA(At, 1, 1); PG8_STAGE(PG8_SA(1, 0), a3, voffA);
            PG8_BAR; PG8_WAIT_L(0); PG8_MMA(1, 0, At, B0); PG8_BAR; PG8_SCHED;
            PG8_STAGE(PG8_SB(1, 1), b3 + hstep, voffB);
            PG8_WAIT_V(6); PG8_BAR; PG8_MMA(1, 1, At, B1); PG8_BAR;
            }
        }
        if constexpr (ALIGN_EPI) { if (wr == 0) PG8_BAR; }
        if constexpr (!Epi::AFTER_DRAIN) { E(acc, cur, wr, wc, fr, fq); S.done(cur); }
        if (!has_next) break;
#pragma unroll
        for (int a = 0; a < 2; ++a)
#pragma unroll
            for (int b = 0; b < 2; ++b)
#pragma unroll
                for (int m = 0; m < 4; ++m)
#pragma unroll
                    for (int n = 0; n < 2; ++n) acc[a][b][m][n] = (f32x4){0.f, 0.f, 0.f, 0.f};
        cur = nxt; cA = nA; cB = nB; ++ui;
        if constexpr (ALIGN_EPI) { if (wr == 1) PG8_BAR; }
    }
    PG8_WAIT_V(0);
    if constexpr (!ALIGN_EPI) { if (wr == 0) PG8_BAR; }
    PG8_BAR;
    if constexpr (Epi::AFTER_DRAIN) { E.fused(acc, cur, wr, wc, fr, fq, lds, wid, lane); S.done(cur); }
#undef PG8_SA
#undef PG8_SB
#undef PG8_STAGE
#undef PG8_LDA
#undef PG8_LDB
#undef PG8_MMA
#undef PG8_WAIT_V
#undef PG8_WAIT_L
#undef PG8_BAR
#undef PG8_SCHED
}
}

#define XB_TMO      128
#define XB_XCNT(j)  (256  + 64 * (j))
#define XB_XSUB(j)  (1280 + 64 * (j))
#define XB_XGEN(j)  (2304 + 64 * (j))
#define XB_TOP      3328
#define XB_TOPGEN   3392
#define XCD_BAR_WORDS 3456
#define XB_SPIN_CAP (1u << 18)
#define LAS __attribute__((address_space(3)))

__device__ __forceinline__ unsigned xb_ld(unsigned* p)              { return __hip_atomic_load(p, __ATOMIC_RELAXED, __HIP_MEMORY_SCOPE_AGENT); }
__device__ __forceinline__ unsigned xb_add(unsigned* p, unsigned v) { return __hip_atomic_fetch_add(p, v, __ATOMIC_RELAXED, __HIP_MEMORY_SCOPE_AGENT); }
__device__ __forceinline__ unsigned xb_xcc_id() { return (unsigned)__builtin_amdgcn_s_getreg((3 << 11) | 20) & 0xFu; }
#define XB_SPIN(cond, bar) do { unsigned _sp = 0; while (cond) { __builtin_amdgcn_s_sleep(1); \
    if ((++_sp & 255u) == 0u) { if (xb_ld(&(bar)[XB_TMO])) break; if (_sp > XB_SPIN_CAP) { atomicAdd(&(bar)[XB_TMO], 1u); break; } } } } while (0)

struct XcdBarrier {
    unsigned* bar; unsigned x;
    volatile LAS unsigned* st;
};

__device__ __forceinline__ XcdBarrier xcd_barrier_post(unsigned* bar, volatile LAS unsigned* st, int tid) {
    XcdBarrier b; b.bar = bar; b.x = (unsigned)__builtin_amdgcn_readfirstlane((int)xb_xcc_id()); b.st = st;
    if (tid == 0) (void)xb_add(&bar[XB_XCNT(b.x)], 1u);
    return b;
}
__device__ __forceinline__ void xcd_barrier_complete(unsigned* bar, unsigned x, unsigned& nloc, unsigned& nx) {
    const unsigned G = gridDim.x * gridDim.y * gridDim.z;
    unsigned sum, cnt, mine, sp = 0u;
    for (;;) {
        sum = 0u; cnt = 0u; mine = 0u;
#pragma unroll
        for (unsigned j = 0; j < 16; ++j) { const unsigned c = xb_ld(&bar[XB_XCNT(j)]); sum += c; cnt += (c > 0u) ? 1u : 0u; mine = (j == x) ? c : mine; }
        if (sum == G) break;
        __builtin_amdgcn_s_sleep(1);
        if ((++sp & 255u) == 0u) { if (xb_ld(&bar[XB_TMO])) break; if (sp > XB_SPIN_CAP) { atomicAdd(&bar[XB_TMO], 1u); break; } }
    }
    nloc = mine > 0u ? mine : 1u; nx = cnt > 0u ? cnt : 1u;
}

__device__ __forceinline__ void xcd_barrier(const XcdBarrier& b, int tid) {
    asm volatile("s_waitcnt vmcnt(0)" ::: "memory");
    __syncthreads();
    if (tid == 0) {
        unsigned* bar = b.bar; unsigned bx_ = b.x; asm volatile("" : "+s"(bar), "+s"(bx_));
        __builtin_amdgcn_s_waitcnt(0);
        unsigned nloc = b.st[0], nx = b.st[1];
        if (nloc == 0u) { xcd_barrier_complete(bar, bx_, nloc, nx); b.st[0] = nloc; b.st[1] = nx; }
        const unsigned old = xb_add(&bar[XB_XSUB(bx_)], 1u);
        const unsigned gen = old / nloc;
        if (old + 1u == (gen + 1u) * nloc) {
            __builtin_amdgcn_fence(__ATOMIC_RELEASE, "agent");
            asm volatile("s_waitcnt vmcnt(0)" ::: "memory");
            const unsigned og = xb_add(&bar[XB_TOP], 1u);
            const unsigned tg = og / nx;
            if (og + 1u == (tg + 1u) * nx) xb_add(&bar[XB_TOPGEN], 1u);
            else XB_SPIN(xb_ld(&bar[XB_TOPGEN]) == tg, bar);
            __builtin_amdgcn_fence(__ATOMIC_ACQUIRE, "agent");
            xb_add(&bar[XB_XGEN(bx_)], 1u);
            asm volatile("s_waitcnt vmcnt(0)" ::: "memory");
        } else {
            XB_SPIN(xb_ld(&bar[XB_XGEN(bx_)]) == gen, bar);
            __builtin_amdgcn_fence(__ATOMIC_ACQUIRE, "agent");
            asm volatile("s_waitcnt vmcnt(0)" ::: "memory");
        }
    }
    __syncthreads();
}


typedef unsigned v4u __attribute__((ext_vector_type(4)));
typedef float f32x4 __attribute__((ext_vector_type(4)));
#define LDS_WAIT() asm volatile("s_waitcnt lgkmcnt(0)" ::: "memory")
constexpr int NWAVES = 8, NTHREADS = 512;
constexpr int RING_BYTES = 131072, LDS_BYTES = 155648;

struct P { const float* in[N_IN]; float* out; unsigned char* ws; };

template <int M> __device__ __forceinline__ float swz_xor(float v) { static_assert(M >= 1 && M < 32, "swizzle xor mask"); return __int_as_float(__builtin_amdgcn_ds_swizzle(__float_as_int(v), (M << 10) | 0x1f)); }
__device__ __forceinline__ float xor32_sum(float v) { auto r = __builtin_amdgcn_permlane32_swap(__float_as_uint(v), __float_as_uint(v), false, false); return __uint_as_float(r[0]) + __uint_as_float(r[1]); }
__device__ __forceinline__ float wave_sum(float v) {
    v += swz_xor<1>(v); v += swz_xor<2>(v); v += swz_xor<4>(v); v += swz_xor<8>(v); v += swz_xor<16>(v);
    return xor32_sum(v);
}

template <bool VPERM = false>
__device__ __forceinline__ void transpose_item(const float* W, int K, int N, bf16* WT, int k0, int n0, int drow0, LAS float* scr, int lane) {
    float tv[32];
#pragma unroll
    for (int i = 0; i < 32; ++i) { const int kk = 2 * i + (lane >> 5); tv[i] = W[(size_t)(k0 + kk) * N + n0 + (lane & 31)]; }
#pragma unroll
    for (int i = 0; i < 32; ++i) { const int kk = 2 * i + (lane >> 5); scr[kk * 33 + (lane & 31)] = tv[i]; }
    LDS_WAIT(); asm volatile("" ::: "memory");
    const int c = lane & 7;
#pragma unroll
    for (int j = 0; j < 4; ++j) { const int n = (lane >> 3) + 8 * j; const LAS float* s = scr + (8 * c) * 33 + n;
        v4u o; o.x = pk2(s[0 * 33], s[1 * 33]); o.y = pk2(s[2 * 33], s[3 * 33]); o.z = pk2(s[4 * 33], s[5 * 33]); o.w = pk2(s[6 * 33], s[7 * 33]);
        const int dr = VPERM ? (((drow0 + n) & ~127) + hg_vpos((drow0 + n) & 127)) : (drow0 + n);
        *(v4u*)(WT + (size_t)dr * K + k0 + 8 * c) = o; }
    LDS_WAIT(); asm volatile("" ::: "memory");
}

__device__ __forceinline__ void phase_prologue(const P& p, LAS unsigned char* lds, int gw, int NGW, int lane, int wave) {
    LAS float* scr = (LAS float*)(lds + wave * 16384);
    unsigned char* ws = p.ws;
    constexpr int IT_ADA = 16 * 192, IT_IN = 16 * 385, IT_BRA = 16 * 32, IT_BRB = 32 * 32, IT_OUT = 16 * 32, IT_UP = 16 * 128, IT_DOWN = 64 * 32;
    constexpr int IT_L = IT_ADA + IT_IN + IT_BRA + IT_BRB + IT_OUT + IT_UP + IT_DOWN;
    for (int it = gw; it < DEPTH * IT_L; it += NGW) {
        const int l = it / IT_L; int r = it % IT_L;
        bf16* wl = (bf16*)(ws + WS_W + (size_t)l * W_LSTRIDE);
        if (r < IT_ADA) { const int kb = r / 192, nb = r % 192; transpose_item(p.in[I_WADA] + (size_t)l * D * 6144, D, 6144, (bf16*)(ws + WS_WADA) + (size_t)l * 6144 * D, kb * 64, nb * 32, nb * 32, scr, lane); continue; } r -= IT_ADA;
        if (r < IT_IN) { const int kb = r / 385, nb = r % 385; const int n0 = nb * 32; const int dr = n0 < 10240 ? n0 : (n0 < 10272 ? PC_DT + (n0 - 10240) : n0 - 32);
            if (n0 >= PC_I && n0 < PC_OG) transpose_item<true>(p.in[I_WIN] + (size_t)l * D * IN_WIDTH, D, IN_WIDTH, (bf16*)((unsigned char*)wl + WO_IN), kb * 64, n0, dr, scr, lane);
            else transpose_item(p.in[I_WIN] + (size_t)l * D * IN_WIDTH, D, IN_WIDTH, (bf16*)((unsigned char*)wl + WO_IN), kb * 64, n0, dr, scr, lane);
            continue; } r -= IT_IN;
        if (r < IT_BRA) { const int kb = r / 32, nb = r % 32; transpose_item(p.in[I_WBRA] + (size_t)l * 1024 * 1024, 1024, 1024, (bf16*)((unsigned char*)wl + WO_BRA), kb * 64, nb * 32, nb * 32, scr, lane); continue; } r -= IT_BRA;
        if (r < IT_BRB) { const int kb = r / 32, nb = r % 32; transpose_item(p.in[I_WBRB] + (size_t)l * 2048 * 1024, 2048, 1024, (bf16*)((unsigned char*)wl + WO_BRB), kb * 64, nb * 32, nb * 32, scr, lane); continue; } r -= IT_BRB;
        if (r < IT_OUT) { const int kb = r / 32, nb = r % 32; transpose_item(p.in[I_WOUT] + (size_t)l * 1024 * 1024, 1024, 1024, (bf16*)((unsigned char*)wl + WO_OUT), kb * 64, nb * 32, nb * 32, scr, lane); continue; } r -= IT_OUT;
        if (r < IT_UP) { const int kb = r / 128, nb = r % 128; transpose_item(p.in[I_WUP] + (size_t)l * 1024 * 4096, 1024, 4096, (bf16*)((unsigned char*)wl + WO_UP), kb * 64, nb * 32, nb * 32, scr, lane); continue; } r -= IT_UP;
        { const int kb = r / 32, nb = r % 32; transpose_item(p.in[I_WDOWN] + (size_t)l * 4096 * 1024, 4096, 1024, (bf16*)((unsigned char*)wl + WO_DOWN), kb * 64, nb * 32, nb * 32, scr, lane); }
    }
    for (int i = gw * 64 + lane; i < DEPTH * 28672; i += NGW * 64) { const int l = i / 28672, r = i % 28672;
        ((v4u*)(ws + WS_W + (size_t)l * W_LSTRIDE + WO_IN + (size_t)IN_WIDTH * D * 2))[r] = (v4u){0u, 0u, 0u, 0u}; }
    for (int i = gw * 64 + lane; i < 256 * 1024; i += NGW * 64) { const int r = i >> 10, c = i & 1023;
        float v = 0.f; if (r < NB) v = p.in[I_CP][r * D + c]; else if (r < NCOND) v = p.in[I_CS][(r - NB) * D + c];
        ((bf16*)(ws + WS_AC))[i] = f2bf(siluf_(v)); }
    for (int c = gw * 64 + lane; c < 1024; c += NGW * 64) { float v[DEPTH], mx = -3.0e38f;
#pragma unroll
        for (int l = 0; l < DEPTH; ++l) { v[l] = p.in[I_LB][l * 1024 + c]; mx = fmaxf(mx, v[l]); }
        float s = 0.f;
#pragma unroll
        for (int l = 0; l < DEPTH; ++l) { v[l] = expf(v[l] - mx); s += v[l]; }
        float cum = 0.f; float* lbs = (float*)(ws + WS_LBS);
#pragma unroll
        for (int l = 0; l < DEPTH; ++l) { if (l > 0) cum += v[l] / s; lbs[l * 1024 + c] = cum; }
    }
}

__device__ __forceinline__ f32x4 unpack4(unsigned long long w) { const unsigned lo = (unsigned)w, hi = (unsigned)(w >> 32); return (f32x4){__uint_as_float(lo << 16), __uint_as_float(lo & 0xffff0000u), __uint_as_float(hi << 16), __uint_as_float(hi & 0xffff0000u)}; }
template <int MODE, int NR>
__device__ __forceinline__ void norm_rows(const float* X32, bf16* X, bf16* H, float* out32, const f32x4 (&mul)[4], const f32x4 (&sh)[4], int lane) {
    if constexpr (MODE == 1) {
        f32x4 v[NR][4];
#pragma unroll
        for (int r = 0; r < NR; ++r) { const f32x4* xr = (const f32x4*)(X32 + (size_t)r * D) + lane;
#pragma unroll
            for (int j = 0; j < 4; ++j) v[r][j] = xr[64 * j]; }
#pragma unroll
        for (int r = 0; r < NR; ++r) { float s = 0.f;
#pragma unroll
            for (int j = 0; j < 4; ++j) s += (v[r][j].x * v[r][j].x + v[r][j].y * v[r][j].y) + (v[r][j].z * v[r][j].z + v[r][j].w * v[r][j].w);
            const float rstd = rsqrtf(wave_sum(s) * (1.f / D) + EPS);
            unsigned long long* o8 = (unsigned long long*)(H + (size_t)r * D) + lane; unsigned long long* x8 = (unsigned long long*)(X + (size_t)r * D) + lane;
#pragma unroll
            for (int j = 0; j < 4; ++j) { const f32x4 y = v[r][j] * rstd * mul[j] + sh[j];
                x8[64 * j] = (unsigned long long)pk2(v[r][j].x, v[r][j].y) | ((unsigned long long)pk2(v[r][j].z, v[r][j].w) << 32);
                o8[64 * j] = (unsigned long long)pk2(y.x, y.y) | ((unsigned long long)pk2(y.z, y.w) << 32); } }
    } else {
        unsigned long long raw[NR][4];
#pragma unroll
        for (int r = 0; r < NR; ++r) { const unsigned long long* xr = (const unsigned long long*)(X + (size_t)r * D) + lane;
#pragma unroll
            for (int j = 0; j < 4; ++j) raw[r][j] = xr[64 * j]; }
#pragma unroll
        for (int r = 0; r < NR; ++r) { f32x4 v[4]; float s = 0.f;
#pragma unroll
            for (int j = 0; j < 4; ++j) { v[j] = unpack4(raw[r][j]); s += (v[j].x * v[j].x + v[j].y * v[j].y) + (v[j].z * v[j].z + v[j].w * v[j].w); }
            const float rstd = rsqrtf(wave_sum(s) * (1.f / D) + EPS);
            if constexpr (MODE == 2) { f32x4* o = (f32x4*)(out32 + (size_t)r * D) + lane;
#pragma unroll
                for (int j = 0; j < 4; ++j) o[64 * j] = v[j] * rstd * mul[j];
            } else { unsigned long long* o8 = (unsigned long long*)(H + (size_t)r * D) + lane;
#pragma unroll
                for (int j = 0; j < 4; ++j) { const f32x4 y = v[j] * rstd * mul[j] + sh[j]; o8[64 * j] = (unsigned long long)pk2(y.x, y.y) | ((unsigned long long)pk2(y.z, y.w) << 32); } } }
    }
}
template <int MODE>
__device__ __forceinline__ void phase_norm(const float* Xp32, const float* Xs32, bf16* X, bf16* H, const float* nw, const float* mod_sh, const float* mod_sc, int gw, int NGW, int lane) {
    f32x4 w4[4];
#pragma unroll
    for (int j = 0; j < 4; ++j) w4[j] = ((const f32x4*)nw)[lane + 64 * j];
    for (int b = gw; b < MP / 8; b += NGW) {
        const int ci = b >> 8; f32x4 mul[4], sh[4];
        const f32x4* shp = (const f32x4*)(mod_sh + (size_t)ci * MODLD) + lane; const f32x4* scp = (const f32x4*)(mod_sc + (size_t)ci * MODLD) + lane;
#pragma unroll
        for (int j = 0; j < 4; ++j) { sh[j] = shp[64 * j]; mul[j] = w4[j] * (scp[64 * j] + 1.0f); }
        const size_t ro = (size_t)b * 8 * D;
        norm_rows<MODE, MODE == 1 ? 4 : 8>(MODE == 1 ? Xp32 + ro : nullptr, X + ro, H + ro, nullptr, mul, sh, lane);
        if constexpr (MODE == 1) norm_rows<MODE, 4>(Xp32 + ro + 4 * D, X + ro + 4 * D, H + ro + 4 * D, nullptr, mul, sh, lane);
    }
    for (int sr = gw; sr < MS; sr += NGW) {
        const int ci = NB + sr; f32x4 mul[4], sh[4];
        const f32x4* shp = (const f32x4*)(mod_sh + (size_t)ci * MODLD) + lane; const f32x4* scp = (const f32x4*)(mod_sc + (size_t)ci * MODLD) + lane;
#pragma unroll
        for (int j = 0; j < 4; ++j) { sh[j] = shp[64 * j]; mul[j] = w4[j] * (scp[64 * j] + 1.0f); }
        const size_t ro = (size_t)(MP + sr) * D;
        norm_rows<MODE, 1>(MODE == 1 ? Xs32 + (size_t)sr * D : nullptr, X + ro, H + ro, nullptr, mul, sh, lane);
    }
}
__device__ __forceinline__ void phase_final(const bf16* X, float* out, const float* nw, int gw, int NGW, int lane) {
    f32x4 w4[4];
#pragma unroll
    for (int j = 0; j < 4; ++j) w4[j] = ((const f32x4*)nw)[lane + 64 * j];
    for (int b = gw; b < MP / 8; b += NGW) { const size_t ro = (size_t)b * 8 * D; norm_rows<2, 8>(nullptr, (bf16*)X + ro, nullptr, out + ro, w4, w4, lane); }
    for (int sr = gw; sr < MS; sr += NGW) { const size_t ro = (size_t)(MP + sr) * D; norm_rows<2, 1>(nullptr, (bf16*)X + ro, nullptr, out + ro, w4, w4, lane); }
}


typedef short s16x4 __attribute__((ext_vector_type(4)));
typedef short bf16x8 __attribute__((ext_vector_type(8)));
__device__ __forceinline__ f32x4 mfma16(bf16x8 a, bf16x8 b, f32x4 c) { return __builtin_amdgcn_mfma_f32_16x16x32_bf16(a, b, c, 0, 0, 0); }
__device__ __forceinline__ s16x4 tr_read4(LAS unsigned char* p) { return __builtin_amdgcn_ds_read_tr16_b64_v4i16((LAS s16x4*)p); }
#define SHFL_XOR(v, M) swz_xor<M>(v)
__device__ __forceinline__ float shfl_up_f(float v, int o, int lane) { return __int_as_float(__builtin_amdgcn_ds_bpermute((lane >= o ? lane - o : lane) << 2, __float_as_int(v))); }
__device__ __forceinline__ void sync_threads() { __syncthreads(); }
__device__ __forceinline__ float __builtin_amdgcn_exp2f_(float x) { return __builtin_amdgcn_exp2f(x); }
#ifdef HOST_EMU
#define FENCE_MEM() do {} while (0)
#define SCHED_FENCE() do {} while (0)
#define LAUNDER_PTR(p) do {} while (0)
#else
#define LAUNDER_PTR(p) asm volatile("" : "+v"(p))
#define FENCE_MEM() asm volatile("" ::: "memory")
#define SCHED_FENCE() __builtin_amdgcn_sched_barrier(0)
#endif
constexpr int RC = 64;
constexpr int NSEG = 4, SEGLEN = 512, NCH = SEGLEN / RC;
constexpr int PQ = 272;
constexpr int PX = 528;

struct RecurBufs {
    bf16* proj;
    bf16* xbcc;
    float* dtv;
    float* cum;
    float* cv;
    float* sseg;
    float* dseg;
    float* hseg;
    float* tseg;
    bf16* ohg;
    bf16* y;
};

__device__ __forceinline__ bf16x8 frag_rows(LAS unsigned char* img, int pitch, int row, int kcol) { return *(LAS bf16x8*)(img + row * pitch + kcol * 2); }
__device__ __forceinline__ bf16x8 frag_tr(LAS unsigned char* img, int pitch, int k0a, int k0b, int col0, int lane) {
    const int q = (lane & 15) >> 2, p = lane & 3;
    const s16x4 a = tr_read4(img + (k0a + q) * pitch + (col0 + 4 * p) * 2);
    const s16x4 b = tr_read4(img + (k0b + q) * pitch + (col0 + 4 * p) * 2);
    return (bf16x8){a[0], a[1], a[2], a[3], b[0], b[1], b[2], b[3]};
}
__device__ __forceinline__ bf16x8 scale_frag(bf16x8 f, float s) {
    bf16x8 o;
#pragma unroll
    for (int j = 0; j < 8; ++j) o[j] = (short)f2bf(bf2f((bf16)f[j]) * s);
    return o;
}
__device__ __forceinline__ bf16x8 scale_frag8(bf16x8 f, const float (&s)[8]) {
    bf16x8 o;
#pragma unroll
    for (int j = 0; j < 8; ++j) o[j] = (short)f2bf(bf2f((bf16)f[j]) * s[j]);
    return o;
}
__device__ __forceinline__ void stage_tile128(const bf16* g, size_t ld, LAS unsigned char* img, int tid) {
#pragma unroll
    for (int i = 0; i < 2; ++i) { const int idx = tid + i * 512, r = idx >> 4, c16 = idx & 15;
        *(LAS v4u*)(img + r * PQ + c16 * 16) = *(const v4u*)(g + (size_t)r * ld + c16 * 8); }
}

constexpr int HG_QT = 0, HG_KT = 17408, HG_V = 34816, HG_PART = 52224, HG_VEC1 = 54272, HG_ST = 52224, HG_VEC = 87040, HG_RED = 89088;

__device__ __forceinline__ void hgrn_state_update(f32x4 (&S)[8], LAS unsigned char* Kt, LAS unsigned char* V, const LAS float* escale, const LAS float* edec, int w, int lane) {
    const int c = lane & 15, g = lane >> 4;
    const f32x4 dc = *(const LAS f32x4*)(edec + 16 * w + 4 * g);
#pragma unroll
    for (int et = 0; et < 8; ++et) S[et] = S[et] * dc;
    const float es = escale[16 * w + c];
#pragma unroll
    for (int ks = 0; ks < 2; ++ks) {
        const bf16x8 A = scale_frag(frag_tr(Kt, PQ, 32 * ks + 8 * g, 32 * ks + 8 * g + 4, 16 * w, lane), es);
#pragma unroll
        for (int et = 0; et < 8; ++et) { const bf16x8 B = frag_tr(V, PQ, 32 * ks + 8 * g, 32 * ks + 8 * g + 4, 16 * et, lane); S[et] = mfma16(A, B, S[et]); }
        SCHED_FENCE();
    }
}

__device__ __forceinline__ void hgrn_pass1(const RecurBufs& rb, const float* lbs_l, int u, int tid, LAS unsigned char* lds) {
    const int b = u >> 5, h = (u >> 2) & 7, seg = u & 3, lane = tid & 63, w = tid >> 6;
    const int d = tid & 127, jq = tid >> 7;
    LAS unsigned char* Qt = lds + HG_QT; LAS unsigned char* Kt = lds + HG_KT; LAS unsigned char* V = lds + HG_V; LAS float* part = (LAS float*)(lds + HG_PART); LAS float* vec = (LAS float*)(lds + HG_VEC1);
    const float lb = lbs_l[h * 128 + d];
    f32x4 S[8];
#pragma unroll
    for (int et = 0; et < 8; ++et) S[et] = (f32x4){0.f, 0.f, 0.f, 0.f};
    float dprod = 1.f;
    const int sr = tid >> 4, sc16 = tid & 15;
    v4u pre[6];
    {   const bf16* gq = rb.proj + ((size_t)b * SEQ + seg * SEGLEN + sr) * LDP + PC_Q + h * 128 + sc16 * 8;
        pre[0] = *(const v4u*)gq; pre[1] = *(const v4u*)(gq + 32 * (size_t)LDP); pre[2] = *(const v4u*)(gq + PC_F); pre[3] = *(const v4u*)(gq + 32 * (size_t)LDP + PC_F);
        pre[4] = *(const v4u*)(gq + PC_I); pre[5] = *(const v4u*)(gq + 32 * (size_t)LDP + PC_I); }
    for (int ch = 0; ch < NCH; ++ch) {
        const size_t row0 = (size_t)b * SEQ + seg * SEGLEN + ch * RC;
        bf16* gq = rb.proj + (row0 + sr) * LDP + PC_Q + h * 128 + sc16 * 8;
        *(LAS v4u*)(Qt + sr * PQ + sc16 * 16) = pre[0]; *(LAS v4u*)(Qt + (sr + 32) * PQ + sc16 * 16) = pre[1];
        *(LAS v4u*)(Kt + sr * PQ + sc16 * 16) = pre[2]; *(LAS v4u*)(Kt + (sr + 32) * PQ + sc16 * 16) = pre[3];
        *(LAS v4u*)(V + sr * PQ + sc16 * 16) = pre[4]; *(LAS v4u*)(V + (sr + 32) * PQ + sc16 * 16) = pre[5];
        if (ch + 1 < NCH) { const bf16* gn = gq + RC * (size_t)LDP;
            pre[0] = *(const v4u*)gn; pre[1] = *(const v4u*)(gn + 32 * (size_t)LDP); pre[2] = *(const v4u*)(gn + PC_F); pre[3] = *(const v4u*)(gn + 32 * (size_t)LDP + PC_F);
            pre[4] = *(const v4u*)(gn + PC_I); pre[5] = *(const v4u*)(gn + 32 * (size_t)LDP + PC_I); }
        sync_threads();
        float qq[16], kk[16], lg[16];
#pragma unroll
        for (int j = 0; j < 16; ++j) { const float q = bf2f(*(const LAS bf16*)(Qt + (16 * jq + j) * PQ + d * 2)), f = bf2f(*(const LAS bf16*)(Kt + (16 * jq + j) * PQ + d * 2));
            const float fg = lb + (1.f - lb) * sigmoidf_(f);
            qq[j] = siluf_(q) * 0.08838834764831845f; kk[j] = 1.f - fg; lg[j] = __logf(fg); }
#pragma unroll
        for (int j = 1; j < 16; ++j) lg[j] += lg[j - 1];
        part[jq * 128 + d] = lg[15];
        sync_threads();
        const float p0 = part[d], p1 = part[128 + d], p2 = part[256 + d], p3 = part[384 + d];
        const float off = (jq > 0 ? p0 : 0.f) + (jq > 1 ? p1 : 0.f) + (jq > 2 ? p2 : 0.f);
        const float bref = p0 + p1, bend = (p0 + p1) + (p2 + p3);
#pragma unroll
        for (int j = 0; j < 16; ++j) { const float e1 = __expf(fminf(fmaxf(off + lg[j] - bref, -80.f), 80.f));
            *(LAS bf16*)(Qt + (16 * jq + j) * PQ + d * 2) = f2bf(qq[j] * e1); *(LAS bf16*)(Kt + (16 * jq + j) * PQ + d * 2) = f2bf(kk[j] * frcp_(e1)); }
        if (jq == 0) { const float eref = __expf(bref), esc = __expf(bend - bref), edc = __expf(bend);
            float* cvp = rb.cv + ((size_t)((b * 8 + h) * 32 + seg * NCH + ch) * 3) * 128;
            cvp[d] = eref; cvp[128 + d] = esc; cvp[256 + d] = edc; vec[128 + d] = esc; vec[256 + d] = edc; }
        dprod *= __expf(bend);
        sync_threads();
        *(v4u*)gq = *(const LAS v4u*)(Qt + sr * PQ + sc16 * 16); *(v4u*)(gq + 32 * (size_t)LDP) = *(const LAS v4u*)(Qt + (sr + 32) * PQ + sc16 * 16);
        *(v4u*)(gq + PC_F) = *(const LAS v4u*)(Kt + sr * PQ + sc16 * 16); *(v4u*)(gq + 32 * (size_t)LDP + PC_F) = *(const LAS v4u*)(Kt + (sr + 32) * PQ + sc16 * 16);
        hgrn_state_update(S, Kt, V, vec + 128, vec + 256, w, lane);
        sync_threads();
    }
    float* sp = rb.sseg + (size_t)u * 16384 + tid * 4;
#pragma unroll
    for (int et = 0; et < 8; ++et) { LAUNDER_PTR(sp); *(f32x4*)sp = S[et]; sp += 2048; }
    if (jq == 0) rb.dseg[u * 128 + d] = dprod;
}

__device__ __forceinline__ void hgrn_pass2(const RecurBufs& rb, const float* hgn_l, float* state_out_l, int u, int tid, LAS unsigned char* lds) {
    const int b = u >> 5, h = (u >> 2) & 7, seg = u & 3, lane = tid & 63, w = tid >> 6, c = lane & 15, g = lane >> 4;
    const int it = w & 3, eh = w >> 2;
    LAS unsigned char* Qt = lds + HG_QT; LAS unsigned char* Kt = lds + HG_KT; LAS unsigned char* V = lds + HG_V; LAS unsigned char* ST = lds + HG_ST;
    LAS float* vec = (LAS float*)(lds + HG_VEC); LAS float* red = (LAS float*)(lds + HG_RED);
    f32x4 S[8];
#pragma unroll
    for (int et = 0; et < 8; ++et) S[et] = (f32x4){0.f, 0.f, 0.f, 0.f};
    for (int s = 0; s < seg; ++s) { const int u2 = u - seg + s;
        const f32x4 dc = *(const f32x4*)(rb.dseg + u2 * 128 + 16 * w + 4 * g);
        const float* sp = rb.sseg + (size_t)u2 * 16384 + tid * 4;
#pragma unroll
        for (int et = 0; et < 8; ++et) { LAUNDER_PTR(sp); S[et] = S[et] * dc + *(const f32x4*)sp; sp += 2048; } }
    const int e0 = 64 * eh + 4 * c;
    const f32x4 hn = *(const f32x4*)(hgn_l + e0);
    const float* cvb = rb.cv + ((size_t)((b * 8 + h) * 32 + seg * NCH) * 3) * 128;
    const int sr = tid >> 4, sc16 = tid & 15;
    const size_t rowS = (size_t)b * SEQ + seg * SEGLEN;
    v4u pre[6];
    {   const bf16* gq = rb.proj + (rowS + sr) * LDP + PC_Q + h * 128 + sc16 * 8;
        pre[0] = *(const v4u*)gq; pre[1] = *(const v4u*)(gq + 32 * (size_t)LDP); pre[2] = *(const v4u*)(gq + PC_F); pre[3] = *(const v4u*)(gq + 32 * (size_t)LDP + PC_F);
        pre[4] = *(const v4u*)(gq + PC_I); pre[5] = *(const v4u*)(gq + 32 * (size_t)LDP + PC_I); }
    float cvn = tid < 384 ? cvb[tid] : 0.f; f32x4 ern = *(const f32x4*)(cvb + 16 * w + 4 * g);
    for (int ch = 0; ch < NCH; ++ch) {
        const size_t row0 = rowS + ch * RC;
        *(LAS v4u*)(Qt + sr * PQ + sc16 * 16) = pre[0]; *(LAS v4u*)(Qt + (sr + 32) * PQ + sc16 * 16) = pre[1];
        *(LAS v4u*)(Kt + sr * PQ + sc16 * 16) = pre[2]; *(LAS v4u*)(Kt + (sr + 32) * PQ + sc16 * 16) = pre[3];
        *(LAS v4u*)(V + sr * PQ + sc16 * 16) = pre[4]; *(LAS v4u*)(V + (sr + 32) * PQ + sc16 * 16) = pre[5];
        if (ch + 1 < NCH) { const bf16* gq = rb.proj + (row0 + RC + sr) * LDP + PC_Q + h * 128 + sc16 * 8;
            pre[0] = *(const v4u*)gq; pre[1] = *(const v4u*)(gq + 32 * (size_t)LDP); pre[2] = *(const v4u*)(gq + PC_F); pre[3] = *(const v4u*)(gq + 32 * (size_t)LDP + PC_F);
            pre[4] = *(const v4u*)(gq + PC_I); pre[5] = *(const v4u*)(gq + 32 * (size_t)LDP + PC_I); }
        if (tid < 384) vec[tid] = cvn;
        {
            const f32x4 er = ern;
            if (ch + 1 < NCH) { if (tid < 384) cvn = cvb[(size_t)(ch + 1) * 384 + tid]; ern = *(const f32x4*)(cvb + (size_t)(ch + 1) * 384 + 16 * w + 4 * g); }
#pragma unroll
            for (int et = 0; et < 8; ++et) { const f32x4 v = S[et] * er;
                *(LAS unsigned long long*)(ST + (16 * et + c) * PQ + (16 * w + 4 * g) * 2) = (unsigned long long)pk2(v[0], v[1]) | ((unsigned long long)pk2(v[2], v[3]) << 32); } }
        unsigned long long ogv[4];
#pragma unroll
        for (int r = 0; r < 4; ++r) ogv[r] = *(const unsigned long long*)(rb.proj + (row0 + 16 * it + 4 * g + r) * LDP + PC_OG + h * 128 + e0);
        sync_threads();
        bf16x8 Qfr[4];
#pragma unroll
        for (int kd = 0; kd < 4; ++kd) Qfr[kd] = frag_rows(Qt, PQ, 16 * it + c, 32 * kd + 8 * g);
        unsigned PT[4][2];
#pragma unroll
        for (int jt = 0; jt < 4; ++jt) {
            f32x4 acc = (f32x4){0.f, 0.f, 0.f, 0.f};
            if (jt <= it) {
#pragma unroll
                for (int kd = 0; kd < 4; ++kd) acc = mfma16(frag_rows(Kt, PQ, 16 * jt + c, 32 * kd + 8 * g), Qfr[kd], acc);
                if (jt == it) {
#pragma unroll
                    for (int r = 0; r < 4; ++r) acc[r] = (4 * g + r <= c) ? acc[r] : 0.f; }
            }
            PT[jt][0] = pk2(acc[0], acc[1]); PT[jt][1] = pk2(acc[2], acc[3]); SCHED_FENCE();
        }
        f32x4 o[4];
#pragma unroll
        for (int et = 0; et < 4; ++et) o[et] = (f32x4){0.f, 0.f, 0.f, 0.f};
#pragma unroll
        for (int ks = 0; ks < 2; ++ks) if (2 * ks <= it) {
            v4u pa = (v4u){PT[2 * ks][0], PT[2 * ks][1], PT[2 * ks + 1][0], PT[2 * ks + 1][1]};
            const bf16x8 A = __builtin_bit_cast(bf16x8, pa);
#pragma unroll
            for (int et = 0; et < 4; ++et) o[et] = mfma16(A, frag_tr(V, PQ, 32 * ks + 4 * g, 32 * ks + 16 + 4 * g, 16 * (4 * eh + et), lane), o[et]);
        }
#pragma unroll
        for (int kd = 0; kd < 4; ++kd) {
#pragma unroll
            for (int et = 0; et < 4; ++et) o[et] = mfma16(Qfr[kd], frag_rows(ST, PQ, 16 * (4 * eh + et) + c, 32 * kd + 8 * g), o[et]);
            SCHED_FENCE(); }
        hgrn_state_update(S, Kt, V, vec + 128, vec + 256, w, lane);
        float ss[4];
#pragma unroll
        for (int r = 0; r < 4; ++r) { float s = 0.f;
#pragma unroll
            for (int et = 0; et < 4; ++et) s += o[et][r] * o[et][r];
            s += SHFL_XOR(s, 1); s += SHFL_XOR(s, 2); s += SHFL_XOR(s, 4); s += SHFL_XOR(s, 8); ss[r] = s; }
        if (c == 0) {
#pragma unroll
            for (int r = 0; r < 4; ++r) red[(16 * it + 4 * g + r) * 2 + eh] = ss[r]; }
        sync_threads();
#pragma unroll
        for (int r = 0; r < 4; ++r) { const int i = 16 * it + 4 * g + r; const float rstd = rsqrtf((red[i * 2] + red[i * 2 + 1]) * (1.f / 128.f) + EPS);
            float ov[4];
#pragma unroll
            for (int et = 0; et < 4; ++et) { const float og = bf2f((bf16)(ogv[r] >> (16 * et))); ov[et] = o[et][r] * rstd * hn[et] * siluf_(og); }
            *(unsigned long long*)(rb.ohg + (row0 + i) * 1024 + h * 128 + e0) = (unsigned long long)pk2(ov[0], ov[1]) | ((unsigned long long)pk2(ov[2], ov[3]) << 32); }
        sync_threads();
    }
    if (seg == NSEG - 1) { float* so = state_out_l + (size_t)(b * 8 + h) * 16384 + (size_t)(16 * w + 4 * g) * 128 + 4 * c;
#pragma unroll
        for (int r = 0; r < 4; ++r)
#pragma unroll
            for (int a = 0; a < 2; ++a) *(f32x4*)(so + r * 128 + 64 * a) = (f32x4){S[4 * a][r], S[4 * a + 1][r], S[4 * a + 2][r], S[4 * a + 3][r]}; }
}

constexpr int PR = 1040;
constexpr int SD_T = 0, SD_H = 66560, SD_XO = 66560  , SD_DT = 136192, SD_CUM = 137216, SD_RED = 138240, SD_END = 139264;
__device__ __forceinline__ int ssd_gcol(int grp, int ch16) { return ch16 < 32 ? grp * 256 + ch16 * 8 : (ch16 < 48 ? 2048 + grp * 128 + (ch16 - 32) * 8 : 3072 + grp * 128 + (ch16 - 48) * 8); }

__device__ __forceinline__ void ssd_state_update(f32x4 (&H)[4][4], LAS unsigned char* Xi, int xp, LAS unsigned char* Bi, int bp, const LAS float* sDt, const LAS float* sCum, int w, int lane) {
    const int g = lane >> 4, k = w >> 1, nh = w & 1;
    const float tot = sCum[63 * 4 + k]; const float et = __expf(tot);
#pragma unroll
    for (int nt = 0; nt < 4; ++nt)
#pragma unroll
        for (int pt = 0; pt < 4; ++pt) H[nt][pt] = H[nt][pt] * et;
#pragma unroll
    for (int ks = 0; ks < 2; ++ks) {
        float wg[8];
#pragma unroll
        for (int j = 0; j < 8; ++j) wg[j] = __expf(tot - sCum[(32 * ks + 8 * g + j) * 4 + k]) * sDt[(32 * ks + 8 * g + j) * 4 + k];
        bf16x8 Bx[4];
#pragma unroll
        for (int pt = 0; pt < 4; ++pt) Bx[pt] = scale_frag8(frag_tr(Xi, xp, 32 * ks + 8 * g, 32 * ks + 8 * g + 4, 64 * k + 16 * pt, lane), wg);
#pragma unroll
        for (int nt = 0; nt < 4; ++nt) { const bf16x8 A = frag_tr(Bi, bp, 32 * ks + 8 * g, 32 * ks + 8 * g + 4, 16 * (4 * nh + nt), lane);
#pragma unroll
            for (int pt = 0; pt < 4; ++pt) H[nt][pt] = mfma16(A, Bx[pt], H[nt][pt]);
            SCHED_FENCE(); }
    }
}

typedef float f32x2r __attribute__((ext_vector_type(2)));
__device__ __forceinline__ f32x2r unpack2(unsigned w) { return (f32x2r){__uint_as_float(w << 16), __uint_as_float(w & 0xffff0000u)}; }
__device__ __forceinline__ f32x2r silu2(f32x2r a) {
    const f32x2r t = a * (-1.4426950408889634f); f32x2r e; e.x = __builtin_amdgcn_exp2f_(t.x); e.y = __builtin_amdgcn_exp2f_(t.y);
    const f32x2r d = e + 1.0f; f32x2r r; r.x = frcp_(d.x); r.y = frcp_(d.y); return a * r; }
constexpr int SD_RH = SD_XO + 64 * PX;
__device__ __forceinline__ void ssd_pass1(const RecurBufs& rb, const float* conv_w, const float* conv_b, const float* dt_bias, const float* a_log, float* conv_out_l, int u, int tid, LAS unsigned char* lds) {
    const int b = u >> 5, grp = (u >> 2) & 7, seg = u & 3, lane = tid & 63, w = tid >> 6;
    LAS unsigned char* T = lds + SD_T; LAS float* sDt = (LAS float*)(lds + SD_DT); LAS float* sCum = (LAS float*)(lds + SD_CUM); LAS unsigned char* RH = lds + SD_RH;
    const int cp = tid & 255, half = tid >> 8, t0c = 2 * cp;
    const int chx = t0c < 256 ? (grp * 256 + t0c) : (t0c < 384 ? (2048 + grp * 128 + (t0c - 256)) : (3072 + grp * 128 + (t0c - 384)));
    const int xcol = (t0c & ~63) + 16 * (t0c & 3) + ((t0c & 63) >> 2);
    const f32x2r w0 = (f32x2r){conv_w[chx], conv_w[chx + 1]}, w1 = (f32x2r){conv_w[4096 + chx], conv_w[4096 + chx + 1]}, w2 = (f32x2r){conv_w[8192 + chx], conv_w[8192 + chx + 1]},
                 w3 = (f32x2r){conv_w[12288 + chx], conv_w[12288 + chx + 1]}, cb = (f32x2r){conv_b[chx], conv_b[chx + 1]};
    const size_t rowS = (size_t)b * SEQ + seg * SEGLEN;
    if (half == 0) {
#pragma unroll
        for (int j = 0; j < 3; ++j) { unsigned v = 0u; if (seg > 0) v = *(const unsigned*)(rb.proj + (rowS - 3 + j) * LDP + PC_XBC + chx); *(LAS unsigned*)(RH + j * 1024 + cp * 4) = v; } }
    f32x4 H[4][4];
#pragma unroll
    for (int nt = 0; nt < 4; ++nt)
#pragma unroll
        for (int pt = 0; pt < 4; ++pt) H[nt][pt] = (f32x4){0.f, 0.f, 0.f, 0.f};
    float tsum = 0.f;
    const int ch16 = tid & 63, rr = tid >> 6;
    const int gcol = ssd_gcol(grp, ch16);
    LAS unsigned char* XO = lds + SD_XO;
    v4u raw[8];
    {   const bf16* gp = rb.proj + (rowS + rr) * LDP + PC_XBC + gcol;
#pragma unroll
        for (int i = 0; i < 8; ++i) { LAUNDER_PTR(gp); raw[i] = *(const v4u*)gp; gp += 8 * (size_t)LDP; } }
    bf16 dtn = 0;
    if (w < 4) dtn = rb.proj[(rowS + lane) * LDP + PC_DT + grp * 4 + w];
    unsigned hr0 = 0u, hr1 = 0u, hr2 = 0u;
    for (int ch = 0; ch < NCH; ++ch) {
        const size_t row0 = rowS + ch * RC;
        if (w < 4) {
            const int head = grp * 4 + w; const size_t row = row0 + lane;
            const float dv = softplusf_(bf2f(dtn) + dt_bias[head]);
            if (ch + 1 < NCH) dtn = rb.proj[(row + RC) * LDP + PC_DT + head];
            float la = dv * (-__expf(a_log[head]));
#pragma unroll
            for (int o = 1; o < 64; o <<= 1) { const float t = shfl_up_f(la, o, lane); if (lane >= o) la += t; }
            sDt[lane * 4 + w] = dv; sCum[lane * 4 + w] = la; rb.dtv[row * 32 + head] = dv; rb.cum[row * 32 + head] = la;
        }
#pragma unroll
        for (int i = 0; i < 8; ++i) *(LAS v4u*)(T + (rr + 8 * i) * PR + ch16 * 16) = raw[i];
        if (ch + 1 < NCH) { const bf16* gp = rb.proj + (row0 + RC + rr) * LDP + PC_XBC + gcol;
#pragma unroll
            for (int i = 0; i < 8; ++i) { LAUNDER_PTR(gp); raw[i] = *(const v4u*)gp; gp += 8 * (size_t)LDP; } }
        sync_threads();
        if (half == 0) { hr0 = *(const LAS unsigned*)(RH + cp * 4); hr1 = *(const LAS unsigned*)(RH + 1024 + cp * 4); hr2 = *(const LAS unsigned*)(RH + 2048 + cp * 4); }
        else { hr0 = *(const LAS unsigned*)(T + 29 * PR + cp * 4); hr1 = *(const LAS unsigned*)(T + 30 * PR + cp * 4); hr2 = *(const LAS unsigned*)(T + 31 * PR + cp * 4); }
        sync_threads();
        {
            f32x2r r0 = unpack2(hr0), r1 = unpack2(hr1), r2 = unpack2(hr2);
            const LAS unsigned char* src = T + (32 * half) * PR + cp * 4;
            unsigned lastw0 = hr0, lastw1 = hr1, lastw2 = hr2;
#pragma unroll 8
            for (int j = 0; j < 32; ++j) { const unsigned cw = *(const LAS unsigned*)(src + j * PR); const f32x2r cur = unpack2(cw);
                const f32x2r a = cb + w0 * r0 + w1 * r1 + w2 * r2 + w3 * cur; r0 = r1; r1 = r2; r2 = cur; lastw0 = lastw1; lastw1 = lastw2; lastw2 = cw;
                const f32x2r v = silu2(a); const unsigned ow = pk2(v.x, v.y);
                if (cp < 128) { LAS unsigned char* d = XO + (32 * half + j) * PX + xcol * 2; *(LAS bf16*)d = (bf16)ow; *(LAS bf16*)(d + 32) = (bf16)(ow >> 16); }
                else *(LAS unsigned*)(T + (32 * half + j) * PR + cp * 4) = ow; }
            if (half == 1) { *(LAS unsigned*)(RH + cp * 4) = lastw0; *(LAS unsigned*)(RH + 1024 + cp * 4) = lastw1; *(LAS unsigned*)(RH + 2048 + cp * 4) = lastw2;
                hr0 = lastw0; hr1 = lastw1; hr2 = lastw2; }
        }
        sync_threads();
        tsum += sCum[63 * 4 + (w >> 1)];
        ssd_state_update(H, XO, PX, T + 512, PR, sDt, sCum, w, lane);
        {   bf16* gp = rb.xbcc + (row0 + rr) * 4096 + gcol;
            const LAS unsigned char* src = ch16 < 32 ? (XO + ch16 * 16) : (T + ch16 * 16); const int spitch = ch16 < 32 ? PX : PR;
#pragma unroll
            for (int i = 0; i < 8; ++i) { LAUNDER_PTR(gp); *(v4u*)gp = *(const LAS v4u*)(src + (rr + 8 * i) * spitch); gp += 8 * 4096; } }
        sync_threads();
    }
    float* hp = rb.hseg + (size_t)u * 32768 + tid * 4;
#pragma unroll
    for (int nt = 0; nt < 4; ++nt)
#pragma unroll
        for (int pt = 0; pt < 4; ++pt) { LAUNDER_PTR(hp); *(f32x4*)hp = H[nt][pt]; hp += 2048; }
    if ((tid & 127) == 0) rb.tseg[u * 4 + (w >> 1)] = tsum;
    if (seg == NSEG - 1 && half == 1) { float* co = conv_out_l + (size_t)b * 3 * 4096;
        const f32x2r a0 = unpack2(hr0), a1 = unpack2(hr1), a2 = unpack2(hr2);
        co[chx] = a0.x; co[chx + 1] = a0.y; co[4096 + chx] = a1.x; co[4096 + chx + 1] = a1.y; co[8192 + chx] = a2.x; co[8192 + chx + 1] = a2.y; }
}

__device__ __forceinline__ void ssd_pass2(const RecurBufs& rb, const float* d_skip, const float* ssm_norm, float* state_out_l, int u, int tid, LAS unsigned char* lds) {
    const int b = u >> 5, grp = (u >> 2) & 7, seg = u & 3, lane = tid & 63, w = tid >> 6, c = lane & 15, g = lane >> 4;
    const int k = w >> 1, hf = w & 1, head = grp * 4 + k;
    LAS unsigned char* T = lds + SD_T; LAS unsigned char* sB = T + 512; LAS unsigned char* sC = T + 768; LAS unsigned char* hS = lds + SD_H + k * (64 * PQ);
    LAS float* sDt = (LAS float*)(lds + SD_DT); LAS float* sCum = (LAS float*)(lds + SD_CUM); LAS float* red = (LAS float*)(lds + SD_RED);
    f32x4 H[4][4];
#pragma unroll
    for (int nt = 0; nt < 4; ++nt)
#pragma unroll
        for (int pt = 0; pt < 4; ++pt) H[nt][pt] = (f32x4){0.f, 0.f, 0.f, 0.f};
    for (int s = 0; s < seg; ++s) { const int u2 = u - seg + s; const float dc = __expf(rb.tseg[u2 * 4 + k]); const float* hp = rb.hseg + (size_t)u2 * 32768 + tid * 4;
#pragma unroll
        for (int nt = 0; nt < 4; ++nt)
#pragma unroll
            for (int pt = 0; pt < 4; ++pt) { LAUNDER_PTR(hp); H[nt][pt] = H[nt][pt] * dc + *(const f32x4*)hp; hp += 2048; } }
    const float Dk = d_skip[head];
    const size_t rowS = (size_t)b * SEQ + seg * SEGLEN;
    const int ch16 = tid & 63, rr = tid >> 6; const int gcol = ssd_gcol(grp, ch16);
    const int chn0 = grp * 256 + k * 64 + 4 * c;
    for (int ch = 0; ch < NCH; ++ch) {
        const size_t row0 = rowS + ch * RC;
        {   v4u raw[8];
            {   const bf16* gp = rb.xbcc + (row0 + rr) * 4096 + gcol;
#pragma unroll
                for (int i = 0; i < 8; ++i) { LAUNDER_PTR(gp); raw[i] = *(const v4u*)gp; gp += 8 * 4096; } }
            if (tid < 256) { sDt[tid] = rb.dtv[(row0 + (tid >> 2)) * 32 + grp * 4 + (tid & 3)]; sCum[tid] = rb.cum[(row0 + (tid >> 2)) * 32 + grp * 4 + (tid & 3)]; }
#pragma unroll
            for (int nt = 0; nt < 4; ++nt)
#pragma unroll
                for (int pt = 0; pt < 4; ++pt) { const f32x4 v = H[nt][pt];
                    *(LAS unsigned long long*)(hS + (4 * c + pt) * PQ + (16 * (4 * hf + nt) + 4 * g) * 2) = (unsigned long long)pk2(v[0], v[1]) | ((unsigned long long)pk2(v[2], v[3]) << 32); }
#pragma unroll
            for (int i = 0; i < 8; ++i) *(LAS v4u*)(T + (rr + 8 * i) * PR + ch16 * 16) = raw[i]; }
        sync_threads();
#pragma unroll 1
        for (int i2 = 0; i2 < 2; ++i2) {
            const int it = i2 ? 3 - hf : hf;
            unsigned long long zz[4];
#pragma unroll
            for (int r = 0; r < 4; ++r) zz[r] = *(const unsigned long long*)(rb.proj + (row0 + 16 * it + 4 * g + r) * LDP + PC_Z + chn0);
            f32x4 ya[4];
#pragma unroll
            for (int pt = 0; pt < 4; ++pt) ya[pt] = (f32x4){0.f, 0.f, 0.f, 0.f};
#pragma unroll
            for (int kn = 0; kn < 4; ++kn) { const bf16x8 Cf = frag_rows(sC, PR, 16 * it + c, 32 * kn + 8 * g);
#pragma unroll
                for (int pt = 0; pt < 4; ++pt) ya[pt] = mfma16(Cf, frag_rows(hS, PQ, 4 * c + pt, 32 * kn + 8 * g), ya[pt]);
                SCHED_FENCE(); }
            {   float ei[4];
#pragma unroll
                for (int r = 0; r < 4; ++r) ei[r] = __expf(sCum[(16 * it + 4 * g + r) * 4 + k]);
#pragma unroll
                for (int pt = 0; pt < 4; ++pt)
#pragma unroll
                    for (int r = 0; r < 4; ++r) ya[pt][r] *= ei[r]; }
            const float cum_i = sCum[(16 * it + c) * 4 + k];
            unsigned PT[4][2];
#pragma unroll
            for (int jt = 0; jt < 4; ++jt) {
                f32x4 acc = (f32x4){0.f, 0.f, 0.f, 0.f};
                if (jt <= it) {
#pragma unroll
                    for (int kn = 0; kn < 4; ++kn) acc = mfma16(frag_rows(sB, PR, 16 * jt + c, 32 * kn + 8 * g), frag_rows(sC, PR, 16 * it + c, 32 * kn + 8 * g), acc);
#pragma unroll
                    for (int r = 0; r < 4; ++r) { const int j = 16 * jt + 4 * g + r; const float df = cum_i - sCum[j * 4 + k]; const bool keep = (jt < it) || (4 * g + r <= c);
                        acc[r] = keep ? acc[r] * __expf(fminf(df, 0.f)) * sDt[j * 4 + k] : 0.f; }
                }
                PT[jt][0] = pk2(acc[0], acc[1]); PT[jt][1] = pk2(acc[2], acc[3]); SCHED_FENCE();
            }
#pragma unroll
            for (int ks = 0; ks < 2; ++ks) if (2 * ks <= it) {
                v4u pa = (v4u){PT[2 * ks][0], PT[2 * ks][1], PT[2 * ks + 1][0], PT[2 * ks + 1][1]};
                const bf16x8 A = __builtin_bit_cast(bf16x8, pa);
#pragma unroll
                for (int pt = 0; pt < 4; ++pt) ya[pt] = mfma16(A, frag_tr(T, PR, 32 * ks + 4 * g, 32 * ks + 16 + 4 * g, 64 * k + 16 * pt, lane), ya[pt]);
                SCHED_FENCE();
            }
#pragma unroll
            for (int r = 0; r < 4; ++r) { const int i = 16 * it + 4 * g + r; float s = 0.f; float yv[4];
#pragma unroll
                for (int pt = 0; pt < 4; ++pt) { const float xc = bf2f(*(const LAS bf16*)(T + i * PR + (64 * k + 16 * pt + c) * 2)); const float z = bf2f((bf16)(zz[r] >> (16 * pt)));
                    const bf16 yb = f2bf((ya[pt][r] + Dk * xc) * siluf_(z)); yv[pt] = bf2f(yb); s += yv[pt] * yv[pt]; }
                *(unsigned long long*)(rb.y + (row0 + i) * 2048 + chn0) = (unsigned long long)pk2(yv[0], yv[1]) | ((unsigned long long)pk2(yv[2], yv[3]) << 32);
                s += SHFL_XOR(s, 1); s += SHFL_XOR(s, 2); s += SHFL_XOR(s, 4); s += SHFL_XOR(s, 8);
                if (c == 0) red[i * 4 + k] = s; }
            SCHED_FENCE();
        }
        ssd_state_update(H, T, PR, T + 512, PR, sDt, sCum, w, lane);
        sync_threads();
        {   const f32x4 nw = *(const f32x4*)(ssm_norm + chn0);
            unsigned long long yy[8];
            const int itA = hf, itB = 3 - hf;
            bf16* yb0 = rb.y + (row0 + 16 * itA + 4 * g) * 2048 + chn0;
            const int jump = (16 * (itB - itA) - 3) * 2048;
            {   bf16* yp = yb0;
#pragma unroll
                for (int q = 0; q < 8; ++q) { LAUNDER_PTR(yp); yy[q] = *(const unsigned long long*)yp; yp += (q == 3) ? jump : 2048; } }
            bf16* yp = yb0;
#pragma unroll
            for (int q = 0; q < 8; ++q) { const int i = 16 * (q < 4 ? itA : itB) + 4 * g + (q & 3);
                const float rstd = rsqrtf(((red[i * 4] + red[i * 4 + 1]) + (red[i * 4 + 2] + red[i * 4 + 3])) * (1.f / 256.f) + EPS);
                const unsigned lo = (unsigned)yy[q], hi = (unsigned)(yy[q] >> 32);
                const float y0 = __uint_as_float(lo << 16) * rstd * nw[0], y1 = __uint_as_float(lo & 0xffff0000u) * rstd * nw[1], y2 = __uint_as_float(hi << 16) * rstd * nw[2], y3 = __uint_as_float(hi & 0xffff0000u) * rstd * nw[3];
                LAUNDER_PTR(yp); *(unsigned long long*)yp = (unsigned long long)pk2(y0, y1) | ((unsigned long long)pk2(y2, y3) << 32); yp += (q == 3) ? jump : 2048; } }
        sync_threads();
    }
    if (seg == NSEG - 1) { float* so = state_out_l + ((size_t)(b * 32 + head) * 64 + 4 * c) * 128 + 64 * hf + 4 * g;
#pragma unroll
        for (int pt = 0; pt < 4; ++pt)
#pragma unroll
            for (int nt = 0; nt < 4; ++nt) *(f32x4*)(so + pt * 128 + 16 * nt) = H[nt][pt]; }
}

__device__ __forceinline__ float row32_sum(float s) { s += SHFL_XOR(s, 1); s += SHFL_XOR(s, 2); s += SHFL_XOR(s, 4); s += SHFL_XOR(s, 8); s += SHFL_XOR(s, 16); return s; }

__device__ __forceinline__ void hgrn_sample_load(f32x4 (&st)[8], const float* state_in, int bh, int tid) {
    const float* sp = state_in + (size_t)bh * 16384 + tid * 4;
#pragma unroll
    for (int it = 0; it < 8; ++it) { LAUNDER_PTR(sp); st[it] = *(const f32x4*)sp; sp += 2048; }
}
__device__ __forceinline__ void hgrn_sample_step(const bf16* proj, const float* lbs_l, const float* hgn_l, const float* state_in, float* state_out, bf16* ohg, int bh, int tid, LAS unsigned char* lds,
                                                 f32x4 (&st)[8], int bh_next) {
    const int b = bh >> 3, h = bh & 7, lane = tid & 63, w = tid >> 6;
    LAS float* sq = (LAS float*)lds; LAS float* sg = sq + 128; LAS float* sk = sq + 256; LAS float* sv = sq + 384; LAS float* so = (LAS float*)(lds + 8192); LAS float* sred = (LAS float*)(lds + 16384);
    const size_t row = (size_t)MP + b;
    float ogv = 0.f, q_ = 0.f, f_ = 0.f, v_ = 0.f, lb_ = 0.f;
    if (tid < 128) { const bf16* pr = proj + row * LDP + h * 128; q_ = bf2f(pr[PC_Q + tid]); f_ = bf2f(pr[PC_F + tid]); lb_ = lbs_l[h * 128 + tid]; v_ = bf2f(pr[PC_I + hg_vpos(tid)]); ogv = bf2f(pr[PC_OG + tid]); }
    if (tid < 128) { const float fg = lb_ + (1.f - lb_) * sigmoidf_(f_);
        sq[tid] = siluf_(q_) * 0.08838834764831845f; sg[tid] = fg; sk[tid] = 1.f - fg; sv[tid] = v_; }
    sync_threads();
    const int dv4 = tid & 31, rg = tid >> 5;
    const f32x4 vv = *(const LAS f32x4*)(sv + 4 * dv4);
    f32x4 oacc = (f32x4){0.f, 0.f, 0.f, 0.f};
    float* op = state_out + (size_t)bh * 16384 + tid * 4;
    const float* np = state_in + (size_t)(bh_next >= 0 ? bh_next : bh) * 16384 + tid * 4;
#pragma unroll
    for (int it = 0; it < 8; ++it) { const int dk = it * 16 + rg; const f32x4 sn = st[it] * sg[dk] + vv * sk[dk]; LAUNDER_PTR(op); *(f32x4*)op = sn; op += 2048; oacc = oacc + sn * sq[dk];
        LAUNDER_PTR(np); if (bh_next >= 0) st[it] = *(const f32x4*)np; np += 2048; }
    *(LAS f32x4*)(so + rg * 128 + 4 * dv4) = oacc;
    sync_threads();
    if (tid < 128) { float o = 0.f;
#pragma unroll
        for (int r = 0; r < 16; ++r) o += so[r * 128 + tid];
        float ss = o * o; ss = row32_sum(ss);
        if ((lane & 31) == 0) sred[tid >> 5] = ss;
        sq[tid] = o; }
    sync_threads();
    if (tid < 128) { const float rstd = rsqrtf(((sred[0] + sred[1]) + (sred[2] + sred[3])) * (1.f / 128.f) + EPS);
        ohg[row * 1024 + h * 128 + tid] = f2bf(sq[tid] * rstd * hgn_l[tid] * siluf_(ogv)); }
    sync_threads();
    (void)w;
}

__device__ __forceinline__ void ssd_sample_load(f32x4 (&st)[16], const float* state_in, int bg, int tid) {
    const float* sp = state_in + ((size_t)((bg >> 3) * 32 + (bg & 7) * 4)) * 8192 + tid * 4;
#pragma unroll
    for (int it = 0; it < 16; ++it) { LAUNDER_PTR(sp); st[it] = *(const f32x4*)sp; sp += 2048; }
}
__device__ __forceinline__ void ssd_sample_step(const bf16* proj, const float* conv_w, const float* conv_b, const float* dt_bias, const float* a_log, const float* d_skip, const float* ssm_norm,
                                                const float* state_in, const float* conv_in, float* state_out, float* conv_out, bf16* ybuf, int bg, int tid, LAS unsigned char* lds,
                                                f32x4 (&st)[16], int bg_next) {
    const int b = bg >> 3, grp = bg & 7, lane = tid & 63, w = tid >> 6;
    LAS float* sx = (LAS float*)(lds + 2048); LAS float* sB = (LAS float*)(lds + 3072); LAS float* sC = (LAS float*)(lds + 3584); LAS float* sdt = (LAS float*)(lds + 4096); LAS float* sdec = (LAS float*)(lds + 4112);
    LAS float* sy = (LAS float*)(lds + 4608); LAS float* sred = (LAS float*)(lds + 16384);
    const size_t row = (size_t)MP + b;
    {
        const int chx = tid < 256 ? (grp * 256 + tid) : (tid < 384 ? (2048 + grp * 128 + (tid - 256)) : (3072 + grp * 128 + (tid - 384)));
        const float* ci = conv_in + (size_t)b * 3 * 4096; const float r0 = ci[chx], r1 = ci[4096 + chx], r2 = ci[8192 + chx];
        const float cur = bf2f(proj[row * LDP + PC_XBC + chx]);
        const float cw0 = conv_w[chx], cw1 = conv_w[4096 + chx], cw2 = conv_w[8192 + chx], cw3 = conv_w[12288 + chx], cbb = conv_b[chx];
        float dtr = 0.f, dtbv = 0.f, alg = 0.f; if (tid < 4) { const int head = grp * 4 + tid; dtr = bf2f(proj[row * LDP + PC_DT + head]); dtbv = dt_bias[head]; alg = a_log[head]; }
        const float a = cbb + cw0 * r0 + cw1 * r1 + cw2 * r2 + cw3 * cur;
        const float v = siluf_(a);
        if (tid < 256) sx[tid] = v; else if (tid < 384) sB[tid - 256] = v; else sC[tid - 384] = v;
        float* co = conv_out + (size_t)b * 3 * 4096; co[chx] = r1; co[4096 + chx] = r2; co[8192 + chx] = cur;
        if (tid < 4) { const float dv = softplusf_(dtr + dtbv); sdt[tid] = dv; sdec[tid] = __expf(dv * (-__expf(alg))); } }
    sync_threads();
    const int n4 = tid & 31, pr_ = tid >> 5;
    const f32x4 Bv = *(const LAS f32x4*)(sB + 4 * n4), Cv = *(const LAS f32x4*)(sC + 4 * n4);
    float* op = state_out + ((size_t)(b * 32 + grp * 4)) * 8192 + tid * 4;
    const int bgn = bg_next >= 0 ? bg_next : bg; const float* np = state_in + ((size_t)((bgn >> 3) * 32 + (bgn & 7) * 4)) * 8192 + tid * 4;
#pragma unroll
    for (int it = 0; it < 16; ++it) { const int k = it >> 2, p = (it & 3) * 16 + pr_; const float xdt = sx[k * 64 + p] * sdt[k];
        const f32x4 hn = st[it] * sdec[k] + Bv * xdt; LAUNDER_PTR(op); *(f32x4*)op = hn; op += 2048;
        LAUNDER_PTR(np); if (bg_next >= 0) st[it] = *(const f32x4*)np; np += 2048;
        const f32x4 t = hn * Cv; float y = (t[0] + t[1]) + (t[2] + t[3]); y = row32_sum(y);
        if ((lane & 31) == 0) sy[k * 64 + p] = y; }
    sync_threads();
    float yv = 0.f;
    if (tid < 256) { const int k = tid >> 6; const float z = bf2f(proj[row * LDP + PC_Z + grp * 256 + tid]);
        yv = (sy[tid] + d_skip[grp * 4 + k] * sx[tid]) * siluf_(z);
        float ss = yv * yv; ss = row32_sum(ss); if ((lane & 31) == 0) sred[tid >> 5] = ss; }
    sync_threads();
    if (tid < 256) { float tot = 0.f;
#pragma unroll
        for (int r = 0; r < 8; ++r) tot += sred[r];
        ybuf[row * 2048 + grp * 256 + tid] = f2bf(yv * rsqrtf(tot * (1.f / 256.f) + EPS) * ssm_norm[grp * 256 + tid]); }
    sync_threads();
    (void)w;
}

static_assert(SD_END <= LDS_BYTES - 256, "LDS map");
static_assert(8 * 16384 <= LDS_BYTES - 256, "skinny LDS");
constexpr int SK_PART = 128 * 32 * 4;
template <int RT, class Epi>
__device__ __forceinline__ void skinny_gemm(const bf16* A, size_t lda, const bf16* Bt, int K, int N, const Epi& epi, int wg, int wg_first, int wg_count, int tid, LAS unsigned char* lds) {
    const int lane = tid & 63, w = tid >> 6, c = lane & 15, g = lane >> 4;
    constexpr int NRG = 8 / RT;
    const int nunit = (N / 32) * NRG, ksteps = K / 256;
    int me = wg - wg_first; if (me < 0 || me >= wg_count) return;
    for (int s = me; s < nunit; s += wg_count) {
        const int n0 = 32 * (s / NRG), r0 = (s % NRG) * (16 * RT);
        f32x4 acc[RT][2];
#pragma unroll
        for (int rt = 0; rt < RT; ++rt) { acc[rt][0] = (f32x4){0.f, 0.f, 0.f, 0.f}; acc[rt][1] = (f32x4){0.f, 0.f, 0.f, 0.f}; }
        const bf16* ap = A + (size_t)(r0 + c) * lda + (size_t)w * (K / 8) + 8 * g;
        const bf16* bp = Bt + (size_t)(n0 + c) * K + (size_t)w * (K / 8) + 8 * g;
#pragma unroll 4
        for (int ks = 0; ks < ksteps; ++ks) {
            bf16x8 af[RT], bfr[2];
#pragma unroll
            for (int rt = 0; rt < RT; ++rt) af[rt] = *(const bf16x8*)(ap + (size_t)(16 * rt) * lda + 32 * ks);
            bfr[0] = *(const bf16x8*)(bp + 32 * ks); bfr[1] = *(const bf16x8*)(bp + (size_t)16 * K + 32 * ks);
#pragma unroll
            for (int rt = 0; rt < RT; ++rt) { acc[rt][0] = mfma16(af[rt], bfr[0], acc[rt][0]); acc[rt][1] = mfma16(af[rt], bfr[1], acc[rt][1]); }
        }
        LAS float* part = (LAS float*)(lds + w * SK_PART);
#pragma unroll
        for (int rt = 0; rt < RT; ++rt)
#pragma unroll
            for (int nt = 0; nt < 2; ++nt)
#pragma unroll
                for (int r = 0; r < 4; ++r) part[(16 * rt + 4 * g + r) * 32 + 16 * nt + c] = acc[rt][nt][r];
        sync_threads();
        if (RT == 8 || tid < 64 * RT) {
            const int row = tid >> 2, c8 = (tid & 3) * 8;
            f32x4 v0 = (f32x4){0.f, 0.f, 0.f, 0.f}, v1 = (f32x4){0.f, 0.f, 0.f, 0.f};
#pragma unroll
            for (int ww = 0; ww < 8; ++ww) { const LAS float* pp = (const LAS float*)(lds + ww * SK_PART) + row * 32 + c8; v0 = v0 + *(const LAS f32x4*)pp; v1 = v1 + *(const LAS f32x4*)(pp + 4); }
            epi(r0 + row, n0 + c8, v0, v1);
        }
        sync_threads();
        if constexpr (Epi::POST) epi.post(r0, tid, lds);
    }
}
struct SkStoreBf16 { static constexpr bool POST = false; bf16* O; int ld; int act;
    __device__ __forceinline__ void operator()(int row, int col, f32x4 v0, f32x4 v1) const {
        if (act) {
#pragma unroll
            for (int j = 0; j < 4; ++j) { const float a = fmaxf(v0[j], 0.f), b = fmaxf(v1[j], 0.f); v0[j] = a * a; v1[j] = b * b; } }
        v4u o; o.x = pk2(v0[0], v0[1]); o.y = pk2(v0[2], v0[3]); o.z = pk2(v1[0], v1[1]); o.w = pk2(v1[2], v1[3]);
        *(v4u*)(O + (size_t)row * ld + col) = o; } };
__device__ __forceinline__ void sk_unpack8(const v4u w, f32x4& lo, f32x4& hi) {
    lo = (f32x4){__uint_as_float(w.x << 16), __uint_as_float(w.x & 0xffff0000u), __uint_as_float(w.y << 16), __uint_as_float(w.y & 0xffff0000u)};
    hi = (f32x4){__uint_as_float(w.z << 16), __uint_as_float(w.z & 0xffff0000u), __uint_as_float(w.w << 16), __uint_as_float(w.w & 0xffff0000u)}; }
struct SkGateA { static constexpr bool POST = false; bf16* T; const bf16* G; int ldg; const float* bm;
    __device__ __forceinline__ void operator()(int row, int col, f32x4 v0, f32x4 v1) const {
        f32x4 g0, g1; sk_unpack8(*(const v4u*)(G + (size_t)row * ldg + col), g0, g1);
        const f32x4 b0 = *(const f32x4*)(bm + col), b1 = *(const f32x4*)(bm + col + 4);
#pragma unroll
        for (int j = 0; j < 4; ++j) { v0[j] *= sigmoidf_(g0[j] + b0[j]); v1[j] *= sigmoidf_(g1[j] + b1[j]); }
        v4u o; o.x = pk2(v0[0], v0[1]); o.y = pk2(v0[2], v0[3]); o.z = pk2(v1[0], v1[1]); o.w = pk2(v1[2], v1[3]);
        *(v4u*)(T + (size_t)row * 1024 + col) = o; } };
struct SkGateB { static constexpr bool POST = false; const bf16* T; bf16* U; const bf16* G; int ldg; const float* bm;
    __device__ __forceinline__ void operator()(int row, int col, f32x4 v0, f32x4 v1) const {
        f32x4 g0, g1; sk_unpack8(*(const v4u*)(G + (size_t)row * ldg + col), g0, g1);
        const f32x4 b0 = *(const f32x4*)(bm + col), b1 = *(const f32x4*)(bm + col + 4);
        f32x4 t0, t1; sk_unpack8(*(const v4u*)(T + (size_t)row * 1024 + col), t0, t1);
#pragma unroll
        for (int j = 0; j < 4; ++j) { v0[j] = t0[j] + v0[j] * sigmoidf_(g0[j] + b0[j]); v1[j] = t1[j] + v1[j] * sigmoidf_(g1[j] + b1[j]); }
        v4u o; o.x = pk2(v0[0], v0[1]); o.y = pk2(v0[2], v0[3]); o.z = pk2(v1[0], v1[1]); o.w = pk2(v1[2], v1[3]);
        *(v4u*)(U + (size_t)row * 1024 + col) = o; } };
struct SkRes { static constexpr bool POST = false; bf16* X; const float* gate; int ldgate;
    __device__ __forceinline__ void operator()(int row, int col, f32x4 v0, f32x4 v1) const {
        const float* gp = gate + (size_t)row * ldgate + col; bf16* xp = X + (size_t)row * 1024 + col;
        f32x4 x0, x1; sk_unpack8(*(const v4u*)xp, x0, x1);
        const f32x4 o0 = x0 + *(const f32x4*)gp * v0, o1 = x1 + *(const f32x4*)(gp + 4) * v1;
        v4u o; o.x = pk2(o0[0], o0[1]); o.y = pk2(o0[2], o0[3]); o.z = pk2(o1[0], o1[1]); o.w = pk2(o1[2], o1[3]); *(v4u*)xp = o; } };

template <int TB>
__device__ __forceinline__ void hgrn_seq(const bf16* proj, const float* lbs_l, const float* hgn_l, const float* state_in, float* state_out, bf16* ohg, int row_base, int T, int bh, int tid,
                                         LAS unsigned char* smem) {
    const int b = bh >> 3, h = bh & 7, lane = tid & 63, wv = tid >> 6;
    typedef float (LAS * arr_t)[128];
    arr_t sQ = (arr_t)(smem), sG = (arr_t)(smem + TB * 512), sK = (arr_t)(smem + 2 * TB * 512);
    LAS float* sRed = (LAS float*)(smem + 3 * TB * 512);
    float S[128];
    if (state_in) {
        const float* sp = state_in + (size_t)bh * 16384 + tid;
#pragma unroll
        for (int c = 0; c < 16; ++c) { asm volatile("" : "+v"(sp));
#pragma unroll
            for (int j = 0; j < 8; ++j) S[c * 8 + j] = sp[j * 128];
            sp += 1024; }
    } else {
#pragma unroll
        for (int d = 0; d < 128; ++d) S[d] = 0.f;
    }
    const float lb = lbs_l[h * 128 + tid], hn = hgn_l[tid];
    for (int t0 = 0; t0 < T; t0 += TB) {
        float v[TB], og[TB], o[TB];
#pragma unroll
        for (int tt = 0; tt < TB; ++tt) { v[tt] = 0.f; og[tt] = 0.f;
            if (t0 + tt < T) { const bf16* pr = proj + (size_t)(row_base + b * T + t0 + tt) * LDP + h * 128 + tid;
                const float q = bf2f(pr[PC_Q]), f = bf2f(pr[PC_F]); v[tt] = bf2f(pr[PC_I + hg_vpos(tid) - tid]); og[tt] = bf2f(pr[PC_OG]);
                const float fg = lb + (1.f - lb) * sigmoidf_(f);
                sQ[tt][tid] = siluf_(q) * 0.08838834764831845f; sG[tt][tid] = fg; sK[tt][tid] = 1.f - fg; } }
        __syncthreads();
#pragma unroll
        for (int tt = 0; tt < TB; ++tt) { float acc = 0.f;
            if (t0 + tt < T) { const float vv = v[tt];
#pragma unroll
                for (int d4 = 0; d4 < 32; ++d4) { const f32x4 g = *(const LAS f32x4*)&sG[tt][d4 * 4], k = *(const LAS f32x4*)&sK[tt][d4 * 4], q = *(const LAS f32x4*)&sQ[tt][d4 * 4];
                    S[d4 * 4 + 0] = g.x * S[d4 * 4 + 0] + k.x * vv; acc += q.x * S[d4 * 4 + 0];
                    S[d4 * 4 + 1] = g.y * S[d4 * 4 + 1] + k.y * vv; acc += q.y * S[d4 * 4 + 1];
                    S[d4 * 4 + 2] = g.z * S[d4 * 4 + 2] + k.z * vv; acc += q.z * S[d4 * 4 + 2];
                    S[d4 * 4 + 3] = g.w * S[d4 * 4 + 3] + k.w * vv; acc += q.w * S[d4 * 4 + 3]; } }
            o[tt] = acc;
            const float ss = wave_sum(acc * acc); if (lane == 0) sRed[tt * 2 + wv] = ss; }
        __syncthreads();
#pragma unroll
        for (int tt = 0; tt < TB; ++tt) if (t0 + tt < T) { const float rstd = rsqrtf((sRed[tt * 2] + sRed[tt * 2 + 1]) * (1.f / 128.f) + EPS);
            ohg[(size_t)(row_base + b * T + t0 + tt) * 1024 + h * 128 + tid] = f2bf(o[tt] * rstd * hn * siluf_(og[tt])); }
        __syncthreads();
    }
    { float* sp = state_out + (size_t)bh * 16384 + tid;
#pragma unroll
      for (int c = 0; c < 16; ++c) { asm volatile("" : "+v"(sp));
#pragma unroll
          for (int j = 0; j < 8; ++j) sp[j * 128] = S[c * 8 + j];
          sp += 1024; } }
}

template <int TB>
__device__ __forceinline__ void ssd_seq(const bf16* proj, const float* conv_w, const float* conv_b, const float* dt_bias, const float* a_log, const float* d_skip, const float* ssm_norm,
                                        const float* state_in, const float* conv_in, float* state_out, float* conv_out, bf16* ybuf, int row_base, int T, int bg, int tid, LAS unsigned char* smem) {
    const int b = bg >> 3, g = bg & 7, lane = tid & 63, wv = tid >> 6, head = g * 4 + wv;
    const int ch_x = g * 256 + tid, ch_bc = tid < 128 ? (2048 + g * 128 + tid) : (3072 + g * 128 + (tid - 128));
    typedef float (LAS * arr_t)[128];
    arr_t sB = (arr_t)(smem), sC = (arr_t)(smem + TB * 512);
    LAS float* sRed = (LAS float*)(smem + 2 * TB * 512);
    const float wx0 = conv_w[0 * 4096 + ch_x], wx1 = conv_w[1 * 4096 + ch_x], wx2 = conv_w[2 * 4096 + ch_x], wx3 = conv_w[3 * 4096 + ch_x], bx = conv_b[ch_x];
    const float wb0 = conv_w[0 * 4096 + ch_bc], wb1 = conv_w[1 * 4096 + ch_bc], wb2 = conv_w[2 * 4096 + ch_bc], wb3 = conv_w[3 * 4096 + ch_bc], bb = conv_b[ch_bc];
    float rx0 = 0.f, rx1 = 0.f, rx2 = 0.f, rb0 = 0.f, rb1 = 0.f, rb2 = 0.f;
    if (conv_in) { const float* ci = conv_in + (size_t)b * 3 * 4096; rx0 = ci[ch_x]; rx1 = ci[4096 + ch_x]; rx2 = ci[8192 + ch_x]; rb0 = ci[ch_bc]; rb1 = ci[4096 + ch_bc]; rb2 = ci[8192 + ch_bc]; }
    float hs[128];
    const size_t sbase = (((size_t)b * 32 + head) * 64 + lane) * 128;
    if (state_in) {
#pragma unroll
        for (int n4 = 0; n4 < 32; ++n4) { const f32x4 t = *(const f32x4*)(state_in + sbase + n4 * 4); hs[n4 * 4] = t.x; hs[n4 * 4 + 1] = t.y; hs[n4 * 4 + 2] = t.z; hs[n4 * 4 + 3] = t.w; }
    } else {
#pragma unroll
        for (int n = 0; n < 128; ++n) hs[n] = 0.f;
    }
    const float A = -expf(a_log[head]), dtb = dt_bias[head], Dk = d_skip[head], nw = ssm_norm[ch_x];
    for (int t0 = 0; t0 < T; t0 += TB) {
        float xc[TB], dtv[TB], dec[TB], zz[TB], yv[TB];
#pragma unroll
        for (int tt = 0; tt < TB; ++tt) { xc[tt] = 0.f; dtv[tt] = 0.f; dec[tt] = 1.f; zz[tt] = 0.f;
            if (t0 + tt < T) { const bf16* pr = proj + (size_t)(row_base + b * T + t0 + tt) * LDP;
                const float cx = bf2f(pr[PC_XBC + ch_x]), cb = bf2f(pr[PC_XBC + ch_bc]);
                const float ax = bx + wx0 * rx0 + wx1 * rx1 + wx2 * rx2 + wx3 * cx; rx0 = rx1; rx1 = rx2; rx2 = cx; xc[tt] = siluf_(ax);
                const float ab = bb + wb0 * rb0 + wb1 * rb1 + wb2 * rb2 + wb3 * cb; rb0 = rb1; rb1 = rb2; rb2 = cb;
                const float sbv = siluf_(ab); if (tid < 128) sB[tt][tid] = sbv; else sC[tt][tid - 128] = sbv;
                const float dv = softplusf_(bf2f(pr[PC_DT + head]) + dtb); dtv[tt] = dv; dec[tt] = __expf(dv * A); zz[tt] = bf2f(pr[PC_Z + ch_x]); } }
        __syncthreads();
#pragma unroll
        for (int tt = 0; tt < TB; ++tt) { float y = 0.f;
            if (t0 + tt < T) { const float xdt = xc[tt] * dtv[tt], dc = dec[tt];
#pragma unroll
                for (int n4 = 0; n4 < 32; ++n4) { const f32x4 bv = *(const LAS f32x4*)&sB[tt][n4 * 4], cv = *(const LAS f32x4*)&sC[tt][n4 * 4];
                    hs[n4 * 4 + 0] = dc * hs[n4 * 4 + 0] + xdt * bv.x; y += hs[n4 * 4 + 0] * cv.x;
                    hs[n4 * 4 + 1] = dc * hs[n4 * 4 + 1] + xdt * bv.y; y += hs[n4 * 4 + 1] * cv.y;
                    hs[n4 * 4 + 2] = dc * hs[n4 * 4 + 2] + xdt * bv.z; y += hs[n4 * 4 + 2] * cv.z;
                    hs[n4 * 4 + 3] = dc * hs[n4 * 4 + 3] + xdt * bv.w; y += hs[n4 * 4 + 3] * cv.w; }
                y = (y + Dk * xc[tt]) * siluf_(zz[tt]); }
            yv[tt] = y;
            const float ss = wave_sum(y * y); if (lane == 0) sRed[tt * 4 + wv] = ss; }
        __syncthreads();
#pragma unroll
        for (int tt = 0; tt < TB; ++tt) if (t0 + tt < T) { const float rstd = rsqrtf(((sRed[tt * 4] + sRed[tt * 4 + 1]) + (sRed[tt * 4 + 2] + sRed[tt * 4 + 3])) * (1.f / 256.f) + EPS);
            ybuf[(size_t)(row_base + b * T + t0 + tt) * 2048 + ch_x] = f2bf(yv[tt] * rstd * nw); }
        __syncthreads();
    }
#pragma unroll
    for (int n4 = 0; n4 < 32; ++n4) *(f32x4*)(state_out + sbase + n4 * 4) = (f32x4){hs[n4 * 4], hs[n4 * 4 + 1], hs[n4 * 4 + 2], hs[n4 * 4 + 3]};
    float* co = conv_out + (size_t)b * 3 * 4096;
    co[ch_x] = rx0; co[4096 + ch_x] = rx1; co[8192 + ch_x] = rx2; co[ch_bc] = rb0; co[4096 + ch_bc] = rb1; co[8192 + ch_bc] = rb2;
}

#ifndef REP_G
#define REP_G 1
#endif
#ifndef REP_R2
#define REP_R2 1
#endif
#ifndef REP_R1
#define REP_R1 1
#endif
#ifndef REP_N
#define REP_N 1
#endif
#ifndef REP_P
#define REP_P 1
#endif
#ifndef REP_H2
#define REP_H2 1
#endif
#ifndef REP_S2
#define REP_S2 1
#endif
#ifndef REP_S1
#define REP_S1 1
#endif
#ifndef REP_SS
#define REP_SS 1
#endif
#ifndef REP_BAR
#define REP_BAR 0
#endif
__device__ __forceinline__ void phase_recur1(const P& p, int l, LAS unsigned char* lds, int tid_in, int skip_hgrn1) {
    unsigned char* ws = p.ws; asm volatile("" : "+s"(ws)); int tid_ = tid_in; asm volatile("" : "+v"(tid_)); const int tid = tid_, G = gridDim.x, wg = blockIdx.x;
    RecurBufs rb{(bf16*)(ws + WS_PROJ), (bf16*)(ws + WS_XBCC), (float*)(ws + WS_DTV), (float*)(ws + WS_CUM), (float*)(ws + WS_CV), (float*)(ws + WS_SSEG), (float*)(ws + WS_DSEG),
                 (float*)(ws + WS_HSEG), (float*)(ws + WS_TSEG), (bf16*)(ws + WS_OHG), (bf16*)(ws + WS_Y)};
    const float* lbs_l = (const float*)(ws + WS_LBS) + l * 1024; float* out = p.out;
    const float* hgn = p.in[I_HGN] + l * HG_DV;
    const float* cw = p.in[I_CONVW] + (size_t)l * 4 * SSM_CH; const float* cb = p.in[I_CONVB] + l * SSM_CH; const float* dtb = p.in[I_DTB] + l * SSM_HEADS;
    const float* alog = p.in[I_ALOG] + l * SSM_HEADS; const float* dsk = p.in[I_DSKIP] + l * SSM_HEADS; const float* ssmn = p.in[I_SSMN] + l * SSM_INNER;
#define TID_L() int tl_ = tid; asm volatile("" : "+v"(tl_)); const int t = tl_
#define R1_PROMPT() do { \
        if (!skip_hgrn1) for (int u = wg; u < 256; u += G) { TID_L(); hgrn_pass1(rb, lbs_l, u, t, lds); } \
        for (int rep = 0; rep < REP_S1; ++rep) for (int u = wg; u < 256; u += G) { TID_L(); ssd_pass1(rb, cw, cb, dtb, alog, out + O_CVP + (size_t)l * NB * 3 * SSM_CH, u, t, lds); } } while (0)
#define R1_SAMPLE() do { for (int rep = 0; rep < REP_SS; ++rep) { \
        {   const float* shg = p.in[I_SHG] + (size_t)l * NSB * HG_H * HG_DK * HG_DV; f32x4 sa[8];        \
            if (wg < NSB * HG_H) { TID_L(); hgrn_sample_load(sa, shg, wg, t); } \
            for (int u = wg; u < NSB * HG_H; u += G) { TID_L(); const int un = u + G < NSB * HG_H ? u + G : -1; \
                hgrn_sample_step(rb.proj, lbs_l, hgn, shg, out + O_HGS + (size_t)l * NSB * HG_H * HG_DK * HG_DV, rb.ohg, u, t, lds, sa, un); } } \
        {   const float* sss = p.in[I_SSSM] + (size_t)l * NSB * SSM_HEADS * SSM_P * SSM_N; f32x4 sa[16]; \
            if (wg < NSB * SSM_G) { TID_L(); ssd_sample_load(sa, sss, wg, t); } \
            for (int u = wg; u < NSB * SSM_G; u += G) { TID_L(); const int un = u + G < NSB * SSM_G ? u + G : -1; \
                ssd_sample_step(rb.proj, cw, cb, dtb, alog, dsk, ssmn, sss, p.in[I_SCONV] + (size_t)l * NSB * 3 * SSM_CH, \
                                out + O_SSMS + (size_t)l * NSB * SSM_HEADS * SSM_P * SSM_N, out + O_CVS + (size_t)l * NSB * 3 * SSM_CH, rb.y, u, t, lds, sa, un); } } } } while (0)
    if (((wg >> 3) & 1) == 0) { R1_PROMPT(); R1_SAMPLE(); } else { R1_SAMPLE(); R1_PROMPT(); }
#undef R1_PROMPT
#undef R1_SAMPLE
}
__device__ __forceinline__ void phase_recur2(const P& p, int l, LAS unsigned char* lds, int tid_in) {
    unsigned char* ws = p.ws; asm volatile("" : "+s"(ws)); int tid_ = tid_in; asm volatile("" : "+v"(tid_)); const int tid = tid_, G = gridDim.x, wg = blockIdx.x;
    RecurBufs rb{(bf16*)(ws + WS_PROJ), (bf16*)(ws + WS_XBCC), (float*)(ws + WS_DTV), (float*)(ws + WS_CUM), (float*)(ws + WS_CV), (float*)(ws + WS_SSEG), (float*)(ws + WS_DSEG),
                 (float*)(ws + WS_HSEG), (float*)(ws + WS_TSEG), (bf16*)(ws + WS_OHG), (bf16*)(ws + WS_Y)};
    float* out = p.out;
    for (int rep = 0; rep < REP_H2; ++rep) for (int u = wg; u < 256; u += G) { TID_L(); hgrn_pass2(rb, p.in[I_HGN] + l * HG_DV, out + O_HGP + (size_t)l * NB * HG_H * HG_DK * HG_DV, u, t, lds); }
    for (int rep = 0; rep < REP_S2; ++rep) for (int u = wg; u < 256; u += G) { TID_L(); ssd_pass2(rb, p.in[I_DSKIP] + l * SSM_HEADS, p.in[I_SSMN] + l * SSM_INNER, out + O_SSMP + (size_t)l * NB * SSM_HEADS * SSM_P * SSM_N, u ^ 3, t, lds); }
}

constexpr size_t WS_SLOT = WS_LBS + 512 * 1024;
constexpr int CW_PCNT = 16384, CW_SCNT = 24576;
#define AGENT_ST(p, v) __hip_atomic_store((p), (v), __ATOMIC_RELAXED, __HIP_MEMORY_SCOPE_AGENT)
#define AGENT_LD(p) __hip_atomic_load((p), __ATOMIC_RELAXED, __HIP_MEMORY_SCOPE_AGENT)
template <int MODE>
struct EpiResNorm {
    static constexpr bool PERM = true, AFTER_DRAIN = true;
    bf16* X; const float* gate; int ldgate;
    bf16* H; float* out32; const float* nw; const float* msh; const float* msc;
    float* slots; unsigned* cnt; unsigned target;
    __device__ __forceinline__ void operator()(const f32x4 (&)[2][2][4][2], const pg8::Unit&, int, int, int, int) const {}
    __device__ __forceinline__ void fused(f32x4 (&acc)[2][2][4][2], const pg8::Unit& u, int wr, int wc, int fr, int fq, LAS unsigned char* lds, int wid, int lane) const {
        constexpr int HALF = pg8::HALF, BM = pg8::BM;
        const int tid = wid * 64 + lane;
        const int row0 = u.pm * BM + wr * 64 + fr, col0 = u.pn * BM + wc * 32 + 8 * fq;
        const size_t brow = (size_t)((u.pm * BM) >> 11) * ldgate;
        {   const float* gp = gate + brow + col0;
            f32x4 gv[2][2];
#pragma unroll
            for (int bj = 0; bj < 2; ++bj)
#pragma unroll
                for (int n = 0; n < 2; ++n) gv[bj][n] = *(const f32x4*)(gp + bj * HALF + 4 * n);
#pragma unroll
            for (int ai = 0; ai < 2; ++ai)
#pragma unroll
                for (int m = 0; m < 4; ++m) { const bf16* xp = X + (size_t)(row0 + ai * HALF + m * 16) * 1024 + col0;
#pragma unroll
                    for (int bj = 0; bj < 2; ++bj) { f32x4 x0, x1; sk_unpack8(*(const v4u*)(xp + bj * HALF), x0, x1);
                        acc[ai][bj][m][0] = x0 + gv[bj][0] * acc[ai][bj][m][0]; acc[ai][bj][m][1] = x1 + gv[bj][1] * acc[ai][bj][m][1]; } }
        }
        LAS float* part = (LAS float*)lds;
        LAS float* rs = (LAS float*)(lds + 4096);
#pragma unroll
        for (int ai = 0; ai < 2; ++ai)
#pragma unroll
            for (int m = 0; m < 4; ++m) { float s = 0.f;
#pragma unroll
                for (int bj = 0; bj < 2; ++bj)
#pragma unroll
                    for (int n = 0; n < 2; ++n) { const f32x4 o = acc[ai][bj][m][n]; s += (o.x * o.x + o.y * o.y) + (o.z * o.z + o.w * o.w); }
                s += swz_xor<16>(s); s = xor32_sum(s);
                if (fq == 0) part[wc * 256 + ai * HALF + wr * 64 + m * 16 + fr] = s; }
        __syncthreads();
        if (tid < 256) { const float t = (part[tid] + part[256 + tid]) + (part[512 + tid] + part[768 + tid]);
            AGENT_ST(slots + ((size_t)(u.pm * 256 + tid) * 4 + u.pn), t); }
        asm volatile("s_waitcnt vmcnt(0)" ::: "memory");
        __syncthreads();
        if (tid == 0) { unsigned* c = cnt + u.pm * 64; (void)__hip_atomic_fetch_add(c, 1u, __ATOMIC_RELAXED, __HIP_MEMORY_SCOPE_AGENT);
            unsigned sp = 0u; while (AGENT_LD(c) < target) { __builtin_amdgcn_s_sleep(1); if (++sp > (1u << 21)) break; } }
        __syncthreads();
        if (tid < 256) { const float* sp_ = slots + (size_t)(u.pm * 256 + tid) * 4;
            const float t0 = AGENT_LD(sp_), t1 = AGENT_LD(sp_ + 1), t2 = AGENT_LD(sp_ + 2), t3 = AGENT_LD(sp_ + 3);
            rs[tid] = rsqrtf(((t0 + t1) + (t2 + t3)) * (1.f / D) + EPS); }
        {   f32x4 mulv[2][2], shv[2][2];
#pragma unroll
            for (int bj = 0; bj < 2; ++bj)
#pragma unroll
                for (int n = 0; n < 2; ++n) { const int c = col0 + bj * HALF + 4 * n; const f32x4 w4 = *(const f32x4*)(nw + c);
                    if constexpr (MODE == 0) { mulv[bj][n] = w4 * (*(const f32x4*)(msc + brow + c) + 1.0f); shv[bj][n] = *(const f32x4*)(msh + brow + c); }
                    else { mulv[bj][n] = w4; shv[bj][n] = (f32x4){0.f, 0.f, 0.f, 0.f}; } }
#pragma unroll
            for (int ai = 0; ai < 2; ++ai)
#pragma unroll
                for (int m = 0; m < 4; ++m) { bf16* xp = X + (size_t)(row0 + ai * HALF + m * 16) * 1024 + col0;
#pragma unroll
                    for (int bj = 0; bj < 2; ++bj) { const f32x4 o0 = acc[ai][bj][m][0], o1 = acc[ai][bj][m][1];
                        v4u ow; ow.x = pk2(o0[0], o0[1]); ow.y = pk2(o0[2], o0[3]); ow.z = pk2(o1[0], o1[1]); ow.w = pk2(o1[2], o1[3]); *(v4u*)(xp + bj * HALF) = ow; } }
            __syncthreads();
#pragma unroll
            for (int ai = 0; ai < 2; ++ai)
#pragma unroll
                for (int m = 0; m < 4; ++m) { const int rl = ai * HALF + wr * 64 + m * 16 + fr; const float r = rs[rl]; const size_t ro = (size_t)(u.pm * BM + rl) * 1024 + col0;
#pragma unroll
                    for (int bj = 0; bj < 2; ++bj) { const f32x4 y0 = acc[ai][bj][m][0] * r * mulv[bj][0] + shv[bj][0], y1 = acc[ai][bj][m][1] * r * mulv[bj][1] + shv[bj][1];
                        if constexpr (MODE == 0) { v4u ow; ow.x = pk2(y0[0], y0[1]); ow.y = pk2(y0[2], y0[3]); ow.z = pk2(y1[0], y1[1]); ow.w = pk2(y1[2], y1[3]); *(v4u*)(H + ro + bj * HALF) = ow; }
                        else { *(f32x4*)(out32 + ro + bj * HALF) = y0; *(f32x4*)(out32 + ro + bj * HALF + 4) = y1; } } }
        }
        __syncthreads();
    }
};
template <int MODE>
struct SkResNorm { static constexpr bool POST = true;
    bf16* X; const float* gate; int ldgate;
    bf16* H; float* out32; const float* nw; const float* msh; const float* msc;
    unsigned* cnt; unsigned target;
    __device__ __forceinline__ void operator()(int row, int col, f32x4 v0, f32x4 v1) const {
        const float* gp = gate + (size_t)row * ldgate + col; bf16* xp = X + (size_t)row * 1024 + col;
        f32x4 x0, x1; sk_unpack8(*(const v4u*)xp, x0, x1);
        const f32x4 o0 = x0 + *(const f32x4*)gp * v0, o1 = x1 + *(const f32x4*)(gp + 4) * v1;
        unsigned long long* x8 = (unsigned long long*)xp;
        AGENT_ST(x8, (unsigned long long)pk2(o0[0], o0[1]) | ((unsigned long long)pk2(o0[2], o0[3]) << 32));
        AGENT_ST(x8 + 1, (unsigned long long)pk2(o1[0], o1[1]) | ((unsigned long long)pk2(o1[2], o1[3]) << 32)); }
    __device__ __forceinline__ void post(int r0, int tid, LAS unsigned char* lds) const {
        asm volatile("s_waitcnt vmcnt(0)" ::: "memory"); __syncthreads();
        volatile LAS unsigned* fl = (volatile LAS unsigned*)(lds + 8 * SK_PART);
        if (tid == 0) fl[0] = __hip_atomic_fetch_add(cnt + (r0 >> 4) * 64, 1u, __ATOMIC_RELAXED, __HIP_MEMORY_SCOPE_AGENT);
        __syncthreads();
        const unsigned old = fl[0];
        if (old + 1u == target) {
            const int lane = tid & 63, w = tid >> 6;
            f32x4 w4[4];
#pragma unroll
            for (int j = 0; j < 4; ++j) w4[j] = ((const f32x4*)nw)[lane + 64 * j];
#pragma unroll 1
            for (int rr = 0; rr < 2; ++rr) { const int row = r0 + 2 * w + rr;
                const unsigned long long* xr = (const unsigned long long*)(X + (size_t)row * D) + lane;
                f32x4 v[4]; float s = 0.f;
#pragma unroll
                for (int j = 0; j < 4; ++j) { v[j] = unpack4(AGENT_LD(xr + 64 * j)); s += (v[j].x * v[j].x + v[j].y * v[j].y) + (v[j].z * v[j].z + v[j].w * v[j].w); }
                const float rstd = rsqrtf(wave_sum(s) * (1.f / D) + EPS);
                if constexpr (MODE == 0) { const f32x4* shp = (const f32x4*)(msh + (size_t)row * ldgate) + lane; const f32x4* scp = (const f32x4*)(msc + (size_t)row * ldgate) + lane;
                    unsigned long long* o8 = (unsigned long long*)(H + (size_t)row * D) + lane;
#pragma unroll
                    for (int j = 0; j < 4; ++j) { const f32x4 y = v[j] * rstd * w4[j] * (scp[64 * j] + 1.0f) + shp[64 * j]; o8[64 * j] = (unsigned long long)pk2(y.x, y.y) | ((unsigned long long)pk2(y.z, y.w) << 32); }
                } else { f32x4* o = (f32x4*)(out32 + (size_t)row * D) + lane;
#pragma unroll
                    for (int j = 0; j < 4; ++j) o[64 * j] = v[j] * rstd * w4[j]; }
            }
        }
        __syncthreads();
    }
};


constexpr int CW_BAR = 4096;
constexpr int MISC_OFF = LDS_BYTES - 256;

__global__ __launch_bounds__(NTHREADS, 2) void k_mega(P p) {
    extern __shared__ __attribute__((aligned(16))) unsigned char shm[];
    LAS unsigned char* lds = (LAS unsigned char*)shm;
    const int wave_u = __builtin_amdgcn_readfirstlane((int)threadIdx.x >> 6);
#define TID() ({ int t__; asm volatile("v_mbcnt_lo_u32_b32 %0, -1, 0\n\tv_mbcnt_hi_u32_b32 %0, -1, %0" : "=v"(t__)); (wave_u << 6) | t__; })
    const int G = gridDim.x, NGW = G * NWAVES;
    unsigned char* ws = p.ws;
#define LANE_GW() int t_ = TID(); asm volatile("" : "+v"(t_)); const int ln = t_ & 63, wv = __builtin_amdgcn_readfirstlane(t_ >> 6), gwv = blockIdx.x * NWAVES + wv; (void)wv
    volatile LAS unsigned* MISC = (volatile LAS unsigned*)(lds + MISC_OFF);
    if (TID() < 16) MISC[TID()] = 0u;
    __syncthreads();
    XcdBarrier bar = xcd_barrier_post((unsigned*)(ws + WS_CTL) + CW_BAR, MISC + 8, TID());
#define WSL() ({ unsigned char* w_ = ws; asm volatile("" : "+s"(w_)); w_; })

    for (int rep = 0; rep < REP_P; ++rep) {   LANE_GW(); phase_prologue(p, lds, gwv, NGW, ln, wv); }
    xcd_barrier(bar, TID());
    {   unsigned char* w = WSL();
        pg8::Gemm g{(const bf16*)(w + WS_AC), (const bf16*)(w + WS_WADA), 256, MODLD, D}; pg8::StaticOrder S; S.init(256, MODLD, G, (int)blockIdx.x);
        pg8::EpiF32 E{(float*)(w + WS_MOD), MODLD, p.in[I_BADA]};
        pg8::gemm_phase<pg8::EpiF32, pg8::StaticOrder>(lds, g, S, E, nullptr, TID()); }
    xcd_barrier(bar, TID());
    for (int li = 0; li < DEPTH; ++li) {
        int l = li; asm volatile("" : "+s"(l));
        if (l == 0) {
            {   unsigned char* w = WSL(); const float* mod_l = (const float*)(w + WS_MOD);
                LANE_GW(); phase_norm<1>(p.in[I_XP], p.in[I_XS], (bf16*)(w + WS_X), (bf16*)(w + WS_H), p.in[I_NMIX], mod_l + 0 * D, mod_l + 1 * D, gwv, NGW, ln); }
            xcd_barrier(bar, TID());
        }
        for (int rep = 0; rep < REP_G; ++rep) { if (rep) xcd_barrier(bar, TID());
        {   unsigned char* w = WSL(); const unsigned char* wl = w + WS_W + (size_t)l * W_LSTRIDE;
            pg8::Gemm g{(const bf16*)(w + WS_H), (const bf16*)(wl + WO_IN), MP, LDP, D}; pg8::StaticOrder S; S.init(MP, LDP, G, (int)blockIdx.x);
            pg8::EpiBf16<0> E{(bf16*)(w + WS_PROJ), LDP};
            pg8::gemm_phase<pg8::EpiBf16<0>, pg8::StaticOrder>(lds, g, S, E, nullptr, TID());
            const int skf = G > 64 ? 64 : 0, skn = G > 64 ? G - 64 : G; skinny_gemm<8>((const bf16*)(w + WS_H) + (size_t)MP * D, D, (const bf16*)(wl + WO_IN), D, LDP, SkStoreBf16{(bf16*)(w + WS_PROJ) + (size_t)MP * LDP, LDP, 0}, (int)blockIdx.x, skf, skn, TID(), lds); } }
        xcd_barrier(bar, TID());
        for (int rep = 0; rep < REP_BAR; ++rep) xcd_barrier(bar, TID());
        phase_recur1(p, l, lds, TID(), 0);
        for (int rep = 1; rep < REP_R1; ++rep) { xcd_barrier(bar, TID()); phase_recur1(p, l, lds, TID(), 1); }
        xcd_barrier(bar, TID());
        for (int rep = 0; rep < REP_R2; ++rep) { if (rep) xcd_barrier(bar, TID()); phase_recur2(p, l, lds, TID()); }
        xcd_barrier(bar, TID());
        for (int rep = 0; rep < REP_G; ++rep) { if (rep) xcd_barrier(bar, TID());
        {   unsigned char* w = WSL(); const unsigned char* wl = w + WS_W + (size_t)l * W_LSTRIDE;
            pg8::Gemm g{(const bf16*)(w + WS_OHG), (const bf16*)(wl + WO_BRA), MP, D, 1024}; pg8::StaticOrder S; S.init(MP, D, G, (int)blockIdx.x);
            pg8::EpiGateA E{(bf16*)(w + WS_T), (const bf16*)(w + WS_PROJ) + PC_GA, LDP, p.in[I_BMERGE] + l * 2048};
            pg8::gemm_phase<pg8::EpiGateA, pg8::StaticOrder>(lds, g, S, E, nullptr, TID());
            skinny_gemm<1>((const bf16*)(w + WS_OHG) + (size_t)MP * D, D, (const bf16*)(wl + WO_BRA), 1024, D, SkGateA{(bf16*)(w + WS_T) + (size_t)MP * D, (const bf16*)(w + WS_PROJ) + (size_t)MP * LDP + PC_GA, LDP, p.in[I_BMERGE] + l * 2048}, (int)blockIdx.x, 0, G, TID(), lds); } }
        asm volatile("s_waitcnt vmcnt(0)" ::: "memory"); __syncthreads();
        for (int rep = 0; rep < REP_G; ++rep) { if (rep) xcd_barrier(bar, TID());
        {   unsigned char* w = WSL(); const unsigned char* wl = w + WS_W + (size_t)l * W_LSTRIDE;
            pg8::Gemm g{(const bf16*)(w + WS_Y), (const bf16*)(wl + WO_BRB), MP, D, 2048}; pg8::StaticOrder S; S.init(MP, D, G, (int)blockIdx.x);
            pg8::EpiGateB E{(const bf16*)(w + WS_T), (bf16*)(w + WS_U), (const bf16*)(w + WS_PROJ) + PC_GB, LDP, p.in[I_BMERGE] + l * 2048 + 1024};
            pg8::gemm_phase<pg8::EpiGateB, pg8::StaticOrder>(lds, g, S, E, nullptr, TID());
            skinny_gemm<1>((const bf16*)(w + WS_Y) + (size_t)MP * 2048, 2048, (const bf16*)(wl + WO_BRB), 2048, D, SkGateB{(const bf16*)(w + WS_T) + (size_t)MP * D, (bf16*)(w + WS_U) + (size_t)MP * D, (const bf16*)(w + WS_PROJ) + (size_t)MP * LDP + PC_GB, LDP, p.in[I_BMERGE] + l * 2048 + 1024}, (int)blockIdx.x, 0, G, TID(), lds); } }
        xcd_barrier(bar, TID());
        {   unsigned char* w = WSL(); const unsigned char* wl = w + WS_W + (size_t)l * W_LSTRIDE; const float* mod_l = (const float*)(w + WS_MOD) + (size_t)l * NADA * D;
            pg8::Gemm g{(const bf16*)(w + WS_U), (const bf16*)(wl + WO_OUT), MP, D, 1024}; pg8::StaticOrder S; S.init(MP, D, G, (int)blockIdx.x);
            const float* mod_s = mod_l + (size_t)NB * MODLD; unsigned* ctl = (unsigned*)(w + WS_CTL);
            EpiResNorm<0> E{(bf16*)(w + WS_X), mod_l + 2 * D, MODLD, (bf16*)(w + WS_H), nullptr, p.in[I_NMLP] + l * D, mod_l + 3 * D, mod_l + 4 * D, (float*)(w + WS_SLOT), ctl + CW_PCNT, 4u * (unsigned)(2 * l + 1)};
            pg8::gemm_phase<EpiResNorm<0>, pg8::StaticOrder>(lds, g, S, E, nullptr, TID());
            skinny_gemm<1>((const bf16*)(w + WS_U) + (size_t)MP * D, D, (const bf16*)(wl + WO_OUT), 1024, D,
                           SkResNorm<0>{(bf16*)(w + WS_X) + (size_t)MP * D, mod_s + 2 * D, MODLD, (bf16*)(w + WS_H) + (size_t)MP * D, nullptr, p.in[I_NMLP] + l * D, mod_s + 3 * D, mod_s + 4 * D, ctl + CW_SCNT, 32u * (unsigned)(2 * l + 1)},
                           (int)blockIdx.x, 0, G, TID(), lds); }
        xcd_barrier(bar, TID());
        for (int rep = 0; rep < REP_G; ++rep) { if (rep) xcd_barrier(bar, TID());
        {   unsigned char* w = WSL(); const unsigned char* wl = w + WS_W + (size_t)l * W_LSTRIDE;
            pg8::Gemm g{(const bf16*)(w + WS_H), (const bf16*)(wl + WO_UP), MP, DFF, 1024}; pg8::StaticOrder S; S.init(MP, DFF, G, (int)blockIdx.x);
            pg8::EpiBf16<1> E{(bf16*)(w + WS_UP), DFF};
            pg8::gemm_phase<pg8::EpiBf16<1>, pg8::StaticOrder>(lds, g, S, E, nullptr, TID());
            skinny_gemm<4>((const bf16*)(w + WS_H) + (size_t)MP * D, D, (const bf16*)(wl + WO_UP), 1024, DFF, SkStoreBf16{(bf16*)(w + WS_UP) + (size_t)MP * DFF, DFF, 1}, (int)blockIdx.x, 0, G, TID(), lds); } }
        xcd_barrier(bar, TID());
        {   unsigned char* w = WSL(); const unsigned char* wl = w + WS_W + (size_t)l * W_LSTRIDE; const float* mod_l = (const float*)(w + WS_MOD) + (size_t)l * NADA * D;
            pg8::Gemm g{(const bf16*)(w + WS_UP), (const bf16*)(wl + WO_DOWN), MP, D, DFF}; pg8::StaticOrder S; S.init(MP, D, G, (int)blockIdx.x);
            const float* mod_s = mod_l + (size_t)NB * MODLD; const float* mod_n = mod_l + NADA * D; const float* mod_ns = mod_n + (size_t)NB * MODLD; unsigned* ctl = (unsigned*)(w + WS_CTL);
            if (l < DEPTH - 1) {
                EpiResNorm<0> E{(bf16*)(w + WS_X), mod_l + 5 * D, MODLD, (bf16*)(w + WS_H), nullptr, p.in[I_NMIX] + (l + 1) * D, mod_n + 0 * D, mod_n + 1 * D, (float*)(w + WS_SLOT), ctl + CW_PCNT, 4u * (unsigned)(2 * l + 2)};
                pg8::gemm_phase<EpiResNorm<0>, pg8::StaticOrder>(lds, g, S, E, nullptr, TID());
                skinny_gemm<1>((const bf16*)(w + WS_UP) + (size_t)MP * DFF, DFF, (const bf16*)(wl + WO_DOWN), DFF, D,
                               SkResNorm<0>{(bf16*)(w + WS_X) + (size_t)MP * D, mod_s + 5 * D, MODLD, (bf16*)(w + WS_H) + (size_t)MP * D, nullptr, p.in[I_NMIX] + (l + 1) * D, mod_ns + 0 * D, mod_ns + 1 * D, ctl + CW_SCNT, 32u * (unsigned)(2 * l + 2)},
                               (int)blockIdx.x, 0, G, TID(), lds);
            } else {
                EpiResNorm<2> E{(bf16*)(w + WS_X), mod_l + 5 * D, MODLD, nullptr, p.out + O_YP, p.in[I_NFIN], nullptr, nullptr, (float*)(w + WS_SLOT), ctl + CW_PCNT, 4u * (unsigned)(2 * l + 2)};
                pg8::gemm_phase<EpiResNorm<2>, pg8::StaticOrder>(lds, g, S, E, nullptr, TID());
                skinny_gemm<1>((const bf16*)(w + WS_UP) + (size_t)MP * DFF, DFF, (const bf16*)(wl + WO_DOWN), DFF, D,
                               SkResNorm<2>{(bf16*)(w + WS_X) + (size_t)MP * D, mod_s + 5 * D, MODLD, nullptr, p.out + O_YS, p.in[I_NFIN], nullptr, nullptr, ctl + CW_SCNT, 32u * (unsigned)(2 * l + 2)},
                               (int)blockIdx.x, 0, G, TID(), lds);
            } }
        xcd_barrier(bar, TID());
    }
}

extern "C" void kernel_launch(void* const* d_in, const int* in_sizes, int n_in, void* d_out, int out_size, void* d_ws, size_t ws_size, hipStream_t stream) {
    static int grid = 0;
    if (grid == 0) {
        if (n_in != N_IN || (size_t)out_size != O_END || ws_size < WS_END) { fprintf(stderr, "kernel_launch: unexpected sizes n_in %d out %d ws %zu\n", n_in, out_size, ws_size); grid = -1; return; }
        int dev = 0, cus = 0, per_cu = 0;
        if (hipGetDevice(&dev) != hipSuccess || hipDeviceGetAttribute(&cus, hipDeviceAttributeMultiprocessorCount, dev) != hipSuccess) { grid = -1; return; }
        if (hipFuncSetAttribute((const void*)k_mega, hipFuncAttributeMaxDynamicSharedMemorySize, LDS_BYTES) != hipSuccess) { fprintf(stderr, "kernel_launch: hipFuncSetAttribute failed\n"); grid = -1; return; }
        if (hipOccupancyMaxActiveBlocksPerMultiprocessor(&per_cu, (const void*)k_mega, NTHREADS, LDS_BYTES) != hipSuccess || per_cu < 1)
            fprintf(stderr, "kernel_launch: note: occupancy query reports %d workgroups per CU\n", per_cu);
        (void)hipGetLastError();
        grid = cus;
    }
    if (grid < 0) return;
    if (hipMemsetAsync((char*)d_ws + WS_CTL, 0, CTL_ZERO_BYTES, stream) != hipSuccess) return;
    P p{};
    for (int i = 0; i < N_IN; ++i) p.in[i] = (const float*)d_in[i];
    p.out = (float*)d_out; p.ws = (unsigned char*)d_ws;
    hipLaunchKernelGGL(k_mega, dim3(grid), dim3(NTHREADS), LDS_BYTES, stream, p);
}
```

```cpp
#include <hip/hip_runtime.h>
#include <cstdio>
#include <cstdint>

constexpr int D = 1024, NB = 8, SEQ = 2048, DEPTH = 4, NSB = 128;
constexpr int MP = NB * SEQ;
constexpr int MS = NSB;
constexpr int MR = MP + MS;
constexpr int MT = 16640;
constexpr int HG_H = 8, HG_DK = 128, HG_DV = 128;
constexpr int SSM_INNER = 2048, SSM_P = 64, SSM_HEADS = 32, SSM_G = 8, SSM_HPG = 4, SSM_N = 128, SSM_CH = 4096;
constexpr int DFF = 4096, NADA = 6;
constexpr int IN_WIDTH = 12320;
constexpr int LDP = 12544;
constexpr int PC_Q = 0, PC_F = 1024, PC_I = 2048, PC_OG = 3072, PC_Z = 4096, PC_XBC = 6144, PC_GA = 10240, PC_GB = 11264, PC_DT = 12288;
constexpr int NCOND = NB + NSB;
constexpr int MODLD = DEPTH * NADA * D;
constexpr float EPS = 1e-6f;

enum { I_XP = 0, I_XS, I_SHG, I_SSSM, I_SCONV, I_CP, I_CS, I_WADA, I_BADA, I_NMIX, I_WIN, I_BMERGE, I_LB, I_HGN, I_CONVW, I_CONVB, I_DTB, I_ALOG, I_DSKIP,
       I_SSMN, I_WBRA, I_WBRB, I_WOUT, I_NMLP, I_WUP, I_WDOWN, I_NFIN, N_IN };

constexpr size_t O_YP = 0;
constexpr size_t O_YS = O_YP + (size_t)MP * D;
constexpr size_t O_HGP = O_YS + (size_t)MS * D;
constexpr size_t O_SSMP = O_HGP + (size_t)DEPTH * NB * HG_H * HG_DK * HG_DV;
constexpr size_t O_CVP = O_SSMP + (size_t)DEPTH * NB * SSM_HEADS * SSM_P * SSM_N;
constexpr size_t O_HGS = O_CVP + (size_t)DEPTH * NB * 3 * SSM_CH;
constexpr size_t O_SSMS = O_HGS + (size_t)DEPTH * NSB * HG_H * HG_DK * HG_DV;
constexpr size_t O_CVS = O_SSMS + (size_t)DEPTH * NSB * SSM_HEADS * SSM_P * SSM_N;
constexpr size_t O_END = O_CVS + (size_t)DEPTH * NSB * 3 * SSM_CH;

constexpr size_t MiB = 1u << 20;
constexpr size_t WS_CTL = 0, CTL_ZERO_BYTES = 1 * MiB;
constexpr size_t WS_LBS = 1 * MiB;
constexpr size_t WS_AC = 2 * MiB;
constexpr size_t WS_MOD = 3 * MiB;
constexpr size_t WS_WADA = 32 * MiB;
constexpr size_t WS_W = 80 * MiB, W_LSTRIDE = 49 * MiB;
constexpr size_t WO_IN = 0, WO_BRA = 24 * MiB + MiB / 2, WO_BRB = WO_BRA + 2 * MiB, WO_OUT = WO_BRB + 4 * MiB, WO_UP = WO_OUT + 2 * MiB, WO_DOWN = WO_UP + 8 * MiB;
constexpr size_t WS_X = 276 * MiB;
constexpr size_t WS_H = 341 * MiB;
constexpr size_t WS_PROJ = 374 * MiB;
constexpr size_t WS_OHG = 773 * MiB;
constexpr size_t WS_Y = 806 * MiB;
constexpr size_t WS_T = 871 * MiB;
constexpr size_t WS_U = 936 * MiB;
constexpr size_t WS_UP = 969 * MiB;
constexpr size_t WS_XBCC = 1100 * MiB;
constexpr size_t WS_DTV = 1230 * MiB, WS_CUM = 1232 * MiB;
constexpr size_t WS_CV = 1234 * MiB;
constexpr size_t WS_SSEG = 1238 * MiB;
constexpr size_t WS_DSEG = 1254 * MiB;
constexpr size_t WS_HSEG = 1255 * MiB;
constexpr size_t WS_TSEG = 1287 * MiB;
constexpr size_t WS_END = 1288 * MiB;
static_assert(WO_DOWN + 8 * MiB <= W_LSTRIDE && (size_t)LDP * D * 2 <= WO_BRA, "weight map");
static_assert(WS_W + 4 * W_LSTRIDE <= WS_X && WS_X + (size_t)MT * D * 4 <= WS_H && WS_H + (size_t)MT * D * 2 <= WS_PROJ && WS_PROJ + (size_t)MT * LDP * 2 <= WS_OHG, "ws map 1");
static_assert(WS_OHG + (size_t)MT * D * 2 <= WS_Y && WS_Y + (size_t)MT * 2048 * 2 <= WS_T && WS_T + (size_t)MT * D * 4 <= WS_U && WS_U + (size_t)MT * D * 2 <= WS_UP && WS_UP + (size_t)MT * DFF * 2 <= WS_XBCC && WS_XBCC + (size_t)MT * 4096 * 2 <= WS_DTV, "ws map 2");
static_assert(WS_MOD + (size_t)256 * MODLD * 4 <= WS_WADA && WS_WADA + (size_t)MODLD * D * 2 <= WS_W, "ws map 0");

typedef unsigned short bf16;
__device__ __forceinline__ float bf2f(bf16 v) { return __uint_as_float(((unsigned)v) << 16); }
__device__ __forceinline__ unsigned pk2(float lo, float hi) { unsigned r; asm("v_cvt_pk_bf16_f32 %0, %1, %2" : "=v"(r) : "v"(lo), "v"(hi)); return r; }
__device__ __forceinline__ bf16 f2bf(float f) { return (bf16)pk2(f, f); }
__device__ __forceinline__ float frcp_(float x) { return __builtin_amdgcn_rcpf(x); }
__device__ __forceinline__ float sigmoidf_(float x) { return frcp_(1.0f + __expf(-x)); }
__device__ __forceinline__ float siluf_(float x) { return x * frcp_(1.0f + __expf(-x)); }
__device__ __forceinline__ float softplusf_(float x) { return x > 20.f ? x : log1pf(__expf(x)); }
__host__ __device__ __forceinline__ int cidx_of_row(int row) { return row < MP ? (row >> 11) : ((row - MP + NB) < NCOND ? (row - MP + NB) : (NCOND - 1)); }
__host__ __device__ __forceinline__ int hg_vpos(int e) { return (e & 64) + 16 * (e & 3) + ((e & 63) >> 2); }

namespace pg8 {
#define PG8_LAS __attribute__((address_space(3)))
typedef unsigned short bf16_t;
typedef short bf16x8 __attribute__((ext_vector_type(8)));
typedef float f32x4 __attribute__((ext_vector_type(4)));
typedef unsigned u32x4 __attribute__((ext_vector_type(4)));
constexpr int BM = 256, BK = 64, HALF = 128, HTB = HALF * BK * 2  , STAGE_BYTES = 8 * HTB, NXCD = 8, WGM = 4;

__host__ __device__ __forceinline__ int lds_byte(int r, int c) { const int st = (r >> 4) * 2 + (c >> 5), rr = r & 15, cc = c & 31, ob = rr * 64 + cc * 2; return st * 1024 + (ob ^ (((ob >> 9) & 1) << 5)); }
__host__ __device__ __forceinline__ void stage_rc(int b, int& R, int& C) { const int st = b / 1024, sb = b % 1024, swz = sb ^ (((sb >> 9) & 1) << 5); R = (st >> 1) * 16 + swz / 64; C = (st & 1) * 32 + (swz % 64) / 2; }
__host__ __device__ __forceinline__ int perm32(int rho) { const int n = rho >> 4, i = rho & 15; return 8 * (i >> 2) + 4 * n + (i & 3); }

struct Unit { int pm, pn; };
struct Gemm { const bf16_t* A; const bf16_t* Bt; int M, N, K; };

struct StaticOrder {
    int nM, nN, nwg, G, c;
    __host__ __device__ void init(int M, int N, int G_, int c_) { nM = M / BM; nN = N / BM; nwg = nM * nN; G = G_; c = c_; }
    __host__ __device__ bool next(int i, Unit& u) const {
        const long L = (long)i * G + c; if (L >= nwg) return false;
        int wgid = (int)L; { const int q = nwg / NXCD, r = nwg % NXCD, xcd = wgid % NXCD, off = wgid / NXCD; wgid = (xcd < r ? xcd * (q + 1) : r * (q + 1) + (xcd - r) * q) + off; }
        const int nig = WGM * nN, gid = wgid / nig, fm = gid * WGM, gsz = (nM - fm) < WGM ? (nM - fm) : WGM;
        u.pm = fm + ((wgid % nig) % gsz); u.pn = (wgid % nig) / gsz; return true;
    }
    __device__ __forceinline__ void a_ready(const Unit&) const {}
    __device__ __forceinline__ void done(const Unit&) const {}
};
__device__ __forceinline__ unsigned cvt_pk_bf16(float lo, float hi) { unsigned r; asm volatile("v_cvt_pk_bf16_f32 %0, %1, %2" : "=v"(r) : "v"(lo), "v"(hi)); return r; }
__device__ __forceinline__ float ep_sigmoid(float x) { return __builtin_amdgcn_rcpf(1.0f + __expf(-x)); }
__device__ __forceinline__ void unpack8(const u32x4 w, f32x4& lo, f32x4& hi) {
    lo = (f32x4){__uint_as_float(w.x << 16), __uint_as_float(w.x & 0xffff0000u), __uint_as_float(w.y << 16), __uint_as_float(w.y & 0xffff0000u)};
    hi = (f32x4){__uint_as_float(w.z << 16), __uint_as_float(w.z & 0xffff0000u), __uint_as_float(w.w << 16), __uint_as_float(w.w & 0xffff0000u)};
}

struct EpiF32 {
    static constexpr bool PERM = false, AFTER_DRAIN = false;
    float* C; int ldc; const float* bias;
    __device__ __forceinline__ void operator()(const f32x4 (&acc)[2][2][4][2], const Unit& u, int wr, int wc, int fr, int fq) const {
        const int row0 = u.pm * BM + wr * 64 + fr, col0 = u.pn * BM + wc * 32 + 4 * fq;
        f32x4 bv[2][2];
#pragma unroll
        for (int bj = 0; bj < 2; ++bj)
#pragma unroll
            for (int n = 0; n < 2; ++n) bv[bj][n] = *(const f32x4*)(bias + col0 + bj * HALF + n * 16);
#pragma unroll
        for (int ai = 0; ai < 2; ++ai)
#pragma unroll
            for (int m = 0; m < 4; ++m) { float* rowp = C + (size_t)(row0 + ai * HALF + m * 16) * ldc + col0;
#pragma unroll
                for (int bj = 0; bj < 2; ++bj)
#pragma unroll
                    for (int n = 0; n < 2; ++n) *(f32x4*)(rowp + bj * HALF + n * 16) = acc[ai][bj][m][n] + bv[bj][n]; }
    }
};
template <int ACT  > struct EpiBf16 {
    static constexpr bool PERM = true, AFTER_DRAIN = false;
    bf16_t* O; int ldc;
    __device__ __forceinline__ void operator()(const f32x4 (&acc)[2][2][4][2], const Unit& u, int wr, int wc, int fr, int fq) const {
        const int row0 = u.pm * BM + wr * 64 + fr; const int col0 = u.pn * BM + wc * 32 + 8 * fq;
#pragma unroll
        for (int ai = 0; ai < 2; ++ai)
#pragma unroll
            for (int m = 0; m < 4; ++m) { bf16_t* rowp = O + (size_t)(row0 + ai * HALF + m * 16) * ldc + col0;
#pragma unroll
                for (int bj = 0; bj < 2; ++bj) { f32x4 v0 = acc[ai][bj][m][0], v1 = acc[ai][bj][m][1];
                    if (ACT == 1) {
#pragma unroll
                        for (int j = 0; j < 4; ++j) { const float a = fmaxf(v0[j], 0.f), b = fmaxf(v1[j], 0.f); v0[j] = a * a; v1[j] = b * b; } }
                    u32x4 w; w.x = cvt_pk_bf16(v0[0], v0[1]); w.y = cvt_pk_bf16(v0[2], v0[3]); w.z = cvt_pk_bf16(v1[0], v1[1]); w.w = cvt_pk_bf16(v1[2], v1[3]);
                    *(u32x4*)(rowp + bj * HALF) = w; } }
    }
};
struct EpiGateA {
    static constexpr bool PERM = true, AFTER_DRAIN = false;
    bf16_t* T; const bf16_t* G; int ldg; const float* bm;
    __device__ __forceinline__ void operator()(const f32x4 (&acc)[2][2][4][2], const Unit& u, int wr, int wc, int fr, int fq) const {
        const int row0 = u.pm * BM + wr * 64 + fr; const int col0 = u.pn * BM + wc * 32 + 8 * fq;
        f32x4 bv[2][2];
#pragma unroll
        for (int bj = 0; bj < 2; ++bj)
#pragma unroll
            for (int n = 0; n < 2; ++n) bv[bj][n] = *(const f32x4*)(bm + col0 + bj * HALF + 4 * n);
#pragma unroll
        for (int ai = 0; ai < 2; ++ai)
#pragma unroll
            for (int m = 0; m < 4; ++m) { const size_t row = (size_t)(row0 + ai * HALF + m * 16);
#pragma unroll
                for (int bj = 0; bj < 2; ++bj) {
                    const u32x4 gw = *(const u32x4*)(G + row * ldg + col0 + bj * HALF); f32x4 g0, g1; unpack8(gw, g0, g1);
                    f32x4 o0, o1;
#pragma unroll
                    for (int j = 0; j < 4; ++j) { o0[j] = ep_sigmoid(g0[j] + bv[bj][0][j]) * acc[ai][bj][m][0][j]; o1[j] = ep_sigmoid(g1[j] + bv[bj][1][j]) * acc[ai][bj][m][1][j]; }
                    u32x4 w; w.x = cvt_pk_bf16(o0[0], o0[1]); w.y = cvt_pk_bf16(o0[2], o0[3]); w.z = cvt_pk_bf16(o1[0], o1[1]); w.w = cvt_pk_bf16(o1[2], o1[3]);
                    *(u32x4*)(T + row * 1024 + col0 + bj * HALF) = w; } }
    }
};
struct EpiGateB {
    static constexpr bool PERM = true, AFTER_DRAIN = false;
    const bf16_t* T; bf16_t* U; const bf16_t* G; int ldg; const float* bm;
    __device__ __forceinline__ void operator()(const f32x4 (&acc)[2][2][4][2], const Unit& u, int wr, int wc, int fr, int fq) const {
        const int row0 = u.pm * BM + wr * 64 + fr; const int col0 = u.pn * BM + wc * 32 + 8 * fq;
        f32x4 bv[2][2];
#pragma unroll
        for (int bj = 0; bj < 2; ++bj)
#pragma unroll
            for (int n = 0; n < 2; ++n) bv[bj][n] = *(const f32x4*)(bm + col0 + bj * HALF + 4 * n);
#pragma unroll
        for (int ai = 0; ai < 2; ++ai)
#pragma unroll
            for (int m = 0; m < 4; ++m) { const size_t row = (size_t)(row0 + ai * HALF + m * 16);
#pragma unroll
                for (int bj = 0; bj < 2; ++bj) {
                    const u32x4 gw = *(const u32x4*)(G + row * ldg + col0 + bj * HALF); f32x4 g0, g1; unpack8(gw, g0, g1);
                    f32x4 t0, t1; unpack8(*(const u32x4*)(T + row * 1024 + col0 + bj * HALF), t0, t1);
                    f32x4 o0, o1;
#pragma unroll
                    for (int j = 0; j < 4; ++j) { o0[j] = t0[j] + ep_sigmoid(g0[j] + bv[bj][0][j]) * acc[ai][bj][m][0][j]; o1[j] = t1[j] + ep_sigmoid(g1[j] + bv[bj][1][j]) * acc[ai][bj][m][1][j]; }
                    u32x4 w; w.x = cvt_pk_bf16(o0[0], o0[1]); w.y = cvt_pk_bf16(o0[2], o0[3]); w.z = cvt_pk_bf16(o1[0], o1[1]); w.w = cvt_pk_bf16(o1[2], o1[3]);
                    *(u32x4*)(U + row * 1024 + col0 + bj * HALF) = w; } }
    }
};
struct EpiRes {
    static constexpr bool PERM = false, AFTER_DRAIN = false;
    bf16_t* X; const float* gate; int ldgate;
    __device__ __forceinline__ void operator()(const f32x4 (&acc)[2][2][4][2], const Unit& u, int wr, int wc, int fr, int fq) const {
        typedef unsigned u32x2 __attribute__((ext_vector_type(2)));
        const int row0 = u.pm * BM + wr * 64 + fr, col0 = u.pn * BM + wc * 32 + 4 * fq;
        const float* gp = gate + (size_t)((u.pm * BM) >> 11) * ldgate + col0;
        f32x4 gv[2][2];
#pragma unroll
        for (int bj = 0; bj < 2; ++bj)
#pragma unroll
            for (int n = 0; n < 2; ++n) gv[bj][n] = *(const f32x4*)(gp + bj * HALF + n * 16);
#pragma unroll
        for (int ai = 0; ai < 2; ++ai)
#pragma unroll
            for (int m = 0; m < 4; ++m) { bf16_t* xp = X + (size_t)(row0 + ai * HALF + m * 16) * 1024 + col0;
#pragma unroll
                for (int bj = 0; bj < 2; ++bj)
#pragma unroll
                    for (int n = 0; n < 2; ++n) { const u32x2 xw = *(const u32x2*)(xp + bj * HALF + n * 16);
                        const f32x4 xv = (f32x4){__uint_as_float(xw.x << 16), __uint_as_float(xw.x & 0xffff0000u), __uint_as_float(xw.y << 16), __uint_as_float(xw.y & 0xffff0000u)};
                        const f32x4 o = xv + gv[bj][n] * acc[ai][bj][m][n];
                        u32x2 ow; ow.x = cvt_pk_bf16(o[0], o[1]); ow.y = cvt_pk_bf16(o[2], o[3]); *(u32x2*)(xp + bj * HALF + n * 16) = ow; } }
    }
};


#ifndef GEMM_ALIGN
#define GEMM_ALIGN true
#endif
#ifndef GEMM_SP2
#define GEMM_SP2 true
#endif
template <class Epi, class Sched, bool ALIGN_EPI = GEMM_ALIGN, bool SP2 = GEMM_SP2>
__device__ __forceinline__ void gemm_phase(PG8_LAS unsigned char* lds, const Gemm g, const Sched& S, const Epi& E, unsigned long long*  , int tid_in) {
    int tid_ = tid_in; asm volatile("" : "+v"(tid_));
    const int tid = tid_, wid = __builtin_amdgcn_readfirstlane(tid >> 6), lane = tid & 63, wr = wid >> 2, wc = wid & 3, fr = lane & 15, fq = lane >> 4;
    const int K = g.K, nt = K / BK;
    unsigned voffA[2], voffB[2];
#pragma unroll
    for (int i = 0; i < 2; ++i) { int R, C; stage_rc(tid * 16 + i * 8192, R, C); const int Rb = Epi::PERM ? ((R & ~31) + perm32(R & 31)) : R;
        voffA[i] = (unsigned)(R * K + C) * 2u; voffB[i] = (unsigned)(Rb * K + C) * 2u; }
    const size_t kstep = (size_t)(BK * 2);
    const size_t hstep = (size_t)HALF * K * 2;
    const size_t tstep = 2 * hstep;
    const unsigned ldsw = (unsigned)wid * 1024u;
    const int aoff = lds_byte(wr * 64 + fr, fq * 8), boff = lds_byte(wc * 32 + fr, fq * 8);
#define PG8_SA(b, h) (((b) * 2 + (h)) * HTB)
#define PG8_SB(b, h) ((4 + (b) * 2 + (h)) * HTB)
#define PG8_STAGE(bufoff, gbase, voff) do { _Pragma("unroll") for (int _i = 0; _i < 2; ++_i) \
        __builtin_amdgcn_global_load_lds((const unsigned*)((const char*)(gbase) + (voff)[_i]), (PG8_LAS unsigned*)(lds + (bufoff) + ldsw + _i * 8192), 16, 0, 0); } while (0)
#define PG8_LDA(dst, b, h) do { _Pragma("unroll") for (int m = 0; m < 4; ++m) _Pragma("unroll") for (int k = 0; k < 2; ++k) dst[m][k] = *(const PG8_LAS bf16x8*)(lds + PG8_SA(b, h) + aoff + m * 2048 + k * 1024); } while (0)
#define PG8_LDB(dst, b, h) do { _Pragma("unroll") for (int n = 0; n < 2; ++n) _Pragma("unroll") for (int k = 0; k < 2; ++k) dst[n][k] = *(const PG8_LAS bf16x8*)(lds + PG8_SB(b, h) + boff + n * 2048 + k * 1024); } while (0)
#define PG8_MMA(ai, bj, At, Bt) do { __builtin_amdgcn_s_setprio(1); _Pragma("unroll") for (int m = 0; m < 4; ++m) _Pragma("unroll") for (int n = 0; n < 2; ++n) _Pragma("unroll") for (int k = 0; k < 2; ++k) \
        acc[ai][bj][m][n] = __builtin_amdgcn_mfma_f32_16x16x32_bf16(Bt[n][k], At[m][k], acc[ai][bj][m][n], 0, 0, 0); __builtin_amdgcn_s_setprio(0); } while (0)
#define PG8_WAIT_V(n) asm volatile("s_waitcnt vmcnt(" #n ")" ::: "memory")
#define PG8_WAIT_L(n) asm volatile("s_waitcnt lgkmcnt(" #n ")" ::: "memory")
#define PG8_BAR __builtin_amdgcn_s_barrier()
#define PG8_SCHED __builtin_amdgcn_sched_barrier(0)
    Unit cur, nxt; int ui = 0;
    if (!S.next(0, cur)) return;
    f32x4 acc[2][2][4][2];
#pragma unroll
    for (int a = 0; a < 2; ++a)
#pragma unroll
        for (int b = 0; b < 2; ++b)
#pragma unroll
            for (int m = 0; m < 4; ++m)
#pragma unroll
                for (int n = 0; n < 2; ++n) acc[a][b][m][n] = (f32x4){0.f, 0.f, 0.f, 0.f};
    bf16x8 At[4][2], B0[2][2], B1[2][2];
    const char* cA = (const char*)g.A + (size_t)cur.pm * tstep; const char* cB = (const char*)g.Bt + (size_t)cur.pn * tstep;
    S.a_ready(cur);
    if constexpr (SP2) {
        PG8_STAGE(PG8_SB(0, 0), cB, voffB); PG8_STAGE(PG8_SB(0, 1), cB + hstep, voffB); PG8_STAGE(PG8_SA(0, 0), cA, voffA); PG8_STAGE(PG8_SA(0, 1), cA + hstep, voffA);
        if (wr == 1) PG8_BAR;
        PG8_WAIT_V(2); PG8_BAR;
        PG8_STAGE(PG8_SB(1, 0), cB + kstep, voffB); PG8_STAGE(PG8_SA(1, 0), cA + kstep, voffA); PG8_STAGE(PG8_SB(1, 1), cB + hstep + kstep, voffB);
        PG8_WAIT_V(6); PG8_BAR;
    } else {
        PG8_STAGE(PG8_SB(0, 0), cB, voffB); PG8_STAGE(PG8_SA(0, 0), cA, voffA); PG8_STAGE(PG8_SB(0, 1), cB + hstep, voffB); PG8_STAGE(PG8_SA(0, 1), cA + hstep, voffA);
        if (wr == 1) PG8_BAR;
        PG8_WAIT_V(4); PG8_BAR;
        PG8_STAGE(PG8_SB(1, 0), cB + kstep, voffB); PG8_STAGE(PG8_SA(1, 0), cA + kstep, voffA); PG8_STAGE(PG8_SB(1, 1), cB + hstep + kstep, voffB);
        PG8_WAIT_V(6); PG8_BAR;
    }
    for (;;) {
        const bool has_next = S.next(ui + 1, nxt);
        const char* nA = has_next ? (const char*)g.A + (size_t)nxt.pm * tstep : cA; const char* nB = has_next ? (const char*)g.Bt + (size_t)nxt.pn * tstep : cB;
        for (int t = 0; t < nt; t += 2) {
            const bool last = (t == nt - 2);
            const char* a1 = cA + (size_t)(t + 1) * kstep;
            const char* a2 = last ? nA : cA + (size_t)(t + 2) * kstep; const char* b2 = last ? nB : cB + (size_t)(t + 2) * kstep;
            const char* a3 = a2 + kstep; const char* b3 = b2 + kstep;
            if (last && has_next) S.a_ready(nxt);
            if constexpr (SP2) {
            PG8_LDB(B0, 0, 0); PG8_LDB(B1, 0, 1); PG8_SCHED; PG8_LDA(At, 0, 0); PG8_STAGE(PG8_SA(1, 1), a1 + hstep, voffA);
            PG8_WAIT_V(8); PG8_WAIT_L(0); PG8_BAR; PG8_MMA(0, 0, At, B0); PG8_MMA(0, 1, At, B1); PG8_BAR; PG8_SCHED;
            PG8_LDA(At, 0, 1); PG8_STAGE(PG8_SB(0, 0), b2, voffB); PG8_STAGE(PG8_SB(0, 1), b2 + hstep, voffB); PG8_STAGE(PG8_SA(0, 0), a2, voffA);
            PG8_WAIT_V(8); PG8_WAIT_L(0); PG8_BAR; PG8_MMA(1, 0, At, B0); PG8_MMA(1, 1, At, B1); PG8_BAR; PG8_SCHED;
            PG8_LDB(B0, 1, 0); PG8_LDB(B1, 1, 1); PG8_SCHED; PG8_LDA(At, 1, 0); PG8_STAGE(PG8_SA(0, 1), a2 + hstep, voffA);
            PG8_WAIT_V(8); PG8_WAIT_L(0); PG8_BAR; PG8_MMA(0, 0, At, B0); PG8_MMA(0, 1, At, B1); PG8_BAR; PG8_SCHED;
            PG8_LDA(At, 1, 1); PG8_STAGE(PG8_SB(1, 0), b3, voffB); PG8_STAGE(PG8_SB(1, 1), b3 + hstep, voffB); PG8_STAGE(PG8_SA(1, 0), a3, voffA);
            PG8_WAIT_V(8); PG8_WAIT_L(0); PG8_BAR; PG8_MMA(1, 0, At, B0); PG8_MMA(1, 1, At, B1); PG8_BAR; PG8_SCHED;
            } else {
            PG8_LDB(B0, 0, 0); PG8_SCHED; PG8_LDA(At, 0, 0); PG8_STAGE(PG8_SA(1, 1), a1 + hstep, voffA);
            PG8_WAIT_L(8); PG8_BAR; PG8_WAIT_L(0); PG8_MMA(0, 0, At, B0); PG8_BAR; PG8_SCHED;
            PG8_LDB(B1, 0, 1); PG8_STAGE(PG8_SB(0, 0), b2, voffB);
            PG8_BAR; PG8_WAIT_L(0); PG8_MMA(0, 1, At, B1); PG8_BAR;
            PG8_LDA(At, 0, 1); PG8_STAGE(PG8_SA(0, 0), a2, voffA);
            PG8_BAR; PG8_WAIT_L(0); PG8_MMA(1, 0, At, B0); PG8_BAR; PG8_SCHED;
            PG8_STAGE(PG8_SB(0, 1), b2 + hstep, voffB);
            PG8_WAIT_V(6); PG8_BAR; PG8_MMA(1, 1, At, B1); PG8_BAR;
            PG8_LDB(B0, 1, 0); PG8_SCHED; PG8_LDA(At, 1, 0); PG8_STAGE(PG8_SA(0, 1), a2 + hstep, voffA);
            PG8_WAIT_L(8); PG8_BAR; PG8_WAIT_L(0); PG8_MMA(0, 0, At, B0); PG8_BAR; PG8_SCHED;
            PG8_LDB(B1, 1, 1); PG8_STAGE(PG8_SB(1, 0), b3, voffB);
            PG8_BAR; PG8_WAIT_L(0); PG8_MMA(0, 1, At, B1); PG8_BAR;
            PG8_LDA(At, 1, 1); PG8_STAGE(PG8_SA(1, 0), a3, voffA);
            PG8_BAR; PG8_WAIT_L(0); PG8_MMA(1, 0, At, B0); PG8_BAR; PG8_SCHED;
            PG8_STAGE(PG8_SB(1, 1), b3 + hstep, voffB);
            PG8_WAIT_V(6); PG8_BAR; PG8_MMA(1, 1, At, B1); PG8_BAR;
            }
        }
        if constexpr (ALIGN_EPI) { if (wr == 0) PG8_BAR; }
        if constexpr (!Epi::AFTER_DRAIN) { E(acc, cur, wr, wc, fr, fq); S.done(cur); }
        if (!has_next) break;
#pragma unroll
        for (int a = 0; a < 2; ++a)
#pragma unroll
            for (int b = 0; b < 2; ++b)
#pragma unroll
                for (int m = 0; m < 4; ++m)
#pragma unroll
                    for (int n = 0; n < 2; ++n) acc[a][b][m][n] = (f32x4){0.f, 0.f, 0.f, 0.f};
        cur = nxt; cA = nA; cB = nB; ++ui;
        if constexpr (ALIGN_EPI) { if (wr == 1) PG8_BAR; }
    }
    PG8_WAIT_V(0);
    if constexpr (!ALIGN_EPI) { if (wr == 0) PG8_BAR; }
    PG8_BAR;
    if constexpr (Epi::AFTER_DRAIN) { E.fused(acc, cur, wr, wc, fr, fq, lds, wid, lane); S.done(cur); }
#undef PG8_SA
#undef PG8_SB
#undef PG8_STAGE
#undef PG8_LDA
#undef PG8_LDB
#undef PG8_MMA
#undef PG8_WAIT_V
#undef PG8_WAIT_L
#undef PG8_BAR
#undef PG8_SCHED
}
}

#define XB_TMO      128
#define XB_XCNT(j)  (256  + 64 * (j))
#define XB_XSUB(j)  (1280 + 64 * (j))
#define XB_XGEN(j)  (2304 + 64 * (j))
#define XB_TOP      3328
#define XB_TOPGEN   3392
#define XCD_BAR_WORDS 3456
#define XB_SPIN_CAP (1u << 18)
#define LAS __attribute__((address_space(3)))

__device__ __forceinline__ unsigned xb_ld(unsigned* p)              { return __hip_atomic_load(p, __ATOMIC_RELAXED, __HIP_MEMORY_SCOPE_AGENT); }
__device__ __forceinline__ unsigned xb_add(unsigned* p, unsigned v) { return __hip_atomic_fetch_add(p, v, __ATOMIC_RELAXED, __HIP_MEMORY_SCOPE_AGENT); }
__device__ __forceinline__ unsigned xb_xcc_id() { return (unsigned)__builtin_amdgcn_s_getreg((3 << 11) | 20) & 0xFu; }
#define XB_SPIN(cond, bar) do { unsigned _sp = 0; while (cond) { __builtin_amdgcn_s_sleep(1); \
    if ((++_sp & 255u) == 0u) { if (xb_ld(&(bar)[XB_TMO])) break; if (_sp > XB_SPIN_CAP) { atomicAdd(&(bar)[XB_TMO], 1u); break; } } } } while (0)

struct XcdBarrier {
    unsigned* bar; unsigned x;
    volatile LAS unsigned* st;
};

__device__ __forceinline__ XcdBarrier xcd_barrier_post(unsigned* bar, volatile LAS unsigned* st, int tid) {
    XcdBarrier b; b.bar = bar; b.x = (unsigned)__builtin_amdgcn_readfirstlane((int)xb_xcc_id()); b.st = st;
    if (tid == 0) (void)xb_add(&bar[XB_XCNT(b.x)], 1u);
    return b;
}
__device__ __forceinline__ void xcd_barrier_complete(unsigned* bar, unsigned x, unsigned& nloc, unsigned& nx) {
    const unsigned G = gridDim.x * gridDim.y * gridDim.z;
    unsigned sum, cnt, mine, sp = 0u;
    for (;;) {
        sum = 0u; cnt = 0u; mine = 0u;
#pragma unroll
        for (unsigned j = 0; j < 16; ++j) { const unsigned c = xb_ld(&bar[XB_XCNT(j)]); sum += c; cnt += (c > 0u) ? 1u : 0u; mine = (j == x) ? c : mine; }
        if (sum == G) break;
        __builtin_amdgcn_s_sleep(1);
        if ((++sp & 255u) == 0u) { if (xb_ld(&bar[XB_TMO])) break; if (sp > XB_SPIN_CAP) { atomicAdd(&bar[XB_TMO], 1u); break; } }
    }
    nloc = mine > 0u ? mine : 1u; nx = cnt > 0u ? cnt : 1u;
}

__device__ __forceinline__ void xcd_barrier(const XcdBarrier& b, int tid) {
    asm volatile("s_waitcnt vmcnt(0)" ::: "memory");
    __syncthreads();
    if (tid == 0) {
        unsigned* bar = b.bar; unsigned bx_ = b.x; asm volatile("" : "+s"(bar), "+s"(bx_));
        __builtin_amdgcn_s_waitcnt(0);
        unsigned nloc = b.st[0], nx = b.st[1];
        if (nloc == 0u) { xcd_barrier_complete(bar, bx_, nloc, nx); b.st[0] = nloc; b.st[1] = nx; }
        const unsigned old = xb_add(&bar[XB_XSUB(bx_)], 1u);
        const unsigned gen = old / nloc;
        if (old + 1u == (gen + 1u) * nloc) {
            __builtin_amdgcn_fence(__ATOMIC_RELEASE, "agent");
            asm volatile("s_waitcnt vmcnt(0)" ::: "memory");
            const unsigned og = xb_add(&bar[XB_TOP], 1u);
            const unsigned tg = og / nx;
            if (og + 1u == (tg + 1u) * nx) xb_add(&bar[XB_TOPGEN], 1u);
            else XB_SPIN(xb_ld(&bar[XB_TOPGEN]) == tg, bar);
            __builtin_amdgcn_fence(__ATOMIC_ACQUIRE, "agent");
            xb_add(&bar[XB_XGEN(bx_)], 1u);
            asm volatile("s_waitcnt vmcnt(0)" ::: "memory");
        } else {
            XB_SPIN(xb_ld(&bar[XB_XGEN(bx_)]) == gen, bar);
            __builtin_amdgcn_fence(__ATOMIC_ACQUIRE, "agent");
            asm volatile("s_waitcnt vmcnt(0)" ::: "memory");
        }
    }
    __syncthreads();
}


typedef unsigned v4u __attribute__((ext_vector_type(4)));
typedef float f32x4 __attribute__((ext_vector_type(4)));
#define LDS_WAIT() asm volatile("s_waitcnt lgkmcnt(0)" ::: "memory")
constexpr int NWAVES = 8, NTHREADS = 512;
constexpr int RING_BYTES = 131072, LDS_BYTES = 155648;

struct P { const float* in[N_IN]; float* out; unsigned char* ws; };

template <int M> __device__ __forceinline__ float swz_xor(float v) { static_assert(M >= 1 && M < 32, "swizzle xor mask"); return __int_as_float(__builtin_amdgcn_ds_swizzle(__float_as_int(v), (M << 10) | 0x1f)); }
__device__ __forceinline__ float xor32_sum(float v) { auto r = __builtin_amdgcn_permlane32_swap(__float_as_uint(v), __float_as_uint(v), false, false); return __uint_as_float(r[0]) + __uint_as_float(r[1]); }
__device__ __forceinline__ float wave_sum(float v) {
    v += swz_xor<1>(v); v += swz_xor<2>(v); v += swz_xor<4>(v); v += swz_xor<8>(v); v += swz_xor<16>(v);
    return xor32_sum(v);
}

template <bool VPERM = false>
__device__ __forceinline__ void transpose_item(const float* W, int K, int N, bf16* WT, int k0, int n0, int drow0, LAS float* scr, int lane) {
    float tv[32];
#pragma unroll
    for (int i = 0; i < 32; ++i) { const int kk = 2 * i + (lane >> 5); tv[i] = W[(size_t)(k0 + kk) * N + n0 + (lane & 31)]; }
#pragma unroll
    for (int i = 0; i < 32; ++i) { const int kk = 2 * i + (lane >> 5); scr[kk * 33 + (lane & 31)] = tv[i]; }
    LDS_WAIT(); asm volatile("" ::: "memory");
    const int c = lane & 7;
#pragma unroll
    for (int j = 0; j < 4; ++j) { const int n = (lane >> 3) + 8 * j; const LAS float* s = scr + (8 * c) * 33 + n;
        v4u o; o.x = pk2(s[0 * 33], s[1 * 33]); o.y = pk2(s[2 * 33], s[3 * 33]); o.z = pk2(s[4 * 33], s[5 * 33]); o.w = pk2(s[6 * 33], s[7 * 33]);
        const int dr = VPERM ? (((drow0 + n) & ~127) + hg_vpos((drow0 + n) & 127)) : (drow0 + n);
        *(v4u*)(WT + (size_t)dr * K + k0 + 8 * c) = o; }
    LDS_WAIT(); asm volatile("" ::: "memory");
}

__device__ __forceinline__ void phase_prologue(const P& p, LAS unsigned char* lds, int gw, int NGW, int lane, int wave) {
    LAS float* scr = (LAS float*)(lds + wave * 16384);
    unsigned char* ws = p.ws;
    constexpr int IT_ADA = 16 * 192, IT_IN = 16 * 385, IT_BRA = 16 * 32, IT_BRB = 32 * 32, IT_OUT = 16 * 32, IT_UP = 16 * 128, IT_DOWN = 64 * 32;
    constexpr int IT_L = IT_ADA + IT_IN + IT_BRA + IT_BRB + IT_OUT + IT_UP + IT_DOWN;
    for (int it = gw; it < DEPTH * IT_L; it += NGW) {
        const int l = it / IT_L; int r = it % IT_L;
        bf16* wl = (bf16*)(ws + WS_W + (size_t)l * W_LSTRIDE);
        if (r < IT_ADA) { const int kb = r / 192, nb = r % 192; transpose_item(p.in[I_WADA] + (size_t)l * D * 6144, D, 6144, (bf16*)(ws + WS_WADA) + (size_t)l * 6144 * D, kb * 64, nb * 32, nb * 32, scr, lane); continue; } r -= IT_ADA;
        if (r < IT_IN) { const int kb = r / 385, nb = r % 385; const int n0 = nb * 32; const int dr = n0 < 10240 ? n0 : (n0 < 10272 ? PC_DT + (n0 - 10240) : n0 - 32);
            if (n0 >= PC_I && n0 < PC_OG) transpose_item<true>(p.in[I_WIN] + (size_t)l * D * IN_WIDTH, D, IN_WIDTH, (bf16*)((unsigned char*)wl + WO_IN), kb * 64, n0, dr, scr, lane);
            else transpose_item(p.in[I_WIN] + (size_t)l * D * IN_WIDTH, D, IN_WIDTH, (bf16*)((unsigned char*)wl + WO_IN), kb * 64, n0, dr, scr, lane);
            continue; } r -= IT_IN;
        if (r < IT_BRA) { const int kb = r / 32, nb = r % 32; transpose_item(p.in[I_WBRA] + (size_t)l * 1024 * 1024, 1024, 1024, (bf16*)((unsigned char*)wl + WO_BRA), kb * 64, nb * 32, nb * 32, scr, lane); continue; } r -= IT_BRA;
        if (r < IT_BRB) { const int kb = r / 32, nb = r % 32; transpose_item(p.in[I_WBRB] + (size_t)l * 2048 * 1024, 2048, 1024, (bf16*)((unsigned char*)wl + WO_BRB), kb * 64, nb * 32, nb * 32, scr, lane); continue; } r -= IT_BRB;
        if (r < IT_OUT) { const int kb = r / 32, nb = r % 32; transpose_item(p.in[I_WOUT] + (size_t)l * 1024 * 1024, 1024, 1024, (bf16*)((unsigned char*)wl + WO_OUT), kb * 64, nb * 32, nb * 32, scr, lane); continue; } r -= IT_OUT;
        if (r < IT_UP) { const int kb = r / 128, nb = r % 128; transpose_item(p.in[I_WUP] + (size_t)l * 1024 * 4096, 1024, 4096, (bf16*)((unsigned char*)wl + WO_UP), kb * 64, nb * 32, nb * 32, scr, lane); continue; } r -= IT_UP;
        { const int kb = r / 32, nb = r % 32; transpose_item(p.in[I_WDOWN] + (size_t)l * 4096 * 1024, 4096, 1024, (bf16*)((unsigned char*)wl + WO_DOWN), kb * 64, nb * 32, nb * 32, scr, lane); }
    }
    for (int i = gw * 64 + lane; i < DEPTH * 28672; i += NGW * 64) { const int l = i / 28672, r = i % 28672;
        ((v4u*)(ws + WS_W + (size_t)l * W_LSTRIDE + WO_IN + (size_t)IN_WIDTH * D * 2))[r] = (v4u){0u, 0u, 0u, 0u}; }
    for (int i = gw * 64 + lane; i < 256 * 1024; i += NGW * 64) { const int r = i >> 10, c = i & 1023;
        float v = 0.f; if (r < NB) v = p.in[I_CP][r * D + c]; else if (r < NCOND) v = p.in[I_CS][(r - NB) * D + c];
        ((bf16*)(ws + WS_AC))[i] = f2bf(siluf_(v)); }
    for (int c = gw * 64 + lane; c < 1024; c += NGW * 64) { float v[DEPTH], mx = -3.0e38f;
#pragma unroll
        for (int l = 0; l < DEPTH; ++l) { v[l] = p.in[I_LB][l * 1024 + c]; mx = fmaxf(mx, v[l]); }
        float s = 0.f;
#pragma unroll
        for (int l = 0; l < DEPTH; ++l) { v[l] = expf(v[l] - mx); s += v[l]; }
        float cum = 0.f; float* lbs = (float*)(ws + WS_LBS);
#pragma unroll
        for (int l = 0; l < DEPTH; ++l) { if (l > 0) cum += v[l] / s; lbs[l * 1024 + c] = cum; }
    }
}

__device__ __forceinline__ f32x4 unpack4(unsigned long long w) { const unsigned lo = (unsigned)w, hi = (unsigned)(w >> 32); return (f32x4){__uint_as_float(lo << 16), __uint_as_float(lo & 0xffff0000u), __uint_as_float(hi << 16), __uint_as_float(hi & 0xffff0000u)}; }
template <int MODE, int NR>
__device__ __forceinline__ void norm_rows(const float* X32, bf16* X, bf16* H, float* out32, const f32x4 (&mul)[4], const f32x4 (&sh)[4], int lane) {
    if constexpr (MODE == 1) {
        f32x4 v[NR][4];
#pragma unroll
        for (int r = 0; r < NR; ++r) { const f32x4* xr = (const f32x4*)(X32 + (size_t)r * D) + lane;
#pragma unroll
            for (int j = 0; j < 4; ++j) v[r][j] = xr[64 * j]; }
#pragma unroll
        for (int r = 0; r < NR; ++r) { float s = 0.f;
#pragma unroll
            for (int j = 0; j < 4; ++j) s += (v[r][j].x * v[r][j].x + v[r][j].y * v[r][j].y) + (v[r][j].z * v[r][j].z + v[r][j].w * v[r][j].w);
            const float rstd = rsqrtf(wave_sum(s) * (1.f / D) + EPS);
            unsigned long long* o8 = (unsigned long long*)(H + (size_t)r * D) + lane; unsigned long long* x8 = (unsigned long long*)(X + (size_t)r * D) + lane;
#pragma unroll
            for (int j = 0; j < 4; ++j) { const f32x4 y = v[r][j] * rstd * mul[j] + sh[j];
                x8[64 * j] = (unsigned long long)pk2(v[r][j].x, v[r][j].y) | ((unsigned long long)pk2(v[r][j].z, v[r][j].w) << 32);
                o8[64 * j] = (unsigned long long)pk2(y.x, y.y) | ((unsigned long long)pk2(y.z, y.w) << 32); } }
    } else {
        unsigned long long raw[NR][4];
#pragma unroll
        for (int r = 0; r < NR; ++r) { const unsigned long long* xr = (const unsigned long long*)(X + (size_t)r * D) + lane;
#pragma unroll
            for (int j = 0; j < 4; ++j) raw[r][j] = xr[64 * j]; }
#pragma unroll
        for (int r = 0; r < NR; ++r) { f32x4 v[4]; float s = 0.f;
#pragma unroll
            for (int j = 0; j < 4; ++j) { v[j] = unpack4(raw[r][j]); s += (v[j].x * v[j].x + v[j].y * v[j].y) + (v[j].z * v[j].z + v[j].w * v[j].w); }
            const float rstd = rsqrtf(wave_sum(s) * (1.f / D) + EPS);
            if constexpr (MODE == 2) { f32x4* o = (f32x4*)(out32 + (size_t)r * D) + lane;
#pragma unroll
                for (int j = 0; j < 4; ++j) o[64 * j] = v[j] * rstd * mul[j];
            } else { unsigned long long* o8 = (unsigned long long*)(H + (size_t)r * D) + lane;
#pragma unroll
                for (int j = 0; j < 4; ++j) { const f32x4 y = v[j] * rstd * mul[j] + sh[j]; o8[64 * j] = (unsigned long long)pk2(y.x, y.y) | ((unsigned long long)pk2(y.z, y.w) << 32); } } }
    }
}
template <int MODE>
__device__ __forceinline__ void phase_norm(const float* Xp32, const float* Xs32, bf16* X, bf16* H, const float* nw, const float* mod_sh, const float* mod_sc, int gw, int NGW, int lane) {
    f32x4 w4[4];
#pragma unroll
    for (int j = 0; j < 4; ++j) w4[j] = ((const f32x4*)nw)[lane + 64 * j];
    for (int b = gw; b < MP / 8; b += NGW) {
        const int ci = b >> 8; f32x4 mul[4], sh[4];
        const f32x4* shp = (const f32x4*)(mod_sh + (size_t)ci * MODLD) + lane; const f32x4* scp = (const f32x4*)(mod_sc + (size_t)ci * MODLD) + lane;
#pragma unroll
        for (int j = 0; j < 4; ++j) { sh[j] = shp[64 * j]; mul[j] = w4[j] * (scp[64 * j] + 1.0f); }
        const size_t ro = (size_t)b * 8 * D;
        norm_rows<MODE, MODE == 1 ? 4 : 8>(MODE == 1 ? Xp32 + ro : nullptr, X + ro, H + ro, nullptr, mul, sh, lane);
        if constexpr (MODE == 1) norm_rows<MODE, 4>(Xp32 + ro + 4 * D, X + ro + 4 * D, H + ro + 4 * D, nullptr, mul, sh, lane);
    }
    for (int sr = gw; sr < MS; sr += NGW) {
        const int ci = NB + sr; f32x4 mul[4], sh[4];
        const f32x4* shp = (const f32x4*)(mod_sh + (size_t)ci * MODLD) + lane; const f32x4* scp = (const f32x4*)(mod_sc + (size_t)ci * MODLD) + lane;
#pragma unroll
        for (int j = 0; j < 4; ++j) { sh[j] = shp[64 * j]; mul[j] = w4[j] * (scp[64 * j] + 1.0f); }
        const size_t ro = (size_t)(MP + sr) * D;
        norm_rows<MODE, 1>(MODE == 1 ? Xs32 + (size_t)sr * D : nullptr, X + ro, H + ro, nullptr, mul, sh, lane);
    }
}
__device__ __forceinline__ void phase_final(const bf16* X, float* out, const float* nw, int gw, int NGW, int lane) {
    f32x4 w4[4];
#pragma unroll
    for (int j = 0; j < 4; ++j) w4[j] = ((const f32x4*)nw)[lane + 64 * j];
    for (int b = gw; b < MP / 8; b += NGW) { const size_t ro = (size_t)b * 8 * D; norm_rows<2, 8>(nullptr, (bf16*)X + ro, nullptr, out + ro, w4, w4, lane); }
    for (int sr = gw; sr < MS; sr += NGW) { const size_t ro = (size_t)(MP + sr) * D; norm_rows<2, 1>(nullptr, (bf16*)X + ro, nullptr, out + ro, w4, w4, lane); }
}


typedef short s16x4 __attribute__((ext_vector_type(4)));
typedef short bf16x8 __attribute__((ext_vector_type(8)));
__device__ __forceinline__ f32x4 mfma16(bf16x8 a, bf16x8 b, f32x4 c) { return __builtin_amdgcn_mfma_f32_16x16x32_bf16(a, b, c, 0, 0, 0); }
__device__ __forceinline__ s16x4 tr_read4(LAS unsigned char* p) { return __builtin_amdgcn_ds_read_tr16_b64_v4i16((LAS s16x4*)p); }
#define SHFL_XOR(v, M) swz_xor<M>(v)
__device__ __forceinline__ float shfl_up_f(float v, int o, int lane) { return __int_as_float(__builtin_amdgcn_ds_bpermute((lane >= o ? lane - o : lane) << 2, __float_as_int(v))); }
__device__ __forceinline__ void sync_threads() { __syncthreads(); }
__device__ __forceinline__ float __builtin_amdgcn_exp2f_(float x) { return __builtin_amdgcn_exp2f(x); }
#ifdef HOST_EMU
#define FENCE_MEM() do {} while (0)
#define SCHED_FENCE() do {} while (0)
#define LAUNDER_PTR(p) do {} while (0)
#else
#define LAUNDER_PTR(p) asm volatile("" : "+v"(p))
#define FENCE_MEM() asm volatile("" ::: "memory")
#define SCHED_FENCE() __builtin_amdgcn_sched_barrier(0)
#endif
constexpr int RC = 64;
constexpr int NSEG = 4, SEGLEN = 512, NCH = SEGLEN / RC;
constexpr int PQ = 272;
constexpr int PX = 528;

struct RecurBufs {
    bf16* proj;
    bf16* xbcc;
    float* dtv;
    float* cum;
    float* cv;
    float* sseg;
    float* dseg;
    float* hseg;
    float* tseg;
    bf16* ohg;
    bf16* y;
};

__device__ __forceinline__ bf16x8 frag_rows(LAS unsigned char* img, int pitch, int row, int kcol) { return *(LAS bf16x8*)(img + row * pitch + kcol * 2); }
__device__ __forceinline__ bf16x8 frag_tr(LAS unsigned char* img, int pitch, int k0a, int k0b, int col0, int lane) {
    const int q = (lane & 15) >> 2, p = lane & 3;
    const s16x4 a = tr_read4(img + (k0a + q) * pitch + (col0 + 4 * p) * 2);
    const s16x4 b = tr_read4(img + (k0b + q) * pitch + (col0 + 4 * p) * 2);
    return (bf16x8){a[0], a[1], a[2], a[3], b[0], b[1], b[2], b[3]};
}
__device__ __forceinline__ bf16x8 scale_frag(bf16x8 f, float s) {
    bf16x8 o;
#pragma unroll
    for (int j = 0; j < 8; ++j) o[j] = (short)f2bf(bf2f((bf16)f[j]) * s);
    return o;
}
__device__ __forceinline__ bf16x8 scale_frag8(bf16x8 f, const float (&s)[8]) {
    bf16x8 o;
#pragma unroll
    for (int j = 0; j < 8; ++j) o[j] = (short)f2bf(bf2f((bf16)f[j]) * s[j]);
    return o;
}
__device__ __forceinline__ void stage_tile128(const bf16* g, size_t ld, LAS unsigned char* img, int tid) {
#pragma unroll
    for (int i = 0; i < 2; ++i) { const int idx = tid + i * 512, r = idx >> 4, c16 = idx & 15;
        *(LAS v4u*)(img + r * PQ + c16 * 16) = *(const v4u*)(g + (size_t)r * ld + c16 * 8); }
}

constexpr int HG_QT = 0, HG_KT = 17408, HG_V = 34816, HG_PART = 52224, HG_VEC1 = 54272, HG_ST = 52224, HG_VEC = 87040, HG_RED = 89088;

__device__ __forceinline__ void hgrn_state_update(f32x4 (&S)[8], LAS unsigned char* Kt, LAS unsigned char* V, const LAS float* escale, const LAS float* edec, int w, int lane) {
    const int c = lane & 15, g = lane >> 4;
    const f32x4 dc = *(const LAS f32x4*)(edec + 16 * w + 4 * g);
#pragma unroll
    for (int et = 0; et < 8; ++et) S[et] = S[et] * dc;
    const float es = escale[16 * w + c];
#pragma unroll
    for (int ks = 0; ks < 2; ++ks) {
        const bf16x8 A = scale_frag(frag_tr(Kt, PQ, 32 * ks + 8 * g, 32 * ks + 8 * g + 4, 16 * w, lane), es);
#pragma unroll
        for (int et = 0; et < 8; ++et) { const bf16x8 B = frag_tr(V, PQ, 32 * ks + 8 * g, 32 * ks + 8 * g + 4, 16 * et, lane); S[et] = mfma16(A, B, S[et]); }
        SCHED_FENCE();
    }
}

__device__ __forceinline__ void hgrn_pass1(const RecurBufs& rb, const float* lbs_l, int u, int tid, LAS unsigned char* lds) {
    const int b = u >> 5, h = (u >> 2) & 7, seg = u & 3, lane = tid & 63, w = tid >> 6;
    const int d = tid & 127, jq = tid >> 7;
    LAS unsigned char* Qt = lds + HG_QT; LAS unsigned char* Kt = lds + HG_KT; LAS unsigned char* V = lds + HG_V; LAS float* part = (LAS float*)(lds + HG_PART); LAS float* vec = (LAS float*)(lds + HG_VEC1);
    const float lb = lbs_l[h * 128 + d];
    f32x4 S[8];
#pragma unroll
    for (int et = 0; et < 8; ++et) S[et] = (f32x4){0.f, 0.f, 0.f, 0.f};
    float dprod = 1.f;
    const int sr = tid >> 4, sc16 = tid & 15;
    v4u pre[6];
    {   const bf16* gq = rb.proj + ((size_t)b * SEQ + seg * SEGLEN + sr) * LDP + PC_Q + h * 128 + sc16 * 8;
        pre[0] = *(const v4u*)gq; pre[1] = *(const v4u*)(gq + 32 * (size_t)LDP); pre[2] = *(const v4u*)(gq + PC_F); pre[3] = *(const v4u*)(gq + 32 * (size_t)LDP + PC_F);
        pre[4] = *(const v4u*)(gq + PC_I); pre[5] = *(const v4u*)(gq + 32 * (size_t)LDP + PC_I); }
    for (int ch = 0; ch < NCH; ++ch) {
        const size_t row0 = (size_t)b * SEQ + seg * SEGLEN + ch * RC;
        bf16* gq = rb.proj + (row0 + sr) * LDP + PC_Q + h * 128 + sc16 * 8;
        *(LAS v4u*)(Qt + sr * PQ + sc16 * 16) = pre[0]; *(LAS v4u*)(Qt + (sr + 32) * PQ + sc16 * 16) = pre[1];
        *(LAS v4u*)(Kt + sr * PQ + sc16 * 16) = pre[2]; *(LAS v4u*)(Kt + (sr + 32) * PQ + sc16 * 16) = pre[3];
        *(LAS v4u*)(V + sr * PQ + sc16 * 16) = pre[4]; *(LAS v4u*)(V + (sr + 32) * PQ + sc16 * 16) = pre[5];
        if (ch + 1 < NCH) { const bf16* gn = gq + RC * (size_t)LDP;
            pre[0] = *(const v4u*)gn; pre[1] = *(const v4u*)(gn + 32 * (size_t)LDP); pre[2] = *(const v4u*)(gn + PC_F); pre[3] = *(const v4u*)(gn + 32 * (size_t)LDP + PC_F);
            pre[4] = *(const v4u*)(gn + PC_I); pre[5] = *(const v4u*)(gn + 32 * (size_t)LDP + PC_I); }
        sync_threads();
        float qq[16], kk[16], lg[16];
#pragma unroll
        for (int j = 0; j < 16; ++j) { const float q = bf2f(*(const LAS bf16*)(Qt + (16 * jq + j) * PQ + d * 2)), f = bf2f(*(const LAS bf16*)(Kt + (16 * jq + j) * PQ + d * 2));
            const float fg = lb + (1.f - lb) * sigmoidf_(f);
            qq[j] = siluf_(q) * 0.08838834764831845f; kk[j] = 1.f - fg; lg[j] = __logf(fg); }
#pragma unroll
        for (int j = 1; j < 16; ++j) lg[j] += lg[j - 1];
        part[jq * 128 + d] = lg[15];
        sync_threads();
        const float p0 = part[d], p1 = part[128 + d], p2 = part[256 + d], p3 = part[384 + d];
        const float off = (jq > 0 ? p0 : 0.f) + (jq > 1 ? p1 : 0.f) + (jq > 2 ? p2 : 0.f);
        const float bref = p0 + p1, bend = (p0 + p1) + (p2 + p3);
#pragma unroll
        for (int j = 0; j < 16; ++j) { const float e1 = __expf(fminf(fmaxf(off + lg[j] - bref, -80.f), 80.f));
            *(LAS bf16*)(Qt + (16 * jq + j) * PQ + d * 2) = f2bf(qq[j] * e1); *(LAS bf16*)(Kt + (16 * jq + j) * PQ + d * 2) = f2bf(kk[j] * frcp_(e1)); }
        if (jq == 0) { const float eref = __expf(bref), esc = __expf(bend - bref), edc = __expf(bend);
            float* cvp = rb.cv + ((size_t)((b * 8 + h) * 32 + seg * NCH + ch) * 3) * 128;
            cvp[d] = eref; cvp[128 + d] = esc; cvp[256 + d] = edc; vec[128 + d] = esc; vec[256 + d] = edc; }
        dprod *= __expf(bend);
        sync_threads();
        *(v4u*)gq = *(const LAS v4u*)(Qt + sr * PQ + sc16 * 16); *(v4u*)(gq + 32 * (size_t)LDP) = *(const LAS v4u*)(Qt + (sr + 32) * PQ + sc16 * 16);
        *(v4u*)(gq + PC_F) = *(const LAS v4u*)(Kt + sr * PQ + sc16 * 16); *(v4u*)(gq + 32 * (size_t)LDP + PC_F) = *(const LAS v4u*)(Kt + (sr + 32) * PQ + sc16 * 16);
        hgrn_state_update(S, Kt, V, vec + 128, vec + 256, w, lane);
        sync_threads();
    }
    float* sp = rb.sseg + (size_t)u * 16384 + tid * 4;
#pragma unroll
    for (int et = 0; et < 8; ++et) { LAUNDER_PTR(sp); *(f32x4*)sp = S[et]; sp += 2048; }
    if (jq == 0) rb.dseg[u * 128 + d] = dprod;
}

__device__ __forceinline__ void hgrn_pass2(const RecurBufs& rb, const float* hgn_l, float* state_out_l, int u, int tid, LAS unsigned char* lds) {
    const int b = u >> 5, h = (u >> 2) & 7, seg = u & 3, lane = tid & 63, w = tid >> 6, c = lane & 15, g = lane >> 4;
    const int it = w & 3, eh = w >> 2;
    LAS unsigned char* Qt = lds + HG_QT; LAS unsigned char* Kt = lds + HG_KT; LAS unsigned char* V = lds + HG_V; LAS unsigned char* ST = lds + HG_ST;
    LAS float* vec = (LAS float*)(lds + HG_VEC); LAS float* red = (LAS float*)(lds + HG_RED);
    f32x4 S[8];
#pragma unroll
    for (int et = 0; et < 8; ++et) S[et] = (f32x4){0.f, 0.f, 0.f, 0.f};
    for (int s = 0; s < seg; ++s) { const int u2 = u - seg + s;
        const f32x4 dc = *(const f32x4*)(rb.dseg + u2 * 128 + 16 * w + 4 * g);
        const float* sp = rb.sseg + (size_t)u2 * 16384 + tid * 4;
#pragma unroll
        for (int et = 0; et < 8; ++et) { LAUNDER_PTR(sp); S[et] = S[et] * dc + *(const f32x4*)sp; sp += 2048; } }
    const int e0 = 64 * eh + 4 * c;
    const f32x4 hn = *(const f32x4*)(hgn_l + e0);
    const float* cvb = rb.cv + ((size_t)((b * 8 + h) * 32 + seg * NCH) * 3) * 128;
    const int sr = tid >> 4, sc16 = tid & 15;
    const size_t rowS = (size_t)b * SEQ + seg * SEGLEN;
    v4u pre[6];
    {   const bf16* gq = rb.proj + (rowS + sr) * LDP + PC_Q + h * 128 + sc16 * 8;
        pre[0] = *(const v4u*)gq; pre[1] = *(const v4u*)(gq + 32 * (size_t)LDP); pre[2] = *(const v4u*)(gq + PC_F); pre[3] = *(const v4u*)(gq + 32 * (size_t)LDP + PC_F);
        pre[4] = *(const v4u*)(gq + PC_I); pre[5] = *(const v4u*)(gq + 32 * (size_t)LDP + PC_I); }
    float cvn = tid < 384 ? cvb[tid] : 0.f; f32x4 ern = *(const f32x4*)(cvb + 16 * w + 4 * g);
    for (int ch = 0; ch < NCH; ++ch) {
        const size_t row0 = rowS + ch * RC;
        *(LAS v4u*)(Qt + sr * PQ + sc16 * 16) = pre[0]; *(LAS v4u*)(Qt + (sr + 32) * PQ + sc16 * 16) = pre[1];
        *(LAS v4u*)(Kt + sr * PQ + sc16 * 16) = pre[2]; *(LAS v4u*)(Kt + (sr + 32) * PQ + sc16 * 16) = pre[3];
        *(LAS v4u*)(V + sr * PQ + sc16 * 16) = pre[4]; *(LAS v4u*)(V + (sr + 32) * PQ + sc16 * 16) = pre[5];
        if (ch + 1 < NCH) { const bf16* gq = rb.proj + (row0 + RC + sr) * LDP + PC_Q + h * 128 + sc16 * 8;
            pre[0] = *(const v4u*)gq; pre[1] = *(const v4u*)(gq + 32 * (size_t)LDP); pre[2] = *(const v4u*)(gq + PC_F); pre[3] = *(const v4u*)(gq + 32 * (size_t)LDP + PC_F);
            pre[4] = *(const v4u*)(gq + PC_I); pre[5] = *(const v4u*)(gq + 32 * (size_t)LDP + PC_I); }
        if (tid < 384) vec[tid] = cvn;
        {
            const f32x4 er = ern;
            if (ch + 1 < NCH) { if (tid < 384) cvn = cvb[(size_t)(ch + 1) * 384 + tid]; ern = *(const f32x4*)(cvb + (size_t)(ch + 1) * 384 + 16 * w + 4 * g); }
#pragma unroll
            for (int et = 0; et < 8; ++et) { const f32x4 v = S[et] * er;
                *(LAS unsigned long long*)(ST + (16 * et + c) * PQ + (16 * w + 4 * g) * 2) = (unsigned long long)pk2(v[0], v[1]) | ((unsigned long long)pk2(v[2], v[3]) << 32); } }
        unsigned long long ogv[4];
#pragma unroll
        for (int r = 0; r < 4; ++r) ogv[r] = *(const unsigned long long*)(rb.proj + (row0 + 16 * it + 4 * g + r) * LDP + PC_OG + h * 128 + e0);
        sync_threads();
        bf16x8 Qfr[4];
#pragma unroll
        for (int kd = 0; kd < 4; ++kd) Qfr[kd] = frag_rows(Qt, PQ, 16 * it + c, 32 * kd + 8 * g);
        unsigned PT[4][2];
#pragma unroll
        for (int jt = 0; jt < 4; ++jt) {
            f32x4 acc = (f32x4){0.f, 0.f, 0.f, 0.f};
            if (jt <= it) {
#pragma unroll
                for (int kd = 0; kd < 4; ++kd) acc = mfma16(frag_rows(Kt, PQ, 16 * jt + c, 32 * kd + 8 * g), Qfr[kd], acc);
                if (jt == it) {
#pragma unroll
                    for (int r = 0; r < 4; ++r) acc[r] = (4 * g + r <= c) ? acc[r] : 0.f; }
            }
            PT[jt][0] = pk2(acc[0], acc[1]); PT[jt][1] = pk2(acc[2], acc[3]); SCHED_FENCE();
        }
        f32x4 o[4];
#pragma unroll
        for (int et = 0; et < 4; ++et) o[et] = (f32x4){0.f, 0.f, 0.f, 0.f};
#pragma unroll
        for (int ks = 0; ks < 2; ++ks) if (2 * ks <= it) {
            v4u pa = (v4u){PT[2 * ks][0], PT[2 * ks][1], PT[2 * ks + 1][0], PT[2 * ks + 1][1]};
            const bf16x8 A = __builtin_bit_cast(bf16x8, pa);
#pragma unroll
            for (int et = 0; et < 4; ++et) o[et] = mfma16(A, frag_tr(V, PQ, 32 * ks + 4 * g, 32 * ks + 16 + 4 * g, 16 * (4 * eh + et), lane), o[et]);
        }
#pragma unroll
        for (int kd = 0; kd < 4; ++kd) {
#pragma unroll
            for (int et = 0; et < 4; ++et) o[et] = mfma16(Qfr[kd], frag_rows(ST, PQ, 16 * (4 * eh + et) + c, 32 * kd + 8 * g), o[et]);
            SCHED_FENCE(); }
        hgrn_state_update(S, Kt, V, vec + 128, vec + 256, w, lane);
        float ss[4];
#pragma unroll
        for (int r = 0; r < 4; ++r) { float s = 0.f;
#pragma unroll
            for (int et = 0; et < 4; ++et) s += o[et][r] * o[et][r];
            s += SHFL_XOR(s, 1); s += SHFL_XOR(s, 2); s += SHFL_XOR(s, 4); s += SHFL_XOR(s, 8); ss[r] = s; }
        if (c == 0) {
#pragma unroll
            for (int r = 0; r < 4; ++r) red[(16 * it + 4 * g + r) * 2 + eh] = ss[r]; }
        sync_threads();
#pragma unroll
        for (int r = 0; r < 4; ++r) { const int i = 16 * it + 4 * g + r; const float rstd = rsqrtf((red[i * 2] + red[i * 2 + 1]) * (1.f / 128.f) + EPS);
            float ov[4];
#pragma unroll
            for (int et = 0; et < 4; ++et) { const float og = bf2f((bf16)(ogv[r] >> (16 * et))); ov[et] = o[et][r] * rstd * hn[et] * siluf_(og); }
            *(unsigned long long*)(rb.ohg + (row0 + i) * 1024 + h * 128 + e0) = (unsigned long long)pk2(ov[0], ov[1]) | ((unsigned long long)pk2(ov[2], ov[3]) << 32); }
        sync_threads();
    }
    if (seg == NSEG - 1) { float* so = state_out_l + (size_t)(b * 8 + h) * 16384 + (size_t)(16 * w + 4 * g) * 128 + 4 * c;
#pragma unroll
        for (int r = 0; r < 4; ++r)
#pragma unroll
            for (int a = 0; a < 2; ++a) *(f32x4*)(so + r * 128 + 64 * a) = (f32x4){S[4 * a][r], S[4 * a + 1][r], S[4 * a + 2][r], S[4 * a + 3][r]}; }
}

constexpr int PR = 1040;
constexpr int SD_T = 0, SD_H = 66560, SD_XO = 66560  , SD_DT = 136192, SD_CUM = 137216, SD_RED = 138240, SD_END = 139264;
__device__ __forceinline__ int ssd_gcol(int grp, int ch16) { return ch16 < 32 ? grp * 256 + ch16 * 8 : (ch16 < 48 ? 2048 + grp * 128 + (ch16 - 32) * 8 : 3072 + grp * 128 + (ch16 - 48) * 8); }

__device__ __forceinline__ void ssd_state_update(f32x4 (&H)[4][4], LAS unsigned char* Xi, int xp, LAS unsigned char* Bi, int bp, const LAS float* sDt, const LAS float* sCum, int w, int lane) {
    const int g = lane >> 4, k = w >> 1, nh = w & 1;
    const float tot = sCum[63 * 4 + k]; const float et = __expf(tot);
#pragma unroll
    for (int nt = 0; nt < 4; ++nt)
#pragma unroll
        for (int pt = 0; pt < 4; ++pt) H[nt][pt] = H[nt][pt] * et;
#pragma unroll
    for (int ks = 0; ks < 2; ++ks) {
        float wg[8];
#pragma unroll
        for (int j = 0; j < 8; ++j) wg[j] = __expf(tot - sCum[(32 * ks + 8 * g + j) * 4 + k]) * sDt[(32 * ks + 8 * g + j) * 4 + k];
        bf16x8 Bx[4];
#pragma unroll
        for (int pt = 0; pt < 4; ++pt) Bx[pt] = scale_frag8(frag_tr(Xi, xp, 32 * ks + 8 * g, 32 * ks + 8 * g + 4, 64 * k + 16 * pt, lane), wg);
#pragma unroll
        for (int nt = 0; nt < 4; ++nt) { const bf16x8 A = frag_tr(Bi, bp, 32 * ks + 8 * g, 32 * ks + 8 * g + 4, 16 * (4 * nh + nt), lane);
#pragma unroll
            for (int pt = 0; pt < 4; ++pt) H[nt][pt] = mfma16(A, Bx[pt], H[nt][pt]);
            SCHED_FENCE(); }
    }
}

typedef float f32x2r __attribute__((ext_vector_type(2)));
__device__ __forceinline__ f32x2r unpack2(unsigned w) { return (f32x2r){__uint_as_float(w << 16), __uint_as_float(w & 0xffff0000u)}; }
__device__ __forceinline__ f32x2r silu2(f32x2r a) {
    const f32x2r t = a * (-1.4426950408889634f); f32x2r e; e.x = __builtin_amdgcn_exp2f_(t.x); e.y = __builtin_amdgcn_exp2f_(t.y);
    const f32x2r d = e + 1.0f; f32x2r r; r.x = frcp_(d.x); r.y = frcp_(d.y); return a * r; }
constexpr int SD_RH = SD_XO + 64 * PX;
__device__ __forceinline__ void ssd_pass1(const RecurBufs& rb, const float* conv_w, const float* conv_b, const float* dt_bias, const float* a_log, float* conv_out_l, int u, int tid, LAS unsigned char* lds) {
    const int b = u >> 5, grp = (u >> 2) & 7, seg = u & 3, lane = tid & 63, w = tid >> 6;
    LAS unsigned char* T = lds + SD_T; LAS float* sDt = (LAS float*)(lds + SD_DT); LAS float* sCum = (LAS float*)(lds + SD_CUM); LAS unsigned char* RH = lds + SD_RH;
    const int cp = tid & 255, half = tid >> 8, t0c = 2 * cp;
    const int chx = t0c < 256 ? (grp * 256 + t0c) : (t0c < 384 ? (2048 + grp * 128 + (t0c - 256)) : (3072 + grp * 128 + (t0c - 384)));
    const int xcol = (t0c & ~63) + 16 * (t0c & 3) + ((t0c & 63) >> 2);
    const f32x2r w0 = (f32x2r){conv_w[chx], conv_w[chx + 1]}, w1 = (f32x2r){conv_w[4096 + chx], conv_w[4096 + chx + 1]}, w2 = (f32x2r){conv_w[8192 + chx], conv_w[8192 + chx + 1]},
                 w3 = (f32x2r){conv_w[12288 + chx], conv_w[12288 + chx + 1]}, cb = (f32x2r){conv_b[chx], conv_b[chx + 1]};
    const size_t rowS = (size_t)b * SEQ + seg * SEGLEN;
    if (half == 0) {
#pragma unroll
        for (int j = 0; j < 3; ++j) { unsigned v = 0u; if (seg > 0) v = *(const unsigned*)(rb.proj + (rowS - 3 + j) * LDP + PC_XBC + chx); *(LAS unsigned*)(RH + j * 1024 + cp * 4) = v; } }
    f32x4 H[4][4];
#pragma unroll
    for (int nt = 0; nt < 4; ++nt)
#pragma unroll
        for (int pt = 0; pt < 4; ++pt) H[nt][pt] = (f32x4){0.f, 0.f, 0.f, 0.f};
    float tsum = 0.f;
    const int ch16 = tid & 63, rr = tid >> 6;
    const int gcol = ssd_gcol(grp, ch16);
    LAS unsigned char* XO = lds + SD_XO;
    v4u raw[8];
    {   const bf16* gp = rb.proj + (rowS + rr) * LDP + PC_XBC + gcol;
#pragma unroll
        for (int i = 0; i < 8; ++i) { LAUNDER_PTR(gp); raw[i] = *(const v4u*)gp; gp += 8 * (size_t)LDP; } }
    bf16 dtn = 0;
    if (w < 4) dtn = rb.proj[(rowS + lane) * LDP + PC_DT + grp * 4 + w];
    unsigned hr0 = 0u, hr1 = 0u, hr2 = 0u;
    for (int ch = 0; ch < NCH; ++ch) {
        const size_t row0 = rowS + ch * RC;
        if (w < 4) {
            const int head = grp * 4 + w; const size_t row = row0 + lane;
            const float dv = softplusf_(bf2f(dtn) + dt_bias[head]);
            if (ch + 1 < NCH) dtn = rb.proj[(row + RC) * LDP + PC_DT + head];
            float la = dv * (-__expf(a_log[head]));
#pragma unroll
            for (int o = 1; o < 64; o <<= 1) { const float t = shfl_up_f(la, o, lane); if (lane >= o) la += t; }
            sDt[lane * 4 + w] = dv; sCum[lane * 4 + w] = la; rb.dtv[row * 32 + head] = dv; rb.cum[row * 32 + head] = la;
        }
#pragma unroll
        for (int i = 0; i < 8; ++i) *(LAS v4u*)(T + (rr + 8 * i) * PR + ch16 * 16) = raw[i];
        if (ch + 1 < NCH) { const bf16* gp = rb.proj + (row0 + RC + rr) * LDP + PC_XBC + gcol;
#pragma unroll
            for (int i = 0; i < 8; ++i) { LAUNDER_PTR(gp); raw[i] = *(const v4u*)gp; gp += 8 * (size_t)LDP; } }
        sync_threads();
        if (half == 0) { hr0 = *(const LAS unsigned*)(RH + cp * 4); hr1 = *(const LAS unsigned*)(RH + 1024 + cp * 4); hr2 = *(const LAS unsigned*)(RH + 2048 + cp * 4); }
        else { hr0 = *(const LAS unsigned*)(T + 29 * PR + cp * 4); hr1 = *(const LAS unsigned*)(T + 30 * PR + cp * 4); hr2 = *(const LAS unsigned*)(T + 31 * PR + cp * 4); }
        sync_threads();
        {
            f32x2r r0 = unpack2(hr0), r1 = unpack2(hr1), r2 = unpack2(hr2);
            const LAS unsigned char* src = T + (32 * half) * PR + cp * 4;
            unsigned lastw0 = hr0, lastw1 = hr1, lastw2 = hr2;
#pragma unroll 8
            for (int j = 0; j < 32; ++j) { const unsigned cw = *(const LAS unsigned*)(src + j * PR); const f32x2r cur = unpack2(cw);
                const f32x2r a = cb + w0 * r0 + w1 * r1 + w2 * r2 + w3 * cur; r0 = r1; r1 = r2; r2 = cur; lastw0 = lastw1; lastw1 = lastw2; lastw2 = cw;
                const f32x2r v = silu2(a); const unsigned ow = pk2(v.x, v.y);
                if (cp < 128) { LAS unsigned char* d = XO + (32 * half + j) * PX + xcol * 2; *(LAS bf16*)d = (bf16)ow; *(LAS bf16*)(d + 32) = (bf16)(ow >> 16); }
                else *(LAS unsigned*)(T + (32 * half + j) * PR + cp * 4) = ow; }
            if (half == 1) { *(LAS unsigned*)(RH + cp * 4) = lastw0; *(LAS unsigned*)(RH + 1024 + cp * 4) = lastw1; *(LAS unsigned*)(RH + 2048 + cp * 4) = lastw2;
                hr0 = lastw0; hr1 = lastw1; hr2 = lastw2; }
        }
        sync_threads();
        tsum += sCum[63 * 4 + (w >> 1)];
        ssd_state_update(H, XO, PX, T + 512, PR, sDt, sCum, w, lane);
        {   bf16* gp = rb.xbcc + (row0 + rr) * 4096 + gcol;
            const LAS unsigned char* src = ch16 < 32 ? (XO + ch16 * 16) : (T + ch16 * 16); const int spitch = ch16 < 32 ? PX : PR;
#pragma unroll
            for (int i = 0; i < 8; ++i) { LAUNDER_PTR(gp); *(v4u*)gp = *(const LAS v4u*)(src + (rr + 8 * i) * spitch); gp += 8 * 4096; } }
        sync_threads();
    }
    float* hp = rb.hseg + (size_t)u * 32768 + tid * 4;
#pragma unroll
    for (int nt = 0; nt < 4; ++nt)
#pragma unroll
        for (int pt = 0; pt < 4; ++pt) { LAUNDER_PTR(hp); *(f32x4*)hp = H[nt][pt]; hp += 2048; }
    if ((tid & 127) == 0) rb.tseg[u * 4 + (w >> 1)] = tsum;
    if (seg == NSEG - 1 && half == 1) { float* co = conv_out_l + (size_t)b * 3 * 4096;
        const f32x2r a0 = unpack2(hr0), a1 = unpack2(hr1), a2 = unpack2(hr2);
        co[chx] = a0.x; co[chx + 1] = a0.y; co[4096 + chx] = a1.x; co[4096 + chx + 1] = a1.y; co[8192 + chx] = a2.x; co[8192 + chx + 1] = a2.y; }
}

__device__ __forceinline__ void ssd_pass2(const RecurBufs& rb, const float* d_skip, const float* ssm_norm, float* state_out_l, int u, int tid, LAS unsigned char* lds) {
    const int b = u >> 5, grp = (u >> 2) & 7, seg = u & 3, lane = tid & 63, w = tid >> 6, c = lane & 15, g = lane >> 4;
    const int k = w >> 1, hf = w & 1, head = grp * 4 + k;
    LAS unsigned char* T = lds + SD_T; LAS unsigned char* sB = T + 512; LAS unsigned char* sC = T + 768; LAS unsigned char* hS = lds + SD_H + k * (64 * PQ);
    LAS float* sDt = (LAS float*)(lds + SD_DT); LAS float* sCum = (LAS float*)(lds + SD_CUM); LAS float* red = (LAS float*)(lds + SD_RED);
    f32x4 H[4][4];
#pragma unroll
    for (int nt = 0; nt < 4; ++nt)
#pragma unroll
        for (int pt = 0; pt < 4; ++pt) H[nt][pt] = (f32x4){0.f, 0.f, 0.f, 0.f};
    for (int s = 0; s < seg; ++s) { const int u2 = u - seg + s; const float dc = __expf(rb.tseg[u2 * 4 + k]); const float* hp = rb.hseg + (size_t)u2 * 32768 + tid * 4;
#pragma unroll
        for (int nt = 0; nt < 4; ++nt)
#pragma unroll
            for (int pt = 0; pt < 4; ++pt) { LAUNDER_PTR(hp); H[nt][pt] = H[nt][pt] * dc + *(const f32x4*)hp; hp += 2048; } }
    const float Dk = d_skip[head];
    const size_t rowS = (size_t)b * SEQ + seg * SEGLEN;
    const int ch16 = tid & 63, rr = tid >> 6; const int gcol = ssd_gcol(grp, ch16);
    const int chn0 = grp * 256 + k * 64 + 4 * c;
    for (int ch = 0; ch < NCH; ++ch) {
        const size_t row0 = rowS + ch * RC;
        {   v4u raw[8];
            {   const bf16* gp = rb.xbcc + (row0 + rr) * 4096 + gcol;
#pragma unroll
                for (int i = 0; i < 8; ++i) { LAUNDER_PTR(gp); raw[i] = *(const v4u*)gp; gp += 8 * 4096; } }
            if (tid < 256) { sDt[tid] = rb.dtv[(row0 + (tid >> 2)) * 32 + grp * 4 + (tid & 3)]; sCum[tid] = rb.cum[(row0 + (tid >> 2)) * 32 + grp * 4 + (tid & 3)]; }
#pragma unroll
            for (int nt = 0; nt < 4; ++nt)
#pragma unroll
                for (int pt = 0; pt < 4; ++pt) { const f32x4 v = H[nt][pt];
                    *(LAS unsigned long long*)(hS + (4 * c + pt) * PQ + (16 * (4 * hf + nt) + 4 * g) * 2) = (unsigned long long)pk2(v[0], v[1]) | ((unsigned long long)pk2(v[2], v[3]) << 32); }
#pragma unroll
            for (int i = 0; i < 8; ++i) *(LAS v4u*)(T + (rr + 8 * i) * PR + ch16 * 16) = raw[i]; }
        sync_threads();
#pragma unroll 1
        for (int i2 = 0; i2 < 2; ++i2) {
            const int it = i2 ? 3 - hf : hf;
            unsigned long long zz[4];
#pragma unroll
            for (int r = 0; r < 4; ++r) zz[r] = *(const unsigned long long*)(rb.proj + (row0 + 16 * it + 4 * g + r) * LDP + PC_Z + chn0);
            f32x4 ya[4];
#pragma unroll
            for (int pt = 0; pt < 4; ++pt) ya[pt] = (f32x4){0.f, 0.f, 0.f, 0.f};
#pragma unroll
            for (int kn = 0; kn < 4; ++kn) { const bf16x8 Cf = frag_rows(sC, PR, 16 * it + c, 32 * kn + 8 * g);
#pragma unroll
                for (int pt = 0; pt < 4; ++pt) ya[pt] = mfma16(Cf, frag_rows(hS, PQ, 4 * c + pt, 32 * kn + 8 * g), ya[pt]);
                SCHED_FENCE(); }
            {   float ei[4];
#pragma unroll
                for (int r = 0; r < 4; ++r) ei[r] = __expf(sCum[(16 * it + 4 * g + r) * 4 + k]);
#pragma unroll
                for (int pt = 0; pt < 4; ++pt)
#pragma unroll
                    for (int r = 0; r < 4; ++r) ya[pt][r] *= ei[r]; }
            const float cum_i = sCum[(16 * it + c) * 4 + k];
            unsigned PT[4][2];
#pragma unroll
            for (int jt = 0; jt < 4; ++jt) {
                f32x4 acc = (f32x4){0.f, 0.f, 0.f, 0.f};
                if (jt <= it) {
#pragma unroll
                    for (int kn = 0; kn < 4; ++kn) acc = mfma16(frag_rows(sB, PR, 16 * jt + c, 32 * kn + 8 * g), frag_rows(sC, PR, 16 * it + c, 32 * kn + 8 * g), acc);
#pragma unroll
                    for (int r = 0; r < 4; ++r) { const int j = 16 * jt + 4 * g + r; const float df = cum_i - sCum[j * 4 + k]; const bool keep = (jt < it) || (4 * g + r <= c);
                        acc[r] = keep ? acc[r] * __expf(fminf(df, 0.f)) * sDt[j * 4 + k] : 0.f; }
                }
                PT[jt][0] = pk2(acc[0], acc[1]); PT[jt][1] = pk2(acc[2], acc[3]); SCHED_FENCE();
            }
#pragma unroll
            for (int ks = 0; ks < 2; ++ks) if (2 * ks <= it) {
                v4u pa = (v4u){PT[2 * ks][0], PT[2 * ks][1], PT[2 * ks + 1][0], PT[2 * ks + 1][1]};
                const bf16x8 A = __builtin_bit_cast(bf16x8, pa);
#pragma unroll
                for (int pt = 0; pt < 4; ++pt) ya[pt] = mfma16(A, frag_tr(T, PR, 32 * ks + 4 * g, 32 * ks + 16 + 4 * g, 64 * k + 16 * pt, lane), ya[pt]);
                SCHED_FENCE();
            }
#pragma unroll
            for (int r = 0; r < 4; ++r) { const int i = 16 * it + 4 * g + r; float s = 0.f; float yv[4];
#pragma unroll
                for (int pt = 0; pt < 4; ++pt) { const float xc = bf2f(*(const LAS bf16*)(T + i * PR + (64 * k + 16 * pt + c) * 2)); const float z = bf2f((bf16)(zz[r] >> (16 * pt)));
                    const bf16 yb = f2bf((ya[pt][r] + Dk * xc) * siluf_(z)); yv[pt] = bf2f(yb); s += yv[pt] * yv[pt]; }
                *(unsigned long long*)(rb.y + (row0 + i) * 2048 + chn0) = (unsigned long long)pk2(yv[0], yv[1]) | ((unsigned long long)pk2(yv[2], yv[3]) << 32);
                s += SHFL_XOR(s, 1); s += SHFL_XOR(s, 2); s += SHFL_XOR(s, 4); s += SHFL_XOR(s, 8);
                if (c == 0) red[i * 4 + k] = s; }
            SCHED_FENCE();
        }
        ssd_state_update(H, T, PR, T + 512, PR, sDt, sCum, w, lane);
        sync_threads();
        {   const f32x4 nw = *(const f32x4*)(ssm_norm + chn0);
            unsigned long long yy[8];
            const int itA = hf, itB = 3 - hf;
            bf16* yb0 = rb.y + (row0 + 16 * itA + 4 * g) * 2048 + chn0;
            const int jump = (16 * (itB - itA) - 3) * 2048;
            {   bf16* yp = yb0;
#pragma unroll
                for (int q = 0; q < 8; ++q) { LAUNDER_PTR(yp); yy[q] = *(const unsigned long long*)yp; yp += (q == 3) ? jump : 2048; } }
            bf16* yp = yb0;
#pragma unroll
            for (int q = 0; q < 8; ++q) { const int i = 16 * (q < 4 ? itA : itB) + 4 * g + (q & 3);
                const float rstd = rsqrtf(((red[i * 4] + red[i * 4 + 1]) + (red[i * 4 + 2] + red[i * 4 + 3])) * (1.f / 256.f) + EPS);
                const unsigned lo = (unsigned)yy[q], hi = (unsigned)(yy[q] >> 32);
                const float y0 = __uint_as_float(lo << 16) * rstd * nw[0], y1 = __uint_as_float(lo & 0xffff0000u) * rstd * nw[1], y2 = __uint_as_float(hi << 16) * rstd * nw[2], y3 = __uint_as_float(hi & 0xffff0000u) * rstd * nw[3];
                LAUNDER_PTR(yp); *(unsigned long long*)yp = (unsigned long long)pk2(y0, y1) | ((unsigned long long)pk2(y2, y3) << 32); yp += (q == 3) ? jump : 2048; } }
        sync_threads();
    }
    if (seg == NSEG - 1) { float* so = state_out_l + ((size_t)(b * 32 + head) * 64 + 4 * c) * 128 + 64 * hf + 4 * g;
#pragma unroll
        for (int pt = 0; pt < 4; ++pt)
#pragma unroll
            for (int nt = 0; nt < 4; ++nt) *(f32x4*)(so + pt * 128 + 16 * nt) = H[nt][pt]; }
}

__device__ __forceinline__ float row32_sum(float s) { s += SHFL_XOR(s, 1); s += SHFL_XOR(s, 2); s += SHFL_XOR(s, 4); s += SHFL_XOR(s, 8); s += SHFL_XOR(s, 16); return s; }

__device__ __forceinline__ void hgrn_sample_load(f32x4 (&st)[8], const float* state_in, int bh, int tid) {
    const float* sp = state_in + (size_t)bh * 16384 + tid * 4;
#pragma unroll
    for (int it = 0; it < 8; ++it) { LAUNDER_PTR(sp); st[it] = __builtin_nontemporal_load((const f32x4*)sp); sp += 2048; }
}
__device__ __forceinline__ void hgrn_sample_step(const bf16* proj, const float* lbs_l, const float* hgn_l, const float* state_in, float* state_out, bf16* ohg, int bh, int tid, LAS unsigned char* lds,
                                                 f32x4 (&st)[8], int bh_next) {
    const int b = bh >> 3, h = bh & 7, lane = tid & 63, w = tid >> 6;
    LAS float* sq = (LAS float*)lds; LAS float* sg = sq + 128; LAS float* sk = sq + 256; LAS float* sv = sq + 384; LAS float* so = (LAS float*)(lds + 8192); LAS float* sred = (LAS float*)(lds + 16384);
    const size_t row = (size_t)MP + b;
    float ogv = 0.f, q_ = 0.f, f_ = 0.f, v_ = 0.f, lb_ = 0.f;
    if (tid < 128) { const bf16* pr = proj + row * LDP + h * 128; q_ = bf2f(pr[PC_Q + tid]); f_ = bf2f(pr[PC_F + tid]); lb_ = lbs_l[h * 128 + tid]; v_ = bf2f(pr[PC_I + hg_vpos(tid)]); ogv = bf2f(pr[PC_OG + tid]); }
    if (tid < 128) { const float fg = lb_ + (1.f - lb_) * sigmoidf_(f_);
        sq[tid] = siluf_(q_) * 0.08838834764831845f; sg[tid] = fg; sk[tid] = 1.f - fg; sv[tid] = v_; }
    sync_threads();
    const int dv4 = tid & 31, rg = tid >> 5;
    const f32x4 vv = *(const LAS f32x4*)(sv + 4 * dv4);
    f32x4 oacc = (f32x4){0.f, 0.f, 0.f, 0.f};
    float* op = state_out + (size_t)bh * 16384 + tid * 4;
    const float* np = state_in + (size_t)(bh_next >= 0 ? bh_next : bh) * 16384 + tid * 4;
#pragma unroll
    for (int it = 0; it < 8; ++it) { const int dk = it * 16 + rg; const f32x4 sn = st[it] * sg[dk] + vv * sk[dk]; LAUNDER_PTR(op); __builtin_nontemporal_store(sn, (f32x4*)op); op += 2048; oacc = oacc + sn * sq[dk];
        LAUNDER_PTR(np); if (bh_next >= 0) st[it] = __builtin_nontemporal_load((const f32x4*)np); np += 2048; }
    *(LAS f32x4*)(so + rg * 128 + 4 * dv4) = oacc;
    sync_threads();
    if (tid < 128) { float o = 0.f;
#pragma unroll
        for (int r = 0; r < 16; ++r) o += so[r * 128 + tid];
        float ss = o * o; ss = row32_sum(ss);
        if ((lane & 31) == 0) sred[tid >> 5] = ss;
        sq[tid] = o; }
    sync_threads();
    if (tid < 128) { const float rstd = rsqrtf(((sred[0] + sred[1]) + (sred[2] + sred[3])) * (1.f / 128.f) + EPS);
        ohg[row * 1024 + h * 128 + tid] = f2bf(sq[tid] * rstd * hgn_l[tid] * siluf_(ogv)); }
    sync_threads();
    (void)w;
}

__device__ __forceinline__ void ssd_sample_load(f32x4 (&st)[16], const float* state_in, int bg, int tid) {
    const float* sp = state_in + ((size_t)((bg >> 3) * 32 + (bg & 7) * 4)) * 8192 + tid * 4;
#pragma unroll
    for (int it = 0; it < 16; ++it) { LAUNDER_PTR(sp); st[it] = __builtin_nontemporal_load((const f32x4*)sp); sp += 2048; }
}
__device__ __forceinline__ void ssd_sample_step(const bf16* proj, const float* conv_w, const float* conv_b, const float* dt_bias, const float* a_log, const float* d_skip, const float* ssm_norm,
                                                const float* state_in, const float* conv_in, float* state_out, float* conv_out, bf16* ybuf, int bg, int tid, LAS unsigned char* lds,
                                                f32x4 (&st)[16], int bg_next) {
    const int b = bg >> 3, grp = bg & 7, lane = tid & 63, w = tid >> 6;
    LAS float* sx = (LAS float*)(lds + 2048); LAS float* sB = (LAS float*)(lds + 3072); LAS float* sC = (LAS float*)(lds + 3584); LAS float* sdt = (LAS float*)(lds + 4096); LAS float* sdec = (LAS float*)(lds + 4112);
    LAS float* sy = (LAS float*)(lds + 4608); LAS float* sred = (LAS float*)(lds + 16384);
    const size_t row = (size_t)MP + b;
    {
        const int chx = tid < 256 ? (grp * 256 + tid) : (tid < 384 ? (2048 + grp * 128 + (tid - 256)) : (3072 + grp * 128 + (tid - 384)));
        const float* ci = conv_in + (size_t)b * 3 * 4096; const float r0 = ci[chx], r1 = ci[4096 + chx], r2 = ci[8192 + chx];
        const float cur = bf2f(proj[row * LDP + PC_XBC + chx]);
        const float cw0 = conv_w[chx], cw1 = conv_w[4096 + chx], cw2 = conv_w[8192 + chx], cw3 = conv_w[12288 + chx], cbb = conv_b[chx];
        float dtr = 0.f, dtbv = 0.f, alg = 0.f; if (tid < 4) { const int head = grp * 4 + tid; dtr = bf2f(proj[row * LDP + PC_DT + head]); dtbv = dt_bias[head]; alg = a_log[head]; }
        const float a = cbb + cw0 * r0 + cw1 * r1 + cw2 * r2 + cw3 * cur;
        const float v = siluf_(a);
        if (tid < 256) sx[tid] = v; else if (tid < 384) sB[tid - 256] = v; else sC[tid - 384] = v;
        float* co = conv_out + (size_t)b * 3 * 4096; co[chx] = r1; co[4096 + chx] = r2; co[8192 + chx] = cur;
        if (tid < 4) { const float dv = softplusf_(dtr + dtbv); sdt[tid] = dv; sdec[tid] = __expf(dv * (-__expf(alg))); } }
    sync_threads();
    const int n4 = tid & 31, pr_ = tid >> 5;
    const f32x4 Bv = *(const LAS f32x4*)(sB + 4 * n4), Cv = *(const LAS f32x4*)(sC + 4 * n4);
    float* op = state_out + ((size_t)(b * 32 + grp * 4)) * 8192 + tid * 4;
    const int bgn = bg_next >= 0 ? bg_next : bg; const float* np = state_in + ((size_t)((bgn >> 3) * 32 + (bgn & 7) * 4)) * 8192 + tid * 4;
#pragma unroll
    for (int it = 0; it < 16; ++it) { const int k = it >> 2, p = (it & 3) * 16 + pr_; const float xdt = sx[k * 64 + p] * sdt[k];
        const f32x4 hn = st[it] * sdec[k] + Bv * xdt; LAUNDER_PTR(op); __builtin_nontemporal_store(hn, (f32x4*)op); op += 2048;
        LAUNDER_PTR(np); if (bg_next >= 0) st[it] = __builtin_nontemporal_load((const f32x4*)np); np += 2048;
        const f32x4 t = hn * Cv; float y = (t[0] + t[1]) + (t[2] + t[3]); y = row32_sum(y);
        if ((lane & 31) == 0) sy[k * 64 + p] = y; }
    sync_threads();
    float yv = 0.f;
    if (tid < 256) { const int k = tid >> 6; const float z = bf2f(proj[row * LDP + PC_Z + grp * 256 + tid]);
        yv = (sy[tid] + d_skip[grp * 4 + k] * sx[tid]) * siluf_(z);
        float ss = yv * yv; ss = row32_sum(ss); if ((lane & 31) == 0) sred[tid >> 5] = ss; }
    sync_threads();
    if (tid < 256) { float tot = 0.f;
#pragma unroll
        for (int r = 0; r < 8; ++r) tot += sred[r];
        ybuf[row * 2048 + grp * 256 + tid] = f2bf(yv * rsqrtf(tot * (1.f / 256.f) + EPS) * ssm_norm[grp * 256 + tid]); }
    sync_threads();
    (void)w;
}

static_assert(SD_END <= LDS_BYTES - 256, "LDS map");
static_assert(8 * 16384 <= LDS_BYTES - 256, "skinny LDS");
constexpr int SK_PART = 128 * 32 * 4;
template <int RT, class Epi>
__device__ __forceinline__ void skinny_gemm(const bf16* A, size_t lda, const bf16* Bt, int K, int N, const Epi& epi, int wg, int wg_first, int wg_count, int tid, LAS unsigned char* lds) {
    const int lane = tid & 63, w = tid >> 6, c = lane & 15, g = lane >> 4;
    constexpr int NRG = 8 / RT;
    const int nunit = (N / 32) * NRG, ksteps = K / 256;
    int me = wg - wg_first; if (me < 0 || me >= wg_count) return;
    for (int s = me; s < nunit; s += wg_count) {
        const int n0 = 32 * (s / NRG), r0 = (s % NRG) * (16 * RT);
        f32x4 acc[RT][2];
#pragma unroll
        for (int rt = 0; rt < RT; ++rt) { acc[rt][0] = (f32x4){0.f, 0.f, 0.f, 0.f}; acc[rt][1] = (f32x4){0.f, 0.f, 0.f, 0.f}; }
        const bf16* ap = A + (size_t)(r0 + c) * lda + (size_t)w * (K / 8) + 8 * g;
        const bf16* bp = Bt + (size_t)(n0 + c) * K + (size_t)w * (K / 8) + 8 * g;
#pragma unroll 4
        for (int ks = 0; ks < ksteps; ++ks) {
            bf16x8 af[RT], bfr[2];
#pragma unroll
            for (int rt = 0; rt < RT; ++rt) af[rt] = *(const bf16x8*)(ap + (size_t)(16 * rt) * lda + 32 * ks);
            bfr[0] = *(const bf16x8*)(bp + 32 * ks); bfr[1] = *(const bf16x8*)(bp + (size_t)16 * K + 32 * ks);
#pragma unroll
            for (int rt = 0; rt < RT; ++rt) { acc[rt][0] = mfma16(af[rt], bfr[0], acc[rt][0]); acc[rt][1] = mfma16(af[rt], bfr[1], acc[rt][1]); }
        }
        LAS float* part = (LAS float*)(lds + w * SK_PART);
#pragma unroll
        for (int rt = 0; rt < RT; ++rt)
#pragma unroll
            for (int nt = 0; nt < 2; ++nt)
#pragma unroll
                for (int r = 0; r < 4; ++r) part[(16 * rt + 4 * g + r) * 32 + 16 * nt + c] = acc[rt][nt][r];
        sync_threads();
        if (RT == 8 || tid < 64 * RT) {
            const int row = tid >> 2, c8 = (tid & 3) * 8;
            f32x4 v0 = (f32x4){0.f, 0.f, 0.f, 0.f}, v1 = (f32x4){0.f, 0.f, 0.f, 0.f};
#pragma unroll
            for (int ww = 0; ww < 8; ++ww) { const LAS float* pp = (const LAS float*)(lds + ww * SK_PART) + row * 32 + c8; v0 = v0 + *(const LAS f32x4*)pp; v1 = v1 + *(const LAS f32x4*)(pp + 4); }
            epi(r0 + row, n0 + c8, v0, v1);
        }
        sync_threads();
    }
}
struct SkStoreBf16 { bf16* O; int ld; int act;
    __device__ __forceinline__ void operator()(int row, int col, f32x4 v0, f32x4 v1) const {
        if (act) {
#pragma unroll
            for (int j = 0; j < 4; ++j) { const float a = fmaxf(v0[j], 0.f), b = fmaxf(v1[j], 0.f); v0[j] = a * a; v1[j] = b * b; } }
        v4u o; o.x = pk2(v0[0], v0[1]); o.y = pk2(v0[2], v0[3]); o.z = pk2(v1[0], v1[1]); o.w = pk2(v1[2], v1[3]);
        *(v4u*)(O + (size_t)row * ld + col) = o; } };
__device__ __forceinline__ void sk_unpack8(const v4u w, f32x4& lo, f32x4& hi) {
    lo = (f32x4){__uint_as_float(w.x << 16), __uint_as_float(w.x & 0xffff0000u), __uint_as_float(w.y << 16), __uint_as_float(w.y & 0xffff0000u)};
    hi = (f32x4){__uint_as_float(w.z << 16), __uint_as_float(w.z & 0xffff0000u), __uint_as_float(w.w << 16), __uint_as_float(w.w & 0xffff0000u)}; }
struct SkGateA { bf16* T; const bf16* G; int ldg; const float* bm;
    __device__ __forceinline__ void operator()(int row, int col, f32x4 v0, f32x4 v1) const {
        f32x4 g0, g1; sk_unpack8(*(const v4u*)(G + (size_t)row * ldg + col), g0, g1);
        const f32x4 b0 = *(const f32x4*)(bm + col), b1 = *(const f32x4*)(bm + col + 4);
#pragma unroll
        for (int j = 0; j < 4; ++j) { v0[j] *= sigmoidf_(g0[j] + b0[j]); v1[j] *= sigmoidf_(g1[j] + b1[j]); }
        v4u o; o.x = pk2(v0[0], v0[1]); o.y = pk2(v0[2], v0[3]); o.z = pk2(v1[0], v1[1]); o.w = pk2(v1[2], v1[3]);
        *(v4u*)(T + (size_t)row * 1024 + col) = o; } };
struct SkGateB { const bf16* T; bf16* U; const bf16* G; int ldg; const float* bm;
    __device__ __forceinline__ void operator()(int row, int col, f32x4 v0, f32x4 v1) const {
        f32x4 g0, g1; sk_unpack8(*(const v4u*)(G + (size_t)row * ldg + col), g0, g1);
        const f32x4 b0 = *(const f32x4*)(bm + col), b1 = *(const f32x4*)(bm + col + 4);
        f32x4 t0, t1; sk_unpack8(*(const v4u*)(T + (size_t)row * 1024 + col), t0, t1);
#pragma unroll
        for (int j = 0; j < 4; ++j) { v0[j] = t0[j] + v0[j] * sigmoidf_(g0[j] + b0[j]); v1[j] = t1[j] + v1[j] * sigmoidf_(g1[j] + b1[j]); }
        v4u o; o.x = pk2(v0[0], v0[1]); o.y = pk2(v0[2], v0[3]); o.z = pk2(v1[0], v1[1]); o.w = pk2(v1[2], v1[3]);
        *(v4u*)(U + (size_t)row * 1024 + col) = o; } };
struct SkRes { bf16* X; const float* gate; int ldgate;
    __device__ __forceinline__ void operator()(int row, int col, f32x4 v0, f32x4 v1) const {
        const float* gp = gate + (size_t)row * ldgate + col; bf16* xp = X + (size_t)row * 1024 + col;
        f32x4 x0, x1; sk_unpack8(*(const v4u*)xp, x0, x1);
        const f32x4 o0 = x0 + *(const f32x4*)gp * v0, o1 = x1 + *(const f32x4*)(gp + 4) * v1;
        v4u o; o.x = pk2(o0[0], o0[1]); o.y = pk2(o0[2], o0[3]); o.z = pk2(o1[0], o1[1]); o.w = pk2(o1[2], o1[3]); *(v4u*)xp = o; } };

template <int TB>
__device__ __forceinline__ void hgrn_seq(const bf16* proj, const float* lbs_l, const float* hgn_l, const float* state_in, float* state_out, bf16* ohg, int row_base, int T, int bh, int tid,
                                         LAS unsigned char* smem) {
    const int b = bh >> 3, h = bh & 7, lane = tid & 63, wv = tid >> 6;
    typedef float (LAS * arr_t)[128];
    arr_t sQ = (arr_t)(smem), sG = (arr_t)(smem + TB * 512), sK = (arr_t)(smem + 2 * TB * 512);
    LAS float* sRed = (LAS float*)(smem + 3 * TB * 512);
    float S[128];
    if (state_in) {
        const float* sp = state_in + (size_t)bh * 16384 + tid;
#pragma unroll
        for (int c = 0; c < 16; ++c) { asm volatile("" : "+v"(sp));
#pragma unroll
            for (int j = 0; j < 8; ++j) S[c * 8 + j] = sp[j * 128];
            sp += 1024; }
    } else {
#pragma unroll
        for (int d = 0; d < 128; ++d) S[d] = 0.f;
    }
    const float lb = lbs_l[h * 128 + tid], hn = hgn_l[tid];
    for (int t0 = 0; t0 < T; t0 += TB) {
        float v[TB], og[TB], o[TB];
#pragma unroll
        for (int tt = 0; tt < TB; ++tt) { v[tt] = 0.f; og[tt] = 0.f;
            if (t0 + tt < T) { const bf16* pr = proj + (size_t)(row_base + b * T + t0 + tt) * LDP + h * 128 + tid;
                const float q = bf2f(pr[PC_Q]), f = bf2f(pr[PC_F]); v[tt] = bf2f(pr[PC_I + hg_vpos(tid) - tid]); og[tt] = bf2f(pr[PC_OG]);
                const float fg = lb + (1.f - lb) * sigmoidf_(f);
                sQ[tt][tid] = siluf_(q) * 0.08838834764831845f; sG[tt][tid] = fg; sK[tt][tid] = 1.f - fg; } }
        __syncthreads();
#pragma unroll
        for (int tt = 0; tt < TB; ++tt) { float acc = 0.f;
            if (t0 + tt < T) { const float vv = v[tt];
#pragma unroll
                for (int d4 = 0; d4 < 32; ++d4) { const f32x4 g = *(const LAS f32x4*)&sG[tt][d4 * 4], k = *(const LAS f32x4*)&sK[tt][d4 * 4], q = *(const LAS f32x4*)&sQ[tt][d4 * 4];
                    S[d4 * 4 + 0] = g.x * S[d4 * 4 + 0] + k.x * vv; acc += q.x * S[d4 * 4 + 0];
                    S[d4 * 4 + 1] = g.y * S[d4 * 4 + 1] + k.y * vv; acc += q.y * S[d4 * 4 + 1];
                    S[d4 * 4 + 2] = g.z * S[d4 * 4 + 2] + k.z * vv; acc += q.z * S[d4 * 4 + 2];
                    S[d4 * 4 + 3] = g.w * S[d4 * 4 + 3] + k.w * vv; acc += q.w * S[d4 * 4 + 3]; } }
            o[tt] = acc;
            const float ss = wave_sum(acc * acc); if (lane == 0) sRed[tt * 2 + wv] = ss; }
        __syncthreads();
#pragma unroll
        for (int tt = 0; tt < TB; ++tt) if (t0 + tt < T) { const float rstd = rsqrtf((sRed[tt * 2] + sRed[tt * 2 + 1]) * (1.f / 128.f) + EPS);
            ohg[(size_t)(row_base + b * T + t0 + tt) * 1024 + h * 128 + tid] = f2bf(o[tt] * rstd * hn * siluf_(og[tt])); }
        __syncthreads();
    }
    { float* sp = state_out + (size_t)bh * 16384 + tid;
#pragma unroll
      for (int c = 0; c < 16; ++c) { asm volatile("" : "+v"(sp));
#pragma unroll
          for (int j = 0; j < 8; ++j) sp[j * 128] = S[c * 8 + j];
          sp += 1024; } }
}

template <int TB>
__device__ __forceinline__ void ssd_seq(const bf16* proj, const float* conv_w, const float* conv_b, const float* dt_bias, const float* a_log, const float* d_skip, const float* ssm_norm,
                                        const float* state_in, const float* conv_in, float* state_out, float* conv_out, bf16* ybuf, int row_base, int T, int bg, int tid, LAS unsigned char* smem) {
    const int b = bg >> 3, g = bg & 7, lane = tid & 63, wv = tid >> 6, head = g * 4 + wv;
    const int ch_x = g * 256 + tid, ch_bc = tid < 128 ? (2048 + g * 128 + tid) : (3072 + g * 128 + (tid - 128));
    typedef float (LAS * arr_t)[128];
    arr_t sB = (arr_t)(smem), sC = (arr_t)(smem + TB * 512);
    LAS float* sRed = (LAS float*)(smem + 2 * TB * 512);
    const float wx0 = conv_w[0 * 4096 + ch_x], wx1 = conv_w[1 * 4096 + ch_x], wx2 = conv_w[2 * 4096 + ch_x], wx3 = conv_w[3 * 4096 + ch_x], bx = conv_b[ch_x];
    const float wb0 = conv_w[0 * 4096 + ch_bc], wb1 = conv_w[1 * 4096 + ch_bc], wb2 = conv_w[2 * 4096 + ch_bc], wb3 = conv_w[3 * 4096 + ch_bc], bb = conv_b[ch_bc];
    float rx0 = 0.f, rx1 = 0.f, rx2 = 0.f, rb0 = 0.f, rb1 = 0.f, rb2 = 0.f;
    if (conv_in) { const float* ci = conv_in + (size_t)b * 3 * 4096; rx0 = ci[ch_x]; rx1 = ci[4096 + ch_x]; rx2 = ci[8192 + ch_x]; rb0 = ci[ch_bc]; rb1 = ci[4096 + ch_bc]; rb2 = ci[8192 + ch_bc]; }
    float hs[128];
    const size_t sbase = (((size_t)b * 32 + head) * 64 + lane) * 128;
    if (state_in) {
#pragma unroll
        for (int n4 = 0; n4 < 32; ++n4) { const f32x4 t = *(const f32x4*)(state_in + sbase + n4 * 4); hs[n4 * 4] = t.x; hs[n4 * 4 + 1] = t.y; hs[n4 * 4 + 2] = t.z; hs[n4 * 4 + 3] = t.w; }
    } else {
#pragma unroll
        for (int n = 0; n < 128; ++n) hs[n] = 0.f;
    }
    const float A = -expf(a_log[head]), dtb = dt_bias[head], Dk = d_skip[head], nw = ssm_norm[ch_x];
    for (int t0 = 0; t0 < T; t0 += TB) {
        float xc[TB], dtv[TB], dec[TB], zz[TB], yv[TB];
#pragma unroll
        for (int tt = 0; tt < TB; ++tt) { xc[tt] = 0.f; dtv[tt] = 0.f; dec[tt] = 1.f; zz[tt] = 0.f;
            if (t0 + tt < T) { const bf16* pr = proj + (size_t)(row_base + b * T + t0 + tt) * LDP;
                const float cx = bf2f(pr[PC_XBC + ch_x]), cb = bf2f(pr[PC_XBC + ch_bc]);
                const float ax = bx + wx0 * rx0 + wx1 * rx1 + wx2 * rx2 + wx3 * cx; rx0 = rx1; rx1 = rx2; rx2 = cx; xc[tt] = siluf_(ax);
                const float ab = bb + wb0 * rb0 + wb1 * rb1 + wb2 * rb2 + wb3 * cb; rb0 = rb1; rb1 = rb2; rb2 = cb;
                const float sbv = siluf_(ab); if (tid < 128) sB[tt][tid] = sbv; else sC[tt][tid - 128] = sbv;
                const float dv = softplusf_(bf2f(pr[PC_DT + head]) + dtb); dtv[tt] = dv; dec[tt] = __expf(dv * A); zz[tt] = bf2f(pr[PC_Z + ch_x]); } }
        __syncthreads();
#pragma unroll
        for (int tt = 0; tt < TB; ++tt) { float y = 0.f;
            if (t0 + tt < T) { const float xdt = xc[tt] * dtv[tt], dc = dec[tt];
#pragma unroll
                for (int n4 = 0; n4 < 32; ++n4) { const f32x4 bv = *(const LAS f32x4*)&sB[tt][n4 * 4], cv = *(const LAS f32x4*)&sC[tt][n4 * 4];
                    hs[n4 * 4 + 0] = dc * hs[n4 * 4 + 0] + xdt * bv.x; y += hs[n4 * 4 + 0] * cv.x;
                    hs[n4 * 4 + 1] = dc * hs[n4 * 4 + 1] + xdt * bv.y; y += hs[n4 * 4 + 1] * cv.y;
                    hs[n4 * 4 + 2] = dc * hs[n4 * 4 + 2] + xdt * bv.z; y += hs[n4 * 4 + 2] * cv.z;
                    hs[n4 * 4 + 3] = dc * hs[n4 * 4 + 3] + xdt * bv.w; y += hs[n4 * 4 + 3] * cv.w; }
                y = (y + Dk * xc[tt]) * siluf_(zz[tt]); }
            yv[tt] = y;
            const float ss = wave_sum(y * y); if (lane == 0) sRed[tt * 4 + wv] = ss; }
        __syncthreads();
#pragma unroll
        for (int tt = 0; tt < TB; ++tt) if (t0 + tt < T) { const float rstd = rsqrtf(((sRed[tt * 4] + sRed[tt * 4 + 1]) + (sRed[tt * 4 + 2] + sRed[tt * 4 + 3])) * (1.f / 256.f) + EPS);
            ybuf[(size_t)(row_base + b * T + t0 + tt) * 2048 + ch_x] = f2bf(yv[tt] * rstd * nw); }
        __syncthreads();
    }
#pragma unroll
    for (int n4 = 0; n4 < 32; ++n4) *(f32x4*)(state_out + sbase + n4 * 4) = (f32x4){hs[n4 * 4], hs[n4 * 4 + 1], hs[n4 * 4 + 2], hs[n4 * 4 + 3]};
    float* co = conv_out + (size_t)b * 3 * 4096;
    co[ch_x] = rx0; co[4096 + ch_x] = rx1; co[8192 + ch_x] = rx2; co[ch_bc] = rb0; co[4096 + ch_bc] = rb1; co[8192 + ch_bc] = rb2;
}

#ifndef REP_G
#define REP_G 1
#endif
#ifndef REP_R2
#define REP_R2 1
#endif
#ifndef REP_R1
#define REP_R1 1
#endif
#ifndef REP_N
#define REP_N 1
#endif
#ifndef REP_P
#define REP_P 1
#endif
#ifndef REP_H2
#define REP_H2 1
#endif
#ifndef REP_S2
#define REP_S2 1
#endif
#ifndef REP_S1
#define REP_S1 1
#endif
#ifndef REP_SS
#define REP_SS 1
#endif
#ifndef REP_BAR
#define REP_BAR 0
#endif
__device__ __forceinline__ void phase_recur1(const P& p, int l, LAS unsigned char* lds, int tid_in, int skip_hgrn1) {
    unsigned char* ws = p.ws; asm volatile("" : "+s"(ws)); int tid_ = tid_in; asm volatile("" : "+v"(tid_)); const int tid = tid_, G = gridDim.x, wg = blockIdx.x;
    RecurBufs rb{(bf16*)(ws + WS_PROJ), (bf16*)(ws + WS_XBCC), (float*)(ws + WS_DTV), (float*)(ws + WS_CUM), (float*)(ws + WS_CV), (float*)(ws + WS_SSEG), (float*)(ws + WS_DSEG),
                 (float*)(ws + WS_HSEG), (float*)(ws + WS_TSEG), (bf16*)(ws + WS_OHG), (bf16*)(ws + WS_Y)};
    const float* lbs_l = (const float*)(ws + WS_LBS) + l * 1024; float* out = p.out;
    const float* hgn = p.in[I_HGN] + l * HG_DV;
    const float* cw = p.in[I_CONVW] + (size_t)l * 4 * SSM_CH; const float* cb = p.in[I_CONVB] + l * SSM_CH; const float* dtb = p.in[I_DTB] + l * SSM_HEADS;
    const float* alog = p.in[I_ALOG] + l * SSM_HEADS; const float* dsk = p.in[I_DSKIP] + l * SSM_HEADS; const float* ssmn = p.in[I_SSMN] + l * SSM_INNER;
#define TID_L() int tl_ = tid; asm volatile("" : "+v"(tl_)); const int t = tl_
#define R1_PROMPT() do { \
        if (!skip_hgrn1) for (int u = wg; u < 256; u += G) { TID_L(); hgrn_pass1(rb, lbs_l, u, t, lds); } \
        for (int rep = 0; rep < REP_S1; ++rep) for (int u = wg; u < 256; u += G) { TID_L(); ssd_pass1(rb, cw, cb, dtb, alog, out + O_CVP + (size_t)l * NB * 3 * SSM_CH, u, t, lds); } } while (0)
#define R1_SAMPLE() do { for (int rep = 0; rep < REP_SS; ++rep) { \
        {   const float* shg = p.in[I_SHG] + (size_t)l * NSB * HG_H * HG_DK * HG_DV; f32x4 sa[8];        \
            if (wg < NSB * HG_H) { TID_L(); hgrn_sample_load(sa, shg, wg, t); } \
            for (int u = wg; u < NSB * HG_H; u += G) { TID_L(); const int un = u + G < NSB * HG_H ? u + G : -1; \
                hgrn_sample_step(rb.proj, lbs_l, hgn, shg, out + O_HGS + (size_t)l * NSB * HG_H * HG_DK * HG_DV, rb.ohg, u, t, lds, sa, un); } } \
        {   const float* sss = p.in[I_SSSM] + (size_t)l * NSB * SSM_HEADS * SSM_P * SSM_N; f32x4 sa[16]; \
            if (wg < NSB * SSM_G) { TID_L(); ssd_sample_load(sa, sss, wg, t); } \
            for (int u = wg; u < NSB * SSM_G; u += G) { TID_L(); const int un = u + G < NSB * SSM_G ? u + G : -1; \
                ssd_sample_step(rb.proj, cw, cb, dtb, alog, dsk, ssmn, sss, p.in[I_SCONV] + (size_t)l * NSB * 3 * SSM_CH, \
                                out + O_SSMS + (size_t)l * NSB * SSM_HEADS * SSM_P * SSM_N, out + O_CVS + (size_t)l * NSB * 3 * SSM_CH, rb.y, u, t, lds, sa, un); } } } } while (0)
    if (((wg >> 3) & 1) == 0) { R1_PROMPT(); R1_SAMPLE(); } else { R1_SAMPLE(); R1_PROMPT(); }
#undef R1_PROMPT
#undef R1_SAMPLE
}
__device__ __forceinline__ void phase_recur2(const P& p, int l, LAS unsigned char* lds, int tid_in) {
    unsigned char* ws = p.ws; asm volatile("" : "+s"(ws)); int tid_ = tid_in; asm volatile("" : "+v"(tid_)); const int tid = tid_, G = gridDim.x, wg = blockIdx.x;
    RecurBufs rb{(bf16*)(ws + WS_PROJ), (bf16*)(ws + WS_XBCC), (float*)(ws + WS_DTV), (float*)(ws + WS_CUM), (float*)(ws + WS_CV), (float*)(ws + WS_SSEG), (float*)(ws + WS_DSEG),
                 (float*)(ws + WS_HSEG), (float*)(ws + WS_TSEG), (bf16*)(ws + WS_OHG), (bf16*)(ws + WS_Y)};
    float* out = p.out;
    for (int rep = 0; rep < REP_H2; ++rep) for (int u = wg; u < 256; u += G) { TID_L(); hgrn_pass2(rb, p.in[I_HGN] + l * HG_DV, out + O_HGP + (size_t)l * NB * HG_H * HG_DK * HG_DV, u, t, lds); }
    for (int rep = 0; rep < REP_S2; ++rep) for (int u = wg; u < 256; u += G) { TID_L(); ssd_pass2(rb, p.in[I_DSKIP] + l * SSM_HEADS, p.in[I_SSMN] + l * SSM_INNER, out + O_SSMP + (size_t)l * NB * SSM_HEADS * SSM_P * SSM_N, u ^ 3, t, lds); }
}


constexpr int CW_BAR = 4096;
constexpr int MISC_OFF = LDS_BYTES - 256;

__global__ __launch_bounds__(NTHREADS, 2) void k_mega(P p) {
    extern __shared__ __attribute__((aligned(16))) unsigned char shm[];
    LAS unsigned char* lds = (LAS unsigned char*)shm;
    const int wave_u = __builtin_amdgcn_readfirstlane((int)threadIdx.x >> 6);
#define TID() ({ int t__; asm volatile("v_mbcnt_lo_u32_b32 %0, -1, 0\n\tv_mbcnt_hi_u32_b32 %0, -1, %0" : "=v"(t__)); (wave_u << 6) | t__; })
    const int G = gridDim.x, NGW = G * NWAVES;
    unsigned char* ws = p.ws;
#define LANE_GW() int t_ = TID(); asm volatile("" : "+v"(t_)); const int ln = t_ & 63, wv = __builtin_amdgcn_readfirstlane(t_ >> 6), gwv = blockIdx.x * NWAVES + wv; (void)wv
    volatile LAS unsigned* MISC = (volatile LAS unsigned*)(lds + MISC_OFF);
    if (TID() < 16) MISC[TID()] = 0u;
    __syncthreads();
    XcdBarrier bar = xcd_barrier_post((unsigned*)(ws + WS_CTL) + CW_BAR, MISC + 8, TID());
#define WSL() ({ unsigned char* w_ = ws; asm volatile("" : "+s"(w_)); w_; })

    for (int rep = 0; rep < REP_P; ++rep) {   LANE_GW(); phase_prologue(p, lds, gwv, NGW, ln, wv); }
    xcd_barrier(bar, TID());
    {   unsigned char* w = WSL();
        pg8::Gemm g{(const bf16*)(w + WS_AC), (const bf16*)(w + WS_WADA), 256, MODLD, D}; pg8::StaticOrder S; S.init(256, MODLD, G, (int)blockIdx.x);
        pg8::EpiF32 E{(float*)(w + WS_MOD), MODLD, p.in[I_BADA]};
        pg8::gemm_phase<pg8::EpiF32, pg8::StaticOrder>(lds, g, S, E, nullptr, TID()); }
    xcd_barrier(bar, TID());
    for (int li = 0; li < DEPTH; ++li) {
        int l = li; asm volatile("" : "+s"(l));
        for (int rep = 0; rep < REP_N; ++rep) {   unsigned char* w = WSL(); const float* mod_l = (const float*)(w + WS_MOD) + (size_t)l * NADA * D;
            LANE_GW();
            if (l == 0) phase_norm<1>(p.in[I_XP], p.in[I_XS], (bf16*)(w + WS_X), (bf16*)(w + WS_H), p.in[I_NMIX] + l * D, mod_l + 0 * D, mod_l + 1 * D, gwv, NGW, ln);
            else phase_norm<0>(nullptr, nullptr, (bf16*)(w + WS_X), (bf16*)(w + WS_H), p.in[I_NMIX] + l * D, mod_l + 0 * D, mod_l + 1 * D, gwv, NGW, ln); }
        xcd_barrier(bar, TID());
        for (int rep = 0; rep < REP_G; ++rep) { if (rep) xcd_barrier(bar, TID());
        {   unsigned char* w = WSL(); const unsigned char* wl = w + WS_W + (size_t)l * W_LSTRIDE;
            pg8::Gemm g{(const bf16*)(w + WS_H), (const bf16*)(wl + WO_IN), MP, LDP, D}; pg8::StaticOrder S; S.init(MP, LDP, G, (int)blockIdx.x);
            pg8::EpiBf16<0> E{(bf16*)(w + WS_PROJ), LDP};
            pg8::gemm_phase<pg8::EpiBf16<0>, pg8::StaticOrder>(lds, g, S, E, nullptr, TID());
            const int skf = G > 64 ? 64 : 0, skn = G > 64 ? G - 64 : G; skinny_gemm<8>((const bf16*)(w + WS_H) + (size_t)MP * D, D, (const bf16*)(wl + WO_IN), D, LDP, SkStoreBf16{(bf16*)(w + WS_PROJ) + (size_t)MP * LDP, LDP, 0}, (int)blockIdx.x, skf, skn, TID(), lds); } }
        xcd_barrier(bar, TID());
        for (int rep = 0; rep < REP_BAR; ++rep) xcd_barrier(bar, TID());
        phase_recur1(p, l, lds, TID(), 0);
        for (int rep = 1; rep < REP_R1; ++rep) { xcd_barrier(bar, TID()); phase_recur1(p, l, lds, TID(), 1); }
        xcd_barrier(bar, TID());
        for (int rep = 0; rep < REP_R2; ++rep) { if (rep) xcd_barrier(bar, TID()); phase_recur2(p, l, lds, TID()); }
        xcd_barrier(bar, TID());
        for (int rep = 0; rep < REP_G; ++rep) { if (rep) xcd_barrier(bar, TID());
        {   unsigned char* w = WSL(); const unsigned char* wl = w + WS_W + (size_t)l * W_LSTRIDE;
            pg8::Gemm g{(const bf16*)(w + WS_OHG), (const bf16*)(wl + WO_BRA), MP, D, 1024}; pg8::StaticOrder S; S.init(MP, D, G, (int)blockIdx.x);
            pg8::EpiGateA E{(bf16*)(w + WS_T), (const bf16*)(w + WS_PROJ) + PC_GA, LDP, p.in[I_BMERGE] + l * 2048};
            pg8::gemm_phase<pg8::EpiGateA, pg8::StaticOrder>(lds, g, S, E, nullptr, TID());
            skinny_gemm<1>((const bf16*)(w + WS_OHG) + (size_t)MP * D, D, (const bf16*)(wl + WO_BRA), 1024, D, SkGateA{(bf16*)(w + WS_T) + (size_t)MP * D, (const bf16*)(w + WS_PROJ) + (size_t)MP * LDP + PC_GA, LDP, p.in[I_BMERGE] + l * 2048}, (int)blockIdx.x, 0, G, TID(), lds); } }
        asm volatile("s_waitcnt vmcnt(0)" ::: "memory"); __syncthreads();
        for (int rep = 0; rep < REP_G; ++rep) { if (rep) xcd_barrier(bar, TID());
        {   unsigned char* w = WSL(); const unsigned char* wl = w + WS_W + (size_t)l * W_LSTRIDE;
            pg8::Gemm g{(const bf16*)(w + WS_Y), (const bf16*)(wl + WO_BRB), MP, D, 2048}; pg8::StaticOrder S; S.init(MP, D, G, (int)blockIdx.x);
            pg8::EpiGateB E{(const bf16*)(w + WS_T), (bf16*)(w + WS_U), (const bf16*)(w + WS_PROJ) + PC_GB, LDP, p.in[I_BMERGE] + l * 2048 + 1024};
            pg8::gemm_phase<pg8::EpiGateB, pg8::StaticOrder>(lds, g, S, E, nullptr, TID());
            skinny_gemm<1>((const bf16*)(w + WS_Y) + (size_t)MP * 2048, 2048, (const bf16*)(wl + WO_BRB), 2048, D, SkGateB{(const bf16*)(w + WS_T) + (size_t)MP * D, (bf16*)(w + WS_U) + (size_t)MP * D, (const bf16*)(w + WS_PROJ) + (size_t)MP * LDP + PC_GB, LDP, p.in[I_BMERGE] + l * 2048 + 1024}, (int)blockIdx.x, 0, G, TID(), lds); } }
        xcd_barrier(bar, TID());
        {   unsigned char* w = WSL(); const unsigned char* wl = w + WS_W + (size_t)l * W_LSTRIDE; const float* mod_l = (const float*)(w + WS_MOD) + (size_t)l * NADA * D;
            pg8::Gemm g{(const bf16*)(w + WS_U), (const bf16*)(wl + WO_OUT), MP, D, 1024}; pg8::StaticOrder S; S.init(MP, D, G, (int)blockIdx.x);
            pg8::EpiRes E{(bf16*)(w + WS_X), mod_l + 2 * D, MODLD};
            pg8::gemm_phase<pg8::EpiRes, pg8::StaticOrder>(lds, g, S, E, nullptr, TID());
            skinny_gemm<1>((const bf16*)(w + WS_U) + (size_t)MP * D, D, (const bf16*)(wl + WO_OUT), 1024, D, SkRes{(bf16*)(w + WS_X) + (size_t)MP * D, mod_l + (size_t)NB * MODLD + 2 * D, MODLD}, (int)blockIdx.x, 0, G, TID(), lds); }
        xcd_barrier(bar, TID());
        for (int rep = 0; rep < REP_N; ++rep) {   unsigned char* w = WSL(); const float* mod_l = (const float*)(w + WS_MOD) + (size_t)l * NADA * D;
            LANE_GW(); phase_norm<0>(nullptr, nullptr, (bf16*)(w + WS_X), (bf16*)(w + WS_H), p.in[I_NMLP] + l * D, mod_l + 3 * D, mod_l + 4 * D, gwv, NGW, ln); }
        xcd_barrier(bar, TID());
        for (int rep = 0; rep < REP_G; ++rep) { if (rep) xcd_barrier(bar, TID());
        {   unsigned char* w = WSL(); const unsigned char* wl = w + WS_W + (size_t)l * W_LSTRIDE;
            pg8::Gemm g{(const bf16*)(w + WS_H), (const bf16*)(wl + WO_UP), MP, DFF, 1024}; pg8::StaticOrder S; S.init(MP, DFF, G, (int)blockIdx.x);
            pg8::EpiBf16<1> E{(bf16*)(w + WS_UP), DFF};
            pg8::gemm_phase<pg8::EpiBf16<1>, pg8::StaticOrder>(lds, g, S, E, nullptr, TID());
            skinny_gemm<4>((const bf16*)(w + WS_H) + (size_t)MP * D, D, (const bf16*)(wl + WO_UP), 1024, DFF, SkStoreBf16{(bf16*)(w + WS_UP) + (size_t)MP * DFF, DFF, 1}, (int)blockIdx.x, 0, G, TID(), lds); } }
        xcd_barrier(bar, TID());
        {   unsigned char* w = WSL(); const unsigned char* wl = w + WS_W + (size_t)l * W_LSTRIDE; const float* mod_l = (const float*)(w + WS_MOD) + (size_t)l * NADA * D;
            pg8::Gemm g{(const bf16*)(w + WS_UP), (const bf16*)(wl + WO_DOWN), MP, D, DFF}; pg8::StaticOrder S; S.init(MP, D, G, (int)blockIdx.x);
            pg8::EpiRes E{(bf16*)(w + WS_X), mod_l + 5 * D, MODLD};
            pg8::gemm_phase<pg8::EpiRes, pg8::StaticOrder>(lds, g, S, E, nullptr, TID());
            skinny_gemm<1>((const bf16*)(w + WS_UP) + (size_t)MP * DFF, DFF, (const bf16*)(wl + WO_DOWN), DFF, D, SkRes{(bf16*)(w + WS_X) + (size_t)MP * D, mod_l + (size_t)NB * MODLD + 5 * D, MODLD}, (int)blockIdx.x, 0, G, TID(), lds); }
        xcd_barrier(bar, TID());
    }
    {   unsigned char* w = WSL(); LANE_GW(); phase_final((const bf16*)(w + WS_X), p.out + O_YP, p.in[I_NFIN], gwv, NGW, ln); }
}

extern "C" void kernel_launch(void* const* d_in, const int* in_sizes, int n_in, void* d_out, int out_size, void* d_ws, size_t ws_size, hipStream_t stream) {
    static int grid = 0;
    if (grid == 0) {
        if (n_in != N_IN || (size_t)out_size != O_END || ws_size < WS_END) { fprintf(stderr, "kernel_launch: unexpected sizes n_in %d out %d ws %zu\n", n_in, out_size, ws_size); grid = -1; return; }
        int dev = 0, cus = 0, per_cu = 0;
        if (hipGetDevice(&dev) != hipSuccess || hipDeviceGetAttribute(&cus, hipDeviceAttributeMultiprocessorCount, dev) != hipSuccess) { grid = -1; return; }
        if (hipFuncSetAttribute((const void*)k_mega, hipFuncAttributeMaxDynamicSharedMemorySize, LDS_BYTES) != hipSuccess) { fprintf(stderr, "kernel_launch: hipFuncSetAttribute failed\n"); grid = -1; return; }
        if (hipOccupancyMaxActiveBlocksPerMultiprocessor(&per_cu, (const void*)k_mega, NTHREADS, LDS_BYTES) != hipSuccess || per_cu < 1)
            fprintf(stderr, "kernel_launch: note: occupancy query reports %d workgroups per CU\n", per_cu);
        (void)hipGetLastError();
        grid = cus;
    }
    if (grid < 0) return;
    if (hipMemsetAsync((char*)d_ws + WS_CTL, 0, CTL_ZERO_BYTES, stream) != hipSuccess) return;
    P p{};
    for (int i = 0; i < N_IN; ++i) p.in[i] = (const float*)d_in[i];
    p.out = (float*)d_out; p.ws = (unsigned char*)d_ws;
    hipLaunchKernelGGL(k_mega, dim3(grid), dim3(NTHREADS), LDS_BYTES, stream, p);
}
```

```cpp
#include <hip/hip_runtime.h>
#include <cstdio>
#include <cstdint>

constexpr int D = 1024, NB = 8, SEQ = 2048, DEPTH = 4, NSB = 128;
constexpr int MP = NB * SEQ;
constexpr int MS = NSB;
constexpr int MR = MP + MS;
constexpr int MT = 16640;
constexpr int HG_H = 8, HG_DK = 128, HG_DV = 128;
constexpr int SSM_INNER = 2048, SSM_P = 64, SSM_HEADS = 32, SSM_G = 8, SSM_HPG = 4, SSM_N = 128, SSM_CH = 4096;
constexpr int DFF = 4096, NADA = 6;
constexpr int IN_WIDTH = 12320;
constexpr int LDP = 12544;
constexpr int PC_Q = 0, PC_F = 1024, PC_I = 2048, PC_OG = 3072, PC_Z = 4096, PC_XBC = 6144, PC_GA = 10240, PC_GB = 11264, PC_DT = 12288;
constexpr int NCOND = NB + NSB;
constexpr int MODLD = DEPTH * NADA * D;
constexpr float EPS = 1e-6f;

enum { I_XP = 0, I_XS, I_SHG, I_SSSM, I_SCONV, I_CP, I_CS, I_WADA, I_BADA, I_NMIX, I_WIN, I_BMERGE, I_LB, I_HGN, I_CONVW, I_CONVB, I_DTB, I_ALOG, I_DSKIP,
       I_SSMN, I_WBRA, I_WBRB, I_WOUT, I_NMLP, I_WUP, I_WDOWN, I_NFIN, N_IN };

constexpr size_t O_YP = 0;
constexpr size_t O_YS = O_YP + (size_t)MP * D;
constexpr size_t O_HGP = O_YS + (size_t)MS * D;
constexpr size_t O_SSMP = O_HGP + (size_t)DEPTH * NB * HG_H * HG_DK * HG_DV;
constexpr size_t O_CVP = O_SSMP + (size_t)DEPTH * NB * SSM_HEADS * SSM_P * SSM_N;
constexpr size_t O_HGS = O_CVP + (size_t)DEPTH * NB * 3 * SSM_CH;
constexpr size_t O_SSMS = O_HGS + (size_t)DEPTH * NSB * HG_H * HG_DK * HG_DV;
constexpr size_t O_CVS = O_SSMS + (size_t)DEPTH * NSB * SSM_HEADS * SSM_P * SSM_N;
constexpr size_t O_END = O_CVS + (size_t)DEPTH * NSB * 3 * SSM_CH;

constexpr size_t MiB = 1u << 20;
constexpr size_t WS_CTL = 0, CTL_ZERO_BYTES = 1 * MiB;
constexpr size_t WS_LBS = 1 * MiB;
constexpr size_t WS_AC = 2 * MiB;
constexpr size_t WS_MOD = 3 * MiB;
constexpr size_t WS_WADA = 32 * MiB;
constexpr size_t WS_W = 80 * MiB, W_LSTRIDE = 49 * MiB;
constexpr size_t WO_IN = 0, WO_BRA = 24 * MiB + MiB / 2, WO_BRB = WO_BRA + 2 * MiB, WO_OUT = WO_BRB + 4 * MiB, WO_UP = WO_OUT + 2 * MiB, WO_DOWN = WO_UP + 8 * MiB;
constexpr size_t WS_X = 276 * MiB;
constexpr size_t WS_H = 341 * MiB;
constexpr size_t WS_PROJ = 374 * MiB;
constexpr size_t WS_OHG = 773 * MiB;
constexpr size_t WS_Y = 806 * MiB;
constexpr size_t WS_T = 871 * MiB;
constexpr size_t WS_U = 936 * MiB;
constexpr size_t WS_UP = 969 * MiB;
constexpr size_t WS_XBCC = 1100 * MiB;
constexpr size_t WS_DTV = 1230 * MiB, WS_CUM = 1232 * MiB;
constexpr size_t WS_CV = 1234 * MiB;
constexpr size_t WS_SSEG = 1238 * MiB;
constexpr size_t WS_DSEG = 1254 * MiB;
constexpr size_t WS_HSEG = 1255 * MiB;
constexpr size_t WS_TSEG = 1287 * MiB;
constexpr size_t WS_END = 1288 * MiB;
static_assert(WO_DOWN + 8 * MiB <= W_LSTRIDE && (size_t)LDP * D * 2 <= WO_BRA, "weight map");
static_assert(WS_W + 4 * W_LSTRIDE <= WS_X && WS_X + (size_t)MT * D * 4 <= WS_H && WS_H + (size_t)MT * D * 2 <= WS_PROJ && WS_PROJ + (size_t)MT * LDP * 2 <= WS_OHG, "ws map 1");
static_assert(WS_OHG + (size_t)MT * D * 2 <= WS_Y && WS_Y + (size_t)MT * 2048 * 2 <= WS_T && WS_T + (size_t)MT * D * 4 <= WS_U && WS_U + (size_t)MT * D * 2 <= WS_UP && WS_UP + (size_t)MT * DFF * 2 <= WS_XBCC && WS_XBCC + (size_t)MT * 4096 * 2 <= WS_DTV, "ws map 2");
static_assert(WS_MOD + (size_t)256 * MODLD * 4 <= WS_WADA && WS_WADA + (size_t)MODLD * D * 2 <= WS_W, "ws map 0");

typedef unsigned short bf16;
__device__ __forceinline__ float bf2f(bf16 v) { return __uint_as_float(((unsigned)v) << 16); }
__device__ __forceinline__ unsigned pk2(float lo, float hi) { unsigned r; asm("v_cvt_pk_bf16_f32 %0, %1, %2" : "=v"(r) : "v"(lo), "v"(hi)); return r; }
__device__ __forceinline__ bf16 f2bf(float f) { return (bf16)pk2(f, f); }
__device__ __forceinline__ float frcp_(float x) { return __builtin_amdgcn_rcpf(x); }
__device__ __forceinline__ float sigmoidf_(float x) { return frcp_(1.0f + __expf(-x)); }
__device__ __forceinline__ float siluf_(float x) { return x * frcp_(1.0f + __expf(-x)); }
__device__ __forceinline__ float softplusf_(float x) { return x > 20.f ? x : log1pf(__expf(x)); }
__host__ __device__ __forceinline__ int cidx_of_row(int row) { return row < MP ? (row >> 11) : ((row - MP + NB) < NCOND ? (row - MP + NB) : (NCOND - 1)); }
__host__ __device__ __forceinline__ int hg_vpos(int e) { return (e & 64) + 16 * (e & 3) + ((e & 63) >> 2); }

namespace pg8 {
#define PG8_LAS __attribute__((address_space(3)))
typedef unsigned short bf16_t;
typedef short bf16x8 __attribute__((ext_vector_type(8)));
typedef float f32x4 __attribute__((ext_vector_type(4)));
typedef unsigned u32x4 __attribute__((ext_vector_type(4)));
constexpr int BM = 256, BK = 64, HALF = 128, HTB = HALF * BK * 2  , STAGE_BYTES = 8 * HTB, NXCD = 8, WGM = 4;

__host__ __device__ __forceinline__ int lds_byte(int r, int c) { const int st = (r >> 4) * 2 + (c >> 5), rr = r & 15, cc = c & 31, ob = rr * 64 + cc * 2; return st * 1024 + (ob ^ (((ob >> 9) & 1) << 5)); }
__host__ __device__ __forceinline__ void stage_rc(int b, int& R, int& C) { const int st = b / 1024, sb = b % 1024, swz = sb ^ (((sb >> 9) & 1) << 5); R = (st >> 1) * 16 + swz / 64; C = (st & 1) * 32 + (swz % 64) / 2; }
__host__ __device__ __forceinline__ int perm32(int rho) { const int n = rho >> 4, i = rho & 15; return 8 * (i >> 2) + 4 * n + (i & 3); }

struct Unit { int pm, pn; };
struct Gemm { const bf16_t* A; const bf16_t* Bt; int M, N, K; };

struct StaticOrder {
    int nM, nN, nwg, G, c;
    __host__ __device__ void init(int M, int N, int G_, int c_) { nM = M / BM; nN = N / BM; nwg = nM * nN; G = G_; c = c_; }
    __host__ __device__ bool next(int i, Unit& u) const {
        const long L = (long)i * G + c; if (L >= nwg) return false;
        int wgid = (int)L; { const int q = nwg / NXCD, r = nwg % NXCD, xcd = wgid % NXCD, off = wgid / NXCD; wgid = (xcd < r ? xcd * (q + 1) : r * (q + 1) + (xcd - r) * q) + off; }
        const int nig = WGM * nN, gid = wgid / nig, fm = gid * WGM, gsz = (nM - fm) < WGM ? (nM - fm) : WGM;
        u.pm = fm + ((wgid % nig) % gsz); u.pn = (wgid % nig) / gsz; return true;
    }
    __device__ __forceinline__ void a_ready(const Unit&) const {}
    __device__ __forceinline__ void done(const Unit&) const {}
};
__device__ __forceinline__ unsigned cvt_pk_bf16(float lo, float hi) { unsigned r; asm volatile("v_cvt_pk_bf16_f32 %0, %1, %2" : "=v"(r) : "v"(lo), "v"(hi)); return r; }
__device__ __forceinline__ float ep_sigmoid(float x) { return __builtin_amdgcn_rcpf(1.0f + __expf(-x)); }
__device__ __forceinline__ void unpack8(const u32x4 w, f32x4& lo, f32x4& hi) {
    lo = (f32x4){__uint_as_float(w.x << 16), __uint_as_float(w.x & 0xffff0000u), __uint_as_float(w.y << 16), __uint_as_float(w.y & 0xffff0000u)};
    hi = (f32x4){__uint_as_float(w.z << 16), __uint_as_float(w.z & 0xffff0000u), __uint_as_float(w.w << 16), __uint_as_float(w.w & 0xffff0000u)};
}

struct EpiF32 {
    static constexpr bool PERM = false, AFTER_DRAIN = false;
    float* C; int ldc; const float* bias;
    __device__ __forceinline__ void operator()(const f32x4 (&acc)[2][2][4][2], const Unit& u, int wr, int wc, int fr, int fq) const {
        const int row0 = u.pm * BM + wr * 64 + fr, col0 = u.pn * BM + wc * 32 + 4 * fq;
        f32x4 bv[2][2];
#pragma unroll
        for (int bj = 0; bj < 2; ++bj)
#pragma unroll
            for (int n = 0; n < 2; ++n) bv[bj][n] = *(const f32x4*)(bias + col0 + bj * HALF + n * 16);
#pragma unroll
        for (int ai = 0; ai < 2; ++ai)
#pragma unroll
            for (int m = 0; m < 4; ++m) { float* rowp = C + (size_t)(row0 + ai * HALF + m * 16) * ldc + col0;
#pragma unroll
                for (int bj = 0; bj < 2; ++bj)
#pragma unroll
                    for (int n = 0; n < 2; ++n) *(f32x4*)(rowp + bj * HALF + n * 16) = acc[ai][bj][m][n] + bv[bj][n]; }
    }
};
template <int ACT  > struct EpiBf16 {
    static constexpr bool PERM = true, AFTER_DRAIN = false;
    bf16_t* O; int ldc;
    __device__ __forceinline__ void operator()(const f32x4 (&acc)[2][2][4][2], const Unit& u, int wr, int wc, int fr, int fq) const {
        const int row0 = u.pm * BM + wr * 64 + fr; const int col0 = u.pn * BM + wc * 32 + 8 * fq;
#pragma unroll
        for (int ai = 0; ai < 2; ++ai)
#pragma unroll
            for (int m = 0; m < 4; ++m) { bf16_t* rowp = O + (size_t)(row0 + ai * HALF + m * 16) * ldc + col0;
#pragma unroll
                for (int bj = 0; bj < 2; ++bj) { f32x4 v0 = acc[ai][bj][m][0], v1 = acc[ai][bj][m][1];
                    if (ACT == 1) {
#pragma unroll
                        for (int j = 0; j < 4; ++j) { const float a = fmaxf(v0[j], 0.f), b = fmaxf(v1[j], 0.f); v0[j] = a * a; v1[j] = b * b; } }
                    u32x4 w; w.x = cvt_pk_bf16(v0[0], v0[1]); w.y = cvt_pk_bf16(v0[2], v0[3]); w.z = cvt_pk_bf16(v1[0], v1[1]); w.w = cvt_pk_bf16(v1[2], v1[3]);
                    *(u32x4*)(rowp + bj * HALF) = w; } }
    }
};
struct EpiGateA {
    static constexpr bool PERM = true, AFTER_DRAIN = false;
    bf16_t* T; const bf16_t* G; int ldg; const float* bm;
    __device__ __forceinline__ void operator()(const f32x4 (&acc)[2][2][4][2], const Unit& u, int wr, int wc, int fr, int fq) const {
        const int row0 = u.pm * BM + wr * 64 + fr; const int col0 = u.pn * BM + wc * 32 + 8 * fq;
        f32x4 bv[2][2];
#pragma unroll
        for (int bj = 0; bj < 2; ++bj)
#pragma unroll
            for (int n = 0; n < 2; ++n) bv[bj][n] = *(const f32x4*)(bm + col0 + bj * HALF + 4 * n);
#pragma unroll
        for (int ai = 0; ai < 2; ++ai)
#pragma unroll
            for (int m = 0; m < 4; ++m) { const size_t row = (size_t)(row0 + ai * HALF + m * 16);
#pragma unroll
                for (int bj = 0; bj < 2; ++bj) {
                    const u32x4 gw = *(const u32x4*)(G + row * ldg + col0 + bj * HALF); f32x4 g0, g1; unpack8(gw, g0, g1);
                    f32x4 o0, o1;
#pragma unroll
                    for (int j = 0; j < 4; ++j) { o0[j] = ep_sigmoid(g0[j] + bv[bj][0][j]) * acc[ai][bj][m][0][j]; o1[j] = ep_sigmoid(g1[j] + bv[bj][1][j]) * acc[ai][bj][m][1][j]; }
                    u32x4 w; w.x = cvt_pk_bf16(o0[0], o0[1]); w.y = cvt_pk_bf16(o0[2], o0[3]); w.z = cvt_pk_bf16(o1[0], o1[1]); w.w = cvt_pk_bf16(o1[2], o1[3]);
                    *(u32x4*)(T + row * 1024 + col0 + bj * HALF) = w; } }
    }
};
struct EpiGateB {
    static constexpr bool PERM = true, AFTER_DRAIN = false;
    const bf16_t* T; bf16_t* U; const bf16_t* G; int ldg; const float* bm;
    __device__ __forceinline__ void operator()(const f32x4 (&acc)[2][2][4][2], const Unit& u, int wr, int wc, int fr, int fq) const {
        const int row0 = u.pm * BM + wr * 64 + fr; const int col0 = u.pn * BM + wc * 32 + 8 * fq;
        f32x4 bv[2][2];
#pragma unroll
        for (int bj = 0; bj < 2; ++bj)
#pragma unroll
            for (int n = 0; n < 2; ++n) bv[bj][n] = *(const f32x4*)(bm + col0 + bj * HALF + 4 * n);
#pragma unroll
        for (int ai = 0; ai < 2; ++ai)
#pragma unroll
            for (int m = 0; m < 4; ++m) { const size_t row = (size_t)(row0 + ai * HALF + m * 16);
#pragma unroll
                for (int bj = 0; bj < 2; ++bj) {
                    const u32x4 gw = *(const u32x4*)(G + row * ldg + col0 + bj * HALF); f32x4 g0, g1; unpack8(gw, g0, g1);
                    f32x4 t0, t1; unpack8(*(const u32x4*)(T + row * 1024 + col0 + bj * HALF), t0, t1);
                    f32x4 o0, o1;
#pragma unroll
                    for (int j = 0; j < 4; ++j) { o0[j] = t0[j] + ep_sigmoid(g0[j] + bv[bj][0][j]) * acc[ai][bj][m][0][j]; o1[j] = t1[j] + ep_sigmoid(g1[j] + bv[bj][1][j]) * acc[ai][bj][m][1][j]; }
                    u32x4 w; w.x = cvt_pk_bf16(o0[0], o0[1]); w.y = cvt_pk_bf16(o0[2], o0[3]); w.z = cvt_pk_bf16(o1[0], o1[1]); w.w = cvt_pk_bf16(o1[2], o1[3]);
                    *(u32x4*)(U + row * 1024 + col0 + bj * HALF) = w; } }
    }
};
struct EpiRes {
    static constexpr bool PERM = false, AFTER_DRAIN = false;
    bf16_t* X; const float* gate; int ldgate;
    __device__ __forceinline__ void operator()(const f32x4 (&acc)[2][2][4][2], const Unit& u, int wr, int wc, int fr, int fq) const {
        typedef unsigned u32x2 __attribute__((ext_vector_type(2)));
        const int row0 = u.pm * BM + wr * 64 + fr, col0 = u.pn * BM + wc * 32 + 4 * fq;
        const float* gp = gate + (size_t)((u.pm * BM) >> 11) * ldgate + col0;
        f32x4 gv[2][2];
#pragma unroll
        for (int bj = 0; bj < 2; ++bj)
#pragma unroll
            for (int n = 0; n < 2; ++n) gv[bj][n] = *(const f32x4*)(gp + bj * HALF + n * 16);
#pragma unroll
        for (int ai = 0; ai < 2; ++ai)
#pragma unroll
            for (int m = 0; m < 4; ++m) { bf16_t* xp = X + (size_t)(row0 + ai * HALF + m * 16) * 1024 + col0;
#pragma unroll
                for (int bj = 0; bj < 2; ++bj)
#pragma unroll
                    for (int n = 0; n < 2; ++n) { const u32x2 xw = *(const u32x2*)(xp + bj * HALF + n * 16);
                        const f32x4 xv = (f32x4){__uint_as_float(xw.x << 16), __uint_as_float(xw.x & 0xffff0000u), __uint_as_float(xw.y << 16), __uint_as_float(xw.y & 0xffff0000u)};
                        const f32x4 o = xv + gv[bj][n] * acc[ai][bj][m][n];
                        u32x2 ow; ow.x = cvt_pk_bf16(o[0], o[1]); ow.y = cvt_pk_bf16(o[2], o[3]); *(u32x2*)(xp + bj * HALF + n * 16) = ow; } }
    }
};


#ifndef GEMM_ALIGN
#define GEMM_ALIGN true
#endif
#ifndef GEMM_SP2
#define GEMM_SP2 true
#endif
template <class Epi, class Sched, bool ALIGN_EPI = GEMM_ALIGN, bool SP2 = GEMM_SP2>
__device__ __forceinline__ void gemm_phase(PG8_LAS unsigned char* lds, const Gemm g, const Sched& S, const Epi& E, unsigned long long*  , int tid_in) {
    int tid_ = tid_in; asm volatile("" : "+v"(tid_));
    const int tid = tid_, wid = __builtin_amdgcn_readfirstlane(tid >> 6), lane = tid & 63, wr = wid >> 2, wc = wid & 3, fr = lane & 15, fq = lane >> 4;
    const int K = g.K, nt = K / BK;
    unsigned voffA[2], voffB[2];
#pragma unroll
    for (int i = 0; i < 2; ++i) { int R, C; stage_rc(tid * 16 + i * 8192, R, C); const int Rb = Epi::PERM ? ((R & ~31) + perm32(R & 31)) : R;
        voffA[i] = (unsigned)(R * K + C) * 2u; voffB[i] = (unsigned)(Rb * K + C) * 2u; }
    const size_t kstep = (size_t)(BK * 2);
    const size_t hstep = (size_t)HALF * K * 2;
    const size_t tstep = 2 * hstep;
    const unsigned ldsw = (unsigned)wid * 1024u;
    const int aoff = lds_byte(wr * 64 + fr, fq * 8), boff = lds_byte(wc * 32 + fr, fq * 8);
#define PG8_SA(b, h) (((b) * 2 + (h)) * HTB)
#define PG8_SB(b, h) ((4 + (b) * 2 + (h)) * HTB)
#define PG8_STAGE(bufoff, gbase, voff) do { _Pragma("unroll") for (int _i = 0; _i < 2; ++_i) \
        __builtin_amdgcn_global_load_lds((const unsigned*)((const char*)(gbase) + (voff)[_i]), (PG8_LAS unsigned*)(lds + (bufoff) + ldsw + _i * 8192), 16, 0, 0); } while (0)
#define PG8_LDA(dst, b, h) do { _Pragma("unroll") for (int m = 0; m < 4; ++m) _Pragma("unroll") for (int k = 0; k < 2; ++k) dst[m][k] = *(const PG8_LAS bf16x8*)(lds + PG8_SA(b, h) + aoff + m * 2048 + k * 1024); } while (0)
#define PG8_LDB(dst, b, h) do { _Pragma("unroll") for (int n = 0; n < 2; ++n) _Pragma("unroll") for (int k = 0; k < 2; ++k) dst[n][k] = *(const PG8_LAS bf16x8*)(lds + PG8_SB(b, h) + boff + n * 2048 + k * 1024); } while (0)
#define PG8_MMA(ai, bj, At, Bt) do { __builtin_amdgcn_s_setprio(1); _Pragma("unroll") for (int m = 0; m < 4; ++m) _Pragma("unroll") for (int n = 0; n < 2; ++n) _Pragma("unroll") for (int k = 0; k < 2; ++k) \
        acc[ai][bj][m][n] = __builtin_amdgcn_mfma_f32_16x16x32_bf16(Bt[n][k], At[m][k], acc[ai][bj][m][n], 0, 0, 0); __builtin_amdgcn_s_setprio(0); } while (0)
#define PG8_WAIT_V(n) asm volatile("s_waitcnt vmcnt(" #n ")" ::: "memory")
#define PG8_WAIT_L(n) asm volatile("s_waitcnt lgkmcnt(" #n ")" ::: "memory")
#define PG8_BAR __builtin_amdgcn_s_barrier()
#define PG8_SCHED __builtin_amdgcn_sched_barrier(0)
    Unit cur, nxt; int ui = 0;
    if (!S.next(0, cur)) return;
    f32x4 acc[2][2][4][2];
#pragma unroll
    for (int a = 0; a < 2; ++a)
#pragma unroll
        for (int b = 0; b < 2; ++b)
#pragma unroll
            for (int m = 0; m < 4; ++m)
#pragma unroll
                for (int n = 0; n < 2; ++n) acc[a][b][m][n] = (f32x4){0.f, 0.f, 0.f, 0.f};
    bf16x8 At[4][2], B0[2][2], B1[2][2];
    const char* cA = (const char*)g.A + (size_t)cur.pm * tstep; const char* cB = (const char*)g.Bt + (size_t)cur.pn * tstep;
    S.a_ready(cur);
    if constexpr (SP2) {
        PG8_STAGE(PG8_SB(0, 0), cB, voffB); PG8_STAGE(PG8_SB(0, 1), cB + hstep, voffB); PG8_STAGE(PG8_SA(0, 0), cA, voffA); PG8_STAGE(PG8_SA(0, 1), cA + hstep, voffA);
        if (wr == 1) PG8_BAR;
        PG8_WAIT_V(2); PG8_BAR;
        PG8_STAGE(PG8_SB(1, 0), cB + kstep, voffB); PG8_STAGE(PG8_SA(1, 0), cA + kstep, voffA); PG8_STAGE(PG8_SB(1, 1), cB + hstep + kstep, voffB);
        PG8_WAIT_V(6); PG8_BAR;
    } else {
        PG8_STAGE(PG8_SB(0, 0), cB, voffB); PG8_STAGE(PG8_SA(0, 0), cA, voffA); PG8_STAGE(PG8_SB(0, 1), cB + hstep, voffB); PG8_STAGE(PG8_SA(0, 1), cA + hstep, voffA);
        if (wr == 1) PG8_BAR;
        PG8_WAIT_V(4); PG8_BAR;
        PG8_STAGE(PG8_SB(1, 0), cB + kstep, voffB); PG8_STAGE(PG8_SA(1, 0), cA + kstep, voffA); PG8_STAGE(PG8_SB(1, 1), cB + hstep + kstep, voffB);
        PG8_WAIT_V(6); PG8_BAR;
    }
    for (;;) {
        const bool has_next = S.next(ui + 1, nxt);
        const char* nA = has_next ? (const char*)g.A + (size_t)nxt.pm * tstep : cA; const char* nB = has_next ? (const char*)g.Bt + (size_t)nxt.pn * tstep : cB;
        for (int t = 0; t < nt; t += 2) {
            const bool last = (t == nt - 2);
            const char* a1 = cA + (size_t)(t + 1) * kstep;
            const char* a2 = last ? nA : cA + (size_t)(t + 2) * kstep; const char* b2 = last ? nB : cB + (size_t)(t + 2) * kstep;
            const char* a3 = a2 + kstep; const char* b3 = b2 + kstep;
            if (last && has_next) S.a_ready(nxt);
            if constexpr (SP2) {
            PG8_LDB(B0, 0, 0); PG8_LDB(B1, 0, 1); PG8_SCHED; PG8_LDA(At, 0, 0); PG8_STAGE(PG8_SA(1, 1), a1 + hstep, voffA);
            PG8_WAIT_V(8); PG8_WAIT_L(0); PG8_BAR; PG8_MMA(0, 0, At, B0); PG8_MMA(0, 1, At, B1); PG8_BAR; PG8_SCHED;
            PG8_LDA(At, 0, 1); PG8_STAGE(PG8_SB(0, 0), b2, voffB); PG8_STAGE(PG8_SB(0, 1), b2 + hstep, voffB); PG8_STAGE(PG8_SA(0, 0), a2, voffA);
            PG8_WAIT_V(8); PG8_WAIT_L(0); PG8_BAR; PG8_MMA(1, 0, At, B0); PG8_MMA(1, 1, At, B1); PG8_BAR; PG8_SCHED;
            PG8_LDB(B0, 1, 0); PG8_LDB(B1, 1, 1); PG8_SCHED; PG8_LDA(At, 1, 0); PG8_STAGE(PG8_SA(0, 1), a2 + hstep, voffA);
            PG8_WAIT_V(8); PG8_WAIT_L(0); PG8_BAR; PG8_MMA(0, 0, At, B0); PG8_MMA(0, 1, At, B1); PG8_BAR; PG8_SCHED;
            PG8_LDA(At, 1, 1); PG8_STAGE(PG8_SB(1, 0), b3, voffB); PG8_STAGE(PG8_SB(1, 1), b3 + hstep, voffB); PG8_STAGE(PG8_SA(1, 0), a3, voffA);
            PG8_WAIT_V(8); PG8_WAIT_L(0); PG8_BAR; PG8_MMA(1, 0, At, B0); PG8_MMA(1, 1, At, B1); PG8_BAR; PG8_SCHED;
            } else {
            PG8_LDB(B0, 0, 0); PG8_SCHED; PG8_LDA(At, 0, 0); PG8_STAGE(PG8_SA(1, 1), a1 + hstep, voffA);
            PG8_WAIT_L(8); PG8_BAR; PG8_WAIT_L(0); PG8_MMA(0, 0, At, B0); PG8_BAR; PG8_SCHED;
            PG8_LDB(B1, 0, 1); PG8_STAGE(PG8_SB(0, 0), b2, voffB);
            PG8_BAR; PG8_WAIT_L(0); PG8_MMA(0, 1, At, B1); PG8_BAR;
            PG8_LDA(At, 0, 1); PG8_STAGE(PG8_SA(0, 0), a2, voffA);
            PG8_BAR; PG8_WAIT_L(0); PG8_MMA(1, 0, At, B0); PG8_BAR; PG8_SCHED;
            PG8_STAGE(PG8_SB(0, 1), b2 + hstep, voffB);
            PG8_WAIT_V(6); PG8_BAR; PG8_MMA(1, 1, At, B1); PG8_BAR;
            PG8_LDB(B0, 1, 0); PG8_SCHED; PG8_LDA(At, 1, 0); PG8_STAGE(PG8_SA(0, 1), a2 + hstep, voffA);
            PG8_WAIT_L(8); PG8_BAR; PG8_WAIT_L(0); PG8_MMA(0, 0, At, B0); PG8_BAR; PG8_SCHED;
            PG8_LDB(B1, 1, 1); PG8_STAGE(PG8_SB(1, 0), b3, voffB);
            PG8_BAR; PG8_WAIT_L(0); PG8_MMA(0, 1, At, B1); PG8_BAR;
            PG8_LDA(At, 1, 1); PG8_STAGE(PG8_SA(1, 0), a3, voffA);
            PG8_BAR; PG8_WAIT_L(0); PG8_MMA(1, 0, At, B0); PG8_BAR; PG8_SCHED;
            PG8_STAGE(PG8_SB(1, 1), b3 + hstep, voffB);
            PG8_WAIT_V(6); PG8_BAR; PG8_MMA(1, 1, At, B1); PG8_BAR;
            }
        }
        if constexpr (ALIGN_EPI) { if (wr == 0) PG8_BAR; }
        if constexpr (!Epi::AFTER_DRAIN) { E(acc, cur, wr, wc, fr, fq); S.done(cur); }
        if (!has_next) break;
#pragma unroll
        for (int a = 0; a < 2; ++a)
#pragma unroll
            for (int b = 0; b < 2; ++b)
#pragma unroll
                for (int m = 0; m < 4; ++m)
#pragma unroll
                    for (int n = 0; n < 2; ++n) acc[a][b][m][n] = (f32x4){0.f, 0.f, 0.f, 0.f};
        cur = nxt; cA = nA; cB = nB; ++ui;
        if constexpr (ALIGN_EPI) { if (wr == 1) PG8_BAR; }
    }
    PG8_WAIT_V(0);
    if constexpr (!ALIGN_EPI) { if (wr == 0) PG8_BAR; }
    PG8_BAR;
    if constexpr (Epi::AFTER_DRAIN) { E.fused(acc, cur, wr, wc, fr, fq, lds, wid, lane); S.done(cur); }
#undef PG8_SA
#undef PG8_SB
#undef PG8_STAGE
#undef PG8_LDA
#undef PG8_LDB
#undef PG8_MMA
#undef PG8_WAIT_V
#undef PG8_WAIT_L
#undef PG8_BAR
#undef PG8_SCHED
}
}

#define XB_TMO      128
#define XB_XCNT(j)  (256  + 64 * (j))
#define XB_XSUB(j)  (1280 + 64 * (j))
#define XB_XGEN(j)  (2304 + 64 * (j))
#define XB_TOP      3328
#define XB_TOPGEN   3392
#define XCD_BAR_WORDS 3456
#define XB_SPIN_CAP (1u << 18)
#define LAS __attribute__((address_space(3)))

__device__ __forceinline__ unsigned xb_ld(unsigned* p)              { return __hip_atomic_load(p, __ATOMIC_RELAXED, __HIP_MEMORY_SCOPE_AGENT); }
__device__ __forceinline__ unsigned xb_add(unsigned* p, unsigned v) { return __hip_atomic_fetch_add(p, v, __ATOMIC_RELAXED, __HIP_MEMORY_SCOPE_AGENT); }
__device__ __forceinline__ unsigned xb_xcc_id() { return (unsigned)__builtin_amdgcn_s_getreg((3 << 11) | 20) & 0xFu; }
#define XB_SPIN(cond, bar) do { unsigned _sp = 0; while (cond) { __builtin_amdgcn_s_sleep(1); \
    if ((++_sp & 255u) == 0u) { if (xb_ld(&(bar)[XB_TMO])) break; if (_sp > XB_SPIN_CAP) { atomicAdd(&(bar)[XB_TMO], 1u); break; } } } } while (0)

struct XcdBarrier {
    unsigned* bar; unsigned x;
    volatile LAS unsigned* st;
};

__device__ __forceinline__ XcdBarrier xcd_barrier_post(unsigned* bar, volatile LAS unsigned* st, int tid) {
    XcdBarrier b; b.bar = bar; b.x = (unsigned)__builtin_amdgcn_readfirstlane((int)xb_xcc_id()); b.st = st;
    if (tid == 0) (void)xb_add(&bar[XB_XCNT(b.x)], 1u);
    return b;
}
__device__ __forceinline__ void xcd_barrier_complete(unsigned* bar, unsigned x, unsigned& nloc, unsigned& nx) {
    const unsigned G = gridDim.x * gridDim.y * gridDim.z;
    unsigned sum, cnt, mine, sp = 0u;
    for (;;) {
        sum = 0u; cnt = 0u; mine = 0u;
#pragma unroll
        for (unsigned j = 0; j < 16; ++j) { const unsigned c = xb_ld(&bar[XB_XCNT(j)]); sum += c; cnt += (c > 0u) ? 1u : 0u; mine = (j == x) ? c : mine; }
        if (sum == G) break;
        __builtin_amdgcn_s_sleep(1);
        if ((++sp & 255u) == 0u) { if (xb_ld(&bar[XB_TMO])) break; if (sp > XB_SPIN_CAP) { atomicAdd(&bar[XB_TMO], 1u); break; } }
    }
    nloc = mine > 0u ? mine : 1u; nx = cnt > 0u ? cnt : 1u;
}

__device__ __forceinline__ void xcd_barrier(const XcdBarrier& b, int tid) {
    asm volatile("s_waitcnt vmcnt(0)" ::: "memory");
    __syncthreads();
    if (tid == 0) {
        unsigned* bar = b.bar; unsigned bx_ = b.x; asm volatile("" : "+s"(bar), "+s"(bx_));
        __builtin_amdgcn_s_waitcnt(0);
        unsigned nloc = b.st[0], nx = b.st[1];
        if (nloc == 0u) { xcd_barrier_complete(bar, bx_, nloc, nx); b.st[0] = nloc; b.st[1] = nx; }
        const unsigned old = xb_add(&bar[XB_XSUB(bx_)], 1u);
        const unsigned gen = old / nloc;
        if (old + 1u == (gen + 1u) * nloc) {
            __builtin_amdgcn_fence(__ATOMIC_RELEASE, "agent");
            asm volatile("s_waitcnt vmcnt(0)" ::: "memory");
            const unsigned og = xb_add(&bar[XB_TOP], 1u);
            const unsigned tg = og / nx;
            if (og + 1u == (tg + 1u) * nx) xb_add(&bar[XB_TOPGEN], 1u);
            else XB_SPIN(xb_ld(&bar[XB_TOPGEN]) == tg, bar);
            __builtin_amdgcn_fence(__ATOMIC_ACQUIRE, "agent");
            xb_add(&bar[XB_XGEN(bx_)], 1u);
            asm volatile("s_waitcnt vmcnt(0)" ::: "memory");
        } else {
            XB_SPIN(xb_ld(&bar[XB_XGEN(bx_)]) == gen, bar);
            __builtin_amdgcn_fence(__ATOMIC_ACQUIRE, "agent");
            asm volatile("s_waitcnt vmcnt(0)" ::: "memory");
        }
    }
    __syncthreads();
}


typedef unsigned v4u __attribute__((ext_vector_type(4)));
typedef float f32x4 __attribute__((ext_vector_type(4)));
#define LDS_WAIT() asm volatile("s_waitcnt lgkmcnt(0)" ::: "memory")
constexpr int NWAVES = 8, NTHREADS = 512;
constexpr int RING_BYTES = 131072, LDS_BYTES = 155648;

struct P { const float* in[N_IN]; float* out; unsigned char* ws; };

template <int M> __device__ __forceinline__ float swz_xor(float v) { static_assert(M >= 1 && M < 32, "swizzle xor mask"); return __int_as_float(__builtin_amdgcn_ds_swizzle(__float_as_int(v), (M << 10) | 0x1f)); }
__device__ __forceinline__ float xor32_sum(float v) { auto r = __builtin_amdgcn_permlane32_swap(__float_as_uint(v), __float_as_uint(v), false, false); return __uint_as_float(r[0]) + __uint_as_float(r[1]); }
__device__ __forceinline__ float wave_sum(float v) {
    v += swz_xor<1>(v); v += swz_xor<2>(v); v += swz_xor<4>(v); v += swz_xor<8>(v); v += swz_xor<16>(v);
    return xor32_sum(v);
}

template <bool VPERM = false>
__device__ __forceinline__ void transpose_item(const float* W, int K, int N, bf16* WT, int k0, int n0, int drow0, LAS float* scr, int lane) {
    float tv[32];
#pragma unroll
    for (int i = 0; i < 32; ++i) { const int kk = 2 * i + (lane >> 5); tv[i] = W[(size_t)(k0 + kk) * N + n0 + (lane & 31)]; }
#pragma unroll
    for (int i = 0; i < 32; ++i) { const int kk = 2 * i + (lane >> 5); scr[kk * 33 + (lane & 31)] = tv[i]; }
    LDS_WAIT(); asm volatile("" ::: "memory");
    const int c = lane & 7;
#pragma unroll
    for (int j = 0; j < 4; ++j) { const int n = (lane >> 3) + 8 * j; const LAS float* s = scr + (8 * c) * 33 + n;
        v4u o; o.x = pk2(s[0 * 33], s[1 * 33]); o.y = pk2(s[2 * 33], s[3 * 33]); o.z = pk2(s[4 * 33], s[5 * 33]); o.w = pk2(s[6 * 33], s[7 * 33]);
        const int dr = VPERM ? (((drow0 + n) & ~127) + hg_vpos((drow0 + n) & 127)) : (drow0 + n);
        *(v4u*)(WT + (size_t)dr * K + k0 + 8 * c) = o; }
    LDS_WAIT(); asm volatile("" ::: "memory");
}

__device__ __forceinline__ void phase_prologue(const P& p, LAS unsigned char* lds, int gw, int NGW, int lane, int wave) {
    LAS float* scr = (LAS float*)(lds + wave * 16384);
    unsigned char* ws = p.ws;
    constexpr int IT_ADA = 16 * 192, IT_IN = 16 * 385, IT_BRA = 16 * 32, IT_BRB = 32 * 32, IT_OUT = 16 * 32, IT_UP = 16 * 128, IT_DOWN = 64 * 32;
    constexpr int IT_L = IT_ADA + IT_IN + IT_BRA + IT_BRB + IT_OUT + IT_UP + IT_DOWN;
    for (int it = gw; it < DEPTH * IT_L; it += NGW) {
        const int l = it / IT_L; int r = it % IT_L;
        bf16* wl = (bf16*)(ws + WS_W + (size_t)l * W_LSTRIDE);
        if (r < IT_ADA) { const int kb = r / 192, nb = r % 192; transpose_item(p.in[I_WADA] + (size_t)l * D * 6144, D, 6144, (bf16*)(ws + WS_WADA) + (size_t)l * 6144 * D, kb * 64, nb * 32, nb * 32, scr, lane); continue; } r -= IT_ADA;
        if (r < IT_IN) { const int kb = r / 385, nb = r % 385; const int n0 = nb * 32; const int dr = n0 < 10240 ? n0 : (n0 < 10272 ? PC_DT + (n0 - 10240) : n0 - 32);
            if (n0 >= PC_I && n0 < PC_OG) transpose_item<true>(p.in[I_WIN] + (size_t)l * D * IN_WIDTH, D, IN_WIDTH, (bf16*)((unsigned char*)wl + WO_IN), kb * 64, n0, dr, scr, lane);
            else transpose_item(p.in[I_WIN] + (size_t)l * D * IN_WIDTH, D, IN_WIDTH, (bf16*)((unsigned char*)wl + WO_IN), kb * 64, n0, dr, scr, lane);
            continue; } r -= IT_IN;
        if (r < IT_BRA) { const int kb = r / 32, nb = r % 32; transpose_item(p.in[I_WBRA] + (size_t)l * 1024 * 1024, 1024, 1024, (bf16*)((unsigned char*)wl + WO_BRA), kb * 64, nb * 32, nb * 32, scr, lane); continue; } r -= IT_BRA;
        if (r < IT_BRB) { const int kb = r / 32, nb = r % 32; transpose_item(p.in[I_WBRB] + (size_t)l * 2048 * 1024, 2048, 1024, (bf16*)((unsigned char*)wl + WO_BRB), kb * 64, nb * 32, nb * 32, scr, lane); continue; } r -= IT_BRB;
        if (r < IT_OUT) { const int kb = r / 32, nb = r % 32; transpose_item(p.in[I_WOUT] + (size_t)l * 1024 * 1024, 1024, 1024, (bf16*)((unsigned char*)wl + WO_OUT), kb * 64, nb * 32, nb * 32, scr, lane); continue; } r -= IT_OUT;
        if (r < IT_UP) { const int kb = r / 128, nb = r % 128; transpose_item(p.in[I_WUP] + (size_t)l * 1024 * 4096, 1024, 4096, (bf16*)((unsigned char*)wl + WO_UP), kb * 64, nb * 32, nb * 32, scr, lane); continue; } r -= IT_UP;
        { const int kb = r / 32, nb = r % 32; transpose_item(p.in[I_WDOWN] + (size_t)l * 4096 * 1024, 4096, 1024, (bf16*)((unsigned char*)wl + WO_DOWN), kb * 64, nb * 32, nb * 32, scr, lane); }
    }
    for (int i = gw * 64 + lane; i < DEPTH * 28672; i += NGW * 64) { const int l = i / 28672, r = i % 28672;
        ((v4u*)(ws + WS_W + (size_t)l * W_LSTRIDE + WO_IN + (size_t)IN_WIDTH * D * 2))[r] = (v4u){0u, 0u, 0u, 0u}; }
    for (int i = gw * 64 + lane; i < 256 * 1024; i += NGW * 64) { const int r = i >> 10, c = i & 1023;
        float v = 0.f; if (r < NB) v = p.in[I_CP][r * D + c]; else if (r < NCOND) v = p.in[I_CS][(r - NB) * D + c];
        ((bf16*)(ws + WS_AC))[i] = f2bf(siluf_(v)); }
    for (int c = gw * 64 + lane; c < 1024; c += NGW * 64) { float v[DEPTH], mx = -3.0e38f;
#pragma unroll
        for (int l = 0; l < DEPTH; ++l) { v[l] = p.in[I_LB][l * 1024 + c]; mx = fmaxf(mx, v[l]); }
        float s = 0.f;
#pragma unroll
        for (int l = 0; l < DEPTH; ++l) { v[l] = expf(v[l] - mx); s += v[l]; }
        float cum = 0.f; float* lbs = (float*)(ws + WS_LBS);
#pragma unroll
        for (int l = 0; l < DEPTH; ++l) { if (l > 0) cum += v[l] / s; lbs[l * 1024 + c] = cum; }
    }
}

__device__ __forceinline__ f32x4 unpack4(unsigned long long w) { const unsigned lo = (unsigned)w, hi = (unsigned)(w >> 32); return (f32x4){__uint_as_float(lo << 16), __uint_as_float(lo & 0xffff0000u), __uint_as_float(hi << 16), __uint_as_float(hi & 0xffff0000u)}; }
template <int MODE, int NR>
__device__ __forceinline__ void norm_rows(const float* X32, bf16* X, bf16* H, float* out32, const f32x4 (&mul)[4], const f32x4 (&sh)[4], int lane) {
    if constexpr (MODE == 1) {
        f32x4 v[NR][4];
#pragma unroll
        for (int r = 0; r < NR; ++r) { const f32x4* xr = (const f32x4*)(X32 + (size_t)r * D) + lane;
#pragma unroll
            for (int j = 0; j < 4; ++j) v[r][j] = xr[64 * j]; }
#pragma unroll
        for (int r = 0; r < NR; ++r) { float s = 0.f;
#pragma unroll
            for (int j = 0; j < 4; ++j) s += (v[r][j].x * v[r][j].x + v[r][j].y * v[r][j].y) + (v[r][j].z * v[r][j].z + v[r][j].w * v[r][j].w);
            const float rstd = rsqrtf(wave_sum(s) * (1.f / D) + EPS);
            unsigned long long* o8 = (unsigned long long*)(H + (size_t)r * D) + lane; unsigned long long* x8 = (unsigned long long*)(X + (size_t)r * D) + lane;
#pragma unroll
            for (int j = 0; j < 4; ++j) { const f32x4 y = v[r][j] * rstd * mul[j] + sh[j];
                x8[64 * j] = (unsigned long long)pk2(v[r][j].x, v[r][j].y) | ((unsigned long long)pk2(v[r][j].z, v[r][j].w) << 32);
                o8[64 * j] = (unsigned long long)pk2(y.x, y.y) | ((unsigned long long)pk2(y.z, y.w) << 32); } }
    } else {
        unsigned long long raw[NR][4];
#pragma unroll
        for (int r = 0; r < NR; ++r) { const unsigned long long* xr = (const unsigned long long*)(X + (size_t)r * D) + lane;
#pragma unroll
            for (int j = 0; j < 4; ++j) raw[r][j] = xr[64 * j]; }
#pragma unroll
        for (int r = 0; r < NR; ++r) { f32x4 v[4]; float s = 0.f;
#pragma unroll
            for (int j = 0; j < 4; ++j) { v[j] = unpack4(raw[r][j]); s += (v[j].x * v[j].x + v[j].y * v[j].y) + (v[j].z * v[j].z + v[j].w * v[j].w); }
            const float rstd = rsqrtf(wave_sum(s) * (1.f / D) + EPS);
            if constexpr (MODE == 2) { f32x4* o = (f32x4*)(out32 + (size_t)r * D) + lane;
#pragma unroll
                for (int j = 0; j < 4; ++j) o[64 * j] = v[j] * rstd * mul[j];
            } else { unsigned long long* o8 = (unsigned long long*)(H + (size_t)r * D) + lane;
#pragma unroll
                for (int j = 0; j < 4; ++j) { const f32x4 y = v[j] * rstd * mul[j] + sh[j]; o8[64 * j] = (unsigned long long)pk2(y.x, y.y) | ((unsigned long long)pk2(y.z, y.w) << 32); } } }
    }
}
template <int MODE>
__device__ __forceinline__ void phase_norm(const float* Xp32, const float* Xs32, bf16* X, bf16* H, const float* nw, const float* mod_sh, const float* mod_sc, int gw, int NGW, int lane) {
    f32x4 w4[4];
#pragma unroll
    for (int j = 0; j < 4; ++j) w4[j] = ((const f32x4*)nw)[lane + 64 * j];
    for (int b = gw; b < MP / 8; b += NGW) {
        const int ci = b >> 8; f32x4 mul[4], sh[4];
        const f32x4* shp = (const f32x4*)(mod_sh + (size_t)ci * MODLD) + lane; const f32x4* scp = (const f32x4*)(mod_sc + (size_t)ci * MODLD) + lane;
#pragma unroll
        for (int j = 0; j < 4; ++j) { sh[j] = shp[64 * j]; mul[j] = w4[j] * (scp[64 * j] + 1.0f); }
        const size_t ro = (size_t)b * 8 * D;
        norm_rows<MODE, MODE == 1 ? 4 : 8>(MODE == 1 ? Xp32 + ro : nullptr, X + ro, H + ro, nullptr, mul, sh, lane);
        if constexpr (MODE == 1) norm_rows<MODE, 4>(Xp32 + ro + 4 * D, X + ro + 4 * D, H + ro + 4 * D, nullptr, mul, sh, lane);
    }
    for (int sr = gw; sr < MS; sr += NGW) {
        const int ci = NB + sr; f32x4 mul[4], sh[4];
        const f32x4* shp = (const f32x4*)(mod_sh + (size_t)ci * MODLD) + lane; const f32x4* scp = (const f32x4*)(mod_sc + (size_t)ci * MODLD) + lane;
#pragma unroll
        for (int j = 0; j < 4; ++j) { sh[j] = shp[64 * j]; mul[j] = w4[j] * (scp[64 * j] + 1.0f); }
        const size_t ro = (size_t)(MP + sr) * D;
        norm_rows<MODE, 1>(MODE == 1 ? Xs32 + (size_t)sr * D : nullptr, X + ro, H + ro, nullptr, mul, sh, lane);
    }
}
__device__ __forceinline__ void phase_final(const bf16* X, float* out, const float* nw, int gw, int NGW, int lane) {
    f32x4 w4[4];
#pragma unroll
    for (int j = 0; j < 4; ++j) w4[j] = ((const f32x4*)nw)[lane + 64 * j];
    for (int b = gw; b < MP / 8; b += NGW) { const size_t ro = (size_t)b * 8 * D; norm_rows<2, 8>(nullptr, (bf16*)X + ro, nullptr, out + ro, w4, w4, lane); }
    for (int sr = gw; sr < MS; sr += NGW) { const size_t ro = (size_t)(MP + sr) * D; norm_rows<2, 1>(nullptr, (bf16*)X + ro, nullptr, out + ro, w4, w4, lane); }
}


typedef short s16x4 __attribute__((ext_vector_type(4)));
typedef short bf16x8 __attribute__((ext_vector_type(8)));
__device__ __forceinline__ f32x4 mfma16(bf16x8 a, bf16x8 b, f32x4 c) { return __builtin_amdgcn_mfma_f32_16x16x32_bf16(a, b, c, 0, 0, 0); }
__device__ __forceinline__ s16x4 tr_read4(LAS unsigned char* p) { return __builtin_amdgcn_ds_read_tr16_b64_v4i16((LAS s16x4*)p); }
#define SHFL_XOR(v, M) swz_xor<M>(v)
__device__ __forceinline__ float shfl_up_f(float v, int o, int lane) { return __int_as_float(__builtin_amdgcn_ds_bpermute((lane >= o ? lane - o : lane) << 2, __float_as_int(v))); }
__device__ __forceinline__ void sync_threads() { __syncthreads(); }
__device__ __forceinline__ float __builtin_amdgcn_exp2f_(float x) { return __builtin_amdgcn_exp2f(x); }
#ifdef HOST_EMU
#define FENCE_MEM() do {} while (0)
#define SCHED_FENCE() do {} while (0)
#define LAUNDER_PTR(p) do {} while (0)
#else
#define LAUNDER_PTR(p) asm volatile("" : "+v"(p))
#define FENCE_MEM() asm volatile("" ::: "memory")
#define SCHED_FENCE() __builtin_amdgcn_sched_barrier(0)
#endif
constexpr int RC = 64;
constexpr int NSEG = 4, SEGLEN = 512, NCH = SEGLEN / RC;
constexpr int PQ = 272;
constexpr int PX = 528;

struct RecurBufs {
    bf16* proj;
    bf16* xbcc;
    float* dtv;
    float* cum;
    float* cv;
    float* sseg;
    float* dseg;
    float* hseg;
    float* tseg;
    bf16* ohg;
    bf16* y;
};

__device__ __forceinline__ bf16x8 frag_rows(LAS unsigned char* img, int pitch, int row, int kcol) { return *(LAS bf16x8*)(img + row * pitch + kcol * 2); }
__device__ __forceinline__ bf16x8 frag_tr(LAS unsigned char* img, int pitch, int k0a, int k0b, int col0, int lane) {
    const int q = (lane & 15) >> 2, p = lane & 3;
    const s16x4 a = tr_read4(img + (k0a + q) * pitch + (col0 + 4 * p) * 2);
    const s16x4 b = tr_read4(img + (k0b + q) * pitch + (col0 + 4 * p) * 2);
    return (bf16x8){a[0], a[1], a[2], a[3], b[0], b[1], b[2], b[3]};
}
__device__ __forceinline__ bf16x8 scale_frag(bf16x8 f, float s) {
    bf16x8 o;
#pragma unroll
    for (int j = 0; j < 8; ++j) o[j] = (short)f2bf(bf2f((bf16)f[j]) * s);
    return o;
}
__device__ __forceinline__ bf16x8 scale_frag8(bf16x8 f, const float (&s)[8]) {
    bf16x8 o;
#pragma unroll
    for (int j = 0; j < 8; ++j) o[j] = (short)f2bf(bf2f((bf16)f[j]) * s[j]);
    return o;
}
__device__ __forceinline__ void stage_tile128(const bf16* g, size_t ld, LAS unsigned char* img, int tid) {
#pragma unroll
    for (int i = 0; i < 2; ++i) { const int idx = tid + i * 512, r = idx >> 4, c16 = idx & 15;
        *(LAS v4u*)(img + r * PQ + c16 * 16) = *(const v4u*)(g + (size_t)r * ld + c16 * 8); }
}

constexpr int HG_QT = 0, HG_KT = 17408, HG_V = 34816, HG_PART = 52224, HG_VEC1 = 54272, HG_ST = 52224, HG_VEC = 87040, HG_RED = 89088;

__device__ __forceinline__ void hgrn_state_update(f32x4 (&S)[8], LAS unsigned char* Kt, LAS unsigned char* V, const LAS float* escale, const LAS float* edec, int w, int lane) {
    const int c = lane & 15, g = lane >> 4;
    const f32x4 dc = *(const LAS f32x4*)(edec + 16 * w + 4 * g);
#pragma unroll
    for (int et = 0; et < 8; ++et) S[et] = S[et] * dc;
    const float es = escale[16 * w + c];
#pragma unroll
    for (int ks = 0; ks < 2; ++ks) {
        const bf16x8 A = scale_frag(frag_tr(Kt, PQ, 32 * ks + 8 * g, 32 * ks + 8 * g + 4, 16 * w, lane), es);
#pragma unroll
        for (int et = 0; et < 8; ++et) { const bf16x8 B = frag_tr(V, PQ, 32 * ks + 8 * g, 32 * ks + 8 * g + 4, 16 * et, lane); S[et] = mfma16(A, B, S[et]); }
        SCHED_FENCE();
    }
}

__device__ __forceinline__ void hgrn_pass1(const RecurBufs& rb, const float* lbs_l, int u, int tid, LAS unsigned char* lds) {
    const int b = u >> 5, h = (u >> 2) & 7, seg = u & 3, lane = tid & 63, w = tid >> 6;
    const int d = tid & 127, jq = tid >> 7;
    LAS unsigned char* Qt = lds + HG_QT; LAS unsigned char* Kt = lds + HG_KT; LAS unsigned char* V = lds + HG_V; LAS float* part = (LAS float*)(lds + HG_PART); LAS float* vec = (LAS float*)(lds + HG_VEC1);
    const float lb = lbs_l[h * 128 + d];
    f32x4 S[8];
#pragma unroll
    for (int et = 0; et < 8; ++et) S[et] = (f32x4){0.f, 0.f, 0.f, 0.f};
    float dprod = 1.f;
    const int sr = tid >> 4, sc16 = tid & 15;
    v4u pre[6];
    {   const bf16* gq = rb.proj + ((size_t)b * SEQ + seg * SEGLEN + sr) * LDP + PC_Q + h * 128 + sc16 * 8;
        pre[0] = *(const v4u*)gq; pre[1] = *(const v4u*)(gq + 32 * (size_t)LDP); pre[2] = *(const v4u*)(gq + PC_F); pre[3] = *(const v4u*)(gq + 32 * (size_t)LDP + PC_F);
        pre[4] = *(const v4u*)(gq + PC_I); pre[5] = *(const v4u*)(gq + 32 * (size_t)LDP + PC_I); }
    for (int ch = 0; ch < NCH; ++ch) {
        const size_t row0 = (size_t)b * SEQ + seg * SEGLEN + ch * RC;
        bf16* gq = rb.proj + (row0 + sr) * LDP + PC_Q + h * 128 + sc16 * 8;
        *(LAS v4u*)(Qt + sr * PQ + sc16 * 16) = pre[0]; *(LAS v4u*)(Qt + (sr + 32) * PQ + sc16 * 16) = pre[1];
        *(LAS v4u*)(Kt + sr * PQ + sc16 * 16) = pre[2]; *(LAS v4u*)(Kt + (sr + 32) * PQ + sc16 * 16) = pre[3];
        *(LAS v4u*)(V + sr * PQ + sc16 * 16) = pre[4]; *(LAS v4u*)(V + (sr + 32) * PQ + sc16 * 16) = pre[5];
        if (ch + 1 < NCH) { const bf16* gn = gq + RC * (size_t)LDP;
            pre[0] = *(const v4u*)gn; pre[1] = *(const v4u*)(gn + 32 * (size_t)LDP); pre[2] = *(const v4u*)(gn + PC_F); pre[3] = *(const v4u*)(gn + 32 * (size_t)LDP + PC_F);
            pre[4] = *(const v4u*)(gn + PC_I); pre[5] = *(const v4u*)(gn + 32 * (size_t)LDP + PC_I); }
        sync_threads();
        float qq[16], kk[16], lg[16];
#pragma unroll
        for (int j = 0; j < 16; ++j) { const float q = bf2f(*(const LAS bf16*)(Qt + (16 * jq + j) * PQ + d * 2)), f = bf2f(*(const LAS bf16*)(Kt + (16 * jq + j) * PQ + d * 2));
            const float fg = lb + (1.f - lb) * sigmoidf_(f);
            qq[j] = siluf_(q) * 0.08838834764831845f; kk[j] = 1.f - fg; lg[j] = __logf(fg); }
#pragma unroll
        for (int j = 1; j < 16; ++j) lg[j] += lg[j - 1];
        part[jq * 128 + d] = lg[15];
        sync_threads();
        const float p0 = part[d], p1 = part[128 + d], p2 = part[256 + d], p3 = part[384 + d];
        const float off = (jq > 0 ? p0 : 0.f) + (jq > 1 ? p1 : 0.f) + (jq > 2 ? p2 : 0.f);
        const float bref = p0 + p1, bend = (p0 + p1) + (p2 + p3);
#pragma unroll
        for (int j = 0; j < 16; ++j) { const float e1 = __expf(fminf(fmaxf(off + lg[j] - bref, -80.f), 80.f));
            *(LAS bf16*)(Qt + (16 * jq + j) * PQ + d * 2) = f2bf(qq[j] * e1); *(LAS bf16*)(Kt + (16 * jq + j) * PQ + d * 2) = f2bf(kk[j] * frcp_(e1)); }
        if (jq == 0) { const float eref = __expf(bref), esc = __expf(bend - bref), edc = __expf(bend);
            float* cvp = rb.cv + ((size_t)((b * 8 + h) * 32 + seg * NCH + ch) * 3) * 128;
            cvp[d] = eref; cvp[128 + d] = esc; cvp[256 + d] = edc; vec[128 + d] = esc; vec[256 + d] = edc; }
        dprod *= __expf(bend);
        sync_threads();
        *(v4u*)gq = *(const LAS v4u*)(Qt + sr * PQ + sc16 * 16); *(v4u*)(gq + 32 * (size_t)LDP) = *(const LAS v4u*)(Qt + (sr + 32) * PQ + sc16 * 16);
        *(v4u*)(gq + PC_F) = *(const LAS v4u*)(Kt + sr * PQ + sc16 * 16); *(v4u*)(gq + 32 * (size_t)LDP + PC_F) = *(const LAS v4u*)(Kt + (sr + 32) * PQ + sc16 * 16);
        hgrn_state_update(S, Kt, V, vec + 128, vec + 256, w, lane);
        sync_threads();
    }
    float* sp = rb.sseg + (size_t)u * 16384 + tid * 4;
#pragma unroll
    for (int et = 0; et < 8; ++et) { LAUNDER_PTR(sp); *(f32x4*)sp = S[et]; sp += 2048; }
    if (jq == 0) rb.dseg[u * 128 + d] = dprod;
}

__device__ __forceinline__ void hgrn_pass2(const RecurBufs& rb, const float* hgn_l, float* state_out_l, int u, int tid, LAS unsigned char* lds) {
    const int b = u >> 5, h = (u >> 2) & 7, seg = u & 3, lane = tid & 63, w = tid >> 6, c = lane & 15, g = lane >> 4;
    const int it = w & 3, eh = w >> 2;
    LAS unsigned char* Qt = lds + HG_QT; LAS unsigned char* Kt = lds + HG_KT; LAS unsigned char* V = lds + HG_V; LAS unsigned char* ST = lds + HG_ST;
    LAS float* vec = (LAS float*)(lds + HG_VEC); LAS float* red = (LAS float*)(lds + HG_RED);
    f32x4 S[8];
#pragma unroll
    for (int et = 0; et < 8; ++et) S[et] = (f32x4){0.f, 0.f, 0.f, 0.f};
    for (int s = 0; s < seg; ++s) { const int u2 = u - seg + s;
        const f32x4 dc = *(const f32x4*)(rb.dseg + u2 * 128 + 16 * w + 4 * g);
        const float* sp = rb.sseg + (size_t)u2 * 16384 + tid * 4;
#pragma unroll
        for (int et = 0; et < 8; ++et) { LAUNDER_PTR(sp); S[et] = S[et] * dc + *(const f32x4*)sp; sp += 2048; } }
    const int e0 = 64 * eh + 4 * c;
    const f32x4 hn = *(const f32x4*)(hgn_l + e0);
    const float* cvb = rb.cv + ((size_t)((b * 8 + h) * 32 + seg * NCH) * 3) * 128;
    const int sr = tid >> 4, sc16 = tid & 15;
    const size_t rowS = (size_t)b * SEQ + seg * SEGLEN;
    v4u pre[6];
    {   const bf16* gq = rb.proj + (rowS + sr) * LDP + PC_Q + h * 128 + sc16 * 8;
        pre[0] = *(const v4u*)gq; pre[1] = *(const v4u*)(gq + 32 * (size_t)LDP); pre[2] = *(const v4u*)(gq + PC_F); pre[3] = *(const v4u*)(gq + 32 * (size_t)LDP + PC_F);
        pre[4] = *(const v4u*)(gq + PC_I); pre[5] = *(const v4u*)(gq + 32 * (size_t)LDP + PC_I); }
    float cvn = tid < 384 ? cvb[tid] : 0.f; f32x4 ern = *(const f32x4*)(cvb + 16 * w + 4 * g);
    for (int ch = 0; ch < NCH; ++ch) {
        const size_t row0 = rowS + ch * RC;
        *(LAS v4u*)(Qt + sr * PQ + sc16 * 16) = pre[0]; *(LAS v4u*)(Qt + (sr + 32) * PQ + sc16 * 16) = pre[1];
        *(LAS v4u*)(Kt + sr * PQ + sc16 * 16) = pre[2]; *(LAS v4u*)(Kt + (sr + 32) * PQ + sc16 * 16) = pre[3];
        *(LAS v4u*)(V + sr * PQ + sc16 * 16) = pre[4]; *(LAS v4u*)(V + (sr + 32) * PQ + sc16 * 16) = pre[5];
        if (ch + 1 < NCH) { const bf16* gq = rb.proj + (row0 + RC + sr) * LDP + PC_Q + h * 128 + sc16 * 8;
            pre[0] = *(const v4u*)gq; pre[1] = *(const v4u*)(gq + 32 * (size_t)LDP); pre[2] = *(const v4u*)(gq + PC_F); pre[3] = *(const v4u*)(gq + 32 * (size_t)LDP + PC_F);
            pre[4] = *(const v4u*)(gq + PC_I); pre[5] = *(const v4u*)(gq + 32 * (size_t)LDP + PC_I); }
        if (tid < 384) vec[tid] = cvn;
        {
            const f32x4 er = ern;
            if (ch + 1 < NCH) { if (tid < 384) cvn = cvb[(size_t)(ch + 1) * 384 + tid]; ern = *(const f32x4*)(cvb + (size_t)(ch + 1) * 384 + 16 * w + 4 * g); }
#pragma unroll
            for (int et = 0; et < 8; ++et) { const f32x4 v = S[et] * er;
                *(LAS unsigned long long*)(ST + (16 * et + c) * PQ + (16 * w + 4 * g) * 2) = (unsigned long long)pk2(v[0], v[1]) | ((unsigned long long)pk2(v[2], v[3]) << 32); } }
        unsigned long long ogv[4];
#pragma unroll
        for (int r = 0; r < 4; ++r) ogv[r] = *(const unsigned long long*)(rb.proj + (row0 + 16 * it + 4 * g + r) * LDP + PC_OG + h * 128 + e0);
        sync_threads();
        bf16x8 Qfr[4];
#pragma unroll
        for (int kd = 0; kd < 4; ++kd) Qfr[kd] = frag_rows(Qt, PQ, 16 * it + c, 32 * kd + 8 * g);
        unsigned PT[4][2];
#pragma unroll
        for (int jt = 0; jt < 4; ++jt) {
            f32x4 acc = (f32x4){0.f, 0.f, 0.f, 0.f};
            if (jt <= it) {
#pragma unroll
                for (int kd = 0; kd < 4; ++kd) acc = mfma16(frag_rows(Kt, PQ, 16 * jt + c, 32 * kd + 8 * g), Qfr[kd], acc);
                if (jt == it) {
#pragma unroll
                    for (int r = 0; r < 4; ++r) acc[r] = (4 * g + r <= c) ? acc[r] : 0.f; }
            }
            PT[jt][0] = pk2(acc[0], acc[1]); PT[jt][1] = pk2(acc[2], acc[3]); SCHED_FENCE();
        }
        f32x4 o[4];
#pragma unroll
        for (int et = 0; et < 4; ++et) o[et] = (f32x4){0.f, 0.f, 0.f, 0.f};
#pragma unroll
        for (int ks = 0; ks < 2; ++ks) if (2 * ks <= it) {
            v4u pa = (v4u){PT[2 * ks][0], PT[2 * ks][1], PT[2 * ks + 1][0], PT[2 * ks + 1][1]};
            const bf16x8 A = __builtin_bit_cast(bf16x8, pa);
#pragma unroll
            for (int et = 0; et < 4; ++et) o[et] = mfma16(A, frag_tr(V, PQ, 32 * ks + 4 * g, 32 * ks + 16 + 4 * g, 16 * (4 * eh + et), lane), o[et]);
        }
#pragma unroll
        for (int kd = 0; kd < 4; ++kd) {
#pragma unroll
            for (int et = 0; et < 4; ++et) o[et] = mfma16(Qfr[kd], frag_rows(ST, PQ, 16 * (4 * eh + et) + c, 32 * kd + 8 * g), o[et]);
            SCHED_FENCE(); }
        hgrn_state_update(S, Kt, V, vec + 128, vec + 256, w, lane);
        float ss[4];
#pragma unroll
        for (int r = 0; r < 4; ++r) { float s = 0.f;
#pragma unroll
            for (int et = 0; et < 4; ++et) s += o[et][r] * o[et][r];
            s += SHFL_XOR(s, 1); s += SHFL_XOR(s, 2); s += SHFL_XOR(s, 4); s += SHFL_XOR(s, 8); ss[r] = s; }
        if (c == 0) {
#pragma unroll
            for (int r = 0; r < 4; ++r) red[(16 * it + 4 * g + r) * 2 + eh] = ss[r]; }
        sync_threads();
#pragma unroll
        for (int r = 0; r < 4; ++r) { const int i = 16 * it + 4 * g + r; const float rstd = rsqrtf((red[i * 2] + red[i * 2 + 1]) * (1.f / 128.f) + EPS);
            float ov[4];
#pragma unroll
            for (int et = 0; et < 4; ++et) { const float og = bf2f((bf16)(ogv[r] >> (16 * et))); ov[et] = o[et][r] * rstd * hn[et] * siluf_(og); }
            *(unsigned long long*)(rb.ohg + (row0 + i) * 1024 + h * 128 + e0) = (unsigned long long)pk2(ov[0], ov[1]) | ((unsigned long long)pk2(ov[2], ov[3]) << 32); }
        sync_threads();
    }
    if (seg == NSEG - 1) { float* so = state_out_l + (size_t)(b * 8 + h) * 16384 + (size_t)(16 * w + 4 * g) * 128 + 4 * c;
#pragma unroll
        for (int r = 0; r < 4; ++r)
#pragma unroll
            for (int a = 0; a < 2; ++a) *(f32x4*)(so + r * 128 + 64 * a) = (f32x4){S[4 * a][r], S[4 * a + 1][r], S[4 * a + 2][r], S[4 * a + 3][r]}; }
}

constexpr int PR = 1040;
constexpr int SD_T = 0, SD_H = 66560, SD_XO = 66560  , SD_DT = 136192, SD_CUM = 137216, SD_RED = 138240, SD_END = 139264;
__device__ __forceinline__ int ssd_gcol(int grp, int ch16) { return ch16 < 32 ? grp * 256 + ch16 * 8 : (ch16 < 48 ? 2048 + grp * 128 + (ch16 - 32) * 8 : 3072 + grp * 128 + (ch16 - 48) * 8); }

__device__ __forceinline__ void ssd_state_update(f32x4 (&H)[4][4], LAS unsigned char* Xi, int xp, LAS unsigned char* Bi, int bp, const LAS float* sDt, const LAS float* sCum, int w, int lane) {
    const int g = lane >> 4, k = w >> 1, nh = w & 1;
    const float tot = sCum[63 * 4 + k]; const float et = __expf(tot);
#pragma unroll
    for (int nt = 0; nt < 4; ++nt)
#pragma unroll
        for (int pt = 0; pt < 4; ++pt) H[nt][pt] = H[nt][pt] * et;
#pragma unroll
    for (int ks = 0; ks < 2; ++ks) {
        float wg[8];
#pragma unroll
        for (int j = 0; j < 8; ++j) wg[j] = __expf(tot - sCum[(32 * ks + 8 * g + j) * 4 + k]) * sDt[(32 * ks + 8 * g + j) * 4 + k];
        bf16x8 Bx[4];
#pragma unroll
        for (int pt = 0; pt < 4; ++pt) Bx[pt] = scale_frag8(frag_tr(Xi, xp, 32 * ks + 8 * g, 32 * ks + 8 * g + 4, 64 * k + 16 * pt, lane), wg);
#pragma unroll
        for (int nt = 0; nt < 4; ++nt) { const bf16x8 A = frag_tr(Bi, bp, 32 * ks + 8 * g, 32 * ks + 8 * g + 4, 16 * (4 * nh + nt), lane);
#pragma unroll
            for (int pt = 0; pt < 4; ++pt) H[nt][pt] = mfma16(A, Bx[pt], H[nt][pt]);
            SCHED_FENCE(); }
    }
}

typedef float f32x2r __attribute__((ext_vector_type(2)));
__device__ __forceinline__ f32x2r unpack2(unsigned w) { return (f32x2r){__uint_as_float(w << 16), __uint_as_float(w & 0xffff0000u)}; }
__device__ __forceinline__ f32x2r silu2(f32x2r a) {
    const f32x2r t = a * (-1.4426950408889634f); f32x2r e; e.x = __builtin_amdgcn_exp2f_(t.x); e.y = __builtin_amdgcn_exp2f_(t.y);
    const f32x2r d = e + 1.0f; f32x2r r; r.x = frcp_(d.x); r.y = frcp_(d.y); return a * r; }
constexpr int SD_RH = SD_XO + 64 * PX;
__device__ __forceinline__ void ssd_pass1(const RecurBufs& rb, const float* conv_w, const float* conv_b, const float* dt_bias, const float* a_log, float* conv_out_l, int u, int tid, LAS unsigned char* lds) {
    const int b = u >> 5, grp = (u >> 2) & 7, seg = u & 3, lane = tid & 63, w = tid >> 6;
    LAS unsigned char* T = lds + SD_T; LAS float* sDt = (LAS float*)(lds + SD_DT); LAS float* sCum = (LAS float*)(lds + SD_CUM); LAS unsigned char* RH = lds + SD_RH;
    const int cp = tid & 255, half = tid >> 8, t0c = 2 * cp;
    const int chx = t0c < 256 ? (grp * 256 + t0c) : (t0c < 384 ? (2048 + grp * 128 + (t0c - 256)) : (3072 + grp * 128 + (t0c - 384)));
    const int xcol = (t0c & ~63) + 16 * (t0c & 3) + ((t0c & 63) >> 2);
    const f32x2r w0 = (f32x2r){conv_w[chx], conv_w[chx + 1]}, w1 = (f32x2r){conv_w[4096 + chx], conv_w[4096 + chx + 1]}, w2 = (f32x2r){conv_w[8192 + chx], conv_w[8192 + chx + 1]},
                 w3 = (f32x2r){conv_w[12288 + chx], conv_w[12288 + chx + 1]}, cb = (f32x2r){conv_b[chx], conv_b[chx + 1]};
    const size_t rowS = (size_t)b * SEQ + seg * SEGLEN;
    if (half == 0) {
#pragma unroll
        for (int j = 0; j < 3; ++j) { unsigned v = 0u; if (seg > 0) v = *(const unsigned*)(rb.proj + (rowS - 3 + j) * LDP + PC_XBC + chx); *(LAS unsigned*)(RH + j * 1024 + cp * 4) = v; } }
    f32x4 H[4][4];
#pragma unroll
    for (int nt = 0; nt < 4; ++nt)
#pragma unroll
        for (int pt = 0; pt < 4; ++pt) H[nt][pt] = (f32x4){0.f, 0.f, 0.f, 0.f};
    float tsum = 0.f;
    const int ch16 = tid & 63, rr = tid >> 6;
    const int gcol = ssd_gcol(grp, ch16);
    LAS unsigned char* XO = lds + SD_XO;
    v4u raw[8];
    {   const bf16* gp = rb.proj + (rowS + rr) * LDP + PC_XBC + gcol;
#pragma unroll
        for (int i = 0; i < 8; ++i) { LAUNDER_PTR(gp); raw[i] = *(const v4u*)gp; gp += 8 * (size_t)LDP; } }
    bf16 dtn = 0;
    if (w < 4) dtn = rb.proj[(rowS + lane) * LDP + PC_DT + grp * 4 + w];
    unsigned hr0 = 0u, hr1 = 0u, hr2 = 0u;
    for (int ch = 0; ch < NCH; ++ch) {
        const size_t row0 = rowS + ch * RC;
        if (w < 4) {
            const int head = grp * 4 + w; const size_t row = row0 + lane;
            const float dv = softplusf_(bf2f(dtn) + dt_bias[head]);
            if (ch + 1 < NCH) dtn = rb.proj[(row + RC) * LDP + PC_DT + head];
            float la = dv * (-__expf(a_log[head]));
#pragma unroll
            for (int o = 1; o < 64; o <<= 1) { const float t = shfl_up_f(la, o, lane); if (lane >= o) la += t; }
            sDt[lane * 4 + w] = dv; sCum[lane * 4 + w] = la; rb.dtv[row * 32 + head] = dv; rb.cum[row * 32 + head] = la;
        }
#pragma unroll
        for (int i = 0; i < 8; ++i) *(LAS v4u*)(T + (rr + 8 * i) * PR + ch16 * 16) = raw[i];
        if (ch + 1 < NCH) { const bf16* gp = rb.proj + (row0 + RC + rr) * LDP + PC_XBC + gcol;
#pragma unroll
            for (int i = 0; i < 8; ++i) { LAUNDER_PTR(gp); raw[i] = *(const v4u*)gp; gp += 8 * (size_t)LDP; } }
        sync_threads();
        if (half == 0) { hr0 = *(const LAS unsigned*)(RH + cp * 4); hr1 = *(const LAS unsigned*)(RH + 1024 + cp * 4); hr2 = *(const LAS unsigned*)(RH + 2048 + cp * 4); }
        else { hr0 = *(const LAS unsigned*)(T + 29 * PR + cp * 4); hr1 = *(const LAS unsigned*)(T + 30 * PR + cp * 4); hr2 = *(const LAS unsigned*)(T + 31 * PR + cp * 4); }
        sync_threads();
        {
            f32x2r r0 = unpack2(hr0), r1 = unpack2(hr1), r2 = unpack2(hr2);
            const LAS unsigned char* src = T + (32 * half) * PR + cp * 4;
            unsigned lastw0 = hr0, lastw1 = hr1, lastw2 = hr2;
#pragma unroll 8
            for (int j = 0; j < 32; ++j) { const unsigned cw = *(const LAS unsigned*)(src + j * PR); const f32x2r cur = unpack2(cw);
                const f32x2r a = cb + w0 * r0 + w1 * r1 + w2 * r2 + w3 * cur; r0 = r1; r1 = r2; r2 = cur; lastw0 = lastw1; lastw1 = lastw2; lastw2 = cw;
                const f32x2r v = silu2(a); const unsigned ow = pk2(v.x, v.y);
                if (cp < 128) { LAS unsigned char* d = XO + (32 * half + j) * PX + xcol * 2; *(LAS bf16*)d = (bf16)ow; *(LAS bf16*)(d + 32) = (bf16)(ow >> 16); }
                else *(LAS unsigned*)(T + (32 * half + j) * PR + cp * 4) = ow; }
            if (half == 1) { *(LAS unsigned*)(RH + cp * 4) = lastw0; *(LAS unsigned*)(RH + 1024 + cp * 4) = lastw1; *(LAS unsigned*)(RH + 2048 + cp * 4) = lastw2;
                hr0 = lastw0; hr1 = lastw1; hr2 = lastw2; }
        }
        sync_threads();
        tsum += sCum[63 * 4 + (w >> 1)];
        ssd_state_update(H, XO, PX, T + 512, PR, sDt, sCum, w, lane);
        {   bf16* gp = rb.xbcc + (row0 + rr) * 4096 + gcol;
            const LAS unsigned char* src = ch16 < 32 ? (XO + ch16 * 16) : (T + ch16 * 16); const int spitch = ch16 < 32 ? PX : PR;
#pragma unroll
            for (int i = 0; i < 8; ++i) { LAUNDER_PTR(gp); *(v4u*)gp = *(const LAS v4u*)(src + (rr + 8 * i) * spitch); gp += 8 * 4096; } }
        sync_threads();
    }
    float* hp = rb.hseg + (size_t)u * 32768 + tid * 4;
#pragma unroll
    for (int nt = 0; nt < 4; ++nt)
#pragma unroll
        for (int pt = 0; pt < 4; ++pt) { LAUNDER_PTR(hp); *(f32x4*)hp = H[nt][pt]; hp += 2048; }
    if ((tid & 127) == 0) rb.tseg[u * 4 + (w >> 1)] = tsum;
    if (seg == NSEG - 1 && half == 1) { float* co = conv_out_l + (size_t)b * 3 * 4096;
        const f32x2r a0 = unpack2(hr0), a1 = unpack2(hr1), a2 = unpack2(hr2);
        co[chx] = a0.x; co[chx + 1] = a0.y; co[4096 + chx] = a1.x; co[4096 + chx + 1] = a1.y; co[8192 + chx] = a2.x; co[8192 + chx + 1] = a2.y; }
}

__device__ __forceinline__ void ssd_pass2(const RecurBufs& rb, const float* d_skip, const float* ssm_norm, float* state_out_l, int u, int tid, LAS unsigned char* lds) {
    const int b = u >> 5, grp = (u >> 2) & 7, seg = u & 3, lane = tid & 63, w = tid >> 6, c = lane & 15, g = lane >> 4;
    const int k = w >> 1, hf = w & 1, head = grp * 4 + k;
    LAS unsigned char* T = lds + SD_T; LAS unsigned char* sB = T + 512; LAS unsigned char* sC = T + 768; LAS unsigned char* hS = lds + SD_H + k * (64 * PQ);
    LAS float* sDt = (LAS float*)(lds + SD_DT); LAS float* sCum = (LAS float*)(lds + SD_CUM); LAS float* red = (LAS float*)(lds + SD_RED);
    f32x4 H[4][4];
#pragma unroll
    for (int nt = 0; nt < 4; ++nt)
#pragma unroll
        for (int pt = 0; pt < 4; ++pt) H[nt][pt] = (f32x4){0.f, 0.f, 0.f, 0.f};
    for (int s = 0; s < seg; ++s) { const int u2 = u - seg + s; const float dc = __expf(rb.tseg[u2 * 4 + k]); const float* hp = rb.hseg + (size_t)u2 * 32768 + tid * 4;
#pragma unroll
        for (int nt = 0; nt < 4; ++nt)
#pragma unroll
            for (int pt = 0; pt < 4; ++pt) { LAUNDER_PTR(hp); H[nt][pt] = H[nt][pt] * dc + *(const f32x4*)hp; hp += 2048; } }
    const float Dk = d_skip[head];
    const size_t rowS = (size_t)b * SEQ + seg * SEGLEN;
    const int ch16 = tid & 63, rr = tid >> 6; const int gcol = ssd_gcol(grp, ch16);
    const int chn0 = grp * 256 + k * 64 + 4 * c;
    for (int ch = 0; ch < NCH; ++ch) {
        const size_t row0 = rowS + ch * RC;
        {   v4u raw[8];
            {   const bf16* gp = rb.xbcc + (row0 + rr) * 4096 + gcol;
#pragma unroll
                for (int i = 0; i < 8; ++i) { LAUNDER_PTR(gp); raw[i] = *(const v4u*)gp; gp += 8 * 4096; } }
            if (tid < 256) { sDt[tid] = rb.dtv[(row0 + (tid >> 2)) * 32 + grp * 4 + (tid & 3)]; sCum[tid] = rb.cum[(row0 + (tid >> 2)) * 32 + grp * 4 + (tid & 3)]; }
#pragma unroll
            for (int nt = 0; nt < 4; ++nt)
#pragma unroll
                for (int pt = 0; pt < 4; ++pt) { const f32x4 v = H[nt][pt];
                    *(LAS unsigned long long*)(hS + (4 * c + pt) * PQ + (16 * (4 * hf + nt) + 4 * g) * 2) = (unsigned long long)pk2(v[0], v[1]) | ((unsigned long long)pk2(v[2], v[3]) << 32); }
#pragma unroll
            for (int i = 0; i < 8; ++i) *(LAS v4u*)(T + (rr + 8 * i) * PR + ch16 * 16) = raw[i]; }
        sync_threads();
#pragma unroll 1
        for (int i2 = 0; i2 < 2; ++i2) {
            const int it = i2 ? 3 - hf : hf;
            unsigned long long zz[4];
#pragma unroll
            for (int r = 0; r < 4; ++r) zz[r] = *(const unsigned long long*)(rb.proj + (row0 + 16 * it + 4 * g + r) * LDP + PC_Z + chn0);
            f32x4 ya[4];
#pragma unroll
            for (int pt = 0; pt < 4; ++pt) ya[pt] = (f32x4){0.f, 0.f, 0.f, 0.f};
#pragma unroll
            for (int kn = 0; kn < 4; ++kn) { const bf16x8 Cf = frag_rows(sC, PR, 16 * it + c, 32 * kn + 8 * g);
#pragma unroll
                for (int pt = 0; pt < 4; ++pt) ya[pt] = mfma16(Cf, frag_rows(hS, PQ, 4 * c + pt, 32 * kn + 8 * g), ya[pt]);
                SCHED_FENCE(); }
            {   float ei[4];
#pragma unroll
                for (int r = 0; r < 4; ++r) ei[r] = __expf(sCum[(16 * it + 4 * g + r) * 4 + k]);
#pragma unroll
                for (int pt = 0; pt < 4; ++pt)
#pragma unroll
                    for (int r = 0; r < 4; ++r) ya[pt][r] *= ei[r]; }
            const float cum_i = sCum[(16 * it + c) * 4 + k];
            unsigned PT[4][2];
#pragma unroll
            for (int jt = 0; jt < 4; ++jt) {
                f32x4 acc = (f32x4){0.f, 0.f, 0.f, 0.f};
                if (jt <= it) {
#pragma unroll
                    for (int kn = 0; kn < 4; ++kn) acc = mfma16(frag_rows(sB, PR, 16 * jt + c, 32 * kn + 8 * g), frag_rows(sC, PR, 16 * it + c, 32 * kn + 8 * g), acc);
#pragma unroll
                    for (int r = 0; r < 4; ++r) { const int j = 16 * jt + 4 * g + r; const float df = cum_i - sCum[j * 4 + k]; const bool keep = (jt < it) || (4 * g + r <= c);
                        acc[r] = keep ? acc[r] * __expf(fminf(df, 0.f)) * sDt[j * 4 + k] : 0.f; }
                }
                PT[jt][0] = pk2(acc[0], acc[1]); PT[jt][1] = pk2(acc[2], acc[3]); SCHED_FENCE();
            }
#pragma unroll
            for (int ks = 0; ks < 2; ++ks) if (2 * ks <= it) {
                v4u pa = (v4u){PT[2 * ks][0], PT[2 * ks][1], PT[2 * ks + 1][0], PT[2 * ks + 1][1]};
                const bf16x8 A = __builtin_bit_cast(bf16x8, pa);
#pragma unroll
                for (int pt = 0; pt < 4; ++pt) ya[pt] = mfma16(A, frag_tr(T, PR, 32 * ks + 4 * g, 32 * ks + 16 + 4 * g, 64 * k + 16 * pt, lane), ya[pt]);
                SCHED_FENCE();
            }
#pragma unroll
            for (int r = 0; r < 4; ++r) { const int i = 16 * it + 4 * g + r; float s = 0.f; float yv[4];
#pragma unroll
                for (int pt = 0; pt < 4; ++pt) { const float xc = bf2f(*(const LAS bf16*)(T + i * PR + (64 * k + 16 * pt + c) * 2)); const float z = bf2f((bf16)(zz[r] >> (16 * pt)));
                    const bf16 yb = f2bf((ya[pt][r] + Dk * xc) * siluf_(z)); yv[pt] = bf2f(yb); s += yv[pt] * yv[pt]; }
                *(unsigned long long*)(rb.y + (row0 + i) * 2048 + chn0) = (unsigned long long)pk2(yv[0], yv[1]) | ((unsigned long long)pk2(yv[2], yv[3]) << 32);
                s += SHFL_XOR(s, 1); s += SHFL_XOR(s, 2); s += SHFL_XOR(s, 4); s += SHFL_XOR(s, 8);
                if (c == 0) red[i * 4 + k] = s; }
            SCHED_FENCE();
        }
        ssd_state_update(H, T, PR, T + 512, PR, sDt, sCum, w, lane);
        sync_threads();
        {   const f32x4 nw = *(const f32x4*)(ssm_norm + chn0);
            unsigned long long yy[8];
            const int itA = hf, itB = 3 - hf;
            bf16* yb0 = rb.y + (row0 + 16 * itA + 4 * g) * 2048 + chn0;
            const int jump = (16 * (itB - itA) - 3) * 2048;
            {   bf16* yp = yb0;
#pragma unroll
                for (int q = 0; q < 8; ++q) { LAUNDER_PTR(yp); yy[q] = *(const unsigned long long*)yp; yp += (q == 3) ? jump : 2048; } }
            bf16* yp = yb0;
#pragma unroll
            for (int q = 0; q < 8; ++q) { const int i = 16 * (q < 4 ? itA : itB) + 4 * g + (q & 3);
                const float rstd = rsqrtf(((red[i * 4] + red[i * 4 + 1]) + (red[i * 4 + 2] + red[i * 4 + 3])) * (1.f / 256.f) + EPS);
                const unsigned lo = (unsigned)yy[q], hi = (unsigned)(yy[q] >> 32);
                const float y0 = __uint_as_float(lo << 16) * rstd * nw[0], y1 = __uint_as_float(lo & 0xffff0000u) * rstd * nw[1], y2 = __uint_as_float(hi << 16) * rstd * nw[2], y3 = __uint_as_float(hi & 0xffff0000u) * rstd * nw[3];
                LAUNDER_PTR(yp); *(unsigned long long*)yp = (unsigned long long)pk2(y0, y1) | ((unsigned long long)pk2(y2, y3) << 32); yp += (q == 3) ? jump : 2048; } }
        sync_threads();
    }
    if (seg == NSEG - 1) { float* so = state_out_l + ((size_t)(b * 32 + head) * 64 + 4 * c) * 128 + 64 * hf + 4 * g;
#pragma unroll
        for (int pt = 0; pt < 4; ++pt)
#pragma unroll
            for (int nt = 0; nt < 4; ++nt) *(f32x4*)(so + pt * 128 + 16 * nt) = H[nt][pt]; }
}

__device__ __forceinline__ float row32_sum(float s) { s += SHFL_XOR(s, 1); s += SHFL_XOR(s, 2); s += SHFL_XOR(s, 4); s += SHFL_XOR(s, 8); s += SHFL_XOR(s, 16); return s; }

__device__ __forceinline__ void hgrn_sample_load(f32x4 (&st)[8], const float* state_in, int bh, int tid) {
    const float* sp = state_in + (size_t)bh * 16384 + tid * 4;
#pragma unroll
    for (int it = 0; it < 8; ++it) { LAUNDER_PTR(sp); st[it] = *(const f32x4*)sp; sp += 2048; }
}
__device__ __forceinline__ void hgrn_sample_step(const bf16* proj, const float* lbs_l, const float* hgn_l, const float* state_in, float* state_out, bf16* ohg, int bh, int tid, LAS unsigned char* lds,
                                                 f32x4 (&st)[8], int bh_next) {
    const int b = bh >> 3, h = bh & 7, lane = tid & 63, w = tid >> 6;
    LAS float* sq = (LAS float*)lds; LAS float* sg = sq + 128; LAS float* sk = sq + 256; LAS float* sv = sq + 384; LAS float* so = (LAS float*)(lds + 8192); LAS float* sred = (LAS float*)(lds + 16384);
    const size_t row = (size_t)MP + b;
    float ogv = 0.f, q_ = 0.f, f_ = 0.f, v_ = 0.f, lb_ = 0.f;
    if (tid < 128) { const bf16* pr = proj + row * LDP + h * 128; q_ = bf2f(pr[PC_Q + tid]); f_ = bf2f(pr[PC_F + tid]); lb_ = lbs_l[h * 128 + tid]; v_ = bf2f(pr[PC_I + hg_vpos(tid)]); ogv = bf2f(pr[PC_OG + tid]); }
    if (tid < 128) { const float fg = lb_ + (1.f - lb_) * sigmoidf_(f_);
        sq[tid] = siluf_(q_) * 0.08838834764831845f; sg[tid] = fg; sk[tid] = 1.f - fg; sv[tid] = v_; }
    sync_threads();
    const int dv4 = tid & 31, rg = tid >> 5;
    const f32x4 vv = *(const LAS f32x4*)(sv + 4 * dv4);
    f32x4 oacc = (f32x4){0.f, 0.f, 0.f, 0.f};
    float* op = state_out + (size_t)bh * 16384 + tid * 4;
    const float* np = state_in + (size_t)(bh_next >= 0 ? bh_next : bh) * 16384 + tid * 4;
#pragma unroll
    for (int it = 0; it < 8; ++it) { const int dk = it * 16 + rg; const f32x4 sn = st[it] * sg[dk] + vv * sk[dk]; LAUNDER_PTR(op); *(f32x4*)op = sn; op += 2048; oacc = oacc + sn * sq[dk];
        LAUNDER_PTR(np); if (bh_next >= 0) st[it] = *(const f32x4*)np; np += 2048; }
    *(LAS f32x4*)(so + rg * 128 + 4 * dv4) = oacc;
    sync_threads();
    if (tid < 128) { float o = 0.f;
#pragma unroll
        for (int r = 0; r < 16; ++r) o += so[r * 128 + tid];
        float ss = o * o; ss = row32_sum(ss);
        if ((lane & 31) == 0) sred[tid >> 5] = ss;
        sq[tid] = o; }
    sync_threads();
    if (tid < 128) { const float rstd = rsqrtf(((sred[0] + sred[1]) + (sred[2] + sred[3])) * (1.f / 128.f) + EPS);
        ohg[row * 1024 + h * 128 + tid] = f2bf(sq[tid] * rstd * hgn_l[tid] * siluf_(ogv)); }
    sync_threads();
    (void)w;
}

__device__ __forceinline__ void ssd_sample_load(f32x4 (&st)[16], const float* state_in, int bg, int tid) {
    const float* sp = state_in + ((size_t)((bg >> 3) * 32 + (bg & 7) * 4)) * 8192 + tid * 4;
#pragma unroll
    for (int it = 0; it < 16; ++it) { LAUNDER_PTR(sp); st[it] = *(const f32x4*)sp; sp += 2048; }
}
__device__ __forceinline__ void ssd_sample_step(const bf16* proj, const float* conv_w, const float* conv_b, const float* dt_bias, const float* a_log, const float* d_skip, const float* ssm_norm,
                                                const float* state_in, const float* conv_in, float* state_out, float* conv_out, bf16* ybuf, int bg, int tid, LAS unsigned char* lds,
                                                f32x4 (&st)[16], int bg_next) {
    const int b = bg >> 3, grp = bg & 7, lane = tid & 63, w = tid >> 6;
    LAS float* sx = (LAS float*)(lds + 2048); LAS float* sB = (LAS float*)(lds + 3072); LAS float* sC = (LAS float*)(lds + 3584); LAS float* sdt = (LAS float*)(lds + 4096); LAS float* sdec = (LAS float*)(lds + 4112);
    LAS float* sy = (LAS float*)(lds + 4608); LAS float* sred = (LAS float*)(lds + 16384);
    const size_t row = (size_t)MP + b;
    {
        const int chx = tid < 256 ? (grp * 256 + tid) : (tid < 384 ? (2048 + grp * 128 + (tid - 256)) : (3072 + grp * 128 + (tid - 384)));
        const float* ci = conv_in + (size_t)b * 3 * 4096; const float r0 = ci[chx], r1 = ci[4096 + chx], r2 = ci[8192 + chx];
        const float cur = bf2f(proj[row * LDP + PC_XBC + chx]);
        const float cw0 = conv_w[chx], cw1 = conv_w[4096 + chx], cw2 = conv_w[8192 + chx], cw3 = conv_w[12288 + chx], cbb = conv_b[chx];
        float dtr = 0.f, dtbv = 0.f, alg = 0.f; if (tid < 4) { const int head = grp * 4 + tid; dtr = bf2f(proj[row * LDP + PC_DT + head]); dtbv = dt_bias[head]; alg = a_log[head]; }
        const float a = cbb + cw0 * r0 + cw1 * r1 + cw2 * r2 + cw3 * cur;
        const float v = siluf_(a);
        if (tid < 256) sx[tid] = v; else if (tid < 384) sB[tid - 256] = v; else sC[tid - 384] = v;
        float* co = conv_out + (size_t)b * 3 * 4096; co[chx] = r1; co[4096 + chx] = r2; co[8192 + chx] = cur;
        if (tid < 4) { const float dv = softplusf_(dtr + dtbv); sdt[tid] = dv; sdec[tid] = __expf(dv * (-__expf(alg))); } }
    sync_threads();
    const int n4 = tid & 31, pr_ = tid >> 5;
    const f32x4 Bv = *(const LAS f32x4*)(sB + 4 * n4), Cv = *(const LAS f32x4*)(sC + 4 * n4);
    float* op = state_out + ((size_t)(b * 32 + grp * 4)) * 8192 + tid * 4;
    const int bgn = bg_next >= 0 ? bg_next : bg; const float* np = state_in + ((size_t)((bgn >> 3) * 32 + (bgn & 7) * 4)) * 8192 + tid * 4;
#pragma unroll
    for (int it = 0; it < 16; ++it) { const int k = it >> 2, p = (it & 3) * 16 + pr_; const float xdt = sx[k * 64 + p] * sdt[k];
        const f32x4 hn = st[it] * sdec[k] + Bv * xdt; LAUNDER_PTR(op); *(f32x4*)op = hn; op += 2048;
        LAUNDER_PTR(np); if (bg_next >= 0) st[it] = *(const f32x4*)np; np += 2048;
        const f32x4 t = hn * Cv; float y = (t[0] + t[1]) + (t[2] + t[3]); y = row32_sum(y);
        if ((lane & 31) == 0) sy[k * 64 + p] = y; }
    sync_threads();
    float yv = 0.f;
    if (tid < 256) { const int k = tid >> 6; const float z = bf2f(proj[row * LDP + PC_Z + grp * 256 + tid]);
        yv = (sy[tid] + d_skip[grp * 4 + k] * sx[tid]) * siluf_(z);
        float ss = yv * yv; ss = row32_sum(ss); if ((lane & 31) == 0) sred[tid >> 5] = ss; }
    sync_threads();
    if (tid < 256) { float tot = 0.f;
#pragma unroll
        for (int r = 0; r < 8; ++r) tot += sred[r];
        ybuf[row * 2048 + grp * 256 + tid] = f2bf(yv * rsqrtf(tot * (1.f / 256.f) + EPS) * ssm_norm[grp * 256 + tid]); }
    sync_threads();
    (void)w;
}

static_assert(SD_END <= LDS_BYTES - 256, "LDS map");
static_assert(8 * 16384 <= LDS_BYTES - 256, "skinny LDS");
constexpr int SK_PART = 128 * 32 * 4;
template <int RT, class Epi>
__device__ __forceinline__ void skinny_gemm(const bf16* A, size_t lda, const bf16* Bt, int K, int N, const Epi& epi, int wg, int wg_first, int wg_count, int tid, LAS unsigned char* lds) {
    const int lane = tid & 63, w = tid >> 6, c = lane & 15, g = lane >> 4;
    constexpr int NRG = 8 / RT;
    const int nunit = (N / 32) * NRG, ksteps = K / 256;
    int me = wg - wg_first; if (me < 0 || me >= wg_count) return;
    for (int s = me; s < nunit; s += wg_count) {
        const int n0 = 32 * (s / NRG), r0 = (s % NRG) * (16 * RT);
        f32x4 acc[RT][2];
#pragma unroll
        for (int rt = 0; rt < RT; ++rt) { acc[rt][0] = (f32x4){0.f, 0.f, 0.f, 0.f}; acc[rt][1] = (f32x4){0.f, 0.f, 0.f, 0.f}; }
        const bf16* ap = A + (size_t)(r0 + c) * lda + (size_t)w * (K / 8) + 8 * g;
        const bf16* bp = Bt + (size_t)(n0 + c) * K + (size_t)w * (K / 8) + 8 * g;
#pragma unroll 4
        for (int ks = 0; ks < ksteps; ++ks) {
            bf16x8 af[RT], bfr[2];
#pragma unroll
            for (int rt = 0; rt < RT; ++rt) af[rt] = *(const bf16x8*)(ap + (size_t)(16 * rt) * lda + 32 * ks);
            bfr[0] = *(const bf16x8*)(bp + 32 * ks); bfr[1] = *(const bf16x8*)(bp + (size_t)16 * K + 32 * ks);
#pragma unroll
            for (int rt = 0; rt < RT; ++rt) { acc[rt][0] = mfma16(af[rt], bfr[0], acc[rt][0]); acc[rt][1] = mfma16(af[rt], bfr[1], acc[rt][1]); }
        }
        LAS float* part = (LAS float*)(lds + w * SK_PART);
#pragma unroll
        for (int rt = 0; rt < RT; ++rt)
#pragma unroll
            for (int nt = 0; nt < 2; ++nt)
#pragma unroll
                for (int r = 0; r < 4; ++r) part[(16 * rt + 4 * g + r) * 32 + 16 * nt + c] = acc[rt][nt][r];
        sync_threads();
        if (RT == 8 || tid < 64 * RT) {
            const int row = tid >> 2, c8 = (tid & 3) * 8;
            f32x4 v0 = (f32x4){0.f, 0.f, 0.f, 0.f}, v1 = (f32x4){0.f, 0.f, 0.f, 0.f};
#pragma unroll
            for (int ww = 0; ww < 8; ++ww) { const LAS float* pp = (const LAS float*)(lds + ww * SK_PART) + row * 32 + c8; v0 = v0 + *(const LAS f32x4*)pp; v1 = v1 + *(const LAS f32x4*)(pp + 4); }
            epi(r0 + row, n0 + c8, v0, v1);
        }
        sync_threads();
    }
}
struct SkStoreBf16 { bf16* O; int ld; int act;
    __device__ __forceinline__ void operator()(int row, int col, f32x4 v0, f32x4 v1) const {
        if (act) {
#pragma unroll
            for (int j = 0; j < 4; ++j) { const float a = fmaxf(v0[j], 0.f), b = fmaxf(v1[j], 0.f); v0[j] = a * a; v1[j] = b * b; } }
        v4u o; o.x = pk2(v0[0], v0[1]); o.y = pk2(v0[2], v0[3]); o.z = pk2(v1[0], v1[1]); o.w = pk2(v1[2], v1[3]);
        *(v4u*)(O + (size_t)row * ld + col) = o; } };
__device__ __forceinline__ void sk_unpack8(const v4u w, f32x4& lo, f32x4& hi) {
    lo = (f32x4){__uint_as_float(w.x << 16), __uint_as_float(w.x & 0xffff0000u), __uint_as_float(w.y << 16), __uint_as_float(w.y & 0xffff0000u)};
    hi = (f32x4){__uint_as_float(w.z << 16), __uint_as_float(w.z & 0xffff0000u), __uint_as_float(w.w << 16), __uint_as_float(w.w & 0xffff0000u)}; }
struct SkGateA { bf16* T; const bf16* G; int ldg; const float* bm;
    __device__ __forceinline__ void operator()(int row, int col, f32x4 v0, f32x4 v1) const {
        f32x4 g0, g1; sk_unpack8(*(const v4u*)(G + (size_t)row * ldg + col), g0, g1);
        const f32x4 b0 = *(const f32x4*)(bm + col), b1 = *(const f32x4*)(bm + col + 4);
#pragma unroll
        for (int j = 0; j < 4; ++j) { v0[j] *= sigmoidf_(g0[j] + b0[j]); v1[j] *= sigmoidf_(g1[j] + b1[j]); }
        v4u o; o.x = pk2(v0[0], v0[1]); o.y = pk2(v0[2], v0[3]); o.z = pk2(v1[0], v1[1]); o.w = pk2(v1[2], v1[3]);
        *(v4u*)(T + (size_t)row * 1024 + col) = o; } };
struct SkGateB { const bf16* T; bf16* U; const bf16* G; int ldg; const float* bm;
    __device__ __forceinline__ void operator()(int row, int col, f32x4 v0, f32x4 v1) const {
        f32x4 g0, g1; sk_unpack8(*(const v4u*)(G + (size_t)row * ldg + col), g0, g1);
        const f32x4 b0 = *(const f32x4*)(bm + col), b1 = *(const f32x4*)(bm + col + 4);
        f32x4 t0, t1; sk_unpack8(*(const v4u*)(T + (size_t)row * 1024 + col), t0, t1);
#pragma unroll
        for (int j = 0; j < 4; ++j) { v0[j] = t0[j] + v0[j] * sigmoidf_(g0[j] + b0[j]); v1[j] = t1[j] + v1[j] * sigmoidf_(g1[j] + b1[j]); }
        v4u o; o.x = pk2(v0[0], v0[1]); o.y = pk2(v0[2], v0[3]); o.z = pk2(v1[0], v1[1]); o.w = pk2(v1[2], v1[3]);
        *(v4u*)(U + (size_t)row * 1024 + col) = o; } };
struct SkRes { bf16* X; const float* gate; int ldgate;
    __device__ __forceinline__ void operator()(int row, int col, f32x4 v0, f32x4 v1) const {
        const float* gp = gate + (size_t)row * ldgate + col; bf16* xp = X + (size_t)row * 1024 + col;
        f32x4 x0, x1; sk_unpack8(*(const v4u*)xp, x0, x1);
        const f32x4 o0 = x0 + *(const f32x4*)gp * v0, o1 = x1 + *(const f32x4*)(gp + 4) * v1;
        v4u o; o.x = pk2(o0[0], o0[1]); o.y = pk2(o0[2], o0[3]); o.z = pk2(o1[0], o1[1]); o.w = pk2(o1[2], o1[3]); *(v4u*)xp = o; } };

template <int TB>
__device__ __forceinline__ void hgrn_seq(const bf16* proj, const float* lbs_l, const float* hgn_l, const float* state_in, float* state_out, bf16* ohg, int row_base, int T, int bh, int tid,
                                         LAS unsigned char* smem) {
    const int b = bh >> 3, h = bh & 7, lane = tid & 63, wv = tid >> 6;
    typedef float (LAS * arr_t)[128];
    arr_t sQ = (arr_t)(smem), sG = (arr_t)(smem + TB * 512), sK = (arr_t)(smem + 2 * TB * 512);
    LAS float* sRed = (LAS float*)(smem + 3 * TB * 512);
    float S[128];
    if (state_in) {
        const float* sp = state_in + (size_t)bh * 16384 + tid;
#pragma unroll
        for (int c = 0; c < 16; ++c) { asm volatile("" : "+v"(sp));
#pragma unroll
            for (int j = 0; j < 8; ++j) S[c * 8 + j] = sp[j * 128];
            sp += 1024; }
    } else {
#pragma unroll
        for (int d = 0; d < 128; ++d) S[d] = 0.f;
    }
    const float lb = lbs_l[h * 128 + tid], hn = hgn_l[tid];
    for (int t0 = 0; t0 < T; t0 += TB) {
        float v[TB], og[TB], o[TB];
#pragma unroll
        for (int tt = 0; tt < TB; ++tt) { v[tt] = 0.f; og[tt] = 0.f;
            if (t0 + tt < T) { const bf16* pr = proj + (size_t)(row_base + b * T + t0 + tt) * LDP + h * 128 + tid;
                const float q = bf2f(pr[PC_Q]), f = bf2f(pr[PC_F]); v[tt] = bf2f(pr[PC_I + hg_vpos(tid) - tid]); og[tt] = bf2f(pr[PC_OG]);
                const float fg = lb + (1.f - lb) * sigmoidf_(f);
                sQ[tt][tid] = siluf_(q) * 0.08838834764831845f; sG[tt][tid] = fg; sK[tt][tid] = 1.f - fg; } }
        __syncthreads();
#pragma unroll
        for (int tt = 0; tt < TB; ++tt) { float acc = 0.f;
            if (t0 + tt < T) { const float vv = v[tt];
#pragma unroll
                for (int d4 = 0; d4 < 32; ++d4) { const f32x4 g = *(const LAS f32x4*)&sG[tt][d4 * 4], k = *(const LAS f32x4*)&sK[tt][d4 * 4], q = *(const LAS f32x4*)&sQ[tt][d4 * 4];
                    S[d4 * 4 + 0] = g.x * S[d4 * 4 + 0] + k.x * vv; acc += q.x * S[d4 * 4 + 0];
                    S[d4 * 4 + 1] = g.y * S[d4 * 4 + 1] + k.y * vv; acc += q.y * S[d4 * 4 + 1];
                    S[d4 * 4 + 2] = g.z * S[d4 * 4 + 2] + k.z * vv; acc += q.z * S[d4 * 4 + 2];
                    S[d4 * 4 + 3] = g.w * S[d4 * 4 + 3] + k.w * vv; acc += q.w * S[d4 * 4 + 3]; } }
            o[tt] = acc;
            const float ss = wave_sum(acc * acc); if (lane == 0) sRed[tt * 2 + wv] = ss; }
        __syncthreads();
#pragma unroll
        for (int tt = 0; tt < TB; ++tt) if (t0 + tt < T) { const float rstd = rsqrtf((sRed[tt * 2] + sRed[tt * 2 + 1]) * (1.f / 128.f) + EPS);
            ohg[(size_t)(row_base + b * T + t0 + tt) * 1024 + h * 128 + tid] = f2bf(o[tt] * rstd * hn * siluf_(og[tt])); }
        __syncthreads();
    }
    { float* sp = state_out + (size_t)bh * 16384 + tid;
#pragma unroll
      for (int c = 0; c < 16; ++c) { asm volatile("" : "+v"(sp));
#pragma unroll
          for (int j = 0; j < 8; ++j) sp[j * 128] = S[c * 8 + j];
          sp += 1024; } }
}

template <int TB>
__device__ __forceinline__ void ssd_seq(const bf16* proj, const float* conv_w, const float* conv_b, const float* dt_bias, const float* a_log, const float* d_skip, const float* ssm_norm,
                                        const float* state_in, const float* conv_in, float* state_out, float* conv_out, bf16* ybuf, int row_base, int T, int bg, int tid, LAS unsigned char* smem) {
    const int b = bg >> 3, g = bg & 7, lane = tid & 63, wv = tid >> 6, head = g * 4 + wv;
    const int ch_x = g * 256 + tid, ch_bc = tid < 128 ? (2048 + g * 128 + tid) : (3072 + g * 128 + (tid - 128));
    typedef float (LAS * arr_t)[128];
    arr_t sB = (arr_t)(smem), sC = (arr_t)(smem + TB * 512);
    LAS float* sRed = (LAS float*)(smem + 2 * TB * 512);
    const float wx0 = conv_w[0 * 4096 + ch_x], wx1 = conv_w[1 * 4096 + ch_x], wx2 = conv_w[2 * 4096 + ch_x], wx3 = conv_w[3 * 4096 + ch_x], bx = conv_b[ch_x];
    const float wb0 = conv_w[0 * 4096 + ch_bc], wb1 = conv_w[1 * 4096 + ch_bc], wb2 = conv_w[2 * 4096 + ch_bc], wb3 = conv_w[3 * 4096 + ch_bc], bb = conv_b[ch_bc];
    float rx0 = 0.f, rx1 = 0.f, rx2 = 0.f, rb0 = 0.f, rb1 = 0.f, rb2 = 0.f;
    if (conv_in) { const float* ci = conv_in + (size_t)b * 3 * 4096; rx0 = ci[ch_x]; rx1 = ci[4096 + ch_x]; rx2 = ci[8192 + ch_x]; rb0 = ci[ch_bc]; rb1 = ci[4096 + ch_bc]; rb2 = ci[8192 + ch_bc]; }
    float hs[128];
    const size_t sbase = (((size_t)b * 32 + head) * 64 + lane) * 128;
    if (state_in) {
#pragma unroll
        for (int n4 = 0; n4 < 32; ++n4) { const f32x4 t = *(const f32x4*)(state_in + sbase + n4 * 4); hs[n4 * 4] = t.x; hs[n4 * 4 + 1] = t.y; hs[n4 * 4 + 2] = t.z; hs[n4 * 4 + 3] = t.w; }
    } else {
#pragma unroll
        for (int n = 0; n < 128; ++n) hs[n] = 0.f;
    }
    const float A = -expf(a_log[head]), dtb = dt_bias[head], Dk = d_skip[head], nw = ssm_norm[ch_x];
    for (int t0 = 0; t0 < T; t0 += TB) {
        float xc[TB], dtv[TB], dec[TB], zz[TB], yv[TB];
#pragma unroll
        for (int tt = 0; tt < TB; ++tt) { xc[tt] = 0.f; dtv[tt] = 0.f; dec[tt] = 1.f; zz[tt] = 0.f;
            if (t0 + tt < T) { const bf16* pr = proj + (size_t)(row_base + b * T + t0 + tt) * LDP;
                const float cx = bf2f(pr[PC_XBC + ch_x]), cb = bf2f(pr[PC_XBC + ch_bc]);
                const float ax = bx + wx0 * rx0 + wx1 * rx1 + wx2 * rx2 + wx3 * cx; rx0 = rx1; rx1 = rx2; rx2 = cx; xc[tt] = siluf_(ax);
                const float ab = bb + wb0 * rb0 + wb1 * rb1 + wb2 * rb2 + wb3 * cb; rb0 = rb1; rb1 = rb2; rb2 = cb;
                const float sbv = siluf_(ab); if (tid < 128) sB[tt][tid] = sbv; else sC[tt][tid - 128] = sbv;
                const float dv = softplusf_(bf2f(pr[PC_DT + head]) + dtb); dtv[tt] = dv; dec[tt] = __expf(dv * A); zz[tt] = bf2f(pr[PC_Z + ch_x]); } }
        __syncthreads();
#pragma unroll
        for (int tt = 0; tt < TB; ++tt) { float y = 0.f;
            if (t0 + tt < T) { const float xdt = xc[tt] * dtv[tt], dc = dec[tt];
#pragma unroll
                for (int n4 = 0; n4 < 32; ++n4) { const f32x4 bv = *(const LAS f32x4*)&sB[tt][n4 * 4], cv = *(const LAS f32x4*)&sC[tt][n4 * 4];
                    hs[n4 * 4 + 0] = dc * hs[n4 * 4 + 0] + xdt * bv.x; y += hs[n4 * 4 + 0] * cv.x;
                    hs[n4 * 4 + 1] = dc * hs[n4 * 4 + 1] + xdt * bv.y; y += hs[n4 * 4 + 1] * cv.y;
                    hs[n4 * 4 + 2] = dc * hs[n4 * 4 + 2] + xdt * bv.z; y += hs[n4 * 4 + 2] * cv.z;
                    hs[n4 * 4 + 3] = dc * hs[n4 * 4 + 3] + xdt * bv.w; y += hs[n4 * 4 + 3] * cv.w; }
                y = (y + Dk * xc[tt]) * siluf_(zz[tt]); }
            yv[tt] = y;
            const float ss = wave_sum(y * y); if (lane == 0) sRed[tt * 4 + wv] = ss; }
        __syncthreads();
#pragma unroll
        for (int tt = 0; tt < TB; ++tt) if (t0 + tt < T) { const float rstd = rsqrtf(((sRed[tt * 4] + sRed[tt * 4 + 1]) + (sRed[tt * 4 + 2] + sRed[tt * 4 + 3])) * (1.f / 256.f) + EPS);
            ybuf[(size_t)(row_base + b * T + t0 + tt) * 2048 + ch_x] = f2bf(yv[tt] * rstd * nw); }
        __syncthreads();
    }
#pragma unroll
    for (int n4 = 0; n4 < 32; ++n4) *(f32x4*)(state_out + sbase + n4 * 4) = (f32x4){hs[n4 * 4], hs[n4 * 4 + 1], hs[n4 * 4 + 2], hs[n4 * 4 + 3]};
    float* co = conv_out + (size_t)b * 3 * 4096;
    co[ch_x] = rx0; co[4096 + ch_x] = rx1; co[8192 + ch_x] = rx2; co[ch_bc] = rb0; co[4096 + ch_bc] = rb1; co[8192 + ch_bc] = rb2;
}

#ifndef REP_G
#define REP_G 1
#endif
#ifndef REP_R2
#define REP_R2 1
#endif
#ifndef REP_R1
#define REP_R1 1
#endif
#ifndef REP_N
#define REP_N 1
#endif
#ifndef REP_P
#define REP_P 1
#endif
#ifndef REP_H2
#define REP_H2 1
#endif
#ifndef REP_S2
#define REP_S2 1
#endif
#ifndef REP_S1
#define REP_S1 1
#endif
#ifndef REP_SS
#define REP_SS 1
#endif
#ifndef REP_BAR
#define REP_BAR 0
#endif
__device__ __forceinline__ void phase_recur1(const P& p, int l, LAS unsigned char* lds, int tid_in, int skip_hgrn1) {
    unsigned char* ws = p.ws; asm volatile("" : "+s"(ws)); int tid_ = tid_in; asm volatile("" : "+v"(tid_)); const int tid = tid_, G = gridDim.x, wg = blockIdx.x;
    RecurBufs rb{(bf16*)(ws + WS_PROJ), (bf16*)(ws + WS_XBCC), (float*)(ws + WS_DTV), (float*)(ws + WS_CUM), (float*)(ws + WS_CV), (float*)(ws + WS_SSEG), (float*)(ws + WS_DSEG),
                 (float*)(ws + WS_HSEG), (float*)(ws + WS_TSEG), (bf16*)(ws + WS_OHG), (bf16*)(ws + WS_Y)};
    const float* lbs_l = (const float*)(ws + WS_LBS) + l * 1024; float* out = p.out;
    const float* hgn = p.in[I_HGN] + l * HG_DV;
    const float* cw = p.in[I_CONVW] + (size_t)l * 4 * SSM_CH; const float* cb = p.in[I_CONVB] + l * SSM_CH; const float* dtb = p.in[I_DTB] + l * SSM_HEADS;
    const float* alog = p.in[I_ALOG] + l * SSM_HEADS; const float* dsk = p.in[I_DSKIP] + l * SSM_HEADS; const float* ssmn = p.in[I_SSMN] + l * SSM_INNER;
#define TID_L() int tl_ = tid; asm volatile("" : "+v"(tl_)); const int t = tl_
#define R1_HG() do { if (!skip_hgrn1) for (int u = wg; u < 256; u += G) { TID_L(); hgrn_pass1(rb, lbs_l, u, t, lds); } } while (0)
#define R1_SD() do { for (int rep = 0; rep < REP_S1; ++rep) for (int u = wg; u < 256; u += G) { TID_L(); ssd_pass1(rb, cw, cb, dtb, alog, out + O_CVP + (size_t)l * NB * 3 * SSM_CH, u, t, lds); } } while (0)
#define R1_SAMPLE() do { for (int rep = 0; rep < REP_SS; ++rep) { \
        {   const float* shg = p.in[I_SHG] + (size_t)l * NSB * HG_H * HG_DK * HG_DV; f32x4 sa[8];        \
            if (wg < NSB * HG_H) { TID_L(); hgrn_sample_load(sa, shg, wg, t); } \
            for (int u = wg; u < NSB * HG_H; u += G) { TID_L(); const int un = u + G < NSB * HG_H ? u + G : -1; \
                hgrn_sample_step(rb.proj, lbs_l, hgn, shg, out + O_HGS + (size_t)l * NSB * HG_H * HG_DK * HG_DV, rb.ohg, u, t, lds, sa, un); } } \
        {   const float* sss = p.in[I_SSSM] + (size_t)l * NSB * SSM_HEADS * SSM_P * SSM_N; f32x4 sa[16]; \
            if (wg < NSB * SSM_G) { TID_L(); ssd_sample_load(sa, sss, wg, t); } \
            for (int u = wg; u < NSB * SSM_G; u += G) { TID_L(); const int un = u + G < NSB * SSM_G ? u + G : -1; \
                ssd_sample_step(rb.proj, cw, cb, dtb, alog, dsk, ssmn, sss, p.in[I_SCONV] + (size_t)l * NSB * 3 * SSM_CH, \
                                out + O_SSMS + (size_t)l * NSB * SSM_HEADS * SSM_P * SSM_N, out + O_CVS + (size_t)l * NSB * 3 * SSM_CH, rb.y, u, t, lds, sa, un); } } } } while (0)
    if (((wg >> 3) & 1) == 0) { R1_HG(); R1_SAMPLE(); R1_SD(); } else { R1_SD(); R1_HG(); R1_SAMPLE(); }
#undef R1_HG
#undef R1_SD
#undef R1_SAMPLE
}
__device__ __forceinline__ void phase_recur2(const P& p, int l, LAS unsigned char* lds, int tid_in) {
    unsigned char* ws = p.ws; asm volatile("" : "+s"(ws)); int tid_ = tid_in; asm volatile("" : "+v"(tid_)); const int tid = tid_, G = gridDim.x, wg = blockIdx.x;
    RecurBufs rb{(bf16*)(ws + WS_PROJ), (bf16*)(ws + WS_XBCC), (float*)(ws + WS_DTV), (float*)(ws + WS_CUM), (float*)(ws + WS_CV), (float*)(ws + WS_SSEG), (float*)(ws + WS_DSEG),
                 (float*)(ws + WS_HSEG), (float*)(ws + WS_TSEG), (bf16*)(ws + WS_OHG), (bf16*)(ws + WS_Y)};
    float* out = p.out;
    for (int rep = 0; rep < REP_H2; ++rep) for (int u = wg; u < 256; u += G) { TID_L(); hgrn_pass2(rb, p.in[I_HGN] + l * HG_DV, out + O_HGP + (size_t)l * NB * HG_H * HG_DK * HG_DV, u, t, lds); }
    for (int rep = 0; rep < REP_S2; ++rep) for (int u = wg; u < 256; u += G) { TID_L(); ssd_pass2(rb, p.in[I_DSKIP] + l * SSM_HEADS, p.in[I_SSMN] + l * SSM_INNER, out + O_SSMP + (size_t)l * NB * SSM_HEADS * SSM_P * SSM_N, u ^ 3, t, lds); }
}


constexpr int CW_BAR = 4096;
constexpr int MISC_OFF = LDS_BYTES - 256;

__global__ __launch_bounds__(NTHREADS, 2) void k_mega(P p) {
    extern __shared__ __attribute__((aligned(16))) unsigned char shm[];
    LAS unsigned char* lds = (LAS unsigned char*)shm;
    const int wave_u = __builtin_amdgcn_readfirstlane((int)threadIdx.x >> 6);
#define TID() ({ int t__; asm volatile("v_mbcnt_lo_u32_b32 %0, -1, 0\n\tv_mbcnt_hi_u32_b32 %0, -1, %0" : "=v"(t__)); (wave_u << 6) | t__; })
    const int G = gridDim.x, NGW = G * NWAVES;
    unsigned char* ws = p.ws;
#define LANE_GW() int t_ = TID(); asm volatile("" : "+v"(t_)); const int ln = t_ & 63, wv = __builtin_amdgcn_readfirstlane(t_ >> 6), gwv = blockIdx.x * NWAVES + wv; (void)wv
    volatile LAS unsigned* MISC = (volatile LAS unsigned*)(lds + MISC_OFF);
    if (TID() < 16) MISC[TID()] = 0u;
    __syncthreads();
    XcdBarrier bar = xcd_barrier_post((unsigned*)(ws + WS_CTL) + CW_BAR, MISC + 8, TID());
#define WSL() ({ unsigned char* w_ = ws; asm volatile("" : "+s"(w_)); w_; })

    for (int rep = 0; rep < REP_P; ++rep) {   LANE_GW(); phase_prologue(p, lds, gwv, NGW, ln, wv); }
    xcd_barrier(bar, TID());
    {   unsigned char* w = WSL();
        pg8::Gemm g{(const bf16*)(w + WS_AC), (const bf16*)(w + WS_WADA), 256, MODLD, D}; pg8::StaticOrder S; S.init(256, MODLD, G, (int)blockIdx.x);
        pg8::EpiF32 E{(float*)(w + WS_MOD), MODLD, p.in[I_BADA]};
        pg8::gemm_phase<pg8::EpiF32, pg8::StaticOrder>(lds, g, S, E, nullptr, TID()); }
    xcd_barrier(bar, TID());
    for (int li = 0; li < DEPTH; ++li) {
        int l = li; asm volatile("" : "+s"(l));
        for (int rep = 0; rep < REP_N; ++rep) {   unsigned char* w = WSL(); const float* mod_l = (const float*)(w + WS_MOD) + (size_t)l * NADA * D;
            LANE_GW();
            if (l == 0) phase_norm<1>(p.in[I_XP], p.in[I_XS], (bf16*)(w + WS_X), (bf16*)(w + WS_H), p.in[I_NMIX] + l * D, mod_l + 0 * D, mod_l + 1 * D, gwv, NGW, ln);
            else phase_norm<0>(nullptr, nullptr, (bf16*)(w + WS_X), (bf16*)(w + WS_H), p.in[I_NMIX] + l * D, mod_l + 0 * D, mod_l + 1 * D, gwv, NGW, ln); }
        xcd_barrier(bar, TID());
        for (int rep = 0; rep < REP_G; ++rep) { if (rep) xcd_barrier(bar, TID());
        {   unsigned char* w = WSL(); const unsigned char* wl = w + WS_W + (size_t)l * W_LSTRIDE;
            pg8::Gemm g{(const bf16*)(w + WS_H), (const bf16*)(wl + WO_IN), MP, LDP, D}; pg8::StaticOrder S; S.init(MP, LDP, G, (int)blockIdx.x);
            pg8::EpiBf16<0> E{(bf16*)(w + WS_PROJ), LDP};
            pg8::gemm_phase<pg8::EpiBf16<0>, pg8::StaticOrder>(lds, g, S, E, nullptr, TID());
            const int skf = G > 64 ? 64 : 0, skn = G > 64 ? G - 64 : G; skinny_gemm<8>((const bf16*)(w + WS_H) + (size_t)MP * D, D, (const bf16*)(wl + WO_IN), D, LDP, SkStoreBf16{(bf16*)(w + WS_PROJ) + (size_t)MP * LDP, LDP, 0}, (int)blockIdx.x, skf, skn, TID(), lds); } }
        xcd_barrier(bar, TID());
        for (int rep = 0; rep < REP_BAR; ++rep) xcd_barrier(bar, TID());
        phase_recur1(p, l, lds, TID(), 0);
        for (int rep = 1; rep < REP_R1; ++rep) { xcd_barrier(bar, TID()); phase_recur1(p, l, lds, TID(), 1); }
        xcd_barrier(bar, TID());
        for (int rep = 0; rep < REP_R2; ++rep) { if (rep) xcd_barrier(bar, TID()); phase_recur2(p, l, lds, TID()); }
        xcd_barrier(bar, TID());
        for (int rep = 0; rep < REP_G; ++rep) { if (rep) xcd_barrier(bar, TID());
        {   unsigned char* w = WSL(); const unsigned char* wl = w + WS_W + (size_t)l * W_LSTRIDE;
            pg8::Gemm g{(const bf16*)(w + WS_OHG), (const bf16*)(wl + WO_BRA), MP, D, 1024}; pg8::StaticOrder S; S.init(MP, D, G, (int)blockIdx.x);
            pg8::EpiGateA E{(bf16*)(w + WS_T), (const bf16*)(w + WS_PROJ) + PC_GA, LDP, p.in[I_BMERGE] + l * 2048};
            pg8::gemm_phase<pg8::EpiGateA, pg8::StaticOrder>(lds, g, S, E, nullptr, TID());
            skinny_gemm<1>((const bf16*)(w + WS_OHG) + (size_t)MP * D, D, (const bf16*)(wl + WO_BRA), 1024, D, SkGateA{(bf16*)(w + WS_T) + (size_t)MP * D, (const bf16*)(w + WS_PROJ) + (size_t)MP * LDP + PC_GA, LDP, p.in[I_BMERGE] + l * 2048}, (int)blockIdx.x, 0, G, TID(), lds); } }
        asm volatile("s_waitcnt vmcnt(0)" ::: "memory"); __syncthreads();
        for (int rep = 0; rep < REP_G; ++rep) { if (rep) xcd_barrier(bar, TID());
        {   unsigned char* w = WSL(); const unsigned char* wl = w + WS_W + (size_t)l * W_LSTRIDE;
            pg8::Gemm g{(const bf16*)(w + WS_Y), (const bf16*)(wl + WO_BRB), MP, D, 2048}; pg8::StaticOrder S; S.init(MP, D, G, (int)blockIdx.x);
            pg8::EpiGateB E{(const bf16*)(w + WS_T), (bf16*)(w + WS_U), (const bf16*)(w + WS_PROJ) + PC_GB, LDP, p.in[I_BMERGE] + l * 2048 + 1024};
            pg8::gemm_phase<pg8::EpiGateB, pg8::StaticOrder>(lds, g, S, E, nullptr, TID());
            skinny_gemm<1>((const bf16*)(w + WS_Y) + (size_t)MP * 2048, 2048, (const bf16*)(wl + WO_BRB), 2048, D, SkGateB{(const bf16*)(w + WS_T) + (size_t)MP * D, (bf16*)(w + WS_U) + (size_t)MP * D, (const bf16*)(w + WS_PROJ) + (size_t)MP * LDP + PC_GB, LDP, p.in[I_BMERGE] + l * 2048 + 1024}, (int)blockIdx.x, 0, G, TID(), lds); } }
        xcd_barrier(bar, TID());
        {   unsigned char* w = WSL(); const unsigned char* wl = w + WS_W + (size_t)l * W_LSTRIDE; const float* mod_l = (const float*)(w + WS_MOD) + (size_t)l * NADA * D;
            pg8::Gemm g{(const bf16*)(w + WS_U), (const bf16*)(wl + WO_OUT), MP, D, 1024}; pg8::StaticOrder S; S.init(MP, D, G, (int)blockIdx.x);
            pg8::EpiRes E{(bf16*)(w + WS_X), mod_l + 2 * D, MODLD};
            pg8::gemm_phase<pg8::EpiRes, pg8::StaticOrder>(lds, g, S, E, nullptr, TID());
            skinny_gemm<1>((const bf16*)(w + WS_U) + (size_t)MP * D, D, (const bf16*)(wl + WO_OUT), 1024, D, SkRes{(bf16*)(w + WS_X) + (size_t)MP * D, mod_l + (size_t)NB * MODLD + 2 * D, MODLD}, (int)blockIdx.x, 0, G, TID(), lds); }
        xcd_barrier(bar, TID());
        for (int rep = 0; rep < REP_N; ++rep) {   unsigned char* w = WSL(); const float* mod_l = (const float*)(w + WS_MOD) + (size_t)l * NADA * D;
            LANE_GW(); phase_norm<0>(nullptr, nullptr, (bf16*)(w + WS_X), (bf16*)(w + WS_H), p.in[I_NMLP] + l * D, mod_l + 3 * D, mod_l + 4 * D, gwv, NGW, ln); }
        xcd_barrier(bar, TID());
        for (int rep = 0; rep < REP_G; ++rep) { if (rep) xcd_barrier(bar, TID());
        {   unsigned char* w = WSL(); const unsigned char* wl = w + WS_W + (size_t)l * W_LSTRIDE;
            pg8::Gemm g{(const bf16*)(w + WS_H), (const bf16*)(wl + WO_UP), MP, DFF, 1024}; pg8::StaticOrder S; S.init(MP, DFF, G, (int)blockIdx.x);
            pg8::EpiBf16<1> E{(bf16*)(w + WS_UP), DFF};
            pg8::gemm_phase<pg8::EpiBf16<1>, pg8::StaticOrder>(lds, g, S, E, nullptr, TID());
            skinny_gemm<4>((const bf16*)(w + WS_H) + (size_t)MP * D, D, (const bf16*)(wl + WO_UP), 1024, DFF, SkStoreBf16{(bf16*)(w + WS_UP) + (size_t)MP * DFF, DFF, 1}, (int)blockIdx.x, 0, G, TID(), lds); } }
        xcd_barrier(bar, TID());
        {   unsigned char* w = WSL(); const unsigned char* wl = w + WS_W + (size_t)l * W_LSTRIDE; const float* mod_l = (const float*)(w + WS_MOD) + (size_t)l * NADA * D;
            pg8::Gemm g{(const bf16*)(w + WS_UP), (const bf16*)(wl + WO_DOWN), MP, D, DFF}; pg8::StaticOrder S; S.init(MP, D, G, (int)blockIdx.x);
            pg8::EpiRes E{(bf16*)(w + WS_X), mod_l + 5 * D, MODLD};
            pg8::gemm_phase<pg8::EpiRes, pg8::StaticOrder>(lds, g, S, E, nullptr, TID());
            skinny_gemm<1>((const bf16*)(w + WS_UP) + (size_t)MP * DFF, DFF, (const bf16*)(wl + WO_DOWN), DFF, D, SkRes{(bf16*)(w + WS_X) + (size_t)MP * D, mod_l + (size_t)NB * MODLD + 5 * D, MODLD}, (int)blockIdx.x, 0, G, TID(), lds); }
        xcd_barrier(bar, TID());
    }
    {   unsigned char* w = WSL(); LANE_GW(); phase_final((const bf16*)(w + WS_X), p.out + O_YP, p.in[I_NFIN], gwv, NGW, ln); }
}

extern "C" void kernel_launch(void* const* d_in, const int* in_sizes, int n_in, void* d_out, int out_size, void* d_ws, size_t ws_size, hipStream_t stream) {
    static int grid = 0;
    if (grid == 0) {
        if (n_in != N_IN || (size_t)out_size != O_END || ws_size < WS_END) { fprintf(stderr, "kernel_launch: unexpected sizes n_in %d out %d ws %zu\n", n_in, out_size, ws_size); grid = -1; return; }
        int dev = 0, cus = 0, per_cu = 0;
        if (hipGetDevice(&dev) != hipSuccess || hipDeviceGetAttribute(&cus, hipDeviceAttributeMultiprocessorCount, dev) != hipSuccess) { grid = -1; return; }
        if (hipFuncSetAttribute((const void*)k_mega, hipFuncAttributeMaxDynamicSharedMemorySize, LDS_BYTES) != hipSuccess) { fprintf(stderr, "kernel_launch: hipFuncSetAttribute failed\n"); grid = -1; return; }
        if (hipOccupancyMaxActiveBlocksPerMultiprocessor(&per_cu, (const void*)k_mega, NTHREADS, LDS_BYTES) != hipSuccess || per_cu < 1)
            fprintf(stderr, "kernel_launch: note: occupancy query reports %d workgroups per CU\n", per_cu);
        (void)hipGetLastError();
        grid = cus;
    }
    if (grid < 0) return;
    if (hipMemsetAsync((char*)d_ws + WS_CTL, 0, CTL_ZERO_BYTES, stream) != hipSuccess) return;
    P p{};
    for (int i = 0; i < N_IN; ++i) p.in[i] = (const float*)d_in[i];
    p.out = (float*)d_out; p.ws = (unsigned char*)d_ws;
    hipLaunchKernelGGL(k_mega, dim3(grid), dim3(NTHREADS), LDS_BYTES, stream, p);
}
```

```cpp
#include <hip/hip_runtime.h>
#include <cstdio>
#include <cstdint>

constexpr int D = 1024, NB = 8, SEQ = 2048, DEPTH = 4, NSB = 128;
constexpr int MP = NB * SEQ;
constexpr int MS = NSB;
constexpr int MR = MP + MS;
constexpr int MT = 16640;
constexpr int HG_H = 8, HG_DK = 128, HG_DV = 128;
constexpr int SSM_INNER = 2048, SSM_P = 64, SSM_HEADS = 32, SSM_G = 8, SSM_HPG = 4, SSM_N = 128, SSM_CH = 4096;
constexpr int DFF = 4096, NADA = 6;
constexpr int IN_WIDTH = 12320;
constexpr int LDP = 12544;
constexpr int PC_Q = 0, PC_F = 1024, PC_I = 2048, PC_OG = 3072, PC_Z = 4096, PC_XBC = 6144, PC_GA = 10240, PC_GB = 11264, PC_DT = 12288;
constexpr int NCOND = NB + NSB;
constexpr int MODLD = DEPTH * NADA * D;
constexpr float EPS = 1e-6f;

enum { I_XP = 0, I_XS, I_SHG, I_SSSM, I_SCONV, I_CP, I_CS, I_WADA, I_BADA, I_NMIX, I_WIN, I_BMERGE, I_LB, I_HGN, I_CONVW, I_CONVB, I_DTB, I_ALOG, I_DSKIP,
       I_SSMN, I_WBRA, I_WBRB, I_WOUT, I_NMLP, I_WUP, I_WDOWN, I_NFIN, N_IN };

constexpr size_t O_YP = 0;
constexpr size_t O_YS = O_YP + (size_t)MP * D;
constexpr size_t O_HGP = O_YS + (size_t)MS * D;
constexpr size_t O_SSMP = O_HGP + (size_t)DEPTH * NB * HG_H * HG_DK * HG_DV;
constexpr size_t O_CVP = O_SSMP + (size_t)DEPTH * NB * SSM_HEADS * SSM_P * SSM_N;
constexpr size_t O_HGS = O_CVP + (size_t)DEPTH * NB * 3 * SSM_CH;
constexpr size_t O_SSMS = O_HGS + (size_t)DEPTH * NSB * HG_H * HG_DK * HG_DV;
constexpr size_t O_CVS = O_SSMS + (size_t)DEPTH * NSB * SSM_HEADS * SSM_P * SSM_N;
constexpr size_t O_END = O_CVS + (size_t)DEPTH * NSB * 3 * SSM_CH;

constexpr size_t MiB = 1u << 20;
constexpr size_t WS_CTL = 0, CTL_ZERO_BYTES = 1 * MiB;
constexpr size_t WS_LBS = 1 * MiB;
constexpr size_t WS_AC = 2 * MiB;
constexpr size_t WS_MOD = 3 * MiB;
constexpr size_t WS_WADA = 32 * MiB;
constexpr size_t WS_W = 80 * MiB, W_LSTRIDE = 49 * MiB;
constexpr size_t WO_IN = 0, WO_BRA = 24 * MiB + MiB / 2, WO_BRB = WO_BRA + 2 * MiB, WO_OUT = WO_BRB + 4 * MiB, WO_UP = WO_OUT + 2 * MiB, WO_DOWN = WO_UP + 8 * MiB;
constexpr size_t WS_X = 276 * MiB;
constexpr size_t WS_H = 341 * MiB;
constexpr size_t WS_PROJ = 374 * MiB;
constexpr size_t WS_OHG = 773 * MiB;
constexpr size_t WS_Y = 806 * MiB;
constexpr size_t WS_T = 871 * MiB;
constexpr size_t WS_U = 936 * MiB;
constexpr size_t WS_UP = 969 * MiB;
constexpr size_t WS_XBCC = 1100 * MiB;
constexpr size_t WS_DTV = 1230 * MiB, WS_CUM = 1232 * MiB;
constexpr size_t WS_CV = 1234 * MiB;
constexpr size_t WS_SSEG = 1238 * MiB;
constexpr size_t WS_DSEG = 1254 * MiB;
constexpr size_t WS_HSEG = 1255 * MiB;
constexpr size_t WS_TSEG = 1287 * MiB;
constexpr size_t WS_END = 1288 * MiB;
static_assert(WO_DOWN + 8 * MiB <= W_LSTRIDE && (size_t)LDP * D * 2 <= WO_BRA, "weight map");
static_assert(WS_W + 4 * W_LSTRIDE <= WS_X && WS_X + (size_t)MT * D * 4 <= WS_H && WS_H + (size_t)MT * D * 2 <= WS_PROJ && WS_PROJ + (size_t)MT * LDP * 2 <= WS_OHG, "ws map 1");
static_assert(WS_OHG + (size_t)MT * D * 2 <= WS_Y && WS_Y + (size_t)MT * 2048 * 2 <= WS_T && WS_T + (size_t)MT * D * 4 <= WS_U && WS_U + (size_t)MT * D * 2 <= WS_UP && WS_UP + (size_t)MT * DFF * 2 <= WS_XBCC && WS_XBCC + (size_t)MT * 4096 * 2 <= WS_DTV, "ws map 2");
static_assert(WS_MOD + (size_t)256 * MODLD * 4 <= WS_WADA && WS_WADA + (size_t)MODLD * D * 2 <= WS_W, "ws map 0");

typedef unsigned short bf16;
__device__ __forceinline__ float bf2f(bf16 v) { return __uint_as_float(((unsigned)v) << 16); }
__device__ __forceinline__ unsigned pk2(float lo, float hi) { unsigned r; asm("v_cvt_pk_bf16_f32 %0, %1, %2" : "=v"(r) : "v"(lo), "v"(hi)); return r; }
__device__ __forceinline__ bf16 f2bf(float f) { return (bf16)pk2(f, f); }
__device__ __forceinline__ float frcp_(float x) { return __builtin_amdgcn_rcpf(x); }
__device__ __forceinline__ float sigmoidf_(float x) { return frcp_(1.0f + __expf(-x)); }
__device__ __forceinline__ float siluf_(float x) { return x * frcp_(1.0f + __expf(-x)); }
__device__ __forceinline__ float softplusf_(float x) { return x > 20.f ? x : log1pf(__expf(x)); }
__host__ __device__ __forceinline__ int cidx_of_row(int row) { return row < MP ? (row >> 11) : ((row - MP + NB) < NCOND ? (row - MP + NB) : (NCOND - 1)); }
__host__ __device__ __forceinline__ int hg_vpos(int e) { return (e & 64) + 16 * (e & 3) + ((e & 63) >> 2); }

namespace pg8 {
#define PG8_LAS __attribute__((address_space(3)))
typedef unsigned short bf16_t;
typedef short bf16x8 __attribute__((ext_vector_type(8)));
typedef float f32x4 __attribute__((ext_vector_type(4)));
typedef unsigned u32x4 __attribute__((ext_vector_type(4)));
constexpr int BM = 256, BK = 64, HALF = 128, HTB = HALF * BK * 2  , STAGE_BYTES = 8 * HTB, NXCD = 8, WGM = 4;

__host__ __device__ __forceinline__ int lds_byte(int r, int c) { const int st = (r >> 4) * 2 + (c >> 5), rr = r & 15, cc = c & 31, ob = rr * 64 + cc * 2; return st * 1024 + (ob ^ (((ob >> 9) & 1) << 5)); }
__host__ __device__ __forceinline__ void stage_rc(int b, int& R, int& C) { const int st = b / 1024, sb = b % 1024, swz = sb ^ (((sb >> 9) & 1) << 5); R = (st >> 1) * 16 + swz / 64; C = (st & 1) * 32 + (swz % 64) / 2; }
__host__ __device__ __forceinline__ int perm32(int rho) { const int n = rho >> 4, i = rho & 15; return 8 * (i >> 2) + 4 * n + (i & 3); }

struct Unit { int pm, pn; };
struct Gemm { const bf16_t* A; const bf16_t* Bt; int M, N, K; };

struct StaticOrder {
    int nM, nN, nwg, G, c;
    __host__ __device__ void init(int M, int N, int G_, int c_) { nM = M / BM; nN = N / BM; nwg = nM * nN; G = G_; c = c_; }
    __host__ __device__ bool next(int i, Unit& u) const {
        const long L = (long)i * G + c; if (L >= nwg) return false;
        int wgid = (int)L; { const int q = nwg / NXCD, r = nwg % NXCD, xcd = wgid % NXCD, off = wgid / NXCD; wgid = (xcd < r ? xcd * (q + 1) : r * (q + 1) + (xcd - r) * q) + off; }
        const int nig = WGM * nN, gid = wgid / nig, fm = gid * WGM, gsz = (nM - fm) < WGM ? (nM - fm) : WGM;
        u.pm = fm + ((wgid % nig) % gsz); u.pn = (wgid % nig) / gsz; return true;
    }
    __device__ __forceinline__ void a_ready(const Unit&) const {}
    __device__ __forceinline__ void done(const Unit&) const {}
};
__device__ __forceinline__ unsigned cvt_pk_bf16(float lo, float hi) { unsigned r; asm volatile("v_cvt_pk_bf16_f32 %0, %1, %2" : "=v"(r) : "v"(lo), "v"(hi)); return r; }
__device__ __forceinline__ float ep_sigmoid(float x) { return __builtin_amdgcn_rcpf(1.0f + __expf(-x)); }
__device__ __forceinline__ void unpack8(const u32x4 w, f32x4& lo, f32x4& hi) {
    lo = (f32x4){__uint_as_float(w.x << 16), __uint_as_float(w.x & 0xffff0000u), __uint_as_float(w.y << 16), __uint_as_float(w.y & 0xffff0000u)};
    hi = (f32x4){__uint_as_float(w.z << 16), __uint_as_float(w.z & 0xffff0000u), __uint_as_float(w.w << 16), __uint_as_float(w.w & 0xffff0000u)};
}

struct EpiF32 {
    static constexpr bool PERM = false, AFTER_DRAIN = false;
    float* C; int ldc; const float* bias;
    __device__ __forceinline__ void operator()(const f32x4 (&acc)[2][2][4][2], const Unit& u, int wr, int wc, int fr, int fq) const {
        const int row0 = u.pm * BM + wr * 64 + fr, col0 = u.pn * BM + wc * 32 + 4 * fq;
        f32x4 bv[2][2];
#pragma unroll
        for (int bj = 0; bj < 2; ++bj)
#pragma unroll
            for (int n = 0; n < 2; ++n) bv[bj][n] = *(const f32x4*)(bias + col0 + bj * HALF + n * 16);
#pragma unroll
        for (int ai = 0; ai < 2; ++ai)
#pragma unroll
            for (int m = 0; m < 4; ++m) { float* rowp = C + (size_t)(row0 + ai * HALF + m * 16) * ldc + col0;
#pragma unroll
                for (int bj = 0; bj < 2; ++bj)
#pragma unroll
                    for (int n = 0; n < 2; ++n) *(f32x4*)(rowp + bj * HALF + n * 16) = acc[ai][bj][m][n] + bv[bj][n]; }
    }
};
template <int ACT  > struct EpiBf16 {
    static constexpr bool PERM = true, AFTER_DRAIN = false;
    bf16_t* O; int ldc;
    __device__ __forceinline__ void operator()(const f32x4 (&acc)[2][2][4][2], const Unit& u, int wr, int wc, int fr, int fq) const {
        const int lane = fr + 16 * fq, r2 = lane >> 2, q2 = lane & 3;
        const int src4 = (r2 + 16 * q2) << 2;
        const int row0 = u.pm * BM + wr * 64 + r2; const int col0 = u.pn * BM + wc * 32 + 8 * q2;
#pragma unroll
        for (int ai = 0; ai < 2; ++ai)
#pragma unroll
            for (int m = 0; m < 4; ++m) { bf16_t* rowp = O + (size_t)(row0 + ai * HALF + m * 16) * ldc + col0;
#pragma unroll
                for (int bj = 0; bj < 2; ++bj) { f32x4 v0 = acc[ai][bj][m][0], v1 = acc[ai][bj][m][1];
                    if (ACT == 1) {
#pragma unroll
                        for (int j = 0; j < 4; ++j) { const float a = fmaxf(v0[j], 0.f), b = fmaxf(v1[j], 0.f); v0[j] = a * a; v1[j] = b * b; } }
                    u32x4 w; w.x = cvt_pk_bf16(v0[0], v0[1]); w.y = cvt_pk_bf16(v0[2], v0[3]); w.z = cvt_pk_bf16(v1[0], v1[1]); w.w = cvt_pk_bf16(v1[2], v1[3]);
                    w.x = (unsigned)__builtin_amdgcn_ds_bpermute(src4, (int)w.x); w.y = (unsigned)__builtin_amdgcn_ds_bpermute(src4, (int)w.y);
                    w.z = (unsigned)__builtin_amdgcn_ds_bpermute(src4, (int)w.z); w.w = (unsigned)__builtin_amdgcn_ds_bpermute(src4, (int)w.w);
                    *(u32x4*)(rowp + bj * HALF) = w; } }
    }
};
struct EpiGateA {
    static constexpr bool PERM = true, AFTER_DRAIN = false;
    bf16_t* T; const bf16_t* G; int ldg; const float* bm;
    __device__ __forceinline__ void operator()(const f32x4 (&acc)[2][2][4][2], const Unit& u, int wr, int wc, int fr, int fq) const {
        const int row0 = u.pm * BM + wr * 64 + fr; const int col0 = u.pn * BM + wc * 32 + 8 * fq;
        f32x4 bv[2][2];
#pragma unroll
        for (int bj = 0; bj < 2; ++bj)
#pragma unroll
            for (int n = 0; n < 2; ++n) bv[bj][n] = *(const f32x4*)(bm + col0 + bj * HALF + 4 * n);
#pragma unroll
        for (int ai = 0; ai < 2; ++ai)
#pragma unroll
            for (int m = 0; m < 4; ++m) { const size_t row = (size_t)(row0 + ai * HALF + m * 16);
#pragma unroll
                for (int bj = 0; bj < 2; ++bj) {
                    const u32x4 gw = *(const u32x4*)(G + row * ldg + col0 + bj * HALF); f32x4 g0, g1; unpack8(gw, g0, g1);
                    f32x4 o0, o1;
#pragma unroll
                    for (int j = 0; j < 4; ++j) { o0[j] = ep_sigmoid(g0[j] + bv[bj][0][j]) * acc[ai][bj][m][0][j]; o1[j] = ep_sigmoid(g1[j] + bv[bj][1][j]) * acc[ai][bj][m][1][j]; }
                    u32x4 w; w.x = cvt_pk_bf16(o0[0], o0[1]); w.y = cvt_pk_bf16(o0[2], o0[3]); w.z = cvt_pk_bf16(o1[0], o1[1]); w.w = cvt_pk_bf16(o1[2], o1[3]);
                    *(u32x4*)(T + row * 1024 + col0 + bj * HALF) = w; } }
    }
};
struct EpiGateB {
    static constexpr bool PERM = true, AFTER_DRAIN = false;
    const bf16_t* T; bf16_t* U; const bf16_t* G; int ldg; const float* bm;
    __device__ __forceinline__ void operator()(const f32x4 (&acc)[2][2][4][2], const Unit& u, int wr, int wc, int fr, int fq) const {
        const int row0 = u.pm * BM + wr * 64 + fr; const int col0 = u.pn * BM + wc * 32 + 8 * fq;
        f32x4 bv[2][2];
#pragma unroll
        for (int bj = 0; bj < 2; ++bj)
#pragma unroll
            for (int n = 0; n < 2; ++n) bv[bj][n] = *(const f32x4*)(bm + col0 + bj * HALF + 4 * n);
#pragma unroll
        for (int ai = 0; ai < 2; ++ai)
#pragma unroll
            for (int m = 0; m < 4; ++m) { const size_t row = (size_t)(row0 + ai * HALF + m * 16);
#pragma unroll
                for (int bj = 0; bj < 2; ++bj) {
                    const u32x4 gw = *(const u32x4*)(G + row * ldg + col0 + bj * HALF); f32x4 g0, g1; unpack8(gw, g0, g1);
                    f32x4 t0, t1; unpack8(*(const u32x4*)(T + row * 1024 + col0 + bj * HALF), t0, t1);
                    f32x4 o0, o1;
#pragma unroll
                    for (int j = 0; j < 4; ++j) { o0[j] = t0[j] + ep_sigmoid(g0[j] + bv[bj][0][j]) * acc[ai][bj][m][0][j]; o1[j] = t1[j] + ep_sigmoid(g1[j] + bv[bj][1][j]) * acc[ai][bj][m][1][j]; }
                    u32x4 w; w.x = cvt_pk_bf16(o0[0], o0[1]); w.y = cvt_pk_bf16(o0[2], o0[3]); w.z = cvt_pk_bf16(o1[0], o1[1]); w.w = cvt_pk_bf16(o1[2], o1[3]);
                    *(u32x4*)(U + row * 1024 + col0 + bj * HALF) = w; } }
    }
};
struct EpiRes {
    static constexpr bool PERM = false, AFTER_DRAIN = false;
    bf16_t* X; const float* gate; int ldgate;
    __device__ __forceinline__ void operator()(const f32x4 (&acc)[2][2][4][2], const Unit& u, int wr, int wc, int fr, int fq) const {
        typedef unsigned u32x2 __attribute__((ext_vector_type(2)));
        const int row0 = u.pm * BM + wr * 64 + fr, col0 = u.pn * BM + wc * 32 + 4 * fq;
        const float* gp = gate + (size_t)((u.pm * BM) >> 11) * ldgate + col0;
        f32x4 gv[2][2];
#pragma unroll
        for (int bj = 0; bj < 2; ++bj)
#pragma unroll
            for (int n = 0; n < 2; ++n) gv[bj][n] = *(const f32x4*)(gp + bj * HALF + n * 16);
#pragma unroll
        for (int ai = 0; ai < 2; ++ai)
#pragma unroll
            for (int m = 0; m < 4; ++m) { bf16_t* xp = X + (size_t)(row0 + ai * HALF + m * 16) * 1024 + col0;
#pragma unroll
                for (int bj = 0; bj < 2; ++bj)
#pragma unroll
                    for (int n = 0; n < 2; ++n) { const u32x2 xw = *(const u32x2*)(xp + bj * HALF + n * 16);
                        const f32x4 xv = (f32x4){__uint_as_float(xw.x << 16), __uint_as_float(xw.x & 0xffff0000u), __uint_as_float(xw.y << 16), __uint_as_float(xw.y & 0xffff0000u)};
                        const f32x4 o = xv + gv[bj][n] * acc[ai][bj][m][n];
                        u32x2 ow; ow.x = cvt_pk_bf16(o[0], o[1]); ow.y = cvt_pk_bf16(o[2], o[3]); *(u32x2*)(xp + bj * HALF + n * 16) = ow; } }
    }
};


#ifndef GEMM_ALIGN
#define GEMM_ALIGN true
#endif
#ifndef GEMM_SP2
#define GEMM_SP2 true
#endif
template <class Epi, class Sched, bool ALIGN_EPI = GEMM_ALIGN, bool SP2 = GEMM_SP2>
__device__ __forceinline__ void gemm_phase(PG8_LAS unsigned char* lds, const Gemm g, const Sched& S, const Epi& E, unsigned long long*  , int tid_in) {
    int tid_ = tid_in; asm volatile("" : "+v"(tid_));
    const int tid = tid_, wid = __builtin_amdgcn_readfirstlane(tid >> 6), lane = tid & 63, wr = wid >> 2, wc = wid & 3, fr = lane & 15, fq = lane >> 4;
    const int K = g.K, nt = K / BK;
    unsigned voffA[2], voffB[2];
#pragma unroll
    for (int i = 0; i < 2; ++i) { int R, C; stage_rc(tid * 16 + i * 8192, R, C); const int Rb = Epi::PERM ? ((R & ~31) + perm32(R & 31)) : R;
        voffA[i] = (unsigned)(R * K + C) * 2u; voffB[i] = (unsigned)(Rb * K + C) * 2u; }
    const size_t kstep = (size_t)(BK * 2);
    const size_t hstep = (size_t)HALF * K * 2;
    const size_t tstep = 2 * hstep;
    const unsigned ldsw = (unsigned)wid * 1024u;
    const int aoff = lds_byte(wr * 64 + fr, fq * 8), boff = lds_byte(wc * 32 + fr, fq * 8);
#define PG8_SA(b, h) (((b) * 2 + (h)) * HTB)
#define PG8_SB(b, h) ((4 + (b) * 2 + (h)) * HTB)
#define PG8_STAGE(bufoff, gbase, voff) do { _Pragma("unroll") for (int _i = 0; _i < 2; ++_i) \
        __builtin_amdgcn_global_load_lds((const unsigned*)((const char*)(gbase) + (voff)[_i]), (PG8_LAS unsigned*)(lds + (bufoff) + ldsw + _i * 8192), 16, 0, 0); } while (0)
#define PG8_LDA(dst, b, h) do { _Pragma("unroll") for (int m = 0; m < 4; ++m) _Pragma("unroll") for (int k = 0; k < 2; ++k) dst[m][k] = *(const PG8_LAS bf16x8*)(lds + PG8_SA(b, h) + aoff + m * 2048 + k * 1024); } while (0)
#define PG8_LDB(dst, b, h) do { _Pragma("unroll") for (int n = 0; n < 2; ++n) _Pragma("unroll") for (int k = 0; k < 2; ++k) dst[n][k] = *(const PG8_LAS bf16x8*)(lds + PG8_SB(b, h) + boff + n * 2048 + k * 1024); } while (0)
#define PG8_MMA(ai, bj, At, Bt) do { __builtin_amdgcn_s_setprio(1); _Pragma("unroll") for (int m = 0; m < 4; ++m) _Pragma("unroll") for (int n = 0; n < 2; ++n) _Pragma("unroll") for (int k = 0; k < 2; ++k) \
        acc[ai][bj][m][n] = __builtin_amdgcn_mfma_f32_16x16x32_bf16(Bt[n][k], At[m][k], acc[ai][bj][m][n], 0, 0, 0); __builtin_amdgcn_s_setprio(0); } while (0)
#define PG8_WAIT_V(n) asm volatile("s_waitcnt vmcnt(" #n ")" ::: "memory")
#define PG8_WAIT_L(n) asm volatile("s_waitcnt lgkmcnt(" #n ")" ::: "memory")
#define PG8_BAR __builtin_amdgcn_s_barrier()
#define PG8_SCHED __builtin_amdgcn_sched_barrier(0)
    Unit cur, nxt; int ui = 0;
    if (!S.next(0, cur)) return;
    f32x4 acc[2][2][4][2];
#pragma unroll
    for (int a = 0; a < 2; ++a)
#pragma unroll
        for (int b = 0; b < 2; ++b)
#pragma unroll
            for (int m = 0; m < 4; ++m)
#pragma unroll
                for (int n = 0; n < 2; ++n) acc[a][b][m][n] = (f32x4){0.f, 0.f, 0.f, 0.f};
    bf16x8 At[4][2], B0[2][2], B1[2][2];
    const char* cA = (const char*)g.A + (size_t)cur.pm * tstep; const char* cB = (const char*)g.Bt + (size_t)cur.pn * tstep;
    S.a_ready(cur);
    if constexpr (SP2) {
        PG8_STAGE(PG8_SB(0, 0), cB, voffB); PG8_STAGE(PG8_SB(0, 1), cB + hstep, voffB); PG8_STAGE(PG8_SA(0, 0), cA, voffA); PG8_STAGE(PG8_SA(0, 1), cA + hstep, voffA);
        if (wr == 1) PG8_BAR;
        PG8_WAIT_V(2); PG8_BAR;
        PG8_STAGE(PG8_SB(1, 0), cB + kstep, voffB); PG8_STAGE(PG8_SA(1, 0), cA + kstep, voffA); PG8_STAGE(PG8_SB(1, 1), cB + hstep + kstep, voffB);
        PG8_WAIT_V(6); PG8_BAR;
    } else {
        PG8_STAGE(PG8_SB(0, 0), cB, voffB); PG8_STAGE(PG8_SA(0, 0), cA, voffA); PG8_STAGE(PG8_SB(0, 1), cB + hstep, voffB); PG8_STAGE(PG8_SA(0, 1), cA + hstep, voffA);
        if (wr == 1) PG8_BAR;
        PG8_WAIT_V(4); PG8_BAR;
        PG8_STAGE(PG8_SB(1, 0), cB + kstep, voffB); PG8_STAGE(PG8_SA(1, 0), cA + kstep, voffA); PG8_STAGE(PG8_SB(1, 1), cB + hstep + kstep, voffB);
        PG8_WAIT_V(6); PG8_BAR;
    }
    for (;;) {
        const bool has_next = S.next(ui + 1, nxt);
        const char* nA = has_next ? (const char*)g.A + (size_t)nxt.pm * tstep : cA; const char* nB = has_next ? (const char*)g.Bt + (size_t)nxt.pn * tstep : cB;
        for (int t = 0; t < nt; t += 2) {
            const bool last = (t == nt - 2);
            const char* a1 = cA + (size_t)(t + 1) * kstep;
            const char* a2 = last ? nA : cA + (size_t)(t + 2) * kstep; const char* b2 = last ? nB : cB + (size_t)(t + 2) * kstep;
            const char* a3 = a2 + kstep; const char* b3 = b2 + kstep;
            if (last && has_next) S.a_ready(nxt);
            if constexpr (SP2) {
            PG8_LDB(B0, 0, 0); PG8_LDB(B1, 0, 1); PG8_SCHED; PG8_LDA(At, 0, 0); PG8_STAGE(PG8_SA(1, 1), a1 + hstep, voffA);
            PG8_WAIT_V(8); PG8_WAIT_L(0); PG8_BAR; PG8_MMA(0, 0, At, B0); PG8_MMA(0, 1, At, B1); PG8_BAR; PG8_SCHED;
            PG8_LDA(At, 0, 1); PG8_STAGE(PG8_SB(0, 0), b2, voffB); PG8_STAGE(PG8_SB(0, 1), b2 + hstep, voffB); PG8_STAGE(PG8_SA(0, 0), a2, voffA);
            PG8_WAIT_V(8); PG8_WAIT_L(0); PG8_BAR; PG8_MMA(1, 0, At, B0); PG8_MMA(1, 1, At, B1); PG8_BAR; PG8_SCHED;
            PG8_LDB(B0, 1, 0); PG8_LDB(B1, 1, 1); PG8_SCHED; PG8_LDA(At, 1, 0); PG8_STAGE(PG8_SA(0, 1), a2 + hstep, voffA);
            PG8_WAIT_V(8); PG8_WAIT_L(0); PG8_BAR; PG8_MMA(0, 0, At, B0); PG8_MMA(0, 1, At, B1); PG8_BAR; PG8_SCHED;
            PG8_LDA(At, 1, 1); PG8_STAGE(PG8_SB(1, 0), b3, voffB); PG8_STAGE(PG8_SB(1, 1), b3 + hstep, voffB); PG8_STAGE(PG8_SA(1, 0), a3, voffA);
            PG8_WAIT_V(8); PG8_WAIT_L(0); PG8_BAR; PG8_MMA(1, 0, At, B0); PG8_MMA(1, 1, At, B1); PG8_BAR; PG8_SCHED;
            } else {
            PG8_LDB(B0, 0, 0); PG8_SCHED; PG8_LDA(At, 0, 0); PG8_STAGE(PG8_SA(1, 1), a1 + hstep, voffA);
            PG8_WAIT_L(8); PG8_BAR; PG8_WAIT_L(0); PG8_MMA(0, 0, At, B0); PG8_BAR; PG8_SCHED;
            PG8_LDB(B1, 0, 1); PG8_STAGE(PG8_SB(0, 0), b2, voffB);
            PG8_BAR; PG8_WAIT_L(0); PG8_MMA(0, 1, At, B1); PG8_BAR;
            PG8_LDA(At, 0, 1); PG8_STAGE(PG8_SA(0, 0), a2, voffA);
            PG8_BAR; PG8_WAIT_L(0); PG8_MMA(1, 0, At, B0); PG8_BAR; PG8_SCHED;
            PG8_STAGE(PG8_SB(0, 1), b2 + hstep, voffB);
            PG8_WAIT_V(6); PG8_BAR; PG8_MMA(1, 1, At, B1); PG8_BAR;
            PG8_LDB(B0, 1, 0); PG8_SCHED; PG8_LDA(At, 1, 0); PG8_STAGE(PG8_SA(0, 1), a2 + hstep, voffA);
            PG8_WAIT_L(8); PG8_BAR; PG8_WAIT_L(0); PG8_MMA(0, 0, At, B0); PG8_BAR; PG8_SCHED;
            PG8_LDB(B1, 1, 1); PG8_STAGE(PG8_SB(1, 0), b3, voffB);
            PG8_BAR; PG8_WAIT_L(0); PG8_MMA(0, 1, At, B1); PG8_BAR;
            PG8_LDA(At, 1, 1); PG8_STAGE(PG8_SA(1, 0), a3, voffA);
            PG8_BAR; PG8_WAIT_L(0); PG8_MMA(1, 0, At, B0); PG8_BAR; PG8_SCHED;
            PG8_STAGE(PG8_SB(1, 1), b3 + hstep, voffB);
            PG8_WAIT_V(6); PG8_BAR; PG8_MMA(1, 1, At, B1); PG8_BAR;
            }
        }
        if constexpr (ALIGN_EPI) { if (wr == 0) PG8_BAR; }
        if constexpr (!Epi::AFTER_DRAIN) { E(acc, cur, wr, wc, fr, fq); S.done(cur); }
        if (!has_next) break;
#pragma unroll
        for (int a = 0; a < 2; ++a)
#pragma unroll
            for (int b = 0; b < 2; ++b)
#pragma unroll
                for (int m = 0; m < 4; ++m)
#pragma unroll
                    for (int n = 0; n < 2; ++n) acc[a][b][m][n] = (f32x4){0.f, 0.f, 0.f, 0.f};
        cur = nxt; cA = nA; cB = nB; ++ui;
        if constexpr (ALIGN_EPI) { if (wr == 1) PG8_BAR; }
    }
    PG8_WAIT_V(0);
    if constexpr (!ALIGN_EPI) { if (wr == 0) PG8_BAR; }
    PG8_BAR;
    if constexpr (Epi::AFTER_DRAIN) { E.fused(acc, cur, wr, wc, fr, fq, lds, wid, lane); S.done(cur); }
#undef PG8_SA
#undef PG8_SB
#undef PG8_STAGE
#undef PG8_LDA
#undef PG8_LDB
#undef PG8_MMA
#undef PG8_WAIT_V
#undef PG8_WAIT_L
#undef PG8_BAR
#undef PG8_SCHED
}
}

#define XB_TMO      128
#define XB_XCNT(j)  (256  + 64 * (j))
#define XB_XSUB(j)  (1280 + 64 * (j))
#define XB_XGEN(j)  (2304 + 64 * (j))
#define XB_TOP      3328
#define XB_TOPGEN   3392
#define XCD_BAR_WORDS 3456
#define XB_SPIN_CAP (1u << 18)
#define LAS __attribute__((address_space(3)))

__device__ __forceinline__ unsigned xb_ld(unsigned* p)              { return __hip_atomic_load(p, __ATOMIC_RELAXED, __HIP_MEMORY_SCOPE_AGENT); }
__device__ __forceinline__ unsigned xb_add(unsigned* p, unsigned v) { return __hip_atomic_fetch_add(p, v, __ATOMIC_RELAXED, __HIP_MEMORY_SCOPE_AGENT); }
__device__ __forceinline__ unsigned xb_xcc_id() { return (unsigned)__builtin_amdgcn_s_getreg((3 << 11) | 20) & 0xFu; }
#define XB_SPIN(cond, bar) do { unsigned _sp = 0; while (cond) { __builtin_amdgcn_s_sleep(1); \
    if ((++_sp & 255u) == 0u) { if (xb_ld(&(bar)[XB_TMO])) break; if (_sp > XB_SPIN_CAP) { atomicAdd(&(bar)[XB_TMO], 1u); break; } } } } while (0)

struct XcdBarrier {
    unsigned* bar; unsigned x;
    volatile LAS unsigned* st;
};

__device__ __forceinline__ XcdBarrier xcd_barrier_post(unsigned* bar, volatile LAS unsigned* st, int tid) {
    XcdBarrier b; b.bar = bar; b.x = (unsigned)__builtin_amdgcn_readfirstlane((int)xb_xcc_id()); b.st = st;
    if (tid == 0) (void)xb_add(&bar[XB_XCNT(b.x)], 1u);
    return b;
}
__device__ __forceinline__ void xcd_barrier_complete(unsigned* bar, unsigned x, unsigned& nloc, unsigned& nx) {
    const unsigned G = gridDim.x * gridDim.y * gridDim.z;
    unsigned sum, cnt, mine, sp = 0u;
    for (;;) {
        sum = 0u; cnt = 0u; mine = 0u;
#pragma unroll
        for (unsigned j = 0; j < 16; ++j) { const unsigned c = xb_ld(&bar[XB_XCNT(j)]); sum += c; cnt += (c > 0u) ? 1u : 0u; mine = (j == x) ? c : mine; }
        if (sum == G) break;
        __builtin_amdgcn_s_sleep(1);
        if ((++sp & 255u) == 0u) { if (xb_ld(&bar[XB_TMO])) break; if (sp > XB_SPIN_CAP) { atomicAdd(&bar[XB_TMO], 1u); break; } }
    }
    nloc = mine > 0u ? mine : 1u; nx = cnt > 0u ? cnt : 1u;
}

__device__ __forceinline__ void xcd_barrier(const XcdBarrier& b, int tid) {
    asm volatile("s_waitcnt vmcnt(0)" ::: "memory");
    __syncthreads();
    if (tid == 0) {
        unsigned* bar = b.bar; unsigned bx_ = b.x; asm volatile("" : "+s"(bar), "+s"(bx_));
        __builtin_amdgcn_s_waitcnt(0);
        unsigned nloc = b.st[0], nx = b.st[1];
        if (nloc == 0u) { xcd_barrier_complete(bar, bx_, nloc, nx); b.st[0] = nloc; b.st[1] = nx; }
        const unsigned old = xb_add(&bar[XB_XSUB(bx_)], 1u);
        const unsigned gen = old / nloc;
        if (old + 1u == (gen + 1u) * nloc) {
            __builtin_amdgcn_fence(__ATOMIC_RELEASE, "agent");
            asm volatile("s_waitcnt vmcnt(0)" ::: "memory");
            const unsigned og = xb_add(&bar[XB_TOP], 1u);
            const unsigned tg = og / nx;
            if (og + 1u == (tg + 1u) * nx) xb_add(&bar[XB_TOPGEN], 1u);
            else XB_SPIN(xb_ld(&bar[XB_TOPGEN]) == tg, bar);
            __builtin_amdgcn_fence(__ATOMIC_ACQUIRE, "agent");
            xb_add(&bar[XB_XGEN(bx_)], 1u);
            asm volatile("s_waitcnt vmcnt(0)" ::: "memory");
        } else {
            XB_SPIN(xb_ld(&bar[XB_XGEN(bx_)]) == gen, bar);
            __builtin_amdgcn_fence(__ATOMIC_ACQUIRE, "agent");
            asm volatile("s_waitcnt vmcnt(0)" ::: "memory");
        }
    }
    __syncthreads();
}


typedef unsigned v4u __attribute__((ext_vector_type(4)));
typedef float f32x4 __attribute__((ext_vector_type(4)));
#define LDS_WAIT() asm volatile("s_waitcnt lgkmcnt(0)" ::: "memory")
constexpr int NWAVES = 8, NTHREADS = 512;
constexpr int RING_BYTES = 131072, LDS_BYTES = 155648;

struct P { const float* in[N_IN]; float* out; unsigned char* ws; };

template <int M> __device__ __forceinline__ float swz_xor(float v) { static_assert(M >= 1 && M < 32, "swizzle xor mask"); return __int_as_float(__builtin_amdgcn_ds_swizzle(__float_as_int(v), (M << 10) | 0x1f)); }
__device__ __forceinline__ float xor32_sum(float v) { auto r = __builtin_amdgcn_permlane32_swap(__float_as_uint(v), __float_as_uint(v), false, false); return __uint_as_float(r[0]) + __uint_as_float(r[1]); }
__device__ __forceinline__ float wave_sum(float v) {
    v += swz_xor<1>(v); v += swz_xor<2>(v); v += swz_xor<4>(v); v += swz_xor<8>(v); v += swz_xor<16>(v);
    return xor32_sum(v);
}

template <bool VPERM = false>
__device__ __forceinline__ void transpose_item(const float* W, int K, int N, bf16* WT, int k0, int n0, int drow0, LAS float* scr, int lane) {
    float tv[32];
#pragma unroll
    for (int i = 0; i < 32; ++i) { const int kk = 2 * i + (lane >> 5); tv[i] = W[(size_t)(k0 + kk) * N + n0 + (lane & 31)]; }
#pragma unroll
    for (int i = 0; i < 32; ++i) { const int kk = 2 * i + (lane >> 5); scr[kk * 33 + (lane & 31)] = tv[i]; }
    LDS_WAIT(); asm volatile("" ::: "memory");
    const int c = lane & 7;
#pragma unroll
    for (int j = 0; j < 4; ++j) { const int n = (lane >> 3) + 8 * j; const LAS float* s = scr + (8 * c) * 33 + n;
        v4u o; o.x = pk2(s[0 * 33], s[1 * 33]); o.y = pk2(s[2 * 33], s[3 * 33]); o.z = pk2(s[4 * 33], s[5 * 33]); o.w = pk2(s[6 * 33], s[7 * 33]);
        const int dr = VPERM ? (((drow0 + n) & ~127) + hg_vpos((drow0 + n) & 127)) : (drow0 + n);
        *(v4u*)(WT + (size_t)dr * K + k0 + 8 * c) = o; }
    LDS_WAIT(); asm volatile("" ::: "memory");
}

__device__ __forceinline__ void phase_prologue(const P& p, LAS unsigned char* lds, int gw, int NGW, int lane, int wave) {
    LAS float* scr = (LAS float*)(lds + wave * 16384);
    unsigned char* ws = p.ws;
    constexpr int IT_ADA = 16 * 192, IT_IN = 16 * 385, IT_BRA = 16 * 32, IT_BRB = 32 * 32, IT_OUT = 16 * 32, IT_UP = 16 * 128, IT_DOWN = 64 * 32;
    constexpr int IT_L = IT_ADA + IT_IN + IT_BRA + IT_BRB + IT_OUT + IT_UP + IT_DOWN;
    for (int it = gw; it < DEPTH * IT_L; it += NGW) {
        const int l = it / IT_L; int r = it % IT_L;
        bf16* wl = (bf16*)(ws + WS_W + (size_t)l * W_LSTRIDE);
        if (r < IT_ADA) { const int kb = r / 192, nb = r % 192; transpose_item(p.in[I_WADA] + (size_t)l * D * 6144, D, 6144, (bf16*)(ws + WS_WADA) + (size_t)l * 6144 * D, kb * 64, nb * 32, nb * 32, scr, lane); continue; } r -= IT_ADA;
        if (r < IT_IN) { const int kb = r / 385, nb = r % 385; const int n0 = nb * 32; const int dr = n0 < 10240 ? n0 : (n0 < 10272 ? PC_DT + (n0 - 10240) : n0 - 32);
            if (n0 >= PC_I && n0 < PC_OG) transpose_item<true>(p.in[I_WIN] + (size_t)l * D * IN_WIDTH, D, IN_WIDTH, (bf16*)((unsigned char*)wl + WO_IN), kb * 64, n0, dr, scr, lane);
            else transpose_item(p.in[I_WIN] + (size_t)l * D * IN_WIDTH, D, IN_WIDTH, (bf16*)((unsigned char*)wl + WO_IN), kb * 64, n0, dr, scr, lane);
            continue; } r -= IT_IN;
        if (r < IT_BRA) { const int kb = r / 32, nb = r % 32; transpose_item(p.in[I_WBRA] + (size_t)l * 1024 * 1024, 1024, 1024, (bf16*)((unsigned char*)wl + WO_BRA), kb * 64, nb * 32, nb * 32, scr, lane); continue; } r -= IT_BRA;
        if (r < IT_BRB) { const int kb = r / 32, nb = r % 32; transpose_item(p.in[I_WBRB] + (size_t)l * 2048 * 1024, 2048, 1024, (bf16*)((unsigned char*)wl + WO_BRB), kb * 64, nb * 32, nb * 32, scr, lane); continue; } r -= IT_BRB;
        if (r < IT_OUT) { const int kb = r / 32, nb = r % 32; transpose_item(p.in[I_WOUT] + (size_t)l * 1024 * 1024, 1024, 1024, (bf16*)((unsigned char*)wl + WO_OUT), kb * 64, nb * 32, nb * 32, scr, lane); continue; } r -= IT_OUT;
        if (r < IT_UP) { const int kb = r / 128, nb = r % 128; transpose_item(p.in[I_WUP] + (size_t)l * 1024 * 4096, 1024, 4096, (bf16*)((unsigned char*)wl + WO_UP), kb * 64, nb * 32, nb * 32, scr, lane); continue; } r -= IT_UP;
        { const int kb = r / 32, nb = r % 32; transpose_item(p.in[I_WDOWN] + (size_t)l * 4096 * 1024, 4096, 1024, (bf16*)((unsigned char*)wl + WO_DOWN), kb * 64, nb * 32, nb * 32, scr, lane); }
    }
    for (int i = gw * 64 + lane; i < DEPTH * 28672; i += NGW * 64) { const int l = i / 28672, r = i % 28672;
        ((v4u*)(ws + WS_W + (size_t)l * W_LSTRIDE + WO_IN + (size_t)IN_WIDTH * D * 2))[r] = (v4u){0u, 0u, 0u, 0u}; }
    for (int i = gw * 64 + lane; i < 256 * 1024; i += NGW * 64) { const int r = i >> 10, c = i & 1023;
        float v = 0.f; if (r < NB) v = p.in[I_CP][r * D + c]; else if (r < NCOND) v = p.in[I_CS][(r - NB) * D + c];
        ((bf16*)(ws + WS_AC))[i] = f2bf(siluf_(v)); }
    for (int c = gw * 64 + lane; c < 1024; c += NGW * 64) { float v[DEPTH], mx = -3.0e38f;
#pragma unroll
        for (int l = 0; l < DEPTH; ++l) { v[l] = p.in[I_LB][l * 1024 + c]; mx = fmaxf(mx, v[l]); }
        float s = 0.f;
#pragma unroll
        for (int l = 0; l < DEPTH; ++l) { v[l] = expf(v[l] - mx); s += v[l]; }
        float cum = 0.f; float* lbs = (float*)(ws + WS_LBS);
#pragma unroll
        for (int l = 0; l < DEPTH; ++l) { if (l > 0) cum += v[l] / s; lbs[l * 1024 + c] = cum; }
    }
}

__device__ __forceinline__ f32x4 unpack4(unsigned long long w) { const unsigned lo = (unsigned)w, hi = (unsigned)(w >> 32); return (f32x4){__uint_as_float(lo << 16), __uint_as_float(lo & 0xffff0000u), __uint_as_float(hi << 16), __uint_as_float(hi & 0xffff0000u)}; }
template <int MODE, int NR>
__device__ __forceinline__ void norm_rows(const float* X32, bf16* X, bf16* H, float* out32, const f32x4 (&mul)[4], const f32x4 (&sh)[4], int lane) {
    if constexpr (MODE == 1) {
        f32x4 v[NR][4];
#pragma unroll
        for (int r = 0; r < NR; ++r) { const f32x4* xr = (const f32x4*)(X32 + (size_t)r * D) + lane;
#pragma unroll
            for (int j = 0; j < 4; ++j) v[r][j] = xr[64 * j]; }
#pragma unroll
        for (int r = 0; r < NR; ++r) { float s = 0.f;
#pragma unroll
            for (int j = 0; j < 4; ++j) s += (v[r][j].x * v[r][j].x + v[r][j].y * v[r][j].y) + (v[r][j].z * v[r][j].z + v[r][j].w * v[r][j].w);
            const float rstd = rsqrtf(wave_sum(s) * (1.f / D) + EPS);
            unsigned long long* o8 = (unsigned long long*)(H + (size_t)r * D) + lane; unsigned long long* x8 = (unsigned long long*)(X + (size_t)r * D) + lane;
#pragma unroll
            for (int j = 0; j < 4; ++j) { const f32x4 y = v[r][j] * rstd * mul[j] + sh[j];
                x8[64 * j] = (unsigned long long)pk2(v[r][j].x, v[r][j].y) | ((unsigned long long)pk2(v[r][j].z, v[r][j].w) << 32);
                o8[64 * j] = (unsigned long long)pk2(y.x, y.y) | ((unsigned long long)pk2(y.z, y.w) << 32); } }
    } else {
        unsigned long long raw[NR][4];
#pragma unroll
        for (int r = 0; r < NR; ++r) { const unsigned long long* xr = (const unsigned long long*)(X + (size_t)r * D) + lane;
#pragma unroll
            for (int j = 0; j < 4; ++j) raw[r][j] = xr[64 * j]; }
#pragma unroll
        for (int r = 0; r < NR; ++r) { f32x4 v[4]; float s = 0.f;
#pragma unroll
            for (int j = 0; j < 4; ++j) { v[j] = unpack4(raw[r][j]); s += (v[j].x * v[j].x + v[j].y * v[j].y) + (v[j].z * v[j].z + v[j].w * v[j].w); }
            const float rstd = rsqrtf(wave_sum(s) * (1.f / D) + EPS);
            if constexpr (MODE == 2) { f32x4* o = (f32x4*)(out32 + (size_t)r * D) + lane;
#pragma unroll
                for (int j = 0; j < 4; ++j) o[64 * j] = v[j] * rstd * mul[j];
            } else { unsigned long long* o8 = (unsigned long long*)(H + (size_t)r * D) + lane;
#pragma unroll
                for (int j = 0; j < 4; ++j) { const f32x4 y = v[j] * rstd * mul[j] + sh[j]; o8[64 * j] = (unsigned long long)pk2(y.x, y.y) | ((unsigned long long)pk2(y.z, y.w) << 32); } } }
    }
}
template <int MODE>
__device__ __forceinline__ void phase_norm(const float* Xp32, const float* Xs32, bf16* X, bf16* H, const float* nw, const float* mod_sh, const float* mod_sc, int gw, int NGW, int lane) {
    f32x4 w4[4];
#pragma unroll
    for (int j = 0; j < 4; ++j) w4[j] = ((const f32x4*)nw)[lane + 64 * j];
    for (int b = gw; b < MP / 8; b += NGW) {
        const int ci = b >> 8; f32x4 mul[4], sh[4];
        const f32x4* shp = (const f32x4*)(mod_sh + (size_t)ci * MODLD) + lane; const f32x4* scp = (const f32x4*)(mod_sc + (size_t)ci * MODLD) + lane;
#pragma unroll
        for (int j = 0; j < 4; ++j) { sh[j] = shp[64 * j]; mul[j] = w4[j] * (scp[64 * j] + 1.0f); }
        const size_t ro = (size_t)b * 8 * D;
        norm_rows<MODE, MODE == 1 ? 4 : 8>(MODE == 1 ? Xp32 + ro : nullptr, X + ro, H + ro, nullptr, mul, sh, lane);
        if constexpr (MODE == 1) norm_rows<MODE, 4>(Xp32 + ro + 4 * D, X + ro + 4 * D, H + ro + 4 * D, nullptr, mul, sh, lane);
    }
    for (int sr = gw; sr < MS; sr += NGW) {
        const int ci = NB + sr; f32x4 mul[4], sh[4];
        const f32x4* shp = (const f32x4*)(mod_sh + (size_t)ci * MODLD) + lane; const f32x4* scp = (const f32x4*)(mod_sc + (size_t)ci * MODLD) + lane;
#pragma unroll
        for (int j = 0; j < 4; ++j) { sh[j] = shp[64 * j]; mul[j] = w4[j] * (scp[64 * j] + 1.0f); }
        const size_t ro = (size_t)(MP + sr) * D;
        norm_rows<MODE, 1>(MODE == 1 ? Xs32 + (size_t)sr * D : nullptr, X + ro, H + ro, nullptr, mul, sh, lane);
    }
}
__device__ __forceinline__ void phase_final(const bf16* X, float* out, const float* nw, int gw, int NGW, int lane) {
    f32x4 w4[4];
#pragma unroll
    for (int j = 0; j < 4; ++j) w4[j] = ((const f32x4*)nw)[lane + 64 * j];
    for (int b = gw; b < MP / 8; b += NGW) { const size_t ro = (size_t)b * 8 * D; norm_rows<2, 8>(nullptr, (bf16*)X + ro, nullptr, out + ro, w4, w4, lane); }
    for (int sr = gw; sr < MS; sr += NGW) { const size_t ro = (size_t)(MP + sr) * D; norm_rows<2, 1>(nullptr, (bf16*)X + ro, nullptr, out + ro, w4, w4, lane); }
}


typedef short s16x4 __attribute__((ext_vector_type(4)));
typedef short bf16x8 __attribute__((ext_vector_type(8)));
__device__ __forceinline__ f32x4 mfma16(bf16x8 a, bf16x8 b, f32x4 c) { return __builtin_amdgcn_mfma_f32_16x16x32_bf16(a, b, c, 0, 0, 0); }
__device__ __forceinline__ s16x4 tr_read4(LAS unsigned char* p) { return __builtin_amdgcn_ds_read_tr16_b64_v4i16((LAS s16x4*)p); }
#define SHFL_XOR(v, M) swz_xor<M>(v)
__device__ __forceinline__ float shfl_up_f(float v, int o, int lane) { return __int_as_float(__builtin_amdgcn_ds_bpermute((lane >= o ? lane - o : lane) << 2, __float_as_int(v))); }
__device__ __forceinline__ void sync_threads() { __syncthreads(); }
__device__ __forceinline__ float __builtin_amdgcn_exp2f_(float x) { return __builtin_amdgcn_exp2f(x); }
#ifdef HOST_EMU
#define FENCE_MEM() do {} while (0)
#define SCHED_FENCE() do {} while (0)
#define LAUNDER_PTR(p) do {} while (0)
#else
#define LAUNDER_PTR(p) asm volatile("" : "+v"(p))
#define FENCE_MEM() asm volatile("" ::: "memory")
#define SCHED_FENCE() __builtin_amdgcn_sched_barrier(0)
#endif
constexpr int RC = 64;
constexpr int NSEG = 4, SEGLEN = 512, NCH = SEGLEN / RC;
constexpr int PQ = 272;
constexpr int PX = 528;

struct RecurBufs {
    bf16* proj;
    bf16* xbcc;
    float* dtv;
    float* cum;
    float* cv;
    float* sseg;
    float* dseg;
    float* hseg;
    float* tseg;
    bf16* ohg;
    bf16* y;
};

__device__ __forceinline__ bf16x8 frag_rows(LAS unsigned char* img, int pitch, int row, int kcol) { return *(LAS bf16x8*)(img + row * pitch + kcol * 2); }
__device__ __forceinline__ bf16x8 frag_tr(LAS unsigned char* img, int pitch, int k0a, int k0b, int col0, int lane) {
    const int q = (lane & 15) >> 2, p = lane & 3;
    const s16x4 a = tr_read4(img + (k0a + q) * pitch + (col0 + 4 * p) * 2);
    const s16x4 b = tr_read4(img + (k0b + q) * pitch + (col0 + 4 * p) * 2);
    return (bf16x8){a[0], a[1], a[2], a[3], b[0], b[1], b[2], b[3]};
}
__device__ __forceinline__ bf16x8 scale_frag(bf16x8 f, float s) {
    bf16x8 o;
#pragma unroll
    for (int j = 0; j < 8; ++j) o[j] = (short)f2bf(bf2f((bf16)f[j]) * s);
    return o;
}
__device__ __forceinline__ bf16x8 scale_frag8(bf16x8 f, const float (&s)[8]) {
    bf16x8 o;
#pragma unroll
    for (int j = 0; j < 8; ++j) o[j] = (short)f2bf(bf2f((bf16)f[j]) * s[j]);
    return o;
}
__device__ __forceinline__ void stage_tile128(const bf16* g, size_t ld, LAS unsigned char* img, int tid) {
#pragma unroll
    for (int i = 0; i < 2; ++i) { const int idx = tid + i * 512, r = idx >> 4, c16 = idx & 15;
        *(LAS v4u*)(img + r * PQ + c16 * 16) = *(const v4u*)(g + (size_t)r * ld + c16 * 8); }
}

constexpr int HG_QT = 0, HG_KT = 17408, HG_V = 34816, HG_PART = 52224, HG_VEC1 = 54272, HG_ST = 52224, HG_VEC = 87040, HG_RED = 89088;

__device__ __forceinline__ void hgrn_state_update(f32x4 (&S)[8], LAS unsigned char* Kt, LAS unsigned char* V, const LAS float* escale, const LAS float* edec, int w, int lane) {
    const int c = lane & 15, g = lane >> 4;
    const f32x4 dc = *(const LAS f32x4*)(edec + 16 * w + 4 * g);
#pragma unroll
    for (int et = 0; et < 8; ++et) S[et] = S[et] * dc;
    const float es = escale[16 * w + c];
#pragma unroll
    for (int ks = 0; ks < 2; ++ks) {
        const bf16x8 A = scale_frag(frag_tr(Kt, PQ, 32 * ks + 8 * g, 32 * ks + 8 * g + 4, 16 * w, lane), es);
#pragma unroll
        for (int et = 0; et < 8; ++et) { const bf16x8 B = frag_tr(V, PQ, 32 * ks + 8 * g, 32 * ks + 8 * g + 4, 16 * et, lane); S[et] = mfma16(A, B, S[et]); }
        SCHED_FENCE();
    }
}

__device__ __forceinline__ void hgrn_pass1(const RecurBufs& rb, const float* lbs_l, int u, int tid, LAS unsigned char* lds) {
    const int b = u >> 5, h = (u >> 2) & 7, seg = u & 3, lane = tid & 63, w = tid >> 6;
    const int d = tid & 127, jq = tid >> 7;
    LAS unsigned char* Qt = lds + HG_QT; LAS unsigned char* Kt = lds + HG_KT; LAS unsigned char* V = lds + HG_V; LAS float* part = (LAS float*)(lds + HG_PART); LAS float* vec = (LAS float*)(lds + HG_VEC1);
    const float lb = lbs_l[h * 128 + d];
    f32x4 S[8];
#pragma unroll
    for (int et = 0; et < 8; ++et) S[et] = (f32x4){0.f, 0.f, 0.f, 0.f};
    float dprod = 1.f;
    const int sr = tid >> 4, sc16 = tid & 15;
    v4u pre[6];
    {   const bf16* gq = rb.proj + ((size_t)b * SEQ + seg * SEGLEN + sr) * LDP + PC_Q + h * 128 + sc16 * 8;
        pre[0] = *(const v4u*)gq; pre[1] = *(const v4u*)(gq + 32 * (size_t)LDP); pre[2] = *(const v4u*)(gq + PC_F); pre[3] = *(const v4u*)(gq + 32 * (size_t)LDP + PC_F);
        pre[4] = *(const v4u*)(gq + PC_I); pre[5] = *(const v4u*)(gq + 32 * (size_t)LDP + PC_I); }
    for (int ch = 0; ch < NCH; ++ch) {
        const size_t row0 = (size_t)b * SEQ + seg * SEGLEN + ch * RC;
        bf16* gq = rb.proj + (row0 + sr) * LDP + PC_Q + h * 128 + sc16 * 8;
        *(LAS v4u*)(Qt + sr * PQ + sc16 * 16) = pre[0]; *(LAS v4u*)(Qt + (sr + 32) * PQ + sc16 * 16) = pre[1];
        *(LAS v4u*)(Kt + sr * PQ + sc16 * 16) = pre[2]; *(LAS v4u*)(Kt + (sr + 32) * PQ + sc16 * 16) = pre[3];
        *(LAS v4u*)(V + sr * PQ + sc16 * 16) = pre[4]; *(LAS v4u*)(V + (sr + 32) * PQ + sc16 * 16) = pre[5];
        if (ch + 1 < NCH) { const bf16* gn = gq + RC * (size_t)LDP;
            pre[0] = *(const v4u*)gn; pre[1] = *(const v4u*)(gn + 32 * (size_t)LDP); pre[2] = *(const v4u*)(gn + PC_F); pre[3] = *(const v4u*)(gn + 32 * (size_t)LDP + PC_F);
            pre[4] = *(const v4u*)(gn + PC_I); pre[5] = *(const v4u*)(gn + 32 * (size_t)LDP + PC_I); }
        sync_threads();
        float qq[16], kk[16], lg[16];
#pragma unroll
        for (int j = 0; j < 16; ++j) { const float q = bf2f(*(const LAS bf16*)(Qt + (16 * jq + j) * PQ + d * 2)), f = bf2f(*(const LAS bf16*)(Kt + (16 * jq + j) * PQ + d * 2));
            const float fg = lb + (1.f - lb) * sigmoidf_(f);
            qq[j] = siluf_(q) * 0.08838834764831845f; kk[j] = 1.f - fg; lg[j] = __logf(fg); }
#pragma unroll
        for (int j = 1; j < 16; ++j) lg[j] += lg[j - 1];
        part[jq * 128 + d] = lg[15];
        sync_threads();
        const float p0 = part[d], p1 = part[128 + d], p2 = part[256 + d], p3 = part[384 + d];
        const float off = (jq > 0 ? p0 : 0.f) + (jq > 1 ? p1 : 0.f) + (jq > 2 ? p2 : 0.f);
        const float bref = p0 + p1, bend = (p0 + p1) + (p2 + p3);
#pragma unroll
        for (int j = 0; j < 16; ++j) { const float e1 = __expf(fminf(fmaxf(off + lg[j] - bref, -80.f), 80.f));
            *(LAS bf16*)(Qt + (16 * jq + j) * PQ + d * 2) = f2bf(qq[j] * e1); *(LAS bf16*)(Kt + (16 * jq + j) * PQ + d * 2) = f2bf(kk[j] * frcp_(e1)); }
        if (jq == 0) { const float eref = __expf(bref), esc = __expf(bend - bref), edc = __expf(bend);
            float* cvp = rb.cv + ((size_t)((b * 8 + h) * 32 + seg * NCH + ch) * 3) * 128;
            cvp[d] = eref; cvp[128 + d] = esc; cvp[256 + d] = edc; vec[128 + d] = esc; vec[256 + d] = edc; }
        dprod *= __expf(bend);
        sync_threads();
        *(v4u*)gq = *(const LAS v4u*)(Qt + sr * PQ + sc16 * 16); *(v4u*)(gq + 32 * (size_t)LDP) = *(const LAS v4u*)(Qt + (sr + 32) * PQ + sc16 * 16);
        *(v4u*)(gq + PC_F) = *(const LAS v4u*)(Kt + sr * PQ + sc16 * 16); *(v4u*)(gq + 32 * (size_t)LDP + PC_F) = *(const LAS v4u*)(Kt + (sr + 32) * PQ + sc16 * 16);
        hgrn_state_update(S, Kt, V, vec + 128, vec + 256, w, lane);
        sync_threads();
    }
    float* sp = rb.sseg + (size_t)u * 16384 + tid * 4;
#pragma unroll
    for (int et = 0; et < 8; ++et) { LAUNDER_PTR(sp); *(f32x4*)sp = S[et]; sp += 2048; }
    if (jq == 0) rb.dseg[u * 128 + d] = dprod;
}

__device__ __forceinline__ void hgrn_pass2(const RecurBufs& rb, const float* hgn_l, float* state_out_l, int u, int tid, LAS unsigned char* lds) {
    const int b = u >> 5, h = (u >> 2) & 7, seg = u & 3, lane = tid & 63, w = tid >> 6, c = lane & 15, g = lane >> 4;
    const int it = w & 3, eh = w >> 2;
    LAS unsigned char* Qt = lds + HG_QT; LAS unsigned char* Kt = lds + HG_KT; LAS unsigned char* V = lds + HG_V; LAS unsigned char* ST = lds + HG_ST;
    LAS float* vec = (LAS float*)(lds + HG_VEC); LAS float* red = (LAS float*)(lds + HG_RED);
    f32x4 S[8];
#pragma unroll
    for (int et = 0; et < 8; ++et) S[et] = (f32x4){0.f, 0.f, 0.f, 0.f};
    for (int s = 0; s < seg; ++s) { const int u2 = u - seg + s;
        const f32x4 dc = *(const f32x4*)(rb.dseg + u2 * 128 + 16 * w + 4 * g);
        const float* sp = rb.sseg + (size_t)u2 * 16384 + tid * 4;
#pragma unroll
        for (int et = 0; et < 8; ++et) { LAUNDER_PTR(sp); S[et] = S[et] * dc + *(const f32x4*)sp; sp += 2048; } }
    const int e0 = 64 * eh + 4 * c;
    const f32x4 hn = *(const f32x4*)(hgn_l + e0);
    const float* cvb = rb.cv + ((size_t)((b * 8 + h) * 32 + seg * NCH) * 3) * 128;
    const int sr = tid >> 4, sc16 = tid & 15;
    const size_t rowS = (size_t)b * SEQ + seg * SEGLEN;
    v4u pre[6];
    {   const bf16* gq = rb.proj + (rowS + sr) * LDP + PC_Q + h * 128 + sc16 * 8;
        pre[0] = *(const v4u*)gq; pre[1] = *(const v4u*)(gq + 32 * (size_t)LDP); pre[2] = *(const v4u*)(gq + PC_F); pre[3] = *(const v4u*)(gq + 32 * (size_t)LDP + PC_F);
        pre[4] = *(const v4u*)(gq + PC_I); pre[5] = *(const v4u*)(gq + 32 * (size_t)LDP + PC_I); }
    float cvn = tid < 384 ? cvb[tid] : 0.f; f32x4 ern = *(const f32x4*)(cvb + 16 * w + 4 * g);
    for (int ch = 0; ch < NCH; ++ch) {
        const size_t row0 = rowS + ch * RC;
        *(LAS v4u*)(Qt + sr * PQ + sc16 * 16) = pre[0]; *(LAS v4u*)(Qt + (sr + 32) * PQ + sc16 * 16) = pre[1];
        *(LAS v4u*)(Kt + sr * PQ + sc16 * 16) = pre[2]; *(LAS v4u*)(Kt + (sr + 32) * PQ + sc16 * 16) = pre[3];
        *(LAS v4u*)(V + sr * PQ + sc16 * 16) = pre[4]; *(LAS v4u*)(V + (sr + 32) * PQ + sc16 * 16) = pre[5];
        if (ch + 1 < NCH) { const bf16* gq = rb.proj + (row0 + RC + sr) * LDP + PC_Q + h * 128 + sc16 * 8;
            pre[0] = *(const v4u*)gq; pre[1] = *(const v4u*)(gq + 32 * (size_t)LDP); pre[2] = *(const v4u*)(gq + PC_F); pre[3] = *(const v4u*)(gq + 32 * (size_t)LDP + PC_F);
            pre[4] = *(const v4u*)(gq + PC_I); pre[5] = *(const v4u*)(gq + 32 * (size_t)LDP + PC_I); }
        if (tid < 384) vec[tid] = cvn;
        {
            const f32x4 er = ern;
            if (ch + 1 < NCH) { if (tid < 384) cvn = cvb[(size_t)(ch + 1) * 384 + tid]; ern = *(const f32x4*)(cvb + (size_t)(ch + 1) * 384 + 16 * w + 4 * g); }
#pragma unroll
            for (int et = 0; et < 8; ++et) { const f32x4 v = S[et] * er;
                *(LAS unsigned long long*)(ST + (16 * et + c) * PQ + (16 * w + 4 * g) * 2) = (unsigned long long)pk2(v[0], v[1]) | ((unsigned long long)pk2(v[2], v[3]) << 32); } }
        unsigned long long ogv[4];
#pragma unroll
        for (int r = 0; r < 4; ++r) ogv[r] = *(const unsigned long long*)(rb.proj + (row0 + 16 * it + 4 * g + r) * LDP + PC_OG + h * 128 + e0);
        sync_threads();
        bf16x8 Qfr[4];
#pragma unroll
        for (int kd = 0; kd < 4; ++kd) Qfr[kd] = frag_rows(Qt, PQ, 16 * it + c, 32 * kd + 8 * g);
        unsigned PT[4][2];
#pragma unroll
        for (int jt = 0; jt < 4; ++jt) {
            f32x4 acc = (f32x4){0.f, 0.f, 0.f, 0.f};
            if (jt <= it) {
#pragma unroll
                for (int kd = 0; kd < 4; ++kd) acc = mfma16(frag_rows(Kt, PQ, 16 * jt + c, 32 * kd + 8 * g), Qfr[kd], acc);
                if (jt == it) {
#pragma unroll
                    for (int r = 0; r < 4; ++r) acc[r] = (4 * g + r <= c) ? acc[r] : 0.f; }
            }
            PT[jt][0] = pk2(acc[0], acc[1]); PT[jt][1] = pk2(acc[2], acc[3]); SCHED_FENCE();
        }
        f32x4 o[4];
#pragma unroll
        for (int et = 0; et < 4; ++et) o[et] = (f32x4){0.f, 0.f, 0.f, 0.f};
#pragma unroll
        for (int ks = 0; ks < 2; ++ks) if (2 * ks <= it) {
            v4u pa = (v4u){PT[2 * ks][0], PT[2 * ks][1], PT[2 * ks + 1][0], PT[2 * ks + 1][1]};
            const bf16x8 A = __builtin_bit_cast(bf16x8, pa);
#pragma unroll
            for (int et = 0; et < 4; ++et) o[et] = mfma16(A, frag_tr(V, PQ, 32 * ks + 4 * g, 32 * ks + 16 + 4 * g, 16 * (4 * eh + et), lane), o[et]);
        }
#pragma unroll
        for (int kd = 0; kd < 4; ++kd) {
#pragma unroll
            for (int et = 0; et < 4; ++et) o[et] = mfma16(Qfr[kd], frag_rows(ST, PQ, 16 * (4 * eh + et) + c, 32 * kd + 8 * g), o[et]);
            SCHED_FENCE(); }
        hgrn_state_update(S, Kt, V, vec + 128, vec + 256, w, lane);
        float ss[4];
#pragma unroll
        for (int r = 0; r < 4; ++r) { float s = 0.f;
#pragma unroll
            for (int et = 0; et < 4; ++et) s += o[et][r] * o[et][r];
            s += SHFL_XOR(s, 1); s += SHFL_XOR(s, 2); s += SHFL_XOR(s, 4); s += SHFL_XOR(s, 8); ss[r] = s; }
        if (c == 0) {
#pragma unroll
            for (int r = 0; r < 4; ++r) red[(16 * it + 4 * g + r) * 2 + eh] = ss[r]; }
        sync_threads();
#pragma unroll
        for (int r = 0; r < 4; ++r) { const int i = 16 * it + 4 * g + r; const float rstd = rsqrtf((red[i * 2] + red[i * 2 + 1]) * (1.f / 128.f) + EPS);
            float ov[4];
#pragma unroll
            for (int et = 0; et < 4; ++et) { const float og = bf2f((bf16)(ogv[r] >> (16 * et))); ov[et] = o[et][r] * rstd * hn[et] * siluf_(og); }
            *(unsigned long long*)(rb.ohg + (row0 + i) * 1024 + h * 128 + e0) = (unsigned long long)pk2(ov[0], ov[1]) | ((unsigned long long)pk2(ov[2], ov[3]) << 32); }
        sync_threads();
    }
    if (seg == NSEG - 1) { float* so = state_out_l + (size_t)(b * 8 + h) * 16384 + (size_t)(16 * w + 4 * g) * 128 + 4 * c;
#pragma unroll
        for (int r = 0; r < 4; ++r)
#pragma unroll
            for (int a = 0; a < 2; ++a) *(f32x4*)(so + r * 128 + 64 * a) = (f32x4){S[4 * a][r], S[4 * a + 1][r], S[4 * a + 2][r], S[4 * a + 3][r]}; }
}

constexpr int PR = 1040;
constexpr int SD_T = 0, SD_H = 66560, SD_XO = 66560  , SD_DT = 136192, SD_CUM = 137216, SD_RED = 138240, SD_END = 139264;
__device__ __forceinline__ int ssd_gcol(int grp, int ch16) { return ch16 < 32 ? grp * 256 + ch16 * 8 : (ch16 < 48 ? 2048 + grp * 128 + (ch16 - 32) * 8 : 3072 + grp * 128 + (ch16 - 48) * 8); }

__device__ __forceinline__ void ssd_state_update(f32x4 (&H)[4][4], LAS unsigned char* Xi, int xp, LAS unsigned char* Bi, int bp, const LAS float* sDt, const LAS float* sCum, int w, int lane) {
    const int g = lane >> 4, k = w >> 1, nh = w & 1;
    const float tot = sCum[63 * 4 + k]; const float et = __expf(tot);
#pragma unroll
    for (int nt = 0; nt < 4; ++nt)
#pragma unroll
        for (int pt = 0; pt < 4; ++pt) H[nt][pt] = H[nt][pt] * et;
#pragma unroll
    for (int ks = 0; ks < 2; ++ks) {
        float wg[8];
#pragma unroll
        for (int j = 0; j < 8; ++j) wg[j] = __expf(tot - sCum[(32 * ks + 8 * g + j) * 4 + k]) * sDt[(32 * ks + 8 * g + j) * 4 + k];
        bf16x8 Bx[4];
#pragma unroll
        for (int pt = 0; pt < 4; ++pt) Bx[pt] = scale_frag8(frag_tr(Xi, xp, 32 * ks + 8 * g, 32 * ks + 8 * g + 4, 64 * k + 16 * pt, lane), wg);
#pragma unroll
        for (int nt = 0; nt < 4; ++nt) { const bf16x8 A = frag_tr(Bi, bp, 32 * ks + 8 * g, 32 * ks + 8 * g + 4, 16 * (4 * nh + nt), lane);
#pragma unroll
            for (int pt = 0; pt < 4; ++pt) H[nt][pt] = mfma16(A, Bx[pt], H[nt][pt]);
            SCHED_FENCE(); }
    }
}

typedef float f32x2r __attribute__((ext_vector_type(2)));
__device__ __forceinline__ f32x2r unpack2(unsigned w) { return (f32x2r){__uint_as_float(w << 16), __uint_as_float(w & 0xffff0000u)}; }
__device__ __forceinline__ f32x2r silu2(f32x2r a) {
    const f32x2r t = a * (-1.4426950408889634f); f32x2r e; e.x = __builtin_amdgcn_exp2f_(t.x); e.y = __builtin_amdgcn_exp2f_(t.y);
    const f32x2r d = e + 1.0f; f32x2r r; r.x = frcp_(d.x); r.y = frcp_(d.y); return a * r; }
constexpr int SD_RH = SD_XO + 64 * PX;
__device__ __forceinline__ void ssd_pass1(const RecurBufs& rb, const float* conv_w, const float* conv_b, const float* dt_bias, const float* a_log, float* conv_out_l, int u, int tid, LAS unsigned char* lds) {
    const int b = u >> 5, grp = (u >> 2) & 7, seg = u & 3, lane = tid & 63, w = tid >> 6;
    LAS unsigned char* T = lds + SD_T; LAS float* sDt = (LAS float*)(lds + SD_DT); LAS float* sCum = (LAS float*)(lds + SD_CUM); LAS unsigned char* RH = lds + SD_RH;
    const int cp = tid & 255, half = tid >> 8, t0c = 2 * cp;
    const int chx = t0c < 256 ? (grp * 256 + t0c) : (t0c < 384 ? (2048 + grp * 128 + (t0c - 256)) : (3072 + grp * 128 + (t0c - 384)));
    const int xcol = (t0c & ~63) + 16 * (t0c & 3) + ((t0c & 63) >> 2);
    const f32x2r w0 = (f32x2r){conv_w[chx], conv_w[chx + 1]}, w1 = (f32x2r){conv_w[4096 + chx], conv_w[4096 + chx + 1]}, w2 = (f32x2r){conv_w[8192 + chx], conv_w[8192 + chx + 1]},
                 w3 = (f32x2r){conv_w[12288 + chx], conv_w[12288 + chx + 1]}, cb = (f32x2r){conv_b[chx], conv_b[chx + 1]};
    const size_t rowS = (size_t)b * SEQ + seg * SEGLEN;
    if (half == 0) {
#pragma unroll
        for (int j = 0; j < 3; ++j) { unsigned v = 0u; if (seg > 0) v = *(const unsigned*)(rb.proj + (rowS - 3 + j) * LDP + PC_XBC + chx); *(LAS unsigned*)(RH + j * 1024 + cp * 4) = v; } }
    f32x4 H[4][4];
#pragma unroll
    for (int nt = 0; nt < 4; ++nt)
#pragma unroll
        for (int pt = 0; pt < 4; ++pt) H[nt][pt] = (f32x4){0.f, 0.f, 0.f, 0.f};
    float tsum = 0.f;
    const int ch16 = tid & 63, rr = tid >> 6;
    const int gcol = ssd_gcol(grp, ch16);
    LAS unsigned char* XO = lds + SD_XO;
    v4u raw[8];
    {   const bf16* gp = rb.proj + (rowS + rr) * LDP + PC_XBC + gcol;
#pragma unroll
        for (int i = 0; i < 8; ++i) { LAUNDER_PTR(gp); raw[i] = *(const v4u*)gp; gp += 8 * (size_t)LDP; } }
    bf16 dtn = 0;
    if (w < 4) dtn = rb.proj[(rowS + lane) * LDP + PC_DT + grp * 4 + w];
    unsigned hr0 = 0u, hr1 = 0u, hr2 = 0u;
    for (int ch = 0; ch < NCH; ++ch) {
        const size_t row0 = rowS + ch * RC;
        if (w < 4) {
            const int head = grp * 4 + w; const size_t row = row0 + lane;
            const float dv = softplusf_(bf2f(dtn) + dt_bias[head]);
            if (ch + 1 < NCH) dtn = rb.proj[(row + RC) * LDP + PC_DT + head];
            float la = dv * (-__expf(a_log[head]));
#pragma unroll
            for (int o = 1; o < 64; o <<= 1) { const float t = shfl_up_f(la, o, lane); if (lane >= o) la += t; }
            sDt[lane * 4 + w] = dv; sCum[lane * 4 + w] = la; rb.dtv[row * 32 + head] = dv; rb.cum[row * 32 + head] = la;
        }
#pragma unroll
        for (int i = 0; i < 8; ++i) *(LAS v4u*)(T + (rr + 8 * i) * PR + ch16 * 16) = raw[i];
        if (ch + 1 < NCH) { const bf16* gp = rb.proj + (row0 + RC + rr) * LDP + PC_XBC + gcol;
#pragma unroll
            for (int i = 0; i < 8; ++i) { LAUNDER_PTR(gp); raw[i] = *(const v4u*)gp; gp += 8 * (size_t)LDP; } }
        sync_threads();
        if (half == 0) { hr0 = *(const LAS unsigned*)(RH + cp * 4); hr1 = *(const LAS unsigned*)(RH + 1024 + cp * 4); hr2 = *(const LAS unsigned*)(RH + 2048 + cp * 4); }
        else { hr0 = *(const LAS unsigned*)(T + 29 * PR + cp * 4); hr1 = *(const LAS unsigned*)(T + 30 * PR + cp * 4); hr2 = *(const LAS unsigned*)(T + 31 * PR + cp * 4); }
        sync_threads();
        {
            f32x2r r0 = unpack2(hr0), r1 = unpack2(hr1), r2 = unpack2(hr2);
            const LAS unsigned char* src = T + (32 * half) * PR + cp * 4;
            unsigned lastw0 = hr0, lastw1 = hr1, lastw2 = hr2;
#pragma unroll 8
            for (int j = 0; j < 32; ++j) { const unsigned cw = *(const LAS unsigned*)(src + j * PR); const f32x2r cur = unpack2(cw);
                const f32x2r a = cb + w0 * r0 + w1 * r1 + w2 * r2 + w3 * cur; r0 = r1; r1 = r2; r2 = cur; lastw0 = lastw1; lastw1 = lastw2; lastw2 = cw;
                const f32x2r v = silu2(a); const unsigned ow = pk2(v.x, v.y);
                if (cp < 128) { LAS unsigned char* d = XO + (32 * half + j) * PX + xcol * 2; *(LAS bf16*)d = (bf16)ow; *(LAS bf16*)(d + 32) = (bf16)(ow >> 16); }
                else *(LAS unsigned*)(T + (32 * half + j) * PR + cp * 4) = ow; }
            if (half == 1) { *(LAS unsigned*)(RH + cp * 4) = lastw0; *(LAS unsigned*)(RH + 1024 + cp * 4) = lastw1; *(LAS unsigned*)(RH + 2048 + cp * 4) = lastw2;
                hr0 = lastw0; hr1 = lastw1; hr2 = lastw2; }
        }
        sync_threads();
        tsum += sCum[63 * 4 + (w >> 1)];
        ssd_state_update(H, XO, PX, T + 512, PR, sDt, sCum, w, lane);
        {   bf16* gp = rb.xbcc + (row0 + rr) * 4096 + gcol;
            const LAS unsigned char* src = ch16 < 32 ? (XO + ch16 * 16) : (T + ch16 * 16); const int spitch = ch16 < 32 ? PX : PR;
#pragma unroll
            for (int i = 0; i < 8; ++i) { LAUNDER_PTR(gp); *(v4u*)gp = *(const LAS v4u*)(src + (rr + 8 * i) * spitch); gp += 8 * 4096; } }
        sync_threads();
    }
    float* hp = rb.hseg + (size_t)u * 32768 + tid * 4;
#pragma unroll
    for (int nt = 0; nt < 4; ++nt)
#pragma unroll
        for (int pt = 0; pt < 4; ++pt) { LAUNDER_PTR(hp); *(f32x4*)hp = H[nt][pt]; hp += 2048; }
    if ((tid & 127) == 0) rb.tseg[u * 4 + (w >> 1)] = tsum;
    if (seg == NSEG - 1 && half == 1) { float* co = conv_out_l + (size_t)b * 3 * 4096;
        const f32x2r a0 = unpack2(hr0), a1 = unpack2(hr1), a2 = unpack2(hr2);
        co[chx] = a0.x; co[chx + 1] = a0.y; co[4096 + chx] = a1.x; co[4096 + chx + 1] = a1.y; co[8192 + chx] = a2.x; co[8192 + chx + 1] = a2.y; }
}

__device__ __forceinline__ void ssd_pass2(const RecurBufs& rb, const float* d_skip, const float* ssm_norm, float* state_out_l, int u, int tid, LAS unsigned char* lds) {
    const int b = u >> 5, grp = (u >> 2) & 7, seg = u & 3, lane = tid & 63, w = tid >> 6, c = lane & 15, g = lane >> 4;
    const int k = w >> 1, hf = w & 1, head = grp * 4 + k;
    LAS unsigned char* T = lds + SD_T; LAS unsigned char* sB = T + 512; LAS unsigned char* sC = T + 768; LAS unsigned char* hS = lds + SD_H + k * (64 * PQ);
    LAS float* sDt = (LAS float*)(lds + SD_DT); LAS float* sCum = (LAS float*)(lds + SD_CUM); LAS float* red = (LAS float*)(lds + SD_RED);
    f32x4 H[4][4];
#pragma unroll
    for (int nt = 0; nt < 4; ++nt)
#pragma unroll
        for (int pt = 0; pt < 4; ++pt) H[nt][pt] = (f32x4){0.f, 0.f, 0.f, 0.f};
    for (int s = 0; s < seg; ++s) { const int u2 = u - seg + s; const float dc = __expf(rb.tseg[u2 * 4 + k]); const float* hp = rb.hseg + (size_t)u2 * 32768 + tid * 4;
#pragma unroll
        for (int nt = 0; nt < 4; ++nt)
#pragma unroll
            for (int pt = 0; pt < 4; ++pt) { LAUNDER_PTR(hp); H[nt][pt] = H[nt][pt] * dc + *(const f32x4*)hp; hp += 2048; } }
    const float Dk = d_skip[head];
    const size_t rowS = (size_t)b * SEQ + seg * SEGLEN;
    const int ch16 = tid & 63, rr = tid >> 6; const int gcol = ssd_gcol(grp, ch16);
    const int chn0 = grp * 256 + k * 64 + 4 * c;
    for (int ch = 0; ch < NCH; ++ch) {
        const size_t row0 = rowS + ch * RC;
        {   v4u raw[8];
            {   const bf16* gp = rb.xbcc + (row0 + rr) * 4096 + gcol;
#pragma unroll
                for (int i = 0; i < 8; ++i) { LAUNDER_PTR(gp); raw[i] = *(const v4u*)gp; gp += 8 * 4096; } }
            if (tid < 256) { sDt[tid] = rb.dtv[(row0 + (tid >> 2)) * 32 + grp * 4 + (tid & 3)]; sCum[tid] = rb.cum[(row0 + (tid >> 2)) * 32 + grp * 4 + (tid & 3)]; }
#pragma unroll
            for (int nt = 0; nt < 4; ++nt)
#pragma unroll
                for (int pt = 0; pt < 4; ++pt) { const f32x4 v = H[nt][pt];
                    *(LAS unsigned long long*)(hS + (4 * c + pt) * PQ + (16 * (4 * hf + nt) + 4 * g) * 2) = (unsigned long long)pk2(v[0], v[1]) | ((unsigned long long)pk2(v[2], v[3]) << 32); }
#pragma unroll
            for (int i = 0; i < 8; ++i) *(LAS v4u*)(T + (rr + 8 * i) * PR + ch16 * 16) = raw[i]; }
        sync_threads();
#pragma unroll 1
        for (int i2 = 0; i2 < 2; ++i2) {
            const int it = i2 ? 3 - hf : hf;
            unsigned long long zz[4];
#pragma unroll
            for (int r = 0; r < 4; ++r) zz[r] = *(const unsigned long long*)(rb.proj + (row0 + 16 * it + 4 * g + r) * LDP + PC_Z + chn0);
            f32x4 ya[4];
#pragma unroll
            for (int pt = 0; pt < 4; ++pt) ya[pt] = (f32x4){0.f, 0.f, 0.f, 0.f};
#pragma unroll
            for (int kn = 0; kn < 4; ++kn) { const bf16x8 Cf = frag_rows(sC, PR, 16 * it + c, 32 * kn + 8 * g);
#pragma unroll
                for (int pt = 0; pt < 4; ++pt) ya[pt] = mfma16(Cf, frag_rows(hS, PQ, 4 * c + pt, 32 * kn + 8 * g), ya[pt]);
                SCHED_FENCE(); }
            {   float ei[4];
#pragma unroll
                for (int r = 0; r < 4; ++r) ei[r] = __expf(sCum[(16 * it + 4 * g + r) * 4 + k]);
#pragma unroll
                for (int pt = 0; pt < 4; ++pt)
#pragma unroll
                    for (int r = 0; r < 4; ++r) ya[pt][r] *= ei[r]; }
            const float cum_i = sCum[(16 * it + c) * 4 + k];
            unsigned PT[4][2];
#pragma unroll
            for (int jt = 0; jt < 4; ++jt) {
                f32x4 acc = (f32x4){0.f, 0.f, 0.f, 0.f};
                if (jt <= it) {
#pragma unroll
                    for (int kn = 0; kn < 4; ++kn) acc = mfma16(frag_rows(sB, PR, 16 * jt + c, 32 * kn + 8 * g), frag_rows(sC, PR, 16 * it + c, 32 * kn + 8 * g), acc);
#pragma unroll
                    for (int r = 0; r < 4; ++r) { const int j = 16 * jt + 4 * g + r; const float df = cum_i - sCum[j * 4 + k]; const bool keep = (jt < it) || (4 * g + r <= c);
                        acc[r] = keep ? acc[r] * __expf(fminf(df, 0.f)) * sDt[j * 4 + k] : 0.f; }
                }
                PT[jt][0] = pk2(acc[0], acc[1]); PT[jt][1] = pk2(acc[2], acc[3]); SCHED_FENCE();
            }
#pragma unroll
            for (int ks = 0; ks < 2; ++ks) if (2 * ks <= it) {
                v4u pa = (v4u){PT[2 * ks][0], PT[2 * ks][1], PT[2 * ks + 1][0], PT[2 * ks + 1][1]};
                const bf16x8 A = __builtin_bit_cast(bf16x8, pa);
#pragma unroll
                for (int pt = 0; pt < 4; ++pt) ya[pt] = mfma16(A, frag_tr(T, PR, 32 * ks + 4 * g, 32 * ks + 16 + 4 * g, 64 * k + 16 * pt, lane), ya[pt]);
                SCHED_FENCE();
            }
#pragma unroll
            for (int r = 0; r < 4; ++r) { const int i = 16 * it + 4 * g + r; float s = 0.f; float yv[4];
#pragma unroll
                for (int pt = 0; pt < 4; ++pt) { const float xc = bf2f(*(const LAS bf16*)(T + i * PR + (64 * k + 16 * pt + c) * 2)); const float z = bf2f((bf16)(zz[r] >> (16 * pt)));
                    const bf16 yb = f2bf((ya[pt][r] + Dk * xc) * siluf_(z)); yv[pt] = bf2f(yb); s += yv[pt] * yv[pt]; }
                *(unsigned long long*)(rb.y + (row0 + i) * 2048 + chn0) = (unsigned long long)pk2(yv[0], yv[1]) | ((unsigned long long)pk2(yv[2], yv[3]) << 32);
                s += SHFL_XOR(s, 1); s += SHFL_XOR(s, 2); s += SHFL_XOR(s, 4); s += SHFL_XOR(s, 8);
                if (c == 0) red[i * 4 + k] = s; }
            SCHED_FENCE();
        }
        ssd_state_update(H, T, PR, T + 512, PR, sDt, sCum, w, lane);
        sync_threads();
        {   const f32x4 nw = *(const f32x4*)(ssm_norm + chn0);
            unsigned long long yy[8];
            const int itA = hf, itB = 3 - hf;
            bf16* yb0 = rb.y + (row0 + 16 * itA + 4 * g) * 2048 + chn0;
            const int jump = (16 * (itB - itA) - 3) * 2048;
            {   bf16* yp = yb0;
#pragma unroll
                for (int q = 0; q < 8; ++q) { LAUNDER_PTR(yp); yy[q] = *(const unsigned long long*)yp; yp += (q == 3) ? jump : 2048; } }
            bf16* yp = yb0;
#pragma unroll
            for (int q = 0; q < 8; ++q) { const int i = 16 * (q < 4 ? itA : itB) + 4 * g + (q & 3);
                const float rstd = rsqrtf(((red[i * 4] + red[i * 4 + 1]) + (red[i * 4 + 2] + red[i * 4 + 3])) * (1.f / 256.f) + EPS);
                const unsigned lo = (unsigned)yy[q], hi = (unsigned)(yy[q] >> 32);
                const float y0 = __uint_as_float(lo << 16) * rstd * nw[0], y1 = __uint_as_float(lo & 0xffff0000u) * rstd * nw[1], y2 = __uint_as_float(hi << 16) * rstd * nw[2], y3 = __uint_as_float(hi & 0xffff0000u) * rstd * nw[3];
                LAUNDER_PTR(yp); *(unsigned long long*)yp = (unsigned long long)pk2(y0, y1) | ((unsigned long long)pk2(y2, y3) << 32); yp += (q == 3) ? jump : 2048; } }
        sync_threads();
    }
    if (seg == NSEG - 1) { float* so = state_out_l + ((size_t)(b * 32 + head) * 64 + 4 * c) * 128 + 64 * hf + 4 * g;
#pragma unroll
        for (int pt = 0; pt < 4; ++pt)
#pragma unroll
            for (int nt = 0; nt < 4; ++nt) *(f32x4*)(so + pt * 128 + 16 * nt) = H[nt][pt]; }
}

__device__ __forceinline__ float row32_sum(float s) { s += SHFL_XOR(s, 1); s += SHFL_XOR(s, 2); s += SHFL_XOR(s, 4); s += SHFL_XOR(s, 8); s += SHFL_XOR(s, 16); return s; }

__device__ __forceinline__ void hgrn_sample_load(f32x4 (&st)[8], const float* state_in, int bh, int tid) {
    const float* sp = state_in + (size_t)bh * 16384 + tid * 4;
#pragma unroll
    for (int it = 0; it < 8; ++it) { LAUNDER_PTR(sp); st[it] = *(const f32x4*)sp; sp += 2048; }
}
__device__ __forceinline__ void hgrn_sample_step(const bf16* proj, const float* lbs_l, const float* hgn_l, const float* state_in, float* state_out, bf16* ohg, int bh, int tid, LAS unsigned char* lds,
                                                 f32x4 (&st)[8], int bh_next) {
    const int b = bh >> 3, h = bh & 7, lane = tid & 63, w = tid >> 6;
    LAS float* sq = (LAS float*)lds; LAS float* sg = sq + 128; LAS float* sk = sq + 256; LAS float* sv = sq + 384; LAS float* so = (LAS float*)(lds + 8192); LAS float* sred = (LAS float*)(lds + 16384);
    const size_t row = (size_t)MP + b;
    float ogv = 0.f, q_ = 0.f, f_ = 0.f, v_ = 0.f, lb_ = 0.f;
    if (tid < 128) { const bf16* pr = proj + row * LDP + h * 128; q_ = bf2f(pr[PC_Q + tid]); f_ = bf2f(pr[PC_F + tid]); lb_ = lbs_l[h * 128 + tid]; v_ = bf2f(pr[PC_I + hg_vpos(tid)]); ogv = bf2f(pr[PC_OG + tid]); }
    if (tid < 128) { const float fg = lb_ + (1.f - lb_) * sigmoidf_(f_);
        sq[tid] = siluf_(q_) * 0.08838834764831845f; sg[tid] = fg; sk[tid] = 1.f - fg; sv[tid] = v_; }
    sync_threads();
    const int dv4 = tid & 31, rg = tid >> 5;
    const f32x4 vv = *(const LAS f32x4*)(sv + 4 * dv4);
    f32x4 oacc = (f32x4){0.f, 0.f, 0.f, 0.f};
    float* op = state_out + (size_t)bh * 16384 + tid * 4;
    const float* np = state_in + (size_t)(bh_next >= 0 ? bh_next : bh) * 16384 + tid * 4;
#pragma unroll
    for (int it = 0; it < 8; ++it) { const int dk = it * 16 + rg; const f32x4 sn = st[it] * sg[dk] + vv * sk[dk]; LAUNDER_PTR(op); *(f32x4*)op = sn; op += 2048; oacc = oacc + sn * sq[dk];
        LAUNDER_PTR(np); if (bh_next >= 0) st[it] = *(const f32x4*)np; np += 2048; }
    *(LAS f32x4*)(so + rg * 128 + 4 * dv4) = oacc;
    sync_threads();
    if (tid < 128) { float o = 0.f;
#pragma unroll
        for (int r = 0; r < 16; ++r) o += so[r * 128 + tid];
        float ss = o * o; ss = row32_sum(ss);
        if ((lane & 31) == 0) sred[tid >> 5] = ss;
        sq[tid] = o; }
    sync_threads();
    if (tid < 128) { const float rstd = rsqrtf(((sred[0] + sred[1]) + (sred[2] + sred[3])) * (1.f / 128.f) + EPS);
        ohg[row * 1024 + h * 128 + tid] = f2bf(sq[tid] * rstd * hgn_l[tid] * siluf_(ogv)); }
    sync_threads();
    (void)w;
}

__device__ __forceinline__ void ssd_sample_load(f32x4 (&st)[16], const float* state_in, int bg, int tid) {
    const float* sp = state_in + ((size_t)((bg >> 3) * 32 + (bg & 7) * 4)) * 8192 + tid * 4;
#pragma unroll
    for (int it = 0; it < 16; ++it) { LAUNDER_PTR(sp); st[it] = *(const f32x4*)sp; sp += 2048; }
}
__device__ __forceinline__ void ssd_sample_step(const bf16* proj, const float* conv_w, const float* conv_b, const float* dt_bias, const float* a_log, const float* d_skip, const float* ssm_norm,
                                                const float* state_in, const float* conv_in, float* state_out, float* conv_out, bf16* ybuf, int bg, int tid, LAS unsigned char* lds,
                                                f32x4 (&st)[16], int bg_next) {
    const int b = bg >> 3, grp = bg & 7, lane = tid & 63, w = tid >> 6;
    LAS float* sx = (LAS float*)(lds + 2048); LAS float* sB = (LAS float*)(lds + 3072); LAS float* sC = (LAS float*)(lds + 3584); LAS float* sdt = (LAS float*)(lds + 4096); LAS float* sdec = (LAS float*)(lds + 4112);
    LAS float* sy = (LAS float*)(lds + 4608); LAS float* sred = (LAS float*)(lds + 16384);
    const size_t row = (size_t)MP + b;
    {
        const int chx = tid < 256 ? (grp * 256 + tid) : (tid < 384 ? (2048 + grp * 128 + (tid - 256)) : (3072 + grp * 128 + (tid - 384)));
        const float* ci = conv_in + (size_t)b * 3 * 4096; const float r0 = ci[chx], r1 = ci[4096 + chx], r2 = ci[8192 + chx];
        const float cur = bf2f(proj[row * LDP + PC_XBC + chx]);
        const float cw0 = conv_w[chx], cw1 = conv_w[4096 + chx], cw2 = conv_w[8192 + chx], cw3 = conv_w[12288 + chx], cbb = conv_b[chx];
        float dtr = 0.f, dtbv = 0.f, alg = 0.f; if (tid < 4) { const int head = grp * 4 + tid; dtr = bf2f(proj[row * LDP + PC_DT + head]); dtbv = dt_bias[head]; alg = a_log[head]; }
        const float a = cbb + cw0 * r0 + cw1 * r1 + cw2 * r2 + cw3 * cur;
        const float v = siluf_(a);
        if (tid < 256) sx[tid] = v; else if (tid < 384) sB[tid - 256] = v; else sC[tid - 384] = v;
        float* co = conv_out + (size_t)b * 3 * 4096; co[chx] = r1; co[4096 + chx] = r2; co[8192 + chx] = cur;
        if (tid < 4) { const float dv = softplusf_(dtr + dtbv); sdt[tid] = dv; sdec[tid] = __expf(dv * (-__expf(alg))); } }
    sync_threads();
    const int n4 = tid & 31, pr_ = tid >> 5;
    const f32x4 Bv = *(const LAS f32x4*)(sB + 4 * n4), Cv = *(const LAS f32x4*)(sC + 4 * n4);
    float* op = state_out + ((size_t)(b * 32 + grp * 4)) * 8192 + tid * 4;
    const int bgn = bg_next >= 0 ? bg_next : bg; const float* np = state_in + ((size_t)((bgn >> 3) * 32 + (bgn & 7) * 4)) * 8192 + tid * 4;
#pragma unroll
    for (int it = 0; it < 16; ++it) { const int k = it >> 2, p = (it & 3) * 16 + pr_; const float xdt = sx[k * 64 + p] * sdt[k];
        const f32x4 hn = st[it] * sdec[k] + Bv * xdt; LAUNDER_PTR(op); *(f32x4*)op = hn; op += 2048;
        LAUNDER_PTR(np); if (bg_next >= 0) st[it] = *(const f32x4*)np; np += 2048;
        const f32x4 t = hn * Cv; float y = (t[0] + t[1]) + (t[2] + t[3]); y = row32_sum(y);
        if ((lane & 31) == 0) sy[k * 64 + p] = y; }
    sync_threads();
    float yv = 0.f;
    if (tid < 256) { const int k = tid >> 6; const float z = bf2f(proj[row * LDP + PC_Z + grp * 256 + tid]);
        yv = (sy[tid] + d_skip[grp * 4 + k] * sx[tid]) * siluf_(z);
        float ss = yv * yv; ss = row32_sum(ss); if ((lane & 31) == 0) sred[tid >> 5] = ss; }
    sync_threads();
    if (tid < 256) { float tot = 0.f;
#pragma unroll
        for (int r = 0; r < 8; ++r) tot += sred[r];
        ybuf[row * 2048 + grp * 256 + tid] = f2bf(yv * rsqrtf(tot * (1.f / 256.f) + EPS) * ssm_norm[grp * 256 + tid]); }
    sync_threads();
    (void)w;
}

static_assert(SD_END <= LDS_BYTES - 256, "LDS map");
static_assert(8 * 16384 <= LDS_BYTES - 256, "skinny LDS");
constexpr int SK_PART = 128 * 32 * 4;
template <int RT, class Epi>
__device__ __forceinline__ void skinny_gemm(const bf16* A, size_t lda, const bf16* Bt, int K, int N, const Epi& epi, int wg, int wg_first, int wg_count, int tid, LAS unsigned char* lds) {
    const int lane = tid & 63, w = tid >> 6, c = lane & 15, g = lane >> 4;
    constexpr int NRG = 8 / RT;
    const int nunit = (N / 32) * NRG, ksteps = K / 256;
    int me = wg - wg_first; if (me < 0 || me >= wg_count) return;
    for (int s = me; s < nunit; s += wg_count) {
        const int n0 = 32 * (s / NRG), r0 = (s % NRG) * (16 * RT);
        f32x4 acc[RT][2];
#pragma unroll
        for (int rt = 0; rt < RT; ++rt) { acc[rt][0] = (f32x4){0.f, 0.f, 0.f, 0.f}; acc[rt][1] = (f32x4){0.f, 0.f, 0.f, 0.f}; }
        const bf16* ap = A + (size_t)(r0 + c) * lda + (size_t)w * (K / 8) + 8 * g;
        const bf16* bp = Bt + (size_t)(n0 + c) * K + (size_t)w * (K / 8) + 8 * g;
#pragma unroll 4
        for (int ks = 0; ks < ksteps; ++ks) {
            bf16x8 af[RT], bfr[2];
#pragma unroll
            for (int rt = 0; rt < RT; ++rt) af[rt] = *(const bf16x8*)(ap + (size_t)(16 * rt) * lda + 32 * ks);
            bfr[0] = *(const bf16x8*)(bp + 32 * ks); bfr[1] = *(const bf16x8*)(bp + (size_t)16 * K + 32 * ks);
#pragma unroll
            for (int rt = 0; rt < RT; ++rt) { acc[rt][0] = mfma16(af[rt], bfr[0], acc[rt][0]); acc[rt][1] = mfma16(af[rt], bfr[1], acc[rt][1]); }
        }
        LAS float* part = (LAS float*)(lds + w * SK_PART);
#pragma unroll
        for (int rt = 0; rt < RT; ++rt)
#pragma unroll
            for (int nt = 0; nt < 2; ++nt)
#pragma unroll
                for (int r = 0; r < 4; ++r) part[(16 * rt + 4 * g + r) * 32 + 16 * nt + c] = acc[rt][nt][r];
        sync_threads();
        if (RT == 8 || tid < 64 * RT) {
            const int row = tid >> 2, c8 = (tid & 3) * 8;
            f32x4 v0 = (f32x4){0.f, 0.f, 0.f, 0.f}, v1 = (f32x4){0.f, 0.f, 0.f, 0.f};
#pragma unroll
            for (int ww = 0; ww < 8; ++ww) { const LAS float* pp = (const LAS float*)(lds + ww * SK_PART) + row * 32 + c8; v0 = v0 + *(const LAS f32x4*)pp; v1 = v1 + *(const LAS f32x4*)(pp + 4); }
            epi(r0 + row, n0 + c8, v0, v1);
        }
        sync_threads();
    }
}
struct SkStoreBf16 { bf16* O; int ld; int act;
    __device__ __forceinline__ void operator()(int row, int col, f32x4 v0, f32x4 v1) const {
        if (act) {
#pragma unroll
            for (int j = 0; j < 4; ++j) { const float a = fmaxf(v0[j], 0.f), b = fmaxf(v1[j], 0.f); v0[j] = a * a; v1[j] = b * b; } }
        v4u o; o.x = pk2(v0[0], v0[1]); o.y = pk2(v0[2], v0[3]); o.z = pk2(v1[0], v1[1]); o.w = pk2(v1[2], v1[3]);
        *(v4u*)(O + (size_t)row * ld + col) = o; } };
__device__ __forceinline__ void sk_unpack8(const v4u w, f32x4& lo, f32x4& hi) {
    lo = (f32x4){__uint_as_float(w.x << 16), __uint_as_float(w.x & 0xffff0000u), __uint_as_float(w.y << 16), __uint_as_float(w.y & 0xffff0000u)};
    hi = (f32x4){__uint_as_float(w.z << 16), __uint_as_float(w.z & 0xffff0000u), __uint_as_float(w.w << 16), __uint_as_float(w.w & 0xffff0000u)}; }
struct SkGateA { bf16* T; const bf16* G; int ldg; const float* bm;
    __device__ __forceinline__ void operator()(int row, int col, f32x4 v0, f32x4 v1) const {
        f32x4 g0, g1; sk_unpack8(*(const v4u*)(G + (size_t)row * ldg + col), g0, g1);
        const f32x4 b0 = *(const f32x4*)(bm + col), b1 = *(const f32x4*)(bm + col + 4);
#pragma unroll
        for (int j = 0; j < 4; ++j) { v0[j] *= sigmoidf_(g0[j] + b0[j]); v1[j] *= sigmoidf_(g1[j] + b1[j]); }
        v4u o; o.x = pk2(v0[0], v0[1]); o.y = pk2(v0[2], v0[3]); o.z = pk2(v1[0], v1[1]); o.w = pk2(v1[2], v1[3]);
        *(v4u*)(T + (size_t)row * 1024 + col) = o; } };
struct SkGateB { const bf16* T; bf16* U; const bf16* G; int ldg; const float* bm;
    __device__ __forceinline__ void operator()(int row, int col, f32x4 v0, f32x4 v1) const {
        f32x4 g0, g1; sk_unpack8(*(const v4u*)(G + (size_t)row * ldg + col), g0, g1);
        const f32x4 b0 = *(const f32x4*)(bm + col), b1 = *(const f32x4*)(bm + col + 4);
        f32x4 t0, t1; sk_unpack8(*(const v4u*)(T + (size_t)row * 1024 + col), t0, t1);
#pragma unroll
        for (int j = 0; j < 4; ++j) { v0[j] = t0[j] + v0[j] * sigmoidf_(g0[j] + b0[j]); v1[j] = t1[j] + v1[j] * sigmoidf_(g1[j] + b1[j]); }
        v4u o; o.x = pk2(v0[0], v0[1]); o.y = pk2(v0[2], v0[3]); o.z = pk2(v1[0], v1[1]); o.w = pk2(v1[2], v1[3]);
        *(v4u*)(U + (size_t)row * 1024 + col) = o; } };
struct SkRes { bf16* X; const float* gate; int ldgate;
    __device__ __forceinline__ void operator()(int row, int col, f32x4 v0, f32x4 v1) const {
        const float* gp = gate + (size_t)row * ldgate + col; bf16* xp = X + (size_t)row * 1024 + col;
        f32x4 x0, x1; sk_unpack8(*(const v4u*)xp, x0, x1);
        const f32x4 o0 = x0 + *(const f32x4*)gp * v0, o1 = x1 + *(const f32x4*)(gp + 4) * v1;
        v4u o; o.x = pk2(o0[0], o0[1]); o.y = pk2(o0[2], o0[3]); o.z = pk2(o1[0], o1[1]); o.w = pk2(o1[2], o1[3]); *(v4u*)xp = o; } };

template <int TB>
__device__ __forceinline__ void hgrn_seq(const bf16* proj, const float* lbs_l, const float* hgn_l, const float* state_in, float* state_out, bf16* ohg, int row_base, int T, int bh, int tid,
                                         LAS unsigned char* smem) {
    const int b = bh >> 3, h = bh & 7, lane = tid & 63, wv = tid >> 6;
    typedef float (LAS * arr_t)[128];
    arr_t sQ = (arr_t)(smem), sG = (arr_t)(smem + TB * 512), sK = (arr_t)(smem + 2 * TB * 512);
    LAS float* sRed = (LAS float*)(smem + 3 * TB * 512);
    float S[128];
    if (state_in) {
        const float* sp = state_in + (size_t)bh * 16384 + tid;
#pragma unroll
        for (int c = 0; c < 16; ++c) { asm volatile("" : "+v"(sp));
#pragma unroll
            for (int j = 0; j < 8; ++j) S[c * 8 + j] = sp[j * 128];
            sp += 1024; }
    } else {
#pragma unroll
        for (int d = 0; d < 128; ++d) S[d] = 0.f;
    }
    const float lb = lbs_l[h * 128 + tid], hn = hgn_l[tid];
    for (int t0 = 0; t0 < T; t0 += TB) {
        float v[TB], og[TB], o[TB];
#pragma unroll
        for (int tt = 0; tt < TB; ++tt) { v[tt] = 0.f; og[tt] = 0.f;
            if (t0 + tt < T) { const bf16* pr = proj + (size_t)(row_base + b * T + t0 + tt) * LDP + h * 128 + tid;
                const float q = bf2f(pr[PC_Q]), f = bf2f(pr[PC_F]); v[tt] = bf2f(pr[PC_I + hg_vpos(tid) - tid]); og[tt] = bf2f(pr[PC_OG]);
                const float fg = lb + (1.f - lb) * sigmoidf_(f);
                sQ[tt][tid] = siluf_(q) * 0.08838834764831845f; sG[tt][tid] = fg; sK[tt][tid] = 1.f - fg; } }
        __syncthreads();
#pragma unroll
        for (int tt = 0; tt < TB; ++tt) { float acc = 0.f;
            if (t0 + tt < T) { const float vv = v[tt];
#pragma unroll
                for (int d4 = 0; d4 < 32; ++d4) { const f32x4 g = *(const LAS f32x4*)&sG[tt][d4 * 4], k = *(const LAS f32x4*)&sK[tt][d4 * 4], q = *(const LAS f32x4*)&sQ[tt][d4 * 4];
                    S[d4 * 4 + 0] = g.x * S[d4 * 4 + 0] + k.x * vv; acc += q.x * S[d4 * 4 + 0];
                    S[d4 * 4 + 1] = g.y * S[d4 * 4 + 1] + k.y * vv; acc += q.y * S[d4 * 4 + 1];
                    S[d4 * 4 + 2] = g.z * S[d4 * 4 + 2] + k.z * vv; acc += q.z * S[d4 * 4 + 2];
                    S[d4 * 4 + 3] = g.w * S[d4 * 4 + 3] + k.w * vv; acc += q.w * S[d4 * 4 + 3]; } }
            o[tt] = acc;
            const float ss = wave_sum(acc * acc); if (lane == 0) sRed[tt * 2 + wv] = ss; }
        __syncthreads();
#pragma unroll
        for (int tt = 0; tt < TB; ++tt) if (t0 + tt < T) { const float rstd = rsqrtf((sRed[tt * 2] + sRed[tt * 2 + 1]) * (1.f / 128.f) + EPS);
            ohg[(size_t)(row_base + b * T + t0 + tt) * 1024 + h * 128 + tid] = f2bf(o[tt] * rstd * hn * siluf_(og[tt])); }
        __syncthreads();
    }
    { float* sp = state_out + (size_t)bh * 16384 + tid;
#pragma unroll
      for (int c = 0; c < 16; ++c) { asm volatile("" : "+v"(sp));
#pragma unroll
          for (int j = 0; j < 8; ++j) sp[j * 128] = S[c * 8 + j];
          sp += 1024; } }
}

template <int TB>
__device__ __forceinline__ void ssd_seq(const bf16* proj, const float* conv_w, const float* conv_b, const float* dt_bias, const float* a_log, const float* d_skip, const float* ssm_norm,
                                        const float* state_in, const float* conv_in, float* state_out, float* conv_out, bf16* ybuf, int row_base, int T, int bg, int tid, LAS unsigned char* smem) {
    const int b = bg >> 3, g = bg & 7, lane = tid & 63, wv = tid >> 6, head = g * 4 + wv;
    const int ch_x = g * 256 + tid, ch_bc = tid < 128 ? (2048 + g * 128 + tid) : (3072 + g * 128 + (tid - 128));
    typedef float (LAS * arr_t)[128];
    arr_t sB = (arr_t)(smem), sC = (arr_t)(smem + TB * 512);
    LAS float* sRed = (LAS float*)(smem + 2 * TB * 512);
    const float wx0 = conv_w[0 * 4096 + ch_x], wx1 = conv_w[1 * 4096 + ch_x], wx2 = conv_w[2 * 4096 + ch_x], wx3 = conv_w[3 * 4096 + ch_x], bx = conv_b[ch_x];
    const float wb0 = conv_w[0 * 4096 + ch_bc], wb1 = conv_w[1 * 4096 + ch_bc], wb2 = conv_w[2 * 4096 + ch_bc], wb3 = conv_w[3 * 4096 + ch_bc], bb = conv_b[ch_bc];
    float rx0 = 0.f, rx1 = 0.f, rx2 = 0.f, rb0 = 0.f, rb1 = 0.f, rb2 = 0.f;
    if (conv_in) { const float* ci = conv_in + (size_t)b * 3 * 4096; rx0 = ci[ch_x]; rx1 = ci[4096 + ch_x]; rx2 = ci[8192 + ch_x]; rb0 = ci[ch_bc]; rb1 = ci[4096 + ch_bc]; rb2 = ci[8192 + ch_bc]; }
    float hs[128];
    const size_t sbase = (((size_t)b * 32 + head) * 64 + lane) * 128;
    if (state_in) {
#pragma unroll
        for (int n4 = 0; n4 < 32; ++n4) { const f32x4 t = *(const f32x4*)(state_in + sbase + n4 * 4); hs[n4 * 4] = t.x; hs[n4 * 4 + 1] = t.y; hs[n4 * 4 + 2] = t.z; hs[n4 * 4 + 3] = t.w; }
    } else {
#pragma unroll
        for (int n = 0; n < 128; ++n) hs[n] = 0.f;
    }
    const float A = -expf(a_log[head]), dtb = dt_bias[head], Dk = d_skip[head], nw = ssm_norm[ch_x];
    for (int t0 = 0; t0 < T; t0 += TB) {
        float xc[TB], dtv[TB], dec[TB], zz[TB], yv[TB];
#pragma unroll
        for (int tt = 0; tt < TB; ++tt) { xc[tt] = 0.f; dtv[tt] = 0.f; dec[tt] = 1.f; zz[tt] = 0.f;
            if (t0 + tt < T) { const bf16* pr = proj + (size_t)(row_base + b * T + t0 + tt) * LDP;
                const float cx = bf2f(pr[PC_XBC + ch_x]), cb = bf2f(pr[PC_XBC + ch_bc]);
                const float ax = bx + wx0 * rx0 + wx1 * rx1 + wx2 * rx2 + wx3 * cx; rx0 = rx1; rx1 = rx2; rx2 = cx; xc[tt] = siluf_(ax);
                const float ab = bb + wb0 * rb0 + wb1 * rb1 + wb2 * rb2 + wb3 * cb; rb0 = rb1; rb1 = rb2; rb2 = cb;
                const float sbv = siluf_(ab); if (tid < 128) sB[tt][tid] = sbv; else sC[tt][tid - 128] = sbv;
                const float dv = softplusf_(bf2f(pr[PC_DT + head]) + dtb); dtv[tt] = dv; dec[tt] = __expf(dv * A); zz[tt] = bf2f(pr[PC_Z + ch_x]); } }
        __syncthreads();
#pragma unroll
        for (int tt = 0; tt < TB; ++tt) { float y = 0.f;
            if (t0 + tt < T) { const float xdt = xc[tt] * dtv[tt], dc = dec[tt];
#pragma unroll
                for (int n4 = 0; n4 < 32; ++n4) { const f32x4 bv = *(const LAS f32x4*)&sB[tt][n4 * 4], cv = *(const LAS f32x4*)&sC[tt][n4 * 4];
                    hs[n4 * 4 + 0] = dc * hs[n4 * 4 + 0] + xdt * bv.x; y += hs[n4 * 4 + 0] * cv.x;
                    hs[n4 * 4 + 1] = dc * hs[n4 * 4 + 1] + xdt * bv.y; y += hs[n4 * 4 + 1] * cv.y;
                    hs[n4 * 4 + 2] = dc * hs[n4 * 4 + 2] + xdt * bv.z; y += hs[n4 * 4 + 2] * cv.z;
                    hs[n4 * 4 + 3] = dc * hs[n4 * 4 + 3] + xdt * bv.w; y += hs[n4 * 4 + 3] * cv.w; }
                y = (y + Dk * xc[tt]) * siluf_(zz[tt]); }
            yv[tt] = y;
            const float ss = wave_sum(y * y); if (lane == 0) sRed[tt * 4 + wv] = ss; }
        __syncthreads();
#pragma unroll
        for (int tt = 0; tt < TB; ++tt) if (t0 + tt < T) { const float rstd = rsqrtf(((sRed[tt * 4] + sRed[tt * 4 + 1]) + (sRed[tt * 4 + 2] + sRed[tt * 4 + 3])) * (1.f / 256.f) + EPS);
            ybuf[(size_t)(row_base + b * T + t0 + tt) * 2048 + ch_x] = f2bf(yv[tt] * rstd * nw); }
        __syncthreads();
    }
#pragma unroll
    for (int n4 = 0; n4 < 32; ++n4) *(f32x4*)(state_out + sbase + n4 * 4) = (f32x4){hs[n4 * 4], hs[n4 * 4 + 1], hs[n4 * 4 + 2], hs[n4 * 4 + 3]};
    float* co = conv_out + (size_t)b * 3 * 4096;
    co[ch_x] = rx0; co[4096 + ch_x] = rx1; co[8192 + ch_x] = rx2; co[ch_bc] = rb0; co[4096 + ch_bc] = rb1; co[8192 + ch_bc] = rb2;
}

#ifndef REP_G
#define REP_G 1
#endif
#ifndef REP_R2
#define REP_R2 1
#endif
#ifndef REP_R1
#define REP_R1 1
#endif
#ifndef REP_N
#define REP_N 1
#endif
#ifndef REP_P
#define REP_P 1
#endif
#ifndef REP_H2
#define REP_H2 1
#endif
#ifndef REP_S2
#define REP_S2 1
#endif
#ifndef REP_S1
#define REP_S1 1
#endif
#ifndef REP_SS
#define REP_SS 1
#endif
#ifndef REP_BAR
#define REP_BAR 0
#endif
__device__ __forceinline__ void phase_recur1(const P& p, int l, LAS unsigned char* lds, int tid_in, int skip_hgrn1) {
    unsigned char* ws = p.ws; asm volatile("" : "+s"(ws)); int tid_ = tid_in; asm volatile("" : "+v"(tid_)); const int tid = tid_, G = gridDim.x, wg = blockIdx.x;
    RecurBufs rb{(bf16*)(ws + WS_PROJ), (bf16*)(ws + WS_XBCC), (float*)(ws + WS_DTV), (float*)(ws + WS_CUM), (float*)(ws + WS_CV), (float*)(ws + WS_SSEG), (float*)(ws + WS_DSEG),
                 (float*)(ws + WS_HSEG), (float*)(ws + WS_TSEG), (bf16*)(ws + WS_OHG), (bf16*)(ws + WS_Y)};
    const float* lbs_l = (const float*)(ws + WS_LBS) + l * 1024; float* out = p.out;
    const float* hgn = p.in[I_HGN] + l * HG_DV;
    const float* cw = p.in[I_CONVW] + (size_t)l * 4 * SSM_CH; const float* cb = p.in[I_CONVB] + l * SSM_CH; const float* dtb = p.in[I_DTB] + l * SSM_HEADS;
    const float* alog = p.in[I_ALOG] + l * SSM_HEADS; const float* dsk = p.in[I_DSKIP] + l * SSM_HEADS; const float* ssmn = p.in[I_SSMN] + l * SSM_INNER;
#define TID_L() int tl_ = tid; asm volatile("" : "+v"(tl_)); const int t = tl_
#define R1_HG() do { if (!skip_hgrn1) for (int u = wg; u < 256; u += G) { TID_L(); hgrn_pass1(rb, lbs_l, u, t, lds); } } while (0)
#define R1_SD() do { for (int rep = 0; rep < REP_S1; ++rep) for (int u = wg; u < 256; u += G) { TID_L(); ssd_pass1(rb, cw, cb, dtb, alog, out + O_CVP + (size_t)l * NB * 3 * SSM_CH, u, t, lds); } } while (0)
#define R1_SAMPLE() do { for (int rep = 0; rep < REP_SS; ++rep) { \
        {   const float* shg = p.in[I_SHG] + (size_t)l * NSB * HG_H * HG_DK * HG_DV; f32x4 sa[8];        \
            if (wg < NSB * HG_H) { TID_L(); hgrn_sample_load(sa, shg, wg, t); } \
            for (int u = wg; u < NSB * HG_H; u += G) { TID_L(); const int un = u + G < NSB * HG_H ? u + G : -1; \
                hgrn_sample_step(rb.proj, lbs_l, hgn, shg, out + O_HGS + (size_t)l * NSB * HG_H * HG_DK * HG_DV, rb.ohg, u, t, lds, sa, un); } } \
        {   const float* sss = p.in[I_SSSM] + (size_t)l * NSB * SSM_HEADS * SSM_P * SSM_N; f32x4 sa[16]; \
            if (wg < NSB * SSM_G) { TID_L(); ssd_sample_load(sa, sss, wg, t); } \
            for (int u = wg; u < NSB * SSM_G; u += G) { TID_L(); const int un = u + G < NSB * SSM_G ? u + G : -1; \
                ssd_sample_step(rb.proj, cw, cb, dtb, alog, dsk, ssmn, sss, p.in[I_SCONV] + (size_t)l * NSB * 3 * SSM_CH, \
                                out + O_SSMS + (size_t)l * NSB * SSM_HEADS * SSM_P * SSM_N, out + O_CVS + (size_t)l * NSB * 3 * SSM_CH, rb.y, u, t, lds, sa, un); } } } } while (0)
    if (((wg >> 3) & 1) == 0) { R1_HG(); R1_SAMPLE(); R1_SD(); } else { R1_SD(); R1_HG(); R1_SAMPLE(); }
#undef R1_HG
#undef R1_SD
#undef R1_SAMPLE
}
__device__ __forceinline__ void phase_recur2(const P& p, int l, LAS unsigned char* lds, int tid_in) {
    unsigned char* ws = p.ws; asm volatile("" : "+s"(ws)); int tid_ = tid_in; asm volatile("" : "+v"(tid_)); const int tid = tid_, G = gridDim.x, wg = blockIdx.x;
    RecurBufs rb{(bf16*)(ws + WS_PROJ), (bf16*)(ws + WS_XBCC), (float*)(ws + WS_DTV), (float*)(ws + WS_CUM), (float*)(ws + WS_CV), (float*)(ws + WS_SSEG), (float*)(ws + WS_DSEG),
                 (float*)(ws + WS_HSEG), (float*)(ws + WS_TSEG), (bf16*)(ws + WS_OHG), (bf16*)(ws + WS_Y)};
    float* out = p.out;
    for (int rep = 0; rep < REP_H2; ++rep) for (int u = wg; u < 256; u += G) { TID_L(); hgrn_pass2(rb, p.in[I_HGN] + l * HG_DV, out + O_HGP + (size_t)l * NB * HG_H * HG_DK * HG_DV, u, t, lds); }
    for (int rep = 0; rep < REP_S2; ++rep) for (int u = wg; u < 256; u += G) { TID_L(); ssd_pass2(rb, p.in[I_DSKIP] + l * SSM_HEADS, p.in[I_SSMN] + l * SSM_INNER, out + O_SSMP + (size_t)l * NB * SSM_HEADS * SSM_P * SSM_N, u ^ 3, t, lds); }
}


constexpr int CW_BAR = 4096;
constexpr int MISC_OFF = LDS_BYTES - 256;

__global__ __launch_bounds__(NTHREADS, 2) void k_mega(P p) {
    extern __shared__ __attribute__((aligned(16))) unsigned char shm[];
    LAS unsigned char* lds = (LAS unsigned char*)shm;
    const int wave_u = __builtin_amdgcn_readfirstlane((int)threadIdx.x >> 6);
#define TID() ({ int t__; asm volatile("v_mbcnt_lo_u32_b32 %0, -1, 0\n\tv_mbcnt_hi_u32_b32 %0, -1, %0" : "=v"(t__)); (wave_u << 6) | t__; })
    const int G = gridDim.x, NGW = G * NWAVES;
    unsigned char* ws = p.ws;
#define LANE_GW() int t_ = TID(); asm volatile("" : "+v"(t_)); const int ln = t_ & 63, wv = __builtin_amdgcn_readfirstlane(t_ >> 6), gwv = blockIdx.x * NWAVES + wv; (void)wv
    volatile LAS unsigned* MISC = (volatile LAS unsigned*)(lds + MISC_OFF);
    if (TID() < 16) MISC[TID()] = 0u;
    __syncthreads();
    XcdBarrier bar = xcd_barrier_post((unsigned*)(ws + WS_CTL) + CW_BAR, MISC + 8, TID());
#define WSL() ({ unsigned char* w_ = ws; asm volatile("" : "+s"(w_)); w_; })

    for (int rep = 0; rep < REP_P; ++rep) {   LANE_GW(); phase_prologue(p, lds, gwv, NGW, ln, wv); }
    xcd_barrier(bar, TID());
    {   unsigned char* w = WSL();
        pg8::Gemm g{(const bf16*)(w + WS_AC), (const bf16*)(w + WS_WADA), 256, MODLD, D}; pg8::StaticOrder S; S.init(256, MODLD, G, (int)blockIdx.x);
        pg8::EpiF32 E{(float*)(w + WS_MOD), MODLD, p.in[I_BADA]};
        pg8::gemm_phase<pg8::EpiF32, pg8::StaticOrder>(lds, g, S, E, nullptr, TID()); }
    xcd_barrier(bar, TID());
    for (int li = 0; li < DEPTH; ++li) {
        int l = li; asm volatile("" : "+s"(l));
        for (int rep = 0; rep < REP_N; ++rep) {   unsigned char* w = WSL(); const float* mod_l = (const float*)(w + WS_MOD) + (size_t)l * NADA * D;
            LANE_GW();
            if (l == 0) phase_norm<1>(p.in[I_XP], p.in[I_XS], (bf16*)(w + WS_X), (bf16*)(w + WS_H), p.in[I_NMIX] + l * D, mod_l + 0 * D, mod_l + 1 * D, gwv, NGW, ln);
            else phase_norm<0>(nullptr, nullptr, (bf16*)(w + WS_X), (bf16*)(w + WS_H), p.in[I_NMIX] + l * D, mod_l + 0 * D, mod_l + 1 * D, gwv, NGW, ln); }
        xcd_barrier(bar, TID());
        for (int rep = 0; rep < REP_G; ++rep) { if (rep) xcd_barrier(bar, TID());
        {   unsigned char* w = WSL(); const unsigned char* wl = w + WS_W + (size_t)l * W_LSTRIDE;
            pg8::Gemm g{(const bf16*)(w + WS_H), (const bf16*)(wl + WO_IN), MP, LDP, D}; pg8::StaticOrder S; S.init(MP, LDP, G, (int)blockIdx.x);
            pg8::EpiBf16<0> E{(bf16*)(w + WS_PROJ), LDP};
            pg8::gemm_phase<pg8::EpiBf16<0>, pg8::StaticOrder>(lds, g, S, E, nullptr, TID());
            const int skf = G > 64 ? 64 : 0, skn = G > 64 ? G - 64 : G; skinny_gemm<8>((const bf16*)(w + WS_H) + (size_t)MP * D, D, (const bf16*)(wl + WO_IN), D, LDP, SkStoreBf16{(bf16*)(w + WS_PROJ) + (size_t)MP * LDP, LDP, 0}, (int)blockIdx.x, skf, skn, TID(), lds); } }
        xcd_barrier(bar, TID());
        for (int rep = 0; rep < REP_BAR; ++rep) xcd_barrier(bar, TID());
        phase_recur1(p, l, lds, TID(), 0);
        for (int rep = 1; rep < REP_R1; ++rep) { xcd_barrier(bar, TID()); phase_recur1(p, l, lds, TID(), 1); }
        xcd_barrier(bar, TID());
        for (int rep = 0; rep < REP_R2; ++rep) { if (rep) xcd_barrier(bar, TID()); phase_recur2(p, l, lds, TID()); }
        xcd_barrier(bar, TID());
        for (int rep = 0; rep < REP_G; ++rep) { if (rep) xcd_barrier(bar, TID());
        {   unsigned char* w = WSL(); const unsigned char* wl = w + WS_W + (size_t)l * W_LSTRIDE;
            pg8::Gemm g{(const bf16*)(w + WS_OHG), (const bf16*)(wl + WO_BRA), MP, D, 1024}; pg8::StaticOrder S; S.init(MP, D, G, (int)blockIdx.x);
            pg8::EpiGateA E{(bf16*)(w + WS_T), (const bf16*)(w + WS_PROJ) + PC_GA, LDP, p.in[I_BMERGE] + l * 2048};
            pg8::gemm_phase<pg8::EpiGateA, pg8::StaticOrder>(lds, g, S, E, nullptr, TID());
            skinny_gemm<1>((const bf16*)(w + WS_OHG) + (size_t)MP * D, D, (const bf16*)(wl + WO_BRA), 1024, D, SkGateA{(bf16*)(w + WS_T) + (size_t)MP * D, (const bf16*)(w + WS_PROJ) + (size_t)MP * LDP + PC_GA, LDP, p.in[I_BMERGE] + l * 2048}, (int)blockIdx.x, 0, G, TID(), lds); } }
        asm volatile("s_waitcnt vmcnt(0)" ::: "memory"); __syncthreads();
        for (int rep = 0; rep < REP_G; ++rep) { if (rep) xcd_barrier(bar, TID());
        {   unsigned char* w = WSL(); const unsigned char* wl = w + WS_W + (size_t)l * W_LSTRIDE;
            pg8::Gemm g{(const bf16*)(w + WS_Y), (const bf16*)(wl + WO_BRB), MP, D, 2048}; pg8::StaticOrder S; S.init(MP, D, G, (int)blockIdx.x);
            pg8::EpiGateB E{(const bf16*)(w + WS_T), (bf16*)(w + WS_U), (const bf16*)(w + WS_PROJ) + PC_GB, LDP, p.in[I_BMERGE] + l * 2048 + 1024};
            pg8::gemm_phase<pg8::EpiGateB, pg8::StaticOrder>(lds, g, S, E, nullptr, TID());
            skinny_gemm<1>((const bf16*)(w + WS_Y) + (size_t)MP * 2048, 2048, (const bf16*)(wl + WO_BRB), 2048, D, SkGateB{(const bf16*)(w + WS_T) + (size_t)MP * D, (bf16*)(w + WS_U) + (size_t)MP * D, (const bf16*)(w + WS_PROJ) + (size_t)MP * LDP + PC_GB, LDP, p.in[I_BMERGE] + l * 2048 + 1024}, (int)blockIdx.x, 0, G, TID(), lds); } }
        xcd_barrier(bar, TID());
        {   unsigned char* w = WSL(); const unsigned char* wl = w + WS_W + (size_t)l * W_LSTRIDE; const float* mod_l = (const float*)(w + WS_MOD) + (size_t)l * NADA * D;
            pg8::Gemm g{(const bf16*)(w + WS_U), (const bf16*)(wl + WO_OUT), MP, D, 1024}; pg8::StaticOrder S; S.init(MP, D, G, (int)blockIdx.x);
            pg8::EpiRes E{(bf16*)(w + WS_X), mod_l + 2 * D, MODLD};
            pg8::gemm_phase<pg8::EpiRes, pg8::StaticOrder>(lds, g, S, E, nullptr, TID());
            skinny_gemm<1>((const bf16*)(w + WS_U) + (size_t)MP * D, D, (const bf16*)(wl + WO_OUT), 1024, D, SkRes{(bf16*)(w + WS_X) + (size_t)MP * D, mod_l + (size_t)NB * MODLD + 2 * D, MODLD}, (int)blockIdx.x, 0, G, TID(), lds); }
        xcd_barrier(bar, TID());
        for (int rep = 0; rep < REP_N; ++rep) {   unsigned char* w = WSL(); const float* mod_l = (const float*)(w + WS_MOD) + (size_t)l * NADA * D;
            LANE_GW(); phase_norm<0>(nullptr, nullptr, (bf16*)(w + WS_X), (bf16*)(w + WS_H), p.in[I_NMLP] + l * D, mod_l + 3 * D, mod_l + 4 * D, gwv, NGW, ln); }
        xcd_barrier(bar, TID());
        for (int rep = 0; rep < REP_G; ++rep) { if (rep) xcd_barrier(bar, TID());
        {   unsigned char* w = WSL(); const unsigned char* wl = w + WS_W + (size_t)l * W_LSTRIDE;
            pg8::Gemm g{(const bf16*)(w + WS_H), (const bf16*)(wl + WO_UP), MP, DFF, 1024}; pg8::StaticOrder S; S.init(MP, DFF, G, (int)blockIdx.x);
            pg8::EpiBf16<1> E{(bf16*)(w + WS_UP), DFF};
            pg8::gemm_phase<pg8::EpiBf16<1>, pg8::StaticOrder>(lds, g, S, E, nullptr, TID());
            skinny_gemm<4>((const bf16*)(w + WS_H) + (size_t)MP * D, D, (const bf16*)(wl + WO_UP), 1024, DFF, SkStoreBf16{(bf16*)(w + WS_UP) + (size_t)MP * DFF, DFF, 1}, (int)blockIdx.x, 0, G, TID(), lds); } }
        xcd_barrier(bar, TID());
        {   unsigned char* w = WSL(); const unsigned char* wl = w + WS_W + (size_t)l * W_LSTRIDE; const float* mod_l = (const float*)(w + WS_MOD) + (size_t)l * NADA * D;
            pg8::Gemm g{(const bf16*)(w + WS_UP), (const bf16*)(wl + WO_DOWN), MP, D, DFF}; pg8::StaticOrder S; S.init(MP, D, G, (int)blockIdx.x);
            pg8::EpiRes E{(bf16*)(w + WS_X), mod_l + 5 * D, MODLD};
            pg8::gemm_phase<pg8::EpiRes, pg8::StaticOrder>(lds, g, S, E, nullptr, TID());
            skinny_gemm<1>((const bf16*)(w + WS_UP) + (size_t)MP * DFF, DFF, (const bf16*)(wl + WO_DOWN), DFF, D, SkRes{(bf16*)(w + WS_X) + (size_t)MP * D, mod_l + (size_t)NB * MODLD + 5 * D, MODLD}, (int)blockIdx.x, 0, G, TID(), lds); }
        xcd_barrier(bar, TID());
    }
    {   unsigned char* w = WSL(); LANE_GW(); phase_final((const bf16*)(w + WS_X), p.out + O_YP, p.in[I_NFIN], gwv, NGW, ln); }
}

extern "C" void kernel_launch(void* const* d_in, const int* in_sizes, int n_in, void* d_out, int out_size, void* d_ws, size_t ws_size, hipStream_t stream) {
    static int grid = 0;
    if (grid == 0) {
        if (n_in != N_IN || (size_t)out_size != O_END || ws_size < WS_END) { fprintf(stderr, "kernel_launch: unexpected sizes n_in %d out %d ws %zu\n", n_in, out_size, ws_size); grid = -1; return; }
        int dev = 0, cus = 0, per_cu = 0;
        if (hipGetDevice(&dev) != hipSuccess || hipDeviceGetAttribute(&cus, hipDeviceAttributeMultiprocessorCount, dev) != hipSuccess) { grid = -1; return; }
        if (hipFuncSetAttribute((const void*)k_mega, hipFuncAttributeMaxDynamicSharedMemorySize, LDS_BYTES) != hipSuccess) { fprintf(stderr, "kernel_launch: hipFuncSetAttribute failed\n"); grid = -1; return; }
        if (hipOccupancyMaxActiveBlocksPerMultiprocessor(&per_cu, (const void*)k_mega, NTHREADS, LDS_BYTES) != hipSuccess || per_cu < 1)
            fprintf(stderr, "kernel_launch: note: occupancy query reports %d workgroups per CU\n", per_cu);
        (void)hipGetLastError();
        grid = cus;
    }
    if (grid < 0) return;
    if (hipMemsetAsync((char*)d_ws + WS_CTL, 0, CTL_ZERO_BYTES, stream) != hipSuccess) return;
    P p{};
    for (int i = 0; i < N_IN; ++i) p.in[i] = (const float*)d_in[i];
    p.out = (float*)d_out; p.ws = (unsigned char*)d_ws;
    hipLaunchKernelGGL(k_mega, dim3(grid), dim3(NTHREADS), LDS_BYTES, stream, p);
}
```

```cpp
#include <hip/hip_runtime.h>
#include <cstdio>
#include <cstdint>

constexpr int D = 1024, NB = 8, SEQ = 2048, DEPTH = 4, NSB = 128;
constexpr int MP = NB * SEQ;
constexpr int MS = NSB;
constexpr int MR = MP + MS;
constexpr int MT = 16640;
constexpr int HG_H = 8, HG_DK = 128, HG_DV = 128;
constexpr int SSM_INNER = 2048, SSM_P = 64, SSM_HEADS = 32, SSM_G = 8, SSM_HPG = 4, SSM_N = 128, SSM_CH = 4096;
constexpr int DFF = 4096, NADA = 6;
constexpr int IN_WIDTH = 12320;
constexpr int LDP = 12544;
constexpr int PC_Q = 0, PC_F = 1024, PC_I = 2048, PC_OG = 3072, PC_Z = 4096, PC_XBC = 6144, PC_GA = 10240, PC_GB = 11264, PC_DT = 12288;
constexpr int NCOND = NB + NSB;
constexpr int MODLD = DEPTH * NADA * D;
constexpr float EPS = 1e-6f;

enum { I_XP = 0, I_XS, I_SHG, I_SSSM, I_SCONV, I_CP, I_CS, I_WADA, I_BADA, I_NMIX, I_WIN, I_BMERGE, I_LB, I_HGN, I_CONVW, I_CONVB, I_DTB, I_ALOG, I_DSKIP,
       I_SSMN, I_WBRA, I_WBRB, I_WOUT, I_NMLP, I_WUP, I_WDOWN, I_NFIN, N_IN };

constexpr size_t O_YP = 0;
constexpr size_t O_YS = O_YP + (size_t)MP * D;
constexpr size_t O_HGP = O_YS + (size_t)MS * D;
constexpr size_t O_SSMP = O_HGP + (size_t)DEPTH * NB * HG_H * HG_DK * HG_DV;
constexpr size_t O_CVP = O_SSMP + (size_t)DEPTH * NB * SSM_HEADS * SSM_P * SSM_N;
constexpr size_t O_HGS = O_CVP + (size_t)DEPTH * NB * 3 * SSM_CH;
constexpr size_t O_SSMS = O_HGS + (size_t)DEPTH * NSB * HG_H * HG_DK * HG_DV;
constexpr size_t O_CVS = O_SSMS + (size_t)DEPTH * NSB * SSM_HEADS * SSM_P * SSM_N;
constexpr size_t O_END = O_CVS + (size_t)DEPTH * NSB * 3 * SSM_CH;

constexpr size_t MiB = 1u << 20;
constexpr size_t WS_CTL = 0, CTL_ZERO_BYTES = 1 * MiB;
constexpr size_t WS_LBS = 1 * MiB;
constexpr size_t WS_AC = 2 * MiB;
constexpr size_t WS_MOD = 3 * MiB;
constexpr size_t WS_WADA = 32 * MiB;
constexpr size_t WS_W = 80 * MiB, W_LSTRIDE = 49 * MiB;
constexpr size_t WO_IN = 0, WO_BRA = 24 * MiB + MiB / 2, WO_BRB = WO_BRA + 2 * MiB, WO_OUT = WO_BRB + 4 * MiB, WO_UP = WO_OUT + 2 * MiB, WO_DOWN = WO_UP + 8 * MiB;
constexpr size_t WS_X = 276 * MiB;
constexpr size_t WS_H = 341 * MiB;
constexpr size_t WS_PROJ = 374 * MiB;
constexpr size_t WS_OHG = 773 * MiB;
constexpr size_t WS_Y = 806 * MiB;
constexpr size_t WS_T = 871 * MiB;
constexpr size_t WS_U = 936 * MiB;
constexpr size_t WS_UP = 969 * MiB;
constexpr size_t WS_XBCC = 1100 * MiB;
constexpr size_t WS_DTV = 1230 * MiB, WS_CUM = 1232 * MiB;
constexpr size_t WS_CV = 1234 * MiB;
constexpr size_t WS_SSEG = 1238 * MiB;
constexpr size_t WS_DSEG = 1254 * MiB;
constexpr size_t WS_HSEG = 1255 * MiB;
constexpr size_t WS_TSEG = 1287 * MiB;
constexpr size_t WS_END = 1288 * MiB;
static_assert(WO_DOWN + 8 * MiB <= W_LSTRIDE && (size_t)LDP * D * 2 <= WO_BRA, "weight map");
static_assert(WS_W + 4 * W_LSTRIDE <= WS_X && WS_X + (size_t)MT * D * 4 <= WS_H && WS_H + (size_t)MT * D * 2 <= WS_PROJ && WS_PROJ + (size_t)MT * LDP * 2 <= WS_OHG, "ws map 1");
static_assert(WS_OHG + (size_t)MT * D * 2 <= WS_Y && WS_Y + (size_t)MT * 2048 * 2 <= WS_T && WS_T + (size_t)MT * D * 4 <= WS_U && WS_U + (size_t)MT * D * 2 <= WS_UP && WS_UP + (size_t)MT * DFF * 2 <= WS_XBCC && WS_XBCC + (size_t)MT * 4096 * 2 <= WS_DTV, "ws map 2");
static_assert(WS_MOD + (size_t)256 * MODLD * 4 <= WS_WADA && WS_WADA + (size_t)MODLD * D * 2 <= WS_W, "ws map 0");

typedef unsigned short bf16;
__device__ __forceinline__ float bf2f(bf16 v) { return __uint_as_float(((unsigned)v) << 16); }
__device__ __forceinline__ unsigned pk2(float lo, float hi) { unsigned r; asm("v_cvt_pk_bf16_f32 %0, %1, %2" : "=v"(r) : "v"(lo), "v"(hi)); return r; }
__device__ __forceinline__ bf16 f2bf(float f) { return (bf16)pk2(f, f); }
__device__ __forceinline__ float frcp_(float x) { return __builtin_amdgcn_rcpf(x); }
__device__ __forceinline__ float sigmoidf_(float x) { return frcp_(1.0f + __expf(-x)); }
__device__ __forceinline__ float siluf_(float x) { return x * frcp_(1.0f + __expf(-x)); }
__device__ __forceinline__ float softplusf_(float x) { return x > 20.f ? x : log1pf(__expf(x)); }
__host__ __device__ __forceinline__ int cidx_of_row(int row) { return row < MP ? (row >> 11) : ((row - MP + NB) < NCOND ? (row - MP + NB) : (NCOND - 1)); }
__host__ __device__ __forceinline__ int hg_vpos(int e) { return (e & 64) + 16 * (e & 3) + ((e & 63) >> 2); }

namespace pg8 {
#define PG8_LAS __attribute__((address_space(3)))
typedef unsigned short bf16_t;
typedef short bf16x8 __attribute__((ext_vector_type(8)));
typedef float f32x4 __attribute__((ext_vector_type(4)));
typedef unsigned u32x4 __attribute__((ext_vector_type(4)));
constexpr int BM = 256, BK = 64, HALF = 128, HTB = HALF * BK * 2  , STAGE_BYTES = 8 * HTB, NXCD = 8, WGM = 4;

__host__ __device__ __forceinline__ int lds_byte(int r, int c) { const int st = (r >> 4) * 2 + (c >> 5), rr = r & 15, cc = c & 31, ob = rr * 64 + cc * 2; return st * 1024 + (ob ^ (((ob >> 9) & 1) << 5)); }
__host__ __device__ __forceinline__ void stage_rc(int b, int& R, int& C) { const int st = b / 1024, sb = b % 1024, swz = sb ^ (((sb >> 9) & 1) << 5); R = (st >> 1) * 16 + swz / 64; C = (st & 1) * 32 + (swz % 64) / 2; }
__host__ __device__ __forceinline__ int perm32(int rho) { const int n = rho >> 4, i = rho & 15; return 8 * (i >> 2) + 4 * n + (i & 3); }

struct Unit { int pm, pn; };
struct Gemm { const bf16_t* A; const bf16_t* Bt; int M, N, K; };

struct StaticOrder {
    int nM, nN, nwg, G, c;
    __host__ __device__ void init(int M, int N, int G_, int c_) { nM = M / BM; nN = N / BM; nwg = nM * nN; G = G_; c = c_; }
    __host__ __device__ bool next(int i, Unit& u) const {
        const long L = (long)i * G + c; if (L >= nwg) return false;
        int wgid = (int)L; { const int q = nwg / NXCD, r = nwg % NXCD, xcd = wgid % NXCD, off = wgid / NXCD; wgid = (xcd < r ? xcd * (q + 1) : r * (q + 1) + (xcd - r) * q) + off; }
        const int nig = WGM * nN, gid = wgid / nig, fm = gid * WGM, gsz = (nM - fm) < WGM ? (nM - fm) : WGM;
        u.pm = fm + ((wgid % nig) % gsz); u.pn = (wgid % nig) / gsz; return true;
    }
    __device__ __forceinline__ void a_ready(const Unit&) const {}
    __device__ __forceinline__ void done(const Unit&) const {}
};
__device__ __forceinline__ unsigned cvt_pk_bf16(float lo, float hi) { unsigned r; asm volatile("v_cvt_pk_bf16_f32 %0, %1, %2" : "=v"(r) : "v"(lo), "v"(hi)); return r; }
__device__ __forceinline__ float ep_sigmoid(float x) { return __builtin_amdgcn_rcpf(1.0f + __expf(-x)); }
__device__ __forceinline__ void unpack8(const u32x4 w, f32x4& lo, f32x4& hi) {
    lo = (f32x4){__uint_as_float(w.x << 16), __uint_as_float(w.x & 0xffff0000u), __uint_as_float(w.y << 16), __uint_as_float(w.y & 0xffff0000u)};
    hi = (f32x4){__uint_as_float(w.z << 16), __uint_as_float(w.z & 0xffff0000u), __uint_as_float(w.w << 16), __uint_as_float(w.w & 0xffff0000u)};
}

struct EpiF32 {
    static constexpr bool PERM = false, AFTER_DRAIN = false;
    float* C; int ldc; const float* bias;
    __device__ __forceinline__ void operator()(const f32x4 (&acc)[2][2][4][2], const Unit& u, int wr, int wc, int fr, int fq) const {
        const int row0 = u.pm * BM + wr * 64 + fr, col0 = u.pn * BM + wc * 32 + 4 * fq;
        f32x4 bv[2][2];
#pragma unroll
        for (int bj = 0; bj < 2; ++bj)
#pragma unroll
            for (int n = 0; n < 2; ++n) bv[bj][n] = *(const f32x4*)(bias + col0 + bj * HALF + n * 16);
#pragma unroll
        for (int ai = 0; ai < 2; ++ai)
#pragma unroll
            for (int m = 0; m < 4; ++m) { float* rowp = C + (size_t)(row0 + ai * HALF + m * 16) * ldc + col0;
#pragma unroll
                for (int bj = 0; bj < 2; ++bj)
#pragma unroll
                    for (int n = 0; n < 2; ++n) *(f32x4*)(rowp + bj * HALF + n * 16) = acc[ai][bj][m][n] + bv[bj][n]; }
    }
};
template <int ACT  > struct EpiBf16 {
    static constexpr bool PERM = true, AFTER_DRAIN = false;
    bf16_t* O; int ldc;
    __device__ __forceinline__ void operator()(const f32x4 (&acc)[2][2][4][2], const Unit& u, int wr, int wc, int fr, int fq) const {
        const int lane = fr + 16 * fq, r2 = lane >> 2, q2 = lane & 3;
        const int src4 = (r2 + 16 * q2) << 2;
        const int row0 = u.pm * BM + wr * 64 + r2; const int col0 = u.pn * BM + wc * 32 + 8 * q2;
#pragma unroll
        for (int ai = 0; ai < 2; ++ai)
#pragma unroll
            for (int m = 0; m < 4; ++m) { bf16_t* rowp = O + (size_t)(row0 + ai * HALF + m * 16) * ldc + col0;
#pragma unroll
                for (int bj = 0; bj < 2; ++bj) { f32x4 v0 = acc[ai][bj][m][0], v1 = acc[ai][bj][m][1];
                    if (ACT == 1) {
#pragma unroll
                        for (int j = 0; j < 4; ++j) { const float a = fmaxf(v0[j], 0.f), b = fmaxf(v1[j], 0.f); v0[j] = a * a; v1[j] = b * b; } }
                    u32x4 w; w.x = cvt_pk_bf16(v0[0], v0[1]); w.y = cvt_pk_bf16(v0[2], v0[3]); w.z = cvt_pk_bf16(v1[0], v1[1]); w.w = cvt_pk_bf16(v1[2], v1[3]);
                    w.x = (unsigned)__builtin_amdgcn_ds_bpermute(src4, (int)w.x); w.y = (unsigned)__builtin_amdgcn_ds_bpermute(src4, (int)w.y);
                    w.z = (unsigned)__builtin_amdgcn_ds_bpermute(src4, (int)w.z); w.w = (unsigned)__builtin_amdgcn_ds_bpermute(src4, (int)w.w);
                    *(u32x4*)(rowp + bj * HALF) = w; } }
    }
};
struct EpiGateA {
    static constexpr bool PERM = true, AFTER_DRAIN = false;
    bf16_t* T; const bf16_t* G; int ldg; const float* bm;
    __device__ __forceinline__ void operator()(const f32x4 (&acc)[2][2][4][2], const Unit& u, int wr, int wc, int fr, int fq) const {
        const int row0 = u.pm * BM + wr * 64 + fr; const int col0 = u.pn * BM + wc * 32 + 8 * fq;
        f32x4 bv[2][2];
#pragma unroll
        for (int bj = 0; bj < 2; ++bj)
#pragma unroll
            for (int n = 0; n < 2; ++n) bv[bj][n] = *(const f32x4*)(bm + col0 + bj * HALF + 4 * n);
#pragma unroll
        for (int ai = 0; ai < 2; ++ai)
#pragma unroll
            for (int m = 0; m < 4; ++m) { const size_t row = (size_t)(row0 + ai * HALF + m * 16);
#pragma unroll
                for (int bj = 0; bj < 2; ++bj) {
                    const u32x4 gw = *(const u32x4*)(G + row * ldg + col0 + bj * HALF); f32x4 g0, g1; unpack8(gw, g0, g1);
                    f32x4 o0, o1;
#pragma unroll
                    for (int j = 0; j < 4; ++j) { o0[j] = ep_sigmoid(g0[j] + bv[bj][0][j]) * acc[ai][bj][m][0][j]; o1[j] = ep_sigmoid(g1[j] + bv[bj][1][j]) * acc[ai][bj][m][1][j]; }
                    u32x4 w; w.x = cvt_pk_bf16(o0[0], o0[1]); w.y = cvt_pk_bf16(o0[2], o0[3]); w.z = cvt_pk_bf16(o1[0], o1[1]); w.w = cvt_pk_bf16(o1[2], o1[3]);
                    *(u32x4*)(T + row * 1024 + col0 + bj * HALF) = w; } }
    }
};
struct EpiGateB {
    static constexpr bool PERM = true, AFTER_DRAIN = false;
    const bf16_t* T; bf16_t* U; const bf16_t* G; int ldg; const float* bm;
    __device__ __forceinline__ void operator()(const f32x4 (&acc)[2][2][4][2], const Unit& u, int wr, int wc, int fr, int fq) const {
        const int row0 = u.pm * BM + wr * 64 + fr; const int col0 = u.pn * BM + wc * 32 + 8 * fq;
        f32x4 bv[2][2];
#pragma unroll
        for (int bj = 0; bj < 2; ++bj)
#pragma unroll
            for (int n = 0; n < 2; ++n) bv[bj][n] = *(const f32x4*)(bm + col0 + bj * HALF + 4 * n);
#pragma unroll
        for (int ai = 0; ai < 2; ++ai)
#pragma unroll
            for (int m = 0; m < 4; ++m) { const size_t row = (size_t)(row0 + ai * HALF + m * 16);
#pragma unroll
                for (int bj = 0; bj < 2; ++bj) {
                    const u32x4 gw = *(const u32x4*)(G + row * ldg + col0 + bj * HALF); f32x4 g0, g1; unpack8(gw, g0, g1);
                    f32x4 t0, t1; unpack8(*(const u32x4*)(T + row * 1024 + col0 + bj * HALF), t0, t1);
                    f32x4 o0, o1;
#pragma unroll
                    for (int j = 0; j < 4; ++j) { o0[j] = t0[j] + ep_sigmoid(g0[j] + bv[bj][0][j]) * acc[ai][bj][m][0][j]; o1[j] = t1[j] + ep_sigmoid(g1[j] + bv[bj][1][j]) * acc[ai][bj][m][1][j]; }
                    u32x4 w; w.x = cvt_pk_bf16(o0[0], o0[1]); w.y = cvt_pk_bf16(o0[2], o0[3]); w.z = cvt_pk_bf16(o1[0], o1[1]); w.w = cvt_pk_bf16(o1[2], o1[3]);
                    *(u32x4*)(U + row * 1024 + col0 + bj * HALF) = w; } }
    }
};
struct EpiRes {
    static constexpr bool PERM = true, AFTER_DRAIN = false;
    bf16_t* X; const float* gate; int ldgate;
    __device__ __forceinline__ void operator()(const f32x4 (&acc)[2][2][4][2], const Unit& u, int wr, int wc, int fr, int fq) const {
        const int row0 = u.pm * BM + wr * 64 + fr, col0 = u.pn * BM + wc * 32 + 8 * fq;
        const float* gp = gate + (size_t)((u.pm * BM) >> 11) * ldgate + col0;
        f32x4 gv[2][2];
#pragma unroll
        for (int bj = 0; bj < 2; ++bj)
#pragma unroll
            for (int n = 0; n < 2; ++n) gv[bj][n] = *(const f32x4*)(gp + bj * HALF + 4 * n);
#pragma unroll
        for (int ai = 0; ai < 2; ++ai)
#pragma unroll
            for (int m = 0; m < 4; ++m) { bf16_t* xp = X + (size_t)(row0 + ai * HALF + m * 16) * 1024 + col0;
#pragma unroll
                for (int bj = 0; bj < 2; ++bj) { const u32x4 xw = *(const u32x4*)(xp + bj * HALF); f32x4 x0, x1; unpack8(xw, x0, x1);
                    const f32x4 o0 = x0 + gv[bj][0] * acc[ai][bj][m][0], o1 = x1 + gv[bj][1] * acc[ai][bj][m][1];
                    u32x4 ow; ow.x = cvt_pk_bf16(o0[0], o0[1]); ow.y = cvt_pk_bf16(o0[2], o0[3]); ow.z = cvt_pk_bf16(o1[0], o1[1]); ow.w = cvt_pk_bf16(o1[2], o1[3]);
                    *(u32x4*)(xp + bj * HALF) = ow; } }
    }
};


#ifndef GEMM_ALIGN
#define GEMM_ALIGN true
#endif
#ifndef GEMM_SP2
#define GEMM_SP2 true
#endif
template <class Epi, class Sched, bool ALIGN_EPI = GEMM_ALIGN, bool SP2 = GEMM_SP2>
__device__ __forceinline__ void gemm_phase(PG8_LAS unsigned char* lds, const Gemm g, const Sched& S, const Epi& E, unsigned long long*  , int tid_in) {
    int tid_ = tid_in; asm volatile("" : "+v"(tid_));
    const int tid = tid_, wid = __builtin_amdgcn_readfirstlane(tid >> 6), lane = tid & 63, wr = wid >> 2, wc = wid & 3, fr = lane & 15, fq = lane >> 4;
    const int K = g.K, nt = K / BK;
    unsigned voffA[2], voffB[2];
#pragma unroll
    for (int i = 0; i < 2; ++i) { int R, C; stage_rc(tid * 16 + i * 8192, R, C); const int Rb = Epi::PERM ? ((R & ~31) + perm32(R & 31)) : R;
        voffA[i] = (unsigned)(R * K + C) * 2u; voffB[i] = (unsigned)(Rb * K + C) * 2u; }
    const size_t kstep = (size_t)(BK * 2);
    const size_t hstep = (size_t)HALF * K * 2;
    const size_t tstep = 2 * hstep;
    const unsigned ldsw = (unsigned)wid * 1024u;
    const int aoff = lds_byte(wr * 64 + fr, fq * 8), boff = lds_byte(wc * 32 + fr, fq * 8);
#define PG8_SA(b, h) (((b) * 2 + (h)) * HTB)
#define PG8_SB(b, h) ((4 + (b) * 2 + (h)) * HTB)
#define PG8_STAGE(bufoff, gbase, voff) do { _Pragma("unroll") for (int _i = 0; _i < 2; ++_i) \
        __builtin_amdgcn_global_load_lds((const unsigned*)((const char*)(gbase) + (voff)[_i]), (PG8_LAS unsigned*)(lds + (bufoff) + ldsw + _i * 8192), 16, 0, 0); } while (0)
#define PG8_LDA(dst, b, h) do { _Pragma("unroll") for (int m = 0; m < 4; ++m) _Pragma("unroll") for (int k = 0; k < 2; ++k) dst[m][k] = *(const PG8_LAS bf16x8*)(lds + PG8_SA(b, h) + aoff + m * 2048 + k * 1024); } while (0)
#define PG8_LDB(dst, b, h) do { _Pragma("unroll") for (int n = 0; n < 2; ++n) _Pragma("unroll") for (int k = 0; k < 2; ++k) dst[n][k] = *(const PG8_LAS bf16x8*)(lds + PG8_SB(b, h) + boff + n * 2048 + k * 1024); } while (0)
#define PG8_MMA(ai, bj, At, Bt) do { __builtin_amdgcn_s_setprio(1); _Pragma("unroll") for (int m = 0; m < 4; ++m) _Pragma("unroll") for (int n = 0; n < 2; ++n) _Pragma("unroll") for (int k = 0; k < 2; ++k) \
        acc[ai][bj][m][n] = __builtin_amdgcn_mfma_f32_16x16x32_bf16(Bt[n][k], At[m][k], acc[ai][bj][m][n], 0, 0, 0); __builtin_amdgcn_s_setprio(0); } while (0)
#define PG8_WAIT_V(n) asm volatile("s_waitcnt vmcnt(" #n ")" ::: "memory")
#define PG8_WAIT_L(n) asm volatile("s_waitcnt lgkmcnt(" #n ")" ::: "memory")
#define PG8_BAR __builtin_amdgcn_s_barrier()
#define PG8_SCHED __builtin_amdgcn_sched_barrier(0)
    Unit cur, nxt; int ui = 0;
    if (!S.next(0, cur)) return;
    f32x4 acc[2][2][4][2];
#pragma unroll
    for (int a = 0; a < 2; ++a)
#pragma unroll
        for (int b = 0; b < 2; ++b)
#pragma unroll
            for (int m = 0; m < 4; ++m)
#pragma unroll
                for (int n = 0; n < 2; ++n) acc[a][b][m][n] = (f32x4){0.f, 0.f, 0.f, 0.f};
    bf16x8 At[4][2], B0[2][2], B1[2][2];
    const char* cA = (const char*)g.A + (size_t)cur.pm * tstep; const char* cB = (const char*)g.Bt + (size_t)cur.pn * tstep;
    S.a_ready(cur);
    if constexpr (SP2) {
        PG8_STAGE(PG8_SB(0, 0), cB, voffB); PG8_STAGE(PG8_SB(0, 1), cB + hstep, voffB); PG8_STAGE(PG8_SA(0, 0), cA, voffA); PG8_STAGE(PG8_SA(0, 1), cA + hstep, voffA);
        if (wr == 1) PG8_BAR;
        PG8_WAIT_V(2); PG8_BAR;
        PG8_STAGE(PG8_SB(1, 0), cB + kstep, voffB); PG8_STAGE(PG8_SA(1, 0), cA + kstep, voffA); PG8_STAGE(PG8_SB(1, 1), cB + hstep + kstep, voffB);
        PG8_WAIT_V(6); PG8_BAR;
    } else {
        PG8_STAGE(PG8_SB(0, 0), cB, voffB); PG8_STAGE(PG8_SA(0, 0), cA, voffA); PG8_STAGE(PG8_SB(0, 1), cB + hstep, voffB); PG8_STAGE(PG8_SA(0, 1), cA + hstep, voffA);
        if (wr == 1) PG8_BAR;
        PG8_WAIT_V(4); PG8_BAR;
        PG8_STAGE(PG8_SB(1, 0), cB + kstep, voffB); PG8_STAGE(PG8_SA(1, 0), cA + kstep, voffA); PG8_STAGE(PG8_SB(1, 1), cB + hstep + kstep, voffB);
        PG8_WAIT_V(6); PG8_BAR;
    }
    for (;;) {
        const bool has_next = S.next(ui + 1, nxt);
        const char* nA = has_next ? (const char*)g.A + (size_t)nxt.pm * tstep : cA; const char* nB = has_next ? (const char*)g.Bt + (size_t)nxt.pn * tstep : cB;
        for (int t = 0; t < nt; t += 2) {
            const bool last = (t == nt - 2);
            const char* a1 = cA + (size_t)(t + 1) * kstep;
            const char* a2 = last ? nA : cA + (size_t)(t + 2) * kstep; const char* b2 = last ? nB : cB + (size_t)(t + 2) * kstep;
            const char* a3 = a2 + kstep; const char* b3 = b2 + kstep;
            if (last && has_next) S.a_ready(nxt);
            if constexpr (SP2) {
            PG8_LDB(B0, 0, 0); PG8_LDB(B1, 0, 1); PG8_SCHED; PG8_LDA(At, 0, 0); PG8_STAGE(PG8_SA(1, 1), a1 + hstep, voffA);
            PG8_WAIT_V(8); PG8_WAIT_L(0); PG8_BAR; PG8_MMA(0, 0, At, B0); PG8_MMA(0, 1, At, B1); PG8_BAR; PG8_SCHED;
            PG8_LDA(At, 0, 1); PG8_STAGE(PG8_SB(0, 0), b2, voffB); PG8_STAGE(PG8_SB(0, 1), b2 + hstep, voffB); PG8_STAGE(PG8_SA(0, 0), a2, voffA);
            PG8_WAIT_V(8); PG8_WAIT_L(0); PG8_BAR; PG8_MMA(1, 0, At, B0); PG8_MMA(1, 1, At, B1); PG8_BAR; PG8_SCHED;
            PG8_LDB(B0, 1, 0); PG8_LDB(B1, 1, 1); PG8_SCHED; PG8_LDA(At, 1, 0); PG8_STAGE(PG8_SA(0, 1), a2 + hstep, voffA);
            PG8_WAIT_V(8); PG8_WAIT_L(0); PG8_BAR; PG8_MMA(0, 0, At, B0); PG8_MMA(0, 1, At, B1); PG8_BAR; PG8_SCHED;
            PG8_LDA(At, 1, 1); PG8_STAGE(PG8_SB(1, 0), b3, voffB); PG8_STAGE(PG8_SB(1, 1), b3 + hstep, voffB); PG8_STAGE(PG8_SA(1, 0), a3, voffA);
            PG8_WAIT_V(8); PG8_WAIT_L(0); PG8_BAR; PG8_MMA(1, 0, At, B0); PG8_MMA(1, 1, At, B1); PG8_BAR; PG8_SCHED;
            } else {
            PG8_LDB(B0, 0, 0); PG8_SCHED; PG8_LDA(At, 0, 0); PG8_STAGE(PG8_SA(1, 1), a1 + hstep, voffA);
            PG8_WAIT_L(8); PG8_BAR; PG8_WAIT_L(0); PG8_MMA(0, 0, At, B0); PG8_BAR; PG8_SCHED;
            PG8_LDB(B1, 0, 1); PG8_STAGE(PG8_SB(0, 0), b2, voffB);
            PG8_BAR; PG8_WAIT_L(0); PG8_MMA(0, 1, At, B1); PG8_BAR;
            PG8_LDA(At, 0, 1); PG8_STAGE(PG8_SA(0, 0), a2, voffA);
            PG8_BAR; PG8_WAIT_L(0); PG8_MMA(1, 0, At, B0); PG8_BAR; PG8_SCHED;
            PG8_STAGE(PG8_SB(0, 1), b2 + hstep, voffB);
            PG8_WAIT_V(6); PG8_BAR; PG8_MMA(1, 1, At, B1); PG8_BAR;
            PG8_LDB(B0, 1, 0); PG8_SCHED; PG8_LDA(At, 1, 0); PG8_STAGE(PG8_SA(0, 1), a2 + hstep, voffA);
            PG8_WAIT_L(8); PG8_BAR; PG8_WAIT_L(0); PG8_MMA(0, 0, At, B0); PG8_BAR; PG8_SCHED;
            PG8_LDB(B1, 1, 1); PG8_STAGE(PG8_SB(1, 0), b3, voffB);
            PG8_BAR; PG8_WAIT_L(0); PG8_MMA(0, 1, At, B1); PG8_BAR;
            PG8_LDA(At, 1, 1); PG8_STAGE(PG8_SA(1, 0), a3, voffA);
            PG8_BAR; PG8_WAIT_L(0); PG8_MMA(1, 0, At, B0); PG8_BAR; PG8_SCHED;
            PG8_STAGE(PG8_SB(1, 1), b3 + hstep, voffB);
            PG8_WAIT_V(6); PG8_BAR; PG8_MMA(1, 1, At, B1); PG8_BAR;
            }
        }
        if constexpr (ALIGN_EPI) { if (wr == 0) PG8_BAR; }
        if constexpr (!Epi::AFTER_DRAIN) { E(acc, cur, wr, wc, fr, fq); S.done(cur); }
        if (!has_next) break;
#pragma unroll
        for (int a = 0; a < 2; ++a)
#pragma unroll
            for (int b = 0; b < 2; ++b)
#pragma unroll
                for (int m = 0; m < 4; ++m)
#pragma unroll
                    for (int n = 0; n < 2; ++n) acc[a][b][m][n] = (f32x4){0.f, 0.f, 0.f, 0.f};
        cur = nxt; cA = nA; cB = nB; ++ui;
        if constexpr (ALIGN_EPI) { if (wr == 1) PG8_BAR; }
    }
    PG8_WAIT_V(0);
    if constexpr (!ALIGN_EPI) { if (wr == 0) PG8_BAR; }
    PG8_BAR;
    if constexpr (Epi::AFTER_DRAIN) { E.fused(acc, cur, wr, wc, fr, fq, lds, wid, lane); S.done(cur); }
#undef PG8_SA
#undef PG8_SB
#undef PG8_STAGE
#undef PG8_LDA
#undef PG8_LDB
#undef PG8_MMA
#undef PG8_WAIT_V
#undef PG8_WAIT_L
#undef PG8_BAR
#undef PG8_SCHED
}
}

#define XB_TMO      128
#define XB_XCNT(j)  (256  + 64 * (j))
#define XB_XSUB(j)  (1280 + 64 * (j))
#define XB_XGEN(j)  (2304 + 64 * (j))
#define XB_TOP      3328
#define XB_TOPGEN   3392
#define XCD_BAR_WORDS 3456
#define XB_SPIN_CAP (1u << 18)
#define LAS __attribute__((address_space(3)))

__device__ __forceinline__ unsigned xb_ld(unsigned* p)              { return __hip_atomic_load(p, __ATOMIC_RELAXED, __HIP_MEMORY_SCOPE_AGENT); }
__device__ __forceinline__ unsigned xb_add(unsigned* p, unsigned v) { return __hip_atomic_fetch_add(p, v, __ATOMIC_RELAXED, __HIP_MEMORY_SCOPE_AGENT); }
__device__ __forceinline__ unsigned xb_xcc_id() { return (unsigned)__builtin_amdgcn_s_getreg((3 << 11) | 20) & 0xFu; }
#define XB_SPIN(cond, bar) do { unsigned _sp = 0; while (cond) { __builtin_amdgcn_s_sleep(1); \
    if ((++_sp & 255u) == 0u) { if (xb_ld(&(bar)[XB_TMO])) break; if (_sp > XB_SPIN_CAP) { atomicAdd(&(bar)[XB_TMO], 1u); break; } } } } while (0)

struct XcdBarrier {
    unsigned* bar; unsigned x;
    volatile LAS unsigned* st;
};

__device__ __forceinline__ XcdBarrier xcd_barrier_post(unsigned* bar, volatile LAS unsigned* st, int tid) {
    XcdBarrier b; b.bar = bar; b.x = (unsigned)__builtin_amdgcn_readfirstlane((int)xb_xcc_id()); b.st = st;
    if (tid == 0) (void)xb_add(&bar[XB_XCNT(b.x)], 1u);
    return b;
}
__device__ __forceinline__ void xcd_barrier_complete(unsigned* bar, unsigned x, unsigned& nloc, unsigned& nx) {
    const unsigned G = gridDim.x * gridDim.y * gridDim.z;
    unsigned sum, cnt, mine, sp = 0u;
    for (;;) {
        sum = 0u; cnt = 0u; mine = 0u;
#pragma unroll
        for (unsigned j = 0; j < 16; ++j) { const unsigned c = xb_ld(&bar[XB_XCNT(j)]); sum += c; cnt += (c > 0u) ? 1u : 0u; mine = (j == x) ? c : mine; }
        if (sum == G) break;
        __builtin_amdgcn_s_sleep(1);
        if ((++sp & 255u) == 0u) { if (xb_ld(&bar[XB_TMO])) break; if (sp > XB_SPIN_CAP) { atomicAdd(&bar[XB_TMO], 1u); break; } }
    }
    nloc = mine > 0u ? mine : 1u; nx = cnt > 0u ? cnt : 1u;
}

__device__ __forceinline__ void xcd_barrier(const XcdBarrier& b, int tid) {
    asm volatile("s_waitcnt vmcnt(0)" ::: "memory");
    __syncthreads();
    if (tid == 0) {
        unsigned* bar = b.bar; unsigned bx_ = b.x; asm volatile("" : "+s"(bar), "+s"(bx_));
        __builtin_amdgcn_s_waitcnt(0);
        unsigned nloc = b.st[0], nx = b.st[1];
        if (nloc == 0u) { xcd_barrier_complete(bar, bx_, nloc, nx); b.st[0] = nloc; b.st[1] = nx; }
        const unsigned old = xb_add(&bar[XB_XSUB(bx_)], 1u);
        const unsigned gen = old / nloc;
        if (old + 1u == (gen + 1u) * nloc) {
            __builtin_amdgcn_fence(__ATOMIC_RELEASE, "agent");
            asm volatile("s_waitcnt vmcnt(0)" ::: "memory");
            const unsigned og = xb_add(&bar[XB_TOP], 1u);
            const unsigned tg = og / nx;
            if (og + 1u == (tg + 1u) * nx) xb_add(&bar[XB_TOPGEN], 1u);
            else XB_SPIN(xb_ld(&bar[XB_TOPGEN]) == tg, bar);
            __builtin_amdgcn_fence(__ATOMIC_ACQUIRE, "agent");
            xb_add(&bar[XB_XGEN(bx_)], 1u);
            asm volatile("s_waitcnt vmcnt(0)" ::: "memory");
        } else {
            XB_SPIN(xb_ld(&bar[XB_XGEN(bx_)]) == gen, bar);
            __builtin_amdgcn_fence(__ATOMIC_ACQUIRE, "agent");
            asm volatile("s_waitcnt vmcnt(0)" ::: "memory");
        }
    }
    __syncthreads();
}


typedef unsigned v4u __attribute__((ext_vector_type(4)));
typedef float f32x4 __attribute__((ext_vector_type(4)));
#define LDS_WAIT() asm volatile("s_waitcnt lgkmcnt(0)" ::: "memory")
constexpr int NWAVES = 8, NTHREADS = 512;
constexpr int RING_BYTES = 131072, LDS_BYTES = 155648;

struct P { const float* in[N_IN]; float* out; unsigned char* ws; };

template <int M> __device__ __forceinline__ float swz_xor(float v) { static_assert(M >= 1 && M < 32, "swizzle xor mask"); return __int_as_float(__builtin_amdgcn_ds_swizzle(__float_as_int(v), (M << 10) | 0x1f)); }
__device__ __forceinline__ float xor32_sum(float v) { auto r = __builtin_amdgcn_permlane32_swap(__float_as_uint(v), __float_as_uint(v), false, false); return __uint_as_float(r[0]) + __uint_as_float(r[1]); }
__device__ __forceinline__ float wave_sum(float v) {
    v += swz_xor<1>(v); v += swz_xor<2>(v); v += swz_xor<4>(v); v += swz_xor<8>(v); v += swz_xor<16>(v);
    return xor32_sum(v);
}

template <bool VPERM = false>
__device__ __forceinline__ void transpose_item(const float* W, int K, int N, bf16* WT, int k0, int n0, int drow0, LAS float* scr, int lane) {
    float tv[32];
#pragma unroll
    for (int i = 0; i < 32; ++i) { const int kk = 2 * i + (lane >> 5); tv[i] = W[(size_t)(k0 + kk) * N + n0 + (lane & 31)]; }
#pragma unroll
    for (int i = 0; i < 32; ++i) { const int kk = 2 * i + (lane >> 5); scr[kk * 33 + (lane & 31)] = tv[i]; }
    LDS_WAIT(); asm volatile("" ::: "memory");
    const int c = lane & 7;
#pragma unroll
    for (int j = 0; j < 4; ++j) { const int n = (lane >> 3) + 8 * j; const LAS float* s = scr + (8 * c) * 33 + n;
        v4u o; o.x = pk2(s[0 * 33], s[1 * 33]); o.y = pk2(s[2 * 33], s[3 * 33]); o.z = pk2(s[4 * 33], s[5 * 33]); o.w = pk2(s[6 * 33], s[7 * 33]);
        const int dr = VPERM ? (((drow0 + n) & ~127) + hg_vpos((drow0 + n) & 127)) : (drow0 + n);
        *(v4u*)(WT + (size_t)dr * K + k0 + 8 * c) = o; }
    LDS_WAIT(); asm volatile("" ::: "memory");
}

__device__ __forceinline__ void phase_prologue(const P& p, LAS unsigned char* lds, int gw, int NGW, int lane, int wave) {
    LAS float* scr = (LAS float*)(lds + wave * 16384);
    unsigned char* ws = p.ws;
    constexpr int IT_ADA = 16 * 192, IT_IN = 16 * 385, IT_BRA = 16 * 32, IT_BRB = 32 * 32, IT_OUT = 16 * 32, IT_UP = 16 * 128, IT_DOWN = 64 * 32;
    constexpr int IT_L = IT_ADA + IT_IN + IT_BRA + IT_BRB + IT_OUT + IT_UP + IT_DOWN;
    for (int it = gw; it < DEPTH * IT_L; it += NGW) {
        const int l = it / IT_L; int r = it % IT_L;
        bf16* wl = (bf16*)(ws + WS_W + (size_t)l * W_LSTRIDE);
        if (r < IT_ADA) { const int kb = r / 192, nb = r % 192; transpose_item(p.in[I_WADA] + (size_t)l * D * 6144, D, 6144, (bf16*)(ws + WS_WADA) + (size_t)l * 6144 * D, kb * 64, nb * 32, nb * 32, scr, lane); continue; } r -= IT_ADA;
        if (r < IT_IN) { const int kb = r / 385, nb = r % 385; const int n0 = nb * 32; const int dr = n0 < 10240 ? n0 : (n0 < 10272 ? PC_DT + (n0 - 10240) : n0 - 32);
            if (n0 >= PC_I && n0 < PC_OG) transpose_item<true>(p.in[I_WIN] + (size_t)l * D * IN_WIDTH, D, IN_WIDTH, (bf16*)((unsigned char*)wl + WO_IN), kb * 64, n0, dr, scr, lane);
            else transpose_item(p.in[I_WIN] + (size_t)l * D * IN_WIDTH, D, IN_WIDTH, (bf16*)((unsigned char*)wl + WO_IN), kb * 64, n0, dr, scr, lane);
            continue; } r -= IT_IN;
        if (r < IT_BRA) { const int kb = r / 32, nb = r % 32; transpose_item(p.in[I_WBRA] + (size_t)l * 1024 * 1024, 1024, 1024, (bf16*)((unsigned char*)wl + WO_BRA), kb * 64, nb * 32, nb * 32, scr, lane); continue; } r -= IT_BRA;
        if (r < IT_BRB) { const int kb = r / 32, nb = r % 32; transpose_item(p.in[I_WBRB] + (size_t)l * 2048 * 1024, 2048, 1024, (bf16*)((unsigned char*)wl + WO_BRB), kb * 64, nb * 32, nb * 32, scr, lane); continue; } r -= IT_BRB;
        if (r < IT_OUT) { const int kb = r / 32, nb = r % 32; transpose_item(p.in[I_WOUT] + (size_t)l * 1024 * 1024, 1024, 1024, (bf16*)((unsigned char*)wl + WO_OUT), kb * 64, nb * 32, nb * 32, scr, lane); continue; } r -= IT_OUT;
        if (r < IT_UP) { const int kb = r / 128, nb = r % 128; transpose_item(p.in[I_WUP] + (size_t)l * 1024 * 4096, 1024, 4096, (bf16*)((unsigned char*)wl + WO_UP), kb * 64, nb * 32, nb * 32, scr, lane); continue; } r -= IT_UP;
        { const int kb = r / 32, nb = r % 32; transpose_item(p.in[I_WDOWN] + (size_t)l * 4096 * 1024, 4096, 1024, (bf16*)((unsigned char*)wl + WO_DOWN), kb * 64, nb * 32, nb * 32, scr, lane); }
    }
    for (int i = gw * 64 + lane; i < DEPTH * 28672; i += NGW * 64) { const int l = i / 28672, r = i % 28672;
        ((v4u*)(ws + WS_W + (size_t)l * W_LSTRIDE + WO_IN + (size_t)IN_WIDTH * D * 2))[r] = (v4u){0u, 0u, 0u, 0u}; }
    for (int i = gw * 64 + lane; i < 256 * 1024; i += NGW * 64) { const int r = i >> 10, c = i & 1023;
        float v = 0.f; if (r < NB) v = p.in[I_CP][r * D + c]; else if (r < NCOND) v = p.in[I_CS][(r - NB) * D + c];
        ((bf16*)(ws + WS_AC))[i] = f2bf(siluf_(v)); }
    for (int c = gw * 64 + lane; c < 1024; c += NGW * 64) { float v[DEPTH], mx = -3.0e38f;
#pragma unroll
        for (int l = 0; l < DEPTH; ++l) { v[l] = p.in[I_LB][l * 1024 + c]; mx = fmaxf(mx, v[l]); }
        float s = 0.f;
#pragma unroll
        for (int l = 0; l < DEPTH; ++l) { v[l] = expf(v[l] - mx); s += v[l]; }
        float cum = 0.f; float* lbs = (float*)(ws + WS_LBS);
#pragma unroll
        for (int l = 0; l < DEPTH; ++l) { if (l > 0) cum += v[l] / s; lbs[l * 1024 + c] = cum; }
    }
}

__device__ __forceinline__ f32x4 unpack4(unsigned long long w) { const unsigned lo = (unsigned)w, hi = (unsigned)(w >> 32); return (f32x4){__uint_as_float(lo << 16), __uint_as_float(lo & 0xffff0000u), __uint_as_float(hi << 16), __uint_as_float(hi & 0xffff0000u)}; }
template <int MODE, int NR>
__device__ __forceinline__ void norm_rows(const float* X32, bf16* X, bf16* H, float* out32, const f32x4 (&mul)[4], const f32x4 (&sh)[4], int lane) {
    if constexpr (MODE == 1) {
        f32x4 v[NR][4];
#pragma unroll
        for (int r = 0; r < NR; ++r) { const f32x4* xr = (const f32x4*)(X32 + (size_t)r * D) + lane;
#pragma unroll
            for (int j = 0; j < 4; ++j) v[r][j] = xr[64 * j]; }
#pragma unroll
        for (int r = 0; r < NR; ++r) { float s = 0.f;
#pragma unroll
            for (int j = 0; j < 4; ++j) s += (v[r][j].x * v[r][j].x + v[r][j].y * v[r][j].y) + (v[r][j].z * v[r][j].z + v[r][j].w * v[r][j].w);
            const float rstd = rsqrtf(wave_sum(s) * (1.f / D) + EPS);
            unsigned long long* o8 = (unsigned long long*)(H + (size_t)r * D) + lane; unsigned long long* x8 = (unsigned long long*)(X + (size_t)r * D) + lane;
#pragma unroll
            for (int j = 0; j < 4; ++j) { const f32x4 y = v[r][j] * rstd * mul[j] + sh[j];
                x8[64 * j] = (unsigned long long)pk2(v[r][j].x, v[r][j].y) | ((unsigned long long)pk2(v[r][j].z, v[r][j].w) << 32);
                o8[64 * j] = (unsigned long long)pk2(y.x, y.y) | ((unsigned long long)pk2(y.z, y.w) << 32); } }
    } else {
        unsigned long long raw[NR][4];
#pragma unroll
        for (int r = 0; r < NR; ++r) { const unsigned long long* xr = (const unsigned long long*)(X + (size_t)r * D) + lane;
#pragma unroll
            for (int j = 0; j < 4; ++j) raw[r][j] = xr[64 * j]; }
#pragma unroll
        for (int r = 0; r < NR; ++r) { f32x4 v[4]; float s = 0.f;
#pragma unroll
            for (int j = 0; j < 4; ++j) { v[j] = unpack4(raw[r][j]); s += (v[j].x * v[j].x + v[j].y * v[j].y) + (v[j].z * v[j].z + v[j].w * v[j].w); }
            const float rstd = rsqrtf(wave_sum(s) * (1.f / D) + EPS);
            if constexpr (MODE == 2) { f32x4* o = (f32x4*)(out32 + (size_t)r * D) + lane;
#pragma unroll
                for (int j = 0; j < 4; ++j) o[64 * j] = v[j] * rstd * mul[j];
            } else { unsigned long long* o8 = (unsigned long long*)(H + (size_t)r * D) + lane;
#pragma unroll
                for (int j = 0; j < 4; ++j) { const f32x4 y = v[j] * rstd * mul[j] + sh[j]; o8[64 * j] = (unsigned long long)pk2(y.x, y.y) | ((unsigned long long)pk2(y.z, y.w) << 32); } } }
    }
}
template <int MODE>
__device__ __forceinline__ void phase_norm(const float* Xp32, const float* Xs32, bf16* X, bf16* H, const float* nw, const float* mod_sh, const float* mod_sc, int gw, int NGW, int lane) {
    f32x4 w4[4];
#pragma unroll
    for (int j = 0; j < 4; ++j) w4[j] = ((const f32x4*)nw)[lane + 64 * j];
    for (int b = gw; b < MP / 8; b += NGW) {
        const int ci = b >> 8; f32x4 mul[4], sh[4];
        const f32x4* shp = (const f32x4*)(mod_sh + (size_t)ci * MODLD) + lane; const f32x4* scp = (const f32x4*)(mod_sc + (size_t)ci * MODLD) + lane;
#pragma unroll
        for (int j = 0; j < 4; ++j) { sh[j] = shp[64 * j]; mul[j] = w4[j] * (scp[64 * j] + 1.0f); }
        const size_t ro = (size_t)b * 8 * D;
        norm_rows<MODE, MODE == 1 ? 4 : 8>(MODE == 1 ? Xp32 + ro : nullptr, X + ro, H + ro, nullptr, mul, sh, lane);
        if constexpr (MODE == 1) norm_rows<MODE, 4>(Xp32 + ro + 4 * D, X + ro + 4 * D, H + ro + 4 * D, nullptr, mul, sh, lane);
    }
    for (int sr = gw; sr < MS; sr += NGW) {
        const int ci = NB + sr; f32x4 mul[4], sh[4];
        const f32x4* shp = (const f32x4*)(mod_sh + (size_t)ci * MODLD) + lane; const f32x4* scp = (const f32x4*)(mod_sc + (size_t)ci * MODLD) + lane;
#pragma unroll
        for (int j = 0; j < 4; ++j) { sh[j] = shp[64 * j]; mul[j] = w4[j] * (scp[64 * j] + 1.0f); }
        const size_t ro = (size_t)(MP + sr) * D;
        norm_rows<MODE, 1>(MODE == 1 ? Xs32 + (size_t)sr * D : nullptr, X + ro, H + ro, nullptr, mul, sh, lane);
    }
}
__device__ __forceinline__ void phase_final(const bf16* X, float* out, const float* nw, int gw, int NGW, int lane) {
    f32x4 w4[4];
#pragma unroll
    for (int j = 0; j < 4; ++j) w4[j] = ((const f32x4*)nw)[lane + 64 * j];
    for (int b = gw; b < MP / 8; b += NGW) { const size_t ro = (size_t)b * 8 * D; norm_rows<2, 8>(nullptr, (bf16*)X + ro, nullptr, out + ro, w4, w4, lane); }
    for (int sr = gw; sr < MS; sr += NGW) { const size_t ro = (size_t)(MP + sr) * D; norm_rows<2, 1>(nullptr, (bf16*)X + ro, nullptr, out + ro, w4, w4, lane); }
}


typedef short s16x4 __attribute__((ext_vector_type(4)));
typedef short bf16x8 __attribute__((ext_vector_type(8)));
__device__ __forceinline__ f32x4 mfma16(bf16x8 a, bf16x8 b, f32x4 c) { return __builtin_amdgcn_mfma_f32_16x16x32_bf16(a, b, c, 0, 0, 0); }
__device__ __forceinline__ s16x4 tr_read4(LAS unsigned char* p) { return __builtin_amdgcn_ds_read_tr16_b64_v4i16((LAS s16x4*)p); }
#define SHFL_XOR(v, M) swz_xor<M>(v)
__device__ __forceinline__ float shfl_up_f(float v, int o, int lane) { return __int_as_float(__builtin_amdgcn_ds_bpermute((lane >= o ? lane - o : lane) << 2, __float_as_int(v))); }
__device__ __forceinline__ void sync_threads() { __syncthreads(); }
__device__ __forceinline__ float __builtin_amdgcn_exp2f_(float x) { return __builtin_amdgcn_exp2f(x); }
#ifdef HOST_EMU
#define FENCE_MEM() do {} while (0)
#define SCHED_FENCE() do {} while (0)
#define LAUNDER_PTR(p) do {} while (0)
#else
#define LAUNDER_PTR(p) asm volatile("" : "+v"(p))
#define FENCE_MEM() asm volatile("" ::: "memory")
#define SCHED_FENCE() __builtin_amdgcn_sched_barrier(0)
#endif
constexpr int RC = 64;
constexpr int NSEG = 4, SEGLEN = 512, NCH = SEGLEN / RC;
constexpr int PQ = 272;
constexpr int PX = 528;

struct RecurBufs {
    bf16* proj;
    bf16* xbcc;
    float* dtv;
    float* cum;
    float* cv;
    float* sseg;
    float* dseg;
    float* hseg;
    float* tseg;
    bf16* ohg;
    bf16* y;
};

__device__ __forceinline__ bf16x8 frag_rows(LAS unsigned char* img, int pitch, int row, int kcol) { return *(LAS bf16x8*)(img + row * pitch + kcol * 2); }
__device__ __forceinline__ bf16x8 frag_tr(LAS unsigned char* img, int pitch, int k0a, int k0b, int col0, int lane) {
    const int q = (lane & 15) >> 2, p = lane & 3;
    const s16x4 a = tr_read4(img + (k0a + q) * pitch + (col0 + 4 * p) * 2);
    const s16x4 b = tr_read4(img + (k0b + q) * pitch + (col0 + 4 * p) * 2);
    return (bf16x8){a[0], a[1], a[2], a[3], b[0], b[1], b[2], b[3]};
}
__device__ __forceinline__ bf16x8 scale_frag(bf16x8 f, float s) {
    bf16x8 o;
#pragma unroll
    for (int j = 0; j < 8; ++j) o[j] = (short)f2bf(bf2f((bf16)f[j]) * s);
    return o;
}
__device__ __forceinline__ bf16x8 scale_frag8(bf16x8 f, const float (&s)[8]) {
    bf16x8 o;
#pragma unroll
    for (int j = 0; j < 8; ++j) o[j] = (short)f2bf(bf2f((bf16)f[j]) * s[j]);
    return o;
}
__device__ __forceinline__ void stage_tile128(const bf16* g, size_t ld, LAS unsigned char* img, int tid) {
#pragma unroll
    for (int i = 0; i < 2; ++i) { const int idx = tid + i * 512, r = idx >> 4, c16 = idx & 15;
        *(LAS v4u*)(img + r * PQ + c16 * 16) = *(const v4u*)(g + (size_t)r * ld + c16 * 8); }
}

constexpr int HG_QT = 0, HG_KT = 17408, HG_V = 34816, HG_PART = 52224, HG_VEC1 = 54272, HG_ST = 52224, HG_VEC = 87040, HG_RED = 89088;

__device__ __forceinline__ void hgrn_state_update(f32x4 (&S)[8], LAS unsigned char* Kt, LAS unsigned char* V, const LAS float* escale, const LAS float* edec, int w, int lane) {
    const int c = lane & 15, g = lane >> 4;
    const f32x4 dc = *(const LAS f32x4*)(edec + 16 * w + 4 * g);
#pragma unroll
    for (int et = 0; et < 8; ++et) S[et] = S[et] * dc;
    const float es = escale[16 * w + c];
#pragma unroll
    for (int ks = 0; ks < 2; ++ks) {
        const bf16x8 A = scale_frag(frag_tr(Kt, PQ, 32 * ks + 8 * g, 32 * ks + 8 * g + 4, 16 * w, lane), es);
#pragma unroll
        for (int et = 0; et < 8; ++et) { const bf16x8 B = frag_tr(V, PQ, 32 * ks + 8 * g, 32 * ks + 8 * g + 4, 16 * et, lane); S[et] = mfma16(A, B, S[et]); }
        SCHED_FENCE();
    }
}

__device__ __forceinline__ void hgrn_pass1(const RecurBufs& rb, const float* lbs_l, int u, int tid, LAS unsigned char* lds) {
    const int b = u >> 5, h = (u >> 2) & 7, seg = u & 3, lane = tid & 63, w = tid >> 6;
    const int d = tid & 127, jq = tid >> 7;
    LAS unsigned char* Qt = lds + HG_QT; LAS unsigned char* Kt = lds + HG_KT; LAS unsigned char* V = lds + HG_V; LAS float* part = (LAS float*)(lds + HG_PART); LAS float* vec = (LAS float*)(lds + HG_VEC1);
    const float lb = lbs_l[h * 128 + d];
    f32x4 S[8];
#pragma unroll
    for (int et = 0; et < 8; ++et) S[et] = (f32x4){0.f, 0.f, 0.f, 0.f};
    float dprod = 1.f;
    const int sr = tid >> 4, sc16 = tid & 15;
    v4u pre[6];
    {   const bf16* gq = rb.proj + ((size_t)b * SEQ + seg * SEGLEN + sr) * LDP + PC_Q + h * 128 + sc16 * 8;
        pre[0] = *(const v4u*)gq; pre[1] = *(const v4u*)(gq + 32 * (size_t)LDP); pre[2] = *(const v4u*)(gq + PC_F); pre[3] = *(const v4u*)(gq + 32 * (size_t)LDP + PC_F);
        pre[4] = *(const v4u*)(gq + PC_I); pre[5] = *(const v4u*)(gq + 32 * (size_t)LDP + PC_I); }
    for (int ch = 0; ch < NCH; ++ch) {
        const size_t row0 = (size_t)b * SEQ + seg * SEGLEN + ch * RC;
        bf16* gq = rb.proj + (row0 + sr) * LDP + PC_Q + h * 128 + sc16 * 8;
        *(LAS v4u*)(Qt + sr * PQ + sc16 * 16) = pre[0]; *(LAS v4u*)(Qt + (sr + 32) * PQ + sc16 * 16) = pre[1];
        *(LAS v4u*)(Kt + sr * PQ + sc16 * 16) = pre[2]; *(LAS v4u*)(Kt + (sr + 32) * PQ + sc16 * 16) = pre[3];
        *(LAS v4u*)(V + sr * PQ + sc16 * 16) = pre[4]; *(LAS v4u*)(V + (sr + 32) * PQ + sc16 * 16) = pre[5];
        if (ch + 1 < NCH) { const bf16* gn = gq + RC * (size_t)LDP;
            pre[0] = *(const v4u*)gn; pre[1] = *(const v4u*)(gn + 32 * (size_t)LDP); pre[2] = *(const v4u*)(gn + PC_F); pre[3] = *(const v4u*)(gn + 32 * (size_t)LDP + PC_F);
            pre[4] = *(const v4u*)(gn + PC_I); pre[5] = *(const v4u*)(gn + 32 * (size_t)LDP + PC_I); }
        sync_threads();
        float qq[16], kk[16], lg[16];
#pragma unroll
        for (int j = 0; j < 16; ++j) { const float q = bf2f(*(const LAS bf16*)(Qt + (16 * jq + j) * PQ + d * 2)), f = bf2f(*(const LAS bf16*)(Kt + (16 * jq + j) * PQ + d * 2));
            const float fg = lb + (1.f - lb) * sigmoidf_(f);
            qq[j] = siluf_(q) * 0.08838834764831845f; kk[j] = 1.f - fg; lg[j] = __logf(fg); }
#pragma unroll
        for (int j = 1; j < 16; ++j) lg[j] += lg[j - 1];
        part[jq * 128 + d] = lg[15];
        sync_threads();
        const float p0 = part[d], p1 = part[128 + d], p2 = part[256 + d], p3 = part[384 + d];
        const float off = (jq > 0 ? p0 : 0.f) + (jq > 1 ? p1 : 0.f) + (jq > 2 ? p2 : 0.f);
        const float bref = p0 + p1, bend = (p0 + p1) + (p2 + p3);
#pragma unroll
        for (int j = 0; j < 16; ++j) { const float e1 = __expf(fminf(fmaxf(off + lg[j] - bref, -80.f), 80.f));
            *(LAS bf16*)(Qt + (16 * jq + j) * PQ + d * 2) = f2bf(qq[j] * e1); *(LAS bf16*)(Kt + (16 * jq + j) * PQ + d * 2) = f2bf(kk[j] * frcp_(e1)); }
        if (jq == 0) { const float eref = __expf(bref), esc = __expf(bend - bref), edc = __expf(bend);
            float* cvp = rb.cv + ((size_t)((b * 8 + h) * 32 + seg * NCH + ch) * 3) * 128;
            cvp[d] = eref; cvp[128 + d] = esc; cvp[256 + d] = edc; vec[128 + d] = esc; vec[256 + d] = edc; }
        dprod *= __expf(bend);
        sync_threads();
        *(v4u*)gq = *(const LAS v4u*)(Qt + sr * PQ + sc16 * 16); *(v4u*)(gq + 32 * (size_t)LDP) = *(const LAS v4u*)(Qt + (sr + 32) * PQ + sc16 * 16);
        *(v4u*)(gq + PC_F) = *(const LAS v4u*)(Kt + sr * PQ + sc16 * 16); *(v4u*)(gq + 32 * (size_t)LDP + PC_F) = *(const LAS v4u*)(Kt + (sr + 32) * PQ + sc16 * 16);
        hgrn_state_update(S, Kt, V, vec + 128, vec + 256, w, lane);
        sync_threads();
    }
    float* sp = rb.sseg + (size_t)u * 16384 + tid * 4;
#pragma unroll
    for (int et = 0; et < 8; ++et) { LAUNDER_PTR(sp); *(f32x4*)sp = S[et]; sp += 2048; }
    if (jq == 0) rb.dseg[u * 128 + d] = dprod;
}

__device__ __forceinline__ void hgrn_pass2(const RecurBufs& rb, const float* hgn_l, float* state_out_l, int u, int tid, LAS unsigned char* lds) {
    const int b = u >> 5, h = (u >> 2) & 7, seg = u & 3, lane = tid & 63, w = tid >> 6, c = lane & 15, g = lane >> 4;
    const int it = w & 3, eh = w >> 2;
    LAS unsigned char* Qt = lds + HG_QT; LAS unsigned char* Kt = lds + HG_KT; LAS unsigned char* V = lds + HG_V; LAS unsigned char* ST = lds + HG_ST;
    LAS float* vec = (LAS float*)(lds + HG_VEC); LAS float* red = (LAS float*)(lds + HG_RED);
    f32x4 S[8];
#pragma unroll
    for (int et = 0; et < 8; ++et) S[et] = (f32x4){0.f, 0.f, 0.f, 0.f};
    for (int s = 0; s < seg; ++s) { const int u2 = u - seg + s;
        const f32x4 dc = *(const f32x4*)(rb.dseg + u2 * 128 + 16 * w + 4 * g);
        const float* sp = rb.sseg + (size_t)u2 * 16384 + tid * 4;
#pragma unroll
        for (int et = 0; et < 8; ++et) { LAUNDER_PTR(sp); S[et] = S[et] * dc + *(const f32x4*)sp; sp += 2048; } }
    const int e0 = 64 * eh + 4 * c;
    const f32x4 hn = *(const f32x4*)(hgn_l + e0);
    const float* cvb = rb.cv + ((size_t)((b * 8 + h) * 32 + seg * NCH) * 3) * 128;
    const int sr = tid >> 4, sc16 = tid & 15;
    const size_t rowS = (size_t)b * SEQ + seg * SEGLEN;
    v4u pre[6];
    {   const bf16* gq = rb.proj + (rowS + sr) * LDP + PC_Q + h * 128 + sc16 * 8;
        pre[0] = *(const v4u*)gq; pre[1] = *(const v4u*)(gq + 32 * (size_t)LDP); pre[2] = *(const v4u*)(gq + PC_F); pre[3] = *(const v4u*)(gq + 32 * (size_t)LDP + PC_F);
        pre[4] = *(const v4u*)(gq + PC_I); pre[5] = *(const v4u*)(gq + 32 * (size_t)LDP + PC_I); }
    float cvn = tid < 384 ? cvb[tid] : 0.f; f32x4 ern = *(const f32x4*)(cvb + 16 * w + 4 * g);
    for (int ch = 0; ch < NCH; ++ch) {
        const size_t row0 = rowS + ch * RC;
        *(LAS v4u*)(Qt + sr * PQ + sc16 * 16) = pre[0]; *(LAS v4u*)(Qt + (sr + 32) * PQ + sc16 * 16) = pre[1];
        *(LAS v4u*)(Kt + sr * PQ + sc16 * 16) = pre[2]; *(LAS v4u*)(Kt + (sr + 32) * PQ + sc16 * 16) = pre[3];
        *(LAS v4u*)(V + sr * PQ + sc16 * 16) = pre[4]; *(LAS v4u*)(V + (sr + 32) * PQ + sc16 * 16) = pre[5];
        if (ch + 1 < NCH) { const bf16* gq = rb.proj + (row0 + RC + sr) * LDP + PC_Q + h * 128 + sc16 * 8;
            pre[0] = *(const v4u*)gq; pre[1] = *(const v4u*)(gq + 32 * (size_t)LDP); pre[2] = *(const v4u*)(gq + PC_F); pre[3] = *(const v4u*)(gq + 32 * (size_t)LDP + PC_F);
            pre[4] = *(const v4u*)(gq + PC_I); pre[5] = *(const v4u*)(gq + 32 * (size_t)LDP + PC_I); }
        if (tid < 384) vec[tid] = cvn;
        {
            const f32x4 er = ern;
            if (ch + 1 < NCH) { if (tid < 384) cvn = cvb[(size_t)(ch + 1) * 384 + tid]; ern = *(const f32x4*)(cvb + (size_t)(ch + 1) * 384 + 16 * w + 4 * g); }
#pragma unroll
            for (int et = 0; et < 8; ++et) { const f32x4 v = S[et] * er;
                *(LAS unsigned long long*)(ST + (16 * et + c) * PQ + (16 * w + 4 * g) * 2) = (unsigned long long)pk2(v[0], v[1]) | ((unsigned long long)pk2(v[2], v[3]) << 32); } }
        unsigned long long ogv[4];
#pragma unroll
        for (int r = 0; r < 4; ++r) ogv[r] = *(const unsigned long long*)(rb.proj + (row0 + 16 * it + 4 * g + r) * LDP + PC_OG + h * 128 + e0);
        sync_threads();
        bf16x8 Qfr[4];
#pragma unroll
        for (int kd = 0; kd < 4; ++kd) Qfr[kd] = frag_rows(Qt, PQ, 16 * it + c, 32 * kd + 8 * g);
        unsigned PT[4][2];
#pragma unroll
        for (int jt = 0; jt < 4; ++jt) {
            f32x4 acc = (f32x4){0.f, 0.f, 0.f, 0.f};
            if (jt <= it) {
#pragma unroll
                for (int kd = 0; kd < 4; ++kd) acc = mfma16(frag_rows(Kt, PQ, 16 * jt + c, 32 * kd + 8 * g), Qfr[kd], acc);
                if (jt == it) {
#pragma unroll
                    for (int r = 0; r < 4; ++r) acc[r] = (4 * g + r <= c) ? acc[r] : 0.f; }
            }
            PT[jt][0] = pk2(acc[0], acc[1]); PT[jt][1] = pk2(acc[2], acc[3]); SCHED_FENCE();
        }
        f32x4 o[4];
#pragma unroll
        for (int et = 0; et < 4; ++et) o[et] = (f32x4){0.f, 0.f, 0.f, 0.f};
#pragma unroll
        for (int ks = 0; ks < 2; ++ks) if (2 * ks <= it) {
            v4u pa = (v4u){PT[2 * ks][0], PT[2 * ks][1], PT[2 * ks + 1][0], PT[2 * ks + 1][1]};
            const bf16x8 A = __builtin_bit_cast(bf16x8, pa);
#pragma unroll
            for (int et = 0; et < 4; ++et) o[et] = mfma16(A, frag_tr(V, PQ, 32 * ks + 4 * g, 32 * ks + 16 + 4 * g, 16 * (4 * eh + et), lane), o[et]);
        }
#pragma unroll
        for (int kd = 0; kd < 4; ++kd) {
#pragma unroll
            for (int et = 0; et < 4; ++et) o[et] = mfma16(Qfr[kd], frag_rows(ST, PQ, 16 * (4 * eh + et) + c, 32 * kd + 8 * g), o[et]);
            SCHED_FENCE(); }
        hgrn_state_update(S, Kt, V, vec + 128, vec + 256, w, lane);
        float ss[4];
#pragma unroll
        for (int r = 0; r < 4; ++r) { float s = 0.f;
#pragma unroll
            for (int et = 0; et < 4; ++et) s += o[et][r] * o[et][r];
            s += SHFL_XOR(s, 1); s += SHFL_XOR(s, 2); s += SHFL_XOR(s, 4); s += SHFL_XOR(s, 8); ss[r] = s; }
        if (c == 0) {
#pragma unroll
            for (int r = 0; r < 4; ++r) red[(16 * it + 4 * g + r) * 2 + eh] = ss[r]; }
        sync_threads();
#pragma unroll
        for (int r = 0; r < 4; ++r) { const int i = 16 * it + 4 * g + r; const float rstd = rsqrtf((red[i * 2] + red[i * 2 + 1]) * (1.f / 128.f) + EPS);
            float ov[4];
#pragma unroll
            for (int et = 0; et < 4; ++et) { const float og = bf2f((bf16)(ogv[r] >> (16 * et))); ov[et] = o[et][r] * rstd * hn[et] * siluf_(og); }
            *(unsigned long long*)(rb.ohg + (row0 + i) * 1024 + h * 128 + e0) = (unsigned long long)pk2(ov[0], ov[1]) | ((unsigned long long)pk2(ov[2], ov[3]) << 32); }
        sync_threads();
    }
    if (seg == NSEG - 1) { float* so = state_out_l + (size_t)(b * 8 + h) * 16384 + (size_t)(16 * w + 4 * g) * 128 + 4 * c;
#pragma unroll
        for (int r = 0; r < 4; ++r)
#pragma unroll
            for (int a = 0; a < 2; ++a) *(f32x4*)(so + r * 128 + 64 * a) = (f32x4){S[4 * a][r], S[4 * a + 1][r], S[4 * a + 2][r], S[4 * a + 3][r]}; }
}

constexpr int PR = 1040;
constexpr int SD_T = 0, SD_H = 66560, SD_XO = 66560  , SD_DT = 136192, SD_CUM = 137216, SD_RED = 138240, SD_END = 139264;
__device__ __forceinline__ int ssd_gcol(int grp, int ch16) { return ch16 < 32 ? grp * 256 + ch16 * 8 : (ch16 < 48 ? 2048 + grp * 128 + (ch16 - 32) * 8 : 3072 + grp * 128 + (ch16 - 48) * 8); }

__device__ __forceinline__ void ssd_state_update(f32x4 (&H)[4][4], LAS unsigned char* Xi, int xp, LAS unsigned char* Bi, int bp, const LAS float* sDt, const LAS float* sCum, int w, int lane) {
    const int g = lane >> 4, k = w >> 1, nh = w & 1;
    const float tot = sCum[63 * 4 + k]; const float et = __expf(tot);
#pragma unroll
    for (int nt = 0; nt < 4; ++nt)
#pragma unroll
        for (int pt = 0; pt < 4; ++pt) H[nt][pt] = H[nt][pt] * et;
#pragma unroll
    for (int ks = 0; ks < 2; ++ks) {
        float wg[8];
#pragma unroll
        for (int j = 0; j < 8; ++j) wg[j] = __expf(tot - sCum[(32 * ks + 8 * g + j) * 4 + k]) * sDt[(32 * ks + 8 * g + j) * 4 + k];
        bf16x8 Bx[4];
#pragma unroll
        for (int pt = 0; pt < 4; ++pt) Bx[pt] = scale_frag8(frag_tr(Xi, xp, 32 * ks + 8 * g, 32 * ks + 8 * g + 4, 64 * k + 16 * pt, lane), wg);
#pragma unroll
        for (int nt = 0; nt < 4; ++nt) { const bf16x8 A = frag_tr(Bi, bp, 32 * ks + 8 * g, 32 * ks + 8 * g + 4, 16 * (4 * nh + nt), lane);
#pragma unroll
            for (int pt = 0; pt < 4; ++pt) H[nt][pt] = mfma16(A, Bx[pt], H[nt][pt]);
            SCHED_FENCE(); }
    }
}

typedef float f32x2r __attribute__((ext_vector_type(2)));
__device__ __forceinline__ f32x2r unpack2(unsigned w) { return (f32x2r){__uint_as_float(w << 16), __uint_as_float(w & 0xffff0000u)}; }
__device__ __forceinline__ f32x2r silu2(f32x2r a) {
    const f32x2r t = a * (-1.4426950408889634f); f32x2r e; e.x = __builtin_amdgcn_exp2f_(t.x); e.y = __builtin_amdgcn_exp2f_(t.y);
    const f32x2r d = e + 1.0f; f32x2r r; r.x = frcp_(d.x); r.y = frcp_(d.y); return a * r; }
constexpr int SD_RH = SD_XO + 64 * PX;
__device__ __forceinline__ void ssd_pass1(const RecurBufs& rb, const float* conv_w, const float* conv_b, const float* dt_bias, const float* a_log, float* conv_out_l, int u, int tid, LAS unsigned char* lds) {
    const int b = u >> 5, grp = (u >> 2) & 7, seg = u & 3, lane = tid & 63, w = tid >> 6;
    LAS unsigned char* T = lds + SD_T; LAS float* sDt = (LAS float*)(lds + SD_DT); LAS float* sCum = (LAS float*)(lds + SD_CUM); LAS unsigned char* RH = lds + SD_RH;
    const int cp = tid & 255, half = tid >> 8, t0c = 2 * cp;
    const int chx = t0c < 256 ? (grp * 256 + t0c) : (t0c < 384 ? (2048 + grp * 128 + (t0c - 256)) : (3072 + grp * 128 + (t0c - 384)));
    const int xcol = (t0c & ~63) + 16 * (t0c & 3) + ((t0c & 63) >> 2);
    const f32x2r w0 = (f32x2r){conv_w[chx], conv_w[chx + 1]}, w1 = (f32x2r){conv_w[4096 + chx], conv_w[4096 + chx + 1]}, w2 = (f32x2r){conv_w[8192 + chx], conv_w[8192 + chx + 1]},
                 w3 = (f32x2r){conv_w[12288 + chx], conv_w[12288 + chx + 1]}, cb = (f32x2r){conv_b[chx], conv_b[chx + 1]};
    const size_t rowS = (size_t)b * SEQ + seg * SEGLEN;
    if (half == 0) {
#pragma unroll
        for (int j = 0; j < 3; ++j) { unsigned v = 0u; if (seg > 0) v = *(const unsigned*)(rb.proj + (rowS - 3 + j) * LDP + PC_XBC + chx); *(LAS unsigned*)(RH + j * 1024 + cp * 4) = v; } }
    f32x4 H[4][4];
#pragma unroll
    for (int nt = 0; nt < 4; ++nt)
#pragma unroll
        for (int pt = 0; pt < 4; ++pt) H[nt][pt] = (f32x4){0.f, 0.f, 0.f, 0.f};
    float tsum = 0.f;
    const int ch16 = tid & 63, rr = tid >> 6;
    const int gcol = ssd_gcol(grp, ch16);
    LAS unsigned char* XO = lds + SD_XO;
    v4u raw[8];
    {   const bf16* gp = rb.proj + (rowS + rr) * LDP + PC_XBC + gcol;
#pragma unroll
        for (int i = 0; i < 8; ++i) { LAUNDER_PTR(gp); raw[i] = *(const v4u*)gp; gp += 8 * (size_t)LDP; } }
    bf16 dtn = 0;
    if (w < 4) dtn = rb.proj[(rowS + lane) * LDP + PC_DT + grp * 4 + w];
    unsigned hr0 = 0u, hr1 = 0u, hr2 = 0u;
    for (int ch = 0; ch < NCH; ++ch) {
        const size_t row0 = rowS + ch * RC;
        if (w < 4) {
            const int head = grp * 4 + w; const size_t row = row0 + lane;
            const float dv = softplusf_(bf2f(dtn) + dt_bias[head]);
            if (ch + 1 < NCH) dtn = rb.proj[(row + RC) * LDP + PC_DT + head];
            float la = dv * (-__expf(a_log[head]));
#pragma unroll
            for (int o = 1; o < 64; o <<= 1) { const float t = shfl_up_f(la, o, lane); if (lane >= o) la += t; }
            sDt[lane * 4 + w] = dv; sCum[lane * 4 + w] = la; rb.dtv[row * 32 + head] = dv; rb.cum[row * 32 + head] = la;
        }
#pragma unroll
        for (int i = 0; i < 8; ++i) *(LAS v4u*)(T + (rr + 8 * i) * PR + ch16 * 16) = raw[i];
        if (ch + 1 < NCH) { const bf16* gp = rb.proj + (row0 + RC + rr) * LDP + PC_XBC + gcol;
#pragma unroll
            for (int i = 0; i < 8; ++i) { LAUNDER_PTR(gp); raw[i] = *(const v4u*)gp; gp += 8 * (size_t)LDP; } }
        sync_threads();
        if (half == 0) { hr0 = *(const LAS unsigned*)(RH + cp * 4); hr1 = *(const LAS unsigned*)(RH + 1024 + cp * 4); hr2 = *(const LAS unsigned*)(RH + 2048 + cp * 4); }
        else { hr0 = *(const LAS unsigned*)(T + 29 * PR + cp * 4); hr1 = *(const LAS unsigned*)(T + 30 * PR + cp * 4); hr2 = *(const LAS unsigned*)(T + 31 * PR + cp * 4); }
        sync_threads();
        {
            f32x2r r0 = unpack2(hr0), r1 = unpack2(hr1), r2 = unpack2(hr2);
            const LAS unsigned char* src = T + (32 * half) * PR + cp * 4;
            unsigned lastw0 = hr0, lastw1 = hr1, lastw2 = hr2;
#pragma unroll 8
            for (int j = 0; j < 32; ++j) { const unsigned cw = *(const LAS unsigned*)(src + j * PR); const f32x2r cur = unpack2(cw);
                const f32x2r a = cb + w0 * r0 + w1 * r1 + w2 * r2 + w3 * cur; r0 = r1; r1 = r2; r2 = cur; lastw0 = lastw1; lastw1 = lastw2; lastw2 = cw;
                const f32x2r v = silu2(a); const unsigned ow = pk2(v.x, v.y);
                if (cp < 128) { LAS unsigned char* d = XO + (32 * half + j) * PX + xcol * 2; *(LAS bf16*)d = (bf16)ow; *(LAS bf16*)(d + 32) = (bf16)(ow >> 16); }
                else *(LAS unsigned*)(T + (32 * half + j) * PR + cp * 4) = ow; }
            if (half == 1) { *(LAS unsigned*)(RH + cp * 4) = lastw0; *(LAS unsigned*)(RH + 1024 + cp * 4) = lastw1; *(LAS unsigned*)(RH + 2048 + cp * 4) = lastw2;
                hr0 = lastw0; hr1 = lastw1; hr2 = lastw2; }
        }
        sync_threads();
        tsum += sCum[63 * 4 + (w >> 1)];
        ssd_state_update(H, XO, PX, T + 512, PR, sDt, sCum, w, lane);
        {   bf16* gp = rb.xbcc + (row0 + rr) * 4096 + gcol;
            const LAS unsigned char* src = ch16 < 32 ? (XO + ch16 * 16) : (T + ch16 * 16); const int spitch = ch16 < 32 ? PX : PR;
#pragma unroll
            for (int i = 0; i < 8; ++i) { LAUNDER_PTR(gp); *(v4u*)gp = *(const LAS v4u*)(src + (rr + 8 * i) * spitch); gp += 8 * 4096; } }
        sync_threads();
    }
    float* hp = rb.hseg + (size_t)u * 32768 + tid * 4;
#pragma unroll
    for (int nt = 0; nt < 4; ++nt)
#pragma unroll
        for (int pt = 0; pt < 4; ++pt) { LAUNDER_PTR(hp); *(f32x4*)hp = H[nt][pt]; hp += 2048; }
    if ((tid & 127) == 0) rb.tseg[u * 4 + (w >> 1)] = tsum;
    if (seg == NSEG - 1 && half == 1) { float* co = conv_out_l + (size_t)b * 3 * 4096;
        const f32x2r a0 = unpack2(hr0), a1 = unpack2(hr1), a2 = unpack2(hr2);
        co[chx] = a0.x; co[chx + 1] = a0.y; co[4096 + chx] = a1.x; co[4096 + chx + 1] = a1.y; co[8192 + chx] = a2.x; co[8192 + chx + 1] = a2.y; }
}

__device__ __forceinline__ void ssd_pass2(const RecurBufs& rb, const float* d_skip, const float* ssm_norm, float* state_out_l, int u, int tid, LAS unsigned char* lds) {
    const int b = u >> 5, grp = (u >> 2) & 7, seg = u & 3, lane = tid & 63, w = tid >> 6, c = lane & 15, g = lane >> 4;
    const int k = w >> 1, hf = w & 1, head = grp * 4 + k;
    LAS unsigned char* T = lds + SD_T; LAS unsigned char* sB = T + 512; LAS unsigned char* sC = T + 768; LAS unsigned char* hS = lds + SD_H + k * (64 * PQ);
    LAS float* sDt = (LAS float*)(lds + SD_DT); LAS float* sCum = (LAS float*)(lds + SD_CUM); LAS float* red = (LAS float*)(lds + SD_RED);
    f32x4 H[4][4];
#pragma unroll
    for (int nt = 0; nt < 4; ++nt)
#pragma unroll
        for (int pt = 0; pt < 4; ++pt) H[nt][pt] = (f32x4){0.f, 0.f, 0.f, 0.f};
    for (int s = 0; s < seg; ++s) { const int u2 = u - seg + s; const float dc = __expf(rb.tseg[u2 * 4 + k]); const float* hp = rb.hseg + (size_t)u2 * 32768 + tid * 4;
#pragma unroll
        for (int nt = 0; nt < 4; ++nt)
#pragma unroll
            for (int pt = 0; pt < 4; ++pt) { LAUNDER_PTR(hp); H[nt][pt] = H[nt][pt] * dc + *(const f32x4*)hp; hp += 2048; } }
    const float Dk = d_skip[head];
    const size_t rowS = (size_t)b * SEQ + seg * SEGLEN;
    const int ch16 = tid & 63, rr = tid >> 6; const int gcol = ssd_gcol(grp, ch16);
    const int chn0 = grp * 256 + k * 64 + 4 * c;
    for (int ch = 0; ch < NCH; ++ch) {
        const size_t row0 = rowS + ch * RC;
        {   v4u raw[8];
            {   const bf16* gp = rb.xbcc + (row0 + rr) * 4096 + gcol;
#pragma unroll
                for (int i = 0; i < 8; ++i) { LAUNDER_PTR(gp); raw[i] = *(const v4u*)gp; gp += 8 * 4096; } }
            if (tid < 256) { sDt[tid] = rb.dtv[(row0 + (tid >> 2)) * 32 + grp * 4 + (tid & 3)]; sCum[tid] = rb.cum[(row0 + (tid >> 2)) * 32 + grp * 4 + (tid & 3)]; }
#pragma unroll
            for (int nt = 0; nt < 4; ++nt)
#pragma unroll
                for (int pt = 0; pt < 4; ++pt) { const f32x4 v = H[nt][pt];
                    *(LAS unsigned long long*)(hS + (4 * c + pt) * PQ + (16 * (4 * hf + nt) + 4 * g) * 2) = (unsigned long long)pk2(v[0], v[1]) | ((unsigned long long)pk2(v[2], v[3]) << 32); }
#pragma unroll
            for (int i = 0; i < 8; ++i) *(LAS v4u*)(T + (rr + 8 * i) * PR + ch16 * 16) = raw[i]; }
        sync_threads();
#pragma unroll 1
        for (int i2 = 0; i2 < 2; ++i2) {
            const int it = i2 ? 3 - hf : hf;
            unsigned long long zz[4];
#pragma unroll
            for (int r = 0; r < 4; ++r) zz[r] = *(const unsigned long long*)(rb.proj + (row0 + 16 * it + 4 * g + r) * LDP + PC_Z + chn0);
            f32x4 ya[4];
#pragma unroll
            for (int pt = 0; pt < 4; ++pt) ya[pt] = (f32x4){0.f, 0.f, 0.f, 0.f};
#pragma unroll
            for (int kn = 0; kn < 4; ++kn) { const bf16x8 Cf = frag_rows(sC, PR, 16 * it + c, 32 * kn + 8 * g);
#pragma unroll
                for (int pt = 0; pt < 4; ++pt) ya[pt] = mfma16(Cf, frag_rows(hS, PQ, 4 * c + pt, 32 * kn + 8 * g), ya[pt]);
                SCHED_FENCE(); }
            {   float ei[4];
#pragma unroll
                for (int r = 0; r < 4; ++r) ei[r] = __expf(sCum[(16 * it + 4 * g + r) * 4 + k]);
#pragma unroll
                for (int pt = 0; pt < 4; ++pt)
#pragma unroll
                    for (int r = 0; r < 4; ++r) ya[pt][r] *= ei[r]; }
            const float cum_i = sCum[(16 * it + c) * 4 + k];
            unsigned PT[4][2];
#pragma unroll
            for (int jt = 0; jt < 4; ++jt) {
                f32x4 acc = (f32x4){0.f, 0.f, 0.f, 0.f};
                if (jt <= it) {
#pragma unroll
                    for (int kn = 0; kn < 4; ++kn) acc = mfma16(frag_rows(sB, PR, 16 * jt + c, 32 * kn + 8 * g), frag_rows(sC, PR, 16 * it + c, 32 * kn + 8 * g), acc);
#pragma unroll
                    for (int r = 0; r < 4; ++r) { const int j = 16 * jt + 4 * g + r; const float df = cum_i - sCum[j * 4 + k]; const bool keep = (jt < it) || (4 * g + r <= c);
                        acc[r] = keep ? acc[r] * __expf(fminf(df, 0.f)) * sDt[j * 4 + k] : 0.f; }
                }
                PT[jt][0] = pk2(acc[0], acc[1]); PT[jt][1] = pk2(acc[2], acc[3]); SCHED_FENCE();
            }
#pragma unroll
            for (int ks = 0; ks < 2; ++ks) if (2 * ks <= it) {
                v4u pa = (v4u){PT[2 * ks][0], PT[2 * ks][1], PT[2 * ks + 1][0], PT[2 * ks + 1][1]};
                const bf16x8 A = __builtin_bit_cast(bf16x8, pa);
#pragma unroll
                for (int pt = 0; pt < 4; ++pt) ya[pt] = mfma16(A, frag_tr(T, PR, 32 * ks + 4 * g, 32 * ks + 16 + 4 * g, 64 * k + 16 * pt, lane), ya[pt]);
                SCHED_FENCE();
            }
#pragma unroll
            for (int r = 0; r < 4; ++r) { const int i = 16 * it + 4 * g + r; float s = 0.f; float yv[4];
#pragma unroll
                for (int pt = 0; pt < 4; ++pt) { const float xc = bf2f(*(const LAS bf16*)(T + i * PR + (64 * k + 16 * pt + c) * 2)); const float z = bf2f((bf16)(zz[r] >> (16 * pt)));
                    const bf16 yb = f2bf((ya[pt][r] + Dk * xc) * siluf_(z)); yv[pt] = bf2f(yb); s += yv[pt] * yv[pt]; }
                *(unsigned long long*)(rb.y + (row0 + i) * 2048 + chn0) = (unsigned long long)pk2(yv[0], yv[1]) | ((unsigned long long)pk2(yv[2], yv[3]) << 32);
                s += SHFL_XOR(s, 1); s += SHFL_XOR(s, 2); s += SHFL_XOR(s, 4); s += SHFL_XOR(s, 8);
                if (c == 0) red[i * 4 + k] = s; }
            SCHED_FENCE();
        }
        ssd_state_update(H, T, PR, T + 512, PR, sDt, sCum, w, lane);
        sync_threads();
        {   const f32x4 nw = *(const f32x4*)(ssm_norm + chn0);
            unsigned long long yy[8];
            const int itA = hf, itB = 3 - hf;
            bf16* yb0 = rb.y + (row0 + 16 * itA + 4 * g) * 2048 + chn0;
            const int jump = (16 * (itB - itA) - 3) * 2048;
            {   bf16* yp = yb0;
#pragma unroll
                for (int q = 0; q < 8; ++q) { LAUNDER_PTR(yp); yy[q] = *(const unsigned long long*)yp; yp += (q == 3) ? jump : 2048; } }
            bf16* yp = yb0;
#pragma unroll
            for (int q = 0; q < 8; ++q) { const int i = 16 * (q < 4 ? itA : itB) + 4 * g + (q & 3);
                const float rstd = rsqrtf(((red[i * 4] + red[i * 4 + 1]) + (red[i * 4 + 2] + red[i * 4 + 3])) * (1.f / 256.f) + EPS);
                const unsigned lo = (unsigned)yy[q], hi = (unsigned)(yy[q] >> 32);
                const float y0 = __uint_as_float(lo << 16) * rstd * nw[0], y1 = __uint_as_float(lo & 0xffff0000u) * rstd * nw[1], y2 = __uint_as_float(hi << 16) * rstd * nw[2], y3 = __uint_as_float(hi & 0xffff0000u) * rstd * nw[3];
                LAUNDER_PTR(yp); *(unsigned long long*)yp = (unsigned long long)pk2(y0, y1) | ((unsigned long long)pk2(y2, y3) << 32); yp += (q == 3) ? jump : 2048; } }
        sync_threads();
    }
    if (seg == NSEG - 1) { float* so = state_out_l + ((size_t)(b * 32 + head) * 64 + 4 * c) * 128 + 64 * hf + 4 * g;
#pragma unroll
        for (int pt = 0; pt < 4; ++pt)
#pragma unroll
            for (int nt = 0; nt < 4; ++nt) *(f32x4*)(so + pt * 128 + 16 * nt) = H[nt][pt]; }
}

__device__ __forceinline__ float row32_sum(float s) { s += SHFL_XOR(s, 1); s += SHFL_XOR(s, 2); s += SHFL_XOR(s, 4); s += SHFL_XOR(s, 8); s += SHFL_XOR(s, 16); return s; }

__device__ __forceinline__ void hgrn_sample_load(f32x4 (&st)[8], const float* state_in, int bh, int tid) {
    const float* sp = state_in + (size_t)bh * 16384 + tid * 4;
#pragma unroll
    for (int it = 0; it < 8; ++it) { LAUNDER_PTR(sp); st[it] = *(const f32x4*)sp; sp += 2048; }
}
__device__ __forceinline__ void hgrn_sample_step(const bf16* proj, const float* lbs_l, const float* hgn_l, const float* state_in, float* state_out, bf16* ohg, int bh, int tid, LAS unsigned char* lds,
                                                 f32x4 (&st)[8], int bh_next) {
    const int b = bh >> 3, h = bh & 7, lane = tid & 63, w = tid >> 6;
    LAS float* sq = (LAS float*)lds; LAS float* sg = sq + 128; LAS float* sk = sq + 256; LAS float* sv = sq + 384; LAS float* so = (LAS float*)(lds + 8192); LAS float* sred = (LAS float*)(lds + 16384);
    const size_t row = (size_t)MP + b;
    float ogv = 0.f, q_ = 0.f, f_ = 0.f, v_ = 0.f, lb_ = 0.f;
    if (tid < 128) { const bf16* pr = proj + row * LDP + h * 128; q_ = bf2f(pr[PC_Q + tid]); f_ = bf2f(pr[PC_F + tid]); lb_ = lbs_l[h * 128 + tid]; v_ = bf2f(pr[PC_I + hg_vpos(tid)]); ogv = bf2f(pr[PC_OG + tid]); }
    if (tid < 128) { const float fg = lb_ + (1.f - lb_) * sigmoidf_(f_);
        sq[tid] = siluf_(q_) * 0.08838834764831845f; sg[tid] = fg; sk[tid] = 1.f - fg; sv[tid] = v_; }
    sync_threads();
    const int dv4 = tid & 31, rg = tid >> 5;
    const f32x4 vv = *(const LAS f32x4*)(sv + 4 * dv4);
    f32x4 oacc = (f32x4){0.f, 0.f, 0.f, 0.f};
    float* op = state_out + (size_t)bh * 16384 + tid * 4;
    const float* np = state_in + (size_t)(bh_next >= 0 ? bh_next : bh) * 16384 + tid * 4;
#pragma unroll
    for (int it = 0; it < 8; ++it) { const int dk = it * 16 + rg; const f32x4 sn = st[it] * sg[dk] + vv * sk[dk]; LAUNDER_PTR(op); *(f32x4*)op = sn; op += 2048; oacc = oacc + sn * sq[dk];
        LAUNDER_PTR(np); if (bh_next >= 0) st[it] = *(const f32x4*)np; np += 2048; }
    *(LAS f32x4*)(so + rg * 128 + 4 * dv4) = oacc;
    sync_threads();
    if (tid < 128) { float o = 0.f;
#pragma unroll
        for (int r = 0; r < 16; ++r) o += so[r * 128 + tid];
        float ss = o * o; ss = row32_sum(ss);
        if ((lane & 31) == 0) sred[tid >> 5] = ss;
        sq[tid] = o; }
    sync_threads();
    if (tid < 128) { const float rstd = rsqrtf(((sred[0] + sred[1]) + (sred[2] + sred[3])) * (1.f / 128.f) + EPS);
        ohg[row * 1024 + h * 128 + tid] = f2bf(sq[tid] * rstd * hgn_l[tid] * siluf_(ogv)); }
    sync_threads();
    (void)w;
}

__device__ __forceinline__ void ssd_sample_load(f32x4 (&st)[16], const float* state_in, int bg, int tid) {
    const float* sp = state_in + ((size_t)((bg >> 3) * 32 + (bg & 7) * 4)) * 8192 + tid * 4;
#pragma unroll
    for (int it = 0; it < 16; ++it) { LAUNDER_PTR(sp); st[it] = *(const f32x4*)sp; sp += 2048; }
}
__device__ __forceinline__ void ssd_sample_step(const bf16* proj, const float* conv_w, const float* conv_b, const float* dt_bias, const float* a_log, const float* d_skip, const float* ssm_norm,
                                                const float* state_in, const float* conv_in, float* state_out, float* conv_out, bf16* ybuf, int bg, int tid, LAS unsigned char* lds,
                                                f32x4 (&st)[16], int bg_next) {
    const int b = bg >> 3, grp = bg & 7, lane = tid & 63, w = tid >> 6;
    LAS float* sx = (LAS float*)(lds + 2048); LAS float* sB = (LAS float*)(lds + 3072); LAS float* sC = (LAS float*)(lds + 3584); LAS float* sdt = (LAS float*)(lds + 4096); LAS float* sdec = (LAS float*)(lds + 4112);
    LAS float* sy = (LAS float*)(lds + 4608); LAS float* sred = (LAS float*)(lds + 16384);
    const size_t row = (size_t)MP + b;
    {
        const int chx = tid < 256 ? (grp * 256 + tid) : (tid < 384 ? (2048 + grp * 128 + (tid - 256)) : (3072 + grp * 128 + (tid - 384)));
        const float* ci = conv_in + (size_t)b * 3 * 4096; const float r0 = ci[chx], r1 = ci[4096 + chx], r2 = ci[8192 + chx];
        const float cur = bf2f(proj[row * LDP + PC_XBC + chx]);
        const float cw0 = conv_w[chx], cw1 = conv_w[4096 + chx], cw2 = conv_w[8192 + chx], cw3 = conv_w[12288 + chx], cbb = conv_b[chx];
        float dtr = 0.f, dtbv = 0.f, alg = 0.f; if (tid < 4) { const int head = grp * 4 + tid; dtr = bf2f(proj[row * LDP + PC_DT + head]); dtbv = dt_bias[head]; alg = a_log[head]; }
        const float a = cbb + cw0 * r0 + cw1 * r1 + cw2 * r2 + cw3 * cur;
        const float v = siluf_(a);
        if (tid < 256) sx[tid] = v; else if (tid < 384) sB[tid - 256] = v; else sC[tid - 384] = v;
        float* co = conv_out + (size_t)b * 3 * 4096; co[chx] = r1; co[4096 + chx] = r2; co[8192 + chx] = cur;
        if (tid < 4) { const float dv = softplusf_(dtr + dtbv); sdt[tid] = dv; sdec[tid] = __expf(dv * (-__expf(alg))); } }
    sync_threads();
    const int n4 = tid & 31, pr_ = tid >> 5;
    const f32x4 Bv = *(const LAS f32x4*)(sB + 4 * n4), Cv = *(const LAS f32x4*)(sC + 4 * n4);
    float* op = state_out + ((size_t)(b * 32 + grp * 4)) * 8192 + tid * 4;
    const int bgn = bg_next >= 0 ? bg_next : bg; const float* np = state_in + ((size_t)((bgn >> 3) * 32 + (bgn & 7) * 4)) * 8192 + tid * 4;
#pragma unroll
    for (int it = 0; it < 16; ++it) { const int k = it >> 2, p = (it & 3) * 16 + pr_; const float xdt = sx[k * 64 + p] * sdt[k];
        const f32x4 hn = st[it] * sdec[k] + Bv * xdt; LAUNDER_PTR(op); *(f32x4*)op = hn; op += 2048;
        LAUNDER_PTR(np); if (bg_next >= 0) st[it] = *(const f32x4*)np; np += 2048;
        const f32x4 t = hn * Cv; float y = (t[0] + t[1]) + (t[2] + t[3]); y = row32_sum(y);
        if ((lane & 31) == 0) sy[k * 64 + p] = y; }
    sync_threads();
    float yv = 0.f;
    if (tid < 256) { const int k = tid >> 6; const float z = bf2f(proj[row * LDP + PC_Z + grp * 256 + tid]);
        yv = (sy[tid] + d_skip[grp * 4 + k] * sx[tid]) * siluf_(z);
        float ss = yv * yv; ss = row32_sum(ss); if ((lane & 31) == 0) sred[tid >> 5] = ss; }
    sync_threads();
    if (tid < 256) { float tot = 0.f;
#pragma unroll
        for (int r = 0; r < 8; ++r) tot += sred[r];
        ybuf[row * 2048 + grp * 256 + tid] = f2bf(yv * rsqrtf(tot * (1.f / 256.f) + EPS) * ssm_norm[grp * 256 + tid]); }
    sync_threads();
    (void)w;
}

static_assert(SD_END <= LDS_BYTES - 256, "LDS map");
static_assert(8 * 16384 <= LDS_BYTES - 256, "skinny LDS");
constexpr int SK_PART = 128 * 32 * 4;
template <int RT, class Epi>
__device__ __forceinline__ void skinny_gemm(const bf16* A, size_t lda, const bf16* Bt, int K, int N, const Epi& epi, int wg, int wg_first, int wg_count, int tid, LAS unsigned char* lds) {
    const int lane = tid & 63, w = tid >> 6, c = lane & 15, g = lane >> 4;
    constexpr int NRG = 8 / RT;
    const int nunit = (N / 32) * NRG, ksteps = K / 256;
    int me = wg - wg_first; if (me < 0 || me >= wg_count) return;
    for (int s = me; s < nunit; s += wg_count) {
        const int n0 = 32 * (s / NRG), r0 = (s % NRG) * (16 * RT);
        f32x4 acc[RT][2];
#pragma unroll
        for (int rt = 0; rt < RT; ++rt) { acc[rt][0] = (f32x4){0.f, 0.f, 0.f, 0.f}; acc[rt][1] = (f32x4){0.f, 0.f, 0.f, 0.f}; }
        const bf16* ap = A + (size_t)(r0 + c) * lda + (size_t)w * (K / 8) + 8 * g;
        const bf16* bp = Bt + (size_t)(n0 + c) * K + (size_t)w * (K / 8) + 8 * g;
#pragma unroll 4
        for (int ks = 0; ks < ksteps; ++ks) {
            bf16x8 af[RT], bfr[2];
#pragma unroll
            for (int rt = 0; rt < RT; ++rt) af[rt] = *(const bf16x8*)(ap + (size_t)(16 * rt) * lda + 32 * ks);
            bfr[0] = *(const bf16x8*)(bp + 32 * ks); bfr[1] = *(const bf16x8*)(bp + (size_t)16 * K + 32 * ks);
#pragma unroll
            for (int rt = 0; rt < RT; ++rt) { acc[rt][0] = mfma16(af[rt], bfr[0], acc[rt][0]); acc[rt][1] = mfma16(af[rt], bfr[1], acc[rt][1]); }
        }
        LAS float* part = (LAS float*)(lds + w * SK_PART);
#pragma unroll
        for (int rt = 0; rt < RT; ++rt)
#pragma unroll
            for (int nt = 0; nt < 2; ++nt)
#pragma unroll
                for (int r = 0; r < 4; ++r) part[(16 * rt + 4 * g + r) * 32 + 16 * nt + c] = acc[rt][nt][r];
        sync_threads();
        if (RT == 8 || tid < 64 * RT) {
            const int row = tid >> 2, c8 = (tid & 3) * 8;
            f32x4 v0 = (f32x4){0.f, 0.f, 0.f, 0.f}, v1 = (f32x4){0.f, 0.f, 0.f, 0.f};
#pragma unroll
            for (int ww = 0; ww < 8; ++ww) { const LAS float* pp = (const LAS float*)(lds + ww * SK_PART) + row * 32 + c8; v0 = v0 + *(const LAS f32x4*)pp; v1 = v1 + *(const LAS f32x4*)(pp + 4); }
            epi(r0 + row, n0 + c8, v0, v1);
        }
        sync_threads();
    }
}
struct SkStoreBf16 { bf16* O; int ld; int act;
    __device__ __forceinline__ void operator()(int row, int col, f32x4 v0, f32x4 v1) const {
        if (act) {
#pragma unroll
            for (int j = 0; j < 4; ++j) { const float a = fmaxf(v0[j], 0.f), b = fmaxf(v1[j], 0.f); v0[j] = a * a; v1[j] = b * b; } }
        v4u o; o.x = pk2(v0[0], v0[1]); o.y = pk2(v0[2], v0[3]); o.z = pk2(v1[0], v1[1]); o.w = pk2(v1[2], v1[3]);
        *(v4u*)(O + (size_t)row * ld + col) = o; } };
__device__ __forceinline__ void sk_unpack8(const v4u w, f32x4& lo, f32x4& hi) {
    lo = (f32x4){__uint_as_float(w.x << 16), __uint_as_float(w.x & 0xffff0000u), __uint_as_float(w.y << 16), __uint_as_float(w.y & 0xffff0000u)};
    hi = (f32x4){__uint_as_float(w.z << 16), __uint_as_float(w.z & 0xffff0000u), __uint_as_float(w.w << 16), __uint_as_float(w.w & 0xffff0000u)}; }
struct SkGateA { bf16* T; const bf16* G; int ldg; const float* bm;
    __device__ __forceinline__ void operator()(int row, int col, f32x4 v0, f32x4 v1) const {
        f32x4 g0, g1; sk_unpack8(*(const v4u*)(G + (size_t)row * ldg + col), g0, g1);
        const f32x4 b0 = *(const f32x4*)(bm + col), b1 = *(const f32x4*)(bm + col + 4);
#pragma unroll
        for (int j = 0; j < 4; ++j) { v0[j] *= sigmoidf_(g0[j] + b0[j]); v1[j] *= sigmoidf_(g1[j] + b1[j]); }
        v4u o; o.x = pk2(v0[0], v0[1]); o.y = pk2(v0[2], v0[3]); o.z = pk2(v1[0], v1[1]); o.w = pk2(v1[2], v1[3]);
        *(v4u*)(T + (size_t)row * 1024 + col) = o; } };
struct SkGateB { const bf16* T; bf16* U; const bf16* G; int ldg; const float* bm;
    __device__ __forceinline__ void operator()(int row, int col, f32x4 v0, f32x4 v1) const {
        f32x4 g0, g1; sk_unpack8(*(const v4u*)(G + (size_t)row * ldg + col), g0, g1);
        const f32x4 b0 = *(const f32x4*)(bm + col), b1 = *(const f32x4*)(bm + col + 4);
        f32x4 t0, t1; sk_unpack8(*(const v4u*)(T + (size_t)row * 1024 + col), t0, t1);
#pragma unroll
        for (int j = 0; j < 4; ++j) { v0[j] = t0[j] + v0[j] * sigmoidf_(g0[j] + b0[j]); v1[j] = t1[j] + v1[j] * sigmoidf_(g1[j] + b1[j]); }
        v4u o; o.x = pk2(v0[0], v0[1]); o.y = pk2(v0[2], v0[3]); o.z = pk2(v1[0], v1[1]); o.w = pk2(v1[2], v1[3]);
        *(v4u*)(U + (size_t)row * 1024 + col) = o; } };
struct SkRes { bf16* X; const float* gate; int ldgate;
    __device__ __forceinline__ void operator()(int row, int col, f32x4 v0, f32x4 v1) const {
        const float* gp = gate + (size_t)row * ldgate + col; bf16* xp = X + (size_t)row * 1024 + col;
        f32x4 x0, x1; sk_unpack8(*(const v4u*)xp, x0, x1);
        const f32x4 o0 = x0 + *(const f32x4*)gp * v0, o1 = x1 + *(const f32x4*)(gp + 4) * v1;
        v4u o; o.x = pk2(o0[0], o0[1]); o.y = pk2(o0[2], o0[3]); o.z = pk2(o1[0], o1[1]); o.w = pk2(o1[2], o1[3]); *(v4u*)xp = o; } };

template <int TB>
__device__ __forceinline__ void hgrn_seq(const bf16* proj, const float* lbs_l, const float* hgn_l, const float* state_in, float* state_out, bf16* ohg, int row_base, int T, int bh, int tid,
                                         LAS unsigned char* smem) {
    const int b = bh >> 3, h = bh & 7, lane = tid & 63, wv = tid >> 6;
    typedef float (LAS * arr_t)[128];
    arr_t sQ = (arr_t)(smem), sG = (arr_t)(smem + TB * 512), sK = (arr_t)(smem + 2 * TB * 512);
    LAS float* sRed = (LAS float*)(smem + 3 * TB * 512);
    float S[128];
    if (state_in) {
        const float* sp = state_in + (size_t)bh * 16384 + tid;
#pragma unroll
        for (int c = 0; c < 16; ++c) { asm volatile("" : "+v"(sp));
#pragma unroll
            for (int j = 0; j < 8; ++j) S[c * 8 + j] = sp[j * 128];
            sp += 1024; }
    } else {
#pragma unroll
        for (int d = 0; d < 128; ++d) S[d] = 0.f;
    }
    const float lb = lbs_l[h * 128 + tid], hn = hgn_l[tid];
    for (int t0 = 0; t0 < T; t0 += TB) {
        float v[TB], og[TB], o[TB];
#pragma unroll
        for (int tt = 0; tt < TB; ++tt) { v[tt] = 0.f; og[tt] = 0.f;
            if (t0 + tt < T) { const bf16* pr = proj + (size_t)(row_base + b * T + t0 + tt) * LDP + h * 128 + tid;
                const float q = bf2f(pr[PC_Q]), f = bf2f(pr[PC_F]); v[tt] = bf2f(pr[PC_I + hg_vpos(tid) - tid]); og[tt] = bf2f(pr[PC_OG]);
                const float fg = lb + (1.f - lb) * sigmoidf_(f);
                sQ[tt][tid] = siluf_(q) * 0.08838834764831845f; sG[tt][tid] = fg; sK[tt][tid] = 1.f - fg; } }
        __syncthreads();
#pragma unroll
        for (int tt = 0; tt < TB; ++tt) { float acc = 0.f;
            if (t0 + tt < T) { const float vv = v[tt];
#pragma unroll
                for (int d4 = 0; d4 < 32; ++d4) { const f32x4 g = *(const LAS f32x4*)&sG[tt][d4 * 4], k = *(const LAS f32x4*)&sK[tt][d4 * 4], q = *(const LAS f32x4*)&sQ[tt][d4 * 4];
                    S[d4 * 4 + 0] = g.x * S[d4 * 4 + 0] + k.x * vv; acc += q.x * S[d4 * 4 + 0];
                    S[d4 * 4 + 1] = g.y * S[d4 * 4 + 1] + k.y * vv; acc += q.y * S[d4 * 4 + 1];
                    S[d4 * 4 + 2] = g.z * S[d4 * 4 + 2] + k.z * vv; acc += q.z * S[d4 * 4 + 2];
                    S[d4 * 4 + 3] = g.w * S[d4 * 4 + 3] + k.w * vv; acc += q.w * S[d4 * 4 + 3]; } }
            o[tt] = acc;
            const float ss = wave_sum(acc * acc); if (lane == 0) sRed[tt * 2 + wv] = ss; }
        __syncthreads();
#pragma unroll
        for (int tt = 0; tt < TB; ++tt) if (t0 + tt < T) { const float rstd = rsqrtf((sRed[tt * 2] + sRed[tt * 2 + 1]) * (1.f / 128.f) + EPS);
            ohg[(size_t)(row_base + b * T + t0 + tt) * 1024 + h * 128 + tid] = f2bf(o[tt] * rstd * hn * siluf_(og[tt])); }
        __syncthreads();
    }
    { float* sp = state_out + (size_t)bh * 16384 + tid;
#pragma unroll
      for (int c = 0; c < 16; ++c) { asm volatile("" : "+v"(sp));
#pragma unroll
          for (int j = 0; j < 8; ++j) sp[j * 128] = S[c * 8 + j];
          sp += 1024; } }
}

template <int TB>
__device__ __forceinline__ void ssd_seq(const bf16* proj, const float* conv_w, const float* conv_b, const float* dt_bias, const float* a_log, const float* d_skip, const float* ssm_norm,
                                        const float* state_in, const float* conv_in, float* state_out, float* conv_out, bf16* ybuf, int row_base, int T, int bg, int tid, LAS unsigned char* smem) {
    const int b = bg >> 3, g = bg & 7, lane = tid & 63, wv = tid >> 6, head = g * 4 + wv;
    const int ch_x = g * 256 + tid, ch_bc = tid < 128 ? (2048 + g * 128 + tid) : (3072 + g * 128 + (tid - 128));
    typedef float (LAS * arr_t)[128];
    arr_t sB = (arr_t)(smem), sC = (arr_t)(smem + TB * 512);
    LAS float* sRed = (LAS float*)(smem + 2 * TB * 512);
    const float wx0 = conv_w[0 * 4096 + ch_x], wx1 = conv_w[1 * 4096 + ch_x], wx2 = conv_w[2 * 4096 + ch_x], wx3 = conv_w[3 * 4096 + ch_x], bx = conv_b[ch_x];
    const float wb0 = conv_w[0 * 4096 + ch_bc], wb1 = conv_w[1 * 4096 + ch_bc], wb2 = conv_w[2 * 4096 + ch_bc], wb3 = conv_w[3 * 4096 + ch_bc], bb = conv_b[ch_bc];
    float rx0 = 0.f, rx1 = 0.f, rx2 = 0.f, rb0 = 0.f, rb1 = 0.f, rb2 = 0.f;
    if (conv_in) { const float* ci = conv_in + (size_t)b * 3 * 4096; rx0 = ci[ch_x]; rx1 = ci[4096 + ch_x]; rx2 = ci[8192 + ch_x]; rb0 = ci[ch_bc]; rb1 = ci[4096 + ch_bc]; rb2 = ci[8192 + ch_bc]; }
    float hs[128];
    const size_t sbase = (((size_t)b * 32 + head) * 64 + lane) * 128;
    if (state_in) {
#pragma unroll
        for (int n4 = 0; n4 < 32; ++n4) { const f32x4 t = *(const f32x4*)(state_in + sbase + n4 * 4); hs[n4 * 4] = t.x; hs[n4 * 4 + 1] = t.y; hs[n4 * 4 + 2] = t.z; hs[n4 * 4 + 3] = t.w; }
    } else {
#pragma unroll
        for (int n = 0; n < 128; ++n) hs[n] = 0.f;
    }
    const float A = -expf(a_log[head]), dtb = dt_bias[head], Dk = d_skip[head], nw = ssm_norm[ch_x];
    for (int t0 = 0; t0 < T; t0 += TB) {
        float xc[TB], dtv[TB], dec[TB], zz[TB], yv[TB];
#pragma unroll
        for (int tt = 0; tt < TB; ++tt) { xc[tt] = 0.f; dtv[tt] = 0.f; dec[tt] = 1.f; zz[tt] = 0.f;
            if (t0 + tt < T) { const bf16* pr = proj + (size_t)(row_base + b * T + t0 + tt) * LDP;
                const float cx = bf2f(pr[PC_XBC + ch_x]), cb = bf2f(pr[PC_XBC + ch_bc]);
                const float ax = bx + wx0 * rx0 + wx1 * rx1 + wx2 * rx2 + wx3 * cx; rx0 = rx1; rx1 = rx2; rx2 = cx; xc[tt] = siluf_(ax);
                const float ab = bb + wb0 * rb0 + wb1 * rb1 + wb2 * rb2 + wb3 * cb; rb0 = rb1; rb1 = rb2; rb2 = cb;
                const float sbv = siluf_(ab); if (tid < 128) sB[tt][tid] = sbv; else sC[tt][tid - 128] = sbv;
                const float dv = softplusf_(bf2f(pr[PC_DT + head]) + dtb); dtv[tt] = dv; dec[tt] = __expf(dv * A); zz[tt] = bf2f(pr[PC_Z + ch_x]); } }
        __syncthreads();
#pragma unroll
        for (int tt = 0; tt < TB; ++tt) { float y = 0.f;
            if (t0 + tt < T) { const float xdt = xc[tt] * dtv[tt], dc = dec[tt];
#pragma unroll
                for (int n4 = 0; n4 < 32; ++n4) { const f32x4 bv = *(const LAS f32x4*)&sB[tt][n4 * 4], cv = *(const LAS f32x4*)&sC[tt][n4 * 4];
                    hs[n4 * 4 + 0] = dc * hs[n4 * 4 + 0] + xdt * bv.x; y += hs[n4 * 4 + 0] * cv.x;
                    hs[n4 * 4 + 1] = dc * hs[n4 * 4 + 1] + xdt * bv.y; y += hs[n4 * 4 + 1] * cv.y;
                    hs[n4 * 4 + 2] = dc * hs[n4 * 4 + 2] + xdt * bv.z; y += hs[n4 * 4 + 2] * cv.z;
                    hs[n4 * 4 + 3] = dc * hs[n4 * 4 + 3] + xdt * bv.w; y += hs[n4 * 4 + 3] * cv.w; }
                y = (y + Dk * xc[tt]) * siluf_(zz[tt]); }
            yv[tt] = y;
            const float ss = wave_sum(y * y); if (lane == 0) sRed[tt * 4 + wv] = ss; }
        __syncthreads();
#pragma unroll
        for (int tt = 0; tt < TB; ++tt) if (t0 + tt < T) { const float rstd = rsqrtf(((sRed[tt * 4] + sRed[tt * 4 + 1]) + (sRed[tt * 4 + 2] + sRed[tt * 4 + 3])) * (1.f / 256.f) + EPS);
            ybuf[(size_t)(row_base + b * T + t0 + tt) * 2048 + ch_x] = f2bf(yv[tt] * rstd * nw); }
        __syncthreads();
    }
#pragma unroll
    for (int n4 = 0; n4 < 32; ++n4) *(f32x4*)(state_out + sbase + n4 * 4) = (f32x4){hs[n4 * 4], hs[n4 * 4 + 1], hs[n4 * 4 + 2], hs[n4 * 4 + 3]};
    float* co = conv_out + (size_t)b * 3 * 4096;
    co[ch_x] = rx0; co[4096 + ch_x] = rx1; co[8192 + ch_x] = rx2; co[ch_bc] = rb0; co[4096 + ch_bc] = rb1; co[8192 + ch_bc] = rb2;
}

#ifndef REP_G
#define REP_G 1
#endif
#ifndef REP_R2
#define REP_R2 1
#endif
#ifndef REP_R1
#define REP_R1 1
#endif
#ifndef REP_N
#define REP_N 1
#endif
#ifndef REP_P
#define REP_P 1
#endif
#ifndef REP_H2
#define REP_H2 1
#endif
#ifndef REP_S2
#define REP_S2 1
#endif
#ifndef REP_S1
#define REP_S1 1
#endif
#ifndef REP_SS
#define REP_SS 1
#endif
#ifndef REP_BAR
#define REP_BAR 0
#endif
__device__ __forceinline__ void phase_recur1(const P& p, int l, LAS unsigned char* lds, int tid_in, int skip_hgrn1) {
    unsigned char* ws = p.ws; asm volatile("" : "+s"(ws)); int tid_ = tid_in; asm volatile("" : "+v"(tid_)); const int tid = tid_, G = gridDim.x, wg = blockIdx.x;
    RecurBufs rb{(bf16*)(ws + WS_PROJ), (bf16*)(ws + WS_XBCC), (float*)(ws + WS_DTV), (float*)(ws + WS_CUM), (float*)(ws + WS_CV), (float*)(ws + WS_SSEG), (float*)(ws + WS_DSEG),
                 (float*)(ws + WS_HSEG), (float*)(ws + WS_TSEG), (bf16*)(ws + WS_OHG), (bf16*)(ws + WS_Y)};
    const float* lbs_l = (const float*)(ws + WS_LBS) + l * 1024; float* out = p.out;
    const float* hgn = p.in[I_HGN] + l * HG_DV;
    const float* cw = p.in[I_CONVW] + (size_t)l * 4 * SSM_CH; const float* cb = p.in[I_CONVB] + l * SSM_CH; const float* dtb = p.in[I_DTB] + l * SSM_HEADS;
    const float* alog = p.in[I_ALOG] + l * SSM_HEADS; const float* dsk = p.in[I_DSKIP] + l * SSM_HEADS; const float* ssmn = p.in[I_SSMN] + l * SSM_INNER;
#define TID_L() int tl_ = tid; asm volatile("" : "+v"(tl_)); const int t = tl_
#define R1_HG() do { if (!skip_hgrn1) for (int u = wg; u < 256; u += G) { TID_L(); hgrn_pass1(rb, lbs_l, u, t, lds); } } while (0)
#define R1_SD() do { for (int rep = 0; rep < REP_S1; ++rep) for (int u = wg; u < 256; u += G) { TID_L(); ssd_pass1(rb, cw, cb, dtb, alog, out + O_CVP + (size_t)l * NB * 3 * SSM_CH, u, t, lds); } } while (0)
#define R1_SAMPLE() do { for (int rep = 0; rep < REP_SS; ++rep) { \
        {   const float* shg = p.in[I_SHG] + (size_t)l * NSB * HG_H * HG_DK * HG_DV; f32x4 sa[8];        \
            if (wg < NSB * HG_H) { TID_L(); hgrn_sample_load(sa, shg, wg, t); } \
            for (int u = wg; u < NSB * HG_H; u += G) { TID_L(); const int un = u + G < NSB * HG_H ? u + G : -1; \
                hgrn_sample_step(rb.proj, lbs_l, hgn, shg, out + O_HGS + (size_t)l * NSB * HG_H * HG_DK * HG_DV, rb.ohg, u, t, lds, sa, un); } } \
        {   const float* sss = p.in[I_SSSM] + (size_t)l * NSB * SSM_HEADS * SSM_P * SSM_N; f32x4 sa[16]; \
            if (wg < NSB * SSM_G) { TID_L(); ssd_sample_load(sa, sss, wg, t); } \
            for (int u = wg; u < NSB * SSM_G; u += G) { TID_L(); const int un = u + G < NSB * SSM_G ? u + G : -1; \
                ssd_sample_step(rb.proj, cw, cb, dtb, alog, dsk, ssmn, sss, p.in[I_SCONV] + (size_t)l * NSB * 3 * SSM_CH, \
                                out + O_SSMS + (size_t)l * NSB * SSM_HEADS * SSM_P * SSM_N, out + O_CVS + (size_t)l * NSB * 3 * SSM_CH, rb.y, u, t, lds, sa, un); } } } } while (0)
    if (((wg >> 3) & 1) == 0) { R1_HG(); R1_SAMPLE(); R1_SD(); } else { R1_SD(); R1_HG(); R1_SAMPLE(); }
#undef R1_HG
#undef R1_SD
#undef R1_SAMPLE
}
__device__ __forceinline__ void phase_recur2(const P& p, int l, LAS unsigned char* lds, int tid_in) {
    unsigned char* ws = p.ws; asm volatile("" : "+s"(ws)); int tid_ = tid_in; asm volatile("" : "+v"(tid_)); const int tid = tid_, G = gridDim.x, wg = blockIdx.x;
    RecurBufs rb{(bf16*)(ws + WS_PROJ), (bf16*)(ws + WS_XBCC), (float*)(ws + WS_DTV), (float*)(ws + WS_CUM), (float*)(ws + WS_CV), (float*)(ws + WS_SSEG), (float*)(ws + WS_DSEG),
                 (float*)(ws + WS_HSEG), (float*)(ws + WS_TSEG), (bf16*)(ws + WS_OHG), (bf16*)(ws + WS_Y)};
    float* out = p.out;
    for (int rep = 0; rep < REP_H2; ++rep) for (int u = wg; u < 256; u += G) { TID_L(); hgrn_pass2(rb, p.in[I_HGN] + l * HG_DV, out + O_HGP + (size_t)l * NB * HG_H * HG_DK * HG_DV, u, t, lds); }
    for (int rep = 0; rep < REP_S2; ++rep) for (int u = wg; u < 256; u += G) { TID_L(); ssd_pass2(rb, p.in[I_DSKIP] + l * SSM_HEADS, p.in[I_SSMN] + l * SSM_INNER, out + O_SSMP + (size_t)l * NB * SSM_HEADS * SSM_P * SSM_N, u ^ 3, t, lds); }
}


constexpr int CW_BAR = 4096;
constexpr int MISC_OFF = LDS_BYTES - 256;

__global__ __launch_bounds__(NTHREADS, 2) void k_mega(P p) {
    extern __shared__ __attribute__((aligned(16))) unsigned char shm[];
    LAS unsigned char* lds = (LAS unsigned char*)shm;
    const int wave_u = __builtin_amdgcn_readfirstlane((int)threadIdx.x >> 6);
#define TID() ({ int t__; asm volatile("v_mbcnt_lo_u32_b32 %0, -1, 0\n\tv_mbcnt_hi_u32_b32 %0, -1, %0" : "=v"(t__)); (wave_u << 6) | t__; })
    const int G = gridDim.x, NGW = G * NWAVES;
    unsigned char* ws = p.ws;
#define LANE_GW() int t_ = TID(); asm volatile("" : "+v"(t_)); const int ln = t_ & 63, wv = __builtin_amdgcn_readfirstlane(t_ >> 6), gwv = blockIdx.x * NWAVES + wv; (void)wv
    volatile LAS unsigned* MISC = (volatile LAS unsigned*)(lds + MISC_OFF);
    if (TID() < 16) MISC[TID()] = 0u;
    __syncthreads();
    XcdBarrier bar = xcd_barrier_post((unsigned*)(ws + WS_CTL) + CW_BAR, MISC + 8, TID());
#define WSL() ({ unsigned char* w_ = ws; asm volatile("" : "+s"(w_)); w_; })

    for (int rep = 0; rep < REP_P; ++rep) {   LANE_GW(); phase_prologue(p, lds, gwv, NGW, ln, wv); }
    xcd_barrier(bar, TID());
    {   unsigned char* w = WSL();
        pg8::Gemm g{(const bf16*)(w + WS_AC), (const bf16*)(w + WS_WADA), 256, MODLD, D}; pg8::StaticOrder S; S.init(256, MODLD, G, (int)blockIdx.x);
        pg8::EpiF32 E{(float*)(w + WS_MOD), MODLD, p.in[I_BADA]};
        pg8::gemm_phase<pg8::EpiF32, pg8::StaticOrder>(lds, g, S, E, nullptr, TID()); }
    xcd_barrier(bar, TID());
    for (int li = 0; li < DEPTH; ++li) {
        int l = li; asm volatile("" : "+s"(l));
        for (int rep = 0; rep < REP_N; ++rep) {   unsigned char* w = WSL(); const float* mod_l = (const float*)(w + WS_MOD) + (size_t)l * NADA * D;
            LANE_GW();
            if (l == 0) phase_norm<1>(p.in[I_XP], p.in[I_XS], (bf16*)(w + WS_X), (bf16*)(w + WS_H), p.in[I_NMIX] + l * D, mod_l + 0 * D, mod_l + 1 * D, gwv, NGW, ln);
            else phase_norm<0>(nullptr, nullptr, (bf16*)(w + WS_X), (bf16*)(w + WS_H), p.in[I_NMIX] + l * D, mod_l + 0 * D, mod_l + 1 * D, gwv, NGW, ln); }
        xcd_barrier(bar, TID());
        for (int rep = 0; rep < REP_G; ++rep) { if (rep) xcd_barrier(bar, TID());
        {   unsigned char* w = WSL(); const unsigned char* wl = w + WS_W + (size_t)l * W_LSTRIDE;
            pg8::Gemm g{(const bf16*)(w + WS_H), (const bf16*)(wl + WO_IN), MP, LDP, D}; pg8::StaticOrder S; S.init(MP, LDP, G, (int)blockIdx.x);
            pg8::EpiBf16<0> E{(bf16*)(w + WS_PROJ), LDP};
            pg8::gemm_phase<pg8::EpiBf16<0>, pg8::StaticOrder>(lds, g, S, E, nullptr, TID());
            const int skf = G > 64 ? 64 : 0, skn = G > 64 ? G - 64 : G; skinny_gemm<8>((const bf16*)(w + WS_H) + (size_t)MP * D, D, (const bf16*)(wl + WO_IN), D, LDP, SkStoreBf16{(bf16*)(w + WS_PROJ) + (size_t)MP * LDP, LDP, 0}, (int)blockIdx.x, skf, skn, TID(), lds); } }
        xcd_barrier(bar, TID());
        for (int rep = 0; rep < REP_BAR; ++rep) xcd_barrier(bar, TID());
        phase_recur1(p, l, lds, TID(), 0);
        for (int rep = 1; rep < REP_R1; ++rep) { xcd_barrier(bar, TID()); phase_recur1(p, l, lds, TID(), 1); }
        xcd_barrier(bar, TID());
        for (int rep = 0; rep < REP_R2; ++rep) { if (rep) xcd_barrier(bar, TID()); phase_recur2(p, l, lds, TID()); }
        xcd_barrier(bar, TID());
        for (int rep = 0; rep < REP_G; ++rep) { if (rep) xcd_barrier(bar, TID());
        {   unsigned char* w = WSL(); const unsigned char* wl = w + WS_W + (size_t)l * W_LSTRIDE;
            pg8::Gemm g{(const bf16*)(w + WS_OHG), (const bf16*)(wl + WO_BRA), MP, D, 1024}; pg8::StaticOrder S; S.init(MP, D, G, (int)blockIdx.x);
            pg8::EpiGateA E{(bf16*)(w + WS_T), (const bf16*)(w + WS_PROJ) + PC_GA, LDP, p.in[I_BMERGE] + l * 2048};
            pg8::gemm_phase<pg8::EpiGateA, pg8::StaticOrder>(lds, g, S, E, nullptr, TID());
            skinny_gemm<1>((const bf16*)(w + WS_OHG) + (size_t)MP * D, D, (const bf16*)(wl + WO_BRA), 1024, D, SkGateA{(bf16*)(w + WS_T) + (size_t)MP * D, (const bf16*)(w + WS_PROJ) + (size_t)MP * LDP + PC_GA, LDP, p.in[I_BMERGE] + l * 2048}, (int)blockIdx.x, 0, G, TID(), lds); } }
        asm volatile("s_waitcnt vmcnt(0)" ::: "memory"); __syncthreads();
        for (int rep = 0; rep < REP_G; ++rep) { if (rep) xcd_barrier(bar, TID());
        {   unsigned char* w = WSL(); const unsigned char* wl = w + WS_W + (size_t)l * W_LSTRIDE;
            pg8::Gemm g{(const bf16*)(w + WS_Y), (const bf16*)(wl + WO_BRB), MP, D, 2048}; pg8::StaticOrder S; S.init(MP, D, G, (int)blockIdx.x);
            pg8::EpiGateB E{(const bf16*)(w + WS_T), (bf16*)(w + WS_U), (const bf16*)(w + WS_PROJ) + PC_GB, LDP, p.in[I_BMERGE] + l * 2048 + 1024};
            pg8::gemm_phase<pg8::EpiGateB, pg8::StaticOrder>(lds, g, S, E, nullptr, TID());
            skinny_gemm<1>((const bf16*)(w + WS_Y) + (size_t)MP * 2048, 2048, (const bf16*)(wl + WO_BRB), 2048, D, SkGateB{(const bf16*)(w + WS_T) + (size_t)MP * D, (bf16*)(w + WS_U) + (size_t)MP * D, (const bf16*)(w + WS_PROJ) + (size_t)MP * LDP + PC_GB, LDP, p.in[I_BMERGE] + l * 2048 + 1024}, (int)blockIdx.x, 0, G, TID(), lds); } }
        xcd_barrier(bar, TID());
        {   unsigned char* w = WSL(); const unsigned char* wl = w + WS_W + (size_t)l * W_LSTRIDE; const float* mod_l = (const float*)(w + WS_MOD) + (size_t)l * NADA * D;
            pg8::Gemm g{(const bf16*)(w + WS_U), (const bf16*)(wl + WO_OUT), MP, D, 1024}; pg8::StaticOrder S; S.init(MP, D, G, (int)blockIdx.x);
            pg8::EpiRes E{(bf16*)(w + WS_X), mod_l + 2 * D, MODLD};
            pg8::gemm_phase<pg8::EpiRes, pg8::StaticOrder>(lds, g, S, E, nullptr, TID());
            skinny_gemm<1>((const bf16*)(w + WS_U) + (size_t)MP * D, D, (const bf16*)(wl + WO_OUT), 1024, D, SkRes{(bf16*)(w + WS_X) + (size_t)MP * D, mod_l + (size_t)NB * MODLD + 2 * D, MODLD}, (int)blockIdx.x, 0, G, TID(), lds); }
        xcd_barrier(bar, TID());
        for (int rep = 0; rep < REP_N; ++rep) {   unsigned char* w = WSL(); const float* mod_l = (const float*)(w + WS_MOD) + (size_t)l * NADA * D;
            LANE_GW(); phase_norm<0>(nullptr, nullptr, (bf16*)(w + WS_X), (bf16*)(w + WS_H), p.in[I_NMLP] + l * D, mod_l + 3 * D, mod_l + 4 * D, gwv, NGW, ln); }
        xcd_barrier(bar, TID());
        for (int rep = 0; rep < REP_G; ++rep) { if (rep) xcd_barrier(bar, TID());
        {   unsigned char* w = WSL(); const unsigned char* wl = w + WS_W + (size_t)l * W_LSTRIDE;
            pg8::Gemm g{(const bf16*)(w + WS_H), (const bf16*)(wl + WO_UP), MP, DFF, 1024}; pg8::StaticOrder S; S.init(MP, DFF, G, (int)blockIdx.x);
            pg8::EpiBf16<1> E{(bf16*)(w + WS_UP), DFF};
            pg8::gemm_phase<pg8::EpiBf16<1>, pg8::StaticOrder>(lds, g, S, E, nullptr, TID());
            skinny_gemm<4>((const bf16*)(w + WS_H) + (size_t)MP * D, D, (const bf16*)(wl + WO_UP), 1024, DFF, SkStoreBf16{(bf16*)(w + WS_UP) + (size_t)MP * DFF, DFF, 1}, (int)blockIdx.x, 0, G, TID(), lds); } }
        xcd_barrier(bar, TID());
        {   unsigned char* w = WSL(); const unsigned char* wl = w + WS_W + (size_t)l * W_LSTRIDE; const float* mod_l = (const float*)(w + WS_MOD) + (size_t)l * NADA * D;
            pg8::Gemm g{(const bf16*)(w + WS_UP), (const bf16*)(wl + WO_DOWN), MP, D, DFF}; pg8::StaticOrder S; S.init(MP, D, G, (int)blockIdx.x);
            pg8::EpiRes E{(bf16*)(w + WS_X), mod_l + 5 * D, MODLD};
            pg8::gemm_phase<pg8::EpiRes, pg8::StaticOrder>(lds, g, S, E, nullptr, TID());
            skinny_gemm<1>((const bf16*)(w + WS_UP) + (size_t)MP * DFF, DFF, (const bf16*)(wl + WO_DOWN), DFF, D, SkRes{(bf16*)(w + WS_X) + (size_t)MP * D, mod_l + (size_t)NB * MODLD + 5 * D, MODLD}, (int)blockIdx.x, 0, G, TID(), lds); }
        xcd_barrier(bar, TID());
    }
    {   unsigned char* w = WSL(); LANE_GW(); phase_final((const bf16*)(w + WS_X), p.out + O_YP, p.in[I_NFIN], gwv, NGW, ln); }
}

extern "C" void kernel_launch(void* const* d_in, const int* in_sizes, int n_in, void* d_out, int out_size, void* d_ws, size_t ws_size, hipStream_t stream) {
    static int grid = 0;
    if (grid == 0) {
        if (n_in != N_IN || (size_t)out_size != O_END || ws_size < WS_END) { fprintf(stderr, "kernel_launch: unexpected sizes n_in %d out %d ws %zu\n", n_in, out_size, ws_size); grid = -1; return; }
        int dev = 0, cus = 0, per_cu = 0;
        if (hipGetDevice(&dev) != hipSuccess || hipDeviceGetAttribute(&cus, hipDeviceAttributeMultiprocessorCount, dev) != hipSuccess) { grid = -1; return; }
        if (hipFuncSetAttribute((const void*)k_mega, hipFuncAttributeMaxDynamicSharedMemorySize, LDS_BYTES) != hipSuccess) { fprintf(stderr, "kernel_launch: hipFuncSetAttribute failed\n"); grid = -1; return; }
        if (hipOccupancyMaxActiveBlocksPerMultiprocessor(&per_cu, (const void*)k_mega, NTHREADS, LDS_BYTES) != hipSuccess || per_cu < 1)
            fprintf(stderr, "kernel_launch: note: occupancy query reports %d workgroups per CU\n", per_cu);
        (void)hipGetLastError();
        grid = cus;
    }
    if (grid < 0) return;
    if (hipMemsetAsync((char*)d_ws + WS_CTL, 0, CTL_ZERO_BYTES, stream) != hipSuccess) return;
    P p{};
    for (int i = 0; i < N_IN; ++i) p.in[i] = (const float*)d_in[i];
    p.out = (float*)d_out; p.ws = (unsigned char*)d_ws;
    hipLaunchKernelGGL(k_mega, dim3(grid), dim3(NTHREADS), LDS_BYTES, stream, p);
}
```

```cpp
#include <hip/hip_runtime.h>
#include <cstdio>
#include <cstdint>

constexpr int D = 1024, NB = 8, SEQ = 2048, DEPTH = 4, NSB = 128;
constexpr int MP = NB * SEQ;
constexpr int MS = NSB;
constexpr int MR = MP + MS;
constexpr int MT = 16640;
constexpr int HG_H = 8, HG_DK = 128, HG_DV = 128;
constexpr int SSM_INNER = 2048, SSM_P = 64, SSM_HEADS = 32, SSM_G = 8, SSM_HPG = 4, SSM_N = 128, SSM_CH = 4096;
constexpr int DFF = 4096, NADA = 6;
constexpr int IN_WIDTH = 12320;
constexpr int LDP = 12544;
constexpr int PC_Q = 0, PC_F = 1024, PC_I = 2048, PC_OG = 3072, PC_Z = 4096, PC_XBC = 6144, PC_GA = 10240, PC_GB = 11264, PC_DT = 12288;
constexpr int NCOND = NB + NSB;
constexpr int MODLD = DEPTH * NADA * D;
constexpr float EPS = 1e-6f;

enum { I_XP = 0, I_XS, I_SHG, I_SSSM, I_SCONV, I_CP, I_CS, I_WADA, I_BADA, I_NMIX, I_WIN, I_BMERGE, I_LB, I_HGN, I_CONVW, I_CONVB, I_DTB, I_ALOG, I_DSKIP,
       I_SSMN, I_WBRA, I_WBRB, I_WOUT, I_NMLP, I_WUP, I_WDOWN, I_NFIN, N_IN };

constexpr size_t O_YP = 0;
constexpr size_t O_YS = O_YP + (size_t)MP * D;
constexpr size_t O_HGP = O_YS + (size_t)MS * D;
constexpr size_t O_SSMP = O_HGP + (size_t)DEPTH * NB * HG_H * HG_DK * HG_DV;
constexpr size_t O_CVP = O_SSMP + (size_t)DEPTH * NB * SSM_HEADS * SSM_P * SSM_N;
constexpr size_t O_HGS = O_CVP + (size_t)DEPTH * NB * 3 * SSM_CH;
constexpr size_t O_SSMS = O_HGS + (size_t)DEPTH * NSB * HG_H * HG_DK * HG_DV;
constexpr size_t O_CVS = O_SSMS + (size_t)DEPTH * NSB * SSM_HEADS * SSM_P * SSM_N;
constexpr size_t O_END = O_CVS + (size_t)DEPTH * NSB * 3 * SSM_CH;

constexpr size_t MiB = 1u << 20;
constexpr size_t WS_CTL = 0, CTL_ZERO_BYTES = 1 * MiB;
constexpr size_t WS_LBS = 1 * MiB;
constexpr size_t WS_AC = 2 * MiB;
constexpr size_t WS_MOD = 3 * MiB;
constexpr size_t WS_WADA = 32 * MiB;
constexpr size_t WS_W = 80 * MiB, W_LSTRIDE = 49 * MiB;
constexpr size_t WO_IN = 0, WO_BRA = 24 * MiB + MiB / 2, WO_BRB = WO_BRA + 2 * MiB, WO_OUT = WO_BRB + 4 * MiB, WO_UP = WO_OUT + 2 * MiB, WO_DOWN = WO_UP + 8 * MiB;
constexpr size_t WS_X = 276 * MiB;
constexpr size_t WS_H = 341 * MiB;
constexpr size_t WS_PROJ = 374 * MiB;
constexpr size_t WS_OHG = 773 * MiB;
constexpr size_t WS_Y = 806 * MiB;
constexpr size_t WS_T = 871 * MiB;
constexpr size_t WS_U = 936 * MiB;
constexpr size_t WS_UP = 969 * MiB;
constexpr size_t WS_XBCC = 1100 * MiB;
constexpr size_t WS_DTV = 1230 * MiB, WS_CUM = 1232 * MiB;
constexpr size_t WS_CV = 1234 * MiB;
constexpr size_t WS_SSEG = 1238 * MiB;
constexpr size_t WS_DSEG = 1254 * MiB;
constexpr size_t WS_HSEG = 1255 * MiB;
constexpr size_t WS_TSEG = 1287 * MiB;
constexpr size_t WS_END = 1288 * MiB;
static_assert(WO_DOWN + 8 * MiB <= W_LSTRIDE && (size_t)LDP * D * 2 <= WO_BRA, "weight map");
static_assert(WS_W + 4 * W_LSTRIDE <= WS_X && WS_X + (size_t)MT * D * 4 <= WS_H && WS_H + (size_t)MT * D * 2 <= WS_PROJ && WS_PROJ + (size_t)MT * LDP * 2 <= WS_OHG, "ws map 1");
static_assert(WS_OHG + (size_t)MT * D * 2 <= WS_Y && WS_Y + (size_t)MT * 2048 * 2 <= WS_T && WS_T + (size_t)MT * D * 4 <= WS_U && WS_U + (size_t)MT * D * 2 <= WS_UP && WS_UP + (size_t)MT * DFF * 2 <= WS_XBCC && WS_XBCC + (size_t)MT * 4096 * 2 <= WS_DTV, "ws map 2");
static_assert(WS_MOD + (size_t)256 * MODLD * 4 <= WS_WADA && WS_WADA + (size_t)MODLD * D * 2 <= WS_W, "ws map 0");

typedef unsigned short bf16;
__device__ __forceinline__ float bf2f(bf16 v) { return __uint_as_float(((unsigned)v) << 16); }
__device__ __forceinline__ unsigned pk2(float lo, float hi) { unsigned r; asm("v_cvt_pk_bf16_f32 %0, %1, %2" : "=v"(r) : "v"(lo), "v"(hi)); return r; }
__device__ __forceinline__ bf16 f2bf(float f) { return (bf16)pk2(f, f); }
__device__ __forceinline__ float frcp_(float x) { return __builtin_amdgcn_rcpf(x); }
__device__ __forceinline__ float sigmoidf_(float x) { return frcp_(1.0f + __expf(-x)); }
__device__ __forceinline__ float siluf_(float x) { return x * frcp_(1.0f + __expf(-x)); }
__device__ __forceinline__ float softplusf_(float x) { return x > 20.f ? x : log1pf(__expf(x)); }
__host__ __device__ __forceinline__ int cidx_of_row(int row) { return row < MP ? (row >> 11) : ((row - MP + NB) < NCOND ? (row - MP + NB) : (NCOND - 1)); }
__host__ __device__ __forceinline__ int hg_vpos(int e) { return (e & 64) + 16 * (e & 3) + ((e & 63) >> 2); }

namespace pg8 {
#define PG8_LAS __attribute__((address_space(3)))
typedef unsigned short bf16_t;
typedef short bf16x8 __attribute__((ext_vector_type(8)));
typedef float f32x4 __attribute__((ext_vector_type(4)));
typedef unsigned u32x4 __attribute__((ext_vector_type(4)));
constexpr int BM = 256, BK = 64, HALF = 128, HTB = HALF * BK * 2  , STAGE_BYTES = 8 * HTB, NXCD = 8, WGM = 4;

__host__ __device__ __forceinline__ int lds_byte(int r, int c) { const int st = (r >> 4) * 2 + (c >> 5), rr = r & 15, cc = c & 31, ob = rr * 64 + cc * 2; return st * 1024 + (ob ^ (((ob >> 9) & 1) << 5)); }
__host__ __device__ __forceinline__ void stage_rc(int b, int& R, int& C) { const int st = b / 1024, sb = b % 1024, swz = sb ^ (((sb >> 9) & 1) << 5); R = (st >> 1) * 16 + swz / 64; C = (st & 1) * 32 + (swz % 64) / 2; }
__host__ __device__ __forceinline__ int perm32(int rho) { const int n = rho >> 4, i = rho & 15; return 8 * (i >> 2) + 4 * n + (i & 3); }

struct Unit { int pm, pn; };
struct Gemm { const bf16_t* A; const bf16_t* Bt; int M, N, K; };

struct StaticOrder {
    int nM, nN, nwg, G, c;
    __host__ __device__ void init(int M, int N, int G_, int c_) { nM = M / BM; nN = N / BM; nwg = nM * nN; G = G_; c = c_; }
    __host__ __device__ bool next(int i, Unit& u) const {
        const long L = (long)i * G + c; if (L >= nwg) return false;
        int wgid = (int)L; { const int q = nwg / NXCD, r = nwg % NXCD, xcd = wgid % NXCD, off = wgid / NXCD; wgid = (xcd < r ? xcd * (q + 1) : r * (q + 1) + (xcd - r) * q) + off; }
        const int nig = WGM * nN, gid = wgid / nig, fm = gid * WGM, gsz = (nM - fm) < WGM ? (nM - fm) : WGM;
        u.pm = fm + ((wgid % nig) % gsz); u.pn = (wgid % nig) / gsz; return true;
    }
    __device__ __forceinline__ void a_ready(const Unit&) const {}
    __device__ __forceinline__ void done(const Unit&) const {}
};
__device__ __forceinline__ unsigned cvt_pk_bf16(float lo, float hi) { unsigned r; asm volatile("v_cvt_pk_bf16_f32 %0, %1, %2" : "=v"(r) : "v"(lo), "v"(hi)); return r; }
__device__ __forceinline__ float ep_sigmoid(float x) { return __builtin_amdgcn_rcpf(1.0f + __expf(-x)); }
__device__ __forceinline__ void unpack8(const u32x4 w, f32x4& lo, f32x4& hi) {
    lo = (f32x4){__uint_as_float(w.x << 16), __uint_as_float(w.x & 0xffff0000u), __uint_as_float(w.y << 16), __uint_as_float(w.y & 0xffff0000u)};
    hi = (f32x4){__uint_as_float(w.z << 16), __uint_as_float(w.z & 0xffff0000u), __uint_as_float(w.w << 16), __uint_as_float(w.w & 0xffff0000u)};
}

struct EpiF32 {
    static constexpr bool PERM = false, AFTER_DRAIN = false;
    float* C; int ldc; const float* bias;
    __device__ __forceinline__ void operator()(const f32x4 (&acc)[2][2][4][2], const Unit& u, int wr, int wc, int fr, int fq) const {
        const int row0 = u.pm * BM + wr * 64 + fr, col0 = u.pn * BM + wc * 32 + 4 * fq;
        f32x4 bv[2][2];
#pragma unroll
        for (int bj = 0; bj < 2; ++bj)
#pragma unroll
            for (int n = 0; n < 2; ++n) bv[bj][n] = *(const f32x4*)(bias + col0 + bj * HALF + n * 16);
#pragma unroll
        for (int ai = 0; ai < 2; ++ai)
#pragma unroll
            for (int m = 0; m < 4; ++m) { float* rowp = C + (size_t)(row0 + ai * HALF + m * 16) * ldc + col0;
#pragma unroll
                for (int bj = 0; bj < 2; ++bj)
#pragma unroll
                    for (int n = 0; n < 2; ++n) *(f32x4*)(rowp + bj * HALF + n * 16) = acc[ai][bj][m][n] + bv[bj][n]; }
    }
};
template <int ACT  > struct EpiBf16 {
    static constexpr bool PERM = true, AFTER_DRAIN = false;
    bf16_t* O; int ldc;
    __device__ __forceinline__ void operator()(const f32x4 (&acc)[2][2][4][2], const Unit& u, int wr, int wc, int fr, int fq) const {
        const int lane = fr + 16 * fq, r2 = lane >> 2, q2 = lane & 3;
        const int src4 = (r2 + 16 * q2) << 2;
        const int row0 = u.pm * BM + wr * 64 + r2; const int col0 = u.pn * BM + wc * 32 + 8 * q2;
#pragma unroll
        for (int ai = 0; ai < 2; ++ai)
#pragma unroll
            for (int m = 0; m < 4; ++m) { bf16_t* rowp = O + (size_t)(row0 + ai * HALF + m * 16) * ldc + col0;
#pragma unroll
                for (int bj = 0; bj < 2; ++bj) { f32x4 v0 = acc[ai][bj][m][0], v1 = acc[ai][bj][m][1];
                    if (ACT == 1) {
#pragma unroll
                        for (int j = 0; j < 4; ++j) { const float a = fmaxf(v0[j], 0.f), b = fmaxf(v1[j], 0.f); v0[j] = a * a; v1[j] = b * b; } }
                    u32x4 w; w.x = cvt_pk_bf16(v0[0], v0[1]); w.y = cvt_pk_bf16(v0[2], v0[3]); w.z = cvt_pk_bf16(v1[0], v1[1]); w.w = cvt_pk_bf16(v1[2], v1[3]);
                    w.x = (unsigned)__builtin_amdgcn_ds_bpermute(src4, (int)w.x); w.y = (unsigned)__builtin_amdgcn_ds_bpermute(src4, (int)w.y);
                    w.z = (unsigned)__builtin_amdgcn_ds_bpermute(src4, (int)w.z); w.w = (unsigned)__builtin_amdgcn_ds_bpermute(src4, (int)w.w);
                    *(u32x4*)(rowp + bj * HALF) = w; } }
    }
};
struct EpiGateA {
    static constexpr bool PERM = true, AFTER_DRAIN = false;
    bf16_t* T; const bf16_t* G; int ldg; const float* bm;
    __device__ __forceinline__ void operator()(const f32x4 (&acc)[2][2][4][2], const Unit& u, int wr, int wc, int fr, int fq) const {
        const int row0 = u.pm * BM + wr * 64 + fr; const int col0 = u.pn * BM + wc * 32 + 8 * fq;
        f32x4 bv[2][2];
#pragma unroll
        for (int bj = 0; bj < 2; ++bj)
#pragma unroll
            for (int n = 0; n < 2; ++n) bv[bj][n] = *(const f32x4*)(bm + col0 + bj * HALF + 4 * n);
#pragma unroll
        for (int ai = 0; ai < 2; ++ai)
#pragma unroll
            for (int m = 0; m < 4; ++m) { const size_t row = (size_t)(row0 + ai * HALF + m * 16);
#pragma unroll
                for (int bj = 0; bj < 2; ++bj) {
                    const u32x4 gw = *(const u32x4*)(G + row * ldg + col0 + bj * HALF); f32x4 g0, g1; unpack8(gw, g0, g1);
                    f32x4 o0, o1;
#pragma unroll
                    for (int j = 0; j < 4; ++j) { o0[j] = ep_sigmoid(g0[j] + bv[bj][0][j]) * acc[ai][bj][m][0][j]; o1[j] = ep_sigmoid(g1[j] + bv[bj][1][j]) * acc[ai][bj][m][1][j]; }
                    u32x4 w; w.x = cvt_pk_bf16(o0[0], o0[1]); w.y = cvt_pk_bf16(o0[2], o0[3]); w.z = cvt_pk_bf16(o1[0], o1[1]); w.w = cvt_pk_bf16(o1[2], o1[3]);
                    *(u32x4*)(T + row * 1024 + col0 + bj * HALF) = w; } }
    }
};
struct EpiGateB {
    static constexpr bool PERM = true, AFTER_DRAIN = false;
    const bf16_t* T; bf16_t* U; const bf16_t* G; int ldg; const float* bm;
    __device__ __forceinline__ void operator()(const f32x4 (&acc)[2][2][4][2], const Unit& u, int wr, int wc, int fr, int fq) const {
        const int row0 = u.pm * BM + wr * 64 + fr; const int col0 = u.pn * BM + wc * 32 + 8 * fq;
        f32x4 bv[2][2];
#pragma unroll
        for (int bj = 0; bj < 2; ++bj)
#pragma unroll
            for (int n = 0; n < 2; ++n) bv[bj][n] = *(const f32x4*)(bm + col0 + bj * HALF + 4 * n);
#pragma unroll
        for (int ai = 0; ai < 2; ++ai)
#pragma unroll
            for (int m = 0; m < 4; ++m) { const size_t row = (size_t)(row0 + ai * HALF + m * 16);
#pragma unroll
                for (int bj = 0; bj < 2; ++bj) {
                    const u32x4 gw = *(const u32x4*)(G + row * ldg + col0 + bj * HALF); f32x4 g0, g1; unpack8(gw, g0, g1);
                    f32x4 t0, t1; unpack8(*(const u32x4*)(T + row * 1024 + col0 + bj * HALF), t0, t1);
                    f32x4 o0, o1;
#pragma unroll
                    for (int j = 0; j < 4; ++j) { o0[j] = t0[j] + ep_sigmoid(g0[j] + bv[bj][0][j]) * acc[ai][bj][m][0][j]; o1[j] = t1[j] + ep_sigmoid(g1[j] + bv[bj][1][j]) * acc[ai][bj][m][1][j]; }
                    u32x4 w; w.x = cvt_pk_bf16(o0[0], o0[1]); w.y = cvt_pk_bf16(o0[2], o0[3]); w.z = cvt_pk_bf16(o1[0], o1[1]); w.w = cvt_pk_bf16(o1[2], o1[3]);
                    *(u32x4*)(U + row * 1024 + col0 + bj * HALF) = w; } }
    }
};
struct EpiRes {
    static constexpr bool PERM = true, AFTER_DRAIN = false;
    bf16_t* X; const float* gate; int ldgate;
    __device__ __forceinline__ void operator()(const f32x4 (&acc)[2][2][4][2], const Unit& u, int wr, int wc, int fr, int fq) const {
        const int row0 = u.pm * BM + wr * 64 + fr, col0 = u.pn * BM + wc * 32 + 8 * fq;
        const float* gp = gate + (size_t)((u.pm * BM) >> 11) * ldgate + col0;
        f32x4 gv[2][2];
#pragma unroll
        for (int bj = 0; bj < 2; ++bj)
#pragma unroll
            for (int n = 0; n < 2; ++n) gv[bj][n] = *(const f32x4*)(gp + bj * HALF + 4 * n);
#pragma unroll
        for (int ai = 0; ai < 2; ++ai)
#pragma unroll
            for (int m = 0; m < 4; ++m) { bf16_t* xp = X + (size_t)(row0 + ai * HALF + m * 16) * 1024 + col0;
#pragma unroll
                for (int bj = 0; bj < 2; ++bj) { const u32x4 xw = *(const u32x4*)(xp + bj * HALF); f32x4 x0, x1; unpack8(xw, x0, x1);
                    const f32x4 o0 = x0 + gv[bj][0] * acc[ai][bj][m][0], o1 = x1 + gv[bj][1] * acc[ai][bj][m][1];
                    u32x4 ow; ow.x = cvt_pk_bf16(o0[0], o0[1]); ow.y = cvt_pk_bf16(o0[2], o0[3]); ow.z = cvt_pk_bf16(o1[0], o1[1]); ow.w = cvt_pk_bf16(o1[2], o1[3]);
                    *(u32x4*)(xp + bj * HALF) = ow; } }
    }
};


#ifndef GEMM_ALIGN
#define GEMM_ALIGN true
#endif
#ifndef GEMM_SP2
#define GEMM_SP2 true
#endif
template <class Epi, class Sched, bool ALIGN_EPI = GEMM_ALIGN, bool SP2 = GEMM_SP2>
__device__ __forceinline__ void gemm_phase(PG8_LAS unsigned char* lds, const Gemm g, const Sched& S, const Epi& E, unsigned long long*  , int tid_in) {
    int tid_ = tid_in; asm volatile("" : "+v"(tid_));
    const int tid = tid_, wid = __builtin_amdgcn_readfirstlane(tid >> 6), lane = tid & 63, wr = wid >> 2, wc = wid & 3, fr = lane & 15, fq = lane >> 4;
    const int K = g.K, nt = K / BK;
    unsigned voffA[2], voffB[2];
#pragma unroll
    for (int i = 0; i < 2; ++i) { int R, C; stage_rc(tid * 16 + i * 8192, R, C); const int Rb = Epi::PERM ? ((R & ~31) + perm32(R & 31)) : R;
        voffA[i] = (unsigned)(R * K + C) * 2u; voffB[i] = (unsigned)(Rb * K + C) * 2u; }
    const size_t kstep = (size_t)(BK * 2);
    const size_t hstep = (size_t)HALF * K * 2;
    const size_t tstep = 2 * hstep;
    const unsigned ldsw = (unsigned)wid * 1024u;
    const int aoff = lds_byte(wr * 64 + fr, fq * 8), boff = lds_byte(wc * 32 + fr, fq * 8);
#define PG8_SA(b, h) (((b) * 2 + (h)) * HTB)
#define PG8_SB(b, h) ((4 + (b) * 2 + (h)) * HTB)
#define PG8_STAGE(bufoff, gbase, voff) do { _Pragma("unroll") for (int _i = 0; _i < 2; ++_i) \
        __builtin_amdgcn_global_load_lds((const unsigned*)((const char*)(gbase) + (voff)[_i]), (PG8_LAS unsigned*)(lds + (bufoff) + ldsw + _i * 8192), 16, 0, 0); } while (0)
#define PG8_LDA(dst, b, h) do { _Pragma("unroll") for (int m = 0; m < 4; ++m) _Pragma("unroll") for (int k = 0; k < 2; ++k) dst[m][k] = *(const PG8_LAS bf16x8*)(lds + PG8_SA(b, h) + aoff + m * 2048 + k * 1024); } while (0)
#define PG8_LDB(dst, b, h) do { _Pragma("unroll") for (int n = 0; n < 2; ++n) _Pragma("unroll") for (int k = 0; k < 2; ++k) dst[n][k] = *(const PG8_LAS bf16x8*)(lds + PG8_SB(b, h) + boff + n * 2048 + k * 1024); } while (0)
#define PG8_MMA(ai, bj, At, Bt) do { __builtin_amdgcn_s_setprio(1); _Pragma("unroll") for (int m = 0; m < 4; ++m) _Pragma("unroll") for (int n = 0; n < 2; ++n) _Pragma("unroll") for (int k = 0; k < 2; ++k) \
        acc[ai][bj][m][n] = __builtin_amdgcn_mfma_f32_16x16x32_bf16(Bt[n][k], At[m][k], acc[ai][bj][m][n], 0, 0, 0); __builtin_amdgcn_s_setprio(0); } while (0)
#define PG8_WAIT_V(n) asm volatile("s_waitcnt vmcnt(" #n ")" ::: "memory")
#define PG8_WAIT_L(n) asm volatile("s_waitcnt lgkmcnt(" #n ")" ::: "memory")
#define PG8_BAR __builtin_amdgcn_s_barrier()
#define PG8_SCHED __builtin_amdgcn_sched_barrier(0)
    Unit cur, nxt; int ui = 0;
    if (!S.next(0, cur)) return;
    f32x4 acc[2][2][4][2];
#pragma unroll
    for (int a = 0; a < 2; ++a)
#pragma unroll
        for (int b = 0; b < 2; ++b)
#pragma unroll
            for (int m = 0; m < 4; ++m)
#pragma unroll
                for (int n = 0; n < 2; ++n) acc[a][b][m][n] = (f32x4){0.f, 0.f, 0.f, 0.f};
    bf16x8 At[4][2], B0[2][2], B1[2][2];
    const char* cA = (const char*)g.A + (size_t)cur.pm * tstep; const char* cB = (const char*)g.Bt + (size_t)cur.pn * tstep;
    S.a_ready(cur);
    if constexpr (SP2) {
        PG8_STAGE(PG8_SB(0, 0), cB, voffB); PG8_STAGE(PG8_SB(0, 1), cB + hstep, voffB); PG8_STAGE(PG8_SA(0, 0), cA, voffA); PG8_STAGE(PG8_SA(0, 1), cA + hstep, voffA);
        if (wr == 1) PG8_BAR;
        PG8_WAIT_V(2); PG8_BAR;
        PG8_STAGE(PG8_SB(1, 0), cB + kstep, voffB); PG8_STAGE(PG8_SA(1, 0), cA + kstep, voffA); PG8_STAGE(PG8_SB(1, 1), cB + hstep + kstep, voffB);
        PG8_WAIT_V(6); PG8_BAR;
    } else {
        PG8_STAGE(PG8_SB(0, 0), cB, voffB); PG8_STAGE(PG8_SA(0, 0), cA, voffA); PG8_STAGE(PG8_SB(0, 1), cB + hstep, voffB); PG8_STAGE(PG8_SA(0, 1), cA + hstep, voffA);
        if (wr == 1) PG8_BAR;
        PG8_WAIT_V(4); PG8_BAR;
        PG8_STAGE(PG8_SB(1, 0), cB + kstep, voffB); PG8_STAGE(PG8_SA(1, 0), cA + kstep, voffA); PG8_STAGE(PG8_SB(1, 1), cB + hstep + kstep, voffB);
        PG8_WAIT_V(6); PG8_BAR;
    }
    for (;;) {
        const bool has_next = S.next(ui + 1, nxt);
        const char* nA = has_next ? (const char*)g.A + (size_t)nxt.pm * tstep : cA; const char* nB = has_next ? (const char*)g.Bt + (size_t)nxt.pn * tstep : cB;
        for (int t = 0; t < nt; t += 2) {
            const bool last = (t == nt - 2);
            const char* a1 = cA + (size_t)(t + 1) * kstep;
            const char* a2 = last ? nA : cA + (size_t)(t + 2) * kstep; const char* b2 = last ? nB : cB + (size_t)(t + 2) * kstep;
            const char* a3 = a2 + kstep; const char* b3 = b2 + kstep;
            if (last && has_next) S.a_ready(nxt);
            if constexpr (SP2) {
            PG8_LDB(B0, 0, 0); PG8_LDB(B1, 0, 1); PG8_SCHED; PG8_LDA(At, 0, 0); PG8_STAGE(PG8_SA(1, 1), a1 + hstep, voffA);
            PG8_WAIT_V(8); PG8_WAIT_L(0); PG8_BAR; PG8_MMA(0, 0, At, B0); PG8_MMA(0, 1, At, B1); PG8_BAR; PG8_SCHED;
            PG8_LDA(At, 0, 1); PG8_STAGE(PG8_SB(0, 0), b2, voffB); PG8_STAGE(PG8_SB(0, 1), b2 + hstep, voffB); PG8_STAGE(PG8_SA(0, 0), a2, voffA);
            PG8_WAIT_V(8); PG8_WAIT_L(0); PG8_BAR; PG8_MMA(1, 0, At, B0); PG8_MMA(1, 1, At, B1); PG8_BAR; PG8_SCHED;
            PG8_LDB(B0, 1, 0); PG8_LDB(B1, 1, 1); PG8_SCHED; PG8_LDA(At, 1, 0); PG8_STAGE(PG8_SA(0, 1), a2 + hstep, voffA);
            PG8_WAIT_V(8); PG8_WAIT_L(0); PG8_BAR; PG8_MMA(0, 0, At, B0); PG8_MMA(0, 1, At, B1); PG8_BAR; PG8_SCHED;
            PG8_LDA(At, 1, 1); PG8_STAGE(PG8_SB(1, 0), b3, voffB); PG8_STAGE(PG8_SB(1, 1), b3 + hstep, voffB); PG8_STAGE(PG8_SA(1, 0), a3, voffA);
            PG8_WAIT_V(8); PG8_WAIT_L(0); PG8_BAR; PG8_MMA(1, 0, At, B0); PG8_MMA(1, 1, At, B1); PG8_BAR; PG8_SCHED;
            } else {
            PG8_LDB(B0, 0, 0); PG8_SCHED; PG8_LDA(At, 0, 0); PG8_STAGE(PG8_SA(1, 1), a1 + hstep, voffA);
            PG8_WAIT_L(8); PG8_BAR; PG8_WAIT_L(0); PG8_MMA(0, 0, At, B0); PG8_BAR; PG8_SCHED;
            PG8_LDB(B1, 0, 1); PG8_STAGE(PG8_SB(0, 0), b2, voffB);
            PG8_BAR; PG8_WAIT_L(0); PG8_MMA(0, 1, At, B1); PG8_BAR;
            PG8_LDA(At, 0, 1); PG8_STAGE(PG8_SA(0, 0), a2, voffA);
            PG8_BAR; PG8_WAIT_L(0); PG8_MMA(1, 0, At, B0); PG8_BAR; PG8_SCHED;
            PG8_STAGE(PG8_SB(0, 1), b2 + hstep, voffB);
            PG8_WAIT_V(6); PG8_BAR; PG8_MMA(1, 1, At, B1); PG8_BAR;
            PG8_LDB(B0, 1, 0); PG8_SCHED; PG8_LDA(At, 1, 0); PG8_STAGE(PG8_SA(0, 1), a2 + hstep, voffA);
            PG8_WAIT_L(8); PG8_BAR; PG8_WAIT_L(0); PG8_MMA(0, 0, At, B0); PG8_BAR; PG8_SCHED;
            PG8_LDB(B1, 1, 1); PG8_STAGE(PG8_SB(1, 0), b3, voffB);
            PG8_BAR; PG8_WAIT_L(0); PG8_MMA(0, 1, At, B1); PG8_BAR;
            PG8_LDA(At, 1, 1); PG8_STAGE(PG8_SA(1, 0), a3, voffA);
            PG8_BAR; PG8_WAIT_L(0); PG8_MMA(1, 0, At, B0); PG8_BAR; PG8_SCHED;
            PG8_STAGE(PG8_SB(1, 1), b3 + hstep, voffB);
            PG8_WAIT_V(6); PG8_BAR; PG8_MMA(1, 1, At, B1); PG8_BAR;
            }
        }
        if constexpr (ALIGN_EPI) { if (wr == 0) PG8_BAR; }
        if constexpr (!Epi::AFTER_DRAIN) { E(acc, cur, wr, wc, fr, fq); S.done(cur); }
        if (!has_next) break;
#pragma unroll
        for (int a = 0; a < 2; ++a)
#pragma unroll
            for (int b = 0; b < 2; ++b)
#pragma unroll
                for (int m = 0; m < 4; ++m)
#pragma unroll
                    for (int n = 0; n < 2; ++n) acc[a][b][m][n] = (f32x4){0.f, 0.f, 0.f, 0.f};
        cur = nxt; cA = nA; cB = nB; ++ui;
        if constexpr (ALIGN_EPI) { if (wr == 1) PG8_BAR; }
    }
    PG8_WAIT_V(0);
    if constexpr (!ALIGN_EPI) { if (wr == 0) PG8_BAR; }
    PG8_BAR;
    if constexpr (Epi::AFTER_DRAIN) { E.fused(acc, cur, wr, wc, fr, fq, lds, wid, lane); S.done(cur); }
#undef PG8_SA
#undef PG8_SB
#undef PG8_STAGE
#undef PG8_LDA
#undef PG8_LDB
#undef PG8_MMA
#undef PG8_WAIT_V
#undef PG8_WAIT_L
#undef PG8_BAR
#undef PG8_SCHED
}
}

#define XB_TMO      128
#define XB_XCNT(j)  (256  + 64 * (j))
#define XB_XSUB(j)  (1280 + 64 * (j))
#define XB_XGEN(j)  (2304 + 64 * (j))
#define XB_TOP      3328
#define XB_TOPGEN   3392
#define XCD_BAR_WORDS 3456
#define XB_SPIN_CAP (1u << 18)
#define LAS __attribute__((address_space(3)))

__device__ __forceinline__ unsigned xb_ld(unsigned* p)              { return __hip_atomic_load(p, __ATOMIC_RELAXED, __HIP_MEMORY_SCOPE_AGENT); }
__device__ __forceinline__ unsigned xb_add(unsigned* p, unsigned v) { return __hip_atomic_fetch_add(p, v, __ATOMIC_RELAXED, __HIP_MEMORY_SCOPE_AGENT); }
__device__ __forceinline__ unsigned xb_xcc_id() { return (unsigned)__builtin_amdgcn_s_getreg((3 << 11) | 20) & 0xFu; }
#define XB_SPIN(cond, bar) do { unsigned _sp = 0; while (cond) { __builtin_amdgcn_s_sleep(1); \
    if ((++_sp & 255u) == 0u) { if (xb_ld(&(bar)[XB_TMO])) break; if (_sp > XB_SPIN_CAP) { atomicAdd(&(bar)[XB_TMO], 1u); break; } } } } while (0)

struct XcdBarrier {
    unsigned* bar; unsigned x;
    volatile LAS unsigned* st;
};

__device__ __forceinline__ XcdBarrier xcd_barrier_post(unsigned* bar, volatile LAS unsigned* st, int tid) {
    XcdBarrier b; b.bar = bar; b.x = (unsigned)__builtin_amdgcn_readfirstlane((int)xb_xcc_id()); b.st = st;
    if (tid == 0) (void)xb_add(&bar[XB_XCNT(b.x)], 1u);
    return b;
}
__device__ __forceinline__ void xcd_barrier_complete(unsigned* bar, unsigned x, unsigned& nloc, unsigned& nx) {
    const unsigned G = gridDim.x * gridDim.y * gridDim.z;
    unsigned sum, cnt, mine, sp = 0u;
    for (;;) {
        sum = 0u; cnt = 0u; mine = 0u;
#pragma unroll
        for (unsigned j = 0; j < 16; ++j) { const unsigned c = xb_ld(&bar[XB_XCNT(j)]); sum += c; cnt += (c > 0u) ? 1u : 0u; mine = (j == x) ? c : mine; }
        if (sum == G) break;
        __builtin_amdgcn_s_sleep(1);
        if ((++sp & 255u) == 0u) { if (xb_ld(&bar[XB_TMO])) break; if (sp > XB_SPIN_CAP) { atomicAdd(&bar[XB_TMO], 1u); break; } }
    }
    nloc = mine > 0u ? mine : 1u; nx = cnt > 0u ? cnt : 1u;
}

__device__ __forceinline__ void xcd_barrier(const XcdBarrier& b, int tid) {
    asm volatile("s_waitcnt vmcnt(0)" ::: "memory");
    __syncthreads();
    if (tid == 0) {
        unsigned* bar = b.bar; unsigned bx_ = b.x; asm volatile("" : "+s"(bar), "+s"(bx_));
        __builtin_amdgcn_s_waitcnt(0);
        unsigned nloc = b.st[0], nx = b.st[1];
        if (nloc == 0u) { xcd_barrier_complete(bar, bx_, nloc, nx); b.st[0] = nloc; b.st[1] = nx; }
        const unsigned old = xb_add(&bar[XB_XSUB(bx_)], 1u);
        const unsigned gen = old / nloc;
        if (old + 1u == (gen + 1u) * nloc) {
            __builtin_amdgcn_fence(__ATOMIC_RELEASE, "agent");
            asm volatile("s_waitcnt vmcnt(0)" ::: "memory");
            const unsigned og = xb_add(&bar[XB_TOP], 1u);
            const unsigned tg = og / nx;
            if (og + 1u == (tg + 1u) * nx) xb_add(&bar[XB_TOPGEN], 1u);
            else XB_SPIN(xb_ld(&bar[XB_TOPGEN]) == tg, bar);
            __builtin_amdgcn_fence(__ATOMIC_ACQUIRE, "agent");
            xb_add(&bar[XB_XGEN(bx_)], 1u);
            asm volatile("s_waitcnt vmcnt(0)" ::: "memory");
        } else {
            XB_SPIN(xb_ld(&bar[XB_XGEN(bx_)]) == gen, bar);
            __builtin_amdgcn_fence(__ATOMIC_ACQUIRE, "agent");
            asm volatile("s_waitcnt vmcnt(0)" ::: "memory");
        }
    }
    __syncthreads();
}


typedef unsigned v4u __attribute__((ext_vector_type(4)));
typedef float f32x4 __attribute__((ext_vector_type(4)));
#define LDS_WAIT() asm volatile("s_waitcnt lgkmcnt(0)" ::: "memory")
constexpr int NWAVES = 8, NTHREADS = 512;
constexpr int RING_BYTES = 131072, LDS_BYTES = 155648;

struct P { const float* in[N_IN]; float* out; unsigned char* ws; };

template <int M> __device__ __forceinline__ float swz_xor(float v) { static_assert(M >= 1 && M < 32, "swizzle xor mask"); return __int_as_float(__builtin_amdgcn_ds_swizzle(__float_as_int(v), (M << 10) | 0x1f)); }
__device__ __forceinline__ float xor32_sum(float v) { auto r = __builtin_amdgcn_permlane32_swap(__float_as_uint(v), __float_as_uint(v), false, false); return __uint_as_float(r[0]) + __uint_as_float(r[1]); }
__device__ __forceinline__ float wave_sum(float v) {
    v += swz_xor<1>(v); v += swz_xor<2>(v); v += swz_xor<4>(v); v += swz_xor<8>(v); v += swz_xor<16>(v);
    return xor32_sum(v);
}

template <bool VPERM = false>
__device__ __forceinline__ void transpose_item(const float* W, int K, int N, bf16* WT, int k0, int n0, int drow0, LAS float* scr, int lane) {
    float tv[32];
#pragma unroll
    for (int i = 0; i < 32; ++i) { const int kk = 2 * i + (lane >> 5); tv[i] = W[(size_t)(k0 + kk) * N + n0 + (lane & 31)]; }
#pragma unroll
    for (int i = 0; i < 32; ++i) { const int kk = 2 * i + (lane >> 5); scr[kk * 33 + (lane & 31)] = tv[i]; }
    LDS_WAIT(); asm volatile("" ::: "memory");
    const int c = lane & 7;
#pragma unroll
    for (int j = 0; j < 4; ++j) { const int n = (lane >> 3) + 8 * j; const LAS float* s = scr + (8 * c) * 33 + n;
        v4u o; o.x = pk2(s[0 * 33], s[1 * 33]); o.y = pk2(s[2 * 33], s[3 * 33]); o.z = pk2(s[4 * 33], s[5 * 33]); o.w = pk2(s[6 * 33], s[7 * 33]);
        const int dr = VPERM ? (((drow0 + n) & ~127) + hg_vpos((drow0 + n) & 127)) : (drow0 + n);
        *(v4u*)(WT + (size_t)dr * K + k0 + 8 * c) = o; }
    LDS_WAIT(); asm volatile("" ::: "memory");
}

struct TItem { const float* W; bf16* WT; int K, N, k0, n0, dr, vperm; };
__device__ __forceinline__ void titem_decode(TItem& t, const P& p, unsigned char* ws, int it, int IT_L) {
    constexpr int IT_ADA = 16 * 192, IT_IN = 16 * 385, IT_BRA = 16 * 32, IT_BRB = 32 * 32, IT_OUT = 16 * 32, IT_UP = 16 * 128;
    const int l = it / IT_L; int r = it % IT_L;
    unsigned char* wl = ws + WS_W + (size_t)l * W_LSTRIDE; t.vperm = 0;
    if (r < IT_ADA) { const int kb = r / 192, nb = r % 192; t.W = p.in[I_WADA] + (size_t)l * D * 6144; t.K = D; t.N = 6144; t.WT = (bf16*)(ws + WS_WADA) + (size_t)l * 6144 * D; t.k0 = kb * 64; t.n0 = nb * 32; t.dr = nb * 32; return; } r -= IT_ADA;
    if (r < IT_IN) { const int kb = r / 385, nb = r % 385; const int n0 = nb * 32; t.W = p.in[I_WIN] + (size_t)l * D * IN_WIDTH; t.K = D; t.N = IN_WIDTH; t.WT = (bf16*)(wl + WO_IN); t.k0 = kb * 64; t.n0 = n0;
        t.dr = n0 < 10240 ? n0 : (n0 < 10272 ? PC_DT + (n0 - 10240) : n0 - 32); t.vperm = (n0 >= PC_I && n0 < PC_OG) ? 1 : 0; return; } r -= IT_IN;
    if (r < IT_BRA) { const int kb = r / 32, nb = r % 32; t.W = p.in[I_WBRA] + (size_t)l * 1024 * 1024; t.K = 1024; t.N = 1024; t.WT = (bf16*)(wl + WO_BRA); t.k0 = kb * 64; t.n0 = nb * 32; t.dr = nb * 32; return; } r -= IT_BRA;
    if (r < IT_BRB) { const int kb = r / 32, nb = r % 32; t.W = p.in[I_WBRB] + (size_t)l * 2048 * 1024; t.K = 2048; t.N = 1024; t.WT = (bf16*)(wl + WO_BRB); t.k0 = kb * 64; t.n0 = nb * 32; t.dr = nb * 32; return; } r -= IT_BRB;
    if (r < IT_OUT) { const int kb = r / 32, nb = r % 32; t.W = p.in[I_WOUT] + (size_t)l * 1024 * 1024; t.K = 1024; t.N = 1024; t.WT = (bf16*)(wl + WO_OUT); t.k0 = kb * 64; t.n0 = nb * 32; t.dr = nb * 32; return; } r -= IT_OUT;
    if (r < IT_UP) { const int kb = r / 128, nb = r % 128; t.W = p.in[I_WUP] + (size_t)l * 1024 * 4096; t.K = 1024; t.N = 4096; t.WT = (bf16*)(wl + WO_UP); t.k0 = kb * 64; t.n0 = nb * 32; t.dr = nb * 32; return; } r -= IT_UP;
    { const int kb = r / 32, nb = r % 32; t.W = p.in[I_WDOWN] + (size_t)l * 4096 * 1024; t.K = 4096; t.N = 1024; t.WT = (bf16*)(wl + WO_DOWN); t.k0 = kb * 64; t.n0 = nb * 32; t.dr = nb * 32; }
}
__device__ __forceinline__ void titem_load(float (&tv)[32], const TItem& t, int lane) {
    const float* wp = t.W + (size_t)(t.k0 + (lane >> 5)) * t.N + t.n0 + (lane & 31); const size_t st = (size_t)2 * t.N;
#pragma unroll
    for (int i = 0; i < 32; ++i) tv[i] = wp[(size_t)i * st];
}
__device__ __forceinline__ void titem_store(const float (&tv)[32], const TItem& t, LAS float* scr, int lane) {
#pragma unroll
    for (int i = 0; i < 32; ++i) { const int kk = 2 * i + (lane >> 5); scr[kk * 33 + (lane & 31)] = tv[i]; }
    LDS_WAIT(); asm volatile("" ::: "memory");
    const int c = lane & 7;
#pragma unroll
    for (int j = 0; j < 4; ++j) { const int n = (lane >> 3) + 8 * j; const LAS float* s = scr + (8 * c) * 33 + n;
        v4u o; o.x = pk2(s[0 * 33], s[1 * 33]); o.y = pk2(s[2 * 33], s[3 * 33]); o.z = pk2(s[4 * 33], s[5 * 33]); o.w = pk2(s[6 * 33], s[7 * 33]);
        const int dn = t.dr + n; const int dr = t.vperm ? ((dn & ~127) + hg_vpos(dn & 127)) : dn;
        *(v4u*)(t.WT + (size_t)dr * t.K + t.k0 + 8 * c) = o; }
    LDS_WAIT(); asm volatile("" ::: "memory");
}
__device__ __forceinline__ void phase_prologue(const P& p, LAS unsigned char* lds, int gw, int NGW, int lane, int wave) {
    LAS float* scr = (LAS float*)(lds + wave * 16384);
    unsigned char* ws = p.ws;
    constexpr int IT_ADA = 16 * 192, IT_IN = 16 * 385, IT_BRA = 16 * 32, IT_BRB = 32 * 32, IT_OUT = 16 * 32, IT_UP = 16 * 128, IT_DOWN = 64 * 32;
    constexpr int IT_L = IT_ADA + IT_IN + IT_BRA + IT_BRB + IT_OUT + IT_UP + IT_DOWN;
    for (int it = gw; it < DEPTH * IT_L; it += 2 * NGW) {
        TItem a, b2; titem_decode(a, p, ws, it, IT_L); const bool hb = it + NGW < DEPTH * IT_L; titem_decode(b2, p, ws, hb ? it + NGW : it, IT_L);
        float ta[32], tb[32];
        titem_load(ta, a, lane); if (hb) titem_load(tb, b2, lane);
        titem_store(ta, a, scr, lane); if (hb) titem_store(tb, b2, scr, lane);
    }
    for (int i = gw * 64 + lane; i < DEPTH * 28672; i += NGW * 64) { const int l = i / 28672, r = i % 28672;
        ((v4u*)(ws + WS_W + (size_t)l * W_LSTRIDE + WO_IN + (size_t)IN_WIDTH * D * 2))[r] = (v4u){0u, 0u, 0u, 0u}; }
    for (int i = gw * 64 + lane; i < 256 * 1024; i += NGW * 64) { const int r = i >> 10, c = i & 1023;
        float v = 0.f; if (r < NB) v = p.in[I_CP][r * D + c]; else if (r < NCOND) v = p.in[I_CS][(r - NB) * D + c];
        ((bf16*)(ws + WS_AC))[i] = f2bf(siluf_(v)); }
    for (int c = gw * 64 + lane; c < 1024; c += NGW * 64) { float v[DEPTH], mx = -3.0e38f;
#pragma unroll
        for (int l = 0; l < DEPTH; ++l) { v[l] = p.in[I_LB][l * 1024 + c]; mx = fmaxf(mx, v[l]); }
        float s = 0.f;
#pragma unroll
        for (int l = 0; l < DEPTH; ++l) { v[l] = expf(v[l] - mx); s += v[l]; }
        float cum = 0.f; float* lbs = (float*)(ws + WS_LBS);
#pragma unroll
        for (int l = 0; l < DEPTH; ++l) { if (l > 0) cum += v[l] / s; lbs[l * 1024 + c] = cum; }
    }
}

__device__ __forceinline__ f32x4 unpack4(unsigned long long w) { const unsigned lo = (unsigned)w, hi = (unsigned)(w >> 32); return (f32x4){__uint_as_float(lo << 16), __uint_as_float(lo & 0xffff0000u), __uint_as_float(hi << 16), __uint_as_float(hi & 0xffff0000u)}; }
template <int MODE, int NR>
__device__ __forceinline__ void norm_rows(const float* X32, bf16* X, bf16* H, float* out32, const f32x4 (&mul)[4], const f32x4 (&sh)[4], int lane) {
    if constexpr (MODE == 1) {
        f32x4 v[NR][4];
#pragma unroll
        for (int r = 0; r < NR; ++r) { const f32x4* xr = (const f32x4*)(X32 + (size_t)r * D) + lane;
#pragma unroll
            for (int j = 0; j < 4; ++j) v[r][j] = xr[64 * j]; }
#pragma unroll
        for (int r = 0; r < NR; ++r) { float s = 0.f;
#pragma unroll
            for (int j = 0; j < 4; ++j) s += (v[r][j].x * v[r][j].x + v[r][j].y * v[r][j].y) + (v[r][j].z * v[r][j].z + v[r][j].w * v[r][j].w);
            const float rstd = rsqrtf(wave_sum(s) * (1.f / D) + EPS);
            unsigned long long* o8 = (unsigned long long*)(H + (size_t)r * D) + lane; unsigned long long* x8 = (unsigned long long*)(X + (size_t)r * D) + lane;
#pragma unroll
            for (int j = 0; j < 4; ++j) { const f32x4 y = v[r][j] * rstd * mul[j] + sh[j];
                x8[64 * j] = (unsigned long long)pk2(v[r][j].x, v[r][j].y) | ((unsigned long long)pk2(v[r][j].z, v[r][j].w) << 32);
                o8[64 * j] = (unsigned long long)pk2(y.x, y.y) | ((unsigned long long)pk2(y.z, y.w) << 32); } }
    } else {
        unsigned long long raw[NR][4];
#pragma unroll
        for (int r = 0; r < NR; ++r) { const unsigned long long* xr = (const unsigned long long*)(X + (size_t)r * D) + lane;
#pragma unroll
            for (int j = 0; j < 4; ++j) raw[r][j] = xr[64 * j]; }
#pragma unroll
        for (int r = 0; r < NR; ++r) { f32x4 v[4]; float s = 0.f;
#pragma unroll
            for (int j = 0; j < 4; ++j) { v[j] = unpack4(raw[r][j]); s += (v[j].x * v[j].x + v[j].y * v[j].y) + (v[j].z * v[j].z + v[j].w * v[j].w); }
            const float rstd = rsqrtf(wave_sum(s) * (1.f / D) + EPS);
            if constexpr (MODE == 2) { f32x4* o = (f32x4*)(out32 + (size_t)r * D) + lane;
#pragma unroll
                for (int j = 0; j < 4; ++j) o[64 * j] = v[j] * rstd * mul[j];
            } else { unsigned long long* o8 = (unsigned long long*)(H + (size_t)r * D) + lane;
#pragma unroll
                for (int j = 0; j < 4; ++j) { const f32x4 y = v[j] * rstd * mul[j] + sh[j]; o8[64 * j] = (unsigned long long)pk2(y.x, y.y) | ((unsigned long long)pk2(y.z, y.w) << 32); } } }
    }
}
template <int MODE>
__device__ __forceinline__ void phase_norm(const float* Xp32, const float* Xs32, bf16* X, bf16* H, const float* nw, const float* mod_sh, const float* mod_sc, int gw, int NGW, int lane) {
    f32x4 w4[4];
#pragma unroll
    for (int j = 0; j < 4; ++j) w4[j] = ((const f32x4*)nw)[lane + 64 * j];
    for (int b = gw; b < MP / 8; b += NGW) {
        const int ci = b >> 8; f32x4 mul[4], sh[4];
        const f32x4* shp = (const f32x4*)(mod_sh + (size_t)ci * MODLD) + lane; const f32x4* scp = (const f32x4*)(mod_sc + (size_t)ci * MODLD) + lane;
#pragma unroll
        for (int j = 0; j < 4; ++j) { sh[j] = shp[64 * j]; mul[j] = w4[j] * (scp[64 * j] + 1.0f); }
        const size_t ro = (size_t)b * 8 * D;
        norm_rows<MODE, MODE == 1 ? 4 : 8>(MODE == 1 ? Xp32 + ro : nullptr, X + ro, H + ro, nullptr, mul, sh, lane);
        if constexpr (MODE == 1) norm_rows<MODE, 4>(Xp32 + ro + 4 * D, X + ro + 4 * D, H + ro + 4 * D, nullptr, mul, sh, lane);
    }
    for (int sr = gw; sr < MS; sr += NGW) {
        const int ci = NB + sr; f32x4 mul[4], sh[4];
        const f32x4* shp = (const f32x4*)(mod_sh + (size_t)ci * MODLD) + lane; const f32x4* scp = (const f32x4*)(mod_sc + (size_t)ci * MODLD) + lane;
#pragma unroll
        for (int j = 0; j < 4; ++j) { sh[j] = shp[64 * j]; mul[j] = w4[j] * (scp[64 * j] + 1.0f); }
        const size_t ro = (size_t)(MP + sr) * D;
        norm_rows<MODE, 1>(MODE == 1 ? Xs32 + (size_t)sr * D : nullptr, X + ro, H + ro, nullptr, mul, sh, lane);
    }
}
__device__ __forceinline__ void phase_final(const bf16* X, float* out, const float* nw, int gw, int NGW, int lane) {
    f32x4 w4[4];
#pragma unroll
    for (int j = 0; j < 4; ++j) w4[j] = ((const f32x4*)nw)[lane + 64 * j];
    for (int b = gw; b < MP / 8; b += NGW) { const size_t ro = (size_t)b * 8 * D; norm_rows<2, 8>(nullptr, (bf16*)X + ro, nullptr, out + ro, w4, w4, lane); }
    for (int sr = gw; sr < MS; sr += NGW) { const size_t ro = (size_t)(MP + sr) * D; norm_rows<2, 1>(nullptr, (bf16*)X + ro, nullptr, out + ro, w4, w4, lane); }
}


typedef short s16x4 __attribute__((ext_vector_type(4)));
typedef short bf16x8 __attribute__((ext_vector_type(8)));
__device__ __forceinline__ f32x4 mfma16(bf16x8 a, bf16x8 b, f32x4 c) { return __builtin_amdgcn_mfma_f32_16x16x32_bf16(a, b, c, 0, 0, 0); }
__device__ __forceinline__ s16x4 tr_read4(LAS unsigned char* p) { return __builtin_amdgcn_ds_read_tr16_b64_v4i16((LAS s16x4*)p); }
#define SHFL_XOR(v, M) swz_xor<M>(v)
__device__ __forceinline__ float shfl_up_f(float v, int o, int lane) { return __int_as_float(__builtin_amdgcn_ds_bpermute((lane >= o ? lane - o : lane) << 2, __float_as_int(v))); }
__device__ __forceinline__ void sync_threads() { __syncthreads(); }
__device__ __forceinline__ float __builtin_amdgcn_exp2f_(float x) { return __builtin_amdgcn_exp2f(x); }
#ifdef HOST_EMU
#define FENCE_MEM() do {} while (0)
#define SCHED_FENCE() do {} while (0)
#define LAUNDER_PTR(p) do {} while (0)
#else
#define LAUNDER_PTR(p) asm volatile("" : "+v"(p))
#define FENCE_MEM() asm volatile("" ::: "memory")
#define SCHED_FENCE() __builtin_amdgcn_sched_barrier(0)
#endif
constexpr int RC = 64;
constexpr int NSEG = 4, SEGLEN = 512, NCH = SEGLEN / RC;
constexpr int PQ = 272;
constexpr int PX = 528;

struct RecurBufs {
    bf16* proj;
    bf16* xbcc;
    float* dtv;
    float* cum;
    float* cv;
    float* sseg;
    float* dseg;
    float* hseg;
    float* tseg;
    bf16* ohg;
    bf16* y;
};

__device__ __forceinline__ bf16x8 frag_rows(LAS unsigned char* img, int pitch, int row, int kcol) { return *(LAS bf16x8*)(img + row * pitch + kcol * 2); }
__device__ __forceinline__ bf16x8 frag_tr(LAS unsigned char* img, int pitch, int k0a, int k0b, int col0, int lane) {
    const int q = (lane & 15) >> 2, p = lane & 3;
    const s16x4 a = tr_read4(img + (k0a + q) * pitch + (col0 + 4 * p) * 2);
    const s16x4 b = tr_read4(img + (k0b + q) * pitch + (col0 + 4 * p) * 2);
    return (bf16x8){a[0], a[1], a[2], a[3], b[0], b[1], b[2], b[3]};
}
__device__ __forceinline__ bf16x8 scale_frag(bf16x8 f, float s) {
    bf16x8 o;
#pragma unroll
    for (int j = 0; j < 8; ++j) o[j] = (short)f2bf(bf2f((bf16)f[j]) * s);
    return o;
}
__device__ __forceinline__ bf16x8 scale_frag8(bf16x8 f, const float (&s)[8]) {
    bf16x8 o;
#pragma unroll
    for (int j = 0; j < 8; ++j) o[j] = (short)f2bf(bf2f((bf16)f[j]) * s[j]);
    return o;
}
__device__ __forceinline__ void stage_tile128(const bf16* g, size_t ld, LAS unsigned char* img, int tid) {
#pragma unroll
    for (int i = 0; i < 2; ++i) { const int idx = tid + i * 512, r = idx >> 4, c16 = idx & 15;
        *(LAS v4u*)(img + r * PQ + c16 * 16) = *(const v4u*)(g + (size_t)r * ld + c16 * 8); }
}

constexpr int HG_QT = 0, HG_KT = 17408, HG_V = 34816, HG_PART = 52224, HG_VEC1 = 54272, HG_ST = 52224, HG_VEC = 87040, HG_RED = 89088;

__device__ __forceinline__ void hgrn_state_update(f32x4 (&S)[8], LAS unsigned char* Kt, LAS unsigned char* V, const LAS float* escale, const LAS float* edec, int w, int lane) {
    const int c = lane & 15, g = lane >> 4;
    const f32x4 dc = *(const LAS f32x4*)(edec + 16 * w + 4 * g);
#pragma unroll
    for (int et = 0; et < 8; ++et) S[et] = S[et] * dc;
    const float es = escale[16 * w + c];
#pragma unroll
    for (int ks = 0; ks < 2; ++ks) {
        const bf16x8 A = scale_frag(frag_tr(Kt, PQ, 32 * ks + 8 * g, 32 * ks + 8 * g + 4, 16 * w, lane), es);
#pragma unroll
        for (int et = 0; et < 8; ++et) { const bf16x8 B = frag_tr(V, PQ, 32 * ks + 8 * g, 32 * ks + 8 * g + 4, 16 * et, lane); S[et] = mfma16(A, B, S[et]); }
        SCHED_FENCE();
    }
}

__device__ __forceinline__ void hgrn_pass1(const RecurBufs& rb, const float* lbs_l, int u, int tid, LAS unsigned char* lds) {
    const int b = u >> 5, h = (u >> 2) & 7, seg = u & 3, lane = tid & 63, w = tid >> 6;
    const int d = tid & 127, jq = tid >> 7;
    LAS unsigned char* Qt = lds + HG_QT; LAS unsigned char* Kt = lds + HG_KT; LAS unsigned char* V = lds + HG_V; LAS float* part = (LAS float*)(lds + HG_PART); LAS float* vec = (LAS float*)(lds + HG_VEC1);
    const float lb = lbs_l[h * 128 + d];
    f32x4 S[8];
#pragma unroll
    for (int et = 0; et < 8; ++et) S[et] = (f32x4){0.f, 0.f, 0.f, 0.f};
    float dprod = 1.f;
    const int sr = tid >> 4, sc16 = tid & 15;
    v4u pre[6];
    {   const bf16* gq = rb.proj + ((size_t)b * SEQ + seg * SEGLEN + sr) * LDP + PC_Q + h * 128 + sc16 * 8;
        pre[0] = *(const v4u*)gq; pre[1] = *(const v4u*)(gq + 32 * (size_t)LDP); pre[2] = *(const v4u*)(gq + PC_F); pre[3] = *(const v4u*)(gq + 32 * (size_t)LDP + PC_F);
        pre[4] = *(const v4u*)(gq + PC_I); pre[5] = *(const v4u*)(gq + 32 * (size_t)LDP + PC_I); }
    for (int ch = 0; ch < NCH; ++ch) {
        const size_t row0 = (size_t)b * SEQ + seg * SEGLEN + ch * RC;
        bf16* gq = rb.proj + (row0 + sr) * LDP + PC_Q + h * 128 + sc16 * 8;
        *(LAS v4u*)(Qt + sr * PQ + sc16 * 16) = pre[0]; *(LAS v4u*)(Qt + (sr + 32) * PQ + sc16 * 16) = pre[1];
        *(LAS v4u*)(Kt + sr * PQ + sc16 * 16) = pre[2]; *(LAS v4u*)(Kt + (sr + 32) * PQ + sc16 * 16) = pre[3];
        *(LAS v4u*)(V + sr * PQ + sc16 * 16) = pre[4]; *(LAS v4u*)(V + (sr + 32) * PQ + sc16 * 16) = pre[5];
        if (ch + 1 < NCH) { const bf16* gn = gq + RC * (size_t)LDP;
            pre[0] = *(const v4u*)gn; pre[1] = *(const v4u*)(gn + 32 * (size_t)LDP); pre[2] = *(const v4u*)(gn + PC_F); pre[3] = *(const v4u*)(gn + 32 * (size_t)LDP + PC_F);
            pre[4] = *(const v4u*)(gn + PC_I); pre[5] = *(const v4u*)(gn + 32 * (size_t)LDP + PC_I); }
        sync_threads();
        float qq[16], kk[16], lg[16];
#pragma unroll
        for (int j = 0; j < 16; ++j) { const float q = bf2f(*(const LAS bf16*)(Qt + (16 * jq + j) * PQ + d * 2)), f = bf2f(*(const LAS bf16*)(Kt + (16 * jq + j) * PQ + d * 2));
            const float fg = lb + (1.f - lb) * sigmoidf_(f);
            qq[j] = siluf_(q) * 0.08838834764831845f; kk[j] = 1.f - fg; lg[j] = __logf(fg); }
#pragma unroll
        for (int j = 1; j < 16; ++j) lg[j] += lg[j - 1];
        part[jq * 128 + d] = lg[15];
        sync_threads();
        const float p0 = part[d], p1 = part[128 + d], p2 = part[256 + d], p3 = part[384 + d];
        const float off = (jq > 0 ? p0 : 0.f) + (jq > 1 ? p1 : 0.f) + (jq > 2 ? p2 : 0.f);
        const float bref = p0 + p1, bend = (p0 + p1) + (p2 + p3);
#pragma unroll
        for (int j = 0; j < 16; ++j) { const float e1 = __expf(fminf(fmaxf(off + lg[j] - bref, -80.f), 80.f));
            *(LAS bf16*)(Qt + (16 * jq + j) * PQ + d * 2) = f2bf(qq[j] * e1); *(LAS bf16*)(Kt + (16 * jq + j) * PQ + d * 2) = f2bf(kk[j] * frcp_(e1)); }
        if (jq == 0) { const float eref = __expf(bref), esc = __expf(bend - bref), edc = __expf(bend);
            float* cvp = rb.cv + ((size_t)((b * 8 + h) * 32 + seg * NCH + ch) * 3) * 128;
            cvp[d] = eref; cvp[128 + d] = esc; cvp[256 + d] = edc; vec[128 + d] = esc; vec[256 + d] = edc; }
        dprod *= __expf(bend);
        sync_threads();
        *(v4u*)gq = *(const LAS v4u*)(Qt + sr * PQ + sc16 * 16); *(v4u*)(gq + 32 * (size_t)LDP) = *(const LAS v4u*)(Qt + (sr + 32) * PQ + sc16 * 16);
        *(v4u*)(gq + PC_F) = *(const LAS v4u*)(Kt + sr * PQ + sc16 * 16); *(v4u*)(gq + 32 * (size_t)LDP + PC_F) = *(const LAS v4u*)(Kt + (sr + 32) * PQ + sc16 * 16);
        hgrn_state_update(S, Kt, V, vec + 128, vec + 256, w, lane);
        sync_threads();
    }
    float* sp = rb.sseg + (size_t)u * 16384 + tid * 4;
#pragma unroll
    for (int et = 0; et < 8; ++et) { LAUNDER_PTR(sp); *(f32x4*)sp = S[et]; sp += 2048; }
    if (jq == 0) rb.dseg[u * 128 + d] = dprod;
}

__device__ __forceinline__ void hgrn_pass2(const RecurBufs& rb, const float* hgn_l, float* state_out_l, int u, int tid, LAS unsigned char* lds) {
    const int b = u >> 5, h = (u >> 2) & 7, seg = u & 3, lane = tid & 63, w = tid >> 6, c = lane & 15, g = lane >> 4;
    const int it = w & 3, eh = w >> 2;
    LAS unsigned char* Qt = lds + HG_QT; LAS unsigned char* Kt = lds + HG_KT; LAS unsigned char* V = lds + HG_V; LAS unsigned char* ST = lds + HG_ST;
    LAS float* vec = (LAS float*)(lds + HG_VEC); LAS float* red = (LAS float*)(lds + HG_RED);
    f32x4 S[8];
#pragma unroll
    for (int et = 0; et < 8; ++et) S[et] = (f32x4){0.f, 0.f, 0.f, 0.f};
    for (int s = 0; s < seg; ++s) { const int u2 = u - seg + s;
        const f32x4 dc = *(const f32x4*)(rb.dseg + u2 * 128 + 16 * w + 4 * g);
        const float* sp = rb.sseg + (size_t)u2 * 16384 + tid * 4;
#pragma unroll
        for (int et = 0; et < 8; ++et) { LAUNDER_PTR(sp); S[et] = S[et] * dc + *(const f32x4*)sp; sp += 2048; } }
    const int e0 = 64 * eh + 4 * c;
    const f32x4 hn = *(const f32x4*)(hgn_l + e0);
    const float* cvb = rb.cv + ((size_t)((b * 8 + h) * 32 + seg * NCH) * 3) * 128;
    const int sr = tid >> 4, sc16 = tid & 15;
    const size_t rowS = (size_t)b * SEQ + seg * SEGLEN;
    v4u pre[6];
    {   const bf16* gq = rb.proj + (rowS + sr) * LDP + PC_Q + h * 128 + sc16 * 8;
        pre[0] = *(const v4u*)gq; pre[1] = *(const v4u*)(gq + 32 * (size_t)LDP); pre[2] = *(const v4u*)(gq + PC_F); pre[3] = *(const v4u*)(gq + 32 * (size_t)LDP + PC_F);
        pre[4] = *(const v4u*)(gq + PC_I); pre[5] = *(const v4u*)(gq + 32 * (size_t)LDP + PC_I); }
    float cvn = tid < 384 ? cvb[tid] : 0.f; f32x4 ern = *(const f32x4*)(cvb + 16 * w + 4 * g);
    for (int ch = 0; ch < NCH; ++ch) {
        const size_t row0 = rowS + ch * RC;
        *(LAS v4u*)(Qt + sr * PQ + sc16 * 16) = pre[0]; *(LAS v4u*)(Qt + (sr + 32) * PQ + sc16 * 16) = pre[1];
        *(LAS v4u*)(Kt + sr * PQ + sc16 * 16) = pre[2]; *(LAS v4u*)(Kt + (sr + 32) * PQ + sc16 * 16) = pre[3];
        *(LAS v4u*)(V + sr * PQ + sc16 * 16) = pre[4]; *(LAS v4u*)(V + (sr + 32) * PQ + sc16 * 16) = pre[5];
        if (ch + 1 < NCH) { const bf16* gq = rb.proj + (row0 + RC + sr) * LDP + PC_Q + h * 128 + sc16 * 8;
            pre[0] = *(const v4u*)gq; pre[1] = *(const v4u*)(gq + 32 * (size_t)LDP); pre[2] = *(const v4u*)(gq + PC_F); pre[3] = *(const v4u*)(gq + 32 * (size_t)LDP + PC_F);
            pre[4] = *(const v4u*)(gq + PC_I); pre[5] = *(const v4u*)(gq + 32 * (size_t)LDP + PC_I); }
        if (tid < 384) vec[tid] = cvn;
        {
            const f32x4 er = ern;
            if (ch + 1 < NCH) { if (tid < 384) cvn = cvb[(size_t)(ch + 1) * 384 + tid]; ern = *(const f32x4*)(cvb + (size_t)(ch + 1) * 384 + 16 * w + 4 * g); }
#pragma unroll
            for (int et = 0; et < 8; ++et) { const f32x4 v = S[et] * er;
                *(LAS unsigned long long*)(ST + (16 * et + c) * PQ + (16 * w + 4 * g) * 2) = (unsigned long long)pk2(v[0], v[1]) | ((unsigned long long)pk2(v[2], v[3]) << 32); } }
        unsigned long long ogv[4];
#pragma unroll
        for (int r = 0; r < 4; ++r) ogv[r] = *(const unsigned long long*)(rb.proj + (row0 + 16 * it + 4 * g + r) * LDP + PC_OG + h * 128 + e0);
        sync_threads();
        bf16x8 Qfr[4];
#pragma unroll
        for (int kd = 0; kd < 4; ++kd) Qfr[kd] = frag_rows(Qt, PQ, 16 * it + c, 32 * kd + 8 * g);
        unsigned PT[4][2];
#pragma unroll
        for (int jt = 0; jt < 4; ++jt) {
            f32x4 acc = (f32x4){0.f, 0.f, 0.f, 0.f};
            if (jt <= it) {
#pragma unroll
                for (int kd = 0; kd < 4; ++kd) acc = mfma16(frag_rows(Kt, PQ, 16 * jt + c, 32 * kd + 8 * g), Qfr[kd], acc);
                if (jt == it) {
#pragma unroll
                    for (int r = 0; r < 4; ++r) acc[r] = (4 * g + r <= c) ? acc[r] : 0.f; }
            }
            PT[jt][0] = pk2(acc[0], acc[1]); PT[jt][1] = pk2(acc[2], acc[3]); SCHED_FENCE();
        }
        f32x4 o[4];
#pragma unroll
        for (int et = 0; et < 4; ++et) o[et] = (f32x4){0.f, 0.f, 0.f, 0.f};
#pragma unroll
        for (int ks = 0; ks < 2; ++ks) if (2 * ks <= it) {
            v4u pa = (v4u){PT[2 * ks][0], PT[2 * ks][1], PT[2 * ks + 1][0], PT[2 * ks + 1][1]};
            const bf16x8 A = __builtin_bit_cast(bf16x8, pa);
#pragma unroll
            for (int et = 0; et < 4; ++et) o[et] = mfma16(A, frag_tr(V, PQ, 32 * ks + 4 * g, 32 * ks + 16 + 4 * g, 16 * (4 * eh + et), lane), o[et]);
        }
#pragma unroll
        for (int kd = 0; kd < 4; ++kd) {
#pragma unroll
            for (int et = 0; et < 4; ++et) o[et] = mfma16(Qfr[kd], frag_rows(ST, PQ, 16 * (4 * eh + et) + c, 32 * kd + 8 * g), o[et]);
            SCHED_FENCE(); }
        hgrn_state_update(S, Kt, V, vec + 128, vec + 256, w, lane);
        float ss[4];
#pragma unroll
        for (int r = 0; r < 4; ++r) { float s = 0.f;
#pragma unroll
            for (int et = 0; et < 4; ++et) s += o[et][r] * o[et][r];
            s += SHFL_XOR(s, 1); s += SHFL_XOR(s, 2); s += SHFL_XOR(s, 4); s += SHFL_XOR(s, 8); ss[r] = s; }
        if (c == 0) {
#pragma unroll
            for (int r = 0; r < 4; ++r) red[(16 * it + 4 * g + r) * 2 + eh] = ss[r]; }
        sync_threads();
#pragma unroll
        for (int r = 0; r < 4; ++r) { const int i = 16 * it + 4 * g + r; const float rstd = rsqrtf((red[i * 2] + red[i * 2 + 1]) * (1.f / 128.f) + EPS);
            float ov[4];
#pragma unroll
            for (int et = 0; et < 4; ++et) { const float og = bf2f((bf16)(ogv[r] >> (16 * et))); ov[et] = o[et][r] * rstd * hn[et] * siluf_(og); }
            *(unsigned long long*)(rb.ohg + (row0 + i) * 1024 + h * 128 + e0) = (unsigned long long)pk2(ov[0], ov[1]) | ((unsigned long long)pk2(ov[2], ov[3]) << 32); }
        sync_threads();
    }
    if (seg == NSEG - 1) { float* so = state_out_l + (size_t)(b * 8 + h) * 16384 + (size_t)(16 * w + 4 * g) * 128 + 4 * c;
#pragma unroll
        for (int r = 0; r < 4; ++r)
#pragma unroll
            for (int a = 0; a < 2; ++a) *(f32x4*)(so + r * 128 + 64 * a) = (f32x4){S[4 * a][r], S[4 * a + 1][r], S[4 * a + 2][r], S[4 * a + 3][r]}; }
}

constexpr int PR = 1040;
constexpr int SD_T = 0, SD_H = 66560, SD_XO = 66560  , SD_DT = 136192, SD_CUM = 137216, SD_RED = 138240, SD_END = 139264;
__device__ __forceinline__ int ssd_gcol(int grp, int ch16) { return ch16 < 32 ? grp * 256 + ch16 * 8 : (ch16 < 48 ? 2048 + grp * 128 + (ch16 - 32) * 8 : 3072 + grp * 128 + (ch16 - 48) * 8); }

__device__ __forceinline__ void ssd_state_update(f32x4 (&H)[4][4], LAS unsigned char* Xi, int xp, LAS unsigned char* Bi, int bp, const LAS float* sDt, const LAS float* sCum, int w, int lane) {
    const int g = lane >> 4, k = w >> 1, nh = w & 1;
    const float tot = sCum[63 * 4 + k]; const float et = __expf(tot);
#pragma unroll
    for (int nt = 0; nt < 4; ++nt)
#pragma unroll
        for (int pt = 0; pt < 4; ++pt) H[nt][pt] = H[nt][pt] * et;
#pragma unroll
    for (int ks = 0; ks < 2; ++ks) {
        float wg[8];
#pragma unroll
        for (int j = 0; j < 8; ++j) wg[j] = __expf(tot - sCum[(32 * ks + 8 * g + j) * 4 + k]) * sDt[(32 * ks + 8 * g + j) * 4 + k];
        bf16x8 Bx[4];
#pragma unroll
        for (int pt = 0; pt < 4; ++pt) Bx[pt] = scale_frag8(frag_tr(Xi, xp, 32 * ks + 8 * g, 32 * ks + 8 * g + 4, 64 * k + 16 * pt, lane), wg);
#pragma unroll
        for (int nt = 0; nt < 4; ++nt) { const bf16x8 A = frag_tr(Bi, bp, 32 * ks + 8 * g, 32 * ks + 8 * g + 4, 16 * (4 * nh + nt), lane);
#pragma unroll
            for (int pt = 0; pt < 4; ++pt) H[nt][pt] = mfma16(A, Bx[pt], H[nt][pt]);
            SCHED_FENCE(); }
    }
}

typedef float f32x2r __attribute__((ext_vector_type(2)));
__device__ __forceinline__ f32x2r unpack2(unsigned w) { return (f32x2r){__uint_as_float(w << 16), __uint_as_float(w & 0xffff0000u)}; }
__device__ __forceinline__ f32x2r silu2(f32x2r a) {
    const f32x2r t = a * (-1.4426950408889634f); f32x2r e; e.x = __builtin_amdgcn_exp2f_(t.x); e.y = __builtin_amdgcn_exp2f_(t.y);
    const f32x2r d = e + 1.0f; f32x2r r; r.x = frcp_(d.x); r.y = frcp_(d.y); return a * r; }
constexpr int SD_RH = SD_XO + 64 * PX;
__device__ __forceinline__ void ssd_pass1(const RecurBufs& rb, const float* conv_w, const float* conv_b, const float* dt_bias, const float* a_log, float* conv_out_l, int u, int tid, LAS unsigned char* lds) {
    const int b = u >> 5, grp = (u >> 2) & 7, seg = u & 3, lane = tid & 63, w = tid >> 6;
    LAS unsigned char* T = lds + SD_T; LAS float* sDt = (LAS float*)(lds + SD_DT); LAS float* sCum = (LAS float*)(lds + SD_CUM); LAS unsigned char* RH = lds + SD_RH;
    const int cp = tid & 255, half = tid >> 8, t0c = 2 * cp;
    const int chx = t0c < 256 ? (grp * 256 + t0c) : (t0c < 384 ? (2048 + grp * 128 + (t0c - 256)) : (3072 + grp * 128 + (t0c - 384)));
    const int xcol = (t0c & ~63) + 16 * (t0c & 3) + ((t0c & 63) >> 2);
    const f32x2r w0 = (f32x2r){conv_w[chx], conv_w[chx + 1]}, w1 = (f32x2r){conv_w[4096 + chx], conv_w[4096 + chx + 1]}, w2 = (f32x2r){conv_w[8192 + chx], conv_w[8192 + chx + 1]},
                 w3 = (f32x2r){conv_w[12288 + chx], conv_w[12288 + chx + 1]}, cb = (f32x2r){conv_b[chx], conv_b[chx + 1]};
    const size_t rowS = (size_t)b * SEQ + seg * SEGLEN;
    if (half == 0) {
#pragma unroll
        for (int j = 0; j < 3; ++j) { unsigned v = 0u; if (seg > 0) v = *(const unsigned*)(rb.proj + (rowS - 3 + j) * LDP + PC_XBC + chx); *(LAS unsigned*)(RH + j * 1024 + cp * 4) = v; } }
    f32x4 H[4][4];
#pragma unroll
    for (int nt = 0; nt < 4; ++nt)
#pragma unroll
        for (int pt = 0; pt < 4; ++pt) H[nt][pt] = (f32x4){0.f, 0.f, 0.f, 0.f};
    float tsum = 0.f;
    const int ch16 = tid & 63, rr = tid >> 6;
    const int gcol = ssd_gcol(grp, ch16);
    LAS unsigned char* XO = lds + SD_XO;
    v4u raw[8];
    {   const bf16* gp = rb.proj + (rowS + rr) * LDP + PC_XBC + gcol;
#pragma unroll
        for (int i = 0; i < 8; ++i) { LAUNDER_PTR(gp); raw[i] = *(const v4u*)gp; gp += 8 * (size_t)LDP; } }
    bf16 dtn = 0;
    if (w < 4) dtn = rb.proj[(rowS + lane) * LDP + PC_DT + grp * 4 + w];
    unsigned hr0 = 0u, hr1 = 0u, hr2 = 0u;
    for (int ch = 0; ch < NCH; ++ch) {
        const size_t row0 = rowS + ch * RC;
        if (w < 4) {
            const int head = grp * 4 + w; const size_t row = row0 + lane;
            const float dv = softplusf_(bf2f(dtn) + dt_bias[head]);
            if (ch + 1 < NCH) dtn = rb.proj[(row + RC) * LDP + PC_DT + head];
            float la = dv * (-__expf(a_log[head]));
#pragma unroll
            for (int o = 1; o < 64; o <<= 1) { const float t = shfl_up_f(la, o, lane); if (lane >= o) la += t; }
            sDt[lane * 4 + w] = dv; sCum[lane * 4 + w] = la; rb.dtv[row * 32 + head] = dv; rb.cum[row * 32 + head] = la;
        }
#pragma unroll
        for (int i = 0; i < 8; ++i) *(LAS v4u*)(T + (rr + 8 * i) * PR + ch16 * 16) = raw[i];
        if (ch + 1 < NCH) { const bf16* gp = rb.proj + (row0 + RC + rr) * LDP + PC_XBC + gcol;
#pragma unroll
            for (int i = 0; i < 8; ++i) { LAUNDER_PTR(gp); raw[i] = *(const v4u*)gp; gp += 8 * (size_t)LDP; } }
        sync_threads();
        if (half == 0) { hr0 = *(const LAS unsigned*)(RH + cp * 4); hr1 = *(const LAS unsigned*)(RH + 1024 + cp * 4); hr2 = *(const LAS unsigned*)(RH + 2048 + cp * 4); }
        else { hr0 = *(const LAS unsigned*)(T + 29 * PR + cp * 4); hr1 = *(const LAS unsigned*)(T + 30 * PR + cp * 4); hr2 = *(const LAS unsigned*)(T + 31 * PR + cp * 4); }
        sync_threads();
        {
            f32x2r r0 = unpack2(hr0), r1 = unpack2(hr1), r2 = unpack2(hr2);
            const LAS unsigned char* src = T + (32 * half) * PR + cp * 4;
            unsigned lastw0 = hr0, lastw1 = hr1, lastw2 = hr2;
#pragma unroll 8
            for (int j = 0; j < 32; ++j) { const unsigned cw = *(const LAS unsigned*)(src + j * PR); const f32x2r cur = unpack2(cw);
                const f32x2r a = cb + w0 * r0 + w1 * r1 + w2 * r2 + w3 * cur; r0 = r1; r1 = r2; r2 = cur; lastw0 = lastw1; lastw1 = lastw2; lastw2 = cw;
                const f32x2r v = silu2(a); const unsigned ow = pk2(v.x, v.y);
                if (cp < 128) { LAS unsigned char* d = XO + (32 * half + j) * PX + xcol * 2; *(LAS bf16*)d = (bf16)ow; *(LAS bf16*)(d + 32) = (bf16)(ow >> 16); }
                else *(LAS unsigned*)(T + (32 * half + j) * PR + cp * 4) = ow; }
            if (half == 1) { *(LAS unsigned*)(RH + cp * 4) = lastw0; *(LAS unsigned*)(RH + 1024 + cp * 4) = lastw1; *(LAS unsigned*)(RH + 2048 + cp * 4) = lastw2;
                hr0 = lastw0; hr1 = lastw1; hr2 = lastw2; }
        }
        sync_threads();
        tsum += sCum[63 * 4 + (w >> 1)];
        ssd_state_update(H, XO, PX, T + 512, PR, sDt, sCum, w, lane);
        {   bf16* gp = rb.xbcc + (row0 + rr) * 4096 + gcol;
            const LAS unsigned char* src = ch16 < 32 ? (XO + ch16 * 16) : (T + ch16 * 16); const int spitch = ch16 < 32 ? PX : PR;
#pragma unroll
            for (int i = 0; i < 8; ++i) { LAUNDER_PTR(gp); *(v4u*)gp = *(const LAS v4u*)(src + (rr + 8 * i) * spitch); gp += 8 * 4096; } }
        sync_threads();
    }
    float* hp = rb.hseg + (size_t)u * 32768 + tid * 4;
#pragma unroll
    for (int nt = 0; nt < 4; ++nt)
#pragma unroll
        for (int pt = 0; pt < 4; ++pt) { LAUNDER_PTR(hp); *(f32x4*)hp = H[nt][pt]; hp += 2048; }
    if ((tid & 127) == 0) rb.tseg[u * 4 + (w >> 1)] = tsum;
    if (seg == NSEG - 1 && half == 1) { float* co = conv_out_l + (size_t)b * 3 * 4096;
        const f32x2r a0 = unpack2(hr0), a1 = unpack2(hr1), a2 = unpack2(hr2);
        co[chx] = a0.x; co[chx + 1] = a0.y; co[4096 + chx] = a1.x; co[4096 + chx + 1] = a1.y; co[8192 + chx] = a2.x; co[8192 + chx + 1] = a2.y; }
}

__device__ __forceinline__ void ssd_pass2(const RecurBufs& rb, const float* d_skip, const float* ssm_norm, float* state_out_l, int u, int tid, LAS unsigned char* lds) {
    const int b = u >> 5, grp = (u >> 2) & 7, seg = u & 3, lane = tid & 63, w = tid >> 6, c = lane & 15, g = lane >> 4;
    const int k = w >> 1, hf = w & 1, head = grp * 4 + k;
    LAS unsigned char* T = lds + SD_T; LAS unsigned char* sB = T + 512; LAS unsigned char* sC = T + 768; LAS unsigned char* hS = lds + SD_H + k * (64 * PQ);
    LAS float* sDt = (LAS float*)(lds + SD_DT); LAS float* sCum = (LAS float*)(lds + SD_CUM); LAS float* red = (LAS float*)(lds + SD_RED);
    f32x4 H[4][4];
#pragma unroll
    for (int nt = 0; nt < 4; ++nt)
#pragma unroll
        for (int pt = 0; pt < 4; ++pt) H[nt][pt] = (f32x4){0.f, 0.f, 0.f, 0.f};
    for (int s = 0; s < seg; ++s) { const int u2 = u - seg + s; const float dc = __expf(rb.tseg[u2 * 4 + k]); const float* hp = rb.hseg + (size_t)u2 * 32768 + tid * 4;
#pragma unroll
        for (int nt = 0; nt < 4; ++nt)
#pragma unroll
            for (int pt = 0; pt < 4; ++pt) { LAUNDER_PTR(hp); H[nt][pt] = H[nt][pt] * dc + *(const f32x4*)hp; hp += 2048; } }
    const float Dk = d_skip[head];
    const size_t rowS = (size_t)b * SEQ + seg * SEGLEN;
    const int ch16 = tid & 63, rr = tid >> 6; const int gcol = ssd_gcol(grp, ch16);
    const int chn0 = grp * 256 + k * 64 + 4 * c;
    for (int ch = 0; ch < NCH; ++ch) {
        const size_t row0 = rowS + ch * RC;
        {   v4u raw[8];
            {   const bf16* gp = rb.xbcc + (row0 + rr) * 4096 + gcol;
#pragma unroll
                for (int i = 0; i < 8; ++i) { LAUNDER_PTR(gp); raw[i] = *(const v4u*)gp; gp += 8 * 4096; } }
            if (tid < 256) { sDt[tid] = rb.dtv[(row0 + (tid >> 2)) * 32 + grp * 4 + (tid & 3)]; sCum[tid] = rb.cum[(row0 + (tid >> 2)) * 32 + grp * 4 + (tid & 3)]; }
#pragma unroll
            for (int nt = 0; nt < 4; ++nt)
#pragma unroll
                for (int pt = 0; pt < 4; ++pt) { const f32x4 v = H[nt][pt];
                    *(LAS unsigned long long*)(hS + (4 * c + pt) * PQ + (16 * (4 * hf + nt) + 4 * g) * 2) = (unsigned long long)pk2(v[0], v[1]) | ((unsigned long long)pk2(v[2], v[3]) << 32); }
#pragma unroll
            for (int i = 0; i < 8; ++i) *(LAS v4u*)(T + (rr + 8 * i) * PR + ch16 * 16) = raw[i]; }
        sync_threads();
#pragma unroll 1
        for (int i2 = 0; i2 < 2; ++i2) {
            const int it = i2 ? 3 - hf : hf;
            unsigned long long zz[4];
#pragma unroll
            for (int r = 0; r < 4; ++r) zz[r] = *(const unsigned long long*)(rb.proj + (row0 + 16 * it + 4 * g + r) * LDP + PC_Z + chn0);
            f32x4 ya[4];
#pragma unroll
            for (int pt = 0; pt < 4; ++pt) ya[pt] = (f32x4){0.f, 0.f, 0.f, 0.f};
#pragma unroll
            for (int kn = 0; kn < 4; ++kn) { const bf16x8 Cf = frag_rows(sC, PR, 16 * it + c, 32 * kn + 8 * g);
#pragma unroll
                for (int pt = 0; pt < 4; ++pt) ya[pt] = mfma16(Cf, frag_rows(hS, PQ, 4 * c + pt, 32 * kn + 8 * g), ya[pt]);
                SCHED_FENCE(); }
            {   float ei[4];
#pragma unroll
                for (int r = 0; r < 4; ++r) ei[r] = __expf(sCum[(16 * it + 4 * g + r) * 4 + k]);
#pragma unroll
                for (int pt = 0; pt < 4; ++pt)
#pragma unroll
                    for (int r = 0; r < 4; ++r) ya[pt][r] *= ei[r]; }
            const float cum_i = sCum[(16 * it + c) * 4 + k];
            unsigned PT[4][2];
#pragma unroll
            for (int jt = 0; jt < 4; ++jt) {
                f32x4 acc = (f32x4){0.f, 0.f, 0.f, 0.f};
                if (jt <= it) {
#pragma unroll
                    for (int kn = 0; kn < 4; ++kn) acc = mfma16(frag_rows(sB, PR, 16 * jt + c, 32 * kn + 8 * g), frag_rows(sC, PR, 16 * it + c, 32 * kn + 8 * g), acc);
#pragma unroll
                    for (int r = 0; r < 4; ++r) { const int j = 16 * jt + 4 * g + r; const float df = cum_i - sCum[j * 4 + k]; const bool keep = (jt < it) || (4 * g + r <= c);
                        acc[r] = keep ? acc[r] * __expf(fminf(df, 0.f)) * sDt[j * 4 + k] : 0.f; }
                }
                PT[jt][0] = pk2(acc[0], acc[1]); PT[jt][1] = pk2(acc[2], acc[3]); SCHED_FENCE();
            }
#pragma unroll
            for (int ks = 0; ks < 2; ++ks) if (2 * ks <= it) {
                v4u pa = (v4u){PT[2 * ks][0], PT[2 * ks][1], PT[2 * ks + 1][0], PT[2 * ks + 1][1]};
                const bf16x8 A = __builtin_bit_cast(bf16x8, pa);
#pragma unroll
                for (int pt = 0; pt < 4; ++pt) ya[pt] = mfma16(A, frag_tr(T, PR, 32 * ks + 4 * g, 32 * ks + 16 + 4 * g, 64 * k + 16 * pt, lane), ya[pt]);
                SCHED_FENCE();
            }
#pragma unroll
            for (int r = 0; r < 4; ++r) { const int i = 16 * it + 4 * g + r; float s = 0.f; float yv[4];
#pragma unroll
                for (int pt = 0; pt < 4; ++pt) { const float xc = bf2f(*(const LAS bf16*)(T + i * PR + (64 * k + 16 * pt + c) * 2)); const float z = bf2f((bf16)(zz[r] >> (16 * pt)));
                    const bf16 yb = f2bf((ya[pt][r] + Dk * xc) * siluf_(z)); yv[pt] = bf2f(yb); s += yv[pt] * yv[pt]; }
                *(unsigned long long*)(rb.y + (row0 + i) * 2048 + chn0) = (unsigned long long)pk2(yv[0], yv[1]) | ((unsigned long long)pk2(yv[2], yv[3]) << 32);
                s += SHFL_XOR(s, 1); s += SHFL_XOR(s, 2); s += SHFL_XOR(s, 4); s += SHFL_XOR(s, 8);
                if (c == 0) red[i * 4 + k] = s; }
            SCHED_FENCE();
        }
        ssd_state_update(H, T, PR, T + 512, PR, sDt, sCum, w, lane);
        sync_threads();
        {   const f32x4 nw = *(const f32x4*)(ssm_norm + chn0);
            unsigned long long yy[8];
            const int itA = hf, itB = 3 - hf;
            bf16* yb0 = rb.y + (row0 + 16 * itA + 4 * g) * 2048 + chn0;
            const int jump = (16 * (itB - itA) - 3) * 2048;
            {   bf16* yp = yb0;
#pragma unroll
                for (int q = 0; q < 8; ++q) { LAUNDER_PTR(yp); yy[q] = *(const unsigned long long*)yp; yp += (q == 3) ? jump : 2048; } }
            bf16* yp = yb0;
#pragma unroll
            for (int q = 0; q < 8; ++q) { const int i = 16 * (q < 4 ? itA : itB) + 4 * g + (q & 3);
                const float rstd = rsqrtf(((red[i * 4] + red[i * 4 + 1]) + (red[i * 4 + 2] + red[i * 4 + 3])) * (1.f / 256.f) + EPS);
                const unsigned lo = (unsigned)yy[q], hi = (unsigned)(yy[q] >> 32);
                const float y0 = __uint_as_float(lo << 16) * rstd * nw[0], y1 = __uint_as_float(lo & 0xffff0000u) * rstd * nw[1], y2 = __uint_as_float(hi << 16) * rstd * nw[2], y3 = __uint_as_float(hi & 0xffff0000u) * rstd * nw[3];
                LAUNDER_PTR(yp); *(unsigned long long*)yp = (unsigned long long)pk2(y0, y1) | ((unsigned long long)pk2(y2, y3) << 32); yp += (q == 3) ? jump : 2048; } }
        sync_threads();
    }
    if (seg == NSEG - 1) { float* so = state_out_l + ((size_t)(b * 32 + head) * 64 + 4 * c) * 128 + 64 * hf + 4 * g;
#pragma unroll
        for (int pt = 0; pt < 4; ++pt)
#pragma unroll
            for (int nt = 0; nt < 4; ++nt) *(f32x4*)(so + pt * 128 + 16 * nt) = H[nt][pt]; }
}

__device__ __forceinline__ float row32_sum(float s) { s += SHFL_XOR(s, 1); s += SHFL_XOR(s, 2); s += SHFL_XOR(s, 4); s += SHFL_XOR(s, 8); s += SHFL_XOR(s, 16); return s; }

__device__ __forceinline__ void hgrn_sample_load(f32x4 (&st)[8], const float* state_in, int bh, int tid) {
    const float* sp = state_in + (size_t)bh * 16384 + tid * 4;
#pragma unroll
    for (int it = 0; it < 8; ++it) { LAUNDER_PTR(sp); st[it] = *(const f32x4*)sp; sp += 2048; }
}
__device__ __forceinline__ void hgrn_sample_step(const bf16* proj, const float* lbs_l, const float* hgn_l, const float* state_in, float* state_out, bf16* ohg, int bh, int tid, LAS unsigned char* lds,
                                                 f32x4 (&st)[8], int bh_next) {
    const int b = bh >> 3, h = bh & 7, lane = tid & 63, w = tid >> 6;
    LAS float* sq = (LAS float*)lds; LAS float* sg = sq + 128; LAS float* sk = sq + 256; LAS float* sv = sq + 384; LAS float* so = (LAS float*)(lds + 8192); LAS float* sred = (LAS float*)(lds + 16384);
    const size_t row = (size_t)MP + b;
    float ogv = 0.f, q_ = 0.f, f_ = 0.f, v_ = 0.f, lb_ = 0.f;
    if (tid < 128) { const bf16* pr = proj + row * LDP + h * 128; q_ = bf2f(pr[PC_Q + tid]); f_ = bf2f(pr[PC_F + tid]); lb_ = lbs_l[h * 128 + tid]; v_ = bf2f(pr[PC_I + hg_vpos(tid)]); ogv = bf2f(pr[PC_OG + tid]); }
    if (tid < 128) { const float fg = lb_ + (1.f - lb_) * sigmoidf_(f_);
        sq[tid] = siluf_(q_) * 0.08838834764831845f; sg[tid] = fg; sk[tid] = 1.f - fg; sv[tid] = v_; }
    sync_threads();
    const int dv4 = tid & 31, rg = tid >> 5;
    const f32x4 vv = *(const LAS f32x4*)(sv + 4 * dv4);
    f32x4 oacc = (f32x4){0.f, 0.f, 0.f, 0.f};
    float* op = state_out + (size_t)bh * 16384 + tid * 4;
    const float* np = state_in + (size_t)(bh_next >= 0 ? bh_next : bh) * 16384 + tid * 4;
#pragma unroll
    for (int it = 0; it < 8; ++it) { const int dk = it * 16 + rg; const f32x4 sn = st[it] * sg[dk] + vv * sk[dk]; LAUNDER_PTR(op); *(f32x4*)op = sn; op += 2048; oacc = oacc + sn * sq[dk];
        LAUNDER_PTR(np); if (bh_next >= 0) st[it] = *(const f32x4*)np; np += 2048; }
    *(LAS f32x4*)(so + rg * 128 + 4 * dv4) = oacc;
    sync_threads();
    if (tid < 128) { float o = 0.f;
#pragma unroll
        for (int r = 0; r < 16; ++r) o += so[r * 128 + tid];
        float ss = o * o; ss = row32_sum(ss);
        if ((lane & 31) == 0) sred[tid >> 5] = ss;
        sq[tid] = o; }
    sync_threads();
    if (tid < 128) { const float rstd = rsqrtf(((sred[0] + sred[1]) + (sred[2] + sred[3])) * (1.f / 128.f) + EPS);
        ohg[row * 1024 + h * 128 + tid] = f2bf(sq[tid] * rstd * hgn_l[tid] * siluf_(ogv)); }
    sync_threads();
    (void)w;
}

__device__ __forceinline__ void ssd_sample_load(f32x4 (&st)[16], const float* state_in, int bg, int tid) {
    const float* sp = state_in + ((size_t)((bg >> 3) * 32 + (bg & 7) * 4)) * 8192 + tid * 4;
#pragma unroll
    for (int it = 0; it < 16; ++it) { LAUNDER_PTR(sp); st[it] = *(const f32x4*)sp; sp += 2048; }
}
__device__ __forceinline__ void ssd_sample_step(const bf16* proj, const float* conv_w, const float* conv_b, const float* dt_bias, const float* a_log, const float* d_skip, const float* ssm_norm,
                                                const float* state_in, const float* conv_in, float* state_out, float* conv_out, bf16* ybuf, int bg, int tid, LAS unsigned char* lds,
                                                f32x4 (&st)[16], int bg_next) {
    const int b = bg >> 3, grp = bg & 7, lane = tid & 63, w = tid >> 6;
    LAS float* sx = (LAS float*)(lds + 2048); LAS float* sB = (LAS float*)(lds + 3072); LAS float* sC = (LAS float*)(lds + 3584); LAS float* sdt = (LAS float*)(lds + 4096); LAS float* sdec = (LAS float*)(lds + 4112);
    LAS float* sy = (LAS float*)(lds + 4608); LAS float* sred = (LAS float*)(lds + 16384);
    const size_t row = (size_t)MP + b;
    {
        const int chx = tid < 256 ? (grp * 256 + tid) : (tid < 384 ? (2048 + grp * 128 + (tid - 256)) : (3072 + grp * 128 + (tid - 384)));
        const float* ci = conv_in + (size_t)b * 3 * 4096; const float r0 = ci[chx], r1 = ci[4096 + chx], r2 = ci[8192 + chx];
        const float cur = bf2f(proj[row * LDP + PC_XBC + chx]);
        const float cw0 = conv_w[chx], cw1 = conv_w[4096 + chx], cw2 = conv_w[8192 + chx], cw3 = conv_w[12288 + chx], cbb = conv_b[chx];
        float dtr = 0.f, dtbv = 0.f, alg = 0.f; if (tid < 4) { const int head = grp * 4 + tid; dtr = bf2f(proj[row * LDP + PC_DT + head]); dtbv = dt_bias[head]; alg = a_log[head]; }
        const float a = cbb + cw0 * r0 + cw1 * r1 + cw2 * r2 + cw3 * cur;
        const float v = siluf_(a);
        if (tid < 256) sx[tid] = v; else if (tid < 384) sB[tid - 256] = v; else sC[tid - 384] = v;
        float* co = conv_out + (size_t)b * 3 * 4096; co[chx] = r1; co[4096 + chx] = r2; co[8192 + chx] = cur;
        if (tid < 4) { const float dv = softplusf_(dtr + dtbv); sdt[tid] = dv; sdec[tid] = __expf(dv * (-__expf(alg))); } }
    sync_threads();
    const int n4 = tid & 31, pr_ = tid >> 5;
    const f32x4 Bv = *(const LAS f32x4*)(sB + 4 * n4), Cv = *(const LAS f32x4*)(sC + 4 * n4);
    float* op = state_out + ((size_t)(b * 32 + grp * 4)) * 8192 + tid * 4;
    const int bgn = bg_next >= 0 ? bg_next : bg; const float* np = state_in + ((size_t)((bgn >> 3) * 32 + (bgn & 7) * 4)) * 8192 + tid * 4;
#pragma unroll
    for (int it = 0; it < 16; ++it) { const int k = it >> 2, p = (it & 3) * 16 + pr_; const float xdt = sx[k * 64 + p] * sdt[k];
        const f32x4 hn = st[it] * sdec[k] + Bv * xdt; LAUNDER_PTR(op); *(f32x4*)op = hn; op += 2048;
        LAUNDER_PTR(np); if (bg_next >= 0) st[it] = *(const f32x4*)np; np += 2048;
        const f32x4 t = hn * Cv; float y = (t[0] + t[1]) + (t[2] + t[3]); y = row32_sum(y);
        if ((lane & 31) == 0) sy[k * 64 + p] = y; }
    sync_threads();
    float yv = 0.f;
    if (tid < 256) { const int k = tid >> 6; const float z = bf2f(proj[row * LDP + PC_Z + grp * 256 + tid]);
        yv = (sy[tid] + d_skip[grp * 4 + k] * sx[tid]) * siluf_(z);
        float ss = yv * yv; ss = row32_sum(ss); if ((lane & 31) == 0) sred[tid >> 5] = ss; }
    sync_threads();
    if (tid < 256) { float tot = 0.f;
#pragma unroll
        for (int r = 0; r < 8; ++r) tot += sred[r];
        ybuf[row * 2048 + grp * 256 + tid] = f2bf(yv * rsqrtf(tot * (1.f / 256.f) + EPS) * ssm_norm[grp * 256 + tid]); }
    sync_threads();
    (void)w;
}

static_assert(SD_END <= LDS_BYTES - 256, "LDS map");
static_assert(8 * 16384 <= LDS_BYTES - 256, "skinny LDS");
constexpr int SK_PART = 128 * 32 * 4;
template <int RT, class Epi>
__device__ __forceinline__ void skinny_gemm(const bf16* A, size_t lda, const bf16* Bt, int K, int N, const Epi& epi, int wg, int wg_first, int wg_count, int tid, LAS unsigned char* lds) {
    const int lane = tid & 63, w = tid >> 6, c = lane & 15, g = lane >> 4;
    constexpr int NRG = 8 / RT;
    const int nunit = (N / 32) * NRG, ksteps = K / 256;
    int me = wg - wg_first; if (me < 0 || me >= wg_count) return;
    for (int s = me; s < nunit; s += wg_count) {
        const int n0 = 32 * (s / NRG), r0 = (s % NRG) * (16 * RT);
        f32x4 acc[RT][2];
#pragma unroll
        for (int rt = 0; rt < RT; ++rt) { acc[rt][0] = (f32x4){0.f, 0.f, 0.f, 0.f}; acc[rt][1] = (f32x4){0.f, 0.f, 0.f, 0.f}; }
        const bf16* ap = A + (size_t)(r0 + c) * lda + (size_t)w * (K / 8) + 8 * g;
        const bf16* bp = Bt + (size_t)(n0 + c) * K + (size_t)w * (K / 8) + 8 * g;
#pragma unroll 4
        for (int ks = 0; ks < ksteps; ++ks) {
            bf16x8 af[RT], bfr[2];
#pragma unroll
            for (int rt = 0; rt < RT; ++rt) af[rt] = *(const bf16x8*)(ap + (size_t)(16 * rt) * lda + 32 * ks);
            bfr[0] = *(const bf16x8*)(bp + 32 * ks); bfr[1] = *(const bf16x8*)(bp + (size_t)16 * K + 32 * ks);
#pragma unroll
            for (int rt = 0; rt < RT; ++rt) { acc[rt][0] = mfma16(af[rt], bfr[0], acc[rt][0]); acc[rt][1] = mfma16(af[rt], bfr[1], acc[rt][1]); }
        }
        LAS float* part = (LAS float*)(lds + w * SK_PART);
#pragma unroll
        for (int rt = 0; rt < RT; ++rt)
#pragma unroll
            for (int nt = 0; nt < 2; ++nt)
#pragma unroll
                for (int r = 0; r < 4; ++r) part[(16 * rt + 4 * g + r) * 32 + 16 * nt + c] = acc[rt][nt][r];
        sync_threads();
        if (RT == 8 || tid < 64 * RT) {
            const int row = tid >> 2, c8 = (tid & 3) * 8;
            f32x4 v0 = (f32x4){0.f, 0.f, 0.f, 0.f}, v1 = (f32x4){0.f, 0.f, 0.f, 0.f};
#pragma unroll
            for (int ww = 0; ww < 8; ++ww) { const LAS float* pp = (const LAS float*)(lds + ww * SK_PART) + row * 32 + c8; v0 = v0 + *(const LAS f32x4*)pp; v1 = v1 + *(const LAS f32x4*)(pp + 4); }
            epi(r0 + row, n0 + c8, v0, v1);
        }
        sync_threads();
    }
}
struct SkStoreBf16 { bf16* O; int ld; int act;
    __device__ __forceinline__ void operator()(int row, int col, f32x4 v0, f32x4 v1) const {
        if (act) {
#pragma unroll
            for (int j = 0; j < 4; ++j) { const float a = fmaxf(v0[j], 0.f), b = fmaxf(v1[j], 0.f); v0[j] = a * a; v1[j] = b * b; } }
        v4u o; o.x = pk2(v0[0], v0[1]); o.y = pk2(v0[2], v0[3]); o.z = pk2(v1[0], v1[1]); o.w = pk2(v1[2], v1[3]);
        *(v4u*)(O + (size_t)row * ld + col) = o; } };
__device__ __forceinline__ void sk_unpack8(const v4u w, f32x4& lo, f32x4& hi) {
    lo = (f32x4){__uint_as_float(w.x << 16), __uint_as_float(w.x & 0xffff0000u), __uint_as_float(w.y << 16), __uint_as_float(w.y & 0xffff0000u)};
    hi = (f32x4){__uint_as_float(w.z << 16), __uint_as_float(w.z & 0xffff0000u), __uint_as_float(w.w << 16), __uint_as_float(w.w & 0xffff0000u)}; }
struct SkGateA { bf16* T; const bf16* G; int ldg; const float* bm;
    __device__ __forceinline__ void operator()(int row, int col, f32x4 v0, f32x4 v1) const {
        f32x4 g0, g1; sk_unpack8(*(const v4u*)(G + (size_t)row * ldg + col), g0, g1);
        const f32x4 b0 = *(const f32x4*)(bm + col), b1 = *(const f32x4*)(bm + col + 4);
#pragma unroll
        for (int j = 0; j < 4; ++j) { v0[j] *= sigmoidf_(g0[j] + b0[j]); v1[j] *= sigmoidf_(g1[j] + b1[j]); }
        v4u o; o.x = pk2(v0[0], v0[1]); o.y = pk2(v0[2], v0[3]); o.z = pk2(v1[0], v1[1]); o.w = pk2(v1[2], v1[3]);
        *(v4u*)(T + (size_t)row * 1024 + col) = o; } };
struct SkGateB { const bf16* T; bf16* U; const bf16* G; int ldg; const float* bm;
    __device__ __forceinline__ void operator()(int row, int col, f32x4 v0, f32x4 v1) const {
        f32x4 g0, g1; sk_unpack8(*(const v4u*)(G + (size_t)row * ldg + col), g0, g1);
        const f32x4 b0 = *(const f32x4*)(bm + col), b1 = *(const f32x4*)(bm + col + 4);
        f32x4 t0, t1; sk_unpack8(*(const v4u*)(T + (size_t)row * 1024 + col), t0, t1);
#pragma unroll
        for (int j = 0; j < 4; ++j) { v0[j] = t0[j] + v0[j] * sigmoidf_(g0[j] + b0[j]); v1[j] = t1[j] + v1[j] * sigmoidf_(g1[j] + b1[j]); }
        v4u o; o.x = pk2(v0[0], v0[1]); o.y = pk2(v0[2], v0[3]); o.z = pk2(v1[0], v1[1]); o.w = pk2(v1[2], v1[3]);
        *(v4u*)(U + (size_t)row * 1024 + col) = o; } };
struct SkRes { bf16* X; const float* gate; int ldgate;
    __device__ __forceinline__ void operator()(int row, int col, f32x4 v0, f32x4 v1) const {
        const float* gp = gate + (size_t)row * ldgate + col; bf16* xp = X + (size_t)row * 1024 + col;
        f32x4 x0, x1; sk_unpack8(*(const v4u*)xp, x0, x1);
        const f32x4 o0 = x0 + *(const f32x4*)gp * v0, o1 = x1 + *(const f32x4*)(gp + 4) * v1;
        v4u o; o.x = pk2(o0[0], o0[1]); o.y = pk2(o0[2], o0[3]); o.z = pk2(o1[0], o1[1]); o.w = pk2(o1[2], o1[3]); *(v4u*)xp = o; } };

template <int TB>
__device__ __forceinline__ void hgrn_seq(const bf16* proj, const float* lbs_l, const float* hgn_l, const float* state_in, float* state_out, bf16* ohg, int row_base, int T, int bh, int tid,
                                         LAS unsigned char* smem) {
    const int b = bh >> 3, h = bh & 7, lane = tid & 63, wv = tid >> 6;
    typedef float (LAS * arr_t)[128];
    arr_t sQ = (arr_t)(smem), sG = (arr_t)(smem + TB * 512), sK = (arr_t)(smem + 2 * TB * 512);
    LAS float* sRed = (LAS float*)(smem + 3 * TB * 512);
    float S[128];
    if (state_in) {
        const float* sp = state_in + (size_t)bh * 16384 + tid;
#pragma unroll
        for (int c = 0; c < 16; ++c) { asm volatile("" : "+v"(sp));
#pragma unroll
            for (int j = 0; j < 8; ++j) S[c * 8 + j] = sp[j * 128];
            sp += 1024; }
    } else {
#pragma unroll
        for (int d = 0; d < 128; ++d) S[d] = 0.f;
    }
    const float lb = lbs_l[h * 128 + tid], hn = hgn_l[tid];
    for (int t0 = 0; t0 < T; t0 += TB) {
        float v[TB], og[TB], o[TB];
#pragma unroll
        for (int tt = 0; tt < TB; ++tt) { v[tt] = 0.f; og[tt] = 0.f;
            if (t0 + tt < T) { const bf16* pr = proj + (size_t)(row_base + b * T + t0 + tt) * LDP + h * 128 + tid;
                const float q = bf2f(pr[PC_Q]), f = bf2f(pr[PC_F]); v[tt] = bf2f(pr[PC_I + hg_vpos(tid) - tid]); og[tt] = bf2f(pr[PC_OG]);
                const float fg = lb + (1.f - lb) * sigmoidf_(f);
                sQ[tt][tid] = siluf_(q) * 0.08838834764831845f; sG[tt][tid] = fg; sK[tt][tid] = 1.f - fg; } }
        __syncthreads();
#pragma unroll
        for (int tt = 0; tt < TB; ++tt) { float acc = 0.f;
            if (t0 + tt < T) { const float vv = v[tt];
#pragma unroll
                for (int d4 = 0; d4 < 32; ++d4) { const f32x4 g = *(const LAS f32x4*)&sG[tt][d4 * 4], k = *(const LAS f32x4*)&sK[tt][d4 * 4], q = *(const LAS f32x4*)&sQ[tt][d4 * 4];
                    S[d4 * 4 + 0] = g.x * S[d4 * 4 + 0] + k.x * vv; acc += q.x * S[d4 * 4 + 0];
                    S[d4 * 4 + 1] = g.y * S[d4 * 4 + 1] + k.y * vv; acc += q.y * S[d4 * 4 + 1];
                    S[d4 * 4 + 2] = g.z * S[d4 * 4 + 2] + k.z * vv; acc += q.z * S[d4 * 4 + 2];
                    S[d4 * 4 + 3] = g.w * S[d4 * 4 + 3] + k.w * vv; acc += q.w * S[d4 * 4 + 3]; } }
            o[tt] = acc;
            const float ss = wave_sum(acc * acc); if (lane == 0) sRed[tt * 2 + wv] = ss; }
        __syncthreads();
#pragma unroll
        for (int tt = 0; tt < TB; ++tt) if (t0 + tt < T) { const float rstd = rsqrtf((sRed[tt * 2] + sRed[tt * 2 + 1]) * (1.f / 128.f) + EPS);
            ohg[(size_t)(row_base + b * T + t0 + tt) * 1024 + h * 128 + tid] = f2bf(o[tt] * rstd * hn * siluf_(og[tt])); }
        __syncthreads();
    }
    { float* sp = state_out + (size_t)bh * 16384 + tid;
#pragma unroll
      for (int c = 0; c < 16; ++c) { asm volatile("" : "+v"(sp));
#pragma unroll
          for (int j = 0; j < 8; ++j) sp[j * 128] = S[c * 8 + j];
          sp += 1024; } }
}

template <int TB>
__device__ __forceinline__ void ssd_seq(const bf16* proj, const float* conv_w, const float* conv_b, const float* dt_bias, const float* a_log, const float* d_skip, const float* ssm_norm,
                                        const float* state_in, const float* conv_in, float* state_out, float* conv_out, bf16* ybuf, int row_base, int T, int bg, int tid, LAS unsigned char* smem) {
    const int b = bg >> 3, g = bg & 7, lane = tid & 63, wv = tid >> 6, head = g * 4 + wv;
    const int ch_x = g * 256 + tid, ch_bc = tid < 128 ? (2048 + g * 128 + tid) : (3072 + g * 128 + (tid - 128));
    typedef float (LAS * arr_t)[128];
    arr_t sB = (arr_t)(smem), sC = (arr_t)(smem + TB * 512);
    LAS float* sRed = (LAS float*)(smem + 2 * TB * 512);
    const float wx0 = conv_w[0 * 4096 + ch_x], wx1 = conv_w[1 * 4096 + ch_x], wx2 = conv_w[2 * 4096 + ch_x], wx3 = conv_w[3 * 4096 + ch_x], bx = conv_b[ch_x];
    const float wb0 = conv_w[0 * 4096 + ch_bc], wb1 = conv_w[1 * 4096 + ch_bc], wb2 = conv_w[2 * 4096 + ch_bc], wb3 = conv_w[3 * 4096 + ch_bc], bb = conv_b[ch_bc];
    float rx0 = 0.f, rx1 = 0.f, rx2 = 0.f, rb0 = 0.f, rb1 = 0.f, rb2 = 0.f;
    if (conv_in) { const float* ci = conv_in + (size_t)b * 3 * 4096; rx0 = ci[ch_x]; rx1 = ci[4096 + ch_x]; rx2 = ci[8192 + ch_x]; rb0 = ci[ch_bc]; rb1 = ci[4096 + ch_bc]; rb2 = ci[8192 + ch_bc]; }
    float hs[128];
    const size_t sbase = (((size_t)b * 32 + head) * 64 + lane) * 128;
    if (state_in) {
#pragma unroll
        for (int n4 = 0; n4 < 32; ++n4) { const f32x4 t = *(const f32x4*)(state_in + sbase + n4 * 4); hs[n4 * 4] = t.x; hs[n4 * 4 + 1] = t.y; hs[n4 * 4 + 2] = t.z; hs[n4 * 4 + 3] = t.w; }
    } else {
#pragma unroll
        for (int n = 0; n < 128; ++n) hs[n] = 0.f;
    }
    const float A = -expf(a_log[head]), dtb = dt_bias[head], Dk = d_skip[head], nw = ssm_norm[ch_x];
    for (int t0 = 0; t0 < T; t0 += TB) {
        float xc[TB], dtv[TB], dec[TB], zz[TB], yv[TB];
#pragma unroll
        for (int tt = 0; tt < TB; ++tt) { xc[tt] = 0.f; dtv[tt] = 0.f; dec[tt] = 1.f; zz[tt] = 0.f;
            if (t0 + tt < T) { const bf16* pr = proj + (size_t)(row_base + b * T + t0 + tt) * LDP;
                const float cx = bf2f(pr[PC_XBC + ch_x]), cb = bf2f(pr[PC_XBC + ch_bc]);
                const float ax = bx + wx0 * rx0 + wx1 * rx1 + wx2 * rx2 + wx3 * cx; rx0 = rx1; rx1 = rx2; rx2 = cx; xc[tt] = siluf_(ax);
                const float ab = bb + wb0 * rb0 + wb1 * rb1 + wb2 * rb2 + wb3 * cb; rb0 = rb1; rb1 = rb2; rb2 = cb;
                const float sbv = siluf_(ab); if (tid < 128) sB[tt][tid] = sbv; else sC[tt][tid - 128] = sbv;
                const float dv = softplusf_(bf2f(pr[PC_DT + head]) + dtb); dtv[tt] = dv; dec[tt] = __expf(dv * A); zz[tt] = bf2f(pr[PC_Z + ch_x]); } }
        __syncthreads();
#pragma unroll
        for (int tt = 0; tt < TB; ++tt) { float y = 0.f;
            if (t0 + tt < T) { const float xdt = xc[tt] * dtv[tt], dc = dec[tt];
#pragma unroll
                for (int n4 = 0; n4 < 32; ++n4) { const f32x4 bv = *(const LAS f32x4*)&sB[tt][n4 * 4], cv = *(const LAS f32x4*)&sC[tt][n4 * 4];
                    hs[n4 * 4 + 0] = dc * hs[n4 * 4 + 0] + xdt * bv.x; y += hs[n4 * 4 + 0] * cv.x;
                    hs[n4 * 4 + 1] = dc * hs[n4 * 4 + 1] + xdt * bv.y; y += hs[n4 * 4 + 1] * cv.y;
                    hs[n4 * 4 + 2] = dc * hs[n4 * 4 + 2] + xdt * bv.z; y += hs[n4 * 4 + 2] * cv.z;
                    hs[n4 * 4 + 3] = dc * hs[n4 * 4 + 3] + xdt * bv.w; y += hs[n4 * 4 + 3] * cv.w; }
                y = (y + Dk * xc[tt]) * siluf_(zz[tt]); }
            yv[tt] = y;
            const float ss = wave_sum(y * y); if (lane == 0) sRed[tt * 4 + wv] = ss; }
        __syncthreads();
#pragma unroll
        for (int tt = 0; tt < TB; ++tt) if (t0 + tt < T) { const float rstd = rsqrtf(((sRed[tt * 4] + sRed[tt * 4 + 1]) + (sRed[tt * 4 + 2] + sRed[tt * 4 + 3])) * (1.f / 256.f) + EPS);
            ybuf[(size_t)(row_base + b * T + t0 + tt) * 2048 + ch_x] = f2bf(yv[tt] * rstd * nw); }
        __syncthreads();
    }
#pragma unroll
    for (int n4 = 0; n4 < 32; ++n4) *(f32x4*)(state_out + sbase + n4 * 4) = (f32x4){hs[n4 * 4], hs[n4 * 4 + 1], hs[n4 * 4 + 2], hs[n4 * 4 + 3]};
    float* co = conv_out + (size_t)b * 3 * 4096;
    co[ch_x] = rx0; co[4096 + ch_x] = rx1; co[8192 + ch_x] = rx2; co[ch_bc] = rb0; co[4096 + ch_bc] = rb1; co[8192 + ch_bc] = rb2;
}

#ifndef REP_G
#define REP_G 1
#endif
#ifndef REP_R2
#define REP_R2 1
#endif
#ifndef REP_R1
#define REP_R1 1
#endif
#ifndef REP_N
#define REP_N 1
#endif
#ifndef REP_P
#define REP_P 1
#endif
#ifndef REP_H2
#define REP_H2 1
#endif
#ifndef REP_S2
#define REP_S2 1
#endif
#ifndef REP_S1
#define REP_S1 1
#endif
#ifndef REP_SS
#define REP_SS 1
#endif
#ifndef REP_BAR
#define REP_BAR 0
#endif
__device__ __forceinline__ void phase_recur1(const P& p, int l, LAS unsigned char* lds, int tid_in, int skip_hgrn1) {
    unsigned char* ws = p.ws; asm volatile("" : "+s"(ws)); int tid_ = tid_in; asm volatile("" : "+v"(tid_)); const int tid = tid_, G = gridDim.x, wg = blockIdx.x;
    RecurBufs rb{(bf16*)(ws + WS_PROJ), (bf16*)(ws + WS_XBCC), (float*)(ws + WS_DTV), (float*)(ws + WS_CUM), (float*)(ws + WS_CV), (float*)(ws + WS_SSEG), (float*)(ws + WS_DSEG),
                 (float*)(ws + WS_HSEG), (float*)(ws + WS_TSEG), (bf16*)(ws + WS_OHG), (bf16*)(ws + WS_Y)};
    const float* lbs_l = (const float*)(ws + WS_LBS) + l * 1024; float* out = p.out;
    const float* hgn = p.in[I_HGN] + l * HG_DV;
    const float* cw = p.in[I_CONVW] + (size_t)l * 4 * SSM_CH; const float* cb = p.in[I_CONVB] + l * SSM_CH; const float* dtb = p.in[I_DTB] + l * SSM_HEADS;
    const float* alog = p.in[I_ALOG] + l * SSM_HEADS; const float* dsk = p.in[I_DSKIP] + l * SSM_HEADS; const float* ssmn = p.in[I_SSMN] + l * SSM_INNER;
#define TID_L() int tl_ = tid; asm volatile("" : "+v"(tl_)); const int t = tl_
#define R1_HG() do { if (!skip_hgrn1) for (int u = wg; u < 256; u += G) { TID_L(); hgrn_pass1(rb, lbs_l, u, t, lds); } } while (0)
#define R1_SD() do { for (int rep = 0; rep < REP_S1; ++rep) for (int u = wg; u < 256; u += G) { TID_L(); ssd_pass1(rb, cw, cb, dtb, alog, out + O_CVP + (size_t)l * NB * 3 * SSM_CH, u, t, lds); } } while (0)
#define R1_SAMPLE() do { for (int rep = 0; rep < REP_SS; ++rep) { \
        {   const float* shg = p.in[I_SHG] + (size_t)l * NSB * HG_H * HG_DK * HG_DV; f32x4 sa[8];        \
            if (wg < NSB * HG_H) { TID_L(); hgrn_sample_load(sa, shg, wg, t); } \
            for (int u = wg; u < NSB * HG_H; u += G) { TID_L(); const int un = u + G < NSB * HG_H ? u + G : -1; \
                hgrn_sample_step(rb.proj, lbs_l, hgn, shg, out + O_HGS + (size_t)l * NSB * HG_H * HG_DK * HG_DV, rb.ohg, u, t, lds, sa, un); } } \
        {   const float* sss = p.in[I_SSSM] + (size_t)l * NSB * SSM_HEADS * SSM_P * SSM_N; f32x4 sa[16]; \
            if (wg < NSB * SSM_G) { TID_L(); ssd_sample_load(sa, sss, wg, t); } \
            for (int u = wg; u < NSB * SSM_G; u += G) { TID_L(); const int un = u + G < NSB * SSM_G ? u + G : -1; \
                ssd_sample_step(rb.proj, cw, cb, dtb, alog, dsk, ssmn, sss, p.in[I_SCONV] + (size_t)l * NSB * 3 * SSM_CH, \
                                out + O_SSMS + (size_t)l * NSB * SSM_HEADS * SSM_P * SSM_N, out + O_CVS + (size_t)l * NSB * 3 * SSM_CH, rb.y, u, t, lds, sa, un); } } } } while (0)
    if (((wg >> 3) & 1) == 0) { R1_HG(); R1_SAMPLE(); R1_SD(); } else { R1_SD(); R1_HG(); R1_SAMPLE(); }
#undef R1_HG
#undef R1_SD
#undef R1_SAMPLE
}
__device__ __forceinline__ void phase_recur2(const P& p, int l, LAS unsigned char* lds, int tid_in) {
    unsigned char* ws = p.ws; asm volatile("" : "+s"(ws)); int tid_ = tid_in; asm volatile("" : "+v"(tid_)); const int tid = tid_, G = gridDim.x, wg = blockIdx.x;
    RecurBufs rb{(bf16*)(ws + WS_PROJ), (bf16*)(ws + WS_XBCC), (float*)(ws + WS_DTV), (float*)(ws + WS_CUM), (float*)(ws + WS_CV), (float*)(ws + WS_SSEG), (float*)(ws + WS_DSEG),
                 (float*)(ws + WS_HSEG), (float*)(ws + WS_TSEG), (bf16*)(ws + WS_OHG), (bf16*)(ws + WS_Y)};
    float* out = p.out;
    for (int rep = 0; rep < REP_H2; ++rep) for (int u = wg; u < 256; u += G) { TID_L(); hgrn_pass2(rb, p.in[I_HGN] + l * HG_DV, out + O_HGP + (size_t)l * NB * HG_H * HG_DK * HG_DV, u, t, lds); }
    for (int rep = 0; rep < REP_S2; ++rep) for (int u = wg; u < 256; u += G) { TID_L(); ssd_pass2(rb, p.in[I_DSKIP] + l * SSM_HEADS, p.in[I_SSMN] + l * SSM_INNER, out + O_SSMP + (size_t)l * NB * SSM_HEADS * SSM_P * SSM_N, u ^ 3, t, lds); }
}


constexpr int CW_BAR = 4096;
constexpr int MISC_OFF = LDS_BYTES - 256;

__global__ __launch_bounds__(NTHREADS, 2) void k_mega(P p) {
    extern __shared__ __attribute__((aligned(16))) unsigned char shm[];
    LAS unsigned char* lds = (LAS unsigned char*)shm;
    const int wave_u = __builtin_amdgcn_readfirstlane((int)threadIdx.x >> 6);
#define TID() ({ int t__; asm volatile("v_mbcnt_lo_u32_b32 %0, -1, 0\n\tv_mbcnt_hi_u32_b32 %0, -1, %0" : "=v"(t__)); (wave_u << 6) | t__; })
    const int G = gridDim.x, NGW = G * NWAVES;
    unsigned char* ws = p.ws;
#define LANE_GW() int t_ = TID(); asm volatile("" : "+v"(t_)); const int ln = t_ & 63, wv = __builtin_amdgcn_readfirstlane(t_ >> 6), gwv = blockIdx.x * NWAVES + wv; (void)wv
    volatile LAS unsigned* MISC = (volatile LAS unsigned*)(lds + MISC_OFF);
    if (TID() < 16) MISC[TID()] = 0u;
    __syncthreads();
    XcdBarrier bar = xcd_barrier_post((unsigned*)(ws + WS_CTL) + CW_BAR, MISC + 8, TID());
#define WSL() ({ unsigned char* w_ = ws; asm volatile("" : "+s"(w_)); w_; })

    for (int rep = 0; rep < REP_P; ++rep) {   LANE_GW(); phase_prologue(p, lds, gwv, NGW, ln, wv); }
    xcd_barrier(bar, TID());
    {   unsigned char* w = WSL();
        pg8::Gemm g{(const bf16*)(w + WS_AC), (const bf16*)(w + WS_WADA), 256, MODLD, D}; pg8::StaticOrder S; S.init(256, MODLD, G, (int)blockIdx.x);
        pg8::EpiF32 E{(float*)(w + WS_MOD), MODLD, p.in[I_BADA]};
        pg8::gemm_phase<pg8::EpiF32, pg8::StaticOrder>(lds, g, S, E, nullptr, TID()); }
    xcd_barrier(bar, TID());
    for (int li = 0; li < DEPTH; ++li) {
        int l = li; asm volatile("" : "+s"(l));
        for (int rep = 0; rep < REP_N; ++rep) {   unsigned char* w = WSL(); const float* mod_l = (const float*)(w + WS_MOD) + (size_t)l * NADA * D;
            LANE_GW();
            if (l == 0) phase_norm<1>(p.in[I_XP], p.in[I_XS], (bf16*)(w + WS_X), (bf16*)(w + WS_H), p.in[I_NMIX] + l * D, mod_l + 0 * D, mod_l + 1 * D, gwv, NGW, ln);
            else phase_norm<0>(nullptr, nullptr, (bf16*)(w + WS_X), (bf16*)(w + WS_H), p.in[I_NMIX] + l * D, mod_l + 0 * D, mod_l + 1 * D, gwv, NGW, ln); }
        xcd_barrier(bar, TID());
        for (int rep = 0; rep < REP_G; ++rep) { if (rep) xcd_barrier(bar, TID());
        {   unsigned char* w = WSL(); const unsigned char* wl = w + WS_W + (size_t)l * W_LSTRIDE;
            pg8::Gemm g{(const bf16*)(w + WS_H), (const bf16*)(wl + WO_IN), MP, LDP, D}; pg8::StaticOrder S; S.init(MP, LDP, G, (int)blockIdx.x);
            pg8::EpiBf16<0> E{(bf16*)(w + WS_PROJ), LDP};
            pg8::gemm_phase<pg8::EpiBf16<0>, pg8::StaticOrder>(lds, g, S, E, nullptr, TID());
            const int skf = G > 64 ? 64 : 0, skn = G > 64 ? G - 64 : G; skinny_gemm<8>((const bf16*)(w + WS_H) + (size_t)MP * D, D, (const bf16*)(wl + WO_IN), D, LDP, SkStoreBf16{(bf16*)(w + WS_PROJ) + (size_t)MP * LDP, LDP, 0}, (int)blockIdx.x, skf, skn, TID(), lds); } }
        xcd_barrier(bar, TID());
        for (int rep = 0; rep < REP_BAR; ++rep) xcd_barrier(bar, TID());
        phase_recur1(p, l, lds, TID(), 0);
        for (int rep = 1; rep < REP_R1; ++rep) { xcd_barrier(bar, TID()); phase_recur1(p, l, lds, TID(), 1); }
        xcd_barrier(bar, TID());
        for (int rep = 0; rep < REP_R2; ++rep) { if (rep) xcd_barrier(bar, TID()); phase_recur2(p, l, lds, TID()); }
        xcd_barrier(bar, TID());
        for (int rep = 0; rep < REP_G; ++rep) { if (rep) xcd_barrier(bar, TID());
        {   unsigned char* w = WSL(); const unsigned char* wl = w + WS_W + (size_t)l * W_LSTRIDE;
            pg8::Gemm g{(const bf16*)(w + WS_OHG), (const bf16*)(wl + WO_BRA), MP, D, 1024}; pg8::StaticOrder S; S.init(MP, D, G, (int)blockIdx.x);
            pg8::EpiGateA E{(bf16*)(w + WS_T), (const bf16*)(w + WS_PROJ) + PC_GA, LDP, p.in[I_BMERGE] + l * 2048};
            pg8::gemm_phase<pg8::EpiGateA, pg8::StaticOrder>(lds, g, S, E, nullptr, TID());
            skinny_gemm<1>((const bf16*)(w + WS_OHG) + (size_t)MP * D, D, (const bf16*)(wl + WO_BRA), 1024, D, SkGateA{(bf16*)(w + WS_T) + (size_t)MP * D, (const bf16*)(w + WS_PROJ) + (size_t)MP * LDP + PC_GA, LDP, p.in[I_BMERGE] + l * 2048}, (int)blockIdx.x, 0, G, TID(), lds); } }
        asm volatile("s_waitcnt vmcnt(0)" ::: "memory"); __syncthreads();
        for (int rep = 0; rep < REP_G; ++rep) { if (rep) xcd_barrier(bar, TID());
        {   unsigned char* w = WSL(); const unsigned char* wl = w + WS_W + (size_t)l * W_LSTRIDE;
            pg8::Gemm g{(const bf16*)(w + WS_Y), (const bf16*)(wl + WO_BRB), MP, D, 2048}; pg8::StaticOrder S; S.init(MP, D, G, (int)blockIdx.x);
            pg8::EpiGateB E{(const bf16*)(w + WS_T), (bf16*)(w + WS_U), (const bf16*)(w + WS_PROJ) + PC_GB, LDP, p.in[I_BMERGE] + l * 2048 + 1024};
            pg8::gemm_phase<pg8::EpiGateB, pg8::StaticOrder>(lds, g, S, E, nullptr, TID());
            skinny_gemm<1>((const bf16*)(w + WS_Y) + (size_t)MP * 2048, 2048, (const bf16*)(wl + WO_BRB), 2048, D, SkGateB{(const bf16*)(w + WS_T) + (size_t)MP * D, (bf16*)(w + WS_U) + (size_t)MP * D, (const bf16*)(w + WS_PROJ) + (size_t)MP * LDP + PC_GB, LDP, p.in[I_BMERGE] + l * 2048 + 1024}, (int)blockIdx.x, 0, G, TID(), lds); } }
        xcd_barrier(bar, TID());
        {   unsigned char* w = WSL(); const unsigned char* wl = w + WS_W + (size_t)l * W_LSTRIDE; const float* mod_l = (const float*)(w + WS_MOD) + (size_t)l * NADA * D;
            pg8::Gemm g{(const bf16*)(w + WS_U), (const bf16*)(wl + WO_OUT), MP, D, 1024}; pg8::StaticOrder S; S.init(MP, D, G, (int)blockIdx.x);
            pg8::EpiRes E{(bf16*)(w + WS_X), mod_l + 2 * D, MODLD};
            pg8::gemm_phase<pg8::EpiRes, pg8::StaticOrder>(lds, g, S, E, nullptr, TID());
            skinny_gemm<1>((const bf16*)(w + WS_U) + (size_t)MP * D, D, (const bf16*)(wl + WO_OUT), 1024, D, SkRes{(bf16*)(w + WS_X) + (size_t)MP * D, mod_l + (size_t)NB * MODLD + 2 * D, MODLD}, (int)blockIdx.x, 0, G, TID(), lds); }
        xcd_barrier(bar, TID());
        for (int rep = 0; rep < REP_N; ++rep) {   unsigned char* w = WSL(); const float* mod_l = (const float*)(w + WS_MOD) + (size_t)l * NADA * D;
            LANE_GW(); phase_norm<0>(nullptr, nullptr, (bf16*)(w + WS_X), (bf16*)(w + WS_H), p.in[I_NMLP] + l * D, mod_l + 3 * D, mod_l + 4 * D, gwv, NGW, ln); }
        xcd_barrier(bar, TID());
        for (int rep = 0; rep < REP_G; ++rep) { if (rep) xcd_barrier(bar, TID());
        {   unsigned char* w = WSL(); const unsigned char* wl = w + WS_W + (size_t)l * W_LSTRIDE;
            pg8::Gemm g{(const bf16*)(w + WS_H), (const bf16*)(wl + WO_UP), MP, DFF, 1024}; pg8::StaticOrder S; S.init(MP, DFF, G, (int)blockIdx.x);
            pg8::EpiBf16<1> E{(bf16*)(w + WS_UP), DFF};
            pg8::gemm_phase<pg8::EpiBf16<1>, pg8::StaticOrder>(lds, g, S, E, nullptr, TID());
            skinny_gemm<4>((const bf16*)(w + WS_H) + (size_t)MP * D, D, (const bf16*)(wl + WO_UP), 1024, DFF, SkStoreBf16{(bf16*)(w + WS_UP) + (size_t)MP * DFF, DFF, 1}, (int)blockIdx.x, 0, G, TID(), lds); } }
        xcd_barrier(bar, TID());
        {   unsigned char* w = WSL(); const unsigned char* wl = w + WS_W + (size_t)l * W_LSTRIDE; const float* mod_l = (const float*)(w + WS_MOD) + (size_t)l * NADA * D;
            pg8::Gemm g{(const bf16*)(w + WS_UP), (const bf16*)(wl + WO_DOWN), MP, D, DFF}; pg8::StaticOrder S; S.init(MP, D, G, (int)blockIdx.x);
            pg8::EpiRes E{(bf16*)(w + WS_X), mod_l + 5 * D, MODLD};
            pg8::gemm_phase<pg8::EpiRes, pg8::StaticOrder>(lds, g, S, E, nullptr, TID());
            skinny_gemm<1>((const bf16*)(w + WS_UP) + (size_t)MP * DFF, DFF, (const bf16*)(wl + WO_DOWN), DFF, D, SkRes{(bf16*)(w + WS_X) + (size_t)MP * D, mod_l + (size_t)NB * MODLD + 5 * D, MODLD}, (int)blockIdx.x, 0, G, TID(), lds); }
        xcd_barrier(bar, TID());
    }
    {   unsigned char* w = WSL(); LANE_GW(); phase_final((const bf16*)(w + WS_X), p.out + O_YP, p.in[I_NFIN], gwv, NGW, ln); }
}

extern "C" void kernel_launch(void* const* d_in, const int* in_sizes, int n_in, void* d_out, int out_size, void* d_ws, size_t ws_size, hipStream_t stream) {
    static int grid = 0;
    if (grid == 0) {
        if (n_in != N_IN || (size_t)out_size != O_END || ws_size < WS_END) { fprintf(stderr, "kernel_launch: unexpected sizes n_in %d out %d ws %zu\n", n_in, out_size, ws_size); grid = -1; return; }
        int dev = 0, cus = 0, per_cu = 0;
        if (hipGetDevice(&dev) != hipSuccess || hipDeviceGetAttribute(&cus, hipDeviceAttributeMultiprocessorCount, dev) != hipSuccess) { grid = -1; return; }
        if (hipFuncSetAttribute((const void*)k_mega, hipFuncAttributeMaxDynamicSharedMemorySize, LDS_BYTES) != hipSuccess) { fprintf(stderr, "kernel_launch: hipFuncSetAttribute failed\n"); grid = -1; return; }
        if (hipOccupancyMaxActiveBlocksPerMultiprocessor(&per_cu, (const void*)k_mega, NTHREADS, LDS_BYTES) != hipSuccess || per_cu < 1)
            fprintf(stderr, "kernel_launch: note: occupancy query reports %d workgroups per CU\n", per_cu);
        (void)hipGetLastError();
        grid = cus;
    }
    if (grid < 0) return;
    if (hipMemsetAsync((char*)d_ws + WS_CTL, 0, CTL_ZERO_BYTES, stream) != hipSuccess) return;
    P p{};
    for (int i = 0; i < N_IN; ++i) p.in[i] = (const float*)d_in[i];
    p.out = (float*)d_out; p.ws = (unsigned char*)d_ws;
    hipLaunchKernelGGL(k_mega, dim3(grid), dim3(NTHREADS), LDS_BYTES, stream, p);
}
```

```cpp
#include <hip/hip_runtime.h>
#include <cstdio>
#include <cstdint>

constexpr int D = 1024, NB = 8, SEQ = 2048, DEPTH = 4, NSB = 128;
constexpr int MP = NB * SEQ;
constexpr int MS = NSB;
constexpr int MR = MP + MS;
constexpr int MT = 16640;
constexpr int HG_H = 8, HG_DK = 128, HG_DV = 128;
constexpr int SSM_INNER = 2048, SSM_P = 64, SSM_HEADS = 32, SSM_G = 8, SSM_HPG = 4, SSM_N = 128, SSM_CH = 4096;
constexpr int DFF = 4096, NADA = 6;
constexpr int IN_WIDTH = 12320;
constexpr int LDP = 12544;
constexpr int PC_Q = 0, PC_F = 1024, PC_I = 2048, PC_OG = 3072, PC_Z = 4096, PC_XBC = 6144, PC_GA = 10240, PC_GB = 11264, PC_DT = 12288;
constexpr int NCOND = NB + NSB;
constexpr int MODLD = DEPTH * NADA * D;
constexpr float EPS = 1e-6f;

enum { I_XP = 0, I_XS, I_SHG, I_SSSM, I_SCONV, I_CP, I_CS, I_WADA, I_BADA, I_NMIX, I_WIN, I_BMERGE, I_LB, I_HGN, I_CONVW, I_CONVB, I_DTB, I_ALOG, I_DSKIP,
       I_SSMN, I_WBRA, I_WBRB, I_WOUT, I_NMLP, I_WUP, I_WDOWN, I_NFIN, N_IN };

constexpr size_t O_YP = 0;
constexpr size_t O_YS = O_YP + (size_t)MP * D;
constexpr size_t O_HGP = O_YS + (size_t)MS * D;
constexpr size_t O_SSMP = O_HGP + (size_t)DEPTH * NB * HG_H * HG_DK * HG_DV;
constexpr size_t O_CVP = O_SSMP + (size_t)DEPTH * NB * SSM_HEADS * SSM_P * SSM_N;
constexpr size_t O_HGS = O_CVP + (size_t)DEPTH * NB * 3 * SSM_CH;
constexpr size_t O_SSMS = O_HGS + (size_t)DEPTH * NSB * HG_H * HG_DK * HG_DV;
constexpr size_t O_CVS = O_SSMS + (size_t)DEPTH * NSB * SSM_HEADS * SSM_P * SSM_N;
constexpr size_t O_END = O_CVS + (size_t)DEPTH * NSB * 3 * SSM_CH;

constexpr size_t MiB = 1u << 20;
constexpr size_t WS_CTL = 0, CTL_ZERO_BYTES = 1 * MiB;
constexpr size_t WS_LBS = 1 * MiB;
constexpr size_t WS_AC = 2 * MiB;
constexpr size_t WS_MOD = 3 * MiB;
constexpr size_t WS_WADA = 32 * MiB;
constexpr size_t WS_W = 80 * MiB, W_LSTRIDE = 49 * MiB;
constexpr size_t WO_IN = 0, WO_BRA = 24 * MiB + MiB / 2, WO_BRB = WO_BRA + 2 * MiB, WO_OUT = WO_BRB + 4 * MiB, WO_UP = WO_OUT + 2 * MiB, WO_DOWN = WO_UP + 8 * MiB;
constexpr size_t WS_X = 276 * MiB;
constexpr size_t WS_H = 341 * MiB;
constexpr size_t WS_PROJ = 374 * MiB;
constexpr size_t WS_OHG = 773 * MiB;
constexpr size_t WS_Y = 806 * MiB;
constexpr size_t WS_T = 871 * MiB;
constexpr size_t WS_U = 936 * MiB;
constexpr size_t WS_UP = 969 * MiB;
constexpr size_t WS_XBCC = 1100 * MiB;
constexpr size_t WS_DTV = 1230 * MiB, WS_CUM = 1232 * MiB;
constexpr size_t WS_CV = 1234 * MiB;
constexpr size_t WS_SSEG = 1238 * MiB;
constexpr size_t WS_DSEG = 1254 * MiB;
constexpr size_t WS_HSEG = 1255 * MiB;
constexpr size_t WS_TSEG = 1287 * MiB;
constexpr size_t WS_END = 1288 * MiB;
static_assert(WO_DOWN + 8 * MiB <= W_LSTRIDE && (size_t)LDP * D * 2 <= WO_BRA, "weight map");
static_assert(WS_W + 4 * W_LSTRIDE <= WS_X && WS_X + (size_t)MT * D * 4 <= WS_H && WS_H + (size_t)MT * D * 2 <= WS_PROJ && WS_PROJ + (size_t)MT * LDP * 2 <= WS_OHG, "ws map 1");
static_assert(WS_OHG + (size_t)MT * D * 2 <= WS_Y && WS_Y + (size_t)MT * 2048 * 2 <= WS_T && WS_T + (size_t)MT * D * 4 <= WS_U && WS_U + (size_t)MT * D * 2 <= WS_UP && WS_UP + (size_t)MT * DFF * 2 <= WS_XBCC && WS_XBCC + (size_t)MT * 4096 * 2 <= WS_DTV, "ws map 2");
static_assert(WS_MOD + (size_t)256 * MODLD * 4 <= WS_WADA && WS_WADA + (size_t)MODLD * D * 2 <= WS_W, "ws map 0");

typedef unsigned short bf16;
__device__ __forceinline__ float bf2f(bf16 v) { return __uint_as_float(((unsigned)v) << 16); }
__device__ __forceinline__ unsigned pk2(float lo, float hi) { unsigned r; asm("v_cvt_pk_bf16_f32 %0, %1, %2" : "=v"(r) : "v"(lo), "v"(hi)); return r; }
__device__ __forceinline__ bf16 f2bf(float f) { return (bf16)pk2(f, f); }
__device__ __forceinline__ float frcp_(float x) { return __builtin_amdgcn_rcpf(x); }
__device__ __forceinline__ float sigmoidf_(float x) { return frcp_(1.0f + __expf(-x)); }
__device__ __forceinline__ float siluf_(float x) { return x * frcp_(1.0f + __expf(-x)); }
__device__ __forceinline__ float softplusf_(float x) { return x > 20.f ? x : log1pf(__expf(x)); }
__host__ __device__ __forceinline__ int cidx_of_row(int row) { return row < MP ? (row >> 11) : ((row - MP + NB) < NCOND ? (row - MP + NB) : (NCOND - 1)); }
__host__ __device__ __forceinline__ int hg_vpos(int e) { return (e & 64) + 16 * (e & 3) + ((e & 63) >> 2); }

namespace pg8 {
#define PG8_LAS __attribute__((address_space(3)))
typedef unsigned short bf16_t;
typedef short bf16x8 __attribute__((ext_vector_type(8)));
typedef float f32x4 __attribute__((ext_vector_type(4)));
typedef unsigned u32x4 __attribute__((ext_vector_type(4)));
constexpr int BM = 256, BK = 64, HALF = 128, HTB = HALF * BK * 2  , STAGE_BYTES = 8 * HTB, NXCD = 8, WGM = 4;

__host__ __device__ __forceinline__ int lds_byte(int r, int c) { const int st = (r >> 4) * 2 + (c >> 5), rr = r & 15, cc = c & 31, ob = rr * 64 + cc * 2; return st * 1024 + (ob ^ (((ob >> 9) & 1) << 5)); }
__host__ __device__ __forceinline__ void stage_rc(int b, int& R, int& C) { const int st = b / 1024, sb = b % 1024, swz = sb ^ (((sb >> 9) & 1) << 5); R = (st >> 1) * 16 + swz / 64; C = (st & 1) * 32 + (swz % 64) / 2; }
__host__ __device__ __forceinline__ int perm32(int rho) { const int n = rho >> 4, i = rho & 15; return 8 * (i >> 2) + 4 * n + (i & 3); }

struct Unit { int pm, pn; };
struct Gemm { const bf16_t* A; const bf16_t* Bt; int M, N, K; };

struct StaticOrder {
    int nM, nN, nwg, G, c;
    __host__ __device__ void init(int M, int N, int G_, int c_) { nM = M / BM; nN = N / BM; nwg = nM * nN; G = G_; c = c_; }
    __host__ __device__ bool next(int i, Unit& u) const {
        const long L = (long)i * G + c; if (L >= nwg) return false;
        int wgid = (int)L; { const int q = nwg / NXCD, r = nwg % NXCD, xcd = wgid % NXCD, off = wgid / NXCD; wgid = (xcd < r ? xcd * (q + 1) : r * (q + 1) + (xcd - r) * q) + off; }
        const int nig = WGM * nN, gid = wgid / nig, fm = gid * WGM, gsz = (nM - fm) < WGM ? (nM - fm) : WGM;
        u.pm = fm + ((wgid % nig) % gsz); u.pn = (wgid % nig) / gsz; return true;
    }
    __device__ __forceinline__ void a_ready(const Unit&) const {}
    __device__ __forceinline__ void done(const Unit&) const {}
};
__device__ __forceinline__ unsigned cvt_pk_bf16(float lo, float hi) { unsigned r; asm volatile("v_cvt_pk_bf16_f32 %0, %1, %2" : "=v"(r) : "v"(lo), "v"(hi)); return r; }
__device__ __forceinline__ float ep_sigmoid(float x) { return __builtin_amdgcn_rcpf(1.0f + __expf(-x)); }
__device__ __forceinline__ void unpack8(const u32x4 w, f32x4& lo, f32x4& hi) {
    lo = (f32x4){__uint_as_float(w.x << 16), __uint_as_float(w.x & 0xffff0000u), __uint_as_float(w.y << 16), __uint_as_float(w.y & 0xffff0000u)};
    hi = (f32x4){__uint_as_float(w.z << 16), __uint_as_float(w.z & 0xffff0000u), __uint_as_float(w.w << 16), __uint_as_float(w.w & 0xffff0000u)};
}

struct EpiF32 {
    static constexpr bool PERM = false, AFTER_DRAIN = false;
    float* C; int ldc; const float* bias;
    __device__ __forceinline__ void operator()(const f32x4 (&acc)[2][2][4][2], const Unit& u, int wr, int wc, int fr, int fq) const {
        const int row0 = u.pm * BM + wr * 64 + fr, col0 = u.pn * BM + wc * 32 + 4 * fq;
        f32x4 bv[2][2];
#pragma unroll
        for (int bj = 0; bj < 2; ++bj)
#pragma unroll
            for (int n = 0; n < 2; ++n) bv[bj][n] = *(const f32x4*)(bias + col0 + bj * HALF + n * 16);
#pragma unroll
        for (int ai = 0; ai < 2; ++ai)
#pragma unroll
            for (int m = 0; m < 4; ++m) { float* rowp = C + (size_t)(row0 + ai * HALF + m * 16) * ldc + col0;
#pragma unroll
                for (int bj = 0; bj < 2; ++bj)
#pragma unroll
                    for (int n = 0; n < 2; ++n) *(f32x4*)(rowp + bj * HALF + n * 16) = acc[ai][bj][m][n] + bv[bj][n]; }
    }
};
template <int ACT  > struct EpiBf16 {
    static constexpr bool PERM = true, AFTER_DRAIN = false;
    bf16_t* O; int ldc;
    __device__ __forceinline__ void operator()(const f32x4 (&acc)[2][2][4][2], const Unit& u, int wr, int wc, int fr, int fq) const {
        const int lane = fr + 16 * fq, r2 = lane >> 2, q2 = lane & 3;
        const int src4 = (r2 + 16 * q2) << 2;
        const int row0 = u.pm * BM + wr * 64 + r2; const int col0 = u.pn * BM + wc * 32 + 8 * q2;
#pragma unroll
        for (int ai = 0; ai < 2; ++ai)
#pragma unroll
            for (int m = 0; m < 4; ++m) { bf16_t* rowp = O + (size_t)(row0 + ai * HALF + m * 16) * ldc + col0;
#pragma unroll
                for (int bj = 0; bj < 2; ++bj) { f32x4 v0 = acc[ai][bj][m][0], v1 = acc[ai][bj][m][1];
                    if (ACT == 1) {
#pragma unroll
                        for (int j = 0; j < 4; ++j) { const float a = fmaxf(v0[j], 0.f), b = fmaxf(v1[j], 0.f); v0[j] = a * a; v1[j] = b * b; } }
                    u32x4 w; w.x = cvt_pk_bf16(v0[0], v0[1]); w.y = cvt_pk_bf16(v0[2], v0[3]); w.z = cvt_pk_bf16(v1[0], v1[1]); w.w = cvt_pk_bf16(v1[2], v1[3]);
                    w.x = (unsigned)__builtin_amdgcn_ds_bpermute(src4, (int)w.x); w.y = (unsigned)__builtin_amdgcn_ds_bpermute(src4, (int)w.y);
                    w.z = (unsigned)__builtin_amdgcn_ds_bpermute(src4, (int)w.z); w.w = (unsigned)__builtin_amdgcn_ds_bpermute(src4, (int)w.w);
                    *(u32x4*)(rowp + bj * HALF) = w; } }
    }
};
struct EpiGateA {
    static constexpr bool PERM = true, AFTER_DRAIN = false;
    bf16_t* T; const bf16_t* G; int ldg; const float* bm;
    __device__ __forceinline__ void operator()(const f32x4 (&acc)[2][2][4][2], const Unit& u, int wr, int wc, int fr, int fq) const {
        const int row0 = u.pm * BM + wr * 64 + fr; const int col0 = u.pn * BM + wc * 32 + 8 * fq;
        f32x4 bv[2][2];
#pragma unroll
        for (int bj = 0; bj < 2; ++bj)
#pragma unroll
            for (int n = 0; n < 2; ++n) bv[bj][n] = *(const f32x4*)(bm + col0 + bj * HALF + 4 * n);
#pragma unroll
        for (int ai = 0; ai < 2; ++ai)
#pragma unroll
            for (int m = 0; m < 4; ++m) { const size_t row = (size_t)(row0 + ai * HALF + m * 16);
#pragma unroll
                for (int bj = 0; bj < 2; ++bj) {
                    const u32x4 gw = *(const u32x4*)(G + row * ldg + col0 + bj * HALF); f32x4 g0, g1; unpack8(gw, g0, g1);
                    f32x4 o0, o1;
#pragma unroll
                    for (int j = 0; j < 4; ++j) { o0[j] = ep_sigmoid(g0[j] + bv[bj][0][j]) * acc[ai][bj][m][0][j]; o1[j] = ep_sigmoid(g1[j] + bv[bj][1][j]) * acc[ai][bj][m][1][j]; }
                    u32x4 w; w.x = cvt_pk_bf16(o0[0], o0[1]); w.y = cvt_pk_bf16(o0[2], o0[3]); w.z = cvt_pk_bf16(o1[0], o1[1]); w.w = cvt_pk_bf16(o1[2], o1[3]);
                    *(u32x4*)(T + row * 1024 + col0 + bj * HALF) = w; } }
    }
};
struct EpiGateB {
    static constexpr bool PERM = true, AFTER_DRAIN = false;
    const bf16_t* T; bf16_t* U; const bf16_t* G; int ldg; const float* bm;
    __device__ __forceinline__ void operator()(const f32x4 (&acc)[2][2][4][2], const Unit& u, int wr, int wc, int fr, int fq) const {
        const int row0 = u.pm * BM + wr * 64 + fr; const int col0 = u.pn * BM + wc * 32 + 8 * fq;
        f32x4 bv[2][2];
#pragma unroll
        for (int bj = 0; bj < 2; ++bj)
#pragma unroll
            for (int n = 0; n < 2; ++n) bv[bj][n] = *(const f32x4*)(bm + col0 + bj * HALF + 4 * n);
#pragma unroll
        for (int ai = 0; ai < 2; ++ai)
#pragma unroll
            for (int m = 0; m < 4; ++m) { const size_t row = (size_t)(row0 + ai * HALF + m * 16);
#pragma unroll
                for (int bj = 0; bj < 2; ++bj) {
                    const u32x4 gw = *(const u32x4*)(G + row * ldg + col0 + bj * HALF); f32x4 g0, g1; unpack8(gw, g0, g1);
                    f32x4 t0, t1; unpack8(*(const u32x4*)(T + row * 1024 + col0 + bj * HALF), t0, t1);
                    f32x4 o0, o1;
#pragma unroll
                    for (int j = 0; j < 4; ++j) { o0[j] = t0[j] + ep_sigmoid(g0[j] + bv[bj][0][j]) * acc[ai][bj][m][0][j]; o1[j] = t1[j] + ep_sigmoid(g1[j] + bv[bj][1][j]) * acc[ai][bj][m][1][j]; }
                    u32x4 w; w.x = cvt_pk_bf16(o0[0], o0[1]); w.y = cvt_pk_bf16(o0[2], o0[3]); w.z = cvt_pk_bf16(o1[0], o1[1]); w.w = cvt_pk_bf16(o1[2], o1[3]);
                    *(u32x4*)(U + row * 1024 + col0 + bj * HALF) = w; } }
    }
};
struct EpiRes {
    static constexpr bool PERM = true, AFTER_DRAIN = false;
    bf16_t* X; const float* gate; int ldgate;
    __device__ __forceinline__ void operator()(const f32x4 (&acc)[2][2][4][2], const Unit& u, int wr, int wc, int fr, int fq) const {
        const int row0 = u.pm * BM + wr * 64 + fr, col0 = u.pn * BM + wc * 32 + 8 * fq;
        const float* gp = gate + (size_t)((u.pm * BM) >> 11) * ldgate + col0;
        f32x4 gv[2][2];
#pragma unroll
        for (int bj = 0; bj < 2; ++bj)
#pragma unroll
            for (int n = 0; n < 2; ++n) gv[bj][n] = *(const f32x4*)(gp + bj * HALF + 4 * n);
#pragma unroll
        for (int ai = 0; ai < 2; ++ai)
#pragma unroll
            for (int m = 0; m < 4; ++m) { bf16_t* xp = X + (size_t)(row0 + ai * HALF + m * 16) * 1024 + col0;
#pragma unroll
                for (int bj = 0; bj < 2; ++bj) { const u32x4 xw = *(const u32x4*)(xp + bj * HALF); f32x4 x0, x1; unpack8(xw, x0, x1);
                    const f32x4 o0 = x0 + gv[bj][0] * acc[ai][bj][m][0], o1 = x1 + gv[bj][1] * acc[ai][bj][m][1];
                    u32x4 ow; ow.x = cvt_pk_bf16(o0[0], o0[1]); ow.y = cvt_pk_bf16(o0[2], o0[3]); ow.z = cvt_pk_bf16(o1[0], o1[1]); ow.w = cvt_pk_bf16(o1[2], o1[3]);
                    *(u32x4*)(xp + bj * HALF) = ow; } }
    }
};


#ifndef GEMM_ALIGN
#define GEMM_ALIGN true
#endif
#ifndef GEMM_SP2
#define GEMM_SP2 true
#endif
template <class Epi, class Sched, bool ALIGN_EPI = GEMM_ALIGN, bool SP2 = GEMM_SP2>
__device__ __forceinline__ void gemm_phase(PG8_LAS unsigned char* lds, const Gemm g, const Sched& S, const Epi& E, unsigned long long*  , int tid_in) {
    int tid_ = tid_in; asm volatile("" : "+v"(tid_));
    const int tid = tid_, wid = __builtin_amdgcn_readfirstlane(tid >> 6), lane = tid & 63, wr = wid >> 2, wc = wid & 3, fr = lane & 15, fq = lane >> 4;
    const int K = g.K, nt = K / BK;
    unsigned voffA[2], voffB[2];
#pragma unroll
    for (int i = 0; i < 2; ++i) { int R, C; stage_rc(tid * 16 + i * 8192, R, C); const int Rb = Epi::PERM ? ((R & ~31) + perm32(R & 31)) : R;
        voffA[i] = (unsigned)(R * K + C) * 2u; voffB[i] = (unsigned)(Rb * K + C) * 2u; }
    const size_t kstep = (size_t)(BK * 2);
    const size_t hstep = (size_t)HALF * K * 2;
    const size_t tstep = 2 * hstep;
    const unsigned ldsw = (unsigned)wid * 1024u;
    const int aoff = lds_byte(wr * 64 + fr, fq * 8), boff = lds_byte(wc * 32 + fr, fq * 8);
#define PG8_SA(b, h) (((b) * 2 + (h)) * HTB)
#define PG8_SB(b, h) ((4 + (b) * 2 + (h)) * HTB)
#define PG8_STAGE(bufoff, gbase, voff) do { _Pragma("unroll") for (int _i = 0; _i < 2; ++_i) \
        __builtin_amdgcn_global_load_lds((const unsigned*)((const char*)(gbase) + (voff)[_i]), (PG8_LAS unsigned*)(lds + (bufoff) + ldsw + _i * 8192), 16, 0, 0); } while (0)
#define PG8_LDA(dst, b, h) do { _Pragma("unroll") for (int m = 0; m < 4; ++m) _Pragma("unroll") for (int k = 0; k < 2; ++k) dst[m][k] = *(const PG8_LAS bf16x8*)(lds + PG8_SA(b, h) + aoff + m * 2048 + k * 1024); } while (0)
#define PG8_LDB(dst, b, h) do { _Pragma("unroll") for (int n = 0; n < 2; ++n) _Pragma("unroll") for (int k = 0; k < 2; ++k) dst[n][k] = *(const PG8_LAS bf16x8*)(lds + PG8_SB(b, h) + boff + n * 2048 + k * 1024); } while (0)
#define PG8_MMA(ai, bj, At, Bt) do { __builtin_amdgcn_s_setprio(1); _Pragma("unroll") for (int m = 0; m < 4; ++m) _Pragma("unroll") for (int n = 0; n < 2; ++n) _Pragma("unroll") for (int k = 0; k < 2; ++k) \
        acc[ai][bj][m][n] = __builtin_amdgcn_mfma_f32_16x16x32_bf16(Bt[n][k], At[m][k], acc[ai][bj][m][n], 0, 0, 0); __builtin_amdgcn_s_setprio(0); } while (0)
#define PG8_WAIT_V(n) asm volatile("s_waitcnt vmcnt(" #n ")" ::: "memory")
#define PG8_WAIT_L(n) asm volatile("s_waitcnt lgkmcnt(" #n ")" ::: "memory")
#define PG8_BAR __builtin_amdgcn_s_barrier()
#define PG8_SCHED __builtin_amdgcn_sched_barrier(0)
    Unit cur, nxt; int ui = 0;
    if (!S.next(0, cur)) return;
    f32x4 acc[2][2][4][2];
#pragma unroll
    for (int a = 0; a < 2; ++a)
#pragma unroll
        for (int b = 0; b < 2; ++b)
#pragma unroll
            for (int m = 0; m < 4; ++m)
#pragma unroll
                for (int n = 0; n < 2; ++n) acc[a][b][m][n] = (f32x4){0.f, 0.f, 0.f, 0.f};
    bf16x8 At[4][2], B0[2][2], B1[2][2];
    const char* cA = (const char*)g.A + (size_t)cur.pm * tstep; const char* cB = (const char*)g.Bt + (size_t)cur.pn * tstep;
    S.a_ready(cur);
    if constexpr (SP2) {
        PG8_STAGE(PG8_SB(0, 0), cB, voffB); PG8_STAGE(PG8_SB(0, 1), cB + hstep, voffB); PG8_STAGE(PG8_SA(0, 0), cA, voffA); PG8_STAGE(PG8_SA(0, 1), cA + hstep, voffA);
        if (wr == 1) PG8_BAR;
        PG8_WAIT_V(2); PG8_BAR;
        PG8_STAGE(PG8_SB(1, 0), cB + kstep, voffB); PG8_STAGE(PG8_SA(1, 0), cA + kstep, voffA); PG8_STAGE(PG8_SB(1, 1), cB + hstep + kstep, voffB);
        PG8_WAIT_V(6); PG8_BAR;
    } else {
        PG8_STAGE(PG8_SB(0, 0), cB, voffB); PG8_STAGE(PG8_SA(0, 0), cA, voffA); PG8_STAGE(PG8_SB(0, 1), cB + hstep, voffB); PG8_STAGE(PG8_SA(0, 1), cA + hstep, voffA);
        if (wr == 1) PG8_BAR;
        PG8_WAIT_V(4); PG8_BAR;
        PG8_STAGE(PG8_SB(1, 0), cB + kstep, voffB); PG8_STAGE(PG8_SA(1, 0), cA + kstep, voffA); PG8_STAGE(PG8_SB(1, 1), cB + hstep + kstep, voffB);
        PG8_WAIT_V(6); PG8_BAR;
    }
    for (;;) {
        const bool has_next = S.next(ui + 1, nxt);
        const char* nA = has_next ? (const char*)g.A + (size_t)nxt.pm * tstep : cA; const char* nB = has_next ? (const char*)g.Bt + (size_t)nxt.pn * tstep : cB;
        for (int t = 0; t < nt; t += 2) {
            const bool last = (t == nt - 2);
            const char* a1 = cA + (size_t)(t + 1) * kstep;
            const char* a2 = last ? nA : cA + (size_t)(t + 2) * kstep; const char* b2 = last ? nB : cB + (size_t)(t + 2) * kstep;
            const char* a3 = a2 + kstep; const char* b3 = b2 + kstep;
            if (last && has_next) S.a_ready(nxt);
            if constexpr (SP2) {
            PG8_LDB(B0, 0, 0); PG8_LDB(B1, 0, 1); PG8_SCHED; PG8_LDA(At, 0, 0); PG8_STAGE(PG8_SA(1, 1), a1 + hstep, voffA);
            PG8_WAIT_V(8); PG8_WAIT_L(0); PG8_BAR; PG8_MMA(0, 0, At, B0); PG8_MMA(0, 1, At, B1); PG8_BAR; PG8_SCHED;
            PG8_LDA(At, 0, 1); PG8_STAGE(PG8_SB(0, 0), b2, voffB); PG8_STAGE(PG8_SB(0, 1), b2 + hstep, voffB); PG8_STAGE(PG8_SA(0, 0), a2, voffA);
            PG8_WAIT_V(8); PG8_WAIT_L(0); PG8_BAR; PG8_MMA(1, 0, At, B0); PG8_MMA(1, 1, At, B1); PG8_BAR; PG8_SCHED;
            PG8_LDB(B0, 1, 0); PG8_LDB(B1, 1, 1); PG8_SCHED; PG8_LDA(At, 1, 0); PG8_STAGE(PG8_SA(0, 1), a2 + hstep, voffA);
            PG8_WAIT_V(8); PG8_WAIT_L(0); PG8_BAR; PG8_MMA(0, 0, At, B0); PG8_MMA(0, 1, At, B1); PG8_BAR; PG8_SCHED;
            PG8_LDA(At, 1, 1); PG8_STAGE(PG8_SB(1, 0), b3, voffB); PG8_STAGE(PG8_SB(1, 1), b3 + hstep, voffB); PG8_STAGE(PG8_SA(1, 0), a3, voffA);
            PG8_WAIT_V(8); PG8_WAIT_L(0); PG8_BAR; PG8_MMA(1, 0, At, B0); PG8_MMA(1, 1, At, B1); PG8_BAR; PG8_SCHED;
            } else {
            PG8_LDB(B0, 0, 0); PG8_SCHED; PG8_LDA(At, 0, 0); PG8_STAGE(PG8_SA(1, 1), a1 + hstep, voffA);
            PG8_WAIT_L(8); PG8_BAR; PG8_WAIT_L(0); PG8_MMA(0, 0, At, B0); PG8_BAR; PG8_SCHED;
            PG8_LDB(B1, 0, 1); PG8_STAGE(PG8_SB(0, 0), b2, voffB);
            PG8_BAR; PG8_WAIT_L(0); PG8_MMA(0, 1, At, B1); PG8_BAR;
            PG8_LDA(At, 0, 1); PG8_STAGE(PG8_SA(0, 0), a2, voffA);
            PG8_BAR; PG8_WAIT_L(0); PG8_MMA(1, 0, At, B0); PG8_BAR; PG8_SCHED;
            PG8_STAGE(PG8_SB(0, 1), b2 + hstep, voffB);
            PG8_WAIT_V(6); PG8_BAR; PG8_MMA(1, 1, At, B1); PG8_BAR;
            PG8_LDB(B0, 1, 0); PG8_SCHED; PG8_LDA(At, 1, 0); PG8_STAGE(PG8_SA(0, 1), a2 + hstep, voffA);
            PG8_WAIT_L(8); PG8_BAR; PG8_WAIT_L(0); PG8_MMA(0, 0, At, B0); PG8_BAR; PG8_SCHED;
            PG8_LDB(B1, 1, 1); PG8_STAGE(PG8_SB(1, 0), b3, voffB);
            PG8_BAR; PG8_WAIT_L(0); PG8_MMA(0, 1, At, B1); PG8_BAR;
            PG8_LDA(At, 1, 1); PG8_STAGE(PG8_SA(1, 0), a3, voffA);
            PG8_BAR; PG8_WAIT_L(0); PG8_MMA(1, 0, At, B0); PG8_BAR; PG8_SCHED;
            PG8_STAGE(PG8_SB(1, 1), b3 + hstep, voffB);
            PG8_WAIT_V(6); PG8_BAR; PG8_MMA(1, 1, At, B1); PG8_BAR;
            }
        }
        if constexpr (ALIGN_EPI) { if (wr == 0) PG8_BAR; }
        if constexpr (!Epi::AFTER_DRAIN) { E(acc, cur, wr, wc, fr, fq); S.done(cur); }
        if (!has_next) break;
#pragma unroll
        for (int a = 0; a < 2; ++a)
#pragma unroll
            for (int b = 0; b < 2; ++b)
#pragma unroll
                for (int m = 0; m < 4; ++m)
#pragma unroll
                    for (int n = 0; n < 2; ++n) acc[a][b][m][n] = (f32x4){0.f, 0.f, 0.f, 0.f};
        cur = nxt; cA = nA; cB = nB; ++ui;
        if constexpr (ALIGN_EPI) { if (wr == 1) PG8_BAR; }
    }
    PG8_WAIT_V(0);
    if constexpr (!ALIGN_EPI) { if (wr == 0) PG8_BAR; }
    PG8_BAR;
    if constexpr (Epi::AFTER_DRAIN) { E.fused(acc, cur, wr, wc, fr, fq, lds, wid, lane); S.done(cur); }
#undef PG8_SA
#undef PG8_SB
#undef PG8_STAGE
#undef PG8_LDA
#undef PG8_LDB
#undef PG8_MMA
#undef PG8_WAIT_V
#undef PG8_WAIT_L
#undef PG8_BAR
#undef PG8_SCHED
}
}

#define XB_TMO      128
#define XB_XCNT(j)  (256  + 64 * (j))
#define XB_XSUB(j)  (1280 + 64 * (j))
#define XB_XGEN(j)  (2304 + 64 * (j))
#define XB_TOP      3328
#define XB_TOPGEN   3392
#define XCD_BAR_WORDS 3456
#define XB_SPIN_CAP (1u << 18)
#define LAS __attribute__((address_space(3)))

__device__ __forceinline__ unsigned xb_ld(unsigned* p)              { return __hip_atomic_load(p, __ATOMIC_RELAXED, __HIP_MEMORY_SCOPE_AGENT); }
__device__ __forceinline__ unsigned xb_add(unsigned* p, unsigned v) { return __hip_atomic_fetch_add(p, v, __ATOMIC_RELAXED, __HIP_MEMORY_SCOPE_AGENT); }
__device__ __forceinline__ unsigned xb_xcc_id() { return (unsigned)__builtin_amdgcn_s_getreg((3 << 11) | 20) & 0xFu; }
#define XB_SPIN(cond, bar) do { unsigned _sp = 0; while (cond) { __builtin_amdgcn_s_sleep(1); \
    if ((++_sp & 255u) == 0u) { if (xb_ld(&(bar)[XB_TMO])) break; if (_sp > XB_SPIN_CAP) { atomicAdd(&(bar)[XB_TMO], 1u); break; } } } } while (0)

struct XcdBarrier {
    unsigned* bar; unsigned x;
    volatile LAS unsigned* st;
};

__device__ __forceinline__ XcdBarrier xcd_barrier_post(unsigned* bar, volatile LAS unsigned* st, int tid) {
    XcdBarrier b; b.bar = bar; b.x = (unsigned)__builtin_amdgcn_readfirstlane((int)xb_xcc_id()); b.st = st;
    if (tid == 0) (void)xb_add(&bar[XB_XCNT(b.x)], 1u);
    return b;
}
__device__ __forceinline__ void xcd_barrier_complete(unsigned* bar, unsigned x, unsigned& nloc, unsigned& nx) {
    const unsigned G = gridDim.x * gridDim.y * gridDim.z;
    unsigned sum, cnt, mine, sp = 0u;
    for (;;) {
        sum = 0u; cnt = 0u; mine = 0u;
#pragma unroll
        for (unsigned j = 0; j < 16; ++j) { const unsigned c = xb_ld(&bar[XB_XCNT(j)]); sum += c; cnt += (c > 0u) ? 1u : 0u; mine = (j == x) ? c : mine; }
        if (sum == G) break;
        __builtin_amdgcn_s_sleep(1);
        if ((++sp & 255u) == 0u) { if (xb_ld(&bar[XB_TMO])) break; if (sp > XB_SPIN_CAP) { atomicAdd(&bar[XB_TMO], 1u); break; } }
    }
    nloc = mine > 0u ? mine : 1u; nx = cnt > 0u ? cnt : 1u;
}

__device__ __forceinline__ void xcd_barrier(const XcdBarrier& b, int tid) {
    asm volatile("s_waitcnt vmcnt(0)" ::: "memory");
    __syncthreads();
    if (tid == 0) {
        unsigned* bar = b.bar; unsigned bx_ = b.x; asm volatile("" : "+s"(bar), "+s"(bx_));
        __builtin_amdgcn_s_waitcnt(0);
        unsigned nloc = b.st[0], nx = b.st[1];
        if (nloc == 0u) { xcd_barrier_complete(bar, bx_, nloc, nx); b.st[0] = nloc; b.st[1] = nx; }
        const unsigned old = xb_add(&bar[XB_XSUB(bx_)], 1u);
        const unsigned gen = old / nloc;
        if (old + 1u == (gen + 1u) * nloc) {
            __builtin_amdgcn_fence(__ATOMIC_RELEASE, "agent");
            asm volatile("s_waitcnt vmcnt(0)" ::: "memory");
            const unsigned og = xb_add(&bar[XB_TOP], 1u);
            const unsigned tg = og / nx;
            if (og + 1u == (tg + 1u) * nx) xb_add(&bar[XB_TOPGEN], 1u);
            else XB_SPIN(xb_ld(&bar[XB_TOPGEN]) == tg, bar);
            __builtin_amdgcn_fence(__ATOMIC_ACQUIRE, "agent");
            xb_add(&bar[XB_XGEN(bx_)], 1u);
            asm volatile("s_waitcnt vmcnt(0)" ::: "memory");
        } else {
            XB_SPIN(xb_ld(&bar[XB_XGEN(bx_)]) == gen, bar);
            __builtin_amdgcn_fence(__ATOMIC_ACQUIRE, "agent");
            asm volatile("s_waitcnt vmcnt(0)" ::: "memory");
        }
    }
    __syncthreads();
}


typedef unsigned v4u __attribute__((ext_vector_type(4)));
typedef float f32x4 __attribute__((ext_vector_type(4)));
#define LDS_WAIT() asm volatile("s_waitcnt lgkmcnt(0)" ::: "memory")
constexpr int NWAVES = 8, NTHREADS = 512;
constexpr int RING_BYTES = 131072, LDS_BYTES = 155648;

struct P { const float* in[N_IN]; float* out; unsigned char* ws; };

template <int M> __device__ __forceinline__ float swz_xor(float v) { static_assert(M >= 1 && M < 32, "swizzle xor mask"); return __int_as_float(__builtin_amdgcn_ds_swizzle(__float_as_int(v), (M << 10) | 0x1f)); }
__device__ __forceinline__ float xor32_sum(float v) { auto r = __builtin_amdgcn_permlane32_swap(__float_as_uint(v), __float_as_uint(v), false, false); return __uint_as_float(r[0]) + __uint_as_float(r[1]); }
__device__ __forceinline__ float wave_sum(float v) {
    v += swz_xor<1>(v); v += swz_xor<2>(v); v += swz_xor<4>(v); v += swz_xor<8>(v); v += swz_xor<16>(v);
    return xor32_sum(v);
}

template <bool VPERM = false>
__device__ __forceinline__ void transpose_item(const float* W, int K, int N, bf16* WT, int k0, int n0, int drow0, LAS float* scr, int lane) {
    float tv[32];
#pragma unroll
    for (int i = 0; i < 32; ++i) { const int kk = 2 * i + (lane >> 5); tv[i] = W[(size_t)(k0 + kk) * N + n0 + (lane & 31)]; }
#pragma unroll
    for (int i = 0; i < 32; ++i) { const int kk = 2 * i + (lane >> 5); scr[kk * 33 + (lane & 31)] = tv[i]; }
    LDS_WAIT(); asm volatile("" ::: "memory");
    const int c = lane & 7;
#pragma unroll
    for (int j = 0; j < 4; ++j) { const int n = (lane >> 3) + 8 * j; const LAS float* s = scr + (8 * c) * 33 + n;
        v4u o; o.x = pk2(s[0 * 33], s[1 * 33]); o.y = pk2(s[2 * 33], s[3 * 33]); o.z = pk2(s[4 * 33], s[5 * 33]); o.w = pk2(s[6 * 33], s[7 * 33]);
        const int dr = VPERM ? (((drow0 + n) & ~127) + hg_vpos((drow0 + n) & 127)) : (drow0 + n);
        *(v4u*)(WT + (size_t)dr * K + k0 + 8 * c) = o; }
    LDS_WAIT(); asm volatile("" ::: "memory");
}

struct TItem { const float* W; bf16* WT; int K, N, k0, n0, dr, vperm; };
__device__ __forceinline__ void titem_decode(TItem& t, const P& p, unsigned char* ws, int it, int IT_L) {
    constexpr int IT_ADA = 16 * 192, IT_IN = 16 * 385, IT_BRA = 16 * 32, IT_BRB = 32 * 32, IT_OUT = 16 * 32, IT_UP = 16 * 128;
    const int l = it / IT_L; int r = it % IT_L;
    unsigned char* wl = ws + WS_W + (size_t)l * W_LSTRIDE; t.vperm = 0;
    if (r < IT_ADA) { const int kb = r / 192, nb = r % 192; t.W = p.in[I_WADA] + (size_t)l * D * 6144; t.K = D; t.N = 6144; t.WT = (bf16*)(ws + WS_WADA) + (size_t)l * 6144 * D; t.k0 = kb * 64; t.n0 = nb * 32; t.dr = nb * 32; return; } r -= IT_ADA;
    if (r < IT_IN) { const int kb = r / 385, nb = r % 385; const int n0 = nb * 32; t.W = p.in[I_WIN] + (size_t)l * D * IN_WIDTH; t.K = D; t.N = IN_WIDTH; t.WT = (bf16*)(wl + WO_IN); t.k0 = kb * 64; t.n0 = n0;
        t.dr = n0 < 10240 ? n0 : (n0 < 10272 ? PC_DT + (n0 - 10240) : n0 - 32); t.vperm = (n0 >= PC_I && n0 < PC_OG) ? 1 : 0; return; } r -= IT_IN;
    if (r < IT_BRA) { const int kb = r / 32, nb = r % 32; t.W = p.in[I_WBRA] + (size_t)l * 1024 * 1024; t.K = 1024; t.N = 1024; t.WT = (bf16*)(wl + WO_BRA); t.k0 = kb * 64; t.n0 = nb * 32; t.dr = nb * 32; return; } r -= IT_BRA;
    if (r < IT_BRB) { const int kb = r / 32, nb = r % 32; t.W = p.in[I_WBRB] + (size_t)l * 2048 * 1024; t.K = 2048; t.N = 1024; t.WT = (bf16*)(wl + WO_BRB); t.k0 = kb * 64; t.n0 = nb * 32; t.dr = nb * 32; return; } r -= IT_BRB;
    if (r < IT_OUT) { const int kb = r / 32, nb = r % 32; t.W = p.in[I_WOUT] + (size_t)l * 1024 * 1024; t.K = 1024; t.N = 1024; t.WT = (bf16*)(wl + WO_OUT); t.k0 = kb * 64; t.n0 = nb * 32; t.dr = nb * 32; return; } r -= IT_OUT;
    if (r < IT_UP) { const int kb = r / 128, nb = r % 128; t.W = p.in[I_WUP] + (size_t)l * 1024 * 4096; t.K = 1024; t.N = 4096; t.WT = (bf16*)(wl + WO_UP); t.k0 = kb * 64; t.n0 = nb * 32; t.dr = nb * 32; return; } r -= IT_UP;
    { const int kb = r / 32, nb = r % 32; t.W = p.in[I_WDOWN] + (size_t)l * 4096 * 1024; t.K = 4096; t.N = 1024; t.WT = (bf16*)(wl + WO_DOWN); t.k0 = kb * 64; t.n0 = nb * 32; t.dr = nb * 32; }
}
__device__ __forceinline__ void titem_load(float (&tv)[32], const TItem& t, int lane) {
    const float* wp = t.W + (size_t)(t.k0 + (lane >> 5)) * t.N + t.n0 + (lane & 31); const size_t st = (size_t)2 * t.N;
#pragma unroll
    for (int i = 0; i < 32; ++i) tv[i] = wp[(size_t)i * st];
}
__device__ __forceinline__ void titem_store(const float (&tv)[32], const TItem& t, LAS float* scr, int lane) {
#pragma unroll
    for (int i = 0; i < 32; ++i) { const int kk = 2 * i + (lane >> 5); scr[kk * 33 + (lane & 31)] = tv[i]; }
    LDS_WAIT(); asm volatile("" ::: "memory");
    const int c = lane & 7;
#pragma unroll
    for (int j = 0; j < 4; ++j) { const int n = (lane >> 3) + 8 * j; const LAS float* s = scr + (8 * c) * 33 + n;
        v4u o; o.x = pk2(s[0 * 33], s[1 * 33]); o.y = pk2(s[2 * 33], s[3 * 33]); o.z = pk2(s[4 * 33], s[5 * 33]); o.w = pk2(s[6 * 33], s[7 * 33]);
        const int dn = t.dr + n; const int dr = t.vperm ? ((dn & ~127) + hg_vpos(dn & 127)) : dn;
        *(v4u*)(t.WT + (size_t)dr * t.K + t.k0 + 8 * c) = o; }
    LDS_WAIT(); asm volatile("" ::: "memory");
}
__device__ __forceinline__ void phase_prologue(const P& p, LAS unsigned char* lds, int gw, int NGW, int lane, int wave) {
    LAS float* scr = (LAS float*)(lds + wave * 16384);
    unsigned char* ws = p.ws;
    constexpr int IT_ADA = 16 * 192, IT_IN = 16 * 385, IT_BRA = 16 * 32, IT_BRB = 32 * 32, IT_OUT = 16 * 32, IT_UP = 16 * 128, IT_DOWN = 64 * 32;
    constexpr int IT_L = IT_ADA + IT_IN + IT_BRA + IT_BRB + IT_OUT + IT_UP + IT_DOWN;
    for (int it = gw; it < DEPTH * IT_L; it += 2 * NGW) {
        TItem a, b2; titem_decode(a, p, ws, it, IT_L); const bool hb = it + NGW < DEPTH * IT_L; titem_decode(b2, p, ws, hb ? it + NGW : it, IT_L);
        float ta[32], tb[32];
        titem_load(ta, a, lane); if (hb) titem_load(tb, b2, lane);
        titem_store(ta, a, scr, lane); if (hb) titem_store(tb, b2, scr, lane);
    }
    for (int i = gw * 64 + lane; i < DEPTH * 28672; i += NGW * 64) { const int l = i / 28672, r = i % 28672;
        ((v4u*)(ws + WS_W + (size_t)l * W_LSTRIDE + WO_IN + (size_t)IN_WIDTH * D * 2))[r] = (v4u){0u, 0u, 0u, 0u}; }
    for (int i = gw * 64 + lane; i < 256 * 1024; i += NGW * 64) { const int r = i >> 10, c = i & 1023;
        float v = 0.f; if (r < NB) v = p.in[I_CP][r * D + c]; else if (r < NCOND) v = p.in[I_CS][(r - NB) * D + c];
        ((bf16*)(ws + WS_AC))[i] = f2bf(siluf_(v)); }
    for (int c = gw * 64 + lane; c < 1024; c += NGW * 64) { float v[DEPTH], mx = -3.0e38f;
#pragma unroll
        for (int l = 0; l < DEPTH; ++l) { v[l] = p.in[I_LB][l * 1024 + c]; mx = fmaxf(mx, v[l]); }
        float s = 0.f;
#pragma unroll
        for (int l = 0; l < DEPTH; ++l) { v[l] = expf(v[l] - mx); s += v[l]; }
        float cum = 0.f; float* lbs = (float*)(ws + WS_LBS);
#pragma unroll
        for (int l = 0; l < DEPTH; ++l) { if (l > 0) cum += v[l] / s; lbs[l * 1024 + c] = cum; }
    }
}

__device__ __forceinline__ f32x4 unpack4(unsigned long long w) { const unsigned lo = (unsigned)w, hi = (unsigned)(w >> 32); return (f32x4){__uint_as_float(lo << 16), __uint_as_float(lo & 0xffff0000u), __uint_as_float(hi << 16), __uint_as_float(hi & 0xffff0000u)}; }
template <int MODE, int NR>
__device__ __forceinline__ void norm_rows(const float* X32, bf16* X, bf16* H, float* out32, const f32x4 (&mul)[4], const f32x4 (&sh)[4], int lane) {
    if constexpr (MODE == 1) {
        f32x4 v[NR][4];
#pragma unroll
        for (int r = 0; r < NR; ++r) { const f32x4* xr = (const f32x4*)(X32 + (size_t)r * D) + lane;
#pragma unroll
            for (int j = 0; j < 4; ++j) v[r][j] = xr[64 * j]; }
#pragma unroll
        for (int r = 0; r < NR; ++r) { float s = 0.f;
#pragma unroll
            for (int j = 0; j < 4; ++j) s += (v[r][j].x * v[r][j].x + v[r][j].y * v[r][j].y) + (v[r][j].z * v[r][j].z + v[r][j].w * v[r][j].w);
            const float rstd = rsqrtf(wave_sum(s) * (1.f / D) + EPS);
            unsigned long long* o8 = (unsigned long long*)(H + (size_t)r * D) + lane; unsigned long long* x8 = (unsigned long long*)(X + (size_t)r * D) + lane;
#pragma unroll
            for (int j = 0; j < 4; ++j) { const f32x4 y = v[r][j] * rstd * mul[j] + sh[j];
                x8[64 * j] = (unsigned long long)pk2(v[r][j].x, v[r][j].y) | ((unsigned long long)pk2(v[r][j].z, v[r][j].w) << 32);
                o8[64 * j] = (unsigned long long)pk2(y.x, y.y) | ((unsigned long long)pk2(y.z, y.w) << 32); } }
    } else {
        unsigned long long raw[NR][4];
#pragma unroll
        for (int r = 0; r < NR; ++r) { const unsigned long long* xr = (const unsigned long long*)(X + (size_t)r * D) + lane;
#pragma unroll
            for (int j = 0; j < 4; ++j) raw[r][j] = xr[64 * j]; }
#pragma unroll
        for (int r = 0; r < NR; ++r) { f32x4 v[4]; float s = 0.f;
#pragma unroll
            for (int j = 0; j < 4; ++j) { v[j] = unpack4(raw[r][j]); s += (v[j].x * v[j].x + v[j].y * v[j].y) + (v[j].z * v[j].z + v[j].w * v[j].w); }
            const float rstd = rsqrtf(wave_sum(s) * (1.f / D) + EPS);
            if constexpr (MODE == 2) { f32x4* o = (f32x4*)(out32 + (size_t)r * D) + lane;
#pragma unroll
                for (int j = 0; j < 4; ++j) o[64 * j] = v[j] * rstd * mul[j];
            } else { unsigned long long* o8 = (unsigned long long*)(H + (size_t)r * D) + lane;
#pragma unroll
                for (int j = 0; j < 4; ++j) { const f32x4 y = v[j] * rstd * mul[j] + sh[j]; o8[64 * j] = (unsigned long long)pk2(y.x, y.y) | ((unsigned long long)pk2(y.z, y.w) << 32); } } }
    }
}
template <int MODE>
__device__ __forceinline__ void phase_norm(const float* Xp32, const float* Xs32, bf16* X, bf16* H, const float* nw, const float* mod_sh, const float* mod_sc, int gw, int NGW, int lane) {
    f32x4 w4[4];
#pragma unroll
    for (int j = 0; j < 4; ++j) w4[j] = ((const f32x4*)nw)[lane + 64 * j];
    for (int b = gw; b < MP / 8; b += NGW) {
        const int ci = b >> 8; f32x4 mul[4], sh[4];
        const f32x4* shp = (const f32x4*)(mod_sh + (size_t)ci * MODLD) + lane; const f32x4* scp = (const f32x4*)(mod_sc + (size_t)ci * MODLD) + lane;
#pragma unroll
        for (int j = 0; j < 4; ++j) { sh[j] = shp[64 * j]; mul[j] = w4[j] * (scp[64 * j] + 1.0f); }
        const size_t ro = (size_t)b * 8 * D;
        norm_rows<MODE, MODE == 1 ? 4 : 8>(MODE == 1 ? Xp32 + ro : nullptr, X + ro, H + ro, nullptr, mul, sh, lane);
        if constexpr (MODE == 1) norm_rows<MODE, 4>(Xp32 + ro + 4 * D, X + ro + 4 * D, H + ro + 4 * D, nullptr, mul, sh, lane);
    }
    for (int sr = gw; sr < MS; sr += NGW) {
        const int ci = NB + sr; f32x4 mul[4], sh[4];
        const f32x4* shp = (const f32x4*)(mod_sh + (size_t)ci * MODLD) + lane; const f32x4* scp = (const f32x4*)(mod_sc + (size_t)ci * MODLD) + lane;
#pragma unroll
        for (int j = 0; j < 4; ++j) { sh[j] = shp[64 * j]; mul[j] = w4[j] * (scp[64 * j] + 1.0f); }
        const size_t ro = (size_t)(MP + sr) * D;
        norm_rows<MODE, 1>(MODE == 1 ? Xs32 + (size_t)sr * D : nullptr, X + ro, H + ro, nullptr, mul, sh, lane);
    }
}
__device__ __forceinline__ void phase_final(const bf16* X, float* out, const float* nw, int gw, int NGW, int lane) {
    f32x4 w4[4];
#pragma unroll
    for (int j = 0; j < 4; ++j) w4[j] = ((const f32x4*)nw)[lane + 64 * j];
    for (int b = gw; b < MP / 8; b += NGW) { const size_t ro = (size_t)b * 8 * D; norm_rows<2, 8>(nullptr, (bf16*)X + ro, nullptr, out + ro, w4, w4, lane); }
    for (int sr = gw; sr < MS; sr += NGW) { const size_t ro = (size_t)(MP + sr) * D; norm_rows<2, 1>(nullptr, (bf16*)X + ro, nullptr, out + ro, w4, w4, lane); }
}


typedef short s16x4 __attribute__((ext_vector_type(4)));
typedef short bf16x8 __attribute__((ext_vector_type(8)));
__device__ __forceinline__ f32x4 mfma16(bf16x8 a, bf16x8 b, f32x4 c) { return __builtin_amdgcn_mfma_f32_16x16x32_bf16(a, b, c, 0, 0, 0); }
__device__ __forceinline__ s16x4 tr_read4(LAS unsigned char* p) { return __builtin_amdgcn_ds_read_tr16_b64_v4i16((LAS s16x4*)p); }
#define SHFL_XOR(v, M) swz_xor<M>(v)
__device__ __forceinline__ float shfl_up_f(float v, int o, int lane) { return __int_as_float(__builtin_amdgcn_ds_bpermute((lane >= o ? lane - o : lane) << 2, __float_as_int(v))); }
__device__ __forceinline__ void sync_threads() { __syncthreads(); }
__device__ __forceinline__ float __builtin_amdgcn_exp2f_(float x) { return __builtin_amdgcn_exp2f(x); }
#ifdef HOST_EMU
#define FENCE_MEM() do {} while (0)
#define SCHED_FENCE() do {} while (0)
#define LAUNDER_PTR(p) do {} while (0)
#else
#define LAUNDER_PTR(p) asm volatile("" : "+v"(p))
#define FENCE_MEM() asm volatile("" ::: "memory")
#define SCHED_FENCE() __builtin_amdgcn_sched_barrier(0)
#endif
constexpr int RC = 64;
constexpr int NSEG = 4, SEGLEN = 512, NCH = SEGLEN / RC;
constexpr int PQ = 272;
constexpr int PX = 528;

struct RecurBufs {
    bf16* proj;
    bf16* xbcc;
    float* dtv;
    float* cum;
    float* cv;
    float* sseg;
    float* dseg;
    float* hseg;
    float* tseg;
    bf16* ohg;
    bf16* y;
};

__device__ __forceinline__ bf16x8 frag_rows(LAS unsigned char* img, int pitch, int row, int kcol) { return *(LAS bf16x8*)(img + row * pitch + kcol * 2); }
__device__ __forceinline__ bf16x8 frag_tr(LAS unsigned char* img, int pitch, int k0a, int k0b, int col0, int lane) {
    const int q = (lane & 15) >> 2, p = lane & 3;
    const s16x4 a = tr_read4(img + (k0a + q) * pitch + (col0 + 4 * p) * 2);
    const s16x4 b = tr_read4(img + (k0b + q) * pitch + (col0 + 4 * p) * 2);
    return (bf16x8){a[0], a[1], a[2], a[3], b[0], b[1], b[2], b[3]};
}
__device__ __forceinline__ bf16x8 scale_frag(bf16x8 f, float s) {
    bf16x8 o;
#pragma unroll
    for (int j = 0; j < 8; ++j) o[j] = (short)f2bf(bf2f((bf16)f[j]) * s);
    return o;
}
__device__ __forceinline__ bf16x8 scale_frag8(bf16x8 f, const float (&s)[8]) {
    bf16x8 o;
#pragma unroll
    for (int j = 0; j < 8; ++j) o[j] = (short)f2bf(bf2f((bf16)f[j]) * s[j]);
    return o;
}
__device__ __forceinline__ void stage_tile128(const bf16* g, size_t ld, LAS unsigned char* img, int tid) {
#pragma unroll
    for (int i = 0; i < 2; ++i) { const int idx = tid + i * 512, r = idx >> 4, c16 = idx & 15;
        *(LAS v4u*)(img + r * PQ + c16 * 16) = *(const v4u*)(g + (size_t)r * ld + c16 * 8); }
}

constexpr int HG_QT = 0, HG_KT = 17408, HG_V = 34816, HG_PART = 52224, HG_VEC1 = 54272, HG_ST = 52224, HG_VEC = 87040, HG_RED = 89088;

__device__ __forceinline__ void hgrn_state_update(f32x4 (&S)[8], LAS unsigned char* Kt, LAS unsigned char* V, const LAS float* escale, const LAS float* edec, int w, int lane) {
    const int c = lane & 15, g = lane >> 4;
    const f32x4 dc = *(const LAS f32x4*)(edec + 16 * w + 4 * g);
#pragma unroll
    for (int et = 0; et < 8; ++et) S[et] = S[et] * dc;
    const float es = escale[16 * w + c];
#pragma unroll
    for (int ks = 0; ks < 2; ++ks) {
        const bf16x8 A = scale_frag(frag_tr(Kt, PQ, 32 * ks + 8 * g, 32 * ks + 8 * g + 4, 16 * w, lane), es);
#pragma unroll
        for (int et = 0; et < 8; ++et) { const bf16x8 B = frag_tr(V, PQ, 32 * ks + 8 * g, 32 * ks + 8 * g + 4, 16 * et, lane); S[et] = mfma16(A, B, S[et]); }
        SCHED_FENCE();
    }
}

__device__ __forceinline__ void hgrn_pass1(const RecurBufs& rb, const float* lbs_l, int u, int tid, LAS unsigned char* lds) {
    const int b = u >> 5, h = (u >> 2) & 7, seg = u & 3, lane = tid & 63, w = tid >> 6;
    const int d = tid & 127, jq = tid >> 7;
    LAS unsigned char* Qt = lds + HG_QT; LAS unsigned char* Kt = lds + HG_KT; LAS unsigned char* V = lds + HG_V; LAS float* part = (LAS float*)(lds + HG_PART); LAS float* vec = (LAS float*)(lds + HG_VEC1);
    const float lb = lbs_l[h * 128 + d];
    f32x4 S[8];
#pragma unroll
    for (int et = 0; et < 8; ++et) S[et] = (f32x4){0.f, 0.f, 0.f, 0.f};
    float dprod = 1.f;
    const int sr = tid >> 4, sc16 = tid & 15;
    v4u pre[6];
    {   const bf16* gq = rb.proj + ((size_t)b * SEQ + seg * SEGLEN + sr) * LDP + PC_Q + h * 128 + sc16 * 8;
        pre[0] = *(const v4u*)gq; pre[1] = *(const v4u*)(gq + 32 * (size_t)LDP); pre[2] = *(const v4u*)(gq + PC_F); pre[3] = *(const v4u*)(gq + 32 * (size_t)LDP + PC_F);
        pre[4] = *(const v4u*)(gq + PC_I); pre[5] = *(const v4u*)(gq + 32 * (size_t)LDP + PC_I); }
    for (int ch = 0; ch < NCH; ++ch) {
        const size_t row0 = (size_t)b * SEQ + seg * SEGLEN + ch * RC;
        bf16* gq = rb.proj + (row0 + sr) * LDP + PC_Q + h * 128 + sc16 * 8;
        *(LAS v4u*)(Qt + sr * PQ + sc16 * 16) = pre[0]; *(LAS v4u*)(Qt + (sr + 32) * PQ + sc16 * 16) = pre[1];
        *(LAS v4u*)(Kt + sr * PQ + sc16 * 16) = pre[2]; *(LAS v4u*)(Kt + (sr + 32) * PQ + sc16 * 16) = pre[3];
        *(LAS v4u*)(V + sr * PQ + sc16 * 16) = pre[4]; *(LAS v4u*)(V + (sr + 32) * PQ + sc16 * 16) = pre[5];
        if (ch + 1 < NCH) { const bf16* gn = gq + RC * (size_t)LDP;
            pre[0] = *(const v4u*)gn; pre[1] = *(const v4u*)(gn + 32 * (size_t)LDP); pre[2] = *(const v4u*)(gn + PC_F); pre[3] = *(const v4u*)(gn + 32 * (size_t)LDP + PC_F);
            pre[4] = *(const v4u*)(gn + PC_I); pre[5] = *(const v4u*)(gn + 32 * (size_t)LDP + PC_I); }
        sync_threads();
        float qq[16], kk[16], lg[16];
#pragma unroll
        for (int j = 0; j < 16; ++j) { const float q = bf2f(*(const LAS bf16*)(Qt + (16 * jq + j) * PQ + d * 2)), f = bf2f(*(const LAS bf16*)(Kt + (16 * jq + j) * PQ + d * 2));
            const float fg = lb + (1.f - lb) * sigmoidf_(f);
            qq[j] = siluf_(q) * 0.08838834764831845f; kk[j] = 1.f - fg; lg[j] = __logf(fg); }
#pragma unroll
        for (int j = 1; j < 16; ++j) lg[j] += lg[j - 1];
        part[jq * 128 + d] = lg[15];
        sync_threads();
        const float p0 = part[d], p1 = part[128 + d], p2 = part[256 + d], p3 = part[384 + d];
        const float off = (jq > 0 ? p0 : 0.f) + (jq > 1 ? p1 : 0.f) + (jq > 2 ? p2 : 0.f);
        const float bref = p0 + p1, bend = (p0 + p1) + (p2 + p3);
#pragma unroll
        for (int j = 0; j < 16; ++j) { const float e1 = __expf(fminf(fmaxf(off + lg[j] - bref, -80.f), 80.f));
            *(LAS bf16*)(Qt + (16 * jq + j) * PQ + d * 2) = f2bf(qq[j] * e1); *(LAS bf16*)(Kt + (16 * jq + j) * PQ + d * 2) = f2bf(kk[j] * frcp_(e1)); }
        if (jq == 0) { const float eref = __expf(bref), esc = __expf(bend - bref), edc = __expf(bend);
            float* cvp = rb.cv + ((size_t)((b * 8 + h) * 32 + seg * NCH + ch) * 3) * 128;
            cvp[d] = eref; cvp[128 + d] = esc; cvp[256 + d] = edc; vec[128 + d] = esc; vec[256 + d] = edc; }
        dprod *= __expf(bend);
        sync_threads();
        *(v4u*)gq = *(const LAS v4u*)(Qt + sr * PQ + sc16 * 16); *(v4u*)(gq + 32 * (size_t)LDP) = *(const LAS v4u*)(Qt + (sr + 32) * PQ + sc16 * 16);
        *(v4u*)(gq + PC_F) = *(const LAS v4u*)(Kt + sr * PQ + sc16 * 16); *(v4u*)(gq + 32 * (size_t)LDP + PC_F) = *(const LAS v4u*)(Kt + (sr + 32) * PQ + sc16 * 16);
        hgrn_state_update(S, Kt, V, vec + 128, vec + 256, w, lane);
        sync_threads();
    }
    float* sp = rb.sseg + (size_t)u * 16384 + tid * 4;
#pragma unroll
    for (int et = 0; et < 8; ++et) { LAUNDER_PTR(sp); *(f32x4*)sp = S[et]; sp += 2048; }
    if (jq == 0) rb.dseg[u * 128 + d] = dprod;
}

__device__ __forceinline__ void hgrn_pass2(const RecurBufs& rb, const float* hgn_l, float* state_out_l, int u, int tid, LAS unsigned char* lds) {
    const int b = u >> 5, h = (u >> 2) & 7, seg = u & 3, lane = tid & 63, w = tid >> 6, c = lane & 15, g = lane >> 4;
    const int it = w & 3, eh = w >> 2;
    LAS unsigned char* Qt = lds + HG_QT; LAS unsigned char* Kt = lds + HG_KT; LAS unsigned char* V = lds + HG_V; LAS unsigned char* ST = lds + HG_ST;
    LAS float* vec = (LAS float*)(lds + HG_VEC); LAS float* red = (LAS float*)(lds + HG_RED);
    f32x4 S[8];
#pragma unroll
    for (int et = 0; et < 8; ++et) S[et] = (f32x4){0.f, 0.f, 0.f, 0.f};
    {
        f32x4 L[3][8], dcs[3];
#pragma unroll
        for (int s = 0; s < 3; ++s) if (s < seg) { const int u2 = u - seg + s;
            dcs[s] = *(const f32x4*)(rb.dseg + u2 * 128 + 16 * w + 4 * g);
            const float* sp = rb.sseg + (size_t)u2 * 16384 + tid * 4;
#pragma unroll
            for (int et = 0; et < 8; ++et) { LAUNDER_PTR(sp); L[s][et] = *(const f32x4*)sp; sp += 2048; } }
#pragma unroll
        for (int s = 0; s < 3; ++s) if (s < seg) {
#pragma unroll
            for (int et = 0; et < 8; ++et) S[et] = S[et] * dcs[s] + L[s][et]; } }
    const int e0 = 64 * eh + 4 * c;
    const f32x4 hn = *(const f32x4*)(hgn_l + e0);
    const float* cvb = rb.cv + ((size_t)((b * 8 + h) * 32 + seg * NCH) * 3) * 128;
    const int sr = tid >> 4, sc16 = tid & 15;
    const size_t rowS = (size_t)b * SEQ + seg * SEGLEN;
    v4u pre[6];
    {   const bf16* gq = rb.proj + (rowS + sr) * LDP + PC_Q + h * 128 + sc16 * 8;
        pre[0] = *(const v4u*)gq; pre[1] = *(const v4u*)(gq + 32 * (size_t)LDP); pre[2] = *(const v4u*)(gq + PC_F); pre[3] = *(const v4u*)(gq + 32 * (size_t)LDP + PC_F);
        pre[4] = *(const v4u*)(gq + PC_I); pre[5] = *(const v4u*)(gq + 32 * (size_t)LDP + PC_I); }
    float cvn = tid < 384 ? cvb[tid] : 0.f; f32x4 ern = *(const f32x4*)(cvb + 16 * w + 4 * g);
    for (int ch = 0; ch < NCH; ++ch) {
        const size_t row0 = rowS + ch * RC;
        *(LAS v4u*)(Qt + sr * PQ + sc16 * 16) = pre[0]; *(LAS v4u*)(Qt + (sr + 32) * PQ + sc16 * 16) = pre[1];
        *(LAS v4u*)(Kt + sr * PQ + sc16 * 16) = pre[2]; *(LAS v4u*)(Kt + (sr + 32) * PQ + sc16 * 16) = pre[3];
        *(LAS v4u*)(V + sr * PQ + sc16 * 16) = pre[4]; *(LAS v4u*)(V + (sr + 32) * PQ + sc16 * 16) = pre[5];
        if (ch + 1 < NCH) { const bf16* gq = rb.proj + (row0 + RC + sr) * LDP + PC_Q + h * 128 + sc16 * 8;
            pre[0] = *(const v4u*)gq; pre[1] = *(const v4u*)(gq + 32 * (size_t)LDP); pre[2] = *(const v4u*)(gq + PC_F); pre[3] = *(const v4u*)(gq + 32 * (size_t)LDP + PC_F);
            pre[4] = *(const v4u*)(gq + PC_I); pre[5] = *(const v4u*)(gq + 32 * (size_t)LDP + PC_I); }
        if (tid < 384) vec[tid] = cvn;
        {
            const f32x4 er = ern;
            if (ch + 1 < NCH) { if (tid < 384) cvn = cvb[(size_t)(ch + 1) * 384 + tid]; ern = *(const f32x4*)(cvb + (size_t)(ch + 1) * 384 + 16 * w + 4 * g); }
#pragma unroll
            for (int et = 0; et < 8; ++et) { const f32x4 v = S[et] * er;
                *(LAS unsigned long long*)(ST + (16 * et + c) * PQ + (16 * w + 4 * g) * 2) = (unsigned long long)pk2(v[0], v[1]) | ((unsigned long long)pk2(v[2], v[3]) << 32); } }
        unsigned long long ogv[4];
#pragma unroll
        for (int r = 0; r < 4; ++r) ogv[r] = *(const unsigned long long*)(rb.proj + (row0 + 16 * it + 4 * g + r) * LDP + PC_OG + h * 128 + e0);
        sync_threads();
        bf16x8 Qfr[4];
#pragma unroll
        for (int kd = 0; kd < 4; ++kd) Qfr[kd] = frag_rows(Qt, PQ, 16 * it + c, 32 * kd + 8 * g);
        unsigned PT[4][2];
#pragma unroll
        for (int jt = 0; jt < 4; ++jt) {
            f32x4 acc = (f32x4){0.f, 0.f, 0.f, 0.f};
            if (jt <= it) {
#pragma unroll
                for (int kd = 0; kd < 4; ++kd) acc = mfma16(frag_rows(Kt, PQ, 16 * jt + c, 32 * kd + 8 * g), Qfr[kd], acc);
                if (jt == it) {
#pragma unroll
                    for (int r = 0; r < 4; ++r) acc[r] = (4 * g + r <= c) ? acc[r] : 0.f; }
            }
            PT[jt][0] = pk2(acc[0], acc[1]); PT[jt][1] = pk2(acc[2], acc[3]); SCHED_FENCE();
        }
        f32x4 o[4];
#pragma unroll
        for (int et = 0; et < 4; ++et) o[et] = (f32x4){0.f, 0.f, 0.f, 0.f};
#pragma unroll
        for (int ks = 0; ks < 2; ++ks) if (2 * ks <= it) {
            v4u pa = (v4u){PT[2 * ks][0], PT[2 * ks][1], PT[2 * ks + 1][0], PT[2 * ks + 1][1]};
            const bf16x8 A = __builtin_bit_cast(bf16x8, pa);
#pragma unroll
            for (int et = 0; et < 4; ++et) o[et] = mfma16(A, frag_tr(V, PQ, 32 * ks + 4 * g, 32 * ks + 16 + 4 * g, 16 * (4 * eh + et), lane), o[et]);
        }
#pragma unroll
        for (int kd = 0; kd < 4; ++kd) {
#pragma unroll
            for (int et = 0; et < 4; ++et) o[et] = mfma16(Qfr[kd], frag_rows(ST, PQ, 16 * (4 * eh + et) + c, 32 * kd + 8 * g), o[et]);
            SCHED_FENCE(); }
        hgrn_state_update(S, Kt, V, vec + 128, vec + 256, w, lane);
        float ss[4];
#pragma unroll
        for (int r = 0; r < 4; ++r) { float s = 0.f;
#pragma unroll
            for (int et = 0; et < 4; ++et) s += o[et][r] * o[et][r];
            s += SHFL_XOR(s, 1); s += SHFL_XOR(s, 2); s += SHFL_XOR(s, 4); s += SHFL_XOR(s, 8); ss[r] = s; }
        if (c == 0) {
#pragma unroll
            for (int r = 0; r < 4; ++r) red[(16 * it + 4 * g + r) * 2 + eh] = ss[r]; }
        sync_threads();
#pragma unroll
        for (int r = 0; r < 4; ++r) { const int i = 16 * it + 4 * g + r; const float rstd = rsqrtf((red[i * 2] + red[i * 2 + 1]) * (1.f / 128.f) + EPS);
            float ov[4];
#pragma unroll
            for (int et = 0; et < 4; ++et) { const float og = bf2f((bf16)(ogv[r] >> (16 * et))); ov[et] = o[et][r] * rstd * hn[et] * siluf_(og); }
            *(unsigned long long*)(rb.ohg + (row0 + i) * 1024 + h * 128 + e0) = (unsigned long long)pk2(ov[0], ov[1]) | ((unsigned long long)pk2(ov[2], ov[3]) << 32); }
        sync_threads();
    }
    if (seg == NSEG - 1) { float* so = state_out_l + (size_t)(b * 8 + h) * 16384 + (size_t)(16 * w + 4 * g) * 128 + 4 * c;
#pragma unroll
        for (int r = 0; r < 4; ++r)
#pragma unroll
            for (int a = 0; a < 2; ++a) *(f32x4*)(so + r * 128 + 64 * a) = (f32x4){S[4 * a][r], S[4 * a + 1][r], S[4 * a + 2][r], S[4 * a + 3][r]}; }
}

constexpr int PR = 1040;
constexpr int SD_T = 0, SD_H = 66560, SD_XO = 66560  , SD_DT = 136192, SD_CUM = 137216, SD_RED = 138240, SD_END = 139264;
__device__ __forceinline__ int ssd_gcol(int grp, int ch16) { return ch16 < 32 ? grp * 256 + ch16 * 8 : (ch16 < 48 ? 2048 + grp * 128 + (ch16 - 32) * 8 : 3072 + grp * 128 + (ch16 - 48) * 8); }

__device__ __forceinline__ void ssd_state_update(f32x4 (&H)[4][4], LAS unsigned char* Xi, int xp, LAS unsigned char* Bi, int bp, const LAS float* sDt, const LAS float* sCum, int w, int lane) {
    const int g = lane >> 4, k = w >> 1, nh = w & 1;
    const float tot = sCum[63 * 4 + k]; const float et = __expf(tot);
#pragma unroll
    for (int nt = 0; nt < 4; ++nt)
#pragma unroll
        for (int pt = 0; pt < 4; ++pt) H[nt][pt] = H[nt][pt] * et;
#pragma unroll
    for (int ks = 0; ks < 2; ++ks) {
        float wg[8];
#pragma unroll
        for (int j = 0; j < 8; ++j) wg[j] = __expf(tot - sCum[(32 * ks + 8 * g + j) * 4 + k]) * sDt[(32 * ks + 8 * g + j) * 4 + k];
        bf16x8 Bx[4];
#pragma unroll
        for (int pt = 0; pt < 4; ++pt) Bx[pt] = scale_frag8(frag_tr(Xi, xp, 32 * ks + 8 * g, 32 * ks + 8 * g + 4, 64 * k + 16 * pt, lane), wg);
#pragma unroll
        for (int nt = 0; nt < 4; ++nt) { const bf16x8 A = frag_tr(Bi, bp, 32 * ks + 8 * g, 32 * ks + 8 * g + 4, 16 * (4 * nh + nt), lane);
#pragma unroll
            for (int pt = 0; pt < 4; ++pt) H[nt][pt] = mfma16(A, Bx[pt], H[nt][pt]);
            SCHED_FENCE(); }
    }
}

typedef float f32x2r __attribute__((ext_vector_type(2)));
__device__ __forceinline__ f32x2r unpack2(unsigned w) { return (f32x2r){__uint_as_float(w << 16), __uint_as_float(w & 0xffff0000u)}; }
__device__ __forceinline__ f32x2r silu2(f32x2r a) {
    const f32x2r t = a * (-1.4426950408889634f); f32x2r e; e.x = __builtin_amdgcn_exp2f_(t.x); e.y = __builtin_amdgcn_exp2f_(t.y);
    const f32x2r d = e + 1.0f; f32x2r r; r.x = frcp_(d.x); r.y = frcp_(d.y); return a * r; }
constexpr int SD_RH = SD_XO + 64 * PX;
__device__ __forceinline__ void ssd_pass1(const RecurBufs& rb, const float* conv_w, const float* conv_b, const float* dt_bias, const float* a_log, float* conv_out_l, int u, int tid, LAS unsigned char* lds) {
    const int b = u >> 5, grp = (u >> 2) & 7, seg = u & 3, lane = tid & 63, w = tid >> 6;
    LAS unsigned char* T = lds + SD_T; LAS float* sDt = (LAS float*)(lds + SD_DT); LAS float* sCum = (LAS float*)(lds + SD_CUM); LAS unsigned char* RH = lds + SD_RH;
    const int cp = tid & 255, half = tid >> 8, t0c = 2 * cp;
    const int chx = t0c < 256 ? (grp * 256 + t0c) : (t0c < 384 ? (2048 + grp * 128 + (t0c - 256)) : (3072 + grp * 128 + (t0c - 384)));
    const int xcol = (t0c & ~63) + 16 * (t0c & 3) + ((t0c & 63) >> 2);
    const f32x2r w0 = (f32x2r){conv_w[chx], conv_w[chx + 1]}, w1 = (f32x2r){conv_w[4096 + chx], conv_w[4096 + chx + 1]}, w2 = (f32x2r){conv_w[8192 + chx], conv_w[8192 + chx + 1]},
                 w3 = (f32x2r){conv_w[12288 + chx], conv_w[12288 + chx + 1]}, cb = (f32x2r){conv_b[chx], conv_b[chx + 1]};
    const size_t rowS = (size_t)b * SEQ + seg * SEGLEN;
    if (half == 0) {
#pragma unroll
        for (int j = 0; j < 3; ++j) { unsigned v = 0u; if (seg > 0) v = *(const unsigned*)(rb.proj + (rowS - 3 + j) * LDP + PC_XBC + chx); *(LAS unsigned*)(RH + j * 1024 + cp * 4) = v; } }
    f32x4 H[4][4];
#pragma unroll
    for (int nt = 0; nt < 4; ++nt)
#pragma unroll
        for (int pt = 0; pt < 4; ++pt) H[nt][pt] = (f32x4){0.f, 0.f, 0.f, 0.f};
    float tsum = 0.f;
    const int ch16 = tid & 63, rr = tid >> 6;
    const int gcol = ssd_gcol(grp, ch16);
    LAS unsigned char* XO = lds + SD_XO;
    v4u raw[8];
    {   const bf16* gp = rb.proj + (rowS + rr) * LDP + PC_XBC + gcol;
#pragma unroll
        for (int i = 0; i < 8; ++i) { LAUNDER_PTR(gp); raw[i] = *(const v4u*)gp; gp += 8 * (size_t)LDP; } }
    bf16 dtn = 0;
    if (w < 4) dtn = rb.proj[(rowS + lane) * LDP + PC_DT + grp * 4 + w];
    unsigned hr0 = 0u, hr1 = 0u, hr2 = 0u;
    for (int ch = 0; ch < NCH; ++ch) {
        const size_t row0 = rowS + ch * RC;
        if (w < 4) {
            const int head = grp * 4 + w; const size_t row = row0 + lane;
            const float dv = softplusf_(bf2f(dtn) + dt_bias[head]);
            if (ch + 1 < NCH) dtn = rb.proj[(row + RC) * LDP + PC_DT + head];
            float la = dv * (-__expf(a_log[head]));
#pragma unroll
            for (int o = 1; o < 64; o <<= 1) { const float t = shfl_up_f(la, o, lane); if (lane >= o) la += t; }
            sDt[lane * 4 + w] = dv; sCum[lane * 4 + w] = la; rb.dtv[row * 32 + head] = dv; rb.cum[row * 32 + head] = la;
        }
#pragma unroll
        for (int i = 0; i < 8; ++i) *(LAS v4u*)(T + (rr + 8 * i) * PR + ch16 * 16) = raw[i];
        if (ch + 1 < NCH) { const bf16* gp = rb.proj + (row0 + RC + rr) * LDP + PC_XBC + gcol;
#pragma unroll
            for (int i = 0; i < 8; ++i) { LAUNDER_PTR(gp); raw[i] = *(const v4u*)gp; gp += 8 * (size_t)LDP; } }
        sync_threads();
        if (half == 0) { hr0 = *(const LAS unsigned*)(RH + cp * 4); hr1 = *(const LAS unsigned*)(RH + 1024 + cp * 4); hr2 = *(const LAS unsigned*)(RH + 2048 + cp * 4); }
        else { hr0 = *(const LAS unsigned*)(T + 29 * PR + cp * 4); hr1 = *(const LAS unsigned*)(T + 30 * PR + cp * 4); hr2 = *(const LAS unsigned*)(T + 31 * PR + cp * 4); }
        sync_threads();
        {
            f32x2r r0 = unpack2(hr0), r1 = unpack2(hr1), r2 = unpack2(hr2);
            const LAS unsigned char* src = T + (32 * half) * PR + cp * 4;
            unsigned lastw0 = hr0, lastw1 = hr1, lastw2 = hr2;
#pragma unroll 8
            for (int j = 0; j < 32; ++j) { const unsigned cw = *(const LAS unsigned*)(src + j * PR); const f32x2r cur = unpack2(cw);
                const f32x2r a = cb + w0 * r0 + w1 * r1 + w2 * r2 + w3 * cur; r0 = r1; r1 = r2; r2 = cur; lastw0 = lastw1; lastw1 = lastw2; lastw2 = cw;
                const f32x2r v = silu2(a); const unsigned ow = pk2(v.x, v.y);
                if (cp < 128) { LAS unsigned char* d = XO + (32 * half + j) * PX + xcol * 2; *(LAS bf16*)d = (bf16)ow; *(LAS bf16*)(d + 32) = (bf16)(ow >> 16); }
                else *(LAS unsigned*)(T + (32 * half + j) * PR + cp * 4) = ow; }
            if (half == 1) { *(LAS unsigned*)(RH + cp * 4) = lastw0; *(LAS unsigned*)(RH + 1024 + cp * 4) = lastw1; *(LAS unsigned*)(RH + 2048 + cp * 4) = lastw2;
                hr0 = lastw0; hr1 = lastw1; hr2 = lastw2; }
        }
        sync_threads();
        tsum += sCum[63 * 4 + (w >> 1)];
        ssd_state_update(H, XO, PX, T + 512, PR, sDt, sCum, w, lane);
        {   bf16* gp = rb.xbcc + (row0 + rr) * 4096 + gcol;
            const LAS unsigned char* src = ch16 < 32 ? (XO + ch16 * 16) : (T + ch16 * 16); const int spitch = ch16 < 32 ? PX : PR;
#pragma unroll
            for (int i = 0; i < 8; ++i) { LAUNDER_PTR(gp); *(v4u*)gp = *(const LAS v4u*)(src + (rr + 8 * i) * spitch); gp += 8 * 4096; } }
        sync_threads();
    }
    float* hp = rb.hseg + (size_t)u * 32768 + tid * 4;
#pragma unroll
    for (int nt = 0; nt < 4; ++nt)
#pragma unroll
        for (int pt = 0; pt < 4; ++pt) { LAUNDER_PTR(hp); *(f32x4*)hp = H[nt][pt]; hp += 2048; }
    if ((tid & 127) == 0) rb.tseg[u * 4 + (w >> 1)] = tsum;
    if (seg == NSEG - 1 && half == 1) { float* co = conv_out_l + (size_t)b * 3 * 4096;
        const f32x2r a0 = unpack2(hr0), a1 = unpack2(hr1), a2 = unpack2(hr2);
        co[chx] = a0.x; co[chx + 1] = a0.y; co[4096 + chx] = a1.x; co[4096 + chx + 1] = a1.y; co[8192 + chx] = a2.x; co[8192 + chx + 1] = a2.y; }
}

__device__ __forceinline__ void ssd_pass2(const RecurBufs& rb, const float* d_skip, const float* ssm_norm, float* state_out_l, int u, int tid, LAS unsigned char* lds) {
    const int b = u >> 5, grp = (u >> 2) & 7, seg = u & 3, lane = tid & 63, w = tid >> 6, c = lane & 15, g = lane >> 4;
    const int k = w >> 1, hf = w & 1, head = grp * 4 + k;
    LAS unsigned char* T = lds + SD_T; LAS unsigned char* sB = T + 512; LAS unsigned char* sC = T + 768; LAS unsigned char* hS = lds + SD_H + k * (64 * PQ);
    LAS float* sDt = (LAS float*)(lds + SD_DT); LAS float* sCum = (LAS float*)(lds + SD_CUM); LAS float* red = (LAS float*)(lds + SD_RED);
    f32x4 H[4][4];
#pragma unroll
    for (int nt = 0; nt < 4; ++nt)
#pragma unroll
        for (int pt = 0; pt < 4; ++pt) H[nt][pt] = (f32x4){0.f, 0.f, 0.f, 0.f};
    for (int s = 0; s < seg; s += 2) {
        f32x4 L0[4][4], L1[4][4]; const bool two = s + 1 < seg;
        const int ua = u - seg + s, ub = two ? ua + 1 : ua;
        const float dca = __expf(rb.tseg[ua * 4 + k]), dcb = __expf(rb.tseg[ub * 4 + k]);
        {   const float* hp = rb.hseg + (size_t)ua * 32768 + tid * 4;
#pragma unroll
            for (int nt = 0; nt < 4; ++nt)
#pragma unroll
                for (int pt = 0; pt < 4; ++pt) { LAUNDER_PTR(hp); L0[nt][pt] = *(const f32x4*)hp; hp += 2048; } }
        if (two) { const float* hp = rb.hseg + (size_t)ub * 32768 + tid * 4;
#pragma unroll
            for (int nt = 0; nt < 4; ++nt)
#pragma unroll
                for (int pt = 0; pt < 4; ++pt) { LAUNDER_PTR(hp); L1[nt][pt] = *(const f32x4*)hp; hp += 2048; } }
#pragma unroll
        for (int nt = 0; nt < 4; ++nt)
#pragma unroll
            for (int pt = 0; pt < 4; ++pt) { H[nt][pt] = H[nt][pt] * dca + L0[nt][pt]; if (two) H[nt][pt] = H[nt][pt] * dcb + L1[nt][pt]; } }
    const float Dk = d_skip[head];
    const size_t rowS = (size_t)b * SEQ + seg * SEGLEN;
    const int ch16 = tid & 63, rr = tid >> 6; const int gcol = ssd_gcol(grp, ch16);
    const int chn0 = grp * 256 + k * 64 + 4 * c;
    for (int ch = 0; ch < NCH; ++ch) {
        const size_t row0 = rowS + ch * RC;
        {   v4u raw[8];
            {   const bf16* gp = rb.xbcc + (row0 + rr) * 4096 + gcol;
#pragma unroll
                for (int i = 0; i < 8; ++i) { LAUNDER_PTR(gp); raw[i] = *(const v4u*)gp; gp += 8 * 4096; } }
            if (tid < 256) { sDt[tid] = rb.dtv[(row0 + (tid >> 2)) * 32 + grp * 4 + (tid & 3)]; sCum[tid] = rb.cum[(row0 + (tid >> 2)) * 32 + grp * 4 + (tid & 3)]; }
#pragma unroll
            for (int nt = 0; nt < 4; ++nt)
#pragma unroll
                for (int pt = 0; pt < 4; ++pt) { const f32x4 v = H[nt][pt];
                    *(LAS unsigned long long*)(hS + (4 * c + pt) * PQ + (16 * (4 * hf + nt) + 4 * g) * 2) = (unsigned long long)pk2(v[0], v[1]) | ((unsigned long long)pk2(v[2], v[3]) << 32); }
#pragma unroll
            for (int i = 0; i < 8; ++i) *(LAS v4u*)(T + (rr + 8 * i) * PR + ch16 * 16) = raw[i]; }
        sync_threads();
#pragma unroll 1
        for (int i2 = 0; i2 < 2; ++i2) {
            const int it = i2 ? 3 - hf : hf;
            unsigned long long zz[4];
#pragma unroll
            for (int r = 0; r < 4; ++r) zz[r] = *(const unsigned long long*)(rb.proj + (row0 + 16 * it + 4 * g + r) * LDP + PC_Z + chn0);
            f32x4 ya[4];
#pragma unroll
            for (int pt = 0; pt < 4; ++pt) ya[pt] = (f32x4){0.f, 0.f, 0.f, 0.f};
#pragma unroll
            for (int kn = 0; kn < 4; ++kn) { const bf16x8 Cf = frag_rows(sC, PR, 16 * it + c, 32 * kn + 8 * g);
#pragma unroll
                for (int pt = 0; pt < 4; ++pt) ya[pt] = mfma16(Cf, frag_rows(hS, PQ, 4 * c + pt, 32 * kn + 8 * g), ya[pt]);
                SCHED_FENCE(); }
            {   float ei[4];
#pragma unroll
                for (int r = 0; r < 4; ++r) ei[r] = __expf(sCum[(16 * it + 4 * g + r) * 4 + k]);
#pragma unroll
                for (int pt = 0; pt < 4; ++pt)
#pragma unroll
                    for (int r = 0; r < 4; ++r) ya[pt][r] *= ei[r]; }
            const float cum_i = sCum[(16 * it + c) * 4 + k];
            unsigned PT[4][2];
#pragma unroll
            for (int jt = 0; jt < 4; ++jt) {
                f32x4 acc = (f32x4){0.f, 0.f, 0.f, 0.f};
                if (jt <= it) {
#pragma unroll
                    for (int kn = 0; kn < 4; ++kn) acc = mfma16(frag_rows(sB, PR, 16 * jt + c, 32 * kn + 8 * g), frag_rows(sC, PR, 16 * it + c, 32 * kn + 8 * g), acc);
#pragma unroll
                    for (int r = 0; r < 4; ++r) { const int j = 16 * jt + 4 * g + r; const float df = cum_i - sCum[j * 4 + k]; const bool keep = (jt < it) || (4 * g + r <= c);
                        acc[r] = keep ? acc[r] * __expf(fminf(df, 0.f)) * sDt[j * 4 + k] : 0.f; }
                }
                PT[jt][0] = pk2(acc[0], acc[1]); PT[jt][1] = pk2(acc[2], acc[3]); SCHED_FENCE();
            }
#pragma unroll
            for (int ks = 0; ks < 2; ++ks) if (2 * ks <= it) {
                v4u pa = (v4u){PT[2 * ks][0], PT[2 * ks][1], PT[2 * ks + 1][0], PT[2 * ks + 1][1]};
                const bf16x8 A = __builtin_bit_cast(bf16x8, pa);
#pragma unroll
                for (int pt = 0; pt < 4; ++pt) ya[pt] = mfma16(A, frag_tr(T, PR, 32 * ks + 4 * g, 32 * ks + 16 + 4 * g, 64 * k + 16 * pt, lane), ya[pt]);
                SCHED_FENCE();
            }
#pragma unroll
            for (int r = 0; r < 4; ++r) { const int i = 16 * it + 4 * g + r; float s = 0.f; float yv[4];
#pragma unroll
                for (int pt = 0; pt < 4; ++pt) { const float xc = bf2f(*(const LAS bf16*)(T + i * PR + (64 * k + 16 * pt + c) * 2)); const float z = bf2f((bf16)(zz[r] >> (16 * pt)));
                    const bf16 yb = f2bf((ya[pt][r] + Dk * xc) * siluf_(z)); yv[pt] = bf2f(yb); s += yv[pt] * yv[pt]; }
                *(unsigned long long*)(rb.y + (row0 + i) * 2048 + chn0) = (unsigned long long)pk2(yv[0], yv[1]) | ((unsigned long long)pk2(yv[2], yv[3]) << 32);
                s += SHFL_XOR(s, 1); s += SHFL_XOR(s, 2); s += SHFL_XOR(s, 4); s += SHFL_XOR(s, 8);
                if (c == 0) red[i * 4 + k] = s; }
            SCHED_FENCE();
        }
        ssd_state_update(H, T, PR, T + 512, PR, sDt, sCum, w, lane);
        sync_threads();
        {   const f32x4 nw = *(const f32x4*)(ssm_norm + chn0);
            unsigned long long yy[8];
            const int itA = hf, itB = 3 - hf;
            bf16* yb0 = rb.y + (row0 + 16 * itA + 4 * g) * 2048 + chn0;
            const int jump = (16 * (itB - itA) - 3) * 2048;
            {   bf16* yp = yb0;
#pragma unroll
                for (int q = 0; q < 8; ++q) { LAUNDER_PTR(yp); yy[q] = *(const unsigned long long*)yp; yp += (q == 3) ? jump : 2048; } }
            bf16* yp = yb0;
#pragma unroll
            for (int q = 0; q < 8; ++q) { const int i = 16 * (q < 4 ? itA : itB) + 4 * g + (q & 3);
                const float rstd = rsqrtf(((red[i * 4] + red[i * 4 + 1]) + (red[i * 4 + 2] + red[i * 4 + 3])) * (1.f / 256.f) + EPS);
                const unsigned lo = (unsigned)yy[q], hi = (unsigned)(yy[q] >> 32);
                const float y0 = __uint_as_float(lo << 16) * rstd * nw[0], y1 = __uint_as_float(lo & 0xffff0000u) * rstd * nw[1], y2 = __uint_as_float(hi << 16) * rstd * nw[2], y3 = __uint_as_float(hi & 0xffff0000u) * rstd * nw[3];
                LAUNDER_PTR(yp); *(unsigned long long*)yp = (unsigned long long)pk2(y0, y1) | ((unsigned long long)pk2(y2, y3) << 32); yp += (q == 3) ? jump : 2048; } }
        sync_threads();
    }
    if (seg == NSEG - 1) { float* so = state_out_l + ((size_t)(b * 32 + head) * 64 + 4 * c) * 128 + 64 * hf + 4 * g;
#pragma unroll
        for (int pt = 0; pt < 4; ++pt)
#pragma unroll
            for (int nt = 0; nt < 4; ++nt) *(f32x4*)(so + pt * 128 + 16 * nt) = H[nt][pt]; }
}

__device__ __forceinline__ float row32_sum(float s) { s += SHFL_XOR(s, 1); s += SHFL_XOR(s, 2); s += SHFL_XOR(s, 4); s += SHFL_XOR(s, 8); s += SHFL_XOR(s, 16); return s; }

__device__ __forceinline__ void hgrn_sample_load(f32x4 (&st)[8], const float* state_in, int bh, int tid) {
    const float* sp = state_in + (size_t)bh * 16384 + tid * 4;
#pragma unroll
    for (int it = 0; it < 8; ++it) { LAUNDER_PTR(sp); st[it] = *(const f32x4*)sp; sp += 2048; }
}
__device__ __forceinline__ void hgrn_sample_step(const bf16* proj, const float* lbs_l, const float* hgn_l, const float* state_in, float* state_out, bf16* ohg, int bh, int tid, LAS unsigned char* lds,
                                                 f32x4 (&st)[8], int bh_next) {
    const int b = bh >> 3, h = bh & 7, lane = tid & 63, w = tid >> 6;
    LAS float* sq = (LAS float*)lds; LAS float* sg = sq + 128; LAS float* sk = sq + 256; LAS float* sv = sq + 384; LAS float* so = (LAS float*)(lds + 8192); LAS float* sred = (LAS float*)(lds + 16384);
    const size_t row = (size_t)MP + b;
    float ogv = 0.f, q_ = 0.f, f_ = 0.f, v_ = 0.f, lb_ = 0.f;
    if (tid < 128) { const bf16* pr = proj + row * LDP + h * 128; q_ = bf2f(pr[PC_Q + tid]); f_ = bf2f(pr[PC_F + tid]); lb_ = lbs_l[h * 128 + tid]; v_ = bf2f(pr[PC_I + hg_vpos(tid)]); ogv = bf2f(pr[PC_OG + tid]); }
    if (tid < 128) { const float fg = lb_ + (1.f - lb_) * sigmoidf_(f_);
        sq[tid] = siluf_(q_) * 0.08838834764831845f; sg[tid] = fg; sk[tid] = 1.f - fg; sv[tid] = v_; }
    sync_threads();
    const int dv4 = tid & 31, rg = tid >> 5;
    const f32x4 vv = *(const LAS f32x4*)(sv + 4 * dv4);
    f32x4 oacc = (f32x4){0.f, 0.f, 0.f, 0.f};
    float* op = state_out + (size_t)bh * 16384 + tid * 4;
    const float* np = state_in + (size_t)(bh_next >= 0 ? bh_next : bh) * 16384 + tid * 4;
#pragma unroll
    for (int it = 0; it < 8; ++it) { const int dk = it * 16 + rg; const f32x4 sn = st[it] * sg[dk] + vv * sk[dk]; LAUNDER_PTR(op); *(f32x4*)op = sn; op += 2048; oacc = oacc + sn * sq[dk];
        LAUNDER_PTR(np); if (bh_next >= 0) st[it] = *(const f32x4*)np; np += 2048; }
    *(LAS f32x4*)(so + rg * 128 + 4 * dv4) = oacc;
    sync_threads();
    if (tid < 128) { float o = 0.f;
#pragma unroll
        for (int r = 0; r < 16; ++r) o += so[r * 128 + tid];
        float ss = o * o; ss = row32_sum(ss);
        if ((lane & 31) == 0) sred[tid >> 5] = ss;
        sq[tid] = o; }
    sync_threads();
    if (tid < 128) { const float rstd = rsqrtf(((sred[0] + sred[1]) + (sred[2] + sred[3])) * (1.f / 128.f) + EPS);
        ohg[row * 1024 + h * 128 + tid] = f2bf(sq[tid] * rstd * hgn_l[tid] * siluf_(ogv)); }
    sync_threads();
    (void)w;
}

__device__ __forceinline__ void ssd_sample_load(f32x4 (&st)[16], const float* state_in, int bg, int tid) {
    const float* sp = state_in + ((size_t)((bg >> 3) * 32 + (bg & 7) * 4)) * 8192 + tid * 4;
#pragma unroll
    for (int it = 0; it < 16; ++it) { LAUNDER_PTR(sp); st[it] = *(const f32x4*)sp; sp += 2048; }
}
__device__ __forceinline__ void ssd_sample_step(const bf16* proj, const float* conv_w, const float* conv_b, const float* dt_bias, const float* a_log, const float* d_skip, const float* ssm_norm,
                                                const float* state_in, const float* conv_in, float* state_out, float* conv_out, bf16* ybuf, int bg, int tid, LAS unsigned char* lds,
                                                f32x4 (&st)[16], int bg_next) {
    const int b = bg >> 3, grp = bg & 7, lane = tid & 63, w = tid >> 6;
    LAS float* sx = (LAS float*)(lds + 2048); LAS float* sB = (LAS float*)(lds + 3072); LAS float* sC = (LAS float*)(lds + 3584); LAS float* sdt = (LAS float*)(lds + 4096); LAS float* sdec = (LAS float*)(lds + 4112);
    LAS float* sy = (LAS float*)(lds + 4608); LAS float* sred = (LAS float*)(lds + 16384);
    const size_t row = (size_t)MP + b;
    {
        const int chx = tid < 256 ? (grp * 256 + tid) : (tid < 384 ? (2048 + grp * 128 + (tid - 256)) : (3072 + grp * 128 + (tid - 384)));
        const float* ci = conv_in + (size_t)b * 3 * 4096; const float r0 = ci[chx], r1 = ci[4096 + chx], r2 = ci[8192 + chx];
        const float cur = bf2f(proj[row * LDP + PC_XBC + chx]);
        const float cw0 = conv_w[chx], cw1 = conv_w[4096 + chx], cw2 = conv_w[8192 + chx], cw3 = conv_w[12288 + chx], cbb = conv_b[chx];
        float dtr = 0.f, dtbv = 0.f, alg = 0.f; if (tid < 4) { const int head = grp * 4 + tid; dtr = bf2f(proj[row * LDP + PC_DT + head]); dtbv = dt_bias[head]; alg = a_log[head]; }
        const float a = cbb + cw0 * r0 + cw1 * r1 + cw2 * r2 + cw3 * cur;
        const float v = siluf_(a);
        if (tid < 256) sx[tid] = v; else if (tid < 384) sB[tid - 256] = v; else sC[tid - 384] = v;
        float* co = conv_out + (size_t)b * 3 * 4096; co[chx] = r1; co[4096 + chx] = r2; co[8192 + chx] = cur;
        if (tid < 4) { const float dv = softplusf_(dtr + dtbv); sdt[tid] = dv; sdec[tid] = __expf(dv * (-__expf(alg))); } }
    sync_threads();
    const int n4 = tid & 31, pr_ = tid >> 5;
    const f32x4 Bv = *(const LAS f32x4*)(sB + 4 * n4), Cv = *(const LAS f32x4*)(sC + 4 * n4);
    float* op = state_out + ((size_t)(b * 32 + grp * 4)) * 8192 + tid * 4;
    const int bgn = bg_next >= 0 ? bg_next : bg; const float* np = state_in + ((size_t)((bgn >> 3) * 32 + (bgn & 7) * 4)) * 8192 + tid * 4;
#pragma unroll
    for (int it = 0; it < 16; ++it) { const int k = it >> 2, p = (it & 3) * 16 + pr_; const float xdt = sx[k * 64 + p] * sdt[k];
        const f32x4 hn = st[it] * sdec[k] + Bv * xdt; LAUNDER_PTR(op); *(f32x4*)op = hn; op += 2048;
        LAUNDER_PTR(np); if (bg_next >= 0) st[it] = *(const f32x4*)np; np += 2048;
        const f32x4 t = hn * Cv; float y = (t[0] + t[1]) + (t[2] + t[3]); y = row32_sum(y);
        if ((lane & 31) == 0) sy[k * 64 + p] = y; }
    sync_threads();
    float yv = 0.f;
    if (tid < 256) { const int k = tid >> 6; const float z = bf2f(proj[row * LDP + PC_Z + grp * 256 + tid]);
        yv = (sy[tid] + d_skip[grp * 4 + k] * sx[tid]) * siluf_(z);
        float ss = yv * yv; ss = row32_sum(ss); if ((lane & 31) == 0) sred[tid >> 5] = ss; }
    sync_threads();
    if (tid < 256) { float tot = 0.f;
#pragma unroll
        for (int r = 0; r < 8; ++r) tot += sred[r];
        ybuf[row * 2048 + grp * 256 + tid] = f2bf(yv * rsqrtf(tot * (1.f / 256.f) + EPS) * ssm_norm[grp * 256 + tid]); }
    sync_threads();
    (void)w;
}

static_assert(SD_END <= LDS_BYTES - 256, "LDS map");
static_assert(8 * 16384 <= LDS_BYTES - 256, "skinny LDS");
constexpr int SK_PART = 128 * 32 * 4;
template <int RT, class Epi>
__device__ __forceinline__ void skinny_gemm(const bf16* A, size_t lda, const bf16* Bt, int K, int N, const Epi& epi, int wg, int wg_first, int wg_count, int tid, LAS unsigned char* lds) {
    const int lane = tid & 63, w = tid >> 6, c = lane & 15, g = lane >> 4;
    constexpr int NRG = 8 / RT;
    const int nunit = (N / 32) * NRG, ksteps = K / 256;
    int me = wg - wg_first; if (me < 0 || me >= wg_count) return;
    for (int s = me; s < nunit; s += wg_count) {
        const int n0 = 32 * (s / NRG), r0 = (s % NRG) * (16 * RT);
        f32x4 acc[RT][2];
#pragma unroll
        for (int rt = 0; rt < RT; ++rt) { acc[rt][0] = (f32x4){0.f, 0.f, 0.f, 0.f}; acc[rt][1] = (f32x4){0.f, 0.f, 0.f, 0.f}; }
        const bf16* ap = A + (size_t)(r0 + c) * lda + (size_t)w * (K / 8) + 8 * g;
        const bf16* bp = Bt + (size_t)(n0 + c) * K + (size_t)w * (K / 8) + 8 * g;
#pragma unroll 4
        for (int ks = 0; ks < ksteps; ++ks) {
            bf16x8 af[RT], bfr[2];
#pragma unroll
            for (int rt = 0; rt < RT; ++rt) af[rt] = *(const bf16x8*)(ap + (size_t)(16 * rt) * lda + 32 * ks);
            bfr[0] = *(const bf16x8*)(bp + 32 * ks); bfr[1] = *(const bf16x8*)(bp + (size_t)16 * K + 32 * ks);
#pragma unroll
            for (int rt = 0; rt < RT; ++rt) { acc[rt][0] = mfma16(af[rt], bfr[0], acc[rt][0]); acc[rt][1] = mfma16(af[rt], bfr[1], acc[rt][1]); }
        }
        LAS float* part = (LAS float*)(lds + w * SK_PART);
#pragma unroll
        for (int rt = 0; rt < RT; ++rt)
#pragma unroll
            for (int nt = 0; nt < 2; ++nt)
#pragma unroll
                for (int r = 0; r < 4; ++r) part[(16 * rt + 4 * g + r) * 32 + 16 * nt + c] = acc[rt][nt][r];
        sync_threads();
        if (RT == 8 || tid < 64 * RT) {
            const int row = tid >> 2, c8 = (tid & 3) * 8;
            f32x4 v0 = (f32x4){0.f, 0.f, 0.f, 0.f}, v1 = (f32x4){0.f, 0.f, 0.f, 0.f};
#pragma unroll
            for (int ww = 0; ww < 8; ++ww) { const LAS float* pp = (const LAS float*)(lds + ww * SK_PART) + row * 32 + c8; v0 = v0 + *(const LAS f32x4*)pp; v1 = v1 + *(const LAS f32x4*)(pp + 4); }
            epi(r0 + row, n0 + c8, v0, v1);
        }
        sync_threads();
    }
}
struct SkStoreBf16 { bf16* O; int ld; int act;
    __device__ __forceinline__ void operator()(int row, int col, f32x4 v0, f32x4 v1) const {
        if (act) {
#pragma unroll
            for (int j = 0; j < 4; ++j) { const float a = fmaxf(v0[j], 0.f), b = fmaxf(v1[j], 0.f); v0[j] = a * a; v1[j] = b * b; } }
        v4u o; o.x = pk2(v0[0], v0[1]); o.y = pk2(v0[2], v0[3]); o.z = pk2(v1[0], v1[1]); o.w = pk2(v1[2], v1[3]);
        *(v4u*)(O + (size_t)row * ld + col) = o; } };
__device__ __forceinline__ void sk_unpack8(const v4u w, f32x4& lo, f32x4& hi) {
    lo = (f32x4){__uint_as_float(w.x << 16), __uint_as_float(w.x & 0xffff0000u), __uint_as_float(w.y << 16), __uint_as_float(w.y & 0xffff0000u)};
    hi = (f32x4){__uint_as_float(w.z << 16), __uint_as_float(w.z & 0xffff0000u), __uint_as_float(w.w << 16), __uint_as_float(w.w & 0xffff0000u)}; }
struct SkGateA { bf16* T; const bf16* G; int ldg; const float* bm;
    __device__ __forceinline__ void operator()(int row, int col, f32x4 v0, f32x4 v1) const {
        f32x4 g0, g1; sk_unpack8(*(const v4u*)(G + (size_t)row * ldg + col), g0, g1);
        const f32x4 b0 = *(const f32x4*)(bm + col), b1 = *(const f32x4*)(bm + col + 4);
#pragma unroll
        for (int j = 0; j < 4; ++j) { v0[j] *= sigmoidf_(g0[j] + b0[j]); v1[j] *= sigmoidf_(g1[j] + b1[j]); }
        v4u o; o.x = pk2(v0[0], v0[1]); o.y = pk2(v0[2], v0[3]); o.z = pk2(v1[0], v1[1]); o.w = pk2(v1[2], v1[3]);
        *(v4u*)(T + (size_t)row * 1024 + col) = o; } };
struct SkGateB { const bf16* T; bf16* U; const bf16* G; int ldg; const float* bm;
    __device__ __forceinline__ void operator()(int row, int col, f32x4 v0, f32x4 v1) const {
        f32x4 g0, g1; sk_unpack8(*(const v4u*)(G + (size_t)row * ldg + col), g0, g1);
        const f32x4 b0 = *(const f32x4*)(bm + col), b1 = *(const f32x4*)(bm + col + 4);
        f32x4 t0, t1; sk_unpack8(*(const v4u*)(T + (size_t)row * 1024 + col), t0, t1);
#pragma unroll
        for (int j = 0; j < 4; ++j) { v0[j] = t0[j] + v0[j] * sigmoidf_(g0[j] + b0[j]); v1[j] = t1[j] + v1[j] * sigmoidf_(g1[j] + b1[j]); }
        v4u o; o.x = pk2(v0[0], v0[1]); o.y = pk2(v0[2], v0[3]); o.z = pk2(v1[0], v1[1]); o.w = pk2(v1[2], v1[3]);
        *(v4u*)(U + (size_t)row * 1024 + col) = o; } };
struct SkRes { bf16* X; const float* gate; int ldgate;
    __device__ __forceinline__ void operator()(int row, int col, f32x4 v0, f32x4 v1) const {
        const float* gp = gate + (size_t)row * ldgate + col; bf16* xp = X + (size_t)row * 1024 + col;
        f32x4 x0, x1; sk_unpack8(*(const v4u*)xp, x0, x1);
        const f32x4 o0 = x0 + *(const f32x4*)gp * v0, o1 = x1 + *(const f32x4*)(gp + 4) * v1;
        v4u o; o.x = pk2(o0[0], o0[1]); o.y = pk2(o0[2], o0[3]); o.z = pk2(o1[0], o1[1]); o.w = pk2(o1[2], o1[3]); *(v4u*)xp = o; } };

template <int TB>
__device__ __forceinline__ void hgrn_seq(const bf16* proj, const float* lbs_l, const float* hgn_l, const float* state_in, float* state_out, bf16* ohg, int row_base, int T, int bh, int tid,
                                         LAS unsigned char* smem) {
    const int b = bh >> 3, h = bh & 7, lane = tid & 63, wv = tid >> 6;
    typedef float (LAS * arr_t)[128];
    arr_t sQ = (arr_t)(smem), sG = (arr_t)(smem + TB * 512), sK = (arr_t)(smem + 2 * TB * 512);
    LAS float* sRed = (LAS float*)(smem + 3 * TB * 512);
    float S[128];
    if (state_in) {
        const float* sp = state_in + (size_t)bh * 16384 + tid;
#pragma unroll
        for (int c = 0; c < 16; ++c) { asm volatile("" : "+v"(sp));
#pragma unroll
            for (int j = 0; j < 8; ++j) S[c * 8 + j] = sp[j * 128];
            sp += 1024; }
    } else {
#pragma unroll
        for (int d = 0; d < 128; ++d) S[d] = 0.f;
    }
    const float lb = lbs_l[h * 128 + tid], hn = hgn_l[tid];
    for (int t0 = 0; t0 < T; t0 += TB) {
        float v[TB], og[TB], o[TB];
#pragma unroll
        for (int tt = 0; tt < TB; ++tt) { v[tt] = 0.f; og[tt] = 0.f;
            if (t0 + tt < T) { const bf16* pr = proj + (size_t)(row_base + b * T + t0 + tt) * LDP + h * 128 + tid;
                const float q = bf2f(pr[PC_Q]), f = bf2f(pr[PC_F]); v[tt] = bf2f(pr[PC_I + hg_vpos(tid) - tid]); og[tt] = bf2f(pr[PC_OG]);
                const float fg = lb + (1.f - lb) * sigmoidf_(f);
                sQ[tt][tid] = siluf_(q) * 0.08838834764831845f; sG[tt][tid] = fg; sK[tt][tid] = 1.f - fg; } }
        __syncthreads();
#pragma unroll
        for (int tt = 0; tt < TB; ++tt) { float acc = 0.f;
            if (t0 + tt < T) { const float vv = v[tt];
#pragma unroll
                for (int d4 = 0; d4 < 32; ++d4) { const f32x4 g = *(const LAS f32x4*)&sG[tt][d4 * 4], k = *(const LAS f32x4*)&sK[tt][d4 * 4], q = *(const LAS f32x4*)&sQ[tt][d4 * 4];
                    S[d4 * 4 + 0] = g.x * S[d4 * 4 + 0] + k.x * vv; acc += q.x * S[d4 * 4 + 0];
                    S[d4 * 4 + 1] = g.y * S[d4 * 4 + 1] + k.y * vv; acc += q.y * S[d4 * 4 + 1];
                    S[d4 * 4 + 2] = g.z * S[d4 * 4 + 2] + k.z * vv; acc += q.z * S[d4 * 4 + 2];
                    S[d4 * 4 + 3] = g.w * S[d4 * 4 + 3] + k.w * vv; acc += q.w * S[d4 * 4 + 3]; } }
            o[tt] = acc;
            const float ss = wave_sum(acc * acc); if (lane == 0) sRed[tt * 2 + wv] = ss; }
        __syncthreads();
#pragma unroll
        for (int tt = 0; tt < TB; ++tt) if (t0 + tt < T) { const float rstd = rsqrtf((sRed[tt * 2] + sRed[tt * 2 + 1]) * (1.f / 128.f) + EPS);
            ohg[(size_t)(row_base + b * T + t0 + tt) * 1024 + h * 128 + tid] = f2bf(o[tt] * rstd * hn * siluf_(og[tt])); }
        __syncthreads();
    }
    { float* sp = state_out + (size_t)bh * 16384 + tid;
#pragma unroll
      for (int c = 0; c < 16; ++c) { asm volatile("" : "+v"(sp));
#pragma unroll
          for (int j = 0; j < 8; ++j) sp[j * 128] = S[c * 8 + j];
          sp += 1024; } }
}

template <int TB>
__device__ __forceinline__ void ssd_seq(const bf16* proj, const float* conv_w, const float* conv_b, const float* dt_bias, const float* a_log, const float* d_skip, const float* ssm_norm,
                                        const float* state_in, const float* conv_in, float* state_out, float* conv_out, bf16* ybuf, int row_base, int T, int bg, int tid, LAS unsigned char* smem) {
    const int b = bg >> 3, g = bg & 7, lane = tid & 63, wv = tid >> 6, head = g * 4 + wv;
    const int ch_x = g * 256 + tid, ch_bc = tid < 128 ? (2048 + g * 128 + tid) : (3072 + g * 128 + (tid - 128));
    typedef float (LAS * arr_t)[128];
    arr_t sB = (arr_t)(smem), sC = (arr_t)(smem + TB * 512);
    LAS float* sRed = (LAS float*)(smem + 2 * TB * 512);
    const float wx0 = conv_w[0 * 4096 + ch_x], wx1 = conv_w[1 * 4096 + ch_x], wx2 = conv_w[2 * 4096 + ch_x], wx3 = conv_w[3 * 4096 + ch_x], bx = conv_b[ch_x];
    const float wb0 = conv_w[0 * 4096 + ch_bc], wb1 = conv_w[1 * 4096 + ch_bc], wb2 = conv_w[2 * 4096 + ch_bc], wb3 = conv_w[3 * 4096 + ch_bc], bb = conv_b[ch_bc];
    float rx0 = 0.f, rx1 = 0.f, rx2 = 0.f, rb0 = 0.f, rb1 = 0.f, rb2 = 0.f;
    if (conv_in) { const float* ci = conv_in + (size_t)b * 3 * 4096; rx0 = ci[ch_x]; rx1 = ci[4096 + ch_x]; rx2 = ci[8192 + ch_x]; rb0 = ci[ch_bc]; rb1 = ci[4096 + ch_bc]; rb2 = ci[8192 + ch_bc]; }
    float hs[128];
    const size_t sbase = (((size_t)b * 32 + head) * 64 + lane) * 128;
    if (state_in) {
#pragma unroll
        for (int n4 = 0; n4 < 32; ++n4) { const f32x4 t = *(const f32x4*)(state_in + sbase + n4 * 4); hs[n4 * 4] = t.x; hs[n4 * 4 + 1] = t.y; hs[n4 * 4 + 2] = t.z; hs[n4 * 4 + 3] = t.w; }
    } else {
#pragma unroll
        for (int n = 0; n < 128; ++n) hs[n] = 0.f;
    }
    const float A = -expf(a_log[head]), dtb = dt_bias[head], Dk = d_skip[head], nw = ssm_norm[ch_x];
    for (int t0 = 0; t0 < T; t0 += TB) {
        float xc[TB], dtv[TB], dec[TB], zz[TB], yv[TB];
#pragma unroll
        for (int tt = 0; tt < TB; ++tt) { xc[tt] = 0.f; dtv[tt] = 0.f; dec[tt] = 1.f; zz[tt] = 0.f;
            if (t0 + tt < T) { const bf16* pr = proj + (size_t)(row_base + b * T + t0 + tt) * LDP;
                const float cx = bf2f(pr[PC_XBC + ch_x]), cb = bf2f(pr[PC_XBC + ch_bc]);
                const float ax = bx + wx0 * rx0 + wx1 * rx1 + wx2 * rx2 + wx3 * cx; rx0 = rx1; rx1 = rx2; rx2 = cx; xc[tt] = siluf_(ax);
                const float ab = bb + wb0 * rb0 + wb1 * rb1 + wb2 * rb2 + wb3 * cb; rb0 = rb1; rb1 = rb2; rb2 = cb;
                const float sbv = siluf_(ab); if (tid < 128) sB[tt][tid] = sbv; else sC[tt][tid - 128] = sbv;
                const float dv = softplusf_(bf2f(pr[PC_DT + head]) + dtb); dtv[tt] = dv; dec[tt] = __expf(dv * A); zz[tt] = bf2f(pr[PC_Z + ch_x]); } }
        __syncthreads();
#pragma unroll
        for (int tt = 0; tt < TB; ++tt) { float y = 0.f;
            if (t0 + tt < T) { const float xdt = xc[tt] * dtv[tt], dc = dec[tt];
#pragma unroll
                for (int n4 = 0; n4 < 32; ++n4) { const f32x4 bv = *(const LAS f32x4*)&sB[tt][n4 * 4], cv = *(const LAS f32x4*)&sC[tt][n4 * 4];
                    hs[n4 * 4 + 0] = dc * hs[n4 * 4 + 0] + xdt * bv.x; y += hs[n4 * 4 + 0] * cv.x;
                    hs[n4 * 4 + 1] = dc * hs[n4 * 4 + 1] + xdt * bv.y; y += hs[n4 * 4 + 1] * cv.y;
                    hs[n4 * 4 + 2] = dc * hs[n4 * 4 + 2] + xdt * bv.z; y += hs[n4 * 4 + 2] * cv.z;
                    hs[n4 * 4 + 3] = dc * hs[n4 * 4 + 3] + xdt * bv.w; y += hs[n4 * 4 + 3] * cv.w; }
                y = (y + Dk * xc[tt]) * siluf_(zz[tt]); }
            yv[tt] = y;
            const float ss = wave_sum(y * y); if (lane == 0) sRed[tt * 4 + wv] = ss; }
        __syncthreads();
#pragma unroll
        for (int tt = 0; tt < TB; ++tt) if (t0 + tt < T) { const float rstd = rsqrtf(((sRed[tt * 4] + sRed[tt * 4 + 1]) + (sRed[tt * 4 + 2] + sRed[tt * 4 + 3])) * (1.f / 256.f) + EPS);
            ybuf[(size_t)(row_base + b * T + t0 + tt) * 2048 + ch_x] = f2bf(yv[tt] * rstd * nw); }
        __syncthreads();
    }
#pragma unroll
    for (int n4 = 0; n4 < 32; ++n4) *(f32x4*)(state_out + sbase + n4 * 4) = (f32x4){hs[n4 * 4], hs[n4 * 4 + 1], hs[n4 * 4 + 2], hs[n4 * 4 + 3]};
    float* co = conv_out + (size_t)b * 3 * 4096;
    co[ch_x] = rx0; co[4096 + ch_x] = rx1; co[8192 + ch_x] = rx2; co[ch_bc] = rb0; co[4096 + ch_bc] = rb1; co[8192 + ch_bc] = rb2;
}

#ifndef REP_G
#define REP_G 1
#endif
#ifndef REP_R2
#define REP_R2 1
#endif
#ifndef REP_R1
#define REP_R1 1
#endif
#ifndef REP_N
#define REP_N 1
#endif
#ifndef REP_P
#define REP_P 1
#endif
#ifndef REP_H2
#define REP_H2 1
#endif
#ifndef REP_S2
#define REP_S2 1
#endif
#ifndef REP_S1
#define REP_S1 1
#endif
#ifndef REP_SS
#define REP_SS 1
#endif
#ifndef REP_BAR
#define REP_BAR 0
#endif
__device__ __forceinline__ void phase_recur1(const P& p, int l, LAS unsigned char* lds, int tid_in, int skip_hgrn1) {
    unsigned char* ws = p.ws; asm volatile("" : "+s"(ws)); int tid_ = tid_in; asm volatile("" : "+v"(tid_)); const int tid = tid_, G = gridDim.x, wg = blockIdx.x;
    RecurBufs rb{(bf16*)(ws + WS_PROJ), (bf16*)(ws + WS_XBCC), (float*)(ws + WS_DTV), (float*)(ws + WS_CUM), (float*)(ws + WS_CV), (float*)(ws + WS_SSEG), (float*)(ws + WS_DSEG),
                 (float*)(ws + WS_HSEG), (float*)(ws + WS_TSEG), (bf16*)(ws + WS_OHG), (bf16*)(ws + WS_Y)};
    const float* lbs_l = (const float*)(ws + WS_LBS) + l * 1024; float* out = p.out;
    const float* hgn = p.in[I_HGN] + l * HG_DV;
    const float* cw = p.in[I_CONVW] + (size_t)l * 4 * SSM_CH; const float* cb = p.in[I_CONVB] + l * SSM_CH; const float* dtb = p.in[I_DTB] + l * SSM_HEADS;
    const float* alog = p.in[I_ALOG] + l * SSM_HEADS; const float* dsk = p.in[I_DSKIP] + l * SSM_HEADS; const float* ssmn = p.in[I_SSMN] + l * SSM_INNER;
#define TID_L() int tl_ = tid; asm volatile("" : "+v"(tl_)); const int t = tl_
#define R1_HG() do { if (!skip_hgrn1) for (int u = wg; u < 256; u += G) { TID_L(); hgrn_pass1(rb, lbs_l, u, t, lds); } } while (0)
#define R1_SD() do { for (int rep = 0; rep < REP_S1; ++rep) for (int u = wg; u < 256; u += G) { TID_L(); ssd_pass1(rb, cw, cb, dtb, alog, out + O_CVP + (size_t)l * NB * 3 * SSM_CH, u, t, lds); } } while (0)
#define R1_SAMPLE() do { for (int rep = 0; rep < REP_SS; ++rep) { \
        {   const float* shg = p.in[I_SHG] + (size_t)l * NSB * HG_H * HG_DK * HG_DV; f32x4 sa[8];        \
            if (wg < NSB * HG_H) { TID_L(); hgrn_sample_load(sa, shg, wg, t); } \
            for (int u = wg; u < NSB * HG_H; u += G) { TID_L(); const int un = u + G < NSB * HG_H ? u + G : -1; \
                hgrn_sample_step(rb.proj, lbs_l, hgn, shg, out + O_HGS + (size_t)l * NSB * HG_H * HG_DK * HG_DV, rb.ohg, u, t, lds, sa, un); } } \
        {   const float* sss = p.in[I_SSSM] + (size_t)l * NSB * SSM_HEADS * SSM_P * SSM_N; f32x4 sa[16]; \
            if (wg < NSB * SSM_G) { TID_L(); ssd_sample_load(sa, sss, wg, t); } \
            for (int u = wg; u < NSB * SSM_G; u += G) { TID_L(); const int un = u + G < NSB * SSM_G ? u + G : -1; \
                ssd_sample_step(rb.proj, cw, cb, dtb, alog, dsk, ssmn, sss, p.in[I_SCONV] + (size_t)l * NSB * 3 * SSM_CH, \
                                out + O_SSMS + (size_t)l * NSB * SSM_HEADS * SSM_P * SSM_N, out + O_CVS + (size_t)l * NSB * 3 * SSM_CH, rb.y, u, t, lds, sa, un); } } } } while (0)
    if (((wg >> 3) & 1) == 0) { R1_HG(); R1_SAMPLE(); R1_SD(); } else { R1_SD(); R1_HG(); R1_SAMPLE(); }
#undef R1_HG
#undef R1_SD
#undef R1_SAMPLE
}
__device__ __forceinline__ void phase_recur2(const P& p, int l, LAS unsigned char* lds, int tid_in) {
    unsigned char* ws = p.ws; asm volatile("" : "+s"(ws)); int tid_ = tid_in; asm volatile("" : "+v"(tid_)); const int tid = tid_, G = gridDim.x, wg = blockIdx.x;
    RecurBufs rb{(bf16*)(ws + WS_PROJ), (bf16*)(ws + WS_XBCC), (float*)(ws + WS_DTV), (float*)(ws + WS_CUM), (float*)(ws + WS_CV), (float*)(ws + WS_SSEG), (float*)(ws + WS_DSEG),
                 (float*)(ws + WS_HSEG), (float*)(ws + WS_TSEG), (bf16*)(ws + WS_OHG), (bf16*)(ws + WS_Y)};
    float* out = p.out;
    for (int rep = 0; rep < REP_H2; ++rep) for (int u = wg; u < 256; u += G) { TID_L(); hgrn_pass2(rb, p.in[I_HGN] + l * HG_DV, out + O_HGP + (size_t)l * NB * HG_H * HG_DK * HG_DV, u, t, lds); }
    for (int rep = 0; rep < REP_S2; ++rep) for (int u = wg; u < 256; u += G) { TID_L(); ssd_pass2(rb, p.in[I_DSKIP] + l * SSM_HEADS, p.in[I_SSMN] + l * SSM_INNER, out + O_SSMP + (size_t)l * NB * SSM_HEADS * SSM_P * SSM_N, u ^ 3, t, lds); }
}


constexpr int CW_BAR = 4096;
constexpr int MISC_OFF = LDS_BYTES - 256;

__global__ __launch_bounds__(NTHREADS, 2) void k_mega(P p) {
    extern __shared__ __attribute__((aligned(16))) unsigned char shm[];
    LAS unsigned char* lds = (LAS unsigned char*)shm;
    const int wave_u = __builtin_amdgcn_readfirstlane((int)threadIdx.x >> 6);
#define TID() ({ int t__; asm volatile("v_mbcnt_lo_u32_b32 %0, -1, 0\n\tv_mbcnt_hi_u32_b32 %0, -1, %0" : "=v"(t__)); (wave_u << 6) | t__; })
    const int G = gridDim.x, NGW = G * NWAVES;
    unsigned char* ws = p.ws;
#define LANE_GW() int t_ = TID(); asm volatile("" : "+v"(t_)); const int ln = t_ & 63, wv = __builtin_amdgcn_readfirstlane(t_ >> 6), gwv = blockIdx.x * NWAVES + wv; (void)wv
    volatile LAS unsigned* MISC = (volatile LAS unsigned*)(lds + MISC_OFF);
    if (TID() < 16) MISC[TID()] = 0u;
    __syncthreads();
    XcdBarrier bar = xcd_barrier_post((unsigned*)(ws + WS_CTL) + CW_BAR, MISC + 8, TID());
#define WSL() ({ unsigned char* w_ = ws; asm volatile("" : "+s"(w_)); w_; })

    for (int rep = 0; rep < REP_P; ++rep) {   LANE_GW(); phase_prologue(p, lds, gwv, NGW, ln, wv); }
    xcd_barrier(bar, TID());
    {   unsigned char* w = WSL();
        pg8::Gemm g{(const bf16*)(w + WS_AC), (const bf16*)(w + WS_WADA), 256, MODLD, D}; pg8::StaticOrder S; S.init(256, MODLD, G, (int)blockIdx.x);
        pg8::EpiF32 E{(float*)(w + WS_MOD), MODLD, p.in[I_BADA]};
        pg8::gemm_phase<pg8::EpiF32, pg8::StaticOrder>(lds, g, S, E, nullptr, TID()); }
    xcd_barrier(bar, TID());
    for (int li = 0; li < DEPTH; ++li) {
        int l = li; asm volatile("" : "+s"(l));
        for (int rep = 0; rep < REP_N; ++rep) {   unsigned char* w = WSL(); const float* mod_l = (const float*)(w + WS_MOD) + (size_t)l * NADA * D;
            LANE_GW();
            if (l == 0) phase_norm<1>(p.in[I_XP], p.in[I_XS], (bf16*)(w + WS_X), (bf16*)(w + WS_H), p.in[I_NMIX] + l * D, mod_l + 0 * D, mod_l + 1 * D, gwv, NGW, ln);
            else phase_norm<0>(nullptr, nullptr, (bf16*)(w + WS_X), (bf16*)(w + WS_H), p.in[I_NMIX] + l * D, mod_l + 0 * D, mod_l + 1 * D, gwv, NGW, ln); }
        xcd_barrier(bar, TID());
        for (int rep = 0; rep < REP_G; ++rep) { if (rep) xcd_barrier(bar, TID());
        {   unsigned char* w = WSL(); const unsigned char* wl = w + WS_W + (size_t)l * W_LSTRIDE;
            pg8::Gemm g{(const bf16*)(w + WS_H), (const bf16*)(wl + WO_IN), MP, LDP, D}; pg8::StaticOrder S; S.init(MP, LDP, G, (int)blockIdx.x);
            pg8::EpiBf16<0> E{(bf16*)(w + WS_PROJ), LDP};
            pg8::gemm_phase<pg8::EpiBf16<0>, pg8::StaticOrder>(lds, g, S, E, nullptr, TID());
            const int skf = G > 64 ? 64 : 0, skn = G > 64 ? G - 64 : G; skinny_gemm<8>((const bf16*)(w + WS_H) + (size_t)MP * D, D, (const bf16*)(wl + WO_IN), D, LDP, SkStoreBf16{(bf16*)(w + WS_PROJ) + (size_t)MP * LDP, LDP, 0}, (int)blockIdx.x, skf, skn, TID(), lds); } }
        xcd_barrier(bar, TID());
        for (int rep = 0; rep < REP_BAR; ++rep) xcd_barrier(bar, TID());
        phase_recur1(p, l, lds, TID(), 0);
        for (int rep = 1; rep < REP_R1; ++rep) { xcd_barrier(bar, TID()); phase_recur1(p, l, lds, TID(), 1); }
        xcd_barrier(bar, TID());
        for (int rep = 0; rep < REP_R2; ++rep) { if (rep) xcd_barrier(bar, TID()); phase_recur2(p, l, lds, TID()); }
        xcd_barrier(bar, TID());
        for (int rep = 0; rep < REP_G; ++rep) { if (rep) xcd_barrier(bar, TID());
        {   unsigned char* w = WSL(); const unsigned char* wl = w + WS_W + (size_t)l * W_LSTRIDE;
            pg8::Gemm g{(const bf16*)(w + WS_OHG), (const bf16*)(wl + WO_BRA), MP, D, 1024}; pg8::StaticOrder S; S.init(MP, D, G, (int)blockIdx.x);
            pg8::EpiGateA E{(bf16*)(w + WS_T), (const bf16*)(w + WS_PROJ) + PC_GA, LDP, p.in[I_BMERGE] + l * 2048};
            pg8::gemm_phase<pg8::EpiGateA, pg8::StaticOrder>(lds, g, S, E, nullptr, TID());
            skinny_gemm<1>((const bf16*)(w + WS_OHG) + (size_t)MP * D, D, (const bf16*)(wl + WO_BRA), 1024, D, SkGateA{(bf16*)(w + WS_T) + (size_t)MP * D, (const bf16*)(w + WS_PROJ) + (size_t)MP * LDP + PC_GA, LDP, p.in[I_BMERGE] + l * 2048}, (int)blockIdx.x, 0, G, TID(), lds); } }
        asm volatile("s_waitcnt vmcnt(0)" ::: "memory"); __syncthreads();
        for (int rep = 0; rep < REP_G; ++rep) { if (rep) xcd_barrier(bar, TID());
        {   unsigned char* w = WSL(); const unsigned char* wl = w + WS_W + (size_t)l * W_LSTRIDE;
            pg8::Gemm g{(const bf16*)(w + WS_Y), (const bf16*)(wl + WO_BRB), MP, D, 2048}; pg8::StaticOrder S; S.init(MP, D, G, (int)blockIdx.x);
            pg8::EpiGateB E{(const bf16*)(w + WS_T), (bf16*)(w + WS_U), (const bf16*)(w + WS_PROJ) + PC_GB, LDP, p.in[I_BMERGE] + l * 2048 + 1024};
            pg8::gemm_phase<pg8::EpiGateB, pg8::StaticOrder>(lds, g, S, E, nullptr, TID());
            skinny_gemm<1>((const bf16*)(w + WS_Y) + (size_t)MP * 2048, 2048, (const bf16*)(wl + WO_BRB), 2048, D, SkGateB{(const bf16*)(w + WS_T) + (size_t)MP * D, (bf16*)(w + WS_U) + (size_t)MP * D, (const bf16*)(w + WS_PROJ) + (size_t)MP * LDP + PC_GB, LDP, p.in[I_BMERGE] + l * 2048 + 1024}, (int)blockIdx.x, 0, G, TID(), lds); } }
        xcd_barrier(bar, TID());
        {   unsigned char* w = WSL(); const unsigned char* wl = w + WS_W + (size_t)l * W_LSTRIDE; const float* mod_l = (const float*)(w + WS_MOD) + (size_t)l * NADA * D;
            pg8::Gemm g{(const bf16*)(w + WS_U), (const bf16*)(wl + WO_OUT), MP, D, 1024}; pg8::StaticOrder S; S.init(MP, D, G, (int)blockIdx.x);
            pg8::EpiRes E{(bf16*)(w + WS_X), mod_l + 2 * D, MODLD};
            pg8::gemm_phase<pg8::EpiRes, pg8::StaticOrder>(lds, g, S, E, nullptr, TID());
            skinny_gemm<1>((const bf16*)(w + WS_U) + (size_t)MP * D, D, (const bf16*)(wl + WO_OUT), 1024, D, SkRes{(bf16*)(w + WS_X) + (size_t)MP * D, mod_l + (size_t)NB * MODLD + 2 * D, MODLD}, (int)blockIdx.x, 0, G, TID(), lds); }
        xcd_barrier(bar, TID());
        for (int rep = 0; rep < REP_N; ++rep) {   unsigned char* w = WSL(); const float* mod_l = (const float*)(w + WS_MOD) + (size_t)l * NADA * D;
            LANE_GW(); phase_norm<0>(nullptr, nullptr, (bf16*)(w + WS_X), (bf16*)(w + WS_H), p.in[I_NMLP] + l * D, mod_l + 3 * D, mod_l + 4 * D, gwv, NGW, ln); }
        xcd_barrier(bar, TID());
        for (int rep = 0; rep < REP_G; ++rep) { if (rep) xcd_barrier(bar, TID());
        {   unsigned char* w = WSL(); const unsigned char* wl = w + WS_W + (size_t)l * W_LSTRIDE;
            pg8::Gemm g{(const bf16*)(w + WS_H), (const bf16*)(wl + WO_UP), MP, DFF, 1024}; pg8::StaticOrder S; S.init(MP, DFF, G, (int)blockIdx.x);
            pg8::EpiBf16<1> E{(bf16*)(w + WS_UP), DFF};
            pg8::gemm_phase<pg8::EpiBf16<1>, pg8::StaticOrder>(lds, g, S, E, nullptr, TID());
            skinny_gemm<4>((const bf16*)(w + WS_H) + (size_t)MP * D, D, (const bf16*)(wl + WO_UP), 1024, DFF, SkStoreBf16{(bf16*)(w + WS_UP) + (size_t)MP * DFF, DFF, 1}, (int)blockIdx.x, 0, G, TID(), lds); } }
        xcd_barrier(bar, TID());
        {   unsigned char* w = WSL(); const unsigned char* wl = w + WS_W + (size_t)l * W_LSTRIDE; const float* mod_l = (const float*)(w + WS_MOD) + (size_t)l * NADA * D;
            pg8::Gemm g{(const bf16*)(w + WS_UP), (const bf16*)(wl + WO_DOWN), MP, D, DFF}; pg8::StaticOrder S; S.init(MP, D, G, (int)blockIdx.x);
            pg8::EpiRes E{(bf16*)(w + WS_X), mod_l + 5 * D, MODLD};
            pg8::gemm_phase<pg8::EpiRes, pg8::StaticOrder>(lds, g, S, E, nullptr, TID());
            skinny_gemm<1>((const bf16*)(w + WS_UP) + (size_t)MP * DFF, DFF, (const bf16*)(wl + WO_DOWN), DFF, D, SkRes{(bf16*)(w + WS_X) + (size_t)MP * D, mod_l + (size_t)NB * MODLD + 5 * D, MODLD}, (int)blockIdx.x, 0, G, TID(), lds); }
        xcd_barrier(bar, TID());
    }
    {   unsigned char* w = WSL(); LANE_GW(); phase_final((const bf16*)(w + WS_X), p.out + O_YP, p.in[I_NFIN], gwv, NGW, ln); }
}

extern "C" void kernel_launch(void* const* d_in, const int* in_sizes, int n_in, void* d_out, int out_size, void* d_ws, size_t ws_size, hipStream_t stream) {
    static int grid = 0;
    if (grid == 0) {
        if (n_in != N_IN || (size_t)out_size != O_END || ws_size < WS_END) { fprintf(stderr, "kernel_launch: unexpected sizes n_in %d out %d ws %zu\n", n_in, out_size, ws_size); grid = -1; return; }
        int dev = 0, cus = 0, per_cu = 0;
        if (hipGetDevice(&dev) != hipSuccess || hipDeviceGetAttribute(&cus, hipDeviceAttributeMultiprocessorCount, dev) != hipSuccess) { grid = -1; return; }
        if (hipFuncSetAttribute((const void*)k_mega, hipFuncAttributeMaxDynamicSharedMemorySize, LDS_BYTES) != hipSuccess) { fprintf(stderr, "kernel_launch: hipFuncSetAttribute failed\n"); grid = -1; return; }
        if (hipOccupancyMaxActiveBlocksPerMultiprocessor(&per_cu, (const void*)k_mega, NTHREADS, LDS_BYTES) != hipSuccess || per_cu < 1)
            fprintf(stderr, "kernel_launch: note: occupancy query reports %d workgroups per CU\n", per_cu);
        (void)hipGetLastError();
        grid = cus;
    }
    if (grid < 0) return;
    if (hipMemsetAsync((char*)d_ws + WS_CTL, 0, CTL_ZERO_BYTES, stream) != hipSuccess) return;
    P p{};
    for (int i = 0; i < N_IN; ++i) p.in[i] = (const float*)d_in[i];
    p.out = (float*)d_out; p.ws = (unsigned char*)d_ws;
    hipLaunchKernelGGL(k_mega, dim3(grid), dim3(NTHREADS), LDS_BYTES, stream, p);
}
```

```cpp
#include <hip/hip_runtime.h>
#include <cstdio>
#include <cstdint>

constexpr int D = 1024, NB = 8, SEQ = 2048, DEPTH = 4, NSB = 128;
constexpr int MP = NB * SEQ;
constexpr int MS = NSB;
constexpr int MR = MP + MS;
constexpr int MT = 16640;
constexpr int HG_H = 8, HG_DK = 128, HG_DV = 128;
constexpr int SSM_INNER = 2048, SSM_P = 64, SSM_HEADS = 32, SSM_G = 8, SSM_HPG = 4, SSM_N = 128, SSM_CH = 4096;
constexpr int DFF = 4096, NADA = 6;
constexpr int IN_WIDTH = 12320;
constexpr int LDP = 12544;
constexpr int PC_Q = 0, PC_F = 1024, PC_I = 2048, PC_OG = 3072, PC_Z = 4096, PC_XBC = 6144, PC_GA = 10240, PC_GB = 11264, PC_DT = 12288;
constexpr int NCOND = NB + NSB;
constexpr int MODLD = DEPTH * NADA * D;
constexpr float EPS = 1e-6f;

enum { I_XP = 0, I_XS, I_SHG, I_SSSM, I_SCONV, I_CP, I_CS, I_WADA, I_BADA, I_NMIX, I_WIN, I_BMERGE, I_LB, I_HGN, I_CONVW, I_CONVB, I_DTB, I_ALOG, I_DSKIP,
       I_SSMN, I_WBRA, I_WBRB, I_WOUT, I_NMLP, I_WUP, I_WDOWN, I_NFIN, N_IN };

constexpr size_t O_YP = 0;
constexpr size_t O_YS = O_YP + (size_t)MP * D;
constexpr size_t O_HGP = O_YS + (size_t)MS * D;
constexpr size_t O_SSMP = O_HGP + (size_t)DEPTH * NB * HG_H * HG_DK * HG_DV;
constexpr size_t O_CVP = O_SSMP + (size_t)DEPTH * NB * SSM_HEADS * SSM_P * SSM_N;
constexpr size_t O_HGS = O_CVP + (size_t)DEPTH * NB * 3 * SSM_CH;
constexpr size_t O_SSMS = O_HGS + (size_t)DEPTH * NSB * HG_H * HG_DK * HG_DV;
constexpr size_t O_CVS = O_SSMS + (size_t)DEPTH * NSB * SSM_HEADS * SSM_P * SSM_N;
constexpr size_t O_END = O_CVS + (size_t)DEPTH * NSB * 3 * SSM_CH;

constexpr size_t MiB = 1u << 20;
constexpr size_t WS_CTL = 0, CTL_ZERO_BYTES = 1 * MiB;
constexpr size_t WS_LBS = 1 * MiB;
constexpr size_t WS_AC = 2 * MiB;
constexpr size_t WS_MOD = 3 * MiB;
constexpr size_t WS_WADA = 32 * MiB;
constexpr size_t WS_W = 80 * MiB, W_LSTRIDE = 49 * MiB;
constexpr size_t WO_IN = 0, WO_BRA = 24 * MiB + MiB / 2, WO_BRB = WO_BRA + 2 * MiB, WO_OUT = WO_BRB + 4 * MiB, WO_UP = WO_OUT + 2 * MiB, WO_DOWN = WO_UP + 8 * MiB;
constexpr size_t WS_X = 276 * MiB;
constexpr size_t WS_H = 341 * MiB;
constexpr size_t WS_PROJ = 374 * MiB;
constexpr size_t WS_OHG = 773 * MiB;
constexpr size_t WS_Y = 806 * MiB;
constexpr size_t WS_T = 871 * MiB;
constexpr size_t WS_U = 936 * MiB;
constexpr size_t WS_UP = 969 * MiB;
constexpr size_t WS_XBCC = 1100 * MiB;
constexpr size_t WS_DTV = 1230 * MiB, WS_CUM = 1232 * MiB;
constexpr size_t WS_CV = 1234 * MiB;
constexpr size_t WS_SSEG = 1238 * MiB;
constexpr size_t WS_DSEG = 1254 * MiB;
constexpr size_t WS_HSEG = 1255 * MiB;
constexpr size_t WS_TSEG = 1287 * MiB;
constexpr size_t WS_END = 1288 * MiB;
static_assert(WO_DOWN + 8 * MiB <= W_LSTRIDE && (size_t)LDP * D * 2 <= WO_BRA, "weight map");
static_assert(WS_W + 4 * W_LSTRIDE <= WS_X && WS_X + (size_t)MT * D * 4 <= WS_H && WS_H + (size_t)MT * D * 2 <= WS_PROJ && WS_PROJ + (size_t)MT * LDP * 2 <= WS_OHG, "ws map 1");
static_assert(WS_OHG + (size_t)MT * D * 2 <= WS_Y && WS_Y + (size_t)MT * 2048 * 2 <= WS_T && WS_T + (size_t)MT * D * 4 <= WS_U && WS_U + (size_t)MT * D * 2 <= WS_UP && WS_UP + (size_t)MT * DFF * 2 <= WS_XBCC && WS_XBCC + (size_t)MT * 4096 * 2 <= WS_DTV, "ws map 2");
static_assert(WS_MOD + (size_t)256 * MODLD * 4 <= WS_WADA && WS_WADA + (size_t)MODLD * D * 2 <= WS_W, "ws map 0");

typedef unsigned short bf16;
__device__ __forceinline__ float bf2f(bf16 v) { return __uint_as_float(((unsigned)v) << 16); }
__device__ __forceinline__ unsigned pk2(float lo, float hi) { unsigned r; asm("v_cvt_pk_bf16_f32 %0, %1, %2" : "=v"(r) : "v"(lo), "v"(hi)); return r; }
__device__ __forceinline__ bf16 f2bf(float f) { return (bf16)pk2(f, f); }
__device__ __forceinline__ float frcp_(float x) { return __builtin_amdgcn_rcpf(x); }
__device__ __forceinline__ float sigmoidf_(float x) { return frcp_(1.0f + __expf(-x)); }
__device__ __forceinline__ float siluf_(float x) { return x * frcp_(1.0f + __expf(-x)); }
__device__ __forceinline__ float softplusf_(float x) { return x > 20.f ? x : log1pf(__expf(x)); }
__host__ __device__ __forceinline__ int cidx_of_row(int row) { return row < MP ? (row >> 11) : ((row - MP + NB) < NCOND ? (row - MP + NB) : (NCOND - 1)); }
__host__ __device__ __forceinline__ int hg_vpos(int e) { return (e & 64) + 16 * (e & 3) + ((e & 63) >> 2); }

namespace pg8 {
#define PG8_LAS __attribute__((address_space(3)))
typedef unsigned short bf16_t;
typedef short bf16x8 __attribute__((ext_vector_type(8)));
typedef float f32x4 __attribute__((ext_vector_type(4)));
typedef unsigned u32x4 __attribute__((ext_vector_type(4)));
constexpr int BM = 256, BK = 64, HALF = 128, HTB = HALF * BK * 2  , STAGE_BYTES = 8 * HTB, NXCD = 8, WGM = 4;

__host__ __device__ __forceinline__ int lds_byte(int r, int c) { const int st = (r >> 4) * 2 + (c >> 5), rr = r & 15, cc = c & 31, ob = rr * 64 + cc * 2; return st * 1024 + (ob ^ (((ob >> 9) & 1) << 5)); }
__host__ __device__ __forceinline__ void stage_rc(int b, int& R, int& C) { const int st = b / 1024, sb = b % 1024, swz = sb ^ (((sb >> 9) & 1) << 5); R = (st >> 1) * 16 + swz / 64; C = (st & 1) * 32 + (swz % 64) / 2; }
__host__ __device__ __forceinline__ int perm32(int rho) { const int n = rho >> 4, i = rho & 15; return 8 * (i >> 2) + 4 * n + (i & 3); }

struct Unit { int pm, pn; };
struct Gemm { const bf16_t* A; const bf16_t* Bt; int M, N, K; };

struct StaticOrder {
    int nM, nN, nwg, G, c;
    __host__ __device__ void init(int M, int N, int G_, int c_) { nM = M / BM; nN = N / BM; nwg = nM * nN; G = G_; c = c_; }
    __host__ __device__ bool next(int i, Unit& u) const {
        const long L = (long)i * G + c; if (L >= nwg) return false;
        int wgid = (int)L; { const int q = nwg / NXCD, r = nwg % NXCD, xcd = wgid % NXCD, off = wgid / NXCD; wgid = (xcd < r ? xcd * (q + 1) : r * (q + 1) + (xcd - r) * q) + off; }
        const int nig = WGM * nN, gid = wgid / nig, fm = gid * WGM, gsz = (nM - fm) < WGM ? (nM - fm) : WGM;
        u.pm = fm + ((wgid % nig) % gsz); u.pn = (wgid % nig) / gsz; return true;
    }
    __device__ __forceinline__ void a_ready(const Unit&) const {}
    __device__ __forceinline__ void done(const Unit&) const {}
};
__device__ __forceinline__ unsigned cvt_pk_bf16(float lo, float hi) { unsigned r; asm volatile("v_cvt_pk_bf16_f32 %0, %1, %2" : "=v"(r) : "v"(lo), "v"(hi)); return r; }
__device__ __forceinline__ float ep_sigmoid(float x) { return __builtin_amdgcn_rcpf(1.0f + __expf(-x)); }
__device__ __forceinline__ void unpack8(const u32x4 w, f32x4& lo, f32x4& hi) {
    lo = (f32x4){__uint_as_float(w.x << 16), __uint_as_float(w.x & 0xffff0000u), __uint_as_float(w.y << 16), __uint_as_float(w.y & 0xffff0000u)};
    hi = (f32x4){__uint_as_float(w.z << 16), __uint_as_float(w.z & 0xffff0000u), __uint_as_float(w.w << 16), __uint_as_float(w.w & 0xffff0000u)};
}

struct EpiF32 {
    static constexpr bool PERM = false, AFTER_DRAIN = false;
    float* C; int ldc; const float* bias;
    __device__ __forceinline__ void operator()(const f32x4 (&acc)[2][2][4][2], const Unit& u, int wr, int wc, int fr, int fq) const {
        const int row0 = u.pm * BM + wr * 64 + fr, col0 = u.pn * BM + wc * 32 + 4 * fq;
        f32x4 bv[2][2];
#pragma unroll
        for (int bj = 0; bj < 2; ++bj)
#pragma unroll
            for (int n = 0; n < 2; ++n) bv[bj][n] = *(const f32x4*)(bias + col0 + bj * HALF + n * 16);
#pragma unroll
        for (int ai = 0; ai < 2; ++ai)
#pragma unroll
            for (int m = 0; m < 4; ++m) { float* rowp = C + (size_t)(row0 + ai * HALF + m * 16) * ldc + col0;
#pragma unroll
                for (int bj = 0; bj < 2; ++bj)
#pragma unroll
                    for (int n = 0; n < 2; ++n) *(f32x4*)(rowp + bj * HALF + n * 16) = acc[ai][bj][m][n] + bv[bj][n]; }
    }
};
template <int ACT  > struct EpiBf16 {
    static constexpr bool PERM = true, AFTER_DRAIN = false;
    bf16_t* O; int ldc;
    __device__ __forceinline__ void operator()(const f32x4 (&acc)[2][2][4][2], const Unit& u, int wr, int wc, int fr, int fq) const {
        const int lane = fr + 16 * fq, r2 = lane >> 2, q2 = lane & 3;
        const int src4 = (r2 + 16 * q2) << 2;
        const int row0 = u.pm * BM + wr * 64 + r2; const int col0 = u.pn * BM + wc * 32 + 8 * q2;
#pragma unroll
        for (int ai = 0; ai < 2; ++ai)
#pragma unroll
            for (int m = 0; m < 4; ++m) { bf16_t* rowp = O + (size_t)(row0 + ai * HALF + m * 16) * ldc + col0;
#pragma unroll
                for (int bj = 0; bj < 2; ++bj) { f32x4 v0 = acc[ai][bj][m][0], v1 = acc[ai][bj][m][1];
                    if (ACT == 1) {
#pragma unroll
                        for (int j = 0; j < 4; ++j) { const float a = fmaxf(v0[j], 0.f), b = fmaxf(v1[j], 0.f); v0[j] = a * a; v1[j] = b * b; } }
                    u32x4 w; w.x = cvt_pk_bf16(v0[0], v0[1]); w.y = cvt_pk_bf16(v0[2], v0[3]); w.z = cvt_pk_bf16(v1[0], v1[1]); w.w = cvt_pk_bf16(v1[2], v1[3]);
                    w.x = (unsigned)__builtin_amdgcn_ds_bpermute(src4, (int)w.x); w.y = (unsigned)__builtin_amdgcn_ds_bpermute(src4, (int)w.y);
                    w.z = (unsigned)__builtin_amdgcn_ds_bpermute(src4, (int)w.z); w.w = (unsigned)__builtin_amdgcn_ds_bpermute(src4, (int)w.w);
                    *(u32x4*)(rowp + bj * HALF) = w; } }
    }
};
struct EpiGateA {
    static constexpr bool PERM = true, AFTER_DRAIN = false;
    bf16_t* T; const bf16_t* G; int ldg; const float* bm;
    __device__ __forceinline__ void operator()(const f32x4 (&acc)[2][2][4][2], const Unit& u, int wr, int wc, int fr, int fq) const {
        const int row0 = u.pm * BM + wr * 64 + fr; const int col0 = u.pn * BM + wc * 32 + 8 * fq;
        f32x4 bv[2][2];
#pragma unroll
        for (int bj = 0; bj < 2; ++bj)
#pragma unroll
            for (int n = 0; n < 2; ++n) bv[bj][n] = *(const f32x4*)(bm + col0 + bj * HALF + 4 * n);
#pragma unroll
        for (int ai = 0; ai < 2; ++ai)
#pragma unroll
            for (int m = 0; m < 4; ++m) { const size_t row = (size_t)(row0 + ai * HALF + m * 16);
#pragma unroll
                for (int bj = 0; bj < 2; ++bj) {
                    const u32x4 gw = *(const u32x4*)(G + row * ldg + col0 + bj * HALF); f32x4 g0, g1; unpack8(gw, g0, g1);
                    f32x4 o0, o1;
#pragma unroll
                    for (int j = 0; j < 4; ++j) { o0[j] = ep_sigmoid(g0[j] + bv[bj][0][j]) * acc[ai][bj][m][0][j]; o1[j] = ep_sigmoid(g1[j] + bv[bj][1][j]) * acc[ai][bj][m][1][j]; }
                    u32x4 w; w.x = cvt_pk_bf16(o0[0], o0[1]); w.y = cvt_pk_bf16(o0[2], o0[3]); w.z = cvt_pk_bf16(o1[0], o1[1]); w.w = cvt_pk_bf16(o1[2], o1[3]);
                    *(u32x4*)(T + row * 1024 + col0 + bj * HALF) = w; } }
    }
};
struct EpiGateB {
    static constexpr bool PERM = true, AFTER_DRAIN = false;
    const bf16_t* T; bf16_t* U; const bf16_t* G; int ldg; const float* bm;
    __device__ __forceinline__ void operator()(const f32x4 (&acc)[2][2][4][2], const Unit& u, int wr, int wc, int fr, int fq) const {
        const int row0 = u.pm * BM + wr * 64 + fr; const int col0 = u.pn * BM + wc * 32 + 8 * fq;
        f32x4 bv[2][2];
#pragma unroll
        for (int bj = 0; bj < 2; ++bj)
#pragma unroll
            for (int n = 0; n < 2; ++n) bv[bj][n] = *(const f32x4*)(bm + col0 + bj * HALF + 4 * n);
#pragma unroll
        for (int ai = 0; ai < 2; ++ai)
#pragma unroll
            for (int m = 0; m < 4; ++m) { const size_t row = (size_t)(row0 + ai * HALF + m * 16);
#pragma unroll
                for (int bj = 0; bj < 2; ++bj) {
                    const u32x4 gw = *(const u32x4*)(G + row * ldg + col0 + bj * HALF); f32x4 g0, g1; unpack8(gw, g0, g1);
                    f32x4 t0, t1; unpack8(*(const u32x4*)(T + row * 1024 + col0 + bj * HALF), t0, t1);
                    f32x4 o0, o1;
#pragma unroll
                    for (int j = 0; j < 4; ++j) { o0[j] = t0[j] + ep_sigmoid(g0[j] + bv[bj][0][j]) * acc[ai][bj][m][0][j]; o1[j] = t1[j] + ep_sigmoid(g1[j] + bv[bj][1][j]) * acc[ai][bj][m][1][j]; }
                    u32x4 w; w.x = cvt_pk_bf16(o0[0], o0[1]); w.y = cvt_pk_bf16(o0[2], o0[3]); w.z = cvt_pk_bf16(o1[0], o1[1]); w.w = cvt_pk_bf16(o1[2], o1[3]);
                    *(u32x4*)(U + row * 1024 + col0 + bj * HALF) = w; } }
    }
};
struct EpiRes {
    static constexpr bool PERM = true, AFTER_DRAIN = false;
    bf16_t* X; const float* gate; int ldgate;
    __device__ __forceinline__ void operator()(const f32x4 (&acc)[2][2][4][2], const Unit& u, int wr, int wc, int fr, int fq) const {
        const int row0 = u.pm * BM + wr * 64 + fr, col0 = u.pn * BM + wc * 32 + 8 * fq;
        const float* gp = gate + (size_t)((u.pm * BM) >> 11) * ldgate + col0;
        f32x4 gv[2][2];
#pragma unroll
        for (int bj = 0; bj < 2; ++bj)
#pragma unroll
            for (int n = 0; n < 2; ++n) gv[bj][n] = *(const f32x4*)(gp + bj * HALF + 4 * n);
#pragma unroll
        for (int ai = 0; ai < 2; ++ai)
#pragma unroll
            for (int m = 0; m < 4; ++m) { bf16_t* xp = X + (size_t)(row0 + ai * HALF + m * 16) * 1024 + col0;
#pragma unroll
                for (int bj = 0; bj < 2; ++bj) { const u32x4 xw = *(const u32x4*)(xp + bj * HALF); f32x4 x0, x1; unpack8(xw, x0, x1);
                    const f32x4 o0 = x0 + gv[bj][0] * acc[ai][bj][m][0], o1 = x1 + gv[bj][1] * acc[ai][bj][m][1];
                    u32x4 ow; ow.x = cvt_pk_bf16(o0[0], o0[1]); ow.y = cvt_pk_bf16(o0[2], o0[3]); ow.z = cvt_pk_bf16(o1[0], o1[1]); ow.w = cvt_pk_bf16(o1[2], o1[3]);
                    *(u32x4*)(xp + bj * HALF) = ow; } }
    }
};


#ifndef GEMM_ALIGN
#define GEMM_ALIGN true
#endif
#ifndef GEMM_SP2
#define GEMM_SP2 true
#endif
template <class Epi, class Sched, bool ALIGN_EPI = GEMM_ALIGN, bool SP2 = GEMM_SP2>
__device__ __forceinline__ void gemm_phase(PG8_LAS unsigned char* lds, const Gemm g, const Sched& S, const Epi& E, unsigned long long*  , int tid_in) {
    int tid_ = tid_in; asm volatile("" : "+v"(tid_));
    const int tid = tid_, wid = __builtin_amdgcn_readfirstlane(tid >> 6), lane = tid & 63, wr = wid >> 2, wc = wid & 3, fr = lane & 15, fq = lane >> 4;
    const int K = g.K, nt = K / BK;
    unsigned voffA[2], voffB[2];
#pragma unroll
    for (int i = 0; i < 2; ++i) { int R, C; stage_rc(tid * 16 + i * 8192, R, C); const int Rb = Epi::PERM ? ((R & ~31) + perm32(R & 31)) : R;
        voffA[i] = (unsigned)(R * K + C) * 2u; voffB[i] = (unsigned)(Rb * K + C) * 2u; }
    const size_t kstep = (size_t)(BK * 2);
    const size_t hstep = (size_t)HALF * K * 2;
    const size_t tstep = 2 * hstep;
    const unsigned ldsw = (unsigned)wid * 1024u;
    const int aoff = lds_byte(wr * 64 + fr, fq * 8), boff = lds_byte(wc * 32 + fr, fq * 8);
#define PG8_SA(b, h) (((b) * 2 + (h)) * HTB)
#define PG8_SB(b, h) ((4 + (b) * 2 + (h)) * HTB)
#define PG8_STAGE(bufoff, gbase, voff) do { _Pragma("unroll") for (int _i = 0; _i < 2; ++_i) \
        __builtin_amdgcn_global_load_lds((const unsigned*)((const char*)(gbase) + (voff)[_i]), (PG8_LAS unsigned*)(lds + (bufoff) + ldsw + _i * 8192), 16, 0, 0); } while (0)
#define PG8_LDA(dst, b, h) do { _Pragma("unroll") for (int m = 0; m < 4; ++m) _Pragma("unroll") for (int k = 0; k < 2; ++k) dst[m][k] = *(const PG8_LAS bf16x8*)(lds + PG8_SA(b, h) + aoff + m * 2048 + k * 1024); } while (0)
#define PG8_LDB(dst, b, h) do { _Pragma("unroll") for (int n = 0; n < 2; ++n) _Pragma("unroll") for (int k = 0; k < 2; ++k) dst[n][k] = *(const PG8_LAS bf16x8*)(lds + PG8_SB(b, h) + boff + n * 2048 + k * 1024); } while (0)
#define PG8_MMA(ai, bj, At, Bt) do { __builtin_amdgcn_s_setprio(1); _Pragma("unroll") for (int m = 0; m < 4; ++m) _Pragma("unroll") for (int n = 0; n < 2; ++n) _Pragma("unroll") for (int k = 0; k < 2; ++k) \
        acc[ai][bj][m][n] = __builtin_amdgcn_mfma_f32_16x16x32_bf16(Bt[n][k], At[m][k], acc[ai][bj][m][n], 0, 0, 0); __builtin_amdgcn_s_setprio(0); } while (0)
#define PG8_WAIT_V(n) asm volatile("s_waitcnt vmcnt(" #n ")" ::: "memory")
#define PG8_WAIT_L(n) asm volatile("s_waitcnt lgkmcnt(" #n ")" ::: "memory")
#define PG8_BAR __builtin_amdgcn_s_barrier()
#define PG8_SCHED __builtin_amdgcn_sched_barrier(0)
    Unit cur, nxt; int ui = 0;
    if (!S.next(0, cur)) return;
    f32x4 acc[2][2][4][2];
#pragma unroll
    for (int a = 0; a < 2; ++a)
#pragma unroll
        for (int b = 0; b < 2; ++b)
#pragma unroll
            for (int m = 0; m < 4; ++m)
#pragma unroll
                for (int n = 0; n < 2; ++n) acc[a][b][m][n] = (f32x4){0.f, 0.f, 0.f, 0.f};
    bf16x8 At[4][2], B0[2][2], B1[2][2];
    const char* cA = (const char*)g.A + (size_t)cur.pm * tstep; const char* cB = (const char*)g.Bt + (size_t)cur.pn * tstep;
    S.a_ready(cur);
    if constexpr (SP2) {
        PG8_STAGE(PG8_SB(0, 0), cB, voffB); PG8_STAGE(PG8_SB(0, 1), cB + hstep, voffB); PG8_STAGE(PG8_SA(0, 0), cA, voffA); PG8_STAGE(PG8_SA(0, 1), cA + hstep, voffA);
        if (wr == 1) PG8_BAR;
        PG8_WAIT_V(2); PG8_BAR;
        PG8_STAGE(PG8_SB(1, 0), cB + kstep, voffB); PG8_STAGE(PG8_SA(1, 0), cA + kstep, voffA); PG8_STAGE(PG8_SB(1, 1), cB + hstep + kstep, voffB);
        PG8_WAIT_V(6); PG8_BAR;
    } else {
        PG8_STAGE(PG8_SB(0, 0), cB, voffB); PG8_STAGE(PG8_SA(0, 0), cA, voffA); PG8_STAGE(PG8_SB(0, 1), cB + hstep, voffB); PG8_STAGE(PG8_SA(0, 1), cA + hstep, voffA);
        if (wr == 1) PG8_BAR;
        PG8_WAIT_V(4); PG8_BAR;
        PG8_STAGE(PG8_SB(1, 0), cB + kstep, voffB); PG8_STAGE(PG8_SA(1, 0), cA + kstep, voffA); PG8_STAGE(PG8_SB(1, 1), cB + hstep + kstep, voffB);
        PG8_WAIT_V(6); PG8_BAR;
    }
    for (;;) {
        const bool has_next = S.next(ui + 1, nxt);
        const char* nA = has_next ? (const char*)g.A + (size_t)nxt.pm * tstep : cA; const char* nB = has_next ? (const char*)g.Bt + (size_t)nxt.pn * tstep : cB;
        for (int t = 0; t < nt; t += 2) {
            const bool last = (t == nt - 2);
            const char* a1 = cA + (size_t)(t + 1) * kstep;
            const char* a2 = last ? nA : cA + (size_t)(t + 2) * kstep; const char* b2 = last ? nB : cB + (size_t)(t + 2) * kstep;
            const char* a3 = a2 + kstep; const char* b3 = b2 + kstep;
            if (last && has_next) S.a_ready(nxt);
            if constexpr (SP2) {
            PG8_LDB(B0, 0, 0); PG8_LDB(B1, 0, 1); PG8_SCHED; PG8_LDA(At, 0, 0); PG8_STAGE(PG8_SA(1, 1), a1 + hstep, voffA);
            PG8_WAIT_V(8); PG8_WAIT_L(0); PG8_BAR; PG8_MMA(0, 0, At, B0); PG8_MMA(0, 1, At, B1); PG8_BAR; PG8_SCHED;
            PG8_LDA(At, 0, 1); PG8_STAGE(PG8_SB(0, 0), b2, voffB); PG8_STAGE(PG8_SB(0, 1), b2 + hstep, voffB); PG8_STAGE(PG8_SA(0, 0), a2, voffA);
            PG8_WAIT_V(8); PG8_WAIT_L(0); PG8_BAR; PG8_MMA(1, 0, At, B0); PG8_MMA(1, 1, At, B1); PG8_BAR; PG8_SCHED;
            PG8_LDB(B0, 1, 0); PG8_LDB(B1, 1, 1); PG8_SCHED; PG8_LDA(At, 1, 0); PG8_STAGE(PG8_SA(0, 1), a2 + hstep, voffA);
            PG8_WAIT_V(8); PG8_WAIT_L(0); PG8_BAR; PG8_MMA(0, 0, At, B0); PG8_MMA(0, 1, At, B1); PG8_BAR; PG8_SCHED;
            PG8_LDA(At, 1, 1); PG8_STAGE(PG8_SB(1, 0), b3, voffB); PG8_STAGE(PG8_SB(1, 1), b3 + hstep, voffB); PG8_STAGE(PG8_SA(1, 0), a3, voffA);
            PG8_WAIT_V(8); PG8_WAIT_L(0); PG8_BAR; PG8_MMA(1, 0, At, B0); PG8_MMA(1, 1, At, B1); PG8_BAR; PG8_SCHED;
            } else {
            PG8_LDB(B0, 0, 0); PG8_SCHED; PG8_LDA(At, 0, 0); PG8_STAGE(PG8_SA(1, 1), a1 + hstep, voffA);
            PG8_WAIT_L(8); PG8_BAR; PG8_WAIT_L(0); PG8_MMA(0, 0, At, B0); PG8_BAR; PG8_SCHED;
            PG8_LDB(B1, 0, 1); PG8_STAGE(PG8_SB(0, 0), b2, voffB);
            PG8_BAR; PG8_WAIT_L(0); PG8_MMA(0, 1, At, B1); PG8_BAR;
            PG8_LDA(At, 0, 1); PG8_STAGE(PG8_SA(0, 0), a2, voffA);
            PG8_BAR; PG8_WAIT_L(0); PG8_MMA(1, 0, At, B0); PG8_BAR; PG8_SCHED;
            PG8_STAGE(PG8_SB(0, 1), b2 + hstep, voffB);
            PG8_WAIT_V(6); PG8_BAR; PG8_MMA(1, 1, At, B1); PG8_BAR;
            PG8_LDB(B0, 1, 0); PG8_SCHED; PG8_LDA(At, 1, 0); PG8_STAGE(PG8_SA(0, 1), a2 + hstep, voffA);
            PG8_WAIT_L(8); PG8_BAR; PG8_WAIT_L(0); PG8_MMA(0, 0, At, B0); PG8_BAR; PG8_SCHED;
            PG8_LDB(B1, 1, 1); PG8_STAGE(PG8_SB(1, 0), b3, voffB);
            PG8_BAR; PG8_WAIT_L(0); PG8_MMA(0, 1, At, B1); PG8_BAR;
            PG8_LDA(At, 1, 1); PG8_STAGE(PG8_SA(1, 0), a3, voffA);
            PG8_BAR; PG8_WAIT_L(0); PG8_MMA(1, 0, At, B0); PG8_BAR; PG8_SCHED;
            PG8_STAGE(PG8_SB(1, 1), b3 + hstep, voffB);
            PG8_WAIT_V(6); PG8_BAR; PG8_MMA(1, 1, At, B1); PG8_BAR;
            }
        }
        if constexpr (ALIGN_EPI) { if (wr == 0) PG8_BAR; }
        if constexpr (!Epi::AFTER_DRAIN) { E(acc, cur, wr, wc, fr, fq); S.done(cur); }
        if (!has_next) break;
#pragma unroll
        for (int a = 0; a < 2; ++a)
#pragma unroll
            for (int b = 0; b < 2; ++b)
#pragma unroll
                for (int m = 0; m < 4; ++m)
#pragma unroll
                    for (int n = 0; n < 2; ++n) acc[a][b][m][n] = (f32x4){0.f, 0.f, 0.f, 0.f};
        cur = nxt; cA = nA; cB = nB; ++ui;
        if constexpr (ALIGN_EPI) { if (wr == 1) PG8_BAR; }
    }
    PG8_WAIT_V(0);
    if constexpr (!ALIGN_EPI) { if (wr == 0) PG8_BAR; }
    PG8_BAR;
    if constexpr (Epi::AFTER_DRAIN) { E.fused(acc, cur, wr, wc, fr, fq, lds, wid, lane); S.done(cur); }
#undef PG8_SA
#undef PG8_SB
#undef PG8_STAGE
#undef PG8_LDA
#undef PG8_LDB
#undef PG8_MMA
#undef PG8_WAIT_V
#undef PG8_WAIT_L
#undef PG8_BAR
#undef PG8_SCHED
}
}

#define XB_TMO      128
#define XB_XCNT(j)  (256  + 64 * (j))
#define XB_XSUB(j)  (1280 + 64 * (j))
#define XB_XGEN(j)  (2304 + 64 * (j))
#define XB_TOP      3328
#define XB_TOPGEN   3392
#define XCD_BAR_WORDS 3456
#define XB_SPIN_CAP (1u << 18)
#define LAS __attribute__((address_space(3)))

__device__ __forceinline__ unsigned xb_ld(unsigned* p)              { return __hip_atomic_load(p, __ATOMIC_RELAXED, __HIP_MEMORY_SCOPE_AGENT); }
__device__ __forceinline__ unsigned xb_add(unsigned* p, unsigned v) { return __hip_atomic_fetch_add(p, v, __ATOMIC_RELAXED, __HIP_MEMORY_SCOPE_AGENT); }
__device__ __forceinline__ unsigned xb_xcc_id() { return (unsigned)__builtin_amdgcn_s_getreg((3 << 11) | 20) & 0xFu; }
#define XB_SPIN(cond, bar) do { unsigned _sp = 0; while (cond) { __builtin_amdgcn_s_sleep(1); \
    if ((++_sp & 255u) == 0u) { if (xb_ld(&(bar)[XB_TMO])) break; if (_sp > XB_SPIN_CAP) { atomicAdd(&(bar)[XB_TMO], 1u); break; } } } } while (0)

struct XcdBarrier {
    unsigned* bar; unsigned x;
    volatile LAS unsigned* st;
};

__device__ __forceinline__ XcdBarrier xcd_barrier_post(unsigned* bar, volatile LAS unsigned* st, int tid) {
    XcdBarrier b; b.bar = bar; b.x = (unsigned)__builtin_amdgcn_readfirstlane((int)xb_xcc_id()); b.st = st;
    if (tid == 0) (void)xb_add(&bar[XB_XCNT(b.x)], 1u);
    return b;
}
__device__ __forceinline__ void xcd_barrier_complete(unsigned* bar, unsigned x, unsigned& nloc, unsigned& nx) {
    const unsigned G = gridDim.x * gridDim.y * gridDim.z;
    unsigned sum, cnt, mine, sp = 0u;
    for (;;) {
        sum = 0u; cnt = 0u; mine = 0u;
#pragma unroll
        for (unsigned j = 0; j < 16; ++j) { const unsigned c = xb_ld(&bar[XB_XCNT(j)]); sum += c; cnt += (c > 0u) ? 1u : 0u; mine = (j == x) ? c : mine; }
        if (sum == G) break;
        __builtin_amdgcn_s_sleep(1);
        if ((++sp & 255u) == 0u) { if (xb_ld(&bar[XB_TMO])) break; if (sp > XB_SPIN_CAP) { atomicAdd(&bar[XB_TMO], 1u); break; } }
    }
    nloc = mine > 0u ? mine : 1u; nx = cnt > 0u ? cnt : 1u;
}

__device__ __forceinline__ void xcd_barrier(const XcdBarrier& b, int tid) {
    asm volatile("s_waitcnt vmcnt(0)" ::: "memory");
    __syncthreads();
    if (tid == 0) {
        unsigned* bar = b.bar; unsigned bx_ = b.x; asm volatile("" : "+s"(bar), "+s"(bx_));
        __builtin_amdgcn_s_waitcnt(0);
        unsigned nloc = b.st[0], nx = b.st[1];
        if (nloc == 0u) { xcd_barrier_complete(bar, bx_, nloc, nx); b.st[0] = nloc; b.st[1] = nx; }
        const unsigned old = xb_add(&bar[XB_XSUB(bx_)], 1u);
        const unsigned gen = old / nloc;
        if (old + 1u == (gen + 1u) * nloc) {
            __builtin_amdgcn_fence(__ATOMIC_RELEASE, "agent");
            asm volatile("s_waitcnt vmcnt(0)" ::: "memory");
            const unsigned og = xb_add(&bar[XB_TOP], 1u);
            const unsigned tg = og / nx;
            if (og + 1u == (tg + 1u) * nx) xb_add(&bar[XB_TOPGEN], 1u);
            else XB_SPIN(xb_ld(&bar[XB_TOPGEN]) == tg, bar);
            __builtin_amdgcn_fence(__ATOMIC_ACQUIRE, "agent");
            xb_add(&bar[XB_XGEN(bx_)], 1u);
            asm volatile("s_waitcnt vmcnt(0)" ::: "memory");
        } else {
            XB_SPIN(xb_ld(&bar[XB_XGEN(bx_)]) == gen, bar);
            __builtin_amdgcn_fence(__ATOMIC_ACQUIRE, "agent");
            asm volatile("s_waitcnt vmcnt(0)" ::: "memory");
        }
    }
    __syncthreads();
}


typedef unsigned v4u __attribute__((ext_vector_type(4)));
typedef float f32x4 __attribute__((ext_vector_type(4)));
#define LDS_WAIT() asm volatile("s_waitcnt lgkmcnt(0)" ::: "memory")
constexpr int NWAVES = 8, NTHREADS = 512;
constexpr int RING_BYTES = 131072, LDS_BYTES = 155648;

struct P { const float* in[N_IN]; float* out; unsigned char* ws; };

template <int M> __device__ __forceinline__ float swz_xor(float v) { static_assert(M >= 1 && M < 32, "swizzle xor mask"); return __int_as_float(__builtin_amdgcn_ds_swizzle(__float_as_int(v), (M << 10) | 0x1f)); }
__device__ __forceinline__ float xor32_sum(float v) { auto r = __builtin_amdgcn_permlane32_swap(__float_as_uint(v), __float_as_uint(v), false, false); return __uint_as_float(r[0]) + __uint_as_float(r[1]); }
__device__ __forceinline__ float wave_sum(float v) {
    v += swz_xor<1>(v); v += swz_xor<2>(v); v += swz_xor<4>(v); v += swz_xor<8>(v); v += swz_xor<16>(v);
    return xor32_sum(v);
}

template <bool VPERM = false>
__device__ __forceinline__ void transpose_item(const float* W, int K, int N, bf16* WT, int k0, int n0, int drow0, LAS float* scr, int lane) {
    float tv[32];
#pragma unroll
    for (int i = 0; i < 32; ++i) { const int kk = 2 * i + (lane >> 5); tv[i] = W[(size_t)(k0 + kk) * N + n0 + (lane & 31)]; }
#pragma unroll
    for (int i = 0; i < 32; ++i) { const int kk = 2 * i + (lane >> 5); scr[kk * 33 + (lane & 31)] = tv[i]; }
    LDS_WAIT(); asm volatile("" ::: "memory");
    const int c = lane & 7;
#pragma unroll
    for (int j = 0; j < 4; ++j) { const int n = (lane >> 3) + 8 * j; const LAS float* s = scr + (8 * c) * 33 + n;
        v4u o; o.x = pk2(s[0 * 33], s[1 * 33]); o.y = pk2(s[2 * 33], s[3 * 33]); o.z = pk2(s[4 * 33], s[5 * 33]); o.w = pk2(s[6 * 33], s[7 * 33]);
        const int dr = VPERM ? (((drow0 + n) & ~127) + hg_vpos((drow0 + n) & 127)) : (drow0 + n);
        *(v4u*)(WT + (size_t)dr * K + k0 + 8 * c) = o; }
    LDS_WAIT(); asm volatile("" ::: "memory");
}

struct TItem { const float* W; bf16* WT; int K, N, k0, n0, dr, vperm; };
__device__ __forceinline__ void titem_decode(TItem& t, const P& p, unsigned char* ws, int it, int IT_L) {
    constexpr int IT_ADA = 16 * 192, IT_IN = 16 * 385, IT_BRA = 16 * 32, IT_BRB = 32 * 32, IT_OUT = 16 * 32, IT_UP = 16 * 128;
    const int l = it / IT_L; int r = it % IT_L;
    unsigned char* wl = ws + WS_W + (size_t)l * W_LSTRIDE; t.vperm = 0;
    if (r < IT_ADA) { const int kb = r / 192, nb = r % 192; t.W = p.in[I_WADA] + (size_t)l * D * 6144; t.K = D; t.N = 6144; t.WT = (bf16*)(ws + WS_WADA) + (size_t)l * 6144 * D; t.k0 = kb * 64; t.n0 = nb * 32; t.dr = nb * 32; return; } r -= IT_ADA;
    if (r < IT_IN) { const int kb = r / 385, nb = r % 385; const int n0 = nb * 32; t.W = p.in[I_WIN] + (size_t)l * D * IN_WIDTH; t.K = D; t.N = IN_WIDTH; t.WT = (bf16*)(wl + WO_IN); t.k0 = kb * 64; t.n0 = n0;
        t.dr = n0 < 10240 ? n0 : (n0 < 10272 ? PC_DT + (n0 - 10240) : n0 - 32); t.vperm = (n0 >= PC_I && n0 < PC_OG) ? 1 : 0; return; } r -= IT_IN;
    if (r < IT_BRA) { const int kb = r / 32, nb = r % 32; t.W = p.in[I_WBRA] + (size_t)l * 1024 * 1024; t.K = 1024; t.N = 1024; t.WT = (bf16*)(wl + WO_BRA); t.k0 = kb * 64; t.n0 = nb * 32; t.dr = nb * 32; return; } r -= IT_BRA;
    if (r < IT_BRB) { const int kb = r / 32, nb = r % 32; t.W = p.in[I_WBRB] + (size_t)l * 2048 * 1024; t.K = 2048; t.N = 1024; t.WT = (bf16*)(wl + WO_BRB); t.k0 = kb * 64; t.n0 = nb * 32; t.dr = nb * 32; return; } r -= IT_BRB;
    if (r < IT_OUT) { const int kb = r / 32, nb = r % 32; t.W = p.in[I_WOUT] + (size_t)l * 1024 * 1024; t.K = 1024; t.N = 1024; t.WT = (bf16*)(wl + WO_OUT); t.k0 = kb * 64; t.n0 = nb * 32; t.dr = nb * 32; return; } r -= IT_OUT;
    if (r < IT_UP) { const int kb = r / 128, nb = r % 128; t.W = p.in[I_WUP] + (size_t)l * 1024 * 4096; t.K = 1024; t.N = 4096; t.WT = (bf16*)(wl + WO_UP); t.k0 = kb * 64; t.n0 = nb * 32; t.dr = nb * 32; return; } r -= IT_UP;
    { const int kb = r / 32, nb = r % 32; t.W = p.in[I_WDOWN] + (size_t)l * 4096 * 1024; t.K = 4096; t.N = 1024; t.WT = (bf16*)(wl + WO_DOWN); t.k0 = kb * 64; t.n0 = nb * 32; t.dr = nb * 32; }
}
__device__ __forceinline__ void titem_load(float (&tv)[32], const TItem& t, int lane) {
    const float* wp = t.W + (size_t)(t.k0 + (lane >> 5)) * t.N + t.n0 + (lane & 31); const size_t st = (size_t)2 * t.N;
#pragma unroll
    for (int i = 0; i < 32; ++i) tv[i] = wp[(size_t)i * st];
}
__device__ __forceinline__ void titem_store(const float (&tv)[32], const TItem& t, LAS float* scr, int lane) {
#pragma unroll
    for (int i = 0; i < 32; ++i) { const int kk = 2 * i + (lane >> 5); scr[kk * 33 + (lane & 31)] = tv[i]; }
    LDS_WAIT(); asm volatile("" ::: "memory");
    const int c = lane & 7;
#pragma unroll
    for (int j = 0; j < 4; ++j) { const int n = (lane >> 3) + 8 * j; const LAS float* s = scr + (8 * c) * 33 + n;
        v4u o; o.x = pk2(s[0 * 33], s[1 * 33]); o.y = pk2(s[2 * 33], s[3 * 33]); o.z = pk2(s[4 * 33], s[5 * 33]); o.w = pk2(s[6 * 33], s[7 * 33]);
        const int dn = t.dr + n; const int dr = t.vperm ? ((dn & ~127) + hg_vpos(dn & 127)) : dn;
        *(v4u*)(t.WT + (size_t)dr * t.K + t.k0 + 8 * c) = o; }
    LDS_WAIT(); asm volatile("" ::: "memory");
}
__device__ __forceinline__ void phase_prologue(const P& p, LAS unsigned char* lds, int gw, int NGW, int lane, int wave) {
    LAS float* scr = (LAS float*)(lds + wave * 16384);
    unsigned char* ws = p.ws;
    constexpr int IT_ADA = 16 * 192, IT_IN = 16 * 385, IT_BRA = 16 * 32, IT_BRB = 32 * 32, IT_OUT = 16 * 32, IT_UP = 16 * 128, IT_DOWN = 64 * 32;
    constexpr int IT_L = IT_ADA + IT_IN + IT_BRA + IT_BRB + IT_OUT + IT_UP + IT_DOWN;
    for (int it = gw; it < DEPTH * IT_L; it += 2 * NGW) {
        TItem a, b2; titem_decode(a, p, ws, it, IT_L); const bool hb = it + NGW < DEPTH * IT_L; titem_decode(b2, p, ws, hb ? it + NGW : it, IT_L);
        float ta[32], tb[32];
        titem_load(ta, a, lane); if (hb) titem_load(tb, b2, lane);
        titem_store(ta, a, scr, lane); if (hb) titem_store(tb, b2, scr, lane);
    }
    for (int i = gw * 64 + lane; i < DEPTH * 28672; i += NGW * 64) { const int l = i / 28672, r = i % 28672;
        ((v4u*)(ws + WS_W + (size_t)l * W_LSTRIDE + WO_IN + (size_t)IN_WIDTH * D * 2))[r] = (v4u){0u, 0u, 0u, 0u}; }
    for (int i = gw * 64 + lane; i < 256 * 1024; i += NGW * 64) { const int r = i >> 10, c = i & 1023;
        float v = 0.f; if (r < NB) v = p.in[I_CP][r * D + c]; else if (r < NCOND) v = p.in[I_CS][(r - NB) * D + c];
        ((bf16*)(ws + WS_AC))[i] = f2bf(siluf_(v)); }
    for (int c = gw * 64 + lane; c < 1024; c += NGW * 64) { float v[DEPTH], mx = -3.0e38f;
#pragma unroll
        for (int l = 0; l < DEPTH; ++l) { v[l] = p.in[I_LB][l * 1024 + c]; mx = fmaxf(mx, v[l]); }
        float s = 0.f;
#pragma unroll
        for (int l = 0; l < DEPTH; ++l) { v[l] = expf(v[l] - mx); s += v[l]; }
        float cum = 0.f; float* lbs = (float*)(ws + WS_LBS);
#pragma unroll
        for (int l = 0; l < DEPTH; ++l) { if (l > 0) cum += v[l] / s; lbs[l * 1024 + c] = cum; }
    }
}

__device__ __forceinline__ f32x4 unpack4(unsigned long long w) { const unsigned lo = (unsigned)w, hi = (unsigned)(w >> 32); return (f32x4){__uint_as_float(lo << 16), __uint_as_float(lo & 0xffff0000u), __uint_as_float(hi << 16), __uint_as_float(hi & 0xffff0000u)}; }
template <int MODE, int NR>
__device__ __forceinline__ void norm_rows(const float* X32, bf16* X, bf16* H, float* out32, const f32x4 (&mul)[4], const f32x4 (&sh)[4], int lane) {
    if constexpr (MODE == 1) {
        f32x4 v[NR][4];
#pragma unroll
        for (int r = 0; r < NR; ++r) { const f32x4* xr = (const f32x4*)(X32 + (size_t)r * D) + lane;
#pragma unroll
            for (int j = 0; j < 4; ++j) v[r][j] = xr[64 * j]; }
#pragma unroll
        for (int r = 0; r < NR; ++r) { float s = 0.f;
#pragma unroll
            for (int j = 0; j < 4; ++j) s += (v[r][j].x * v[r][j].x + v[r][j].y * v[r][j].y) + (v[r][j].z * v[r][j].z + v[r][j].w * v[r][j].w);
            const float rstd = rsqrtf(wave_sum(s) * (1.f / D) + EPS);
            unsigned long long* o8 = (unsigned long long*)(H + (size_t)r * D) + lane; unsigned long long* x8 = (unsigned long long*)(X + (size_t)r * D) + lane;
#pragma unroll
            for (int j = 0; j < 4; ++j) { const f32x4 y = v[r][j] * rstd * mul[j] + sh[j];
                x8[64 * j] = (unsigned long long)pk2(v[r][j].x, v[r][j].y) | ((unsigned long long)pk2(v[r][j].z, v[r][j].w) << 32);
                o8[64 * j] = (unsigned long long)pk2(y.x, y.y) | ((unsigned long long)pk2(y.z, y.w) << 32); } }
    } else {
        unsigned long long raw[NR][4];
#pragma unroll
        for (int r = 0; r < NR; ++r) { const unsigned long long* xr = (const unsigned long long*)(X + (size_t)r * D) + lane;
#pragma unroll
            for (int j = 0; j < 4; ++j) raw[r][j] = xr[64 * j]; }
#pragma unroll
        for (int r = 0; r < NR; ++r) { f32x4 v[4]; float s = 0.f;
#pragma unroll
            for (int j = 0; j < 4; ++j) { v[j] = unpack4(raw[r][j]); s += (v[j].x * v[j].x + v[j].y * v[j].y) + (v[j].z * v[j].z + v[j].w * v[j].w); }
            const float rstd = rsqrtf(wave_sum(s) * (1.f / D) + EPS);
            if constexpr (MODE == 2) { f32x4* o = (f32x4*)(out32 + (size_t)r * D) + lane;
#pragma unroll
                for (int j = 0; j < 4; ++j) o[64 * j] = v[j] * rstd * mul[j];
            } else { unsigned long long* o8 = (unsigned long long*)(H + (size_t)r * D) + lane;
#pragma unroll
                for (int j = 0; j < 4; ++j) { const f32x4 y = v[j] * rstd * mul[j] + sh[j]; o8[64 * j] = (unsigned long long)pk2(y.x, y.y) | ((unsigned long long)pk2(y.z, y.w) << 32); } } }
    }
}
template <int MODE>
__device__ __forceinline__ void phase_norm(const float* Xp32, const float* Xs32, bf16* X, bf16* H, const float* nw, const float* mod_sh, const float* mod_sc, int gw, int NGW, int lane) {
    f32x4 w4[4];
#pragma unroll
    for (int j = 0; j < 4; ++j) w4[j] = ((const f32x4*)nw)[lane + 64 * j];
    for (int b = gw; b < MP / 8; b += NGW) {
        const int ci = b >> 8; f32x4 mul[4], sh[4];
        const f32x4* shp = (const f32x4*)(mod_sh + (size_t)ci * MODLD) + lane; const f32x4* scp = (const f32x4*)(mod_sc + (size_t)ci * MODLD) + lane;
#pragma unroll
        for (int j = 0; j < 4; ++j) { sh[j] = shp[64 * j]; mul[j] = w4[j] * (scp[64 * j] + 1.0f); }
        const size_t ro = (size_t)b * 8 * D;
        norm_rows<MODE, MODE == 1 ? 4 : 8>(MODE == 1 ? Xp32 + ro : nullptr, X + ro, H + ro, nullptr, mul, sh, lane);
        if constexpr (MODE == 1) norm_rows<MODE, 4>(Xp32 + ro + 4 * D, X + ro + 4 * D, H + ro + 4 * D, nullptr, mul, sh, lane);
    }
    for (int sr = gw; sr < MS; sr += NGW) {
        const int ci = NB + sr; f32x4 mul[4], sh[4];
        const f32x4* shp = (const f32x4*)(mod_sh + (size_t)ci * MODLD) + lane; const f32x4* scp = (const f32x4*)(mod_sc + (size_t)ci * MODLD) + lane;
#pragma unroll
        for (int j = 0; j < 4; ++j) { sh[j] = shp[64 * j]; mul[j] = w4[j] * (scp[64 * j] + 1.0f); }
        const size_t ro = (size_t)(MP + sr) * D;
        norm_rows<MODE, 1>(MODE == 1 ? Xs32 + (size_t)sr * D : nullptr, X + ro, H + ro, nullptr, mul, sh, lane);
    }
}
__device__ __forceinline__ void phase_final(const bf16* X, float* out, const float* nw, int gw, int NGW, int lane) {
    f32x4 w4[4];
#pragma unroll
    for (int j = 0; j < 4; ++j) w4[j] = ((const f32x4*)nw)[lane + 64 * j];
    for (int b = gw; b < MP / 8; b += NGW) { const size_t ro = (size_t)b * 8 * D; norm_rows<2, 8>(nullptr, (bf16*)X + ro, nullptr, out + ro, w4, w4, lane); }
    for (int sr = gw; sr < MS; sr += NGW) { const size_t ro = (size_t)(MP + sr) * D; norm_rows<2, 1>(nullptr, (bf16*)X + ro, nullptr, out + ro, w4, w4, lane); }
}


typedef short s16x4 __attribute__((ext_vector_type(4)));
typedef short bf16x8 __attribute__((ext_vector_type(8)));
__device__ __forceinline__ f32x4 mfma16(bf16x8 a, bf16x8 b, f32x4 c) { return __builtin_amdgcn_mfma_f32_16x16x32_bf16(a, b, c, 0, 0, 0); }
__device__ __forceinline__ s16x4 tr_read4(LAS unsigned char* p) { return __builtin_amdgcn_ds_read_tr16_b64_v4i16((LAS s16x4*)p); }
#define SHFL_XOR(v, M) swz_xor<M>(v)
__device__ __forceinline__ float shfl_up_f(float v, int o, int lane) { return __int_as_float(__builtin_amdgcn_ds_bpermute((lane >= o ? lane - o : lane) << 2, __float_as_int(v))); }
__device__ __forceinline__ void sync_threads() { __syncthreads(); }
__device__ __forceinline__ float __builtin_amdgcn_exp2f_(float x) { return __builtin_amdgcn_exp2f(x); }
#ifdef HOST_EMU
#define FENCE_MEM() do {} while (0)
#define SCHED_FENCE() do {} while (0)
#define LAUNDER_PTR(p) do {} while (0)
#else
#define LAUNDER_PTR(p) asm volatile("" : "+v"(p))
#define FENCE_MEM() asm volatile("" ::: "memory")
#define SCHED_FENCE() __builtin_amdgcn_sched_barrier(0)
#endif
constexpr int RC = 64;
constexpr int NSEG = 4, SEGLEN = 512, NCH = SEGLEN / RC;
constexpr int PQ = 272;
constexpr int PX = 528;

struct RecurBufs {
    bf16* proj;
    bf16* xbcc;
    float* dtv;
    float* cum;
    float* cv;
    float* sseg;
    float* dseg;
    float* hseg;
    float* tseg;
    bf16* ohg;
    bf16* y;
};

__device__ __forceinline__ bf16x8 frag_rows(LAS unsigned char* img, int pitch, int row, int kcol) { return *(LAS bf16x8*)(img + row * pitch + kcol * 2); }
__device__ __forceinline__ bf16x8 frag_tr(LAS unsigned char* img, int pitch, int k0a, int k0b, int col0, int lane) {
    const int q = (lane & 15) >> 2, p = lane & 3;
    const s16x4 a = tr_read4(img + (k0a + q) * pitch + (col0 + 4 * p) * 2);
    const s16x4 b = tr_read4(img + (k0b + q) * pitch + (col0 + 4 * p) * 2);
    return (bf16x8){a[0], a[1], a[2], a[3], b[0], b[1], b[2], b[3]};
}
__device__ __forceinline__ bf16x8 scale_frag(bf16x8 f, float s) {
    bf16x8 o;
#pragma unroll
    for (int j = 0; j < 8; ++j) o[j] = (short)f2bf(bf2f((bf16)f[j]) * s);
    return o;
}
__device__ __forceinline__ bf16x8 scale_frag8(bf16x8 f, const float (&s)[8]) {
    bf16x8 o;
#pragma unroll
    for (int j = 0; j < 8; ++j) o[j] = (short)f2bf(bf2f((bf16)f[j]) * s[j]);
    return o;
}
__device__ __forceinline__ void stage_tile128(const bf16* g, size_t ld, LAS unsigned char* img, int tid) {
#pragma unroll
    for (int i = 0; i < 2; ++i) { const int idx = tid + i * 512, r = idx >> 4, c16 = idx & 15;
        *(LAS v4u*)(img + r * PQ + c16 * 16) = *(const v4u*)(g + (size_t)r * ld + c16 * 8); }
}

constexpr int HG_QT = 0, HG_KT = 17408, HG_V = 34816, HG_PART = 52224, HG_VEC1 = 54272, HG_ST = 52224, HG_VEC = 87040, HG_RED = 89088;

__device__ __forceinline__ void hgrn_state_update(f32x4 (&S)[8], LAS unsigned char* Kt, LAS unsigned char* V, const LAS float* escale, const LAS float* edec, int w, int lane) {
    const int c = lane & 15, g = lane >> 4;
    const f32x4 dc = *(const LAS f32x4*)(edec + 16 * w + 4 * g);
#pragma unroll
    for (int et = 0; et < 8; ++et) S[et] = S[et] * dc;
    const float es = escale[16 * w + c];
#pragma unroll
    for (int ks = 0; ks < 2; ++ks) {
        const bf16x8 A = scale_frag(frag_tr(Kt, PQ, 32 * ks + 8 * g, 32 * ks + 8 * g + 4, 16 * w, lane), es);
#pragma unroll
        for (int et = 0; et < 8; ++et) { const bf16x8 B = frag_tr(V, PQ, 32 * ks + 8 * g, 32 * ks + 8 * g + 4, 16 * et, lane); S[et] = mfma16(A, B, S[et]); }
        SCHED_FENCE();
    }
}

__device__ __forceinline__ void hgrn_pass1(const RecurBufs& rb, const float* lbs_l, int u, int tid, LAS unsigned char* lds) {
    const int b = u >> 5, h = (u >> 2) & 7, seg = u & 3, lane = tid & 63, w = tid >> 6;
    const int d = tid & 127, jq = tid >> 7;
    LAS unsigned char* Qt = lds + HG_QT; LAS unsigned char* Kt = lds + HG_KT; LAS unsigned char* V = lds + HG_V; LAS float* part = (LAS float*)(lds + HG_PART); LAS float* vec = (LAS float*)(lds + HG_VEC1);
    const float lb = lbs_l[h * 128 + d];
    f32x4 S[8];
#pragma unroll
    for (int et = 0; et < 8; ++et) S[et] = (f32x4){0.f, 0.f, 0.f, 0.f};
    float dprod = 1.f;
    const int sr = tid >> 4, sc16 = tid & 15;
    v4u pre[6];
    {   const bf16* gq = rb.proj + ((size_t)b * SEQ + seg * SEGLEN + sr) * LDP + PC_Q + h * 128 + sc16 * 8;
        pre[0] = *(const v4u*)gq; pre[1] = *(const v4u*)(gq + 32 * (size_t)LDP); pre[2] = *(const v4u*)(gq + PC_F); pre[3] = *(const v4u*)(gq + 32 * (size_t)LDP + PC_F);
        pre[4] = *(const v4u*)(gq + PC_I); pre[5] = *(const v4u*)(gq + 32 * (size_t)LDP + PC_I); }
    for (int ch = 0; ch < NCH; ++ch) {
        const size_t row0 = (size_t)b * SEQ + seg * SEGLEN + ch * RC;
        bf16* gq = rb.proj + (row0 + sr) * LDP + PC_Q + h * 128 + sc16 * 8;
        *(LAS v4u*)(Qt + sr * PQ + sc16 * 16) = pre[0]; *(LAS v4u*)(Qt + (sr + 32) * PQ + sc16 * 16) = pre[1];
        *(LAS v4u*)(Kt + sr * PQ + sc16 * 16) = pre[2]; *(LAS v4u*)(Kt + (sr + 32) * PQ + sc16 * 16) = pre[3];
        *(LAS v4u*)(V + sr * PQ + sc16 * 16) = pre[4]; *(LAS v4u*)(V + (sr + 32) * PQ + sc16 * 16) = pre[5];
        if (ch + 1 < NCH) { const bf16* gn = gq + RC * (size_t)LDP;
            pre[0] = *(const v4u*)gn; pre[1] = *(const v4u*)(gn + 32 * (size_t)LDP); pre[2] = *(const v4u*)(gn + PC_F); pre[3] = *(const v4u*)(gn + 32 * (size_t)LDP + PC_F);
            pre[4] = *(const v4u*)(gn + PC_I); pre[5] = *(const v4u*)(gn + 32 * (size_t)LDP + PC_I); }
        sync_threads();
        float qq[16], kk[16], lg[16];
#pragma unroll
        for (int j = 0; j < 16; ++j) { const float q = bf2f(*(const LAS bf16*)(Qt + (16 * jq + j) * PQ + d * 2)), f = bf2f(*(const LAS bf16*)(Kt + (16 * jq + j) * PQ + d * 2));
            const float fg = lb + (1.f - lb) * sigmoidf_(f);
            qq[j] = siluf_(q) * 0.08838834764831845f; kk[j] = 1.f - fg; lg[j] = __logf(fg); }
#pragma unroll
        for (int j = 1; j < 16; ++j) lg[j] += lg[j - 1];
        part[jq * 128 + d] = lg[15];
        sync_threads();
        const float p0 = part[d], p1 = part[128 + d], p2 = part[256 + d], p3 = part[384 + d];
        const float off = (jq > 0 ? p0 : 0.f) + (jq > 1 ? p1 : 0.f) + (jq > 2 ? p2 : 0.f);
        const float bref = p0 + p1, bend = (p0 + p1) + (p2 + p3);
#pragma unroll
        for (int j = 0; j < 16; ++j) { const float e1 = __expf(fminf(fmaxf(off + lg[j] - bref, -80.f), 80.f));
            *(LAS bf16*)(Qt + (16 * jq + j) * PQ + d * 2) = f2bf(qq[j] * e1); *(LAS bf16*)(Kt + (16 * jq + j) * PQ + d * 2) = f2bf(kk[j] * frcp_(e1)); }
        if (jq == 0) { const float eref = __expf(bref), esc = __expf(bend - bref), edc = __expf(bend);
            float* cvp = rb.cv + ((size_t)((b * 8 + h) * 32 + seg * NCH + ch) * 3) * 128;
            cvp[d] = eref; cvp[128 + d] = esc; cvp[256 + d] = edc; vec[128 + d] = esc; vec[256 + d] = edc; }
        dprod *= __expf(bend);
        sync_threads();
        *(v4u*)gq = *(const LAS v4u*)(Qt + sr * PQ + sc16 * 16); *(v4u*)(gq + 32 * (size_t)LDP) = *(const LAS v4u*)(Qt + (sr + 32) * PQ + sc16 * 16);
        *(v4u*)(gq + PC_F) = *(const LAS v4u*)(Kt + sr * PQ + sc16 * 16); *(v4u*)(gq + 32 * (size_t)LDP + PC_F) = *(const LAS v4u*)(Kt + (sr + 32) * PQ + sc16 * 16);
        hgrn_state_update(S, Kt, V, vec + 128, vec + 256, w, lane);
        sync_threads();
    }
    float* sp = rb.sseg + (size_t)u * 16384 + tid * 4;
#pragma unroll
    for (int et = 0; et < 8; ++et) { LAUNDER_PTR(sp); *(f32x4*)sp = S[et]; sp += 2048; }
    if (jq == 0) rb.dseg[u * 128 + d] = dprod;
}

__device__ __forceinline__ void hgrn_pass2(const RecurBufs& rb, const float* hgn_l, float* state_out_l, int u, int tid, LAS unsigned char* lds) {
    const int b = u >> 5, h = (u >> 2) & 7, seg = u & 3, lane = tid & 63, w = tid >> 6, c = lane & 15, g = lane >> 4;
    const int it = w & 3, eh = w >> 2;
    LAS unsigned char* Qt = lds + HG_QT; LAS unsigned char* Kt = lds + HG_KT; LAS unsigned char* V = lds + HG_V; LAS unsigned char* ST = lds + HG_ST;
    LAS float* vec = (LAS float*)(lds + HG_VEC); LAS float* red = (LAS float*)(lds + HG_RED);
    f32x4 S[8];
#pragma unroll
    for (int et = 0; et < 8; ++et) S[et] = (f32x4){0.f, 0.f, 0.f, 0.f};
    f32x4 L[3][8], dcs[3];
#pragma unroll
        for (int s = 0; s < 3; ++s) if (s < seg) { const int u2 = u - seg + s;
            dcs[s] = *(const f32x4*)(rb.dseg + u2 * 128 + 16 * w + 4 * g);
            const float* sp = rb.sseg + (size_t)u2 * 16384 + tid * 4;
#pragma unroll
            for (int et = 0; et < 8; ++et) { LAUNDER_PTR(sp); L[s][et] = *(const f32x4*)sp; sp += 2048; } }
    const int e0 = 64 * eh + 4 * c;
    const f32x4 hn = *(const f32x4*)(hgn_l + e0);
    const float* cvb = rb.cv + ((size_t)((b * 8 + h) * 32 + seg * NCH) * 3) * 128;
    const int sr = tid >> 4, sc16 = tid & 15;
    const size_t rowS = (size_t)b * SEQ + seg * SEGLEN;
    v4u pre[6];
    {   const bf16* gq = rb.proj + (rowS + sr) * LDP + PC_Q + h * 128 + sc16 * 8;
        pre[0] = *(const v4u*)gq; pre[1] = *(const v4u*)(gq + 32 * (size_t)LDP); pre[2] = *(const v4u*)(gq + PC_F); pre[3] = *(const v4u*)(gq + 32 * (size_t)LDP + PC_F);
        pre[4] = *(const v4u*)(gq + PC_I); pre[5] = *(const v4u*)(gq + 32 * (size_t)LDP + PC_I); }
    float cvn = tid < 384 ? cvb[tid] : 0.f; f32x4 ern = *(const f32x4*)(cvb + 16 * w + 4 * g);
#pragma unroll
        for (int s = 0; s < 3; ++s) if (s < seg) {
#pragma unroll
            for (int et = 0; et < 8; ++et) S[et] = S[et] * dcs[s] + L[s][et]; }
    for (int ch = 0; ch < NCH; ++ch) {
        const size_t row0 = rowS + ch * RC;
        *(LAS v4u*)(Qt + sr * PQ + sc16 * 16) = pre[0]; *(LAS v4u*)(Qt + (sr + 32) * PQ + sc16 * 16) = pre[1];
        *(LAS v4u*)(Kt + sr * PQ + sc16 * 16) = pre[2]; *(LAS v4u*)(Kt + (sr + 32) * PQ + sc16 * 16) = pre[3];
        *(LAS v4u*)(V + sr * PQ + sc16 * 16) = pre[4]; *(LAS v4u*)(V + (sr + 32) * PQ + sc16 * 16) = pre[5];
        if (ch + 1 < NCH) { const bf16* gq = rb.proj + (row0 + RC + sr) * LDP + PC_Q + h * 128 + sc16 * 8;
            pre[0] = *(const v4u*)gq; pre[1] = *(const v4u*)(gq + 32 * (size_t)LDP); pre[2] = *(const v4u*)(gq + PC_F); pre[3] = *(const v4u*)(gq + 32 * (size_t)LDP + PC_F);
            pre[4] = *(const v4u*)(gq + PC_I); pre[5] = *(const v4u*)(gq + 32 * (size_t)LDP + PC_I); }
        if (tid < 384) vec[tid] = cvn;
        {
            const f32x4 er = ern;
            if (ch + 1 < NCH) { if (tid < 384) cvn = cvb[(size_t)(ch + 1) * 384 + tid]; ern = *(const f32x4*)(cvb + (size_t)(ch + 1) * 384 + 16 * w + 4 * g); }
#pragma unroll
            for (int et = 0; et < 8; ++et) { const f32x4 v = S[et] * er;
                *(LAS unsigned long long*)(ST + (16 * et + c) * PQ + (16 * w + 4 * g) * 2) = (unsigned long long)pk2(v[0], v[1]) | ((unsigned long long)pk2(v[2], v[3]) << 32); } }
        unsigned long long ogv[4];
#pragma unroll
        for (int r = 0; r < 4; ++r) ogv[r] = *(const unsigned long long*)(rb.proj + (row0 + 16 * it + 4 * g + r) * LDP + PC_OG + h * 128 + e0);
        sync_threads();
        bf16x8 Qfr[4];
#pragma unroll
        for (int kd = 0; kd < 4; ++kd) Qfr[kd] = frag_rows(Qt, PQ, 16 * it + c, 32 * kd + 8 * g);
        unsigned PT[4][2];
#pragma unroll
        for (int jt = 0; jt < 4; ++jt) {
            f32x4 acc = (f32x4){0.f, 0.f, 0.f, 0.f};
            if (jt <= it) {
#pragma unroll
                for (int kd = 0; kd < 4; ++kd) acc = mfma16(frag_rows(Kt, PQ, 16 * jt + c, 32 * kd + 8 * g), Qfr[kd], acc);
                if (jt == it) {
#pragma unroll
                    for (int r = 0; r < 4; ++r) acc[r] = (4 * g + r <= c) ? acc[r] : 0.f; }
            }
            PT[jt][0] = pk2(acc[0], acc[1]); PT[jt][1] = pk2(acc[2], acc[3]); SCHED_FENCE();
        }
        f32x4 o[4];
#pragma unroll
        for (int et = 0; et < 4; ++et) o[et] = (f32x4){0.f, 0.f, 0.f, 0.f};
#pragma unroll
        for (int ks = 0; ks < 2; ++ks) if (2 * ks <= it) {
            v4u pa = (v4u){PT[2 * ks][0], PT[2 * ks][1], PT[2 * ks + 1][0], PT[2 * ks + 1][1]};
            const bf16x8 A = __builtin_bit_cast(bf16x8, pa);
#pragma unroll
            for (int et = 0; et < 4; ++et) o[et] = mfma16(A, frag_tr(V, PQ, 32 * ks + 4 * g, 32 * ks + 16 + 4 * g, 16 * (4 * eh + et), lane), o[et]);
        }
#pragma unroll
        for (int kd = 0; kd < 4; ++kd) {
#pragma unroll
            for (int et = 0; et < 4; ++et) o[et] = mfma16(Qfr[kd], frag_rows(ST, PQ, 16 * (4 * eh + et) + c, 32 * kd + 8 * g), o[et]);
            SCHED_FENCE(); }
        hgrn_state_update(S, Kt, V, vec + 128, vec + 256, w, lane);
        float ss[4];
#pragma unroll
        for (int r = 0; r < 4; ++r) { float s = 0.f;
#pragma unroll
            for (int et = 0; et < 4; ++et) s += o[et][r] * o[et][r];
            s += SHFL_XOR(s, 1); s += SHFL_XOR(s, 2); s += SHFL_XOR(s, 4); s += SHFL_XOR(s, 8); ss[r] = s; }
        if (c == 0) {
#pragma unroll
            for (int r = 0; r < 4; ++r) red[(16 * it + 4 * g + r) * 2 + eh] = ss[r]; }
        sync_threads();
#pragma unroll
        for (int r = 0; r < 4; ++r) { const int i = 16 * it + 4 * g + r; const float rstd = rsqrtf((red[i * 2] + red[i * 2 + 1]) * (1.f / 128.f) + EPS);
            float ov[4];
#pragma unroll
            for (int et = 0; et < 4; ++et) { const float og = bf2f((bf16)(ogv[r] >> (16 * et))); ov[et] = o[et][r] * rstd * hn[et] * siluf_(og); }
            *(unsigned long long*)(rb.ohg + (row0 + i) * 1024 + h * 128 + e0) = (unsigned long long)pk2(ov[0], ov[1]) | ((unsigned long long)pk2(ov[2], ov[3]) << 32); }
        sync_threads();
    }
    if (seg == NSEG - 1) { float* so = state_out_l + (size_t)(b * 8 + h) * 16384 + (size_t)(16 * w + 4 * g) * 128 + 4 * c;
#pragma unroll
        for (int r = 0; r < 4; ++r)
#pragma unroll
            for (int a = 0; a < 2; ++a) *(f32x4*)(so + r * 128 + 64 * a) = (f32x4){S[4 * a][r], S[4 * a + 1][r], S[4 * a + 2][r], S[4 * a + 3][r]}; }
}

constexpr int PR = 1040;
constexpr int SD_T = 0, SD_H = 66560, SD_XO = 66560  , SD_DT = 136192, SD_CUM = 137216, SD_RED = 138240, SD_END = 139264;
__device__ __forceinline__ int ssd_gcol(int grp, int ch16) { return ch16 < 32 ? grp * 256 + ch16 * 8 : (ch16 < 48 ? 2048 + grp * 128 + (ch16 - 32) * 8 : 3072 + grp * 128 + (ch16 - 48) * 8); }

__device__ __forceinline__ void ssd_state_update(f32x4 (&H)[4][4], LAS unsigned char* Xi, int xp, LAS unsigned char* Bi, int bp, const LAS float* sDt, const LAS float* sCum, int w, int lane) {
    const int g = lane >> 4, k = w >> 1, nh = w & 1;
    const float tot = sCum[63 * 4 + k]; const float et = __expf(tot);
#pragma unroll
    for (int nt = 0; nt < 4; ++nt)
#pragma unroll
        for (int pt = 0; pt < 4; ++pt) H[nt][pt] = H[nt][pt] * et;
#pragma unroll
    for (int ks = 0; ks < 2; ++ks) {
        float wg[8];
#pragma unroll
        for (int j = 0; j < 8; ++j) wg[j] = __expf(tot - sCum[(32 * ks + 8 * g + j) * 4 + k]) * sDt[(32 * ks + 8 * g + j) * 4 + k];
        bf16x8 Bx[4];
#pragma unroll
        for (int pt = 0; pt < 4; ++pt) Bx[pt] = scale_frag8(frag_tr(Xi, xp, 32 * ks + 8 * g, 32 * ks + 8 * g + 4, 64 * k + 16 * pt, lane), wg);
#pragma unroll
        for (int nt = 0; nt < 4; ++nt) { const bf16x8 A = frag_tr(Bi, bp, 32 * ks + 8 * g, 32 * ks + 8 * g + 4, 16 * (4 * nh + nt), lane);
#pragma unroll
            for (int pt = 0; pt < 4; ++pt) H[nt][pt] = mfma16(A, Bx[pt], H[nt][pt]);
            SCHED_FENCE(); }
    }
}

typedef float f32x2r __attribute__((ext_vector_type(2)));
__device__ __forceinline__ f32x2r unpack2(unsigned w) { return (f32x2r){__uint_as_float(w << 16), __uint_as_float(w & 0xffff0000u)}; }
__device__ __forceinline__ f32x2r silu2(f32x2r a) {
    const f32x2r t = a * (-1.4426950408889634f); f32x2r e; e.x = __builtin_amdgcn_exp2f_(t.x); e.y = __builtin_amdgcn_exp2f_(t.y);
    const f32x2r d = e + 1.0f; f32x2r r; r.x = frcp_(d.x); r.y = frcp_(d.y); return a * r; }
constexpr int SD_RH = SD_XO + 64 * PX;
__device__ __forceinline__ void ssd_pass1(const RecurBufs& rb, const float* conv_w, const float* conv_b, const float* dt_bias, const float* a_log, float* conv_out_l, int u, int tid, LAS unsigned char* lds) {
    const int b = u >> 5, grp = (u >> 2) & 7, seg = u & 3, lane = tid & 63, w = tid >> 6;
    LAS unsigned char* T = lds + SD_T; LAS float* sDt = (LAS float*)(lds + SD_DT); LAS float* sCum = (LAS float*)(lds + SD_CUM); LAS unsigned char* RH = lds + SD_RH;
    const int cp = tid & 255, half = tid >> 8, t0c = 2 * cp;
    const int chx = t0c < 256 ? (grp * 256 + t0c) : (t0c < 384 ? (2048 + grp * 128 + (t0c - 256)) : (3072 + grp * 128 + (t0c - 384)));
    const int xcol = (t0c & ~63) + 16 * (t0c & 3) + ((t0c & 63) >> 2);
    const f32x2r w0 = (f32x2r){conv_w[chx], conv_w[chx + 1]}, w1 = (f32x2r){conv_w[4096 + chx], conv_w[4096 + chx + 1]}, w2 = (f32x2r){conv_w[8192 + chx], conv_w[8192 + chx + 1]},
                 w3 = (f32x2r){conv_w[12288 + chx], conv_w[12288 + chx + 1]}, cb = (f32x2r){conv_b[chx], conv_b[chx + 1]};
    const size_t rowS = (size_t)b * SEQ + seg * SEGLEN;
    if (half == 0) {
#pragma unroll
        for (int j = 0; j < 3; ++j) { unsigned v = 0u; if (seg > 0) v = *(const unsigned*)(rb.proj + (rowS - 3 + j) * LDP + PC_XBC + chx); *(LAS unsigned*)(RH + j * 1024 + cp * 4) = v; } }
    f32x4 H[4][4];
#pragma unroll
    for (int nt = 0; nt < 4; ++nt)
#pragma unroll
        for (int pt = 0; pt < 4; ++pt) H[nt][pt] = (f32x4){0.f, 0.f, 0.f, 0.f};
    float tsum = 0.f;
    const int ch16 = tid & 63, rr = tid >> 6;
    const int gcol = ssd_gcol(grp, ch16);
    LAS unsigned char* XO = lds + SD_XO;
    v4u raw[8];
    {   const bf16* gp = rb.proj + (rowS + rr) * LDP + PC_XBC + gcol;
#pragma unroll
        for (int i = 0; i < 8; ++i) { LAUNDER_PTR(gp); raw[i] = *(const v4u*)gp; gp += 8 * (size_t)LDP; } }
    bf16 dtn = 0;
    if (w < 4) dtn = rb.proj[(rowS + lane) * LDP + PC_DT + grp * 4 + w];
    unsigned hr0 = 0u, hr1 = 0u, hr2 = 0u;
    for (int ch = 0; ch < NCH; ++ch) {
        const size_t row0 = rowS + ch * RC;
        if (w < 4) {
            const int head = grp * 4 + w; const size_t row = row0 + lane;
            const float dv = softplusf_(bf2f(dtn) + dt_bias[head]);
            if (ch + 1 < NCH) dtn = rb.proj[(row + RC) * LDP + PC_DT + head];
            float la = dv * (-__expf(a_log[head]));
#pragma unroll
            for (int o = 1; o < 64; o <<= 1) { const float t = shfl_up_f(la, o, lane); if (lane >= o) la += t; }
            sDt[lane * 4 + w] = dv; sCum[lane * 4 + w] = la; rb.dtv[row * 32 + head] = dv; rb.cum[row * 32 + head] = la;
        }
#pragma unroll
        for (int i = 0; i < 8; ++i) *(LAS v4u*)(T + (rr + 8 * i) * PR + ch16 * 16) = raw[i];
        if (ch + 1 < NCH) { const bf16* gp = rb.proj + (row0 + RC + rr) * LDP + PC_XBC + gcol;
#pragma unroll
            for (int i = 0; i < 8; ++i) { LAUNDER_PTR(gp); raw[i] = *(const v4u*)gp; gp += 8 * (size_t)LDP; } }
        sync_threads();
        if (half == 0) { hr0 = *(const LAS unsigned*)(RH + cp * 4); hr1 = *(const LAS unsigned*)(RH + 1024 + cp * 4); hr2 = *(const LAS unsigned*)(RH + 2048 + cp * 4); }
        else { hr0 = *(const LAS unsigned*)(T + 29 * PR + cp * 4); hr1 = *(const LAS unsigned*)(T + 30 * PR + cp * 4); hr2 = *(const LAS unsigned*)(T + 31 * PR + cp * 4); }
        sync_threads();
        {
            f32x2r r0 = unpack2(hr0), r1 = unpack2(hr1), r2 = unpack2(hr2);
            const LAS unsigned char* src = T + (32 * half) * PR + cp * 4;
            unsigned lastw0 = hr0, lastw1 = hr1, lastw2 = hr2;
#pragma unroll 8
            for (int j = 0; j < 32; ++j) { const unsigned cw = *(const LAS unsigned*)(src + j * PR); const f32x2r cur = unpack2(cw);
                const f32x2r a = cb + w0 * r0 + w1 * r1 + w2 * r2 + w3 * cur; r0 = r1; r1 = r2; r2 = cur; lastw0 = lastw1; lastw1 = lastw2; lastw2 = cw;
                const f32x2r v = silu2(a); const unsigned ow = pk2(v.x, v.y);
                if (cp < 128) { LAS unsigned char* d = XO + (32 * half + j) * PX + xcol * 2; *(LAS bf16*)d = (bf16)ow; *(LAS bf16*)(d + 32) = (bf16)(ow >> 16); }
                else *(LAS unsigned*)(T + (32 * half + j) * PR + cp * 4) = ow; }
            if (half == 1) { *(LAS unsigned*)(RH + cp * 4) = lastw0; *(LAS unsigned*)(RH + 1024 + cp * 4) = lastw1; *(LAS unsigned*)(RH + 2048 + cp * 4) = lastw2;
                hr0 = lastw0; hr1 = lastw1; hr2 = lastw2; }
        }
        sync_threads();
        tsum += sCum[63 * 4 + (w >> 1)];
        ssd_state_update(H, XO, PX, T + 512, PR, sDt, sCum, w, lane);
        {   bf16* gp = rb.xbcc + (row0 + rr) * 4096 + gcol;
            const LAS unsigned char* src = ch16 < 32 ? (XO + ch16 * 16) : (T + ch16 * 16); const int spitch = ch16 < 32 ? PX : PR;
#pragma unroll
            for (int i = 0; i < 8; ++i) { LAUNDER_PTR(gp); *(v4u*)gp = *(const LAS v4u*)(src + (rr + 8 * i) * spitch); gp += 8 * 4096; } }
        sync_threads();
    }
    float* hp = rb.hseg + (size_t)u * 32768 + tid * 4;
#pragma unroll
    for (int nt = 0; nt < 4; ++nt)
#pragma unroll
        for (int pt = 0; pt < 4; ++pt) { LAUNDER_PTR(hp); *(f32x4*)hp = H[nt][pt]; hp += 2048; }
    if ((tid & 127) == 0) rb.tseg[u * 4 + (w >> 1)] = tsum;
    if (seg == NSEG - 1 && half == 1) { float* co = conv_out_l + (size_t)b * 3 * 4096;
        const f32x2r a0 = unpack2(hr0), a1 = unpack2(hr1), a2 = unpack2(hr2);
        co[chx] = a0.x; co[chx + 1] = a0.y; co[4096 + chx] = a1.x; co[4096 + chx + 1] = a1.y; co[8192 + chx] = a2.x; co[8192 + chx + 1] = a2.y; }
}

__device__ __forceinline__ void ssd_pass2(const RecurBufs& rb, const float* d_skip, const float* ssm_norm, float* state_out_l, int u, int tid, LAS unsigned char* lds) {
    const int b = u >> 5, grp = (u >> 2) & 7, seg = u & 3, lane = tid & 63, w = tid >> 6, c = lane & 15, g = lane >> 4;
    const int k = w >> 1, hf = w & 1, head = grp * 4 + k;
    LAS unsigned char* T = lds + SD_T; LAS unsigned char* sB = T + 512; LAS unsigned char* sC = T + 768; LAS unsigned char* hS = lds + SD_H + k * (64 * PQ);
    LAS float* sDt = (LAS float*)(lds + SD_DT); LAS float* sCum = (LAS float*)(lds + SD_CUM); LAS float* red = (LAS float*)(lds + SD_RED);
    f32x4 H[4][4];
#pragma unroll
    for (int nt = 0; nt < 4; ++nt)
#pragma unroll
        for (int pt = 0; pt < 4; ++pt) H[nt][pt] = (f32x4){0.f, 0.f, 0.f, 0.f};
    for (int s = 0; s < seg; s += 2) {
        f32x4 L0[4][4], L1[4][4]; const bool two = s + 1 < seg;
        const int ua = u - seg + s, ub = two ? ua + 1 : ua;
        const float dca = __expf(rb.tseg[ua * 4 + k]), dcb = __expf(rb.tseg[ub * 4 + k]);
        {   const float* hp = rb.hseg + (size_t)ua * 32768 + tid * 4;
#pragma unroll
            for (int nt = 0; nt < 4; ++nt)
#pragma unroll
                for (int pt = 0; pt < 4; ++pt) { LAUNDER_PTR(hp); L0[nt][pt] = *(const f32x4*)hp; hp += 2048; } }
        if (two) { const float* hp = rb.hseg + (size_t)ub * 32768 + tid * 4;
#pragma unroll
            for (int nt = 0; nt < 4; ++nt)
#pragma unroll
                for (int pt = 0; pt < 4; ++pt) { LAUNDER_PTR(hp); L1[nt][pt] = *(const f32x4*)hp; hp += 2048; } }
#pragma unroll
        for (int nt = 0; nt < 4; ++nt)
#pragma unroll
            for (int pt = 0; pt < 4; ++pt) { H[nt][pt] = H[nt][pt] * dca + L0[nt][pt]; if (two) H[nt][pt] = H[nt][pt] * dcb + L1[nt][pt]; } }
    const float Dk = d_skip[head];
    const size_t rowS = (size_t)b * SEQ + seg * SEGLEN;
    const int ch16 = tid & 63, rr = tid >> 6; const int gcol = ssd_gcol(grp, ch16);
    const int chn0 = grp * 256 + k * 64 + 4 * c;
    for (int ch = 0; ch < NCH; ++ch) {
        const size_t row0 = rowS + ch * RC;
        {   v4u raw[8];
            {   const bf16* gp = rb.xbcc + (row0 + rr) * 4096 + gcol;
#pragma unroll
                for (int i = 0; i < 8; ++i) { LAUNDER_PTR(gp); raw[i] = *(const v4u*)gp; gp += 8 * 4096; } }
            if (tid < 256) { sDt[tid] = rb.dtv[(row0 + (tid >> 2)) * 32 + grp * 4 + (tid & 3)]; sCum[tid] = rb.cum[(row0 + (tid >> 2)) * 32 + grp * 4 + (tid & 3)]; }
#pragma unroll
            for (int nt = 0; nt < 4; ++nt)
#pragma unroll
                for (int pt = 0; pt < 4; ++pt) { const f32x4 v = H[nt][pt];
                    *(LAS unsigned long long*)(hS + (4 * c + pt) * PQ + (16 * (4 * hf + nt) + 4 * g) * 2) = (unsigned long long)pk2(v[0], v[1]) | ((unsigned long long)pk2(v[2], v[3]) << 32); }
#pragma unroll
            for (int i = 0; i < 8; ++i) *(LAS v4u*)(T + (rr + 8 * i) * PR + ch16 * 16) = raw[i]; }
        sync_threads();
#pragma unroll 1
        for (int i2 = 0; i2 < 2; ++i2) {
            const int it = i2 ? 3 - hf : hf;
            unsigned long long zz[4];
#pragma unroll
            for (int r = 0; r < 4; ++r) zz[r] = *(const unsigned long long*)(rb.proj + (row0 + 16 * it + 4 * g + r) * LDP + PC_Z + chn0);
            f32x4 ya[4];
#pragma unroll
            for (int pt = 0; pt < 4; ++pt) ya[pt] = (f32x4){0.f, 0.f, 0.f, 0.f};
#pragma unroll
            for (int kn = 0; kn < 4; ++kn) { const bf16x8 Cf = frag_rows(sC, PR, 16 * it + c, 32 * kn + 8 * g);
#pragma unroll
                for (int pt = 0; pt < 4; ++pt) ya[pt] = mfma16(Cf, frag_rows(hS, PQ, 4 * c + pt, 32 * kn + 8 * g), ya[pt]);
                SCHED_FENCE(); }
            {   float ei[4];
#pragma unroll
                for (int r = 0; r < 4; ++r) ei[r] = __expf(sCum[(16 * it + 4 * g + r) * 4 + k]);
#pragma unroll
                for (int pt = 0; pt < 4; ++pt)
#pragma unroll
                    for (int r = 0; r < 4; ++r) ya[pt][r] *= ei[r]; }
            const float cum_i = sCum[(16 * it + c) * 4 + k];
            unsigned PT[4][2];
#pragma unroll
            for (int jt = 0; jt < 4; ++jt) {
                f32x4 acc = (f32x4){0.f, 0.f, 0.f, 0.f};
                if (jt <= it) {
#pragma unroll
                    for (int kn = 0; kn < 4; ++kn) acc = mfma16(frag_rows(sB, PR, 16 * jt + c, 32 * kn + 8 * g), frag_rows(sC, PR, 16 * it + c, 32 * kn + 8 * g), acc);
#pragma unroll
                    for (int r = 0; r < 4; ++r) { const int j = 16 * jt + 4 * g + r; const float df = cum_i - sCum[j * 4 + k]; const bool keep = (jt < it) || (4 * g + r <= c);
                        acc[r] = keep ? acc[r] * __expf(fminf(df, 0.f)) * sDt[j * 4 + k] : 0.f; }
                }
                PT[jt][0] = pk2(acc[0], acc[1]); PT[jt][1] = pk2(acc[2], acc[3]); SCHED_FENCE();
            }
#pragma unroll
            for (int ks = 0; ks < 2; ++ks) if (2 * ks <= it) {
                v4u pa = (v4u){PT[2 * ks][0], PT[2 * ks][1], PT[2 * ks + 1][0], PT[2 * ks + 1][1]};
                const bf16x8 A = __builtin_bit_cast(bf16x8, pa);
#pragma unroll
                for (int pt = 0; pt < 4; ++pt) ya[pt] = mfma16(A, frag_tr(T, PR, 32 * ks + 4 * g, 32 * ks + 16 + 4 * g, 64 * k + 16 * pt, lane), ya[pt]);
                SCHED_FENCE();
            }
#pragma unroll
            for (int r = 0; r < 4; ++r) { const int i = 16 * it + 4 * g + r; float s = 0.f; float yv[4];
#pragma unroll
                for (int pt = 0; pt < 4; ++pt) { const float xc = bf2f(*(const LAS bf16*)(T + i * PR + (64 * k + 16 * pt + c) * 2)); const float z = bf2f((bf16)(zz[r] >> (16 * pt)));
                    const bf16 yb = f2bf((ya[pt][r] + Dk * xc) * siluf_(z)); yv[pt] = bf2f(yb); s += yv[pt] * yv[pt]; }
                *(unsigned long long*)(rb.y + (row0 + i) * 2048 + chn0) = (unsigned long long)pk2(yv[0], yv[1]) | ((unsigned long long)pk2(yv[2], yv[3]) << 32);
                s += SHFL_XOR(s, 1); s += SHFL_XOR(s, 2); s += SHFL_XOR(s, 4); s += SHFL_XOR(s, 8);
                if (c == 0) red[i * 4 + k] = s; }
            SCHED_FENCE();
        }
        ssd_state_update(H, T, PR, T + 512, PR, sDt, sCum, w, lane);
        sync_threads();
        {   const f32x4 nw = *(const f32x4*)(ssm_norm + chn0);
            unsigned long long yy[8];
            const int itA = hf, itB = 3 - hf;
            bf16* yb0 = rb.y + (row0 + 16 * itA + 4 * g) * 2048 + chn0;
            const int jump = (16 * (itB - itA) - 3) * 2048;
            {   bf16* yp = yb0;
#pragma unroll
                for (int q = 0; q < 8; ++q) { LAUNDER_PTR(yp); yy[q] = *(const unsigned long long*)yp; yp += (q == 3) ? jump : 2048; } }
            bf16* yp = yb0;
#pragma unroll
            for (int q = 0; q < 8; ++q) { const int i = 16 * (q < 4 ? itA : itB) + 4 * g + (q & 3);
                const float rstd = rsqrtf(((red[i * 4] + red[i * 4 + 1]) + (red[i * 4 + 2] + red[i * 4 + 3])) * (1.f / 256.f) + EPS);
                const unsigned lo = (unsigned)yy[q], hi = (unsigned)(yy[q] >> 32);
                const float y0 = __uint_as_float(lo << 16) * rstd * nw[0], y1 = __uint_as_float(lo & 0xffff0000u) * rstd * nw[1], y2 = __uint_as_float(hi << 16) * rstd * nw[2], y3 = __uint_as_float(hi & 0xffff0000u) * rstd * nw[3];
                LAUNDER_PTR(yp); *(unsigned long long*)yp = (unsigned long long)pk2(y0, y1) | ((unsigned long long)pk2(y2, y3) << 32); yp += (q == 3) ? jump : 2048; } }
        sync_threads();
    }
    if (seg == NSEG - 1) { float* so = state_out_l + ((size_t)(b * 32 + head) * 64 + 4 * c) * 128 + 64 * hf + 4 * g;
#pragma unroll
        for (int pt = 0; pt < 4; ++pt)
#pragma unroll
            for (int nt = 0; nt < 4; ++nt) *(f32x4*)(so + pt * 128 + 16 * nt) = H[nt][pt]; }
}

__device__ __forceinline__ float row32_sum(float s) { s += SHFL_XOR(s, 1); s += SHFL_XOR(s, 2); s += SHFL_XOR(s, 4); s += SHFL_XOR(s, 8); s += SHFL_XOR(s, 16); return s; }

__device__ __forceinline__ void hgrn_sample_load(f32x4 (&st)[8], const float* state_in, int bh, int tid) {
    const float* sp = state_in + (size_t)bh * 16384 + tid * 4;
#pragma unroll
    for (int it = 0; it < 8; ++it) { LAUNDER_PTR(sp); st[it] = *(const f32x4*)sp; sp += 2048; }
}
__device__ __forceinline__ void hgrn_sample_step(const bf16* proj, const float* lbs_l, const float* hgn_l, const float* state_in, float* state_out, bf16* ohg, int bh, int tid, LAS unsigned char* lds,
                                                 f32x4 (&st)[8], int bh_next) {
    const int b = bh >> 3, h = bh & 7, lane = tid & 63, w = tid >> 6;
    LAS float* sq = (LAS float*)lds; LAS float* sg = sq + 128; LAS float* sk = sq + 256; LAS float* sv = sq + 384; LAS float* so = (LAS float*)(lds + 8192); LAS float* sred = (LAS float*)(lds + 16384);
    const size_t row = (size_t)MP + b;
    float ogv = 0.f, q_ = 0.f, f_ = 0.f, v_ = 0.f, lb_ = 0.f;
    if (tid < 128) { const bf16* pr = proj + row * LDP + h * 128; q_ = bf2f(pr[PC_Q + tid]); f_ = bf2f(pr[PC_F + tid]); lb_ = lbs_l[h * 128 + tid]; v_ = bf2f(pr[PC_I + hg_vpos(tid)]); ogv = bf2f(pr[PC_OG + tid]); }
    if (tid < 128) { const float fg = lb_ + (1.f - lb_) * sigmoidf_(f_);
        sq[tid] = siluf_(q_) * 0.08838834764831845f; sg[tid] = fg; sk[tid] = 1.f - fg; sv[tid] = v_; }
    sync_threads();
    const int dv4 = tid & 31, rg = tid >> 5;
    const f32x4 vv = *(const LAS f32x4*)(sv + 4 * dv4);
    f32x4 oacc = (f32x4){0.f, 0.f, 0.f, 0.f};
    float* op = state_out + (size_t)bh * 16384 + tid * 4;
    const float* np = state_in + (size_t)(bh_next >= 0 ? bh_next : bh) * 16384 + tid * 4;
#pragma unroll
    for (int it = 0; it < 8; ++it) { const int dk = it * 16 + rg; const f32x4 sn = st[it] * sg[dk] + vv * sk[dk]; LAUNDER_PTR(op); *(f32x4*)op = sn; op += 2048; oacc = oacc + sn * sq[dk];
        LAUNDER_PTR(np); if (bh_next >= 0) st[it] = *(const f32x4*)np; np += 2048; }
    *(LAS f32x4*)(so + rg * 128 + 4 * dv4) = oacc;
    sync_threads();
    if (tid < 128) { float o = 0.f;
#pragma unroll
        for (int r = 0; r < 16; ++r) o += so[r * 128 + tid];
        float ss = o * o; ss = row32_sum(ss);
        if ((lane & 31) == 0) sred[tid >> 5] = ss;
        sq[tid] = o; }
    sync_threads();
    if (tid < 128) { const float rstd = rsqrtf(((sred[0] + sred[1]) + (sred[2] + sred[3])) * (1.f / 128.f) + EPS);
        ohg[row * 1024 + h * 128 + tid] = f2bf(sq[tid] * rstd * hgn_l[tid] * siluf_(ogv)); }
    sync_threads();
    (void)w;
}

__device__ __forceinline__ void ssd_sample_load(f32x4 (&st)[16], const float* state_in, int bg, int tid) {
    const float* sp = state_in + ((size_t)((bg >> 3) * 32 + (bg & 7) * 4)) * 8192 + tid * 4;
#pragma unroll
    for (int it = 0; it < 16; ++it) { LAUNDER_PTR(sp); st[it] = *(const f32x4*)sp; sp += 2048; }
}
__device__ __forceinline__ void ssd_sample_step(const bf16* proj, const float* conv_w, const float* conv_b, const float* dt_bias, const float* a_log, const float* d_skip, const float* ssm_norm,
                                                const float* state_in, const float* conv_in, float* state_out, float* conv_out, bf16* ybuf, int bg, int tid, LAS unsigned char* lds,
                                                f32x4 (&st)[16], int bg_next) {
    const int b = bg >> 3, grp = bg & 7, lane = tid & 63, w = tid >> 6;
    LAS float* sx = (LAS float*)(lds + 2048); LAS float* sB = (LAS float*)(lds + 3072); LAS float* sC = (LAS float*)(lds + 3584); LAS float* sdt = (LAS float*)(lds + 4096); LAS float* sdec = (LAS float*)(lds + 4112);
    LAS float* sy = (LAS float*)(lds + 4608); LAS float* sred = (LAS float*)(lds + 16384);
    const size_t row = (size_t)MP + b;
    {
        const int chx = tid < 256 ? (grp * 256 + tid) : (tid < 384 ? (2048 + grp * 128 + (tid - 256)) : (3072 + grp * 128 + (tid - 384)));
        const float* ci = conv_in + (size_t)b * 3 * 4096; const float r0 = ci[chx], r1 = ci[4096 + chx], r2 = ci[8192 + chx];
        const float cur = bf2f(proj[row * LDP + PC_XBC + chx]);
        const float cw0 = conv_w[chx], cw1 = conv_w[4096 + chx], cw2 = conv_w[8192 + chx], cw3 = conv_w[12288 + chx], cbb = conv_b[chx];
        float dtr = 0.f, dtbv = 0.f, alg = 0.f; if (tid < 4) { const int head = grp * 4 + tid; dtr = bf2f(proj[row * LDP + PC_DT + head]); dtbv = dt_bias[head]; alg = a_log[head]; }
        const float a = cbb + cw0 * r0 + cw1 * r1 + cw2 * r2 + cw3 * cur;
        const float v = siluf_(a);
        if (tid < 256) sx[tid] = v; else if (tid < 384) sB[tid - 256] = v; else sC[tid - 384] = v;
        float* co = conv_out + (size_t)b * 3 * 4096; co[chx] = r1; co[4096 + chx] = r2; co[8192 + chx] = cur;
        if (tid < 4) { const float dv = softplusf_(dtr + dtbv); sdt[tid] = dv; sdec[tid] = __expf(dv * (-__expf(alg))); } }
    sync_threads();
    const int n4 = tid & 31, pr_ = tid >> 5;
    const f32x4 Bv = *(const LAS f32x4*)(sB + 4 * n4), Cv = *(const LAS f32x4*)(sC + 4 * n4);
    float* op = state_out + ((size_t)(b * 32 + grp * 4)) * 8192 + tid * 4;
    const int bgn = bg_next >= 0 ? bg_next : bg; const float* np = state_in + ((size_t)((bgn >> 3) * 32 + (bgn & 7) * 4)) * 8192 + tid * 4;
#pragma unroll
    for (int it = 0; it < 16; ++it) { const int k = it >> 2, p = (it & 3) * 16 + pr_; const float xdt = sx[k * 64 + p] * sdt[k];
        const f32x4 hn = st[it] * sdec[k] + Bv * xdt; LAUNDER_PTR(op); *(f32x4*)op = hn; op += 2048;
        LAUNDER_PTR(np); if (bg_next >= 0) st[it] = *(const f32x4*)np; np += 2048;
        const f32x4 t = hn * Cv; float y = (t[0] + t[1]) + (t[2] + t[3]); y = row32_sum(y);
        if ((lane & 31) == 0) sy[k * 64 + p] = y; }
    sync_threads();
    float yv = 0.f;
    if (tid < 256) { const int k = tid >> 6; const float z = bf2f(proj[row * LDP + PC_Z + grp * 256 + tid]);
        yv = (sy[tid] + d_skip[grp * 4 + k] * sx[tid]) * siluf_(z);
        float ss = yv * yv; ss = row32_sum(ss); if ((lane & 31) == 0) sred[tid >> 5] = ss; }
    sync_threads();
    if (tid < 256) { float tot = 0.f;
#pragma unroll
        for (int r = 0; r < 8; ++r) tot += sred[r];
        ybuf[row * 2048 + grp * 256 + tid] = f2bf(yv * rsqrtf(tot * (1.f / 256.f) + EPS) * ssm_norm[grp * 256 + tid]); }
    sync_threads();
    (void)w;
}

static_assert(SD_END <= LDS_BYTES - 256, "LDS map");
static_assert(8 * 16384 <= LDS_BYTES - 256, "skinny LDS");
constexpr int SK_PART = 128 * 32 * 4;
template <int RT, class Epi>
__device__ __forceinline__ void skinny_gemm(const bf16* A, size_t lda, const bf16* Bt, int K, int N, const Epi& epi, int wg, int wg_first, int wg_count, int tid, LAS unsigned char* lds) {
    const int lane = tid & 63, w = tid >> 6, c = lane & 15, g = lane >> 4;
    constexpr int NRG = 8 / RT;
    const int nunit = (N / 32) * NRG, ksteps = K / 256;
    int me = wg - wg_first; if (me < 0 || me >= wg_count) return;
    for (int s = me; s < nunit; s += wg_count) {
        const int n0 = 32 * (s / NRG), r0 = (s % NRG) * (16 * RT);
        f32x4 acc[RT][2];
#pragma unroll
        for (int rt = 0; rt < RT; ++rt) { acc[rt][0] = (f32x4){0.f, 0.f, 0.f, 0.f}; acc[rt][1] = (f32x4){0.f, 0.f, 0.f, 0.f}; }
        const bf16* ap = A + (size_t)(r0 + c) * lda + (size_t)w * (K / 8) + 8 * g;
        const bf16* bp = Bt + (size_t)(n0 + c) * K + (size_t)w * (K / 8) + 8 * g;
#pragma unroll 4
        for (int ks = 0; ks < ksteps; ++ks) {
            bf16x8 af[RT], bfr[2];
#pragma unroll
            for (int rt = 0; rt < RT; ++rt) af[rt] = *(const bf16x8*)(ap + (size_t)(16 * rt) * lda + 32 * ks);
            bfr[0] = *(const bf16x8*)(bp + 32 * ks); bfr[1] = *(const bf16x8*)(bp + (size_t)16 * K + 32 * ks);
#pragma unroll
            for (int rt = 0; rt < RT; ++rt) { acc[rt][0] = mfma16(af[rt], bfr[0], acc[rt][0]); acc[rt][1] = mfma16(af[rt], bfr[1], acc[rt][1]); }
        }
        LAS float* part = (LAS float*)(lds + w * SK_PART);
#pragma unroll
        for (int rt = 0; rt < RT; ++rt)
#pragma unroll
            for (int nt = 0; nt < 2; ++nt)
#pragma unroll
                for (int r = 0; r < 4; ++r) part[(16 * rt + 4 * g + r) * 32 + 16 * nt + c] = acc[rt][nt][r];
        sync_threads();
        if (RT == 8 || tid < 64 * RT) {
            const int row = tid >> 2, c8 = (tid & 3) * 8;
            f32x4 v0 = (f32x4){0.f, 0.f, 0.f, 0.f}, v1 = (f32x4){0.f, 0.f, 0.f, 0.f};
#pragma unroll
            for (int ww = 0; ww < 8; ++ww) { const LAS float* pp = (const LAS float*)(lds + ww * SK_PART) + row * 32 + c8; v0 = v0 + *(const LAS f32x4*)pp; v1 = v1 + *(const LAS f32x4*)(pp + 4); }
            epi(r0 + row, n0 + c8, v0, v1);
        }
        sync_threads();
    }
}
struct SkStoreBf16 { bf16* O; int ld; int act;
    __device__ __forceinline__ void operator()(int row, int col, f32x4 v0, f32x4 v1) const {
        if (act) {
#pragma unroll
            for (int j = 0; j < 4; ++j) { const float a = fmaxf(v0[j], 0.f), b = fmaxf(v1[j], 0.f); v0[j] = a * a; v1[j] = b * b; } }
        v4u o; o.x = pk2(v0[0], v0[1]); o.y = pk2(v0[2], v0[3]); o.z = pk2(v1[0], v1[1]); o.w = pk2(v1[2], v1[3]);
        *(v4u*)(O + (size_t)row * ld + col) = o; } };
__device__ __forceinline__ void sk_unpack8(const v4u w, f32x4& lo, f32x4& hi) {
    lo = (f32x4){__uint_as_float(w.x << 16), __uint_as_float(w.x & 0xffff0000u), __uint_as_float(w.y << 16), __uint_as_float(w.y & 0xffff0000u)};
    hi = (f32x4){__uint_as_float(w.z << 16), __uint_as_float(w.z & 0xffff0000u), __uint_as_float(w.w << 16), __uint_as_float(w.w & 0xffff0000u)}; }
struct SkGateA { bf16* T; const bf16* G; int ldg; const float* bm;
    __device__ __forceinline__ void operator()(int row, int col, f32x4 v0, f32x4 v1) const {
        f32x4 g0, g1; sk_unpack8(*(const v4u*)(G + (size_t)row * ldg + col), g0, g1);
        const f32x4 b0 = *(const f32x4*)(bm + col), b1 = *(const f32x4*)(bm + col + 4);
#pragma unroll
        for (int j = 0; j < 4; ++j) { v0[j] *= sigmoidf_(g0[j] + b0[j]); v1[j] *= sigmoidf_(g1[j] + b1[j]); }
        v4u o; o.x = pk2(v0[0], v0[1]); o.y = pk2(v0[2], v0[3]); o.z = pk2(v1[0], v1[1]); o.w = pk2(v1[2], v1[3]);
        *(v4u*)(T + (size_t)row * 1024 + col) = o; } };
struct SkGateB { const bf16* T; bf16* U; const bf16* G; int ldg; const float* bm;
    __device__ __forceinline__ void operator()(int row, int col, f32x4 v0, f32x4 v1) const {
        f32x4 g0, g1; sk_unpack8(*(const v4u*)(G + (size_t)row * ldg + col), g0, g1);
        const f32x4 b0 = *(const f32x4*)(bm + col), b1 = *(const f32x4*)(bm + col + 4);
        f32x4 t0, t1; sk_unpack8(*(const v4u*)(T + (size_t)row * 1024 + col), t0, t1);
#pragma unroll
        for (int j = 0; j < 4; ++j) { v0[j] = t0[j] + v0[j] * sigmoidf_(g0[j] + b0[j]); v1[j] = t1[j] + v1[j] * sigmoidf_(g1[j] + b1[j]); }
        v4u o; o.x = pk2(v0[0], v0[1]); o.y = pk2(v0[2], v0[3]); o.z = pk2(v1[0], v1[1]); o.w = pk2(v1[2], v1[3]);
        *(v4u*)(U + (size_t)row * 1024 + col) = o; } };
struct SkRes { bf16* X; const float* gate; int ldgate;
    __device__ __forceinline__ void operator()(int row, int col, f32x4 v0, f32x4 v1) const {
        const float* gp = gate + (size_t)row * ldgate + col; bf16* xp = X + (size_t)row * 1024 + col;
        f32x4 x0, x1; sk_unpack8(*(const v4u*)xp, x0, x1);
        const f32x4 o0 = x0 + *(const f32x4*)gp * v0, o1 = x1 + *(const f32x4*)(gp + 4) * v1;
        v4u o; o.x = pk2(o0[0], o0[1]); o.y = pk2(o0[2], o0[3]); o.z = pk2(o1[0], o1[1]); o.w = pk2(o1[2], o1[3]); *(v4u*)xp = o; } };

template <int TB>
__device__ __forceinline__ void hgrn_seq(const bf16* proj, const float* lbs_l, const float* hgn_l, const float* state_in, float* state_out, bf16* ohg, int row_base, int T, int bh, int tid,
                                         LAS unsigned char* smem) {
    const int b = bh >> 3, h = bh & 7, lane = tid & 63, wv = tid >> 6;
    typedef float (LAS * arr_t)[128];
    arr_t sQ = (arr_t)(smem), sG = (arr_t)(smem + TB * 512), sK = (arr_t)(smem + 2 * TB * 512);
    LAS float* sRed = (LAS float*)(smem + 3 * TB * 512);
    float S[128];
    if (state_in) {
        const float* sp = state_in + (size_t)bh * 16384 + tid;
#pragma unroll
        for (int c = 0; c < 16; ++c) { asm volatile("" : "+v"(sp));
#pragma unroll
            for (int j = 0; j < 8; ++j) S[c * 8 + j] = sp[j * 128];
            sp += 1024; }
    } else {
#pragma unroll
        for (int d = 0; d < 128; ++d) S[d] = 0.f;
    }
    const float lb = lbs_l[h * 128 + tid], hn = hgn_l[tid];
    for (int t0 = 0; t0 < T; t0 += TB) {
        float v[TB], og[TB], o[TB];
#pragma unroll
        for (int tt = 0; tt < TB; ++tt) { v[tt] = 0.f; og[tt] = 0.f;
            if (t0 + tt < T) { const bf16* pr = proj + (size_t)(row_base + b * T + t0 + tt) * LDP + h * 128 + tid;
                const float q = bf2f(pr[PC_Q]), f = bf2f(pr[PC_F]); v[tt] = bf2f(pr[PC_I + hg_vpos(tid) - tid]); og[tt] = bf2f(pr[PC_OG]);
                const float fg = lb + (1.f - lb) * sigmoidf_(f);
                sQ[tt][tid] = siluf_(q) * 0.08838834764831845f; sG[tt][tid] = fg; sK[tt][tid] = 1.f - fg; } }
        __syncthreads();
#pragma unroll
        for (int tt = 0; tt < TB; ++tt) { float acc = 0.f;
            if (t0 + tt < T) { const float vv = v[tt];
#pragma unroll
                for (int d4 = 0; d4 < 32; ++d4) { const f32x4 g = *(const LAS f32x4*)&sG[tt][d4 * 4], k = *(const LAS f32x4*)&sK[tt][d4 * 4], q = *(const LAS f32x4*)&sQ[tt][d4 * 4];
                    S[d4 * 4 + 0] = g.x * S[d4 * 4 + 0] + k.x * vv; acc += q.x * S[d4 * 4 + 0];
                    S[d4 * 4 + 1] = g.y * S[d4 * 4 + 1] + k.y * vv; acc += q.y * S[d4 * 4 + 1];
                    S[d4 * 4 + 2] = g.z * S[d4 * 4 + 2] + k.z * vv; acc += q.z * S[d4 * 4 + 2];
                    S[d4 * 4 + 3] = g.w * S[d4 * 4 + 3] + k.w * vv; acc += q.w * S[d4 * 4 + 3]; } }
            o[tt] = acc;
            const float ss = wave_sum(acc * acc); if (lane == 0) sRed[tt * 2 + wv] = ss; }
        __syncthreads();
#pragma unroll
        for (int tt = 0; tt < TB; ++tt) if (t0 + tt < T) { const float rstd = rsqrtf((sRed[tt * 2] + sRed[tt * 2 + 1]) * (1.f / 128.f) + EPS);
            ohg[(size_t)(row_base + b * T + t0 + tt) * 1024 + h * 128 + tid] = f2bf(o[tt] * rstd * hn * siluf_(og[tt])); }
        __syncthreads();
    }
    { float* sp = state_out + (size_t)bh * 16384 + tid;
#pragma unroll
      for (int c = 0; c < 16; ++c) { asm volatile("" : "+v"(sp));
#pragma unroll
          for (int j = 0; j < 8; ++j) sp[j * 128] = S[c * 8 + j];
          sp += 1024; } }
}

template <int TB>
__device__ __forceinline__ void ssd_seq(const bf16* proj, const float* conv_w, const float* conv_b, const float* dt_bias, const float* a_log, const float* d_skip, const float* ssm_norm,
                                        const float* state_in, const float* conv_in, float* state_out, float* conv_out, bf16* ybuf, int row_base, int T, int bg, int tid, LAS unsigned char* smem) {
    const int b = bg >> 3, g = bg & 7, lane = tid & 63, wv = tid >> 6, head = g * 4 + wv;
    const int ch_x = g * 256 + tid, ch_bc = tid < 128 ? (2048 + g * 128 + tid) : (3072 + g * 128 + (tid - 128));
    typedef float (LAS * arr_t)[128];
    arr_t sB = (arr_t)(smem), sC = (arr_t)(smem + TB * 512);
    LAS float* sRed = (LAS float*)(smem + 2 * TB * 512);
    const float wx0 = conv_w[0 * 4096 + ch_x], wx1 = conv_w[1 * 4096 + ch_x], wx2 = conv_w[2 * 4096 + ch_x], wx3 = conv_w[3 * 4096 + ch_x], bx = conv_b[ch_x];
    const float wb0 = conv_w[0 * 4096 + ch_bc], wb1 = conv_w[1 * 4096 + ch_bc], wb2 = conv_w[2 * 4096 + ch_bc], wb3 = conv_w[3 * 4096 + ch_bc], bb = conv_b[ch_bc];
    float rx0 = 0.f, rx1 = 0.f, rx2 = 0.f, rb0 = 0.f, rb1 = 0.f, rb2 = 0.f;
    if (conv_in) { const float* ci = conv_in + (size_t)b * 3 * 4096; rx0 = ci[ch_x]; rx1 = ci[4096 + ch_x]; rx2 = ci[8192 + ch_x]; rb0 = ci[ch_bc]; rb1 = ci[4096 + ch_bc]; rb2 = ci[8192 + ch_bc]; }
    float hs[128];
    const size_t sbase = (((size_t)b * 32 + head) * 64 + lane) * 128;
    if (state_in) {
#pragma unroll
        for (int n4 = 0; n4 < 32; ++n4) { const f32x4 t = *(const f32x4*)(state_in + sbase + n4 * 4); hs[n4 * 4] = t.x; hs[n4 * 4 + 1] = t.y; hs[n4 * 4 + 2] = t.z; hs[n4 * 4 + 3] = t.w; }
    } else {
#pragma unroll
        for (int n = 0; n < 128; ++n) hs[n] = 0.f;
    }
    const float A = -expf(a_log[head]), dtb = dt_bias[head], Dk = d_skip[head], nw = ssm_norm[ch_x];
    for (int t0 = 0; t0 < T; t0 += TB) {
        float xc[TB], dtv[TB], dec[TB], zz[TB], yv[TB];
#pragma unroll
        for (int tt = 0; tt < TB; ++tt) { xc[tt] = 0.f; dtv[tt] = 0.f; dec[tt] = 1.f; zz[tt] = 0.f;
            if (t0 + tt < T) { const bf16* pr = proj + (size_t)(row_base + b * T + t0 + tt) * LDP;
                const float cx = bf2f(pr[PC_XBC + ch_x]), cb = bf2f(pr[PC_XBC + ch_bc]);
                const float ax = bx + wx0 * rx0 + wx1 * rx1 + wx2 * rx2 + wx3 * cx; rx0 = rx1; rx1 = rx2; rx2 = cx; xc[tt] = siluf_(ax);
                const float ab = bb + wb0 * rb0 + wb1 * rb1 + wb2 * rb2 + wb3 * cb; rb0 = rb1; rb1 = rb2; rb2 = cb;
                const float sbv = siluf_(ab); if (tid < 128) sB[tt][tid] = sbv; else sC[tt][tid - 128] = sbv;
                const float dv = softplusf_(bf2f(pr[PC_DT + head]) + dtb); dtv[tt] = dv; dec[tt] = __expf(dv * A); zz[tt] = bf2f(pr[PC_Z + ch_x]); } }
        __syncthreads();
#pragma unroll
        for (int tt = 0; tt < TB; ++tt) { float y = 0.f;
            if (t0 + tt < T) { const float xdt = xc[tt] * dtv[tt], dc = dec[tt];
#pragma unroll
                for (int n4 = 0; n4 < 32; ++n4) { const f32x4 bv = *(const LAS f32x4*)&sB[tt][n4 * 4], cv = *(const LAS f32x4*)&sC[tt][n4 * 4];
                    hs[n4 * 4 + 0] = dc * hs[n4 * 4 + 0] + xdt * bv.x; y += hs[n4 * 4 + 0] * cv.x;
                    hs[n4 * 4 + 1] = dc * hs[n4 * 4 + 1] + xdt * bv.y; y += hs[n4 * 4 + 1] * cv.y;
                    hs[n4 * 4 + 2] = dc * hs[n4 * 4 + 2] + xdt * bv.z; y += hs[n4 * 4 + 2] * cv.z;
                    hs[n4 * 4 + 3] = dc * hs[n4 * 4 + 3] + xdt * bv.w; y += hs[n4 * 4 + 3] * cv.w; }
                y = (y + Dk * xc[tt]) * siluf_(zz[tt]); }
            yv[tt] = y;
            const float ss = wave_sum(y * y); if (lane == 0) sRed[tt * 4 + wv] = ss; }
        __syncthreads();
#pragma unroll
        for (int tt = 0; tt < TB; ++tt) if (t0 + tt < T) { const float rstd = rsqrtf(((sRed[tt * 4] + sRed[tt * 4 + 1]) + (sRed[tt * 4 + 2] + sRed[tt * 4 + 3])) * (1.f / 256.f) + EPS);
            ybuf[(size_t)(row_base + b * T + t0 + tt) * 2048 + ch_x] = f2bf(yv[tt] * rstd * nw); }
        __syncthreads();
    }
#pragma unroll
    for (int n4 = 0; n4 < 32; ++n4) *(f32x4*)(state_out + sbase + n4 * 4) = (f32x4){hs[n4 * 4], hs[n4 * 4 + 1], hs[n4 * 4 + 2], hs[n4 * 4 + 3]};
    float* co = conv_out + (size_t)b * 3 * 4096;
    co[ch_x] = rx0; co[4096 + ch_x] = rx1; co[8192 + ch_x] = rx2; co[ch_bc] = rb0; co[4096 + ch_bc] = rb1; co[8192 + ch_bc] = rb2;
}

#ifndef REP_G
#define REP_G 1
#endif
#ifndef REP_R2
#define REP_R2 1
#endif
#ifndef REP_R1
#define REP_R1 1
#endif
#ifndef REP_N
#define REP_N 1
#endif
#ifndef REP_P
#define REP_P 1
#endif
#ifndef REP_H2
#define REP_H2 1
#endif
#ifndef REP_S2
#define REP_S2 1
#endif
#ifndef REP_S1
#define REP_S1 1
#endif
#ifndef REP_SS
#define REP_SS 1
#endif
#ifndef REP_BAR
#define REP_BAR 0
#endif
__device__ __forceinline__ void phase_recur1(const P& p, int l, LAS unsigned char* lds, int tid_in, int skip_hgrn1) {
    unsigned char* ws = p.ws; asm volatile("" : "+s"(ws)); int tid_ = tid_in; asm volatile("" : "+v"(tid_)); const int tid = tid_, G = gridDim.x, wg = blockIdx.x;
    RecurBufs rb{(bf16*)(ws + WS_PROJ), (bf16*)(ws + WS_XBCC), (float*)(ws + WS_DTV), (float*)(ws + WS_CUM), (float*)(ws + WS_CV), (float*)(ws + WS_SSEG), (float*)(ws + WS_DSEG),
                 (float*)(ws + WS_HSEG), (float*)(ws + WS_TSEG), (bf16*)(ws + WS_OHG), (bf16*)(ws + WS_Y)};
    const float* lbs_l = (const float*)(ws + WS_LBS) + l * 1024; float* out = p.out;
    const float* hgn = p.in[I_HGN] + l * HG_DV;
    const float* cw = p.in[I_CONVW] + (size_t)l * 4 * SSM_CH; const float* cb = p.in[I_CONVB] + l * SSM_CH; const float* dtb = p.in[I_DTB] + l * SSM_HEADS;
    const float* alog = p.in[I_ALOG] + l * SSM_HEADS; const float* dsk = p.in[I_DSKIP] + l * SSM_HEADS; const float* ssmn = p.in[I_SSMN] + l * SSM_INNER;
#define TID_L() int tl_ = tid; asm volatile("" : "+v"(tl_)); const int t = tl_
#define R1_HG() do { if (!skip_hgrn1) for (int u = wg; u < 256; u += G) { TID_L(); hgrn_pass1(rb, lbs_l, u, t, lds); } } while (0)
#define R1_SD() do { for (int rep = 0; rep < REP_S1; ++rep) for (int u = wg; u < 256; u += G) { TID_L(); ssd_pass1(rb, cw, cb, dtb, alog, out + O_CVP + (size_t)l * NB * 3 * SSM_CH, u, t, lds); } } while (0)
#define R1_SAMPLE() do { for (int rep = 0; rep < REP_SS; ++rep) { \
        {   const float* shg = p.in[I_SHG] + (size_t)l * NSB * HG_H * HG_DK * HG_DV; f32x4 sa[8];        \
            if (wg < NSB * HG_H) { TID_L(); hgrn_sample_load(sa, shg, wg, t); } \
            for (int u = wg; u < NSB * HG_H; u += G) { TID_L(); const int un = u + G < NSB * HG_H ? u + G : -1; \
                hgrn_sample_step(rb.proj, lbs_l, hgn, shg, out + O_HGS + (size_t)l * NSB * HG_H * HG_DK * HG_DV, rb.ohg, u, t, lds, sa, un); } } \
        {   const float* sss = p.in[I_SSSM] + (size_t)l * NSB * SSM_HEADS * SSM_P * SSM_N; f32x4 sa[16]; \
            if (wg < NSB * SSM_G) { TID_L(); ssd_sample_load(sa, sss, wg, t); } \
            for (int u = wg; u < NSB * SSM_G; u += G) { TID_L(); const int un = u + G < NSB * SSM_G ? u + G : -1; \
                ssd_sample_step(rb.proj, cw, cb, dtb, alog, dsk, ssmn, sss, p.in[I_SCONV] + (size_t)l * NSB * 3 * SSM_CH, \
                                out + O_SSMS + (size_t)l * NSB * SSM_HEADS * SSM_P * SSM_N, out + O_CVS + (size_t)l * NSB * 3 * SSM_CH, rb.y, u, t, lds, sa, un); } } } } while (0)
    if (((wg >> 3) & 1) == 0) { R1_HG(); R1_SAMPLE(); R1_SD(); } else { R1_SD(); R1_HG(); R1_SAMPLE(); }
#undef R1_HG
#undef R1_SD
#undef R1_SAMPLE
}
__device__ __forceinline__ void phase_recur2(const P& p, int l, LAS unsigned char* lds, int tid_in) {
    unsigned char* ws = p.ws; asm volatile("" : "+s"(ws)); int tid_ = tid_in; asm volatile("" : "+v"(tid_)); const int tid = tid_, G = gridDim.x, wg = blockIdx.x;
    RecurBufs rb{(bf16*)(ws + WS_PROJ), (bf16*)(ws + WS_XBCC), (float*)(ws + WS_DTV), (float*)(ws + WS_CUM), (float*)(ws + WS_CV), (float*)(ws + WS_SSEG), (float*)(ws + WS_DSEG),
                 (float*)(ws + WS_HSEG), (float*)(ws + WS_TSEG), (bf16*)(ws + WS_OHG), (bf16*)(ws + WS_Y)};
    float* out = p.out;
    for (int rep = 0; rep < REP_H2; ++rep) for (int u = wg; u < 256; u += G) { TID_L(); hgrn_pass2(rb, p.in[I_HGN] + l * HG_DV, out + O_HGP + (size_t)l * NB * HG_H * HG_DK * HG_DV, u, t, lds); }
    for (int rep = 0; rep < REP_S2; ++rep) for (int u = wg; u < 256; u += G) { TID_L(); ssd_pass2(rb, p.in[I_DSKIP] + l * SSM_HEADS, p.in[I_SSMN] + l * SSM_INNER, out + O_SSMP + (size_t)l * NB * SSM_HEADS * SSM_P * SSM_N, u ^ 3, t, lds); }
}


constexpr int CW_BAR = 4096;
constexpr int MISC_OFF = LDS_BYTES - 256;

__global__ __launch_bounds__(NTHREADS, 2) void k_mega(P p) {
    extern __shared__ __attribute__((aligned(16))) unsigned char shm[];
    LAS unsigned char* lds = (LAS unsigned char*)shm;
    const int wave_u = __builtin_amdgcn_readfirstlane((int)threadIdx.x >> 6);
#define TID() ({ int t__; asm volatile("v_mbcnt_lo_u32_b32 %0, -1, 0\n\tv_mbcnt_hi_u32_b32 %0, -1, %0" : "=v"(t__)); (wave_u << 6) | t__; })
    const int G = gridDim.x, NGW = G * NWAVES;
    unsigned char* ws = p.ws;
#define LANE_GW() int t_ = TID(); asm volatile("" : "+v"(t_)); const int ln = t_ & 63, wv = __builtin_amdgcn_readfirstlane(t_ >> 6), gwv = blockIdx.x * NWAVES + wv; (void)wv
    volatile LAS unsigned* MISC = (volatile LAS unsigned*)(lds + MISC_OFF);
    if (TID() < 16) MISC[TID()] = 0u;
    __syncthreads();
    XcdBarrier bar = xcd_barrier_post((unsigned*)(ws + WS_CTL) + CW_BAR, MISC + 8, TID());
#define WSL() ({ unsigned char* w_ = ws; asm volatile("" : "+s"(w_)); w_; })

    for (int rep = 0; rep < REP_P; ++rep) {   LANE_GW(); phase_prologue(p, lds, gwv, NGW, ln, wv); }
    xcd_barrier(bar, TID());
    {   unsigned char* w = WSL();
        pg8::Gemm g{(const bf16*)(w + WS_AC), (const bf16*)(w + WS_WADA), 256, MODLD, D}; pg8::StaticOrder S; S.init(256, MODLD, G, (int)blockIdx.x);
        pg8::EpiF32 E{(float*)(w + WS_MOD), MODLD, p.in[I_BADA]};
        pg8::gemm_phase<pg8::EpiF32, pg8::StaticOrder>(lds, g, S, E, nullptr, TID()); }
    xcd_barrier(bar, TID());
    for (int li = 0; li < DEPTH; ++li) {
        int l = li; asm volatile("" : "+s"(l));
        for (int rep = 0; rep < REP_N; ++rep) {   unsigned char* w = WSL(); const float* mod_l = (const float*)(w + WS_MOD) + (size_t)l * NADA * D;
            LANE_GW();
            if (l == 0) phase_norm<1>(p.in[I_XP], p.in[I_XS], (bf16*)(w + WS_X), (bf16*)(w + WS_H), p.in[I_NMIX] + l * D, mod_l + 0 * D, mod_l + 1 * D, gwv, NGW, ln);
            else phase_norm<0>(nullptr, nullptr, (bf16*)(w + WS_X), (bf16*)(w + WS_H), p.in[I_NMIX] + l * D, mod_l + 0 * D, mod_l + 1 * D, gwv, NGW, ln); }
        xcd_barrier(bar, TID());
        for (int rep = 0; rep < REP_G; ++rep) { if (rep) xcd_barrier(bar, TID());
        {   unsigned char* w = WSL(); const unsigned char* wl = w + WS_W + (size_t)l * W_LSTRIDE;
            pg8::Gemm g{(const bf16*)(w + WS_H), (const bf16*)(wl + WO_IN), MP, LDP, D}; pg8::StaticOrder S; S.init(MP, LDP, G, (int)blockIdx.x);
            pg8::EpiBf16<0> E{(bf16*)(w + WS_PROJ), LDP};
            pg8::gemm_phase<pg8::EpiBf16<0>, pg8::StaticOrder>(lds, g, S, E, nullptr, TID());
            const int skf = G > 64 ? 64 : 0, skn = G > 64 ? G - 64 : G; skinny_gemm<8>((const bf16*)(w + WS_H) + (size_t)MP * D, D, (const bf16*)(wl + WO_IN), D, LDP, SkStoreBf16{(bf16*)(w + WS_PROJ) + (size_t)MP * LDP, LDP, 0}, (int)blockIdx.x, skf, skn, TID(), lds); } }
        xcd_barrier(bar, TID());
        for (int rep = 0; rep < REP_BAR; ++rep) xcd_barrier(bar, TID());
        phase_recur1(p, l, lds, TID(), 0);
        for (int rep = 1; rep < REP_R1; ++rep) { xcd_barrier(bar, TID()); phase_recur1(p, l, lds, TID(), 1); }
        xcd_barrier(bar, TID());
        for (int rep = 0; rep < REP_R2; ++rep) { if (rep) xcd_barrier(bar, TID()); phase_recur2(p, l, lds, TID()); }
        xcd_barrier(bar, TID());
        for (int rep = 0; rep < REP_G; ++rep) { if (rep) xcd_barrier(bar, TID());
        {   unsigned char* w = WSL(); const unsigned char* wl = w + WS_W + (size_t)l * W_LSTRIDE;
            pg8::Gemm g{(const bf16*)(w + WS_OHG), (const bf16*)(wl + WO_BRA), MP, D, 1024}; pg8::StaticOrder S; S.init(MP, D, G, (int)blockIdx.x);
            pg8::EpiGateA E{(bf16*)(w + WS_T), (const bf16*)(w + WS_PROJ) + PC_GA, LDP, p.in[I_BMERGE] + l * 2048};
            pg8::gemm_phase<pg8::EpiGateA, pg8::StaticOrder>(lds, g, S, E, nullptr, TID());
            skinny_gemm<1>((const bf16*)(w + WS_OHG) + (size_t)MP * D, D, (const bf16*)(wl + WO_BRA), 1024, D, SkGateA{(bf16*)(w + WS_T) + (size_t)MP * D, (const bf16*)(w + WS_PROJ) + (size_t)MP * LDP + PC_GA, LDP, p.in[I_BMERGE] + l * 2048}, (int)blockIdx.x, 0, G, TID(), lds); } }
        asm volatile("s_waitcnt vmcnt(0)" ::: "memory"); __syncthreads();
        for (int rep = 0; rep < REP_G; ++rep) { if (rep) xcd_barrier(bar, TID());
        {   unsigned char* w = WSL(); const unsigned char* wl = w + WS_W + (size_t)l * W_LSTRIDE;
            pg8::Gemm g{(const bf16*)(w + WS_Y), (const bf16*)(wl + WO_BRB), MP, D, 2048}; pg8::StaticOrder S; S.init(MP, D, G, (int)blockIdx.x);
            pg8::EpiGateB E{(const bf16*)(w + WS_T), (bf16*)(w + WS_U), (const bf16*)(w + WS_PROJ) + PC_GB, LDP, p.in[I_BMERGE] + l * 2048 + 1024};
            pg8::gemm_phase<pg8::EpiGateB, pg8::StaticOrder>(lds, g, S, E, nullptr, TID());
            skinny_gemm<1>((const bf16*)(w + WS_Y) + (size_t)MP * 2048, 2048, (const bf16*)(wl + WO_BRB), 2048, D, SkGateB{(const bf16*)(w + WS_T) + (size_t)MP * D, (bf16*)(w + WS_U) + (size_t)MP * D, (const bf16*)(w + WS_PROJ) + (size_t)MP * LDP + PC_GB, LDP, p.in[I_BMERGE] + l * 2048 + 1024}, (int)blockIdx.x, 0, G, TID(), lds); } }
        xcd_barrier(bar, TID());
        {   unsigned char* w = WSL(); const unsigned char* wl = w + WS_W + (size_t)l * W_LSTRIDE; const float* mod_l = (const float*)(w + WS_MOD) + (size_t)l * NADA * D;
            pg8::Gemm g{(const bf16*)(w + WS_U), (const bf16*)(wl + WO_OUT), MP, D, 1024}; pg8::StaticOrder S; S.init(MP, D, G, (int)blockIdx.x);
            pg8::EpiRes E{(bf16*)(w + WS_X), mod_l + 2 * D, MODLD};
            pg8::gemm_phase<pg8::EpiRes, pg8::StaticOrder>(lds, g, S, E, nullptr, TID());
            skinny_gemm<1>((const bf16*)(w + WS_U) + (size_t)MP * D, D, (const bf16*)(wl + WO_OUT), 1024, D, SkRes{(bf16*)(w + WS_X) + (size_t)MP * D, mod_l + (size_t)NB * MODLD + 2 * D, MODLD}, (int)blockIdx.x, 0, G, TID(), lds); }
        xcd_barrier(bar, TID());
        for (int rep = 0; rep < REP_N; ++rep) {   unsigned char* w = WSL(); const float* mod_l = (const float*)(w + WS_MOD) + (size_t)l * NADA * D;
            LANE_GW(); phase_norm<0>(nullptr, nullptr, (bf16*)(w + WS_X), (bf16*)(w + WS_H), p.in[I_NMLP] + l * D, mod_l + 3 * D, mod_l + 4 * D, gwv, NGW, ln); }
        xcd_barrier(bar, TID());
        for (int rep = 0; rep < REP_G; ++rep) { if (rep) xcd_barrier(bar, TID());
        {   unsigned char* w = WSL(); const unsigned char* wl = w + WS_W + (size_t)l * W_LSTRIDE;
            pg8::Gemm g{(const bf16*)(w + WS_H), (const bf16*)(wl + WO_UP), MP, DFF, 1024}; pg8::StaticOrder S; S.init(MP, DFF, G, (int)blockIdx.x);
            pg8::EpiBf16<1> E{(bf16*)(w + WS_UP), DFF};
            pg8::gemm_phase<pg8::EpiBf16<1>, pg8::StaticOrder>(lds, g, S, E, nullptr, TID());
            skinny_gemm<4>((const bf16*)(w + WS_H) + (size_t)MP * D, D, (const bf16*)(wl + WO_UP), 1024, DFF, SkStoreBf16{(bf16*)(w + WS_UP) + (size_t)MP * DFF, DFF, 1}, (int)blockIdx.x, 0, G, TID(), lds); } }
        xcd_barrier(bar, TID());
        {   unsigned char* w = WSL(); const unsigned char* wl = w + WS_W + (size_t)l * W_LSTRIDE; const float* mod_l = (const float*)(w + WS_MOD) + (size_t)l * NADA * D;
            pg8::Gemm g{(const bf16*)(w + WS_UP), (const bf16*)(wl + WO_DOWN), MP, D, DFF}; pg8::StaticOrder S; S.init(MP, D, G, (int)blockIdx.x);
            pg8::EpiRes E{(bf16*)(w + WS_X), mod_l + 5 * D, MODLD};
            pg8::gemm_phase<pg8::EpiRes, pg8::StaticOrder>(lds, g, S, E, nullptr, TID());
            skinny_gemm<1>((const bf16*)(w + WS_UP) + (size_t)MP * DFF, DFF, (const bf16*)(wl + WO_DOWN), DFF, D, SkRes{(bf16*)(w + WS_X) + (size_t)MP * D, mod_l + (size_t)NB * MODLD + 5 * D, MODLD}, (int)blockIdx.x, 0, G, TID(), lds); }
        xcd_barrier(bar, TID());
    }
    {   unsigned char* w = WSL(); LANE_GW(); phase_final((const bf16*)(w + WS_X), p.out + O_YP, p.in[I_NFIN], gwv, NGW, ln); }
}

extern "C" void kernel_launch(void* const* d_in, const int* in_sizes, int n_in, void* d_out, int out_size, void* d_ws, size_t ws_size, hipStream_t stream) {
    static int grid = 0;
    if (grid == 0) {
        if (n_in != N_IN || (size_t)out_size != O_END || ws_size < WS_END) { fprintf(stderr, "kernel_launch: unexpected sizes n_in %d out %d ws %zu\n", n_in, out_size, ws_size); grid = -1; return; }
        int dev = 0, cus = 0, per_cu = 0;
        if (hipGetDevice(&dev) != hipSuccess || hipDeviceGetAttribute(&cus, hipDeviceAttributeMultiprocessorCount, dev) != hipSuccess) { grid = -1; return; }
        if (hipFuncSetAttribute((const void*)k_mega, hipFuncAttributeMaxDynamicSharedMemorySize, LDS_BYTES) != hipSuccess) { fprintf(stderr, "kernel_launch: hipFuncSetAttribute failed\n"); grid = -1; return; }
        if (hipOccupancyMaxActiveBlocksPerMultiprocessor(&per_cu, (const void*)k_mega, NTHREADS, LDS_BYTES) != hipSuccess || per_cu < 1)
            fprintf(stderr, "kernel_launch: note: occupancy query reports %d workgroups per CU\n", per_cu);
        (void)hipGetLastError();
        grid = cus;
    }
    if (grid < 0) return;
    if (hipMemsetAsync((char*)d_ws + WS_CTL, 0, CTL_ZERO_BYTES, stream) != hipSuccess) return;
    P p{};
    for (int i = 0; i < N_IN; ++i) p.in[i] = (const float*)d_in[i];
    p.out = (float*)d_out; p.ws = (unsigned char*)d_ws;
    hipLaunchKernelGGL(k_mega, dim3(grid), dim3(NTHREADS), LDS_BYTES, stream, p);
}
```
